# Optimizing an MI355X kernel written in HIP

```python
import math
import jax, jax.numpy as jnp
from jax import lax
import numpy as np

D_MODEL = 1024
BATCH = 8
SEQ = 2048
DEPTH = 1

SSM_WIDTH = D_MODEL // 2
SSM_GROUP = 16
SSM_GROUPS = SSM_WIDTH // SSM_GROUP
SSM_STATE = 64
ATTN_HEAD_DIM = 64
ATTN_HEADS = D_MODEL // (2 * ATTN_HEAD_DIM)
ATTN_WIDTH = ATTN_HEADS * 2 * ATTN_HEAD_DIM
Q_BLOCK = 128
IN_WIDTH = SSM_WIDTH + 3 * ATTN_WIDTH + 2 * D_MODEL
N_EXPERTS = 32
TOP_K = 4
D_FF = D_MODEL
SWIGLU_ALPHA = 1.702
SWIGLU_LIMIT = 7.0
MOE_BLOCK = 256
NORM_EPS = 1e-5

kernel_name = "hybrid_s5_diffattn_moe_block"


def rms_norm(x, gain, eps=NORM_EPS):
    xf = x.astype(jnp.float32)
    y = xf * lax.rsqrt(jnp.mean(xf * xf, axis=-1, keepdims=True) + eps)
    return (y * gain.astype(jnp.float32)).astype(x.dtype)


def _complex_linear_combine(e1, e2):
    a1r, a1i, b1r, b1i = e1
    a2r, a2i, b2r, b2i = e2
    ar = a1r * a2r - a1i * a2i
    ai = a1r * a2i + a1i * a2r
    br = a2r * b1r - a2i * b1i + b2r
    bi = a2r * b1i + a2i * b1r + b2i
    return (ar, ai, br, bi)


def s5_ssm(u, lambda_re, lambda_im, log_dt, b_re, b_im, c_re, c_im, d_skip):
    bsz, seq, _ = u.shape
    uf = u.astype(jnp.float32).reshape(bsz, seq, SSM_GROUPS, SSM_GROUP)
    dt = jnp.exp(log_dt.astype(jnp.float32))[:, None]
    lr = jnp.minimum(lambda_re.astype(jnp.float32), -1e-4)
    li = lambda_im.astype(jnp.float32)
    mag = jnp.exp(lr * dt)
    abar_re = mag * jnp.cos(li * dt)
    abar_im = mag * jnp.sin(li * dt)
    den = lr * lr + li * li
    nr = abar_re - 1.0
    coef_re = (nr * lr + abar_im * li) / den
    coef_im = (abar_im * lr - nr * li) / den
    br = b_re.astype(jnp.float32)
    bi = b_im.astype(jnp.float32)
    bbar_re = coef_re[..., None] * br - coef_im[..., None] * bi
    bbar_im = coef_re[..., None] * bi + coef_im[..., None] * br
    bu_re = jnp.einsum('bsgh,gph->bsgp', uf, bbar_re)
    bu_im = jnp.einsum('bsgh,gph->bsgp', uf, bbar_im)
    a_re = jnp.broadcast_to(abar_re, bu_re.shape)
    a_im = jnp.broadcast_to(abar_im, bu_im.shape)
    _, _, x_re, x_im = lax.associative_scan(
        _complex_linear_combine, (a_re, a_im, bu_re, bu_im), axis=1)
    y = (jnp.einsum('bsgp,ghp->bsgh', x_re, c_re.astype(jnp.float32))
         - jnp.einsum('bsgp,ghp->bsgh', x_im, c_im.astype(jnp.float32))
         + d_skip.astype(jnp.float32) * uf)
    return y.reshape(bsz, seq, SSM_WIDTH)


def diff_attention(q, k, v, q_gain, k_gain, lq1, lk1, lq2, lk2, subln_gain, lambda_init):
    bsz, seq, _ = q.shape
    q = rms_norm(q.reshape(bsz, seq, ATTN_HEADS, 2, ATTN_HEAD_DIM), q_gain)
    k = rms_norm(k.reshape(bsz, seq, ATTN_HEADS, 2, ATTN_HEAD_DIM), k_gain)
    q = q.transpose(0, 3, 2, 1, 4)
    k = k.transpose(0, 3, 2, 1, 4)
    v = v.reshape(bsz, seq, ATTN_HEADS, 2 * ATTN_HEAD_DIM).transpose(0, 2, 1, 3)
    lam = (jnp.exp(jnp.sum(lq1.astype(jnp.float32) * lk1.astype(jnp.float32)))
           - jnp.exp(jnp.sum(lq2.astype(jnp.float32) * lk2.astype(jnp.float32)))
           + lambda_init)
    scale = 1.0 / math.sqrt(ATTN_HEAD_DIM)
    outs = []
    for i in range(seq // Q_BLOCK):
        q0 = i * Q_BLOCK
        kend = q0 + Q_BLOCK
        s = jnp.einsum('bmhqd,bmhkd->bmhqk', q[:, :, :, q0:kend], k[:, :, :, :kend]).astype(jnp.float32) * scale
        mask = jnp.arange(kend)[None, :] <= (q0 + jnp.arange(Q_BLOCK))[:, None]
        p = jax.nn.softmax(jnp.where(mask, s, -jnp.inf), axis=-1)
        a = p[:, 0] - lam * p[:, 1]
        outs.append(jnp.einsum('bhqk,bhkv->bhqv', a.astype(v.dtype), v[:, :, :kend]))
    o = jnp.concatenate(outs, axis=2)
    o = rms_norm(o, subln_gain) * (1.0 - lambda_init)
    return o.transpose(0, 2, 1, 3).reshape(bsz, seq, ATTN_WIDTH)


def clamped_swiglu_expert(xb, w1, b1, w2, b2):
    h = xb @ w1 + b1
    gate = jnp.minimum(h[..., ::2], SWIGLU_LIMIT)
    up = jnp.clip(h[..., 1::2], -SWIGLU_LIMIT, SWIGLU_LIMIT)
    glu = gate * jax.nn.sigmoid(SWIGLU_ALPHA * gate)
    return ((up + 1.0) * glu) @ w2 + b2


def moe_ffn(h, w_router, b_router, w1, b1, w2, b2):
    bsz, seq, d = h.shape
    n_tok = bsz * seq
    xt = h.reshape(n_tok, d)
    logits = (xt @ w_router + b_router).astype(jnp.float32)
    top_vals, top_idx = lax.top_k(logits, TOP_K)
    gates = jax.nn.softmax(top_vals, axis=-1)
    n_pairs = n_tok * TOP_K
    e_flat = top_idx.reshape(-1).astype(jnp.int32)
    tok_flat = jnp.arange(n_pairs, dtype=jnp.int32) // TOP_K
    g_flat = gates.reshape(-1)
    order = jnp.argsort(e_flat)
    e_sorted = e_flat[order]
    counts = jnp.bincount(e_flat, length=N_EXPERTS)
    padded = (counts + MOE_BLOCK - 1) // MOE_BLOCK * MOE_BLOCK
    pad_end = jnp.cumsum(padded)
    pad_start = pad_end - padded
    grp_start = jnp.cumsum(counts) - counts
    dest = pad_start[e_sorted] + (jnp.arange(n_pairs, dtype=jnp.int32) - grp_start[e_sorted])
    n_slots = n_pairs + N_EXPERTS * MOE_BLOCK
    n_blocks = n_slots // MOE_BLOCK
    slot_tok = jnp.full((n_slots,), n_tok, jnp.int32).at[dest].set(tok_flat[order])
    slot_gate = jnp.zeros((n_slots,), jnp.float32).at[dest].set(g_flat[order])
    block_exp = jnp.minimum(
        jnp.searchsorted(pad_end, jnp.arange(n_blocks) * MOE_BLOCK, side='right'), N_EXPERTS - 1)
    x_pad = jnp.concatenate([xt, jnp.zeros((1, d), xt.dtype)], axis=0)
    xb = x_pad[slot_tok].reshape(n_blocks, MOE_BLOCK, d)

    def expert_block(args):
        xblk, e = args
        return clamped_swiglu_expert(xblk, w1[e], b1[e], w2[e], b2[e])

    yb = lax.map(expert_block, (xb, block_exp))
    y = yb.reshape(n_slots, d).astype(jnp.float32) * slot_gate[:, None]
    out = jax.ops.segment_sum(y, slot_tok, num_segments=n_tok + 1)[:n_tok]
    return out.reshape(bsz, seq, d).astype(h.dtype)


def setup_inputs(seed: int = 0) -> dict:
    key = jax.random.key(seed)
    ks = jax.random.split(key, 32)
    L, D, G, H, P = DEPTH, D_MODEL, SSM_GROUPS, SSM_GROUP, SSM_STATE
    nrm = lambda k, shape, s: jax.random.normal(k, shape, jnp.float32) * s
    lam_im0 = jnp.pi * jnp.arange(P, dtype=jnp.float32)
    return {
        "x": nrm(ks[0], (BATCH, SEQ, D), 1.0),
        "norm1_gain": 1.0 + nrm(ks[1], (L, D), 0.01),
        "w_in": nrm(ks[2], (L, D, IN_WIDTH), D ** -0.5),
        "lambda_re": -0.5 + nrm(ks[3], (L, G, P), 0.01),
        "lambda_im": lam_im0 + nrm(ks[4], (L, G, P), 0.01),
        "log_dt": jax.random.uniform(ks[5], (L, G), jnp.float32, math.log(1e-3), math.log(1e-1)),
        "ssm_b_re": nrm(ks[6], (L, G, P, H), (2 * H) ** -0.5),
        "ssm_b_im": nrm(ks[7], (L, G, P, H), (2 * H) ** -0.5),
        "ssm_c_re": nrm(ks[8], (L, G, H, P), P ** -0.5),
        "ssm_c_im": nrm(ks[9], (L, G, H, P), P ** -0.5),
        "ssm_d": nrm(ks[10], (L, G, H), 1.0),
        "w_glu": nrm(ks[11], (L, SSM_WIDTH, SSM_WIDTH), SSM_WIDTH ** -0.5),
        "b_glu": nrm(ks[12], (L, SSM_WIDTH), 0.01),
        "q_norm_gain": 1.0 + nrm(ks[13], (L, ATTN_HEAD_DIM), 0.01),
        "k_norm_gain": 1.0 + nrm(ks[14], (L, ATTN_HEAD_DIM), 0.01),
        "lambda_q1": nrm(ks[15], (L, ATTN_HEAD_DIM), 0.1),
        "lambda_k1": nrm(ks[16], (L, ATTN_HEAD_DIM), 0.1),
        "lambda_q2": nrm(ks[17], (L, ATTN_HEAD_DIM), 0.1),
        "lambda_k2": nrm(ks[18], (L, ATTN_HEAD_DIM), 0.1),
        "subln_gain": 1.0 + nrm(ks[19], (L, 2 * ATTN_HEAD_DIM), 0.01),
        "w_proj_ssm": nrm(ks[20], (L, SSM_WIDTH, D), SSM_WIDTH ** -0.5),
        "w_proj_attn": nrm(ks[21], (L, ATTN_WIDTH, D), ATTN_WIDTH ** -0.5),
        "w_out": nrm(ks[22], (L, D, D), D ** -0.5),
        "norm2_gain": 1.0 + nrm(ks[23], (L, D), 0.01),
        "w_router": nrm(ks[24], (L, D, N_EXPERTS), D ** -0.5),
        "b_router": nrm(ks[25], (L, N_EXPERTS), 0.01),
        "w_exp1": nrm(ks[26], (L, N_EXPERTS, D, 2 * D_FF), D ** -0.5),
        "b_exp1": nrm(ks[27], (L, N_EXPERTS, 2 * D_FF), 0.01),
        "w_exp2": nrm(ks[28], (L, N_EXPERTS, D_FF, D), D_FF ** -0.5),
        "b_exp2": nrm(ks[29], (L, N_EXPERTS, D), 0.01),
    }


def reference(x, norm1_gain, w_in, lambda_re, lambda_im, log_dt, ssm_b_re, ssm_b_im, ssm_c_re,
              ssm_c_im, ssm_d, w_glu, b_glu, q_norm_gain, k_norm_gain, lambda_q1, lambda_k1,
              lambda_q2, lambda_k2, subln_gain, w_proj_ssm, w_proj_attn, w_out, norm2_gain,
              w_router, b_router, w_exp1, b_exp1, w_exp2, b_exp2):
    splits = np.cumsum([SSM_WIDTH, ATTN_WIDTH, ATTN_WIDTH, ATTN_WIDTH, D_MODEL]).tolist()
    for l in range(DEPTH):
        lambda_init = 0.8 - 0.6 * math.exp(-0.3 * l)
        h = rms_norm(x, norm1_gain[l])
        proj = h @ w_in[l]
        u_ssm, q, k, v, g_ssm, g_attn = jnp.split(proj, splits, axis=-1)
        y = s5_ssm(u_ssm, lambda_re[l], lambda_im[l], log_dt[l], ssm_b_re[l], ssm_b_im[l],
                   ssm_c_re[l], ssm_c_im[l], ssm_d[l])
        z = jax.nn.gelu(y)
        ssm_out = (z * jax.nn.sigmoid(z @ w_glu[l].astype(jnp.float32) + b_glu[l])).astype(x.dtype)
        attn_out = diff_attention(q, k, v, q_norm_gain[l], k_norm_gain[l], lambda_q1[l], lambda_k1[l],
                                  lambda_q2[l], lambda_k2[l], subln_gain[l], lambda_init)
        merged = (jax.nn.sigmoid(g_ssm) * (ssm_out @ w_proj_ssm[l])
                  + jax.nn.sigmoid(g_attn) * (attn_out @ w_proj_attn[l]))
        x = x + merged @ w_out[l]
        h2 = rms_norm(x, norm2_gain[l])
        x = x + moe_ffn(h2, w_router[l], b_router[l], w_exp1[l], b_exp1[l], w_exp2[l], b_exp2[l])
    return x
```

```cpp
#include <hip/hip_runtime.h>
#include <hip/hip_bf16.h>
#include <stdint.h>
#include <math.h>
#include <cstdio>

constexpr int D = 1024, BATCH = 8, SEQ = 2048, T = BATCH * SEQ;
constexpr int SSM_W = 512, SSM_H = 16, SSM_G = 32, SSM_P = 64;
constexpr int CH_L = 32, NCH = SEQ / CH_L;
constexpr int ACAT_ROWS = BATCH * NCH;
constexpr int ACAT_LD = CH_L * SSM_H + 2 * SSM_P;
constexpr int AH = 8, AW = 1024;
constexpr int IN_W = 5632;
constexpr int NE = 32, DFF = 1024;
constexpr float EPS = 1e-5f;
constexpr int OFF_U = 0, OFF_Q = 512, OFF_K = 1536, OFF_V = 2560, OFF_GS = 3584, OFF_GA = 4608;
constexpr int CAP = T;
constexpr int MAXBLK = 288;
constexpr float QC2 = 0.125f * 1.4426950408889634f;
constexpr int MA_LD = 1536;

constexpr size_t MiB = 1u << 20;
constexpr size_t WS_CTL = 0, CTL_ZERO_BYTES = 64 * 1024;
constexpr size_t WS_WIN_T = 2 * MiB;
constexpr size_t WS_WGLU_T = 13 * MiB;
constexpr size_t WS_WP_T = 14 * MiB;
constexpr size_t WS_WOUT_T = 17 * MiB;
constexpr size_t WS_WR_T = 19 * MiB;
constexpr size_t WS_KJ = 21 * MiB;
constexpr size_t WS_WS_T = 22 * MiB;
constexpr size_t WS_BT_SSM = 26 * MiB;
constexpr size_t WS_W1_T = 48 * MiB;
constexpr size_t WS_W2_T = 176 * MiB;
constexpr size_t WS_XN = 240 * MiB;
constexpr size_t WS_ACAT = 272 * MiB;
constexpr size_t WS_Q = 292 * MiB, WS_K = 324 * MiB, WS_V = 356 * MiB;
constexpr size_t WS_GS = 388 * MiB, WS_GA = 420 * MiB;
constexpr size_t WS_X1 = 292 * MiB;
constexpr size_t WS_Z = 452 * MiB;
constexpr size_t WS_MA = 468 * MiB;
constexpr size_t WS_MERGED = 516 * MiB;
constexpr size_t WS_H2 = 548 * MiB;
constexpr size_t WS_SLOT_TOK = 582 * MiB;
constexpr size_t WS_SLOT_GATE = 584 * MiB;
constexpr size_t WS_TOK_EP = 586 * MiB;
constexpr size_t WS_ACT = 588 * MiB;
constexpr size_t WS_Y = 732 * MiB;
constexpr size_t WS_END = 876 * MiB;
constexpr int CW_CNT = 64;
constexpr int CW_BAR = 4096;

typedef unsigned short bf16_t;
typedef short bf16x8 __attribute__((ext_vector_type(8)));
typedef float f32x4 __attribute__((ext_vector_type(4)));
typedef float f32x2 __attribute__((ext_vector_type(2)));
typedef unsigned u32x4 __attribute__((ext_vector_type(4)));
typedef unsigned u32x2 __attribute__((ext_vector_type(2)));
#define LAS __attribute__((address_space(3)))
#define GAS __attribute__((address_space(1)))

__device__ __forceinline__ float wave_sum(float v) {
#pragma unroll
    for (int o = 1; o < 64; o <<= 1) v += __shfl_xor(v, o);
    return v;
}
typedef __bf16 bf16x2_hw __attribute__((ext_vector_type(2)));
__device__ __forceinline__ unsigned pk2(float lo, float hi) { const f32x2 v = {lo, hi}; return __builtin_bit_cast(unsigned, __builtin_convertvector(v, bf16x2_hw)); }
__device__ __forceinline__ unsigned f2bf(float f) { return pk2(f, 0.f) & 0xffffu; }
__device__ __forceinline__ float bf2f(unsigned short b) { return __builtin_bit_cast(float, (unsigned)b << 16); }
__device__ __forceinline__ float bflo(unsigned w) { return __builtin_bit_cast(float, w << 16); }
__device__ __forceinline__ float bfhi(unsigned w) { return __builtin_bit_cast(float, w & 0xffff0000u); }
__device__ __forceinline__ float sigmoid_f(float x) { return __builtin_amdgcn_rcpf(1.f + __expf(-x)); }
__device__ __forceinline__ float sigmoid_c(float x) { x = fminf(fmaxf(x, -30.f), 30.f); return __builtin_amdgcn_rcpf(1.f + __expf(-x)); }
__device__ __forceinline__ float gelu_tanh(float x) { const float u = 0.7978845608028654f * (x + 0.044715f * x * x * x); return x * sigmoid_f(2.f * u); }

__device__ __forceinline__ unsigned pk4_fp8(float a, float b, float cc, float d) { int w = 0; w = __builtin_amdgcn_cvt_pk_fp8_f32(a, b, w, false); w = __builtin_amdgcn_cvt_pk_fp8_f32(cc, d, w, true); return (unsigned)w; }
__device__ __forceinline__ void unpk4_fp8(unsigned w, float& a, float& b, float& cc, float& d) { const f32x2 lo = __builtin_amdgcn_cvt_pk_f32_fp8((int)w, false), hi = __builtin_amdgcn_cvt_pk_f32_fp8((int)w, true); a = lo.x; b = lo.y; cc = hi.x; d = hi.y; }
constexpr float W8_SCALE = 64.f;
#ifndef WT_STORES
#define WT_STORES 0
#endif
__device__ __forceinline__ void store16(void* p, const u32x4 v) {
#if WT_STORES
    asm volatile("global_store_dwordx4 %0, %1, off sc1\n\ts_nop 1" :: "v"(p), "v"(v) : "memory");
#else
    *(u32x4*)p = v;
#endif
}
#ifndef NT_STREAMS
#define NT_STREAMS 1
#endif
#if NT_STREAMS
#define NT_LOAD(p) __builtin_nontemporal_load(p)
#define NT_STORE(v, p) __builtin_nontemporal_store((v), (p))
#else
#define NT_LOAD(p) (*(p))
#define NT_STORE(v, p) (*(p) = (v))
#endif
__device__ __forceinline__ int opaque_tid() { int t = threadIdx.x; asm volatile("" : "+v"(t)); return t; }

struct Params {
    const float* in[30];
    float* out;
    unsigned char* ws;
};
enum { I_X = 0, I_G1, I_WIN, I_LRE, I_LIM, I_LOGDT, I_BRE, I_BIM, I_CRE, I_CIM, I_DSK, I_WGLU, I_BGLU, I_QG, I_KG, I_LQ1, I_LK1, I_LQ2, I_LK2, I_SG, I_WPS, I_WPA, I_WOUT, I_G2, I_WR, I_BR, I_W1, I_B1, I_W2, I_B2 };

constexpr int NWAVES = 8, NTHREADS = 512;
constexpr int LDS_BYTES = 147456;
constexpr int RING_BYTES = 131072;
constexpr int MISC_OFF = RING_BYTES + 320;
__device__ __forceinline__ void p0_transpose_item(const float* __restrict__ W, int N, bf16_t* __restrict__ WT, int ldo, int k_off, LAS float* scr, int kb, int nb, int lane) {
    const int k0 = 64 * kb, n0 = 32 * nb;
    { f32x4 v[8];
#pragma unroll
        for (int i = 0; i < 8; ++i) v[i] = NT_LOAD((const f32x4*)(W + (size_t)(k0 + 8 * i + (lane >> 3)) * N + n0 + (lane & 7) * 4));
#pragma unroll
        for (int i = 0; i < 8; ++i) { LAS float* d = scr + (8 * i + (lane >> 3)) * 33 + (lane & 7) * 4; d[0] = v[i].x; d[1] = v[i].y; d[2] = v[i].z; d[3] = v[i].w; } }
    asm volatile("s_waitcnt lgkmcnt(0)" ::: "memory");
    const int c = lane & 7;
#pragma unroll
    for (int j = 0; j < 4; ++j) { const int n = (lane >> 3) + 8 * j; const LAS float* s = scr + (8 * c) * 33 + n;
        u32x4 o; o.x = pk2(s[0 * 33], s[1 * 33]); o.y = pk2(s[2 * 33], s[3 * 33]); o.z = pk2(s[4 * 33], s[5 * 33]); o.w = pk2(s[6 * 33], s[7 * 33]);
        *(u32x4*)(WT + (size_t)(n0 + n) * ldo + k_off + k0 + 8 * c) = o; }
    asm volatile("s_waitcnt lgkmcnt(0)" ::: "memory");
}
__device__ __forceinline__ void p0_transpose_item_fp8(const float* __restrict__ W, int N, unsigned char* __restrict__ WT, int ldo, LAS float* scr, int kb, int nb, int lane) {
    const int k0 = 64 * kb, n0 = 32 * nb;
    { f32x4 v[8];
#pragma unroll
        for (int i = 0; i < 8; ++i) v[i] = NT_LOAD((const f32x4*)(W + (size_t)(k0 + 8 * i + (lane >> 3)) * N + n0 + (lane & 7) * 4));
#pragma unroll
        for (int i = 0; i < 8; ++i) { LAS float* d = scr + (8 * i + (lane >> 3)) * 33 + (lane & 7) * 4; d[0] = v[i].x; d[1] = v[i].y; d[2] = v[i].z; d[3] = v[i].w; } }
    asm volatile("s_waitcnt lgkmcnt(0)" ::: "memory");
    const int n = lane >> 1, half = lane & 1; const LAS float* s = scr + (32 * half) * 33 + n;
    unsigned o[8];
#pragma unroll
    for (int q = 0; q < 8; ++q) o[q] = pk4_fp8(s[(4 * q) * 33] * W8_SCALE, s[(4 * q + 1) * 33] * W8_SCALE, s[(4 * q + 2) * 33] * W8_SCALE, s[(4 * q + 3) * 33] * W8_SCALE);
    u32x4* dst = (u32x4*)(WT + (size_t)(n0 + n) * ldo + k0 + 32 * half);
    dst[0] = (u32x4){o[0], o[1], o[2], o[3]}; dst[1] = (u32x4){o[4], o[5], o[6], o[7]};
    asm volatile("s_waitcnt lgkmcnt(0)" ::: "memory");
}
__device__ __forceinline__ void p0_transpose_f32_item(const float* __restrict__ W, float* __restrict__ WT, int K, LAS float* scr, int kb, int lane) {
    const int k0 = 64 * kb;
#pragma unroll 8
    for (int i = 0; i < 32; ++i) { const int kk = 2 * i + (lane >> 5); scr[kk * 33 + (lane & 31)] = W[(size_t)(k0 + kk) * 32 + (lane & 31)]; }
    asm volatile("s_waitcnt lgkmcnt(0)" ::: "memory");
#pragma unroll 8
    for (int n = 0; n < 32; ++n) WT[(size_t)n * K + k0 + lane] = scr[lane * 33 + n];
    asm volatile("s_waitcnt lgkmcnt(0)" ::: "memory");
}
__device__ __forceinline__ void rms_row_to_bf16(const float* __restrict__ xrow, const float* __restrict__ g, bf16_t* __restrict__ orow, int lane) {
    const f32x4* xr = (const f32x4*)xrow + lane; const f32x4* gr = (const f32x4*)g + lane;
    f32x4 v[4]; float s = 0.f;
#pragma unroll
    for (int j = 0; j < 4; ++j) { v[j] = NT_LOAD(xr + 64 * j); s += (v[j].x * v[j].x + v[j].y * v[j].y) + (v[j].z * v[j].z + v[j].w * v[j].w); }
    const float r = rsqrtf(wave_sum(s) * (1.f / D) + EPS);
    u32x2* o8 = (u32x2*)orow + lane;
#pragma unroll
    for (int j = 0; j < 4; ++j) { const f32x4 gg = gr[64 * j]; u32x2 w; w.x = pk2(v[j].x * r * gg.x, v[j].y * r * gg.y); w.y = pk2(v[j].z * r * gg.z, v[j].w * r * gg.w); o8[64 * j] = w; }
}
struct SsmGP { float lrdt, lidt, cr, ci; };
__device__ __forceinline__ SsmGP ssm_gp(const Params& P, int g, int p) {
    const float dt = expf(P.in[I_LOGDT][g]);
    const float lr = fminf(P.in[I_LRE][g * SSM_P + p], -1e-4f), li = P.in[I_LIM][g * SSM_P + p];
    const float mag = expf(lr * dt);
    float sn, cs; sincosf(li * dt, &sn, &cs);
    const float ar = mag * cs, ai = mag * sn;
    const float den = lr * lr + li * li, nr = ar - 1.f;
    SsmGP r; r.lrdt = lr * dt; r.lidt = li * dt; r.cr = (nr * lr + ai * li) / den; r.ci = (ai * lr - nr * li) / den;
    return r;
}
__device__ __forceinline__ void ssm_pow(const SsmGP& q, int j, float& pr, float& pi) {
    const float m = expf((float)j * q.lrdt); float sn, cs; sincosf((float)j * q.lidt, &sn, &cs); pr = m * cs; pi = m * sn;
}

#ifndef EXP_DMA_AUX
#define EXP_DMA_AUX 2
#endif
struct ExpItem { const float* W; unsigned char* WT; int N, ldo, kb, nb; };
__device__ __forceinline__ ExpItem exp_item(const Params& P, int it) {
    constexpr int I_E1 = (1024 / 128) * (2048 / 32), I_E2 = (1024 / 128) * (1024 / 32);
    ExpItem x;
    if (it < NE * I_E1) { const int e = it / I_E1, q = it % I_E1; x.W = P.in[I_W1] + (size_t)e * D * 2 * DFF; x.WT = P.ws + WS_W1_T + (size_t)e * 2 * DFF * D; x.N = 2 * DFF; x.ldo = D; x.kb = q / 64; x.nb = q % 64; }
    else { const int r = it - NE * I_E1, e = r / I_E2, q = r % I_E2; x.W = P.in[I_W2] + (size_t)e * DFF * D; x.WT = P.ws + WS_W2_T + (size_t)e * D * DFF; x.N = D; x.ldo = DFF; x.kb = q / 32; x.nb = q % 32; }
    return x;
}
__device__ __forceinline__ void exp_dma(const ExpItem& x, int lane, LAS unsigned char* buf) {
    const float* src = x.W + (size_t)(128 * x.kb + (lane >> 3)) * x.N + 32 * x.nb;
#pragma unroll
    for (int i = 0; i < 16; ++i) __builtin_amdgcn_global_load_lds((const unsigned*)(src + (size_t)(8 * i) * x.N + ((((lane & 7) ^ (lane >> 3) ^ (i >> 1)) & 7) << 2)), (LAS unsigned*)(buf + i * 1024), 16, 0, EXP_DMA_AUX);
}
#if defined(PROBE_CONV_NOSTORE)
#define g_conv_nostore nostore_
__device__ __forceinline__ void exp_finish_lds(const ExpItem& x, int lane, const LAS unsigned char* buf, bool nostore_ = false) {
#else
__device__ __forceinline__ void exp_finish_lds(const ExpItem& x, int lane, const LAS unsigned char* buf) {
#endif
    const int c = lane & 7;
#pragma unroll
    for (int pass = 0; pass < 4; ++pass) {
        const int n = 8 * pass + (lane >> 3), q0 = (n >> 2) ^ c;
        const LAS unsigned char* rb = buf + c * 2048 + ((n & 3) << 2);
        float f[16];
#pragma unroll
        for (int j = 0; j < 16; ++j) f[j] = *(const LAS float*)(rb + j * 128 + (((q0 ^ j) & 7) << 4)) * W8_SCALE;
        const u32x4 o = (u32x4){pk4_fp8(f[0], f[1], f[2], f[3]), pk4_fp8(f[4], f[5], f[6], f[7]), pk4_fp8(f[8], f[9], f[10], f[11]), pk4_fp8(f[12], f[13], f[14], f[15])};
#if defined(PROBE_CONV_NOSTORE)
        if (g_conv_nostore) { asm volatile("" :: "v"(o)); } else
#endif
#if NT_STREAMS && !defined(CONV_ST_DEFAULT)
        __builtin_nontemporal_store(o, (u32x4*)(x.WT + (size_t)(32 * x.nb + n) * x.ldo + 128 * x.kb + 16 * c));
#else
        *(u32x4*)(x.WT + (size_t)(32 * x.nb + n) * x.ldo + 128 * x.kb + 16 * c) = o;
#endif
    }
    asm volatile("s_waitcnt lgkmcnt(0)" ::: "memory");
}
constexpr int EXP_ITEMS = NE * ((1024 / 128) * (2048 / 32) + (1024 / 128) * (1024 / 32));
constexpr int EXP_N_IN = 32, EXP_N_S2 = 20, EXP_N_GLU = 20, EXP_N_M1 = 0;
constexpr int EXP_IN0 = 0, EXP_S20 = 128 * EXP_N_IN, EXP_GLU0 = EXP_S20 + 128 * EXP_N_S2, EXP_ATT0 = EXP_GLU0 + 128 * EXP_N_GLU, EXP_M10 = EXP_ITEMS - 128 * EXP_N_M1;
static_assert((EXP_M10 - EXP_ATT0) % 256 == 0 && EXP_M10 >= NE * (1024 / 128) * (2048 / 32), "item split (the expert-GEMM-1 tail share must be W2 items only)");
__device__ __forceinline__ void expert_convert_slice(const Params& P, LAS unsigned char* lds, int i0, int i1, bool probe_nostore = false) {
    const int tid = opaque_tid(), lane = tid & 63, wave = __builtin_amdgcn_readfirstlane(tid >> 6);
    LAS unsigned char* b0 = lds + wave * 16384;
    for (int it = i0 + wave; it < i1; it += NWAVES) {
        const ExpItem c0 = exp_item(P, it);
        exp_dma(c0, lane, b0);
        asm volatile("s_waitcnt vmcnt(0)" ::: "memory");
#if defined(PROBE_CONV_NOSTORE)
        exp_finish_lds(c0, lane, b0, probe_nostore);
#else
        exp_finish_lds(c0, lane, b0);
#endif
    }
}
__device__ __forceinline__ void p0_prologue(const Params& P, LAS unsigned char* lds, int vcu, int G) {
    const int tid = opaque_tid(), lane = tid & 63, wave = __builtin_amdgcn_readfirstlane(tid >> 6);
    LAS float* scr = (LAS float*)(lds + wave * 16384);
    unsigned char* ws = P.ws;
    const int gw = vcu * NWAVES + wave, NGW = G * NWAVES;
    constexpr int I_IN = (D / 64) * (IN_W / 32);
    constexpr int I_GLU = (512 / 64) * (512 / 32);
    constexpr int I_PS = (512 / 64) * (1024 / 32);
    constexpr int I_PA = (1024 / 64) * (1024 / 32);
    constexpr int I_OUT = I_PA;
    constexpr int I_R = 1024 / 64;
    constexpr int I_E1 = (1024 / 64) * (2048 / 32);
    constexpr int I_E2 = (1024 / 64) * (1024 / 32);
#ifndef EXPERTS_IN_ATTN
#define EXPERTS_IN_ATTN 1
#endif
    constexpr int NITEMS = I_IN + I_GLU + I_PS + I_PA + I_OUT + I_R + (EXPERTS_IN_ATTN ? 0 : NE * I_E1 + NE * I_E2);
    for (int it = gw; it < NITEMS; it += NGW) {
        int r = it;
        if (r < I_IN) { const int nblk = IN_W / 32; p0_transpose_item(P.in[I_WIN], IN_W, (bf16_t*)(ws + WS_WIN_T), D, 0, scr, r / nblk, r % nblk, lane); continue; } r -= I_IN;
        if (r < I_GLU) { const int nblk = 512 / 32; p0_transpose_item(P.in[I_WGLU], 512, (bf16_t*)(ws + WS_WGLU_T), 512, 0, scr, r / nblk, r % nblk, lane); continue; } r -= I_GLU;
        if (r < I_PS) { const int nblk = 1024 / 32; p0_transpose_item(P.in[I_WPS], 1024, (bf16_t*)(ws + WS_WP_T), MA_LD, 1024, scr, r / nblk, r % nblk, lane); continue; } r -= I_PS;
        if (r < I_PA) { const int nblk = 1024 / 32; p0_transpose_item(P.in[I_WPA], 1024, (bf16_t*)(ws + WS_WP_T), MA_LD, 0, scr, r / nblk, r % nblk, lane); continue; } r -= I_PA;
        if (r < I_OUT) { const int nblk = 1024 / 32; p0_transpose_item(P.in[I_WOUT], 1024, (bf16_t*)(ws + WS_WOUT_T), D, 0, scr, r / nblk, r % nblk, lane); continue; } r -= I_OUT;
        if (r < I_R) { p0_transpose_f32_item(P.in[I_WR], (float*)(ws + WS_WR_T), D, scr, r, lane); continue; } r -= I_R;
        if (EXPERTS_IN_ATTN) continue;
        if (r < NE * I_E1) { const int e = r / I_E1, q = r % I_E1, nblk = 2048 / 32;
            p0_transpose_item_fp8(P.in[I_W1] + (size_t)e * D * 2 * DFF, 2 * DFF, ws + WS_W1_T + (size_t)e * 2 * DFF * D, D, scr, q / nblk, q % nblk, lane); continue; } r -= NE * I_E1;
        { const int e = r / I_E2, q = r % I_E2, nblk = 1024 / 32;
            p0_transpose_item_fp8(P.in[I_W2] + (size_t)e * DFF * D, D, ws + WS_W2_T + (size_t)e * D * DFF, DFF, scr, q / nblk, q % nblk, lane); }
    }
#if EXPERTS_IN_ATTN
    if (G != 256) { __syncthreads(); for (int c0 = vcu * 64; c0 < EXP_ATT0; c0 += G * 64) expert_convert_slice(P, lds, c0, min(EXP_ATT0, c0 + 64));
        for (int c0 = EXP_M10 + vcu * 64; c0 < EXP_ITEMS; c0 += G * 64) expert_convert_slice(P, lds, c0, min(EXP_ITEMS, c0 + 64)); __syncthreads(); }
#endif
    for (int m = gw; m < T; m += NGW) rms_row_to_bf16(P.in[I_X] + (size_t)m * D, P.in[I_G1], (bf16_t*)(ws + WS_XN) + (size_t)m * D, lane);
    if (gw == 0) { u32x4* z = (u32x4*)(ws + WS_H2 + (size_t)T * D); z[lane] = (u32x4){0u, 0u, 0u, 0u}; }
    const int gt = vcu * NTHREADS + tid, NGT = G * NTHREADS;
    for (int it = gw; it < SSM_G * CH_L; it += NGW) {
        const int g = it / CH_L, j = it % CH_L, h = lane >> 2, hq = (lane & 3) * 4;
        { const SsmGP q = ssm_gp(P, g, lane); float pr, pi; ssm_pow(q, j, pr, pi); scr[2 * lane] = pr * q.cr - pi * q.ci; scr[2 * lane + 1] = pr * q.ci + pi * q.cr; }
        asm volatile("s_waitcnt lgkmcnt(0)" ::: "memory");
        float a0 = 0.f, a1 = 0.f, a2 = 0.f, a3 = 0.f;
#pragma unroll 4
        for (int p = 0; p < SSM_P; ++p) {
            const float wr = scr[2 * p], wi = scr[2 * p + 1];
            const float cre = P.in[I_CRE][(g * SSM_H + h) * SSM_P + p], cim = P.in[I_CIM][(g * SSM_H + h) * SSM_P + p];
            const float mr = cre * wr - cim * wi, mi = cre * wi + cim * wr;
            const f32x4 br = *(const f32x4*)(P.in[I_BRE] + (g * SSM_P + p) * SSM_H + hq), bi = *(const f32x4*)(P.in[I_BIM] + (g * SSM_P + p) * SSM_H + hq);
            a0 += mr * br.x - mi * bi.x; a1 += mr * br.y - mi * bi.y; a2 += mr * br.z - mi * bi.z; a3 += mr * br.w - mi * bi.w;
        }
        if (j == 0) { const float dsk = P.in[I_DSK][g * SSM_H + h]; if (hq == (h & 12)) { const int w = h & 3; if (w == 0) a0 += dsk; else if (w == 1) a1 += dsk; else if (w == 2) a2 += dsk; else a3 += dsk; } }
        *(f32x4*)((float*)(ws + WS_KJ) + ((size_t)(g * CH_L + j) * SSM_H + h) * SSM_H + hq) = (f32x4){a0, a1, a2, a3};
        asm volatile("s_waitcnt lgkmcnt(0)" ::: "memory");
    }
    for (int it = gt; it < SSM_G * 128 * CH_L; it += NGT) {
        const int s = it % CH_L, n = (it / CH_L) % 128, g = it / (CH_L * 128), p = n & 63, part = n >> 6;
        const SsmGP q = ssm_gp(P, g, p); float pr, pi; ssm_pow(q, CH_L - 1 - s, pr, pi);
        const float wr = pr * q.cr - pi * q.ci, wi = pr * q.ci + pi * q.cr;
        const float* br = P.in[I_BRE] + (g * SSM_P + p) * SSM_H; const float* bi = P.in[I_BIM] + (g * SSM_P + p) * SSM_H;
        unsigned o[8];
#pragma unroll
        for (int h2 = 0; h2 < 8; ++h2) {
            float v0, v1;
            if (part == 0) { v0 = wr * br[2 * h2] - wi * bi[2 * h2]; v1 = wr * br[2 * h2 + 1] - wi * bi[2 * h2 + 1]; }
            else { v0 = wr * bi[2 * h2] + wi * br[2 * h2]; v1 = wr * bi[2 * h2 + 1] + wi * br[2 * h2 + 1]; }
            o[h2] = pk2(v0, v1);
        }
        u32x4* dst = (u32x4*)((bf16_t*)(ws + WS_WS_T) + ((size_t)(g * 128 + n) * 512 + s * 16));
        dst[0] = (u32x4){o[0], o[1], o[2], o[3]}; dst[1] = (u32x4){o[4], o[5], o[6], o[7]};
    }
    for (int it = gt; it < SSM_G * CH_L * SSM_P; it += NGT) {
        const int p = it % SSM_P, t = (it / SSM_P) % CH_L, g = it / (SSM_P * CH_L);
        const SsmGP q = ssm_gp(P, g, p); float pr, pi; ssm_pow(q, t + 1, pr, pi);
        bf16_t* base = (bf16_t*)(ws + WS_BT_SSM) + ((size_t)(g * 512 + t * 16)) * ACAT_LD + 512 + p;
#pragma unroll 4
        for (int h = 0; h < SSM_H; ++h) {
            const float cre = P.in[I_CRE][(g * SSM_H + h) * SSM_P + p], cim = P.in[I_CIM][(g * SSM_H + h) * SSM_P + p];
            base[(size_t)h * ACAT_LD] = (bf16_t)f2bf(cre * pr - cim * pi);
            base[(size_t)h * ACAT_LD + 64] = (bf16_t)f2bf(-(cre * pi + cim * pr));
        }
    }
}
__device__ __forceinline__ void ssm_toeplitz_expand(const Params& P, int vcu, int G) {
    const int gt = vcu * NTHREADS + opaque_tid(), NGT = G * NTHREADS;
    unsigned char* ws = P.ws;
    for (int it = gt; it < SSM_G * 512 * 64; it += NGT) {
        const int kc = it & 63, n = (it >> 6) & 511, g = it >> 15;
        const int s = kc >> 1, hq = (kc & 1) * 8, t = n >> 4, h = n & 15;
        u32x4 o = (u32x4){0u, 0u, 0u, 0u};
        if (s <= t) { const float* kj = (const float*)(ws + WS_KJ) + ((size_t)(g * CH_L + (t - s)) * SSM_H + h) * SSM_H + hq;
            const f32x4 a = *(const f32x4*)kj, b = *(const f32x4*)(kj + 4);
            o.x = pk2(a.x, a.y); o.y = pk2(a.z, a.w); o.z = pk2(b.x, b.y); o.w = pk2(b.z, b.w); }
        *(u32x4*)((bf16_t*)(ws + WS_BT_SSM) + ((size_t)(g * 512 + n)) * ACAT_LD + kc * 8) = o;
    }
}
#ifndef PG_WGM
#define PG_WGM 8
#endif
namespace pg {
constexpr int BM = 256, BK = 64, HALF = 128, HTB = HALF * BK * 2, STAGE_BYTES = 8 * HTB;
__host__ __device__ __forceinline__ int lds_byte(int r, int c) { const int st = (r >> 4) * 2 + (c >> 5), rr = r & 15, cc = c & 31, ob = rr * 64 + cc * 2; return st * 1024 + (ob ^ (((ob >> 9) & 1) << 5)); }
__host__ __device__ __forceinline__ void stage_rc(int b, int& R, int& C) { const int st = b / 1024, sb = b % 1024, swz = sb ^ (((sb >> 9) & 1) << 5); R = (st >> 1) * 16 + swz / 64; C = (st & 1) * 32 + (swz % 64) / 2; }
__host__ __device__ __forceinline__ int perm32(int rho) { const int n = rho >> 4, i = rho & 15; return 8 * (i >> 2) + 4 * n + (i & 3); }

struct Unit {
    const char* A;
    const char* B;
    unsigned aoff[2][2];
    int pm, pn, aux, aux2;
    int ord;
};
struct EpiInfo { int pm, pn, aux, aux2, ord; };
typedef f32x4 Acc[2][2][4][2];

typedef int v8i_t __attribute__((ext_vector_type(8)));
typedef int v4i_t __attribute__((ext_vector_type(4)));
template <bool FP8 = false, int BAUX = 0  , class Sched, class Epi>
__device__ __forceinline__ void gemm_phase(LAS unsigned char* lds, const Sched& S, const Epi& E, const int nt, const int ldb, const int ktm = -1  ) {
    const int tid = opaque_tid(), wid = __builtin_amdgcn_readfirstlane(tid >> 6), lane = tid & 63, wr = wid >> 2, wc = wid & 3, fr = lane & 15, fq = lane >> 4;
    unsigned voffB[2];
#pragma unroll
    for (int i = 0; i < 2; ++i) { int R, C; stage_rc(tid * 16 + i * 8192, R, C); voffB[i] = (unsigned)((64 * (R >> 5) + perm32(R & 31)) * ldb + C) * 2u; }
    const unsigned hB = (unsigned)(32 * ldb * 2);
    const unsigned ldsw = (unsigned)wid * 1024u;
    const int aoffl = lds_byte(wr * 64 + fr, fq * 8), boffl = lds_byte(wc * 32 + fr, fq * 8);
#define PG_SA(b, h) (((b) * 2 + (h)) * pg::HTB)
#define PG_SB(b, h) ((4 + (b) * 2 + (h)) * pg::HTB)
#define PG_GLDS(gp, bufoff, i) __builtin_amdgcn_global_load_lds((const unsigned*)(gp), (LAS unsigned*)(lds + (bufoff) + ldsw + (i) * 8192), 16, 0, 0)
#define PG_STAGE_A(bufoff, Ab, o0, o1, kt) do { const char* _b = (Ab) + (size_t)((kt) & ktm) * 128; PG_GLDS(_b + (o0), bufoff, 0); PG_GLDS(_b + (o1), bufoff, 1); } while (0)
#define PG_GLDSB(gp, bufoff, i) __builtin_amdgcn_global_load_lds((const unsigned*)(gp), (LAS unsigned*)(lds + (bufoff) + ldsw + (i) * 8192), 16, 0, BAUX)
#define PG_STAGE_B(bufoff, Bb, h, kt) do { const char* _b = (Bb) + (size_t)((kt) & ktm) * 128 + (h) * hB; PG_GLDSB(_b + voffB[0], bufoff, 0); PG_GLDSB(_b + voffB[1], bufoff, 1); } while (0)
#define PG_LDA(dst, b, h) do { _Pragma("unroll") for (int m = 0; m < 4; ++m) _Pragma("unroll") for (int k = 0; k < 2; ++k) dst[m][k] = *(const LAS bf16x8*)(lds + PG_SA(b, h) + aoffl + m * 2048 + k * 1024); } while (0)
#define PG_LDB(dst, b, h) do { _Pragma("unroll") for (int n = 0; n < 2; ++n) _Pragma("unroll") for (int k = 0; k < 2; ++k) dst[n][k] = *(const LAS bf16x8*)(lds + PG_SB(b, h) + boffl + n * 2048 + k * 1024); } while (0)
#define PG_CAT8(lo, hi) __builtin_shufflevector(__builtin_bit_cast(v4i_t, lo), __builtin_bit_cast(v4i_t, hi), 0, 1, 2, 3, 4, 5, 6, 7)
#define PG_MMA(ai, bj, At, Bt) do { __builtin_amdgcn_s_setprio(1); if constexpr (FP8) { _Pragma("unroll") for (int m = 0; m < 4; ++m) _Pragma("unroll") for (int n = 0; n < 2; ++n) \
            acc[ai][bj][m][n] = __builtin_amdgcn_mfma_scale_f32_16x16x128_f8f6f4(PG_CAT8(Bt[n][0], Bt[n][1]), PG_CAT8(At[m][0], At[m][1]), acc[ai][bj][m][n], 0, 0, 0, 0x79797979, 0, 0x7f7f7f7f); } \
        else { _Pragma("unroll") for (int m = 0; m < 4; ++m) _Pragma("unroll") for (int n = 0; n < 2; ++n) _Pragma("unroll") for (int k = 0; k < 2; ++k) \
        acc[ai][bj][m][n] = __builtin_amdgcn_mfma_f32_16x16x32_bf16(Bt[n][k], At[m][k], acc[ai][bj][m][n], 0, 0, 0); } __builtin_amdgcn_s_setprio(0); } while (0)
#define PG_WAIT_V(n) asm volatile("s_waitcnt vmcnt(" #n ")" ::: "memory")
#define PG_WAIT_L(n) asm volatile("s_waitcnt lgkmcnt(" #n ")" ::: "memory")
#define PG_BAR __builtin_amdgcn_s_barrier()
#define PG_SCHED __builtin_amdgcn_sched_barrier(0)
#define PG_KLOOP(T0, T1) _Pragma("clang loop unroll(disable)") for (int t = (T0); t < (T1); t += 2) { \
            const bool last = (t == nt - 2); \
            PG_LDB(B0, 0, 0); PG_LDB(B1, 0, 1); PG_SCHED; PG_LDA(At, 0, 0); PG_STAGE_A(PG_SA(1, 1), st.A, st.aoff[1][0], st.aoff[1][1], t + 1); \
            if (last) { Unit nu_; has_next = S.next(ui + 1, nu_); if (has_next) { st = nu_; } } \
            const int k2 = last ? 0 : t + 2, k3 = k2 + 1; \
            PG_WAIT_V(8); PG_WAIT_L(0); PG_BAR; PG_MMA(0, 0, At, B0); PG_MMA(0, 1, At, B1); PG_BAR; PG_SCHED; \
            PG_LDA(At, 0, 1); PG_STAGE_B(PG_SB(0, 0), st.B, 0, k2); PG_STAGE_B(PG_SB(0, 1), st.B, 1, k2); PG_STAGE_A(PG_SA(0, 0), st.A, st.aoff[0][0], st.aoff[0][1], k2); \
            PG_WAIT_V(8); PG_WAIT_L(0); PG_BAR; PG_MMA(1, 0, At, B0); PG_MMA(1, 1, At, B1); PG_BAR; PG_SCHED; \
            PG_LDB(B0, 1, 0); PG_LDB(B1, 1, 1); PG_SCHED; PG_LDA(At, 1, 0); PG_STAGE_A(PG_SA(0, 1), st.A, st.aoff[1][0], st.aoff[1][1], k2); \
            PG_WAIT_V(8); PG_WAIT_L(0); PG_BAR; PG_MMA(0, 0, At, B0); PG_MMA(0, 1, At, B1); PG_BAR; PG_SCHED; \
            PG_LDA(At, 1, 1); PG_STAGE_B(PG_SB(1, 0), st.B, 0, k3); PG_STAGE_B(PG_SB(1, 1), st.B, 1, k3); PG_STAGE_A(PG_SA(1, 0), st.A, st.aoff[0][0], st.aoff[0][1], k3); \
            PG_WAIT_V(8); PG_WAIT_L(0); PG_BAR; PG_MMA(1, 0, At, B0); PG_MMA(1, 1, At, B1); PG_BAR; PG_SCHED; \
        }
    Unit st; int ui = 0;
    if (!S.next(0, st)) return;
    EpiInfo cur; cur.pm = st.pm; cur.pn = st.pn; cur.aux = st.aux; cur.aux2 = st.aux2; cur.ord = st.ord;
    Acc acc;
#pragma unroll
    for (int a = 0; a < 2; ++a)
#pragma unroll
        for (int b = 0; b < 2; ++b)
#pragma unroll
            for (int m = 0; m < 4; ++m)
#pragma unroll
                for (int n = 0; n < 2; ++n) acc[a][b][m][n] = (f32x4){0.f, 0.f, 0.f, 0.f};
    bf16x8 At[4][2], B0[2][2], B1[2][2];
    PG_STAGE_B(PG_SB(0, 0), st.B, 0, 0); PG_STAGE_B(PG_SB(0, 1), st.B, 1, 0); PG_STAGE_A(PG_SA(0, 0), st.A, st.aoff[0][0], st.aoff[0][1], 0); PG_STAGE_A(PG_SA(0, 1), st.A, st.aoff[1][0], st.aoff[1][1], 0);
    if (wr == 1) PG_BAR;
    PG_WAIT_V(2); PG_BAR;
    PG_STAGE_B(PG_SB(1, 0), st.B, 0, 1); PG_STAGE_A(PG_SA(1, 0), st.A, st.aoff[0][0], st.aoff[0][1], 1); PG_STAGE_B(PG_SB(1, 1), st.B, 1, 1);
    PG_WAIT_V(6); PG_BAR;
    for (;;) {
        bool has_next = false;
        if constexpr (Epi::HAS_MID) { PG_KLOOP(0, Epi::MID_T) E.mid(acc, cur, wr, wc, fr, fq); PG_KLOOP(Epi::MID_T, nt) } else { PG_KLOOP(0, nt) }
        if (wr == 0) PG_BAR;
        E(acc, cur, wr, wc, fr, fq);
        if (!has_next) break;
#pragma unroll
        for (int a = 0; a < 2; ++a)
#pragma unroll
            for (int b = 0; b < 2; ++b)
#pragma unroll
                for (int m = 0; m < 4; ++m)
#pragma unroll
                    for (int n = 0; n < 2; ++n) acc[a][b][m][n] = (f32x4){0.f, 0.f, 0.f, 0.f};
        cur.pm = st.pm; cur.pn = st.pn; cur.aux = st.aux; cur.aux2 = st.aux2; cur.ord = st.ord; ++ui;
        if (wr == 1) PG_BAR;
    }
    PG_WAIT_V(0);
    PG_BAR;
#undef PG_SA
#undef PG_SB
#undef PG_GLDS
#undef PG_GLDSB
#undef PG_STAGE_A
#undef PG_STAGE_B
#undef PG_LDA
#undef PG_LDB
#undef PG_MMA
#undef PG_WAIT_V
#undef PG_WAIT_L
#undef PG_BAR
#undef PG_SCHED
#undef PG_KLOOP
}

struct LaneRC { int R[2], C[2]; __device__ __forceinline__ LaneRC() { const int t = opaque_tid(); stage_rc(t * 16, R[0], C[0]); stage_rc(t * 16 + 8192, R[1], C[1]); } };

struct DenseSched {
    const bf16_t* A; const bf16_t* Bt; int lda, ldb, nM, nN, nwg, G, c;
    __device__ __forceinline__ void init(const bf16_t* A_, int lda_, const bf16_t* Bt_, int ldb_, int M, int N, int G_, int c_) { A = A_; Bt = Bt_; lda = lda_; ldb = ldb_; nM = M / BM; nN = N / BM; nwg = nM * nN; G = G_; c = c_; }
    __device__ __forceinline__ bool next(int i, Unit& u) const {
        const long L = (long)i * G + c; if (L >= nwg) return false;
        int wgid = (int)L; { const int q = nwg / 8, r = nwg % 8, xcd = wgid % 8, off = wgid / 8; wgid = (xcd < r ? xcd * (q + 1) : r * (q + 1) + (xcd - r) * q) + off; }
        const int WGM = PG_WGM, nig = WGM * nN, gid = wgid / nig, fm = gid * WGM, gsz = (nM - fm) < WGM ? (nM - fm) : WGM;
        u.pm = fm + ((wgid % nig) % gsz); u.pn = (wgid % nig) / gsz; u.aux = 0; u.aux2 = 0; u.ord = i;
        u.A = (const char*)A; u.B = (const char*)(Bt + (size_t)u.pn * BM * ldb); const LaneRC rc;
#pragma unroll
        for (int h = 0; h < 2; ++h)
#pragma unroll
            for (int j = 0; j < 2; ++j) u.aoff[h][j] = (unsigned)(((u.pm * BM + 128 * h + rc.R[j]) * lda + rc.C[j]) * 2);
        return true;
    }
};
}
namespace pg {
constexpr int TAB_OFF = RING_BYTES + 1024;
__device__ __forceinline__ void moe_build_tab(LAS unsigned char* lds, const unsigned* cnt) {
    LAS int* tab = (LAS int*)(lds + TAB_OFF);
    if (threadIdx.x == 0) { int acc = 0; for (int e = 0; e < NE; ++e) { const int n = (int)__hip_atomic_load(cnt + e, __ATOMIC_RELAXED, __HIP_MEMORY_SCOPE_AGENT); tab[e] = acc; tab[40 + e] = n; acc += (n + 255) >> 8; } tab[NE] = acc; }
    __syncthreads();
}
#ifndef MOE_MAXU_OVERRIDE
#define MOE_MAXU_OVERRIDE 9
#endif
constexpr int MOE_MAXU = MOE_MAXU_OVERRIDE;
constexpr int UT_OFF = RING_BYTES + 1536;
constexpr int UB_OFF = UT_OFF + MOE_MAXU * 512;
static_assert(UB_OFF + MOE_MAXU * 1024 <= LDS_BYTES, "LDS map");
template <int KIND>
struct MoeSched {
    static constexpr int NPN = KIND == 1 ? 8 : 4;
    unsigned char* ws; const LAS int* tab; LAS unsigned char* lds; int G, c; bool freeze = false;
    __device__ __forceinline__ bool unit(int i, int& e, int& rb, int& pn) const {
        const int x = c & 7, j = c >> 3, NJ = G >> 3;
        int L = i * NJ + j; e = -1; rb = 0; pn = 0;
#pragma unroll
        for (int q = 0; q < NE / 8; ++q) { const int eq = x + 8 * q, uq = (tab[eq + 1] - tab[eq]) * NPN;
            if (e < 0) { if (L < uq) { e = eq; rb = L / NPN; pn = L % NPN; } else L -= uq; } }
        if (e < 0) return false;
        e = __builtin_amdgcn_readfirstlane(e); rb = __builtin_amdgcn_readfirstlane(rb); pn = __builtin_amdgcn_readfirstlane(pn);
        return true;
    }
    __device__ __forceinline__ void init(unsigned char* ws_, LAS unsigned char* lds_, int G_, int c_, const float* bias) {
        ws = ws_; lds = lds_; tab = (const LAS int*)(lds_ + TAB_OFF); G = G_; c = c_;
        const int tid = opaque_tid();
        for (int i = 0; i < MOE_MAXU; ++i) { int e, rb, pn; if (!unit(i, e, rb, pn)) break;
            if (tid < 256) { if (KIND == 1) { const int nvalid = min(256, tab[40 + e] - rb * 256); const int tok = tid < nvalid ? ((const int*)(ws + WS_SLOT_TOK))[(size_t)e * CAP + rb * 256 + tid] : T;
                    ((LAS unsigned short*)(lds + UT_OFF))[i * 256 + tid] = (unsigned short)tok; } }
            else ((LAS float*)(lds + UB_OFF))[i * 256 + tid - 256] = bias[(size_t)e * (NPN * 256) + pn * 256 + tid - 256]; }
        __syncthreads();
    }
    __device__ __forceinline__ bool next(int i, Unit& u) const {
        int e, rb, pn; if (!unit(i, e, rb, pn)) return false;
#if defined(PROBE_FREEZE)
        if (freeze) { int e0, r0, p0; unit(0, e0, r0, p0); e = e0; rb = r0; pn = p0; }
#endif
        const int blk = tab[e] + rb, nvalid = min(256, tab[40 + e] - rb * 256);
        u.pm = rb; u.pn = pn; u.aux = e; u.ord = i; const LaneRC rc;
        if (KIND == 1) {
            u.aux2 = blk; u.A = (const char*)(ws + WS_H2); u.B = (const char*)(ws + WS_W1_T + ((size_t)e * 2 * DFF + (size_t)pn * BM) * D);
#pragma unroll
            for (int h = 0; h < 2; ++h)
#pragma unroll
                for (int jj = 0; jj < 2; ++jj) { const int r = 128 * h + rc.R[jj]; int tok;
                    if (i < MOE_MAXU) tok = ((const LAS unsigned short*)(lds + UT_OFF))[i * 256 + r];
                    else { tok = r < nvalid ? ((const int*)(ws + WS_SLOT_TOK))[(size_t)e * CAP + rb * 256 + r] : T; __builtin_amdgcn_s_waitcnt(0x0F70); }
                    u.aoff[h][jj] = (unsigned)(tok * D + rc.C[jj] * 2); }
        } else {
            u.aux2 = blk | (nvalid << 16); u.A = (const char*)(ws + WS_ACT); u.B = (const char*)(ws + WS_W2_T + ((size_t)e * D + (size_t)pn * BM) * DFF);
#pragma unroll
            for (int h = 0; h < 2; ++h)
#pragma unroll
                for (int jj = 0; jj < 2; ++jj) u.aoff[h][jj] = (unsigned)((blk * 256 + 128 * h + rc.R[jj]) * DFF + rc.C[jj] * 2);
        }
        return true;
    }
};
}
namespace pg {
struct EpiBase { static constexpr bool HAS_MID = false; static constexpr int MID_T = -1; __device__ __forceinline__ void mid(Acc&, const EpiInfo&, int, int, int, int) const {} };
__device__ __forceinline__ u32x4 pack8(const f32x4 a, const f32x4 b) { u32x4 w; w.x = pk2(a[0], a[1]); w.y = pk2(a[2], a[3]); w.z = pk2(b[0], b[1]); w.w = pk2(b[2], b[3]); return w; }
__device__ __forceinline__ void unpack8(const u32x4 w, f32x4& a, f32x4& b) { a = (f32x4){bflo(w.x), bfhi(w.x), bflo(w.y), bfhi(w.y)}; b = (f32x4){bflo(w.z), bfhi(w.z), bflo(w.w), bfhi(w.w)}; }

struct EpiNull : EpiBase {
    __device__ __forceinline__ void operator()(Acc& acc, const EpiInfo&, int, int, int, int) const {
#pragma unroll
        for (int a = 0; a < 2; ++a)
#pragma unroll
            for (int b = 0; b < 2; ++b)
#pragma unroll
                for (int m = 0; m < 4; ++m)
#pragma unroll
                    for (int n = 0; n < 2; ++n) asm volatile("" :: "v"(acc[a][b][m][n]));
    }
};
struct EpiInProj : EpiBase {
    unsigned char* ws; const float* qg; const float* kg;
    __device__ __forceinline__ void operator()(Acc& acc, const EpiInfo& u, int wr, int wc, int fr, int fq) const {
        const int pn = u.pn, row0 = u.pm * BM + wr * 64 + fr, colw = 64 * wc + 8 * fq;
        if (pn < 2) {
            bf16_t* acat = (bf16_t*)(ws + WS_ACAT);
#pragma unroll
            for (int ai = 0; ai < 2; ++ai)
#pragma unroll
                for (int m = 0; m < 4; ++m) { const int tok = row0 + ai * 128 + m * 16;
#pragma unroll
                    for (int bj = 0; bj < 2; ++bj) { const int cu = pn * 256 + colw + 32 * bj, g = cu >> 4, h0 = cu & 15;
                        *(u32x4*)(acat + ((size_t)(g * ACAT_ROWS + (tok >> 5))) * ACAT_LD + (tok & 31) * 16 + h0) = pack8(acc[ai][bj][m][0], acc[ai][bj][m][1]); } }
        } else if (pn < 10) {
            const bool isq = pn < 6; const float* gain = isq ? qg : kg; const float sc = isq ? QC2 : 1.f;
            bf16_t* dst = (bf16_t*)(ws + (isq ? WS_Q : WS_K)) + (size_t)(pn - (isq ? 2 : 6)) * 256 + colw;
            f32x4 gv[2][2];
#pragma unroll
            for (int bj = 0; bj < 2; ++bj)
#pragma unroll
                for (int n = 0; n < 2; ++n) gv[bj][n] = *(const f32x4*)(gain + 32 * bj + 8 * fq + 4 * n);
#pragma unroll
            for (int ai = 0; ai < 2; ++ai)
#pragma unroll
                for (int m = 0; m < 4; ++m) { const int tok = row0 + ai * 128 + m * 16; float ss = 0.f;
#pragma unroll
                    for (int bj = 0; bj < 2; ++bj)
#pragma unroll
                        for (int n = 0; n < 2; ++n) { const f32x4 v = acc[ai][bj][m][n]; ss += (v[0] * v[0] + v[1] * v[1]) + (v[2] * v[2] + v[3] * v[3]); }
                    ss += __shfl_xor(ss, 16); ss += __shfl_xor(ss, 32);
                    const float r = rsqrtf(ss * (1.f / 64.f) + EPS) * sc;
#pragma unroll
                    for (int bj = 0; bj < 2; ++bj) store16(dst + (size_t)tok * D + 32 * bj, pack8(acc[ai][bj][m][0] * r * gv[bj][0], acc[ai][bj][m][1] * r * gv[bj][1])); }
        } else {
            const size_t base = pn < 14 ? WS_V : (pn < 18 ? WS_GS : WS_GA); const int t0 = pn < 14 ? 10 : (pn < 18 ? 14 : 18); const bool ntst = pn >= 14;
            bf16_t* dst = (bf16_t*)(ws + base) + (size_t)(pn - t0) * 256 + colw;
#pragma unroll
            for (int ai = 0; ai < 2; ++ai)
#pragma unroll
                for (int m = 0; m < 4; ++m) { const int tok = row0 + ai * 128 + m * 16;
#pragma unroll
                    for (int bj = 0; bj < 2; ++bj) { const u32x4 w = pack8(acc[ai][bj][m][0], acc[ai][bj][m][1]); if (ntst) NT_STORE(w, (u32x4*)(dst + (size_t)tok * D + 32 * bj)); else store16(dst + (size_t)tok * D + 32 * bj, w); } }
        }
    }
};
struct EpiSsm2 : EpiBase {
    unsigned char* ws;
    __device__ __forceinline__ void operator()(Acc& acc, const EpiInfo& u, int wr, int wc, int fr, int fq) const {
        bf16_t* Z = (bf16_t*)(ws + WS_Z); const int g = u.aux;
#pragma unroll
        for (int ai = 0; ai < 2; ++ai)
#pragma unroll
            for (int m = 0; m < 4; ++m) { const int r = u.pm * BM + ai * 128 + wr * 64 + m * 16 + fr, b = r >> 6, c = r & 63;
#pragma unroll
                for (int bj = 0; bj < 2; ++bj) { const int n_ = u.pn * 256 + 64 * wc + 32 * bj + 8 * fq, t = n_ >> 4, h0 = n_ & 15; const int tok = b * SEQ + c * CH_L + t;
                    f32x4 a = acc[ai][bj][m][0], bb = acc[ai][bj][m][1];
#pragma unroll
                    for (int q = 0; q < 4; ++q) { a[q] = gelu_tanh(a[q]); bb[q] = gelu_tanh(bb[q]); }
                    *(u32x4*)(Z + (size_t)tok * SSM_W + 16 * g + h0) = pack8(a, bb); } }
    }
};
struct EpiGlu : EpiBase {
    unsigned char* ws; const float* bglu;
    __device__ __forceinline__ void operator()(Acc& acc, const EpiInfo& u, int wr, int wc, int fr, int fq) const {
        const bf16_t* Z = (const bf16_t*)(ws + WS_Z); bf16_t* MA = (bf16_t*)(ws + WS_MA);
#pragma unroll
        for (int bj = 0; bj < 2; ++bj) { const int col = u.pn * 256 + 64 * wc + 32 * bj + 8 * fq; const f32x4 b0 = *(const f32x4*)(bglu + col), b1 = *(const f32x4*)(bglu + col + 4);
#pragma unroll
            for (int ai = 0; ai < 2; ++ai)
#pragma unroll
                for (int m = 0; m < 4; ++m) { const int tok = u.pm * BM + ai * 128 + wr * 64 + m * 16 + fr;
                    f32x4 z0, z1; unpack8(*(const u32x4*)(Z + (size_t)tok * SSM_W + col), z0, z1);
                    f32x4 a = acc[ai][bj][m][0] + b0, bb = acc[ai][bj][m][1] + b1;
#pragma unroll
                    for (int q = 0; q < 4; ++q) { a[q] = z0[q] * sigmoid_f(a[q]); bb[q] = z1[q] * sigmoid_f(bb[q]); }
                    *(u32x4*)(MA + (size_t)tok * MA_LD + 1024 + col) = pack8(a, bb); } }
    }
};
struct EpiMerged : EpiBase {
    static constexpr bool HAS_MID = true; static constexpr int MID_T = 16;
    unsigned char* ws;
    __device__ __forceinline__ float ratio(float a, float s) const { a = fminf(fmaxf(a, -30.f), 30.f); s = fminf(fmaxf(s, -30.f), 30.f); return (1.f + __expf(-s)) * __builtin_amdgcn_rcpf(1.f + __expf(-a)); }
    __device__ __forceinline__ void mid(Acc& acc, const EpiInfo& u, int wr, int wc, int fr, int fq) const {
        asm volatile("" : "+v"(fr), "+v"(fq));
        const bf16_t* GS = (const bf16_t*)(ws + WS_GS); const bf16_t* GA = (const bf16_t*)(ws + WS_GA);
#pragma unroll
        for (int ai = 0; ai < 2; ++ai)
#pragma unroll
            for (int m = 0; m < 4; ++m) { const int tok = u.pm * BM + ai * 128 + wr * 64 + m * 16 + fr;
#pragma unroll
                for (int bj = 0; bj < 2; ++bj) { const int col = u.pn * 256 + 64 * wc + 32 * bj + 8 * fq;
                    const u32x4 ws_ = *(const u32x4*)(GS + (size_t)tok * D + col), wa_ = *(const u32x4*)(GA + (size_t)tok * D + col);
                    acc[ai][bj][m][0][0] *= ratio(bflo(wa_.x), bflo(ws_.x)); acc[ai][bj][m][0][1] *= ratio(bfhi(wa_.x), bfhi(ws_.x));
                    acc[ai][bj][m][0][2] *= ratio(bflo(wa_.y), bflo(ws_.y)); acc[ai][bj][m][0][3] *= ratio(bfhi(wa_.y), bfhi(ws_.y));
                    acc[ai][bj][m][1][0] *= ratio(bflo(wa_.z), bflo(ws_.z)); acc[ai][bj][m][1][1] *= ratio(bfhi(wa_.z), bfhi(ws_.z));
                    acc[ai][bj][m][1][2] *= ratio(bflo(wa_.w), bflo(ws_.w)); acc[ai][bj][m][1][3] *= ratio(bfhi(wa_.w), bfhi(ws_.w));
                    asm volatile("" ::: "memory"); } }
    }
    __device__ __forceinline__ void operator()(Acc& acc, const EpiInfo& u, int wr, int wc, int fr, int fq) const {
        asm volatile("" : "+v"(fr), "+v"(fq));
        const bf16_t* GS = (const bf16_t*)(ws + WS_GS); bf16_t* O = (bf16_t*)(ws + WS_MERGED);
#pragma unroll
        for (int ai = 0; ai < 2; ++ai)
#pragma unroll
            for (int m = 0; m < 4; ++m) { const int tok = u.pm * BM + ai * 128 + wr * 64 + m * 16 + fr;
#pragma unroll
                for (int bj = 0; bj < 2; ++bj) { const int col = u.pn * 256 + 64 * wc + 32 * bj + 8 * fq;
                    f32x4 s0, s1; unpack8(*(const u32x4*)(GS + (size_t)tok * D + col), s0, s1);
                    f32x4 a = acc[ai][bj][m][0], bb = acc[ai][bj][m][1];
#pragma unroll
                    for (int q = 0; q < 4; ++q) { a[q] *= sigmoid_c(s0[q]); bb[q] *= sigmoid_c(s1[q]); }
                    *(u32x4*)(O + (size_t)tok * D + col) = pack8(a, bb); } }
    }
};
struct EpiWout : EpiBase {
    const float* x; float* out;
    __device__ __forceinline__ void operator()(Acc& acc, const EpiInfo& u, int wr, int wc, int fr, int fq) const {
#pragma unroll
        for (int ai = 0; ai < 2; ++ai)
#pragma unroll
            for (int m = 0; m < 4; ++m) { const int tok = u.pm * BM + ai * 128 + wr * 64 + m * 16 + fr;
#pragma unroll
                for (int bj = 0; bj < 2; ++bj) { const size_t o = (size_t)tok * D + u.pn * 256 + 64 * wc + 32 * bj + 8 * fq;
                    { const f32x4 y0 = NT_LOAD((const f32x4*)(x + o)) + acc[ai][bj][m][0], y1 = NT_LOAD((const f32x4*)(x + o + 4)) + acc[ai][bj][m][1]; store16(out + o, __builtin_bit_cast(u32x4, y0)); store16(out + o + 4, __builtin_bit_cast(u32x4, y1)); } } }
    }
};
struct EpiMoe1 : EpiBase {
    unsigned char* ws; const float* b1; LAS unsigned char* lds; bool nostore = false;
    __device__ __forceinline__ void operator()(Acc& acc, const EpiInfo& u, int wr, int wc, int fr, int fq) const {
        asm volatile("" : "+v"(fr), "+v"(fq));
        unsigned char* ACT = ws + WS_ACT; const int e = u.aux, blk = u.aux2;
        f32x4 cb[2][2];
#pragma unroll
        for (int bj = 0; bj < 2; ++bj) { const int cl = 64 * wc + 32 * bj + 8 * fq;
            if (u.ord < MOE_MAXU) { const LAS float* bl = (const LAS float*)(lds + UB_OFF) + u.ord * 256 + cl; cb[bj][0] = *(const LAS f32x4*)bl; cb[bj][1] = *(const LAS f32x4*)(bl + 4); }
            else { const float* bg = b1 + (size_t)e * 2 * DFF + u.pn * 256 + cl; cb[bj][0] = *(const f32x4*)bg; cb[bj][1] = *(const f32x4*)(bg + 4); __builtin_amdgcn_s_waitcnt(0x0F70); } }
#pragma unroll
        for (int ai = 0; ai < 2; ++ai)
#pragma unroll
            for (int m = 0; m < 4; ++m) { const int row = ai * 128 + wr * 64 + m * 16 + fr; unsigned w[2];
#pragma unroll
                for (int bj = 0; bj < 2; ++bj) { const f32x4 h0 = acc[ai][bj][m][0] + cb[bj][0], h1 = acc[ai][bj][m][1] + cb[bj][1]; float o[4];
#pragma unroll
                    for (int q = 0; q < 4; ++q) { const float gr = q < 2 ? h0[2 * q] : h1[2 * q - 4], ur = q < 2 ? h0[2 * q + 1] : h1[2 * q - 3];
                        const float gate = fminf(gr, 7.f), up = fminf(fmaxf(ur, -7.f), 7.f); o[q] = (up + 1.f) * gate * sigmoid_f(1.702f * gate); }
                    w[bj] = pk4_fp8(o[0], o[1], o[2], o[3]); }
                unsigned char* rowp = ACT + ((size_t)blk * 256 + row) * DFF + ((u.pn * 256 + 64 * wc + 8 * fq) >> 1);
#if defined(PROBE_NOSTORE)
                if (nostore) { asm volatile("" :: "v"(w[0]), "v"(w[1])); } else
#endif
                { *(unsigned*)rowp = w[0]; *(unsigned*)(rowp + 16) = w[1]; } }
    }
};
struct EpiMoe2 : EpiBase {
    unsigned char* ws; const float* b2; LAS unsigned char* lds; bool nostore = false;
    __device__ __forceinline__ void operator()(Acc& acc, const EpiInfo& u, int wr, int wc, int fr, int fq) const {
        asm volatile("" : "+v"(fr), "+v"(fq));
        bf16_t* Y = (bf16_t*)(ws + WS_Y); const int e = u.aux, blk = u.aux2 & 0xffff;
        f32x4 cb[2][2];
#pragma unroll
        for (int bj = 0; bj < 2; ++bj) { const int cl = 64 * wc + 32 * bj + 8 * fq;
            if (u.ord < MOE_MAXU) { const LAS float* bl = (const LAS float*)(lds + UB_OFF) + u.ord * 256 + cl; cb[bj][0] = *(const LAS f32x4*)bl; cb[bj][1] = *(const LAS f32x4*)(bl + 4); }
            else { const float* bg = b2 + (size_t)e * D + u.pn * 256 + cl; cb[bj][0] = *(const f32x4*)bg; cb[bj][1] = *(const f32x4*)(bg + 4); __builtin_amdgcn_s_waitcnt(0x0F70); } }
#pragma unroll
        for (int ai = 0; ai < 2; ++ai)
#pragma unroll
            for (int m = 0; m < 4; ++m) { const int row = ai * 128 + wr * 64 + m * 16 + fr;
#pragma unroll
                for (int bj = 0; bj < 2; ++bj) { const int col = u.pn * 256 + 64 * wc + 32 * bj + 8 * fq;
                    const u32x4 w = pack8(acc[ai][bj][m][0] + cb[bj][0], acc[ai][bj][m][1] + cb[bj][1]);
#if defined(PROBE_NOSTORE)
                    if (nostore) { asm volatile("" :: "v"(w)); } else
#endif
                    store16(Y + ((size_t)blk * 256 + row) * D + col, w); } }
    }
};
}
namespace attn_body {
using bf16=__hip_bfloat16;
using bf16x8=__attribute__((ext_vector_type(8)))short;
using s16x4=__attribute__((ext_vector_type(4)))short;
using f32x16=__attribute__((ext_vector_type(16)))float;
using u32x4=__attribute__((ext_vector_type(4)))unsigned;
constexpr int SEQ=2048,D=64,DM=1024;
constexpr int NW=8,QBLK=32,QB=QBLK*NW,KVBLK=64,NQB=SEQ/QB;
constexpr int ATTN_PITCH=DM, ATTN_UNIT_ROWS=QB;
__device__ __forceinline__ int crow(int r,int hi){return (r&3)+8*(r>>2)+4*hi;}
#define SBAR() __builtin_amdgcn_sched_barrier(0)
__device__ __forceinline__ void cmask(f32x16&p0,f32x16&p1,int jb,int qrel,int hi){
  const float NEG=-INFINITY; int kb=64*jb+4*hi;
  #pragma unroll
  for(int r=0;r<16;++r){int kv=kb+(r&3)+8*(r>>2); if(kv>qrel)p0[r]=NEG; if(kv+32>qrel)p1[r]=NEG;}
}

constexpr int NSLOT=3, SLOTB=8192;
constexpr int LDS_K=0, LDS_V=NSLOT*SLOTB, LDS_WS=2*NSLOT*SLOTB, LDS_OST=LDS_WS+NW*64*4, ALDS_BYTES=LDS_OST+NW*4096;
constexpr float C2=0.125f*1.4426950408889634f;
__device__ __forceinline__ void glds16(const void*gsrc,unsigned lds_dst){unsigned keep;
  asm volatile("s_mov_b32 %0, m0\n\ts_mov_b32 m0, %2\n\ts_nop 0\n\tglobal_load_lds_dwordx4 %1, off\n\ts_mov_b32 m0, %0":"=&s"(keep):"v"(gsrc),"s"(lds_dst):"memory");}
__device__ __forceinline__ float max3f(float a,float b,float c){float r;asm("v_max3_f32 %0, %1, %2, %3":"=v"(r):"v"(a),"v"(b),"v"(c));return r;}
__device__ __forceinline__ float max2f(float a,float b){float r;asm("v_max_f32_e32 %0, %1, %2":"=v"(r):"v"(a),"v"(b));return r;}
__device__ __forceinline__ float fadd_s(float a,float b){float r;asm("v_add_f32_e32 %0, %1, %2":"=v"(r):"v"(a),"v"(b));return r;}
__device__ __forceinline__ float fsub_s(float a,float b){float r;asm("v_sub_f32_e32 %0, %1, %2":"=v"(r):"v"(a),"v"(b));return r;}
typedef float f32x2_t __attribute__((ext_vector_type(2))); typedef __bf16 bf16x2_t __attribute__((ext_vector_type(2)));
__device__ __forceinline__ unsigned cvtpk_s(float lo,float hi){f32x2_t v={lo,hi};bf16x2_t b=__builtin_convertvector(v,bf16x2_t);return __builtin_bit_cast(unsigned,b);}
#define WAIT_BAR(N) asm volatile("s_waitcnt vmcnt(" #N ") lgkmcnt(0)\n\ts_barrier":::"memory")

__device__ __forceinline__ void qkt(f32x16&p0,f32x16&p1,const char*Kslot,const bf16x8*qr,const f32x16&negm,int r32,int hi){
  const char*kb=Kslot+hi*1024+r32*16;
  #pragma unroll
  for(int d0=0;d0<4;++d0){
    const bf16x8 b0=*reinterpret_cast<const bf16x8*>(kb+d0*2048);
    const bf16x8 b1=*reinterpret_cast<const bf16x8*>(kb+d0*2048+512);
    if(d0==0){p0=__builtin_amdgcn_mfma_f32_32x32x16_bf16(b0,qr[0],negm,0,0,0);p1=__builtin_amdgcn_mfma_f32_32x32x16_bf16(b1,qr[0],negm,0,0,0);}
    else{p0=__builtin_amdgcn_mfma_f32_32x32x16_bf16(b0,qr[d0],p0,0,0,0);p1=__builtin_amdgcn_mfma_f32_32x32x16_bf16(b1,qr[d0],p1,0,0,0);}}
}
typedef __attribute__((address_space(3))) const char* lds_cptr;
typedef short v4i16_t __attribute__((ext_vector_type(4)));
__device__ __forceinline__ void kload8(bf16x8*kf,lds_cptr kp){
  kf[0]=*(const __attribute__((address_space(3))) bf16x8*)(kp);      kf[1]=*(const __attribute__((address_space(3))) bf16x8*)(kp+512);
  kf[2]=*(const __attribute__((address_space(3))) bf16x8*)(kp+2048); kf[3]=*(const __attribute__((address_space(3))) bf16x8*)(kp+2560);
  kf[4]=*(const __attribute__((address_space(3))) bf16x8*)(kp+4096); kf[5]=*(const __attribute__((address_space(3))) bf16x8*)(kp+4608);
  kf[6]=*(const __attribute__((address_space(3))) bf16x8*)(kp+6144); kf[7]=*(const __attribute__((address_space(3))) bf16x8*)(kp+6656);
}
__device__ __forceinline__ void kload2(bf16x8*kf,lds_cptr kp,int j){ kf[2*j]=*(const __attribute__((address_space(3))) bf16x8*)(kp+j*2048); kf[2*j+1]=*(const __attribute__((address_space(3))) bf16x8*)(kp+j*2048+512); }
__device__ __forceinline__ s16x4 vtr(lds_cptr p){ return __builtin_bit_cast(s16x4,__builtin_amdgcn_ds_read_tr16_b64_v4i16((__attribute__((address_space(3))) v4i16_t*)p)); }
__device__ __forceinline__ float rowmax(const f32x16&p0,const f32x16&p1){
  float a=max3f(p0[0],p0[1],p1[0]),b=max3f(p0[2],p0[3],p1[1]);a=max3f(a,p1[2],p1[3]);
  #pragma unroll
  for(int r=4;r<16;r+=4){a=max3f(a,p0[r],p0[r+1]);b=max3f(b,p0[r+2],p0[r+3]);a=max3f(a,p1[r],p1[r+1]);b=max3f(b,p1[r+2],p1[r+3]);}
  const float m=max2f(a,b);
  auto rr=__builtin_amdgcn_permlane32_swap(__float_as_uint(m),__float_as_uint(m),false,false);
  return max2f(__uint_as_float(rr[0]),__uint_as_float(rr[1]));
}
__device__ __forceinline__ void pv(f32x16*o,int vb,bf16x8 pa0,bf16x8 pa1,bf16x8 pa2,bf16x8 pa3){
  #pragma unroll
  for(int d0=0;d0<2;++d0){s16x4 lo[4],hi[4];
    #pragma unroll
    for(int ks=0;ks<4;++ks){
      asm volatile("ds_read_b64_tr_b16 %0,%1 offset:%c2":"=&v"(lo[ks]):"v"(vb),"i"(d0*4096+ks*1024):"memory");
      asm volatile("ds_read_b64_tr_b16 %0,%1 offset:%c2":"=&v"(hi[ks]):"v"(vb),"i"(d0*4096+ks*1024+512):"memory");}
    asm volatile("s_waitcnt lgkmcnt(0)":::"memory");SBAR();
    #define PK(k) (bf16x8){lo[k][0],lo[k][1],lo[k][2],lo[k][3],hi[k][0],hi[k][1],hi[k][2],hi[k][3]}
    o[d0]=__builtin_amdgcn_mfma_f32_32x32x16_bf16(pa0,PK(0),o[d0],0,0,0);
    o[d0]=__builtin_amdgcn_mfma_f32_32x32x16_bf16(pa1,PK(1),o[d0],0,0,0);
    o[d0]=__builtin_amdgcn_mfma_f32_32x32x16_bf16(pa2,PK(2),o[d0],0,0,0);
    o[d0]=__builtin_amdgcn_mfma_f32_32x32x16_bf16(pa3,PK(3),o[d0],0,0,0);
    #undef PK
  }
}

#ifndef ATTN_STORE16
#define ATTN_STORE16(p,v) (*(u32x4*)(p)=(v))
#endif
template<int THRL> __device__ __forceinline__ void attn_unit(int b,int qcol,int kcol,int vcol,int ocol,int qb,const bf16*Q,const bf16*__restrict__ K,const bf16*__restrict__ V,bf16*O,char*shm){
  int tid_=threadIdx.x; asm volatile("":"+v"(tid_));
  const int tid=tid_,lane=tid&63,r32=lane&31,hi=lane>>5; const int wid=__builtin_amdgcn_readfirstlane(tid>>6);
  const long rowbase=(long)b*SEQ; const int q0=qb*QB;
  const bf16*Qw=Q+(rowbase+q0+wid*QBLK)*DM+qcol;
  const bf16*Kh=K+rowbase*DM+kcol,*Vh=V+rowbase*DM+vcol;
  const unsigned lds0=(unsigned)(uintptr_t)shm;
  float*wsf=(float*)(shm+LDS_WS)+wid*64;
  const bf16*ksrc=Kh+(long)lane*DM+wid*8;
  const bf16*vsrc=Vh+(long)(16*(wid&3)+(lane>>2))*DM+(wid>>2)*32+(lane&3)*8;
  const unsigned kdst=lds0+LDS_K+wid*1024, vdst=lds0+LDS_V+wid*1024;
  #define DMA_K(t,slot) glds16(ksrc+(long)(t)*KVBLK*DM,(unsigned)__builtin_amdgcn_readfirstlane(kdst+(slot)))
  #define DMA_V(t,slot) glds16(vsrc+(long)(t)*KVBLK*DM,(unsigned)__builtin_amdgcn_readfirstlane(vdst+(slot)))
  const int vb0=(int)(lds0+LDS_V)+((lane>>4)&1)*32+(lane&3)*8+(4*hi+((lane&15)>>2))*64;
  const char*Kbase=shm+LDS_K; bf16x8 kf[8];
  const lds_cptr shm3=(lds_cptr)shm; const lds_cptr kp0=shm3+LDS_K+hi*1024+r32*16; const lds_cptr vp0=shm3+LDS_V+((lane>>4)&1)*32+(lane&3)*8+(4*hi+((lane&15)>>2))*64;
  const int NT=(q0+QB)/KVBLK;
  DMA_K(0,0);DMA_V(0,0);DMA_K(1,SLOTB);
  bf16x8 qr[4];
  #pragma unroll
  for(int d0=0;d0<4;++d0)qr[d0]=*reinterpret_cast<const bf16x8*>(&Qw[(long)r32*DM+d0*16+hi*8]);
  float l_reg=0.f;f32x16 o[2];o[0]=f32x16{};o[1]=f32x16{};const f32x16 negm=f32x16{};
  const int qrel=wid*QBLK+r32;
  #define CMASK(P0,P1,t) do{int jb_=(t)-(NT-4); if(jb_>=0)cmask(P0,P1,jb_,qrel,hi);}while(0)
  #define START(P0,P1) do{ _Pragma("unroll") for(int r=0;r<16;++r)P0[r]=__builtin_amdgcn_exp2f(P0[r]); }while(0)
  #define RESC() do{}while(0)
  f32x16 pA0,pA1,pB0,pB1;
  int sl_prev=0,sl_cur=0,sl_next=SLOTB;
  #define ROT() do{sl_prev=sl_cur;sl_cur=sl_next;sl_next=(sl_next==(NSLOT-1)*SLOTB)?0:sl_next+SLOTB;}while(0)
  DMA_K(2,2*SLOTB);
  WAIT_BAR(3);
  qkt(pA0,pA1,Kbase,qr,negm,r32,hi);asm volatile("s_nop 15\n\ts_nop 7":"+v"(pA0),"+v"(pA1));CMASK(pA0,pA1,0);
  START(pA0,pA1);
  _Pragma("unroll") for(int r=0;r<16;++r)pA1[r]=__builtin_amdgcn_exp2f(pA1[r]);
  WAIT_BAR(0);
  DMA_K(3,0);DMA_V(1,SLOTB);
  ROT();
  kload8(kf,kp0+sl_cur);
  WAIT_BAR(2);
  s16x4 vlo[8],vhi[8]; u32x4 pw0,pw1,pw2,pw3;
  #define PKW(P,B) cvtpk_s(P[B],P[B+1])
  #define PAF(k) __builtin_bit_cast(bf16x8,pw##k)
  #define VFR(i) (bf16x8){vlo[i][0],vlo[i][1],vlo[i][2],vlo[i][3],vhi[i][0],vhi[i][1],vhi[i][2],vhi[i][3]}
  #define PIN(x) asm volatile("":"+v"(x))
  #define MX3(a,b,c) __builtin_fmaxf(__builtin_fmaxf((a),(b)),(c))
  #define GAPA(MF,A0,A1,A2,A3,W0,W1,PW) do{ MF; sacc+=A0; sacc+=A1; sacc+=A2; sacc+=A3; PIN(sacc); W0; W1; PIN(PW); SBAR(); }while(0)
  #define EX(v) __builtin_amdgcn_exp2f(v)
  #define GAPB(MF,X,B) do{ MF; X[B]=EX(X[B]); X[B+1]=EX(X[B+1]); X[B+2]=EX(X[B+2]); X[B+3]=EX(X[B+3]); PIN(X); SBAR(); }while(0)
  #define VRD(i) do{ vlo[i]=vtr(vp_+(((i)>>2)*4096+((i)&3)*1024)); vhi[i]=vtr(vp_+(((i)>>2)*4096+((i)&3)*1024+512)); }while(0)
  #define KRD(G,j) do{ if(G){ kload2(kf,kp0+sl_next,j); SBAR(); } }while(0)
  #define STEP(C0,C1,P0,P1,t,GK,GV,GL) do{ SBAR(); \
    const lds_cptr vp_=vp0+sl_prev; \
    VRD(0); SBAR(); float sacc=(P0[0]+P0[1]); \
    GAPA(C0=__builtin_amdgcn_mfma_f32_32x32x16_bf16(kf[0],qr[0],negm,0,0,0), P0[2],P0[3],P0[4],P0[5],     pw0[0]=PKW(P0,0), pw0[1]=PKW(P0,2), pw0); \
    VRD(4); SBAR(); GAPA(C1=__builtin_amdgcn_mfma_f32_32x32x16_bf16(kf[1],qr[0],negm,0,0,0), P0[6],P0[7],P0[8],P0[9],     pw0[2]=PKW(P0,4), pw0[3]=PKW(P0,6), pw0); \
    VRD(1); SBAR(); GAPA(C0=__builtin_amdgcn_mfma_f32_32x32x16_bf16(kf[2],qr[1],C0,0,0,0),   P0[10],P0[11],P0[12],P0[13], pw1[0]=PKW(P0,8), pw1[1]=PKW(P0,10), pw1); \
    VRD(5); SBAR(); GAPA(C1=__builtin_amdgcn_mfma_f32_32x32x16_bf16(kf[3],qr[1],C1,0,0,0),   P0[14],P0[15],P1[0],P1[1],   pw1[2]=PKW(P0,12),pw1[3]=PKW(P0,14), pw1); \
    VRD(2); SBAR(); GAPA(C0=__builtin_amdgcn_mfma_f32_32x32x16_bf16(kf[4],qr[2],C0,0,0,0),   P1[2],P1[3],P1[4],P1[5],     pw2[0]=PKW(P1,0), pw2[1]=PKW(P1,2), pw2); \
    VRD(6); SBAR(); GAPA(C1=__builtin_amdgcn_mfma_f32_32x32x16_bf16(kf[5],qr[2],C1,0,0,0),   P1[6],P1[7],P1[8],P1[9],     pw2[2]=PKW(P1,4), pw2[3]=PKW(P1,6), pw2); \
    VRD(3); SBAR(); GAPA(C0=__builtin_amdgcn_mfma_f32_32x32x16_bf16(kf[6],qr[3],C0,0,0,0),   P1[10],P1[11],P1[12],P1[13], pw3[0]=PKW(P1,8), pw3[1]=PKW(P1,10), pw3); \
    VRD(7); SBAR(); GAPA(C1=__builtin_amdgcn_mfma_f32_32x32x16_bf16(kf[7],qr[3],C1,0,0,0),   P1[14],P1[15],0.f,0.f,       pw3[2]=PKW(P1,12),pw3[3]=PKW(P1,14), pw3); \
    l_reg+=sacc; \
    if(GK){DMA_K((t)+3,sl_cur);} if(GV){DMA_V((t)+1,sl_next);} \
    CMASK(C0,C1,t); \
    SBAR(); \
    GAPB(o[0]=__builtin_amdgcn_mfma_f32_32x32x16_bf16(PAF(0),VFR(0),o[0],0,0,0), C0,0); \
    GAPB(o[1]=__builtin_amdgcn_mfma_f32_32x32x16_bf16(PAF(0),VFR(4),o[1],0,0,0), C0,4); \
    KRD(GL,0); GAPB(o[0]=__builtin_amdgcn_mfma_f32_32x32x16_bf16(PAF(1),VFR(1),o[0],0,0,0), C0,8); \
    KRD(GL,1); GAPB(o[1]=__builtin_amdgcn_mfma_f32_32x32x16_bf16(PAF(1),VFR(5),o[1],0,0,0), C0,12); \
    KRD(GL,2); GAPB(o[0]=__builtin_amdgcn_mfma_f32_32x32x16_bf16(PAF(2),VFR(2),o[0],0,0,0), C1,0); \
    KRD(GL,3); GAPB(o[1]=__builtin_amdgcn_mfma_f32_32x32x16_bf16(PAF(2),VFR(6),o[1],0,0,0), C1,4); \
    GAPB(o[0]=__builtin_amdgcn_mfma_f32_32x32x16_bf16(PAF(3),VFR(3),o[0],0,0,0), C1,8); \
    GAPB(o[1]=__builtin_amdgcn_mfma_f32_32x32x16_bf16(PAF(3),VFR(7),o[1],0,0,0), C1,12); \
    }while(0)
  int t=1;
  #undef CMASK
  #define CMASK(P0,P1,t) do{}while(0)
  for(;t+5<NT;t+=2){
    STEP(pB0,pB1,pA0,pA1,t,true,true,true);     WAIT_BAR(2); RESC(); ROT();
    STEP(pA0,pA1,pB0,pB1,t+1,true,true,true);   WAIT_BAR(2); RESC(); ROT();
  }
  #undef CMASK
  #define CMASK(P0,P1,t) do{int jb_=(t)-(NT-4); if(jb_>=0)cmask(P0,P1,jb_,qrel,hi);}while(0)
  #define ENDW(tt) do{ if((tt)+3<NT){WAIT_BAR(2);} else if((tt)+2<NT){WAIT_BAR(1);} else {WAIT_BAR(0);} }while(0)
  for(;t+1<NT;t+=2){
    STEP(pB0,pB1,pA0,pA1,t,(t+3<NT),(t+1<NT),(t+1<NT));       ENDW(t);   RESC(); ROT();
    STEP(pA0,pA1,pB0,pB1,t+1,(t+4<NT),(t+2<NT),(t+2<NT));     ENDW(t+1); RESC(); ROT();
  }
  STEP(pB0,pB1,pA0,pA1,NT-1,false,false,false); RESC();
  { float sacc=pB0[0]+pB0[1]; _Pragma("unroll") for(int r=2;r<16;++r)sacc+=pB0[r]; _Pragma("unroll") for(int r=0;r<16;++r)sacc+=pB1[r]; l_reg+=sacc;
    pw0=(u32x4){PKW(pB0,0),PKW(pB0,2),PKW(pB0,4),PKW(pB0,6)};pw1=(u32x4){PKW(pB0,8),PKW(pB0,10),PKW(pB0,12),PKW(pB0,14)};pw2=(u32x4){PKW(pB1,0),PKW(pB1,2),PKW(pB1,4),PKW(pB1,6)};pw3=(u32x4){PKW(pB1,8),PKW(pB1,10),PKW(pB1,12),PKW(pB1,14)};
    SBAR(); pv(o,vb0+sl_cur,PAF(0),PAF(1),PAF(2),PAF(3)); }
  #undef PKW
  #undef PAF
  #undef VFR
  #undef PIN
  #undef MX3
  #undef GAPA
  #undef GAPB
  #undef EX
  #undef VRD
  #undef KRD
  #undef STEP
  #undef ENDW
  {auto rr=__builtin_amdgcn_permlane32_swap(__float_as_uint(l_reg),__float_as_uint(l_reg),false,false);l_reg=__uint_as_float(rr[0])+__uint_as_float(rr[1]);}
  if(hi==0)wsf[32+r32]=l_reg;asm volatile("s_waitcnt lgkmcnt(0)":::"memory");
  float rli[16];
  #pragma unroll
  for(int r=0;r<16;++r)rli[r]=__builtin_amdgcn_rcpf(wsf[32+crow(r,hi)]);
  bf16*Ow=O+(rowbase+q0+wid*QBLK)*DM+ocol;
  { bf16*stg=(bf16*)(shm+LDS_OST)+wid*2048;
    #pragma unroll
    for(int r=0;r<16;++r){const int orow=crow(r,hi);
      #pragma unroll
      for(int d0=0;d0<2;++d0)stg[orow*64+d0*32+r32]=__float2bfloat16(o[d0][r]*rli[r]);}
    asm volatile("s_waitcnt lgkmcnt(0)":::"memory");
    #pragma unroll
    for(int i=0;i<4;++i){const int row=i*8+(lane>>3),ch=lane&7; const u32x4 v=*(const u32x4*)(stg+row*64+ch*8); ATTN_STORE16(Ow+(long)row*DM+ch*8,v);} }
  asm volatile("s_waitcnt lgkmcnt(0)\n\ts_barrier":::"memory");
  #undef DMA_K
  #undef DMA_V
  #undef CMASK
  #undef START
  #undef RESC
  #undef ROT
}
constexpr int ATTN_LDS_BYTES=ALDS_BYTES;

#undef SBAR
#undef WAIT_BAR
#undef ATTN_STORE16
}
namespace attn128 {
using bf16=__hip_bfloat16;
using bf16x8=__attribute__((ext_vector_type(8)))short;
using s16x4=__attribute__((ext_vector_type(4)))short;
using f32x16=__attribute__((ext_vector_type(16)))float;
using u32x4=__attribute__((ext_vector_type(4)))unsigned;
constexpr int SEQ=2048,D=64,DM=1024;
constexpr int NW=8,QBLK=32,QB=QBLK*NW,KVBLK=64,NQB=SEQ/QB;
constexpr int ATTN_PITCH=DM, ATTN_UNIT_ROWS=QB;
__device__ __forceinline__ int crow(int r,int hi){return (r&3)+8*(r>>2)+4*hi;}
#define SBAR() __builtin_amdgcn_sched_barrier(0)
__device__ __forceinline__ void cmask(f32x16&p0,f32x16&p1,int jb,int qrel,int hi){
  const float NEG=-INFINITY; int kb=64*jb+4*hi;
  #pragma unroll
  for(int r=0;r<16;++r){int kv=kb+(r&3)+8*(r>>2); if(kv>qrel)p0[r]=NEG; if(kv+32>qrel)p1[r]=NEG;}
}

constexpr int NSLOT=3, SLOTB=8192;
constexpr int VSLOTB=2*SLOTB;
constexpr int LDS_K=0, LDS_V=NSLOT*SLOTB, LDS_WS=LDS_V+NSLOT*VSLOTB, LDS_OST=LDS_WS+NW*64*4, ALDS_BYTES=LDS_OST+NW*4096;
constexpr float C2=0.125f*1.4426950408889634f;
__device__ __forceinline__ void glds16(const void*gsrc,unsigned lds_dst){unsigned keep;
  asm volatile("s_mov_b32 %0, m0\n\ts_mov_b32 m0, %2\n\ts_nop 0\n\tglobal_load_lds_dwordx4 %1, off\n\ts_mov_b32 m0, %0":"=&s"(keep):"v"(gsrc),"s"(lds_dst):"memory");}
__device__ __forceinline__ float max3f(float a,float b,float c){float r;asm("v_max3_f32 %0, %1, %2, %3":"=v"(r):"v"(a),"v"(b),"v"(c));return r;}
__device__ __forceinline__ float max2f(float a,float b){float r;asm("v_max_f32_e32 %0, %1, %2":"=v"(r):"v"(a),"v"(b));return r;}
__device__ __forceinline__ float fadd_s(float a,float b){float r;asm("v_add_f32_e32 %0, %1, %2":"=v"(r):"v"(a),"v"(b));return r;}
__device__ __forceinline__ float fsub_s(float a,float b){float r;asm("v_sub_f32_e32 %0, %1, %2":"=v"(r):"v"(a),"v"(b));return r;}
typedef float f32x2_t __attribute__((ext_vector_type(2))); typedef __bf16 bf16x2_t __attribute__((ext_vector_type(2)));
__device__ __forceinline__ unsigned cvtpk_s(float lo,float hi){f32x2_t v={lo,hi};bf16x2_t b=__builtin_convertvector(v,bf16x2_t);return __builtin_bit_cast(unsigned,b);}
#define WAIT_BAR(N) asm volatile("s_waitcnt vmcnt(" #N ") lgkmcnt(0)\n\ts_barrier":::"memory")

__device__ __forceinline__ void qkt(f32x16&p0,f32x16&p1,const char*Kslot,const bf16x8*qr,const f32x16&negm,int r32,int hi){
  const char*kb=Kslot+hi*1024+r32*16;
  #pragma unroll
  for(int d0=0;d0<4;++d0){
    const bf16x8 b0=*reinterpret_cast<const bf16x8*>(kb+d0*2048);
    const bf16x8 b1=*reinterpret_cast<const bf16x8*>(kb+d0*2048+512);
    if(d0==0){p0=__builtin_amdgcn_mfma_f32_32x32x16_bf16(b0,qr[0],negm,0,0,0);p1=__builtin_amdgcn_mfma_f32_32x32x16_bf16(b1,qr[0],negm,0,0,0);}
    else{p0=__builtin_amdgcn_mfma_f32_32x32x16_bf16(b0,qr[d0],p0,0,0,0);p1=__builtin_amdgcn_mfma_f32_32x32x16_bf16(b1,qr[d0],p1,0,0,0);}}
}
typedef __attribute__((address_space(3))) const char* lds_cptr;
typedef short v4i16_t __attribute__((ext_vector_type(4)));
__device__ __forceinline__ void kload8(bf16x8*kf,lds_cptr kp){
  kf[0]=*(const __attribute__((address_space(3))) bf16x8*)(kp);      kf[1]=*(const __attribute__((address_space(3))) bf16x8*)(kp+512);
  kf[2]=*(const __attribute__((address_space(3))) bf16x8*)(kp+2048); kf[3]=*(const __attribute__((address_space(3))) bf16x8*)(kp+2560);
  kf[4]=*(const __attribute__((address_space(3))) bf16x8*)(kp+4096); kf[5]=*(const __attribute__((address_space(3))) bf16x8*)(kp+4608);
  kf[6]=*(const __attribute__((address_space(3))) bf16x8*)(kp+6144); kf[7]=*(const __attribute__((address_space(3))) bf16x8*)(kp+6656);
}
__device__ __forceinline__ void kload2(bf16x8*kf,lds_cptr kp,int j){ kf[2*j]=*(const __attribute__((address_space(3))) bf16x8*)(kp+j*2048); kf[2*j+1]=*(const __attribute__((address_space(3))) bf16x8*)(kp+j*2048+512); }
__device__ __forceinline__ s16x4 vtr(lds_cptr p){ return __builtin_bit_cast(s16x4,__builtin_amdgcn_ds_read_tr16_b64_v4i16((__attribute__((address_space(3))) v4i16_t*)p)); }
__device__ __forceinline__ float rowmax(const f32x16&p0,const f32x16&p1){
  float a=max3f(p0[0],p0[1],p1[0]),b=max3f(p0[2],p0[3],p1[1]);a=max3f(a,p1[2],p1[3]);
  #pragma unroll
  for(int r=4;r<16;r+=4){a=max3f(a,p0[r],p0[r+1]);b=max3f(b,p0[r+2],p0[r+3]);a=max3f(a,p1[r],p1[r+1]);b=max3f(b,p1[r+2],p1[r+3]);}
  const float m=max2f(a,b);
  auto rr=__builtin_amdgcn_permlane32_swap(__float_as_uint(m),__float_as_uint(m),false,false);
  return max2f(__uint_as_float(rr[0]),__uint_as_float(rr[1]));
}
__device__ __forceinline__ void pv(f32x16*o,int vb,bf16x8 pa0,bf16x8 pa1,bf16x8 pa2,bf16x8 pa3){
  #pragma unroll
  for(int d0=0;d0<4;++d0){s16x4 lo[4],hi[4];
    #pragma unroll
    for(int ks=0;ks<4;++ks){
      asm volatile("ds_read_b64_tr_b16 %0,%1 offset:%c2":"=&v"(lo[ks]):"v"(vb),"i"(d0*4096+ks*1024):"memory");
      asm volatile("ds_read_b64_tr_b16 %0,%1 offset:%c2":"=&v"(hi[ks]):"v"(vb),"i"(d0*4096+ks*1024+512):"memory");}
    asm volatile("s_waitcnt lgkmcnt(0)":::"memory");SBAR();
    #define PK(k) (bf16x8){lo[k][0],lo[k][1],lo[k][2],lo[k][3],hi[k][0],hi[k][1],hi[k][2],hi[k][3]}
    o[d0]=__builtin_amdgcn_mfma_f32_32x32x16_bf16(pa0,PK(0),o[d0],0,0,0);
    o[d0]=__builtin_amdgcn_mfma_f32_32x32x16_bf16(pa1,PK(1),o[d0],0,0,0);
    o[d0]=__builtin_amdgcn_mfma_f32_32x32x16_bf16(pa2,PK(2),o[d0],0,0,0);
    o[d0]=__builtin_amdgcn_mfma_f32_32x32x16_bf16(pa3,PK(3),o[d0],0,0,0);
    #undef PK
  }
}

#ifndef ATTN_STORE16
#define ATTN_STORE16(p,v) (*(u32x4*)(p)=(v))
#endif
template<int THRL> __device__ __forceinline__ void attn_unit(int b,int qcol,int kcol,int vcol,int ocol,int qb,const bf16*Q,const bf16*__restrict__ K,const bf16*__restrict__ V,bf16*O,char*shm){
  int tid_=threadIdx.x; asm volatile("":"+v"(tid_));
  const int tid=tid_,lane=tid&63,r32=lane&31,hi=lane>>5; const int wid=__builtin_amdgcn_readfirstlane(tid>>6);
  const long rowbase=(long)b*SEQ; const int q0=qb*QB;
  const bf16*Qw=Q+(rowbase+q0+wid*QBLK)*DM+qcol;
  const bf16*Kh=K+rowbase*DM+kcol,*Vh=V+rowbase*DM+vcol;
  const unsigned lds0=(unsigned)(uintptr_t)shm;
  float*wsf=(float*)(shm+LDS_WS)+wid*64;
  const bf16*ksrc=Kh+(long)lane*DM+wid*8;
  const bf16*vsrc=Vh+(long)(16*(wid&3)+(lane>>2))*DM+(wid>>2)*32+(lane&3)*8;
  const unsigned kdst=lds0+LDS_K+wid*1024, vdst=lds0+LDS_V+wid*1024;
  #define DMA_K(t,slot) glds16(ksrc+(long)(t)*KVBLK*DM,(unsigned)__builtin_amdgcn_readfirstlane(kdst+(slot)))
  #define DMA_V(t,slot) do{ glds16(vsrc+(long)(t)*KVBLK*DM,(unsigned)__builtin_amdgcn_readfirstlane(vdst+2*(slot))); glds16(vsrc+64+(long)(t)*KVBLK*DM,(unsigned)__builtin_amdgcn_readfirstlane(vdst+8192+2*(slot))); }while(0)
  const int vb0=(int)(lds0+LDS_V)+((lane>>4)&1)*32+(lane&3)*8+(4*hi+((lane&15)>>2))*64;
  const char*Kbase=shm+LDS_K; bf16x8 kf[8];
  const lds_cptr shm3=(lds_cptr)shm; const lds_cptr kp0=shm3+LDS_K+hi*1024+r32*16; const lds_cptr vp0=shm3+LDS_V+((lane>>4)&1)*32+(lane&3)*8+(4*hi+((lane&15)>>2))*64;
  const int NT=(q0+QB)/KVBLK;
  DMA_K(0,0);DMA_V(0,0);DMA_K(1,SLOTB);
  bf16x8 qr[4];
  #pragma unroll
  for(int d0=0;d0<4;++d0)qr[d0]=*reinterpret_cast<const bf16x8*>(&Qw[(long)r32*DM+d0*16+hi*8]);
  float l_reg=0.f;f32x16 o[4];o[0]=f32x16{};o[1]=f32x16{};o[2]=f32x16{};o[3]=f32x16{};const f32x16 negm=f32x16{};
  const int qrel=wid*QBLK+r32;
  #define CMASK(P0,P1,t) do{int jb_=(t)-(NT-4); if(jb_>=0)cmask(P0,P1,jb_,qrel,hi);}while(0)
  #define START(P0,P1) do{ _Pragma("unroll") for(int r=0;r<16;++r)P0[r]=__builtin_amdgcn_exp2f(P0[r]); }while(0)
  #define RESC() do{}while(0)
  f32x16 pA0,pA1,pB0,pB1;
  int sl_prev=0,sl_cur=0,sl_next=SLOTB;
  #define ROT() do{sl_prev=sl_cur;sl_cur=sl_next;sl_next=(sl_next==(NSLOT-1)*SLOTB)?0:sl_next+SLOTB;}while(0)
  DMA_K(2,2*SLOTB);
  WAIT_BAR(4);
  qkt(pA0,pA1,Kbase,qr,negm,r32,hi);asm volatile("s_nop 15\n\ts_nop 7":"+v"(pA0),"+v"(pA1));CMASK(pA0,pA1,0);
  START(pA0,pA1);
  _Pragma("unroll") for(int r=0;r<16;++r)pA1[r]=__builtin_amdgcn_exp2f(pA1[r]);
  WAIT_BAR(0);
  DMA_K(3,0);DMA_V(1,SLOTB);
  ROT();
  kload8(kf,kp0+sl_cur);
  WAIT_BAR(3);
  s16x4 vlo[8],vhi[8]; u32x4 pw0,pw1,pw2,pw3;
  #define PKW(P,B) cvtpk_s(P[B],P[B+1])
  #define PAF(k) __builtin_bit_cast(bf16x8,pw##k)
  #define VFR(i) (bf16x8){vlo[i][0],vlo[i][1],vlo[i][2],vlo[i][3],vhi[i][0],vhi[i][1],vhi[i][2],vhi[i][3]}
  #define PIN(x) asm volatile("":"+v"(x))
  #define MX3(a,b,c) __builtin_fmaxf(__builtin_fmaxf((a),(b)),(c))
  #define GAPA(MF,A0,A1,A2,A3,W0,W1,PW) do{ MF; sacc+=A0; sacc+=A1; sacc+=A2; sacc+=A3; PIN(sacc); W0; W1; PIN(PW); SBAR(); }while(0)
  #define EX(v) __builtin_amdgcn_exp2f(v)
  #define GAPB(MF,X,B) do{ MF; X[B]=EX(X[B]); X[B+1]=EX(X[B+1]); PIN(X); SBAR(); }while(0)
  #define VRD2(i) do{ vlo[i]=vtr(vp_+((((i)>>2)+2)*4096+((i)&3)*1024)); vhi[i]=vtr(vp_+((((i)>>2)+2)*4096+((i)&3)*1024+512)); }while(0)
  #define VRD(i) do{ vlo[i]=vtr(vp_+(((i)>>2)*4096+((i)&3)*1024)); vhi[i]=vtr(vp_+(((i)>>2)*4096+((i)&3)*1024+512)); }while(0)
  #define KRD(G,j) do{ if(G){ kload2(kf,kp0+sl_next,j); SBAR(); } }while(0)
  #define STEP(C0,C1,P0,P1,t,GK,GV,GL) do{ SBAR(); \
    const lds_cptr vp_=vp0+2*sl_prev; \
    VRD(0); SBAR(); float sacc=(P0[0]+P0[1]); \
    GAPA(C0=__builtin_amdgcn_mfma_f32_32x32x16_bf16(kf[0],qr[0],negm,0,0,0), P0[2],P0[3],P0[4],P0[5],     pw0[0]=PKW(P0,0), pw0[1]=PKW(P0,2), pw0); \
    VRD(4); SBAR(); GAPA(C1=__builtin_amdgcn_mfma_f32_32x32x16_bf16(kf[1],qr[0],negm,0,0,0), P0[6],P0[7],P0[8],P0[9],     pw0[2]=PKW(P0,4), pw0[3]=PKW(P0,6), pw0); \
    VRD(1); SBAR(); GAPA(C0=__builtin_amdgcn_mfma_f32_32x32x16_bf16(kf[2],qr[1],C0,0,0,0),   P0[10],P0[11],P0[12],P0[13], pw1[0]=PKW(P0,8), pw1[1]=PKW(P0,10), pw1); \
    VRD(5); SBAR(); GAPA(C1=__builtin_amdgcn_mfma_f32_32x32x16_bf16(kf[3],qr[1],C1,0,0,0),   P0[14],P0[15],P1[0],P1[1],   pw1[2]=PKW(P0,12),pw1[3]=PKW(P0,14), pw1); \
    VRD(2); SBAR(); GAPA(C0=__builtin_amdgcn_mfma_f32_32x32x16_bf16(kf[4],qr[2],C0,0,0,0),   P1[2],P1[3],P1[4],P1[5],     pw2[0]=PKW(P1,0), pw2[1]=PKW(P1,2), pw2); \
    VRD(6); SBAR(); GAPA(C1=__builtin_amdgcn_mfma_f32_32x32x16_bf16(kf[5],qr[2],C1,0,0,0),   P1[6],P1[7],P1[8],P1[9],     pw2[2]=PKW(P1,4), pw2[3]=PKW(P1,6), pw2); \
    VRD(3); SBAR(); GAPA(C0=__builtin_amdgcn_mfma_f32_32x32x16_bf16(kf[6],qr[3],C0,0,0,0),   P1[10],P1[11],P1[12],P1[13], pw3[0]=PKW(P1,8), pw3[1]=PKW(P1,10), pw3); \
    VRD(7); SBAR(); GAPA(C1=__builtin_amdgcn_mfma_f32_32x32x16_bf16(kf[7],qr[3],C1,0,0,0),   P1[14],P1[15],0.f,0.f,       pw3[2]=PKW(P1,12),pw3[3]=PKW(P1,14), pw3); \
    l_reg+=sacc; \
    if(GK){DMA_K((t)+3,sl_cur);} if(GV){DMA_V((t)+1,sl_next);} \
    CMASK(C0,C1,t); \
    SBAR(); \
    GAPB(o[0]=__builtin_amdgcn_mfma_f32_32x32x16_bf16(PAF(0),VFR(0),o[0],0,0,0), C0,0);  VRD2(0); SBAR(); \
    GAPB(o[1]=__builtin_amdgcn_mfma_f32_32x32x16_bf16(PAF(0),VFR(4),o[1],0,0,0), C0,2);  VRD2(4); SBAR(); \
    KRD(GL,0); GAPB(o[0]=__builtin_amdgcn_mfma_f32_32x32x16_bf16(PAF(1),VFR(1),o[0],0,0,0), C0,4);  VRD2(1); SBAR(); \
    KRD(GL,1); GAPB(o[1]=__builtin_amdgcn_mfma_f32_32x32x16_bf16(PAF(1),VFR(5),o[1],0,0,0), C0,6);  VRD2(5); SBAR(); \
    KRD(GL,2); GAPB(o[0]=__builtin_amdgcn_mfma_f32_32x32x16_bf16(PAF(2),VFR(2),o[0],0,0,0), C0,8);  VRD2(2); SBAR(); \
    KRD(GL,3); GAPB(o[1]=__builtin_amdgcn_mfma_f32_32x32x16_bf16(PAF(2),VFR(6),o[1],0,0,0), C0,10); VRD2(6); SBAR(); \
    GAPB(o[0]=__builtin_amdgcn_mfma_f32_32x32x16_bf16(PAF(3),VFR(3),o[0],0,0,0), C0,12); VRD2(3); SBAR(); \
    GAPB(o[1]=__builtin_amdgcn_mfma_f32_32x32x16_bf16(PAF(3),VFR(7),o[1],0,0,0), C0,14); VRD2(7); SBAR(); \
    GAPB(o[2]=__builtin_amdgcn_mfma_f32_32x32x16_bf16(PAF(0),VFR(0),o[2],0,0,0), C1,0); \
    GAPB(o[3]=__builtin_amdgcn_mfma_f32_32x32x16_bf16(PAF(0),VFR(4),o[3],0,0,0), C1,2); \
    GAPB(o[2]=__builtin_amdgcn_mfma_f32_32x32x16_bf16(PAF(1),VFR(1),o[2],0,0,0), C1,4); \
    GAPB(o[3]=__builtin_amdgcn_mfma_f32_32x32x16_bf16(PAF(1),VFR(5),o[3],0,0,0), C1,6); \
    GAPB(o[2]=__builtin_amdgcn_mfma_f32_32x32x16_bf16(PAF(2),VFR(2),o[2],0,0,0), C1,8); \
    GAPB(o[3]=__builtin_amdgcn_mfma_f32_32x32x16_bf16(PAF(2),VFR(6),o[3],0,0,0), C1,10); \
    GAPB(o[2]=__builtin_amdgcn_mfma_f32_32x32x16_bf16(PAF(3),VFR(3),o[2],0,0,0), C1,12); \
    GAPB(o[3]=__builtin_amdgcn_mfma_f32_32x32x16_bf16(PAF(3),VFR(7),o[3],0,0,0), C1,14); \
    }while(0)
  int t=1;
  #undef CMASK
  #define CMASK(P0,P1,t) do{}while(0)
  for(;t+5<NT;t+=2){
    STEP(pB0,pB1,pA0,pA1,t,true,true,true);     WAIT_BAR(3); RESC(); ROT();
    STEP(pA0,pA1,pB0,pB1,t+1,true,true,true);   WAIT_BAR(3); RESC(); ROT();
  }
  #undef CMASK
  #define CMASK(P0,P1,t) do{int jb_=(t)-(NT-4); if(jb_>=0)cmask(P0,P1,jb_,qrel,hi);}while(0)
  #define ENDW(tt) do{ if((tt)+3<NT){WAIT_BAR(3);} else if((tt)+2<NT){WAIT_BAR(2);} else {WAIT_BAR(0);} }while(0)
  for(;t+1<NT;t+=2){
    STEP(pB0,pB1,pA0,pA1,t,(t+3<NT),(t+1<NT),(t+1<NT));       ENDW(t);   RESC(); ROT();
    STEP(pA0,pA1,pB0,pB1,t+1,(t+4<NT),(t+2<NT),(t+2<NT));     ENDW(t+1); RESC(); ROT();
  }
  STEP(pB0,pB1,pA0,pA1,NT-1,false,false,false); RESC();
  { float sacc=pB0[0]+pB0[1]; _Pragma("unroll") for(int r=2;r<16;++r)sacc+=pB0[r]; _Pragma("unroll") for(int r=0;r<16;++r)sacc+=pB1[r]; l_reg+=sacc;
    pw0=(u32x4){PKW(pB0,0),PKW(pB0,2),PKW(pB0,4),PKW(pB0,6)};pw1=(u32x4){PKW(pB0,8),PKW(pB0,10),PKW(pB0,12),PKW(pB0,14)};pw2=(u32x4){PKW(pB1,0),PKW(pB1,2),PKW(pB1,4),PKW(pB1,6)};pw3=(u32x4){PKW(pB1,8),PKW(pB1,10),PKW(pB1,12),PKW(pB1,14)};
    SBAR(); pv(o,vb0+2*sl_cur,PAF(0),PAF(1),PAF(2),PAF(3)); }
  #undef PKW
  #undef PAF
  #undef VFR
  #undef PIN
  #undef MX3
  #undef GAPA
  #undef GAPB
  #undef EX
  #undef VRD
  #undef VRD2
  #undef KRD
  #undef STEP
  #undef ENDW
  {auto rr=__builtin_amdgcn_permlane32_swap(__float_as_uint(l_reg),__float_as_uint(l_reg),false,false);l_reg=__uint_as_float(rr[0])+__uint_as_float(rr[1]);}
  if(hi==0)wsf[32+r32]=l_reg;asm volatile("s_waitcnt lgkmcnt(0)":::"memory");
  float rli[16];
  #pragma unroll
  for(int r=0;r<16;++r)rli[r]=__builtin_amdgcn_rcpf(wsf[32+crow(r,hi)]);
  bf16*Ow=O+(rowbase+q0+wid*QBLK)*DM+ocol;
  { bf16*stg=(bf16*)(shm+LDS_OST)+wid*2048;
    #pragma unroll
    for(int hv=0;hv<2;++hv){
      #pragma unroll
      for(int r=0;r<16;++r){const int orow=crow(r,hi);
        #pragma unroll
        for(int d0=0;d0<2;++d0)stg[orow*64+d0*32+r32]=__float2bfloat16(o[2*hv+d0][r]*rli[r]);}
      asm volatile("s_waitcnt lgkmcnt(0)":::"memory");
      #pragma unroll
      for(int i=0;i<4;++i){const int row=i*8+(lane>>3),ch=lane&7; const u32x4 v=*(const u32x4*)(stg+row*64+ch*8); ATTN_STORE16(Ow+(long)row*DM+hv*64+ch*8,v);}
      asm volatile("s_waitcnt lgkmcnt(0)":::"memory"); } }
  asm volatile("s_waitcnt lgkmcnt(0)\n\ts_barrier":::"memory");
  #undef DMA_K
  #undef DMA_V
  #undef CMASK
  #undef START
  #undef RESC
  #undef ROT
}
constexpr int ATTN_LDS_BYTES=ALDS_BYTES;

#undef SBAR
#undef WAIT_BAR
#undef ATTN_STORE16
}
constexpr size_t WS_ATT0 = WS_ACT, WS_ATT1 = WS_ACT + 32 * MiB;

__device__ __forceinline__ void diff_combine(const Params& P, int b, int h, int qb) {
    int tid_ = threadIdx.x; asm volatile("" : "+v"(tid_));
    const int tid = tid_, lane = tid & 63, wid = tid >> 6;
    const float lam = __expf(wave_sum(P.in[I_LQ1][lane] * P.in[I_LK1][lane])) - __expf(wave_sum(P.in[I_LQ2][lane] * P.in[I_LK2][lane])) + 0.2f;
    const int ch = lane & 15;
    const f32x4 g0 = *(const f32x4*)(P.in[I_SG] + 8 * ch), g1 = *(const f32x4*)(P.in[I_SG] + 8 * ch + 4);
    const size_t row0 = (size_t)b * SEQ + qb * 256 + wid * 32 + (lane >> 4);
    const bf16_t* s0 = (const bf16_t*)(P.ws + WS_ATT0) + row0 * D + h * 128 + 8 * ch; const bf16_t* s1 = (const bf16_t*)(P.ws + WS_ATT1) + row0 * D + h * 128 + 8 * ch;
    bf16_t* dst = (bf16_t*)(P.ws + WS_MA) + row0 * MA_LD + h * 128 + 8 * ch;
#pragma unroll
    for (int it = 0; it < 8; ++it) {
        f32x4 a0, a1, b0, b1; pg::unpack8(*(const u32x4*)(s0 + (size_t)(4 * it) * D), a0, a1); pg::unpack8(*(const u32x4*)(s1 + (size_t)(4 * it) * D), b0, b1);
        const f32x4 o0 = a0 - lam * b0, o1 = a1 - lam * b1;
        float ss = (o0[0] * o0[0] + o0[1] * o0[1]) + (o0[2] * o0[2] + o0[3] * o0[3]) + (o1[0] * o1[0] + o1[1] * o1[1]) + (o1[2] * o1[2] + o1[3] * o1[3]);
        ss += __shfl_xor(ss, 1); ss += __shfl_xor(ss, 2); ss += __shfl_xor(ss, 4); ss += __shfl_xor(ss, 8);
        const float r = rsqrtf(ss * (1.f / 128.f) + EPS) * 0.8f;
        *(u32x4*)(dst + (size_t)(4 * it) * MA_LD) = pg::pack8(o0 * r * g0, o1 * r * g1);
    }
}
__device__ __forceinline__ void attn_phase(const Params& P, char* lds, int vcu, int G) {
    using attn_body::bf16;
    const bf16* Q = (const bf16*)(P.ws + WS_Q); const bf16* K = (const bf16*)(P.ws + WS_K); const bf16* V = (const bf16*)(P.ws + WS_V);
    for (int v = vcu; v < 256; v += G) {
        const int bh = v >> 2, b = bh >> 3, h = bh & 7, s = v & 3;
        for (int i = 0; i < 2; ++i) { const int qb = i == 0 ? 7 - s : s;
#ifndef ATTN_V128
#define ATTN_V128 1
#endif
#if ATTN_V128
            for (int m = 0; m < 2; ++m) {
#if EXPERTS_IN_ATTN
#ifndef CONV_SLOTS
#define CONV_SLOTS 4
#endif
#ifndef CONV_SPLIT
#define CONV_SPLIT 1
#endif
                if (CONV_SLOTS == 2 ? (i == 0 && m == ((v >> 2) & 1)) : ((i * 2 + m - (((v >> 2) + v) & 3)) & (CONV_SPLIT == 2 ? 1 : 3)) == 0) {
                    constexpr int per = (EXP_M10 - EXP_ATT0) / 256; const int hsel = CONV_SPLIT == 2 ? (((i * 2 + m - (((v >> 2) + v) & 3)) >> 1) & 1) : 0;
                    expert_convert_slice(P, (LAS unsigned char*)lds, EXP_ATT0 + v * per + hsel * (per / 2), CONV_SPLIT == 2 ? EXP_ATT0 + v * per + (hsel + 1) * (per / 2) : EXP_ATT0 + (v + 1) * per);
#if defined(PROBE_CONV2)
                    asm volatile("s_waitcnt vmcnt(0) lgkmcnt(0)" ::: "memory"); __syncthreads(); expert_convert_slice(P, (LAS unsigned char*)lds, EXP_ATT0 + v * per, EXP_ATT0 + (v + 1) * per, true);
#endif
                    asm volatile("s_waitcnt vmcnt(0) lgkmcnt(0)" ::: "memory"); __syncthreads(); }
#endif
                attn128::attn_unit<8>(b, h * 128 + m * 64, h * 128 + m * 64, h * 128, h * 128, qb, (const attn128::bf16*)Q, (const attn128::bf16*)K, (const attn128::bf16*)V, (attn128::bf16*)(P.ws + (m == 0 ? WS_ATT0 : WS_ATT1)), lds); }
#else
            for (int pass = 0; pass < 4; ++pass) { const int m = pass >> 1, vh = pass & 1;
#if EXPERTS_IN_ATTN
                if (i * 4 + pass == (((v >> 2) + v) & 3)) {
                    constexpr int per = (EXP_M10 - EXP_ATT0) / 256; expert_convert_slice(P, (LAS unsigned char*)lds, EXP_ATT0 + v * per, EXP_ATT0 + (v + 1) * per);
                    asm volatile("s_waitcnt vmcnt(0) lgkmcnt(0)" ::: "memory"); __syncthreads(); }
#endif
                attn_body::attn_unit<8>(b, h * 128 + m * 64, h * 128 + m * 64, h * 128 + vh * 64, h * 128 + vh * 64, qb, Q, K, V, (bf16*)(P.ws + (m == 0 ? WS_ATT0 : WS_ATT1)), lds); }
#endif
            asm volatile("s_waitcnt vmcnt(0)" ::: "memory");
            diff_combine(P, b, h, qb);
        }
    }
}

__device__ __forceinline__ void ssm1_phase(const Params& P, LAS unsigned char* lds, int vcu, int G) {
    const int tid = opaque_tid(), lane = tid & 63, wid = __builtin_amdgcn_readfirstlane(tid >> 6), fr = lane & 15, fq = lane >> 4;
    LAS float* Sl = (LAS float*)lds;
    for (int u = vcu; u < SSM_G * BATCH; u += G) {
        const int g = u >> 3, b = u & 7;
        bf16_t* A = (bf16_t*)(P.ws + WS_ACAT) + (size_t)(g * ACAT_ROWS + b * NCH) * ACAT_LD;
        const bf16_t* Bw = (const bf16_t*)(P.ws + WS_WS_T) + (size_t)(g * 128 + 16 * wid + fr) * 512 + fq * 8;
        f32x4 acc[4];
#pragma unroll
        for (int m = 0; m < 4; ++m) acc[m] = (f32x4){0.f, 0.f, 0.f, 0.f};
#pragma unroll 4
        for (int ks = 0; ks < 16; ++ks) {
            const bf16x8 bf = *(const bf16x8*)(Bw + ks * 32);
#pragma unroll
            for (int m = 0; m < 4; ++m) { const bf16x8 af = *(const bf16x8*)(A + (size_t)(16 * m + fr) * ACAT_LD + ks * 32 + fq * 8);
                acc[m] = __builtin_amdgcn_mfma_f32_16x16x32_bf16(af, bf, acc[m], 0, 0, 0); }
        }
#pragma unroll
        for (int m = 0; m < 4; ++m)
#pragma unroll
            for (int q = 0; q < 4; ++q) Sl[(16 * m + 4 * fq + q) * 129 + 16 * wid + fr] = acc[m][q];
        __syncthreads();
        if (tid < SSM_P) {
            const int p = tid; const SsmGP gp = ssm_gp(P, g, p); float aLr, aLi; ssm_pow(gp, CH_L, aLr, aLi);
            float xr = 0.f, xi = 0.f;
            bf16_t* xp = A + 512 + p;
            for (int c = 0; c < NCH; ++c) {
                xp[(size_t)c * ACAT_LD] = (bf16_t)f2bf(xr); xp[(size_t)c * ACAT_LD + 64] = (bf16_t)f2bf(xi);
                const float sr = Sl[c * 129 + p], si = Sl[c * 129 + 64 + p];
                const float nr = aLr * xr - aLi * xi + sr, ni = aLr * xi + aLi * xr + si; xr = nr; xi = ni;
            }
        }
        __syncthreads();
    }
}
namespace pg {
struct Ssm2Sched {
    unsigned char* ws; int G, c;
    __device__ __forceinline__ void init(unsigned char* ws_, int G_, int c_) { ws = ws_; G = G_; c = c_; }
    __device__ __forceinline__ bool next(int i, Unit& u) const {
        const int L = i * G + c; if (L >= SSM_G * 4) return false;
        const int g = L >> 2; u.pm = (L >> 1) & 1; u.pn = L & 1; u.aux = g; u.aux2 = 0; u.ord = i; const LaneRC rc;
        u.A = (const char*)((const bf16_t*)(ws + WS_ACAT) + (size_t)g * ACAT_ROWS * ACAT_LD); u.B = (const char*)((const bf16_t*)(ws + WS_BT_SSM) + ((size_t)g * 512 + u.pn * BM) * ACAT_LD);
#pragma unroll
        for (int h = 0; h < 2; ++h)
#pragma unroll
            for (int j = 0; j < 2; ++j) u.aoff[h][j] = (unsigned)(((u.pm * BM + 128 * h + rc.R[j]) * ACAT_LD + rc.C[j]) * 2);
        return true;
    }
};
}

constexpr int RT_LG_OFF = RING_BYTES + 2048;
constexpr int RT_HIST_OFF = RT_LG_OFF + 64 * 33 * 4;
__device__ __forceinline__ void router_phase(const Params& P, LAS unsigned char* lds, int vcu, int G) {
    const int tid = opaque_tid(), lane = tid & 63, wid = __builtin_amdgcn_readfirstlane(tid >> 6);
    const float* wrt = (const float*)(P.ws + WS_WR_T);
#pragma unroll 4
    for (int i = 0; i < 16; ++i) ((LAS f32x4*)lds)[tid + NTHREADS * i] = ((const f32x4*)wrt)[tid + NTHREADS * i];
    LAS float* lg = (LAS float*)(lds + RT_LG_OFF); LAS int* hist = (LAS int*)(lds + RT_HIST_OFF);
    unsigned* cnt = (unsigned*)(P.ws + WS_CTL) + CW_CNT;
    int* slot_tok = (int*)(P.ws + WS_SLOT_TOK); float* slot_gate = (float*)(P.ws + WS_SLOT_GATE); int* tok_ep = (int*)(P.ws + WS_TOK_EP);
    unsigned char* H2 = P.ws + WS_H2;
    f32x4 g2v[4];
#pragma unroll
    for (int j = 0; j < 4; ++j) g2v[j] = ((const f32x4*)P.in[I_G2])[lane + 64 * j];
    for (int tb = vcu; tb < T / 64; tb += G) {
        if (tid < 64) hist[tid] = 0;
        __syncthreads();
        f32x4 n0[4], n1[4];
#pragma unroll
        for (int j = 0; j < 4; ++j) { const int tn = tb * 64 + wid * 8; n0[j] = NT_LOAD((const f32x4*)((const float*)(P.ws + WS_X1) + (size_t)tn * D) + lane + 64 * j); n1[j] = NT_LOAD((const f32x4*)((const float*)(P.ws + WS_X1) + (size_t)(tn + 1) * D) + lane + 64 * j); }
        for (int pass = 0; pass < 4; ++pass) {
            const int t0 = tb * 64 + wid * 8 + pass * 2;
            f32x4 h0[4], h1[4]; float s0 = 0.f, s1 = 0.f;
#pragma unroll
            for (int j = 0; j < 4; ++j) { h0[j] = n0[j]; h1[j] = n1[j]; }
#pragma unroll
            for (int j = 0; j < 4; ++j) { const int tn = tb * 64 + wid * 8 + min(pass + 1, 3) * 2; n0[j] = NT_LOAD((const f32x4*)((const float*)(P.ws + WS_X1) + (size_t)tn * D) + lane + 64 * j); n1[j] = NT_LOAD((const f32x4*)((const float*)(P.ws + WS_X1) + (size_t)(tn + 1) * D) + lane + 64 * j); }
#pragma unroll
            for (int j = 0; j < 4; ++j) {
                s0 += (h0[j].x * h0[j].x + h0[j].y * h0[j].y) + (h0[j].z * h0[j].z + h0[j].w * h0[j].w); s1 += (h1[j].x * h1[j].x + h1[j].y * h1[j].y) + (h1[j].z * h1[j].z + h1[j].w * h1[j].w); }
            const float r0 = rsqrtf(wave_sum(s0) * (1.f / D) + EPS), r1 = rsqrtf(wave_sum(s1) * (1.f / D) + EPS);
#pragma unroll
            for (int j = 0; j < 4; ++j) { h0[j] = h0[j] * r0 * g2v[j]; h1[j] = h1[j] * r1 * g2v[j];
                ((unsigned*)(H2 + (size_t)t0 * D))[lane + 64 * j] = pk4_fp8(h0[j].x, h0[j].y, h0[j].z, h0[j].w);
                ((unsigned*)(H2 + (size_t)(t0 + 1) * D))[lane + 64 * j] = pk4_fp8(h1[j].x, h1[j].y, h1[j].z, h1[j].w); }
            float v[64];
#pragma unroll
            for (int e = 0; e < NE; ++e) { float a0 = 0.f, a1 = 0.f;
#pragma unroll
                for (int j = 0; j < 4; ++j) { const f32x4 w = ((const LAS f32x4*)(lds + e * 4096))[lane + 64 * j];
                    a0 += (h0[j].x * w.x + h0[j].y * w.y) + (h0[j].z * w.z + h0[j].w * w.w); a1 += (h1[j].x * w.x + h1[j].y * w.y) + (h1[j].z * w.z + h1[j].w * w.w); }
                v[e] = a0; v[32 + e] = a1; }
#pragma unroll
            for (int half = 32; half >= 1; half >>= 1) { const bool upper = (lane & half) != 0;
#pragma unroll
                for (int i = 0; i < half; ++i) { const float send = upper ? v[i] : v[i + half], keep = upper ? v[i + half] : v[i]; v[i] = keep + __shfl_xor(send, half); } }
            lg[(wid * 8 + pass * 2 + (lane >> 5)) * 33 + (lane & 31)] = v[0] + P.in[I_BR][lane & 31];
        }
        __syncthreads();
        if (wid == 0) {
            const int tok = tb * 64 + lane;
            float tv[4]; int ti[4];
#pragma unroll
            for (int k = 0; k < 4; ++k) { tv[k] = -INFINITY; ti[k] = 0; }
            for (int e = 0; e < NE; ++e) { const float x = lg[lane * 33 + e];
                if (x > tv[3]) { if (x > tv[2]) { tv[3] = tv[2]; ti[3] = ti[2]; if (x > tv[1]) { tv[2] = tv[1]; ti[2] = ti[1]; if (x > tv[0]) { tv[1] = tv[0]; ti[1] = ti[0]; tv[0] = x; ti[0] = e; } else { tv[1] = x; ti[1] = e; } } else { tv[2] = x; ti[2] = e; } } else { tv[3] = x; ti[3] = e; } } }
            const float e1 = __expf(tv[1] - tv[0]), e2 = __expf(tv[2] - tv[0]), e3 = __expf(tv[3] - tv[0]); const float inv = 1.f / (1.f + e1 + e2 + e3);
            const float gk[4] = {inv, e1 * inv, e2 * inv, e3 * inv};
            int lp[4];
#pragma unroll
            for (int k = 0; k < 4; ++k) lp[k] = atomicAdd((int*)&hist[ti[k]], 1);
            asm volatile("s_waitcnt lgkmcnt(0)" ::: "memory");
            if (lane < NE) { const int n = hist[lane]; hist[32 + lane] = n ? (int)atomicAdd(&cnt[lane], (unsigned)n) : 0; }
            asm volatile("s_waitcnt vmcnt(0) lgkmcnt(0)" ::: "memory");
#pragma unroll
            for (int k = 0; k < 4; ++k) { const int e = ti[k], pos = hist[32 + e] + lp[k];
                slot_tok[(size_t)e * CAP + pos] = tok; slot_gate[(size_t)e * CAP + pos] = gk[k]; tok_ep[tok * 4 + k] = (e << 16) | pos; }
        }
        __syncthreads();
    }
}

#ifndef COMB_Y_DEFAULT
#define COMB_Y_LOAD(p) NT_LOAD(p)
#else
#define COMB_Y_LOAD(p) (*(p))
#endif
__device__ __forceinline__ void combine_phase(const Params& P, LAS unsigned char* lds, int vcu, int G) {
    const int tid = opaque_tid(), lane = tid & 63, wid = __builtin_amdgcn_readfirstlane(tid >> 6);
    const LAS int* tab = (const LAS int*)(lds + pg::TAB_OFF);
    const int* tok_ep = (const int*)(P.ws + WS_TOK_EP); const bf16_t* Y = (const bf16_t*)(P.ws + WS_Y); const float* sgate = (const float*)(P.ws + WS_SLOT_GATE);
    for (int tok = vcu * NWAVES + wid; tok < T; tok += G * NWAVES) {
        f32x4 a[4];
#pragma unroll
        for (int j = 0; j < 4; ++j) a[j] = NT_LOAD((const f32x4*)((const float*)(P.ws + WS_X1) + (size_t)tok * D) + lane + 64 * j);
#pragma unroll
        for (int k = 0; k < 4; ++k) { const int ep = tok_ep[tok * 4 + k]; const int slot = tab[ep >> 16] * 256 + (ep & 0xffff); const float gk = sgate[(size_t)(ep >> 16) * CAP + (ep & 0xffff)];
#pragma unroll
            for (int j = 0; j < 4; ++j) { const u32x2 w = COMB_Y_LOAD((const u32x2*)(Y + (size_t)slot * D) + lane + 64 * j); a[j] += gk * (f32x4){bflo(w.x), bfhi(w.x), bflo(w.y), bfhi(w.y)}; } }
#pragma unroll
        for (int j = 0; j < 4; ++j) NT_STORE(a[j], (f32x4*)(P.out + (size_t)tok * D) + lane + 64 * j);
    }
}
#define XB_TMO      128
#define XB_XCNT(j)  (256  + 64 * (j))
#define XB_XSUB(j)  (1280 + 64 * (j))
#define XB_XGEN(j)  (2304 + 64 * (j))
#define XB_TOP      3328
#define XB_TOPGEN   3392
#define XCD_BAR_WORDS 3456
#define XB_SPIN_CAP (1u << 18)
__device__ __forceinline__ unsigned xb_ld(unsigned* p)              { return __hip_atomic_load(p, __ATOMIC_RELAXED, __HIP_MEMORY_SCOPE_AGENT); }
__device__ __forceinline__ unsigned xb_add(unsigned* p, unsigned v) { return __hip_atomic_fetch_add(p, v, __ATOMIC_RELAXED, __HIP_MEMORY_SCOPE_AGENT); }
__device__ __forceinline__ unsigned xb_xcc_id() { return (unsigned)__builtin_amdgcn_s_getreg((3 << 11) | 20) & 0xFu; }
#define XB_SPIN(cond, bar) do { unsigned _sp = 0; while (cond) { __builtin_amdgcn_s_sleep(1); \
    if ((++_sp & 255u) == 0u) { if (xb_ld(&(bar)[XB_TMO])) break; if (_sp > XB_SPIN_CAP) { atomicAdd(&(bar)[XB_TMO], 1u); break; } } } } while (0)
struct XcdBarrier { unsigned* bar; unsigned x; volatile LAS unsigned* st; };
__device__ __forceinline__ XcdBarrier xcd_barrier_post(unsigned* bar, volatile LAS unsigned* st) {
    XcdBarrier b; b.bar = bar; b.x = xb_xcc_id(); b.st = st;
    if (threadIdx.x == 0) (void)xb_add(&bar[XB_XCNT(b.x)], 1u);
    return b;
}
__device__ __forceinline__ void xcd_barrier_complete(unsigned* bar, unsigned x, unsigned& nloc, unsigned& nx) {
    const unsigned G = gridDim.x * gridDim.y * gridDim.z;
    unsigned sum, cnt, mine, sp = 0u;
    for (;;) {
        sum = 0u; cnt = 0u; mine = 0u;
#pragma unroll
        for (unsigned j = 0; j < 16; ++j) { const unsigned c = xb_ld(&bar[XB_XCNT(j)]); sum += c; cnt += (c > 0u) ? 1u : 0u; mine = (j == x) ? c : mine; }
        if (sum == G) break;
        __builtin_amdgcn_s_sleep(1);
        if ((++sp & 255u) == 0u) { if (xb_ld(&bar[XB_TMO])) break; if (sp > XB_SPIN_CAP) { atomicAdd(&bar[XB_TMO], 1u); break; } }
    }
    nloc = mine > 0u ? mine : 1u; nx = cnt > 0u ? cnt : 1u;
}
__device__ __forceinline__ void xcd_barrier(const XcdBarrier& b) {
    asm volatile("s_waitcnt vmcnt(0)" ::: "memory");
    __syncthreads();
    if (threadIdx.x == 0) {
        unsigned* bar = b.bar;
        __builtin_amdgcn_s_waitcnt(0);
        unsigned nloc = b.st[0], nx = b.st[1];
        if (nloc == 0u) { xcd_barrier_complete(bar, b.x, nloc, nx); b.st[0] = nloc; b.st[1] = nx; }
        const unsigned old = xb_add(&bar[XB_XSUB(b.x)], 1u);
        const unsigned gen = old / nloc;
        if (old + 1u == (gen + 1u) * nloc) {
            __builtin_amdgcn_fence(__ATOMIC_RELEASE, "agent");
            asm volatile("s_waitcnt vmcnt(0)" ::: "memory");
            const unsigned og = xb_add(&bar[XB_TOP], 1u);
            const unsigned tg = og / nx;
            if (og + 1u == (tg + 1u) * nx) xb_add(&bar[XB_TOPGEN], 1u);
            else XB_SPIN(xb_ld(&bar[XB_TOPGEN]) == tg, bar);
            __builtin_amdgcn_fence(__ATOMIC_ACQUIRE, "agent");
            xb_add(&bar[XB_XGEN(b.x)], 1u);
            asm volatile("s_waitcnt vmcnt(0)" ::: "memory");
        } else {
            XB_SPIN(xb_ld(&bar[XB_XGEN(b.x)]) == gen, bar);
            __builtin_amdgcn_fence(__ATOMIC_ACQUIRE, "agent");
            asm volatile("s_waitcnt vmcnt(0)" ::: "memory");
        }
    }
    __syncthreads();
}
#ifndef PH_MASK
#define PH_MASK 0xffffffffu
#endif
__global__ void __launch_bounds__(NTHREADS, 2) mega_fwd(Params P) {
    extern __shared__ __attribute__((aligned(16))) unsigned char lds_[];
    LAS unsigned char* lds = (LAS unsigned char*)lds_;
    const int tid = threadIdx.x;
    const int G = gridDim.x, bx = blockIdx.x, vcu = (G % 8 == 0) ? (bx % 8) * (G / 8) + bx / 8 : bx;
    for (int u = tid; u < (LDS_BYTES - RING_BYTES) / 4; u += NTHREADS) ((LAS unsigned*)(lds + RING_BYTES))[u] = 0u;
    __syncthreads();
    unsigned* ctl = (unsigned*)(P.ws + WS_CTL);
    const XcdBarrier bar = xcd_barrier_post(ctl + CW_BAR, (volatile LAS unsigned*)(lds + MISC_OFF) + 8);
#ifndef PH_REP
#define PH_REP 0u
#endif
#ifndef BAR_REP
#define BAR_REP 1
#endif
#define GRID_BAR() do { for (int b_ = 0; b_ < BAR_REP; ++b_) xcd_barrier(bar); } while (0)
#define ON(k) for (int r_ = 0; r_ < 1 + (int)((PH_REP >> (k)) & 1u); ++r_) if ((PH_MASK >> (k)) & 1u)
#ifndef FWD_REP
#define FWD_REP 1
#endif
    for (int fwd_ = 0; fwd_ < FWD_REP; ++fwd_) {
    if (fwd_ > 0) { GRID_BAR(); if (bx == 0 && tid < 64) ctl[CW_CNT + tid] = 0u; }
    ON(0) p0_prologue(P, lds, vcu, G);
    GRID_BAR();
    ON(1) { pg::DenseSched S; S.init((const bf16_t*)(P.ws + WS_XN), D, (const bf16_t*)(P.ws + WS_WIN_T), D, T, IN_W, G, bx);
        pg::EpiInProj E; E.ws = P.ws; E.qg = P.in[I_QG]; E.kg = P.in[I_KG];
#if defined(PROBE_NULL_EPI)
        if (r_ == 1) { pg::EpiNull EN; pg::gemm_phase(lds, S, EN, D / 64, D); } else
#endif
#ifndef INPROJ_BAUX
#define INPROJ_BAUX 0
#endif
        pg::gemm_phase<false, INPROJ_BAUX>(lds, S, E, D / 64, D);
#if EXPERTS_IN_ATTN
        if (r_ == 0 && G == 256 && bx >= 128) expert_convert_slice(P, lds, EXP_IN0 + (bx - 128) * EXP_N_IN, EXP_IN0 + (bx - 127) * EXP_N_IN);
        __syncthreads();
#endif
    }
    GRID_BAR();
    ON(2) { ssm_toeplitz_expand(P, vcu, G); ssm1_phase(P, lds, vcu, G); }
    ON(3) attn_phase(P, (char*)lds_, vcu, G);
    GRID_BAR();
    ON(4) { pg::Ssm2Sched S; S.init(P.ws, G, bx); pg::EpiSsm2 E; E.ws = P.ws; pg::gemm_phase(lds, S, E, ACAT_LD / 64, ACAT_LD);
#if EXPERTS_IN_ATTN
        if (r_ == 0 && G == 256 && bx >= 128) expert_convert_slice(P, lds, EXP_S20 + (bx - 128) * EXP_N_S2, EXP_S20 + (bx - 127) * EXP_N_S2);
        __syncthreads();
#endif
    }
    GRID_BAR();
    ON(5) { pg::DenseSched S; S.init((const bf16_t*)(P.ws + WS_Z), SSM_W, (const bf16_t*)(P.ws + WS_WGLU_T), SSM_W, T, SSM_W, G, bx);
        pg::EpiGlu E; E.ws = P.ws; E.bglu = P.in[I_BGLU]; pg::gemm_phase(lds, S, E, SSM_W / 64, SSM_W);
#if EXPERTS_IN_ATTN
        if (r_ == 0 && G == 256 && bx >= 128) expert_convert_slice(P, lds, EXP_GLU0 + (bx - 128) * EXP_N_GLU, EXP_GLU0 + (bx - 127) * EXP_N_GLU);
        __syncthreads();
#endif
    }
    GRID_BAR();
    ON(6) { pg::DenseSched S; S.init((const bf16_t*)(P.ws + WS_MA), MA_LD, (const bf16_t*)(P.ws + WS_WP_T), MA_LD, T, D, G, bx);
        pg::EpiMerged E; E.ws = P.ws; pg::gemm_phase(lds, S, E, MA_LD / 64, MA_LD); }
    GRID_BAR();
    ON(7) { pg::DenseSched S; S.init((const bf16_t*)(P.ws + WS_MERGED), D, (const bf16_t*)(P.ws + WS_WOUT_T), D, T, D, G, bx);
        pg::EpiWout E; E.x = P.in[I_X]; E.out = (float*)(P.ws + WS_X1); pg::gemm_phase(lds, S, E, D / 64, D); }
    GRID_BAR();
    ON(8) router_phase(P, lds, vcu, G);
    GRID_BAR();
    pg::moe_build_tab(lds, (const unsigned*)(P.ws + WS_CTL) + CW_CNT);
    ON(9) { pg::MoeSched<1> S; S.init(P.ws, lds, G, bx, P.in[I_B1]); pg::EpiMoe1 E; E.ws = P.ws; E.b1 = P.in[I_B1]; E.lds = lds; E.nostore = (r_ == 1);
#if defined(PROBE_MOE_NT)
        if (r_ == 1) { pg::EpiNull EN; pg::gemm_phase<true>(lds, S, EN, PROBE_MOE_NT, D / 2, 7); } else
#endif
        pg::gemm_phase<true>(lds, S, E, D / 128, D / 2);
#if EXPERTS_IN_ATTN
        if (r_ == 0 && G == 256 && (bx >> 3) >= 16) { const int k_ = (bx & 7) * 16 + (bx >> 3) - 16; expert_convert_slice(P, lds, EXP_M10 + k_ * EXP_N_M1, EXP_M10 + (k_ + 1) * EXP_N_M1); }
        __syncthreads();
#endif
    }
    GRID_BAR();
    ON(10) { pg::MoeSched<2> S; S.init(P.ws, lds, G, bx, P.in[I_B2]);
#if defined(PROBE_FREEZE)
        S.freeze = (r_ == 1);
#endif
 pg::EpiMoe2 E; E.ws = P.ws; E.b2 = P.in[I_B2]; E.lds = lds; E.nostore = (r_ == 1);
#if defined(PROBE_MOE_NT)
        if (r_ == 1) { pg::EpiNull EN; pg::gemm_phase<true>(lds, S, EN, PROBE_MOE_NT, DFF / 2, 7); } else
#endif
        pg::gemm_phase<true>(lds, S, E, DFF / 128, DFF / 2); }
    GRID_BAR();
    ON(11) combine_phase(P, lds, vcu, G);
    }
#undef ON
}

extern "C" void kernel_launch(void* const* d_in, const int* in_sizes, int n_in, void* d_out, int out_size, void* d_ws, size_t ws_size, hipStream_t stream) {
    static int grid = 0;
    if (grid == 0) {
        int dev = 0, cus = 0, per_cu = 0;
        if (hipGetDevice(&dev) != hipSuccess || hipDeviceGetAttribute(&cus, hipDeviceAttributeMultiprocessorCount, dev) != hipSuccess) { fprintf(stderr, "kernel_launch: device query failed\n"); grid = -1; return; }
        if (hipFuncSetAttribute((const void*)mega_fwd, hipFuncAttributeMaxDynamicSharedMemorySize, LDS_BYTES) != hipSuccess) { fprintf(stderr, "kernel_launch: hipFuncSetAttribute failed\n"); grid = -1; return; }
        if (hipOccupancyMaxActiveBlocksPerMultiprocessor(&per_cu, (const void*)mega_fwd, NTHREADS, LDS_BYTES) != hipSuccess || per_cu < 1) { fprintf(stderr, "kernel_launch: occupancy query reports %d workgroups per CU\n", per_cu); per_cu = 1; }
        (void)hipGetLastError();
        grid = cus;
        if (ws_size < WS_END) { fprintf(stderr, "kernel_launch: workspace too small\n"); grid = -1; return; }
    }
    if (grid < 0) return;
    hipMemsetAsync((char*)d_ws + WS_CTL, 0, CTL_ZERO_BYTES, stream);
    Params P{};
    for (int i = 0; i < 30; ++i) P.in[i] = (const float*)d_in[i];
    P.out = (float*)d_out; P.ws = (unsigned char*)d_ws;
    hipLaunchKernelGGL(mega_fwd, dim3(grid), dim3(NTHREADS), LDS_BYTES, stream, P);
#if defined(PROBE_TWO_LAUNCHES)
    hipMemsetAsync((char*)d_ws + WS_CTL, 0, CTL_ZERO_BYTES, stream);
    hipLaunchKernelGGL(mega_fwd, dim3(grid), dim3(NTHREADS), LDS_BYTES, stream, P);
#endif
}
```

```cpp
#include <hip/hip_runtime.h>
#include <hip/hip_bf16.h>
#include <stdint.h>
#include <math.h>
#include <cstdio>

constexpr int D = 1024, BATCH = 8, SEQ = 2048, T = BATCH * SEQ;
constexpr int SSM_W = 512, SSM_H = 16, SSM_G = 32, SSM_P = 64;
constexpr int CH_L = 32, NCH = SEQ / CH_L;
constexpr int ACAT_ROWS = BATCH * NCH;
constexpr int ACAT_LD = CH_L * SSM_H + 2 * SSM_P;
constexpr int AH = 8, AW = 1024;
constexpr int IN_W = 5632;
constexpr int NE = 32, DFF = 1024;
constexpr float EPS = 1e-5f;
constexpr int OFF_U = 0, OFF_Q = 512, OFF_K = 1536, OFF_V = 2560, OFF_GS = 3584, OFF_GA = 4608;
constexpr int CAP = T;
constexpr int MAXBLK = 288;
constexpr float QC2 = 0.125f * 1.4426950408889634f;
constexpr int MA_LD = 1536;

constexpr size_t MiB = 1u << 20;
constexpr size_t WS_CTL = 0, CTL_ZERO_BYTES = 64 * 1024;
constexpr size_t WS_WIN_T = 2 * MiB;
constexpr size_t WS_WGLU_T = 13 * MiB;
constexpr size_t WS_WP_T = 14 * MiB;
constexpr size_t WS_WOUT_T = 17 * MiB;
constexpr size_t WS_WR_T = 19 * MiB;
constexpr size_t WS_KJ = 21 * MiB;
constexpr size_t WS_WS_T = 22 * MiB;
constexpr size_t WS_BT_SSM = 26 * MiB;
constexpr size_t WS_W1_T = 48 * MiB;
constexpr size_t WS_W2_T = 176 * MiB;
constexpr size_t WS_XN = 240 * MiB;
constexpr size_t WS_ACAT = 272 * MiB;
constexpr size_t WS_Q = 292 * MiB, WS_K = 324 * MiB, WS_V = 356 * MiB;
constexpr size_t WS_GS = 388 * MiB, WS_GA = 420 * MiB;
constexpr size_t WS_X1 = 292 * MiB;
constexpr size_t WS_Z = 452 * MiB;
constexpr size_t WS_MA = 468 * MiB;
constexpr size_t WS_MERGED = 516 * MiB;
constexpr size_t WS_H2 = 548 * MiB;
constexpr size_t WS_SLOT_TOK = 582 * MiB;
constexpr size_t WS_SLOT_GATE = 584 * MiB;
constexpr size_t WS_TOK_EP = 586 * MiB;
constexpr size_t WS_ACT = 588 * MiB;
constexpr size_t WS_Y = 732 * MiB;
constexpr size_t WS_END = 876 * MiB;
constexpr int CW_CNT = 64;
constexpr int CW_BAR = 4096;

typedef unsigned short bf16_t;
typedef short bf16x8 __attribute__((ext_vector_type(8)));
typedef float f32x4 __attribute__((ext_vector_type(4)));
typedef float f32x2 __attribute__((ext_vector_type(2)));
typedef unsigned u32x4 __attribute__((ext_vector_type(4)));
typedef unsigned u32x2 __attribute__((ext_vector_type(2)));
#define LAS __attribute__((address_space(3)))
#define GAS __attribute__((address_space(1)))

__device__ __forceinline__ float wave_sum(float v) {
#pragma unroll
    for (int o = 1; o < 64; o <<= 1) v += __shfl_xor(v, o);
    return v;
}
typedef __bf16 bf16x2_hw __attribute__((ext_vector_type(2)));
__device__ __forceinline__ unsigned pk2(float lo, float hi) { const f32x2 v = {lo, hi}; return __builtin_bit_cast(unsigned, __builtin_convertvector(v, bf16x2_hw)); }
__device__ __forceinline__ unsigned f2bf(float f) { return pk2(f, 0.f) & 0xffffu; }
__device__ __forceinline__ float bf2f(unsigned short b) { return __builtin_bit_cast(float, (unsigned)b << 16); }
__device__ __forceinline__ float bflo(unsigned w) { return __builtin_bit_cast(float, w << 16); }
__device__ __forceinline__ float bfhi(unsigned w) { return __builtin_bit_cast(float, w & 0xffff0000u); }
__device__ __forceinline__ float sigmoid_f(float x) { return __builtin_amdgcn_rcpf(1.f + __expf(-x)); }
__device__ __forceinline__ float sigmoid_c(float x) { x = fminf(fmaxf(x, -30.f), 30.f); return __builtin_amdgcn_rcpf(1.f + __expf(-x)); }
__device__ __forceinline__ float gelu_tanh(float x) { const float u = 0.7978845608028654f * (x + 0.044715f * x * x * x); return x * sigmoid_f(2.f * u); }

__device__ __forceinline__ unsigned pk4_fp8(float a, float b, float cc, float d) { int w = 0; w = __builtin_amdgcn_cvt_pk_fp8_f32(a, b, w, false); w = __builtin_amdgcn_cvt_pk_fp8_f32(cc, d, w, true); return (unsigned)w; }
__device__ __forceinline__ void unpk4_fp8(unsigned w, float& a, float& b, float& cc, float& d) { const f32x2 lo = __builtin_amdgcn_cvt_pk_f32_fp8((int)w, false), hi = __builtin_amdgcn_cvt_pk_f32_fp8((int)w, true); a = lo.x; b = lo.y; cc = hi.x; d = hi.y; }
constexpr float W8_SCALE = 64.f;
#ifndef WT_STORES
#define WT_STORES 0
#endif
__device__ __forceinline__ void store16(void* p, const u32x4 v) {
#if WT_STORES
    asm volatile("global_store_dwordx4 %0, %1, off sc1\n\ts_nop 1" :: "v"(p), "v"(v) : "memory");
#else
    *(u32x4*)p = v;
#endif
}
#ifndef NT_STREAMS
#define NT_STREAMS 1
#endif
#if NT_STREAMS
#define NT_LOAD(p) __builtin_nontemporal_load(p)
#define NT_STORE(v, p) __builtin_nontemporal_store((v), (p))
#else
#define NT_LOAD(p) (*(p))
#define NT_STORE(v, p) (*(p) = (v))
#endif
__device__ __forceinline__ int opaque_tid() { int t = threadIdx.x; asm volatile("" : "+v"(t)); return t; }

struct Params {
    const float* in[30];
    float* out;
    unsigned char* ws;
};
enum { I_X = 0, I_G1, I_WIN, I_LRE, I_LIM, I_LOGDT, I_BRE, I_BIM, I_CRE, I_CIM, I_DSK, I_WGLU, I_BGLU, I_QG, I_KG, I_LQ1, I_LK1, I_LQ2, I_LK2, I_SG, I_WPS, I_WPA, I_WOUT, I_G2, I_WR, I_BR, I_W1, I_B1, I_W2, I_B2 };

constexpr int NWAVES = 8, NTHREADS = 512;
constexpr int LDS_BYTES = 147456;
constexpr int RING_BYTES = 131072;
constexpr int MISC_OFF = RING_BYTES + 320;
__device__ __forceinline__ void p0_transpose_item(const float* __restrict__ W, int N, bf16_t* __restrict__ WT, int ldo, int k_off, LAS float* scr, int kb, int nb, int lane) {
    const int k0 = 64 * kb, n0 = 32 * nb;
    { f32x4 v[8];
#pragma unroll
        for (int i = 0; i < 8; ++i) v[i] = NT_LOAD((const f32x4*)(W + (size_t)(k0 + 8 * i + (lane >> 3)) * N + n0 + (lane & 7) * 4));
#pragma unroll
        for (int i = 0; i < 8; ++i) { LAS float* d = scr + (8 * i + (lane >> 3)) * 33 + (lane & 7) * 4; d[0] = v[i].x; d[1] = v[i].y; d[2] = v[i].z; d[3] = v[i].w; } }
    asm volatile("s_waitcnt lgkmcnt(0)" ::: "memory");
    const int c = lane & 7;
#pragma unroll
    for (int j = 0; j < 4; ++j) { const int n = (lane >> 3) + 8 * j; const LAS float* s = scr + (8 * c) * 33 + n;
        u32x4 o; o.x = pk2(s[0 * 33], s[1 * 33]); o.y = pk2(s[2 * 33], s[3 * 33]); o.z = pk2(s[4 * 33], s[5 * 33]); o.w = pk2(s[6 * 33], s[7 * 33]);
        *(u32x4*)(WT + (size_t)(n0 + n) * ldo + k_off + k0 + 8 * c) = o; }
    asm volatile("s_waitcnt lgkmcnt(0)" ::: "memory");
}
__device__ __forceinline__ void p0_transpose_item_fp8(const float* __restrict__ W, int N, unsigned char* __restrict__ WT, int ldo, LAS float* scr, int kb, int nb, int lane) {
    const int k0 = 64 * kb, n0 = 32 * nb;
    { f32x4 v[8];
#pragma unroll
        for (int i = 0; i < 8; ++i) v[i] = NT_LOAD((const f32x4*)(W + (size_t)(k0 + 8 * i + (lane >> 3)) * N + n0 + (lane & 7) * 4));
#pragma unroll
        for (int i = 0; i < 8; ++i) { LAS float* d = scr + (8 * i + (lane >> 3)) * 33 + (lane & 7) * 4; d[0] = v[i].x; d[1] = v[i].y; d[2] = v[i].z; d[3] = v[i].w; } }
    asm volatile("s_waitcnt lgkmcnt(0)" ::: "memory");
    const int n = lane >> 1, half = lane & 1; const LAS float* s = scr + (32 * half) * 33 + n;
    unsigned o[8];
#pragma unroll
    for (int q = 0; q < 8; ++q) o[q] = pk4_fp8(s[(4 * q) * 33] * W8_SCALE, s[(4 * q + 1) * 33] * W8_SCALE, s[(4 * q + 2) * 33] * W8_SCALE, s[(4 * q + 3) * 33] * W8_SCALE);
    u32x4* dst = (u32x4*)(WT + (size_t)(n0 + n) * ldo + k0 + 32 * half);
    dst[0] = (u32x4){o[0], o[1], o[2], o[3]}; dst[1] = (u32x4){o[4], o[5], o[6], o[7]};
    asm volatile("s_waitcnt lgkmcnt(0)" ::: "memory");
}
__device__ __forceinline__ void p0_transpose_f32_item(const float* __restrict__ W, float* __restrict__ WT, int K, LAS float* scr, int kb, int lane) {
    const int k0 = 64 * kb;
#pragma unroll 8
    for (int i = 0; i < 32; ++i) { const int kk = 2 * i + (lane >> 5); scr[kk * 33 + (lane & 31)] = W[(size_t)(k0 + kk) * 32 + (lane & 31)]; }
    asm volatile("s_waitcnt lgkmcnt(0)" ::: "memory");
#pragma unroll 8
    for (int n = 0; n < 32; ++n) WT[(size_t)n * K + k0 + lane] = scr[lane * 33 + n];
    asm volatile("s_waitcnt lgkmcnt(0)" ::: "memory");
}
__device__ __forceinline__ void rms_row_to_bf16(const float* __restrict__ xrow, const float* __restrict__ g, bf16_t* __restrict__ orow, int lane) {
    const f32x4* xr = (const f32x4*)xrow + lane; const f32x4* gr = (const f32x4*)g + lane;
    f32x4 v[4]; float s = 0.f;
#pragma unroll
    for (int j = 0; j < 4; ++j) { v[j] = NT_LOAD(xr + 64 * j); s += (v[j].x * v[j].x + v[j].y * v[j].y) + (v[j].z * v[j].z + v[j].w * v[j].w); }
    const float r = rsqrtf(wave_sum(s) * (1.f / D) + EPS);
    u32x2* o8 = (u32x2*)orow + lane;
#pragma unroll
    for (int j = 0; j < 4; ++j) { const f32x4 gg = gr[64 * j]; u32x2 w; w.x = pk2(v[j].x * r * gg.x, v[j].y * r * gg.y); w.y = pk2(v[j].z * r * gg.z, v[j].w * r * gg.w); o8[64 * j] = w; }
}
struct SsmGP { float lrdt, lidt, cr, ci; };
__device__ __forceinline__ SsmGP ssm_gp(const Params& P, int g, int p) {
    const float dt = expf(P.in[I_LOGDT][g]);
    const float lr = fminf(P.in[I_LRE][g * SSM_P + p], -1e-4f), li = P.in[I_LIM][g * SSM_P + p];
    const float mag = expf(lr * dt);
    float sn, cs; sincosf(li * dt, &sn, &cs);
    const float ar = mag * cs, ai = mag * sn;
    const float den = lr * lr + li * li, nr = ar - 1.f;
    SsmGP r; r.lrdt = lr * dt; r.lidt = li * dt; r.cr = (nr * lr + ai * li) / den; r.ci = (ai * lr - nr * li) / den;
    return r;
}
__device__ __forceinline__ void ssm_pow(const SsmGP& q, int j, float& pr, float& pi) {
    const float m = expf((float)j * q.lrdt); float sn, cs; sincosf((float)j * q.lidt, &sn, &cs); pr = m * cs; pi = m * sn;
}

#ifndef EXP_DMA_AUX
#define EXP_DMA_AUX 2
#endif
struct ExpItem { const float* W; unsigned char* WT; int N, ldo, kb, nb; };
__device__ __forceinline__ ExpItem exp_item(const Params& P, int it) {
    constexpr int I_E1 = (1024 / 128) * (2048 / 32), I_E2 = (1024 / 128) * (1024 / 32);
    ExpItem x;
    if (it < NE * I_E1) { const int e = it / I_E1, q = it % I_E1; x.W = P.in[I_W1] + (size_t)e * D * 2 * DFF; x.WT = P.ws + WS_W1_T + (size_t)e * 2 * DFF * D; x.N = 2 * DFF; x.ldo = D; x.kb = q / 64; x.nb = q % 64; }
    else { const int r = it - NE * I_E1, e = r / I_E2, q = r % I_E2; x.W = P.in[I_W2] + (size_t)e * DFF * D; x.WT = P.ws + WS_W2_T + (size_t)e * D * DFF; x.N = D; x.ldo = DFF; x.kb = q / 32; x.nb = q % 32; }
    return x;
}
__device__ __forceinline__ void exp_dma(const ExpItem& x, int lane, LAS unsigned char* buf) {
    const float* src = x.W + (size_t)(128 * x.kb + (lane >> 3)) * x.N + 32 * x.nb;
#pragma unroll
    for (int i = 0; i < 16; ++i) __builtin_amdgcn_global_load_lds((const unsigned*)(src + (size_t)(8 * i) * x.N + ((((lane & 7) ^ (lane >> 3) ^ (i >> 1)) & 7) << 2)), (LAS unsigned*)(buf + i * 1024), 16, 0, EXP_DMA_AUX);
}
#if defined(PROBE_CONV_NOSTORE)
#define g_conv_nostore nostore_
__device__ __forceinline__ void exp_finish_lds(const ExpItem& x, int lane, const LAS unsigned char* buf, bool nostore_ = false) {
#else
__device__ __forceinline__ void exp_finish_lds(const ExpItem& x, int lane, const LAS unsigned char* buf) {
#endif
    const int c = lane & 7;
#pragma unroll
    for (int pass = 0; pass < 4; ++pass) {
        const int n = 8 * pass + (lane >> 3), q0 = (n >> 2) ^ c;
        const LAS unsigned char* rb = buf + c * 2048 + ((n & 3) << 2);
        float f[16];
#pragma unroll
        for (int j = 0; j < 16; ++j) f[j] = *(const LAS float*)(rb + j * 128 + (((q0 ^ j) & 7) << 4)) * W8_SCALE;
        const u32x4 o = (u32x4){pk4_fp8(f[0], f[1], f[2], f[3]), pk4_fp8(f[4], f[5], f[6], f[7]), pk4_fp8(f[8], f[9], f[10], f[11]), pk4_fp8(f[12], f[13], f[14], f[15])};
#if defined(PROBE_CONV_NOSTORE)
        if (g_conv_nostore) { asm volatile("" :: "v"(o)); } else
#endif
#if NT_STREAMS && !defined(CONV_ST_DEFAULT)
        __builtin_nontemporal_store(o, (u32x4*)(x.WT + (size_t)(32 * x.nb + n) * x.ldo + 128 * x.kb + 16 * c));
#else
        *(u32x4*)(x.WT + (size_t)(32 * x.nb + n) * x.ldo + 128 * x.kb + 16 * c) = o;
#endif
    }
    asm volatile("s_waitcnt lgkmcnt(0)" ::: "memory");
}
constexpr int EXP_ITEMS = NE * ((1024 / 128) * (2048 / 32) + (1024 / 128) * (1024 / 32));
constexpr int EXP_N_IN = 32, EXP_N_S2 = 20, EXP_N_GLU = 20, EXP_N_M1 = 0;
constexpr int EXP_IN0 = 0, EXP_S20 = 128 * EXP_N_IN, EXP_GLU0 = EXP_S20 + 128 * EXP_N_S2, EXP_ATT0 = EXP_GLU0 + 128 * EXP_N_GLU, EXP_M10 = EXP_ITEMS - 128 * EXP_N_M1;
static_assert((EXP_M10 - EXP_ATT0) % 256 == 0 && EXP_M10 >= NE * (1024 / 128) * (2048 / 32), "item split (the expert-GEMM-1 tail share must be W2 items only)");
__device__ __forceinline__ void expert_convert_slice(const Params& P, LAS unsigned char* lds, int i0, int i1, bool probe_nostore = false) {
    const int tid = opaque_tid(), lane = tid & 63, wave = __builtin_amdgcn_readfirstlane(tid >> 6);
    LAS unsigned char* b0 = lds + wave * 16384;
    for (int it = i0 + wave; it < i1; it += NWAVES) {
        const ExpItem c0 = exp_item(P, it);
        exp_dma(c0, lane, b0);
        asm volatile("s_waitcnt vmcnt(0)" ::: "memory");
#if defined(PROBE_CONV_NOSTORE)
        exp_finish_lds(c0, lane, b0, probe_nostore);
#else
        exp_finish_lds(c0, lane, b0);
#endif
    }
}
__device__ __forceinline__ void p0_prologue(const Params& P, LAS unsigned char* lds, int vcu, int G) {
    const int tid = opaque_tid(), lane = tid & 63, wave = __builtin_amdgcn_readfirstlane(tid >> 6);
    LAS float* scr = (LAS float*)(lds + wave * 16384);
    unsigned char* ws = P.ws;
    const int gw = vcu * NWAVES + wave, NGW = G * NWAVES;
    constexpr int I_IN = (D / 64) * (IN_W / 32);
    constexpr int I_GLU = (512 / 64) * (512 / 32);
    constexpr int I_PS = (512 / 64) * (1024 / 32);
    constexpr int I_PA = (1024 / 64) * (1024 / 32);
    constexpr int I_OUT = I_PA;
    constexpr int I_R = 1024 / 64;
    constexpr int I_E1 = (1024 / 64) * (2048 / 32);
    constexpr int I_E2 = (1024 / 64) * (1024 / 32);
#ifndef EXPERTS_IN_ATTN
#define EXPERTS_IN_ATTN 1
#endif
    constexpr int NITEMS = I_IN + I_GLU + I_PS + I_PA + I_OUT + I_R + (EXPERTS_IN_ATTN ? 0 : NE * I_E1 + NE * I_E2);
    for (int it = gw; it < NITEMS; it += NGW) {
        int r = it;
        if (r < I_IN) { const int nblk = IN_W / 32; p0_transpose_item(P.in[I_WIN], IN_W, (bf16_t*)(ws + WS_WIN_T), D, 0, scr, r / nblk, r % nblk, lane); continue; } r -= I_IN;
        if (r < I_GLU) { const int nblk = 512 / 32; p0_transpose_item(P.in[I_WGLU], 512, (bf16_t*)(ws + WS_WGLU_T), 512, 0, scr, r / nblk, r % nblk, lane); continue; } r -= I_GLU;
        if (r < I_PS) { const int nblk = 1024 / 32; p0_transpose_item(P.in[I_WPS], 1024, (bf16_t*)(ws + WS_WP_T), MA_LD, 1024, scr, r / nblk, r % nblk, lane); continue; } r -= I_PS;
        if (r < I_PA) { const int nblk = 1024 / 32; p0_transpose_item(P.in[I_WPA], 1024, (bf16_t*)(ws + WS_WP_T), MA_LD, 0, scr, r / nblk, r % nblk, lane); continue; } r -= I_PA;
        if (r < I_OUT) { const int nblk = 1024 / 32; p0_transpose_item(P.in[I_WOUT], 1024, (bf16_t*)(ws + WS_WOUT_T), D, 0, scr, r / nblk, r % nblk, lane); continue; } r -= I_OUT;
        if (r < I_R) { p0_transpose_f32_item(P.in[I_WR], (float*)(ws + WS_WR_T), D, scr, r, lane); continue; } r -= I_R;
        if (EXPERTS_IN_ATTN) continue;
        if (r < NE * I_E1) { const int e = r / I_E1, q = r % I_E1, nblk = 2048 / 32;
            p0_transpose_item_fp8(P.in[I_W1] + (size_t)e * D * 2 * DFF, 2 * DFF, ws + WS_W1_T + (size_t)e * 2 * DFF * D, D, scr, q / nblk, q % nblk, lane); continue; } r -= NE * I_E1;
        { const int e = r / I_E2, q = r % I_E2, nblk = 1024 / 32;
            p0_transpose_item_fp8(P.in[I_W2] + (size_t)e * DFF * D, D, ws + WS_W2_T + (size_t)e * D * DFF, DFF, scr, q / nblk, q % nblk, lane); }
    }
#if EXPERTS_IN_ATTN
    if (G != 256) { __syncthreads(); for (int c0 = vcu * 64; c0 < EXP_ATT0; c0 += G * 64) expert_convert_slice(P, lds, c0, min(EXP_ATT0, c0 + 64));
        for (int c0 = EXP_M10 + vcu * 64; c0 < EXP_ITEMS; c0 += G * 64) expert_convert_slice(P, lds, c0, min(EXP_ITEMS, c0 + 64)); __syncthreads(); }
#endif
    for (int m = gw; m < T; m += NGW) rms_row_to_bf16(P.in[I_X] + (size_t)m * D, P.in[I_G1], (bf16_t*)(ws + WS_XN) + (size_t)m * D, lane);
    if (gw == 0) { u32x4* z = (u32x4*)(ws + WS_H2 + (size_t)T * D); z[lane] = (u32x4){0u, 0u, 0u, 0u}; }
    const int gt = vcu * NTHREADS + tid, NGT = G * NTHREADS;
    for (int it = gw; it < SSM_G * CH_L; it += NGW) {
        const int g = it / CH_L, j = it % CH_L, h = lane >> 2, hq = (lane & 3) * 4;
        { const SsmGP q = ssm_gp(P, g, lane); float pr, pi; ssm_pow(q, j, pr, pi); scr[2 * lane] = pr * q.cr - pi * q.ci; scr[2 * lane + 1] = pr * q.ci + pi * q.cr; }
        asm volatile("s_waitcnt lgkmcnt(0)" ::: "memory");
        float a0 = 0.f, a1 = 0.f, a2 = 0.f, a3 = 0.f;
#pragma unroll 4
        for (int p = 0; p < SSM_P; ++p) {
            const float wr = scr[2 * p], wi = scr[2 * p + 1];
            const float cre = P.in[I_CRE][(g * SSM_H + h) * SSM_P + p], cim = P.in[I_CIM][(g * SSM_H + h) * SSM_P + p];
            const float mr = cre * wr - cim * wi, mi = cre * wi + cim * wr;
            const f32x4 br = *(const f32x4*)(P.in[I_BRE] + (g * SSM_P + p) * SSM_H + hq), bi = *(const f32x4*)(P.in[I_BIM] + (g * SSM_P + p) * SSM_H + hq);
            a0 += mr * br.x - mi * bi.x; a1 += mr * br.y - mi * bi.y; a2 += mr * br.z - mi * bi.z; a3 += mr * br.w - mi * bi.w;
        }
        if (j == 0) { const float dsk = P.in[I_DSK][g * SSM_H + h]; if (hq == (h & 12)) { const int w = h & 3; if (w == 0) a0 += dsk; else if (w == 1) a1 += dsk; else if (w == 2) a2 += dsk; else a3 += dsk; } }
        *(f32x4*)((float*)(ws + WS_KJ) + ((size_t)(g * CH_L + j) * SSM_H + h) * SSM_H + hq) = (f32x4){a0, a1, a2, a3};
        asm volatile("s_waitcnt lgkmcnt(0)" ::: "memory");
    }
    for (int it = gt; it < SSM_G * 128 * CH_L; it += NGT) {
        const int s = it % CH_L, n = (it / CH_L) % 128, g = it / (CH_L * 128), p = n & 63, part = n >> 6;
        const SsmGP q = ssm_gp(P, g, p); float pr, pi; ssm_pow(q, CH_L - 1 - s, pr, pi);
        const float wr = pr * q.cr - pi * q.ci, wi = pr * q.ci + pi * q.cr;
        const float* br = P.in[I_BRE] + (g * SSM_P + p) * SSM_H; const float* bi = P.in[I_BIM] + (g * SSM_P + p) * SSM_H;
        unsigned o[8];
#pragma unroll
        for (int h2 = 0; h2 < 8; ++h2) {
            float v0, v1;
            if (part == 0) { v0 = wr * br[2 * h2] - wi * bi[2 * h2]; v1 = wr * br[2 * h2 + 1] - wi * bi[2 * h2 + 1]; }
            else { v0 = wr * bi[2 * h2] + wi * br[2 * h2]; v1 = wr * bi[2 * h2 + 1] + wi * br[2 * h2 + 1]; }
            o[h2] = pk2(v0, v1);
        }
        u32x4* dst = (u32x4*)((bf16_t*)(ws + WS_WS_T) + ((size_t)(g * 128 + n) * 512 + s * 16));
        dst[0] = (u32x4){o[0], o[1], o[2], o[3]}; dst[1] = (u32x4){o[4], o[5], o[6], o[7]};
    }
    for (int it = gt; it < SSM_G * CH_L * SSM_P; it += NGT) {
        const int p = it % SSM_P, t = (it / SSM_P) % CH_L, g = it / (SSM_P * CH_L);
        const SsmGP q = ssm_gp(P, g, p); float pr, pi; ssm_pow(q, t + 1, pr, pi);
        bf16_t* base = (bf16_t*)(ws + WS_BT_SSM) + ((size_t)(g * 512 + t * 16)) * ACAT_LD + 512 + p;
#pragma unroll 4
        for (int h = 0; h < SSM_H; ++h) {
            const float cre = P.in[I_CRE][(g * SSM_H + h) * SSM_P + p], cim = P.in[I_CIM][(g * SSM_H + h) * SSM_P + p];
            base[(size_t)h * ACAT_LD] = (bf16_t)f2bf(cre * pr - cim * pi);
            base[(size_t)h * ACAT_LD + 64] = (bf16_t)f2bf(-(cre * pi + cim * pr));
        }
    }
}
__device__ __forceinline__ void ssm_toeplitz_expand(const Params& P, int vcu, int G) {
    const int gt = vcu * NTHREADS + opaque_tid(), NGT = G * NTHREADS;
    unsigned char* ws = P.ws;
    for (int it = gt; it < SSM_G * 512 * 64; it += NGT) {
        const int kc = it & 63, n = (it >> 6) & 511, g = it >> 15;
        const int s = kc >> 1, hq = (kc & 1) * 8, t = n >> 4, h = n & 15;
        u32x4 o = (u32x4){0u, 0u, 0u, 0u};
        if (s <= t) { const float* kj = (const float*)(ws + WS_KJ) + ((size_t)(g * CH_L + (t - s)) * SSM_H + h) * SSM_H + hq;
            const f32x4 a = *(const f32x4*)kj, b = *(const f32x4*)(kj + 4);
            o.x = pk2(a.x, a.y); o.y = pk2(a.z, a.w); o.z = pk2(b.x, b.y); o.w = pk2(b.z, b.w); }
        *(u32x4*)((bf16_t*)(ws + WS_BT_SSM) + ((size_t)(g * 512 + n)) * ACAT_LD + kc * 8) = o;
    }
}
#ifndef PG_WGM
#define PG_WGM 8
#endif
namespace pg {
constexpr int BM = 256, BK = 64, HALF = 128, HTB = HALF * BK * 2, STAGE_BYTES = 8 * HTB;
__host__ __device__ __forceinline__ int lds_byte(int r, int c) { const int st = (r >> 4) * 2 + (c >> 5), rr = r & 15, cc = c & 31, ob = rr * 64 + cc * 2; return st * 1024 + (ob ^ (((ob >> 9) & 1) << 5)); }
__host__ __device__ __forceinline__ void stage_rc(int b, int& R, int& C) { const int st = b / 1024, sb = b % 1024, swz = sb ^ (((sb >> 9) & 1) << 5); R = (st >> 1) * 16 + swz / 64; C = (st & 1) * 32 + (swz % 64) / 2; }
__host__ __device__ __forceinline__ int perm32(int rho) { const int n = rho >> 4, i = rho & 15; return 8 * (i >> 2) + 4 * n + (i & 3); }

struct Unit {
    const char* A;
    const char* B;
    unsigned aoff[2][2];
    int pm, pn, aux, aux2;
    int ord;
};
struct EpiInfo { int pm, pn, aux, aux2, ord; };
typedef f32x4 Acc[2][2][4][2];

typedef int v8i_t __attribute__((ext_vector_type(8)));
typedef int v4i_t __attribute__((ext_vector_type(4)));
template <bool FP8 = false, int BAUX = 0  , class Sched, class Epi>
__device__ __forceinline__ void gemm_phase(LAS unsigned char* lds, const Sched& S, const Epi& E, const int nt, const int ldb, const int ktm = -1  ) {
    const int tid = opaque_tid(), wid = __builtin_amdgcn_readfirstlane(tid >> 6), lane = tid & 63, wr = wid >> 2, wc = wid & 3, fr = lane & 15, fq = lane >> 4;
    unsigned voffB[2];
#pragma unroll
    for (int i = 0; i < 2; ++i) { int R, C; stage_rc(tid * 16 + i * 8192, R, C); voffB[i] = (unsigned)((64 * (R >> 5) + perm32(R & 31)) * ldb + C) * 2u; }
    const unsigned hB = (unsigned)(32 * ldb * 2);
    const unsigned ldsw = (unsigned)wid * 1024u;
    const int aoffl = lds_byte(wr * 64 + fr, fq * 8), boffl = lds_byte(wc * 32 + fr, fq * 8);
#define PG_SA(b, h) (((b) * 2 + (h)) * pg::HTB)
#define PG_SB(b, h) ((4 + (b) * 2 + (h)) * pg::HTB)
#define PG_GLDS(gp, bufoff, i) __builtin_amdgcn_global_load_lds((const unsigned*)(gp), (LAS unsigned*)(lds + (bufoff) + ldsw + (i) * 8192), 16, 0, 0)
#define PG_STAGE_A(bufoff, Ab, o0, o1, kt) do { const char* _b = (Ab) + (size_t)((kt) & ktm) * 128; PG_GLDS(_b + (o0), bufoff, 0); PG_GLDS(_b + (o1), bufoff, 1); } while (0)
#define PG_GLDSB(gp, bufoff, i) __builtin_amdgcn_global_load_lds((const unsigned*)(gp), (LAS unsigned*)(lds + (bufoff) + ldsw + (i) * 8192), 16, 0, BAUX)
#define PG_STAGE_B(bufoff, Bb, h, kt) do { const char* _b = (Bb) + (size_t)((kt) & ktm) * 128 + (h) * hB; PG_GLDSB(_b + voffB[0], bufoff, 0); PG_GLDSB(_b + voffB[1], bufoff, 1); } while (0)
#define PG_LDA(dst, b, h) do { _Pragma("unroll") for (int m = 0; m < 4; ++m) _Pragma("unroll") for (int k = 0; k < 2; ++k) dst[m][k] = *(const LAS bf16x8*)(lds + PG_SA(b, h) + aoffl + m * 2048 + k * 1024); } while (0)
#define PG_LDB(dst, b, h) do { _Pragma("unroll") for (int n = 0; n < 2; ++n) _Pragma("unroll") for (int k = 0; k < 2; ++k) dst[n][k] = *(const LAS bf16x8*)(lds + PG_SB(b, h) + boffl + n * 2048 + k * 1024); } while (0)
#define PG_CAT8(lo, hi) __builtin_shufflevector(__builtin_bit_cast(v4i_t, lo), __builtin_bit_cast(v4i_t, hi), 0, 1, 2, 3, 4, 5, 6, 7)
#define PG_MMA(ai, bj, At, Bt) do { __builtin_amdgcn_s_setprio(1); if constexpr (FP8) { _Pragma("unroll") for (int m = 0; m < 4; ++m) _Pragma("unroll") for (int n = 0; n < 2; ++n) \
            acc[ai][bj][m][n] = __builtin_amdgcn_mfma_scale_f32_16x16x128_f8f6f4(PG_CAT8(Bt[n][0], Bt[n][1]), PG_CAT8(At[m][0], At[m][1]), acc[ai][bj][m][n], 0, 0, 0, 0x79797979, 0, 0x7f7f7f7f); } \
        else { _Pragma("unroll") for (int m = 0; m < 4; ++m) _Pragma("unroll") for (int n = 0; n < 2; ++n) _Pragma("unroll") for (int k = 0; k < 2; ++k) \
        acc[ai][bj][m][n] = __builtin_amdgcn_mfma_f32_16x16x32_bf16(Bt[n][k], At[m][k], acc[ai][bj][m][n], 0, 0, 0); } __builtin_amdgcn_s_setprio(0); } while (0)
#define PG_WAIT_V(n) asm volatile("s_waitcnt vmcnt(" #n ")" ::: "memory")
#define PG_WAIT_L(n) asm volatile("s_waitcnt lgkmcnt(" #n ")" ::: "memory")
#define PG_BAR __builtin_amdgcn_s_barrier()
#define PG_SCHED __builtin_amdgcn_sched_barrier(0)
#define PG_KLOOP(T0, T1) _Pragma("clang loop unroll(disable)") for (int t = (T0); t < (T1); t += 2) { \
            const bool last = (t == nt - 2); \
            PG_LDB(B0, 0, 0); PG_LDB(B1, 0, 1); PG_SCHED; PG_LDA(At, 0, 0); PG_STAGE_A(PG_SA(1, 1), st.A, st.aoff[1][0], st.aoff[1][1], t + 1); \
            if (last) { Unit nu_; has_next = S.next(ui + 1, nu_); if (has_next) { st = nu_; } } \
            const int k2 = last ? 0 : t + 2, k3 = k2 + 1; \
            PG_WAIT_V(8); PG_WAIT_L(0); PG_BAR; PG_MMA(0, 0, At, B0); PG_MMA(0, 1, At, B1); PG_BAR; PG_SCHED; \
            PG_LDA(At, 0, 1); PG_STAGE_B(PG_SB(0, 0), st.B, 0, k2); PG_STAGE_B(PG_SB(0, 1), st.B, 1, k2); PG_STAGE_A(PG_SA(0, 0), st.A, st.aoff[0][0], st.aoff[0][1], k2); \
            PG_WAIT_V(8); PG_WAIT_L(0); PG_BAR; PG_MMA(1, 0, At, B0); PG_MMA(1, 1, At, B1); PG_BAR; PG_SCHED; \
            PG_LDB(B0, 1, 0); PG_LDB(B1, 1, 1); PG_SCHED; PG_LDA(At, 1, 0); PG_STAGE_A(PG_SA(0, 1), st.A, st.aoff[1][0], st.aoff[1][1], k2); \
            PG_WAIT_V(8); PG_WAIT_L(0); PG_BAR; PG_MMA(0, 0, At, B0); PG_MMA(0, 1, At, B1); PG_BAR; PG_SCHED; \
            PG_LDA(At, 1, 1); PG_STAGE_B(PG_SB(1, 0), st.B, 0, k3); PG_STAGE_B(PG_SB(1, 1), st.B, 1, k3); PG_STAGE_A(PG_SA(1, 0), st.A, st.aoff[0][0], st.aoff[0][1], k3); \
            PG_WAIT_V(8); PG_WAIT_L(0); PG_BAR; PG_MMA(1, 0, At, B0); PG_MMA(1, 1, At, B1); PG_BAR; PG_SCHED; \
        }
    Unit st; int ui = 0;
    if (!S.next(0, st)) return;
    EpiInfo cur; cur.pm = st.pm; cur.pn = st.pn; cur.aux = st.aux; cur.aux2 = st.aux2; cur.ord = st.ord;
    Acc acc;
#pragma unroll
    for (int a = 0; a < 2; ++a)
#pragma unroll
        for (int b = 0; b < 2; ++b)
#pragma unroll
            for (int m = 0; m < 4; ++m)
#pragma unroll
                for (int n = 0; n < 2; ++n) acc[a][b][m][n] = (f32x4){0.f, 0.f, 0.f, 0.f};
    bf16x8 At[4][2], B0[2][2], B1[2][2];
    PG_STAGE_B(PG_SB(0, 0), st.B, 0, 0); PG_STAGE_B(PG_SB(0, 1), st.B, 1, 0); PG_STAGE_A(PG_SA(0, 0), st.A, st.aoff[0][0], st.aoff[0][1], 0); PG_STAGE_A(PG_SA(0, 1), st.A, st.aoff[1][0], st.aoff[1][1], 0);
    if (wr == 1) PG_BAR;
    PG_WAIT_V(2); PG_BAR;
    PG_STAGE_B(PG_SB(1, 0), st.B, 0, 1); PG_STAGE_A(PG_SA(1, 0), st.A, st.aoff[0][0], st.aoff[0][1], 1); PG_STAGE_B(PG_SB(1, 1), st.B, 1, 1);
    PG_WAIT_V(6); PG_BAR;
    for (;;) {
        bool has_next = false;
        if constexpr (Epi::HAS_MID) { PG_KLOOP(0, Epi::MID_T) E.mid(acc, cur, wr, wc, fr, fq); PG_KLOOP(Epi::MID_T, nt) } else { PG_KLOOP(0, nt) }
        if (wr == 0) PG_BAR;
        E(acc, cur, wr, wc, fr, fq);
        if (!has_next) break;
#pragma unroll
        for (int a = 0; a < 2; ++a)
#pragma unroll
            for (int b = 0; b < 2; ++b)
#pragma unroll
                for (int m = 0; m < 4; ++m)
#pragma unroll
                    for (int n = 0; n < 2; ++n) acc[a][b][m][n] = (f32x4){0.f, 0.f, 0.f, 0.f};
        cur.pm = st.pm; cur.pn = st.pn; cur.aux = st.aux; cur.aux2 = st.aux2; cur.ord = st.ord; ++ui;
        if (wr == 1) PG_BAR;
    }
    PG_WAIT_V(0);
    PG_BAR;
#undef PG_SA
#undef PG_SB
#undef PG_GLDS
#undef PG_GLDSB
#undef PG_STAGE_A
#undef PG_STAGE_B
#undef PG_LDA
#undef PG_LDB
#undef PG_MMA
#undef PG_WAIT_V
#undef PG_WAIT_L
#undef PG_BAR
#undef PG_SCHED
#undef PG_KLOOP
}

struct LaneRC { int R[2], C[2]; __device__ __forceinline__ LaneRC() { const int t = opaque_tid(); stage_rc(t * 16, R[0], C[0]); stage_rc(t * 16 + 8192, R[1], C[1]); } };

struct DenseSched {
    const bf16_t* A; const bf16_t* Bt; int lda, ldb, nM, nN, nwg, G, c;
    __device__ __forceinline__ void init(const bf16_t* A_, int lda_, const bf16_t* Bt_, int ldb_, int M, int N, int G_, int c_) { A = A_; Bt = Bt_; lda = lda_; ldb = ldb_; nM = M / BM; nN = N / BM; nwg = nM * nN; G = G_; c = c_; }
    __device__ __forceinline__ bool next(int i, Unit& u) const {
        const long L = (long)i * G + c; if (L >= nwg) return false;
        int wgid = (int)L; { const int q = nwg / 8, r = nwg % 8, xcd = wgid % 8, off = wgid / 8; wgid = (xcd < r ? xcd * (q + 1) : r * (q + 1) + (xcd - r) * q) + off; }
        const int WGM = PG_WGM, nig = WGM * nN, gid = wgid / nig, fm = gid * WGM, gsz = (nM - fm) < WGM ? (nM - fm) : WGM;
        u.pm = fm + ((wgid % nig) % gsz); u.pn = (wgid % nig) / gsz; u.aux = 0; u.aux2 = 0; u.ord = i;
        u.A = (const char*)A; u.B = (const char*)(Bt + (size_t)u.pn * BM * ldb); const LaneRC rc;
#pragma unroll
        for (int h = 0; h < 2; ++h)
#pragma unroll
            for (int j = 0; j < 2; ++j) u.aoff[h][j] = (unsigned)(((u.pm * BM + 128 * h + rc.R[j]) * lda + rc.C[j]) * 2);
        return true;
    }
};
}
namespace pg {
constexpr int TAB_OFF = RING_BYTES + 1024;
__device__ __forceinline__ void moe_build_tab(LAS unsigned char* lds, const unsigned* cnt) {
    LAS int* tab = (LAS int*)(lds + TAB_OFF);
    if (threadIdx.x == 0) { int acc = 0; for (int e = 0; e < NE; ++e) { const int n = (int)__hip_atomic_load(cnt + e, __ATOMIC_RELAXED, __HIP_MEMORY_SCOPE_AGENT); tab[e] = acc; tab[40 + e] = n; acc += (n + 255) >> 8; } tab[NE] = acc; }
    __syncthreads();
}
#ifndef MOE_MAXU_OVERRIDE
#define MOE_MAXU_OVERRIDE 9
#endif
constexpr int MOE_MAXU = MOE_MAXU_OVERRIDE;
constexpr int UT_OFF = RING_BYTES + 1536;
constexpr int UB_OFF = UT_OFF + MOE_MAXU * 512;
static_assert(UB_OFF + MOE_MAXU * 1024 <= LDS_BYTES, "LDS map");
template <int KIND>
struct MoeSched {
    static constexpr int NPN = KIND == 1 ? 8 : 4;
    unsigned char* ws; const LAS int* tab; LAS unsigned char* lds; int G, c; bool freeze = false;
    __device__ __forceinline__ bool unit(int i, int& e, int& rb, int& pn) const {
        const int x = c & 7, j = c >> 3, NJ = G >> 3;
        int L = i * NJ + j; e = -1; rb = 0; pn = 0;
#pragma unroll
        for (int q = 0; q < NE / 8; ++q) { const int eq = x + 8 * q, uq = (tab[eq + 1] - tab[eq]) * NPN;
            if (e < 0) { if (L < uq) { e = eq; rb = L / NPN; pn = L % NPN; } else L -= uq; } }
        if (e < 0) return false;
        e = __builtin_amdgcn_readfirstlane(e); rb = __builtin_amdgcn_readfirstlane(rb); pn = __builtin_amdgcn_readfirstlane(pn);
        return true;
    }
    __device__ __forceinline__ void init(unsigned char* ws_, LAS unsigned char* lds_, int G_, int c_, const float* bias) {
        ws = ws_; lds = lds_; tab = (const LAS int*)(lds_ + TAB_OFF); G = G_; c = c_;
        const int tid = opaque_tid();
        for (int i = 0; i < MOE_MAXU; ++i) { int e, rb, pn; if (!unit(i, e, rb, pn)) break;
            if (tid < 256) { if (KIND == 1) { const int nvalid = min(256, tab[40 + e] - rb * 256); const int tok = tid < nvalid ? ((const int*)(ws + WS_SLOT_TOK))[(size_t)e * CAP + rb * 256 + tid] : T;
                    ((LAS unsigned short*)(lds + UT_OFF))[i * 256 + tid] = (unsigned short)tok; } }
            else ((LAS float*)(lds + UB_OFF))[i * 256 + tid - 256] = bias[(size_t)e * (NPN * 256) + pn * 256 + tid - 256]; }
        __syncthreads();
    }
    __device__ __forceinline__ bool next(int i, Unit& u) const {
        int e, rb, pn; if (!unit(i, e, rb, pn)) return false;
#if defined(PROBE_FREEZE)
        if (freeze) { int e0, r0, p0; unit(0, e0, r0, p0); e = e0; rb = r0; pn = p0; }
#endif
        const int blk = tab[e] + rb, nvalid = min(256, tab[40 + e] - rb * 256);
        u.pm = rb; u.pn = pn; u.aux = e; u.ord = i; const LaneRC rc;
        if (KIND == 1) {
            u.aux2 = blk; u.A = (const char*)(ws + WS_H2); u.B = (const char*)(ws + WS_W1_T + ((size_t)e * 2 * DFF + (size_t)pn * BM) * D);
#pragma unroll
            for (int h = 0; h < 2; ++h)
#pragma unroll
                for (int jj = 0; jj < 2; ++jj) { const int r = 128 * h + rc.R[jj]; int tok;
                    if (i < MOE_MAXU) tok = ((const LAS unsigned short*)(lds + UT_OFF))[i * 256 + r];
                    else { tok = r < nvalid ? ((const int*)(ws + WS_SLOT_TOK))[(size_t)e * CAP + rb * 256 + r] : T; __builtin_amdgcn_s_waitcnt(0x0F70); }
                    u.aoff[h][jj] = (unsigned)(tok * D + rc.C[jj] * 2); }
        } else {
            u.aux2 = blk | (nvalid << 16); u.A = (const char*)(ws + WS_ACT); u.B = (const char*)(ws + WS_W2_T + ((size_t)e * D + (size_t)pn * BM) * DFF);
#pragma unroll
            for (int h = 0; h < 2; ++h)
#pragma unroll
                for (int jj = 0; jj < 2; ++jj) u.aoff[h][jj] = (unsigned)((blk * 256 + 128 * h + rc.R[jj]) * DFF + rc.C[jj] * 2);
        }
        return true;
    }
};
}
namespace pg {
struct EpiBase { static constexpr bool HAS_MID = false; static constexpr int MID_T = -1; __device__ __forceinline__ void mid(Acc&, const EpiInfo&, int, int, int, int) const {} };
__device__ __forceinline__ u32x4 pack8(const f32x4 a, const f32x4 b) { u32x4 w; w.x = pk2(a[0], a[1]); w.y = pk2(a[2], a[3]); w.z = pk2(b[0], b[1]); w.w = pk2(b[2], b[3]); return w; }
__device__ __forceinline__ void unpack8(const u32x4 w, f32x4& a, f32x4& b) { a = (f32x4){bflo(w.x), bfhi(w.x), bflo(w.y), bfhi(w.y)}; b = (f32x4){bflo(w.z), bfhi(w.z), bflo(w.w), bfhi(w.w)}; }

struct EpiNull : EpiBase {
    __device__ __forceinline__ void operator()(Acc& acc, const EpiInfo&, int, int, int, int) const {
#pragma unroll
        for (int a = 0; a < 2; ++a)
#pragma unroll
            for (int b = 0; b < 2; ++b)
#pragma unroll
                for (int m = 0; m < 4; ++m)
#pragma unroll
                    for (int n = 0; n < 2; ++n) asm volatile("" :: "v"(acc[a][b][m][n]));
    }
};
struct EpiInProj : EpiBase {
    unsigned char* ws; const float* qg; const float* kg;
    __device__ __forceinline__ void operator()(Acc& acc, const EpiInfo& u, int wr, int wc, int fr, int fq) const {
        const int pn = u.pn, row0 = u.pm * BM + wr * 64 + fr, colw = 64 * wc + 8 * fq;
        if (pn < 2) {
            bf16_t* acat = (bf16_t*)(ws + WS_ACAT);
#pragma unroll
            for (int ai = 0; ai < 2; ++ai)
#pragma unroll
                for (int m = 0; m < 4; ++m) { const int tok = row0 + ai * 128 + m * 16;
#pragma unroll
                    for (int bj = 0; bj < 2; ++bj) { const int cu = pn * 256 + colw + 32 * bj, g = cu >> 4, h0 = cu & 15;
                        *(u32x4*)(acat + ((size_t)(g * ACAT_ROWS + (tok >> 5))) * ACAT_LD + (tok & 31) * 16 + h0) = pack8(acc[ai][bj][m][0], acc[ai][bj][m][1]); } }
        } else if (pn < 10) {
            const bool isq = pn < 6; const float* gain = isq ? qg : kg; const float sc = isq ? QC2 : 1.f;
            bf16_t* dst = (bf16_t*)(ws + (isq ? WS_Q : WS_K)) + (size_t)(pn - (isq ? 2 : 6)) * 256 + colw;
            f32x4 gv[2][2];
#pragma unroll
            for (int bj = 0; bj < 2; ++bj)
#pragma unroll
                for (int n = 0; n < 2; ++n) gv[bj][n] = *(const f32x4*)(gain + 32 * bj + 8 * fq + 4 * n);
#pragma unroll
            for (int ai = 0; ai < 2; ++ai)
#pragma unroll
                for (int m = 0; m < 4; ++m) { const int tok = row0 + ai * 128 + m * 16; float ss = 0.f;
#pragma unroll
                    for (int bj = 0; bj < 2; ++bj)
#pragma unroll
                        for (int n = 0; n < 2; ++n) { const f32x4 v = acc[ai][bj][m][n]; ss += (v[0] * v[0] + v[1] * v[1]) + (v[2] * v[2] + v[3] * v[3]); }
                    ss += __shfl_xor(ss, 16); ss += __shfl_xor(ss, 32);
                    const float r = rsqrtf(ss * (1.f / 64.f) + EPS) * sc;
#pragma unroll
                    for (int bj = 0; bj < 2; ++bj) store16(dst + (size_t)tok * D + 32 * bj, pack8(acc[ai][bj][m][0] * r * gv[bj][0], acc[ai][bj][m][1] * r * gv[bj][1])); }
        } else {
            const size_t base = pn < 14 ? WS_V : (pn < 18 ? WS_GS : WS_GA); const int t0 = pn < 14 ? 10 : (pn < 18 ? 14 : 18); const bool ntst = pn >= 14;
            bf16_t* dst = (bf16_t*)(ws + base) + (size_t)(pn - t0) * 256 + colw;
#pragma unroll
            for (int ai = 0; ai < 2; ++ai)
#pragma unroll
                for (int m = 0; m < 4; ++m) { const int tok = row0 + ai * 128 + m * 16;
#pragma unroll
                    for (int bj = 0; bj < 2; ++bj) { const u32x4 w = pack8(acc[ai][bj][m][0], acc[ai][bj][m][1]); if (ntst) NT_STORE(w, (u32x4*)(dst + (size_t)tok * D + 32 * bj)); else store16(dst + (size_t)tok * D + 32 * bj, w); } }
        }
    }
};
struct EpiSsm2 : EpiBase {
    unsigned char* ws;
    __device__ __forceinline__ void operator()(Acc& acc, const EpiInfo& u, int wr, int wc, int fr, int fq) const {
        bf16_t* Z = (bf16_t*)(ws + WS_Z); const int g = u.aux;
#pragma unroll
        for (int ai = 0; ai < 2; ++ai)
#pragma unroll
            for (int m = 0; m < 4; ++m) { const int r = u.pm * BM + ai * 128 + wr * 64 + m * 16 + fr, b = r >> 6, c = r & 63;
#pragma unroll
                for (int bj = 0; bj < 2; ++bj) { const int n_ = u.pn * 256 + 64 * wc + 32 * bj + 8 * fq, t = n_ >> 4, h0 = n_ & 15; const int tok = b * SEQ + c * CH_L + t;
                    f32x4 a = acc[ai][bj][m][0], bb = acc[ai][bj][m][1];
#pragma unroll
                    for (int q = 0; q < 4; ++q) { a[q] = gelu_tanh(a[q]); bb[q] = gelu_tanh(bb[q]); }
                    *(u32x4*)(Z + (size_t)tok * SSM_W + 16 * g + h0) = pack8(a, bb); } }
    }
};
struct EpiGlu : EpiBase {
    unsigned char* ws; const float* bglu;
    __device__ __forceinline__ void operator()(Acc& acc, const EpiInfo& u, int wr, int wc, int fr, int fq) const {
        asm volatile("" : "+v"(fr), "+v"(fq));
        const bf16_t* Z = (const bf16_t*)(ws + WS_Z); bf16_t* MA = (bf16_t*)(ws + WS_MA);
        const int col0 = u.pn * 256 + 64 * wc + 8 * fq;
        f32x4 cb[2][2];
#pragma unroll
        for (int bj = 0; bj < 2; ++bj) { cb[bj][0] = *(const f32x4*)(bglu + col0 + 32 * bj); cb[bj][1] = *(const f32x4*)(bglu + col0 + 32 * bj + 4); }
#pragma unroll
        for (int ai = 0; ai < 2; ++ai) { u32x4 zz[4][2];
#pragma unroll
            for (int m = 0; m < 4; ++m) { const int tok = u.pm * BM + ai * 128 + wr * 64 + m * 16 + fr;
#pragma unroll
                for (int bj = 0; bj < 2; ++bj) zz[m][bj] = *(const u32x4*)(Z + (size_t)tok * SSM_W + col0 + 32 * bj); }
            asm volatile("" ::: "memory");
#pragma unroll
            for (int m = 0; m < 4; ++m) { const int tok = u.pm * BM + ai * 128 + wr * 64 + m * 16 + fr;
#pragma unroll
                for (int bj = 0; bj < 2; ++bj) { f32x4 z0, z1; unpack8(zz[m][bj], z0, z1);
                    f32x4 a = acc[ai][bj][m][0] + cb[bj][0], bb = acc[ai][bj][m][1] + cb[bj][1];
#pragma unroll
                    for (int q = 0; q < 4; ++q) { a[q] = z0[q] * sigmoid_f(a[q]); bb[q] = z1[q] * sigmoid_f(bb[q]); }
                    *(u32x4*)(MA + (size_t)tok * MA_LD + 1024 + col0 + 32 * bj) = pack8(a, bb); } }
            asm volatile("" ::: "memory"); }
    }
};
struct EpiMerged : EpiBase {
    static constexpr bool HAS_MID = true; static constexpr int MID_T = 16;
    unsigned char* ws;
    __device__ __forceinline__ float ratio(float a, float s) const { a = fminf(fmaxf(a, -30.f), 30.f); s = fminf(fmaxf(s, -30.f), 30.f); return (1.f + __expf(-s)) * __builtin_amdgcn_rcpf(1.f + __expf(-a)); }
    __device__ __forceinline__ void mid(Acc& acc, const EpiInfo& u, int wr, int wc, int fr, int fq) const {
        asm volatile("" : "+v"(fr), "+v"(fq));
        const bf16_t* GS = (const bf16_t*)(ws + WS_GS); const bf16_t* GA = (const bf16_t*)(ws + WS_GA);
        const int col0 = u.pn * 256 + 64 * wc + 8 * fq;
#pragma unroll
        for (int ai = 0; ai < 2; ++ai)
#pragma unroll
            for (int mp = 0; mp < 2; ++mp) { u32x4 gs_[2][2], ga_[2][2];
#pragma unroll
                for (int mm = 0; mm < 2; ++mm) { const int tok = u.pm * BM + ai * 128 + wr * 64 + (2 * mp + mm) * 16 + fr;
#pragma unroll
                    for (int bj = 0; bj < 2; ++bj) { gs_[mm][bj] = *(const u32x4*)(GS + (size_t)tok * D + col0 + 32 * bj); ga_[mm][bj] = *(const u32x4*)(GA + (size_t)tok * D + col0 + 32 * bj); } }
#pragma unroll
                for (int mm = 0; mm < 2; ++mm)
#pragma unroll
                    for (int bj = 0; bj < 2; ++bj) { const int m = 2 * mp + mm; const u32x4 ws_ = gs_[mm][bj], wa_ = ga_[mm][bj];
                        acc[ai][bj][m][0][0] *= ratio(bflo(wa_.x), bflo(ws_.x)); acc[ai][bj][m][0][1] *= ratio(bfhi(wa_.x), bfhi(ws_.x));
                        acc[ai][bj][m][0][2] *= ratio(bflo(wa_.y), bflo(ws_.y)); acc[ai][bj][m][0][3] *= ratio(bfhi(wa_.y), bfhi(ws_.y));
                        acc[ai][bj][m][1][0] *= ratio(bflo(wa_.z), bflo(ws_.z)); acc[ai][bj][m][1][1] *= ratio(bfhi(wa_.z), bfhi(ws_.z));
                        acc[ai][bj][m][1][2] *= ratio(bflo(wa_.w), bflo(ws_.w)); acc[ai][bj][m][1][3] *= ratio(bfhi(wa_.w), bfhi(ws_.w)); }
                asm volatile("" ::: "memory"); }
    }
    __device__ __forceinline__ void operator()(Acc& acc, const EpiInfo& u, int wr, int wc, int fr, int fq) const {
        asm volatile("" : "+v"(fr), "+v"(fq));
        const bf16_t* GS = (const bf16_t*)(ws + WS_GS); bf16_t* O = (bf16_t*)(ws + WS_MERGED);
        const int col0 = u.pn * 256 + 64 * wc + 8 * fq;
#pragma unroll
        for (int ai = 0; ai < 2; ++ai) { u32x4 gs_[4][2];
#pragma unroll
            for (int m = 0; m < 4; ++m) { const int tok = u.pm * BM + ai * 128 + wr * 64 + m * 16 + fr;
#pragma unroll
                for (int bj = 0; bj < 2; ++bj) gs_[m][bj] = *(const u32x4*)(GS + (size_t)tok * D + col0 + 32 * bj); }
#pragma unroll
            for (int m = 0; m < 4; ++m) { const int tok = u.pm * BM + ai * 128 + wr * 64 + m * 16 + fr;
#pragma unroll
                for (int bj = 0; bj < 2; ++bj) { f32x4 s0, s1; unpack8(gs_[m][bj], s0, s1);
                    f32x4 a = acc[ai][bj][m][0], bb = acc[ai][bj][m][1];
#pragma unroll
                    for (int q = 0; q < 4; ++q) { a[q] *= sigmoid_c(s0[q]); bb[q] *= sigmoid_c(s1[q]); }
                    *(u32x4*)(O + (size_t)tok * D + col0 + 32 * bj) = pack8(a, bb); } }
            asm volatile("" ::: "memory"); }
    }
};
struct EpiWout : EpiBase {
    const float* x; float* out;
    __device__ __forceinline__ void operator()(Acc& acc, const EpiInfo& u, int wr, int wc, int fr, int fq) const {
        asm volatile("" : "+v"(fr), "+v"(fq));
        const int col0 = u.pn * 256 + 64 * wc + 8 * fq;
#pragma unroll
        for (int ai = 0; ai < 2; ++ai)
#pragma unroll
            for (int mp = 0; mp < 2; ++mp) { f32x4 xv[2][2][2];
#pragma unroll
                for (int mm = 0; mm < 2; ++mm) { const int tok = u.pm * BM + ai * 128 + wr * 64 + (2 * mp + mm) * 16 + fr;
#pragma unroll
                    for (int bj = 0; bj < 2; ++bj) { const size_t o = (size_t)tok * D + col0 + 32 * bj; xv[mm][bj][0] = NT_LOAD((const f32x4*)(x + o)); xv[mm][bj][1] = NT_LOAD((const f32x4*)(x + o + 4)); } }
                asm volatile("" ::: "memory");
#pragma unroll
                for (int mm = 0; mm < 2; ++mm) { const int m = 2 * mp + mm, tok = u.pm * BM + ai * 128 + wr * 64 + m * 16 + fr;
#pragma unroll
                    for (int bj = 0; bj < 2; ++bj) { const size_t o = (size_t)tok * D + col0 + 32 * bj;
                        *(f32x4*)(out + o) = xv[mm][bj][0] + acc[ai][bj][m][0]; *(f32x4*)(out + o + 4) = xv[mm][bj][1] + acc[ai][bj][m][1]; } }
                asm volatile("" ::: "memory"); }
    }
};
struct EpiMoe1 : EpiBase {
    unsigned char* ws; const float* b1; LAS unsigned char* lds; bool nostore = false;
    __device__ __forceinline__ void operator()(Acc& acc, const EpiInfo& u, int wr, int wc, int fr, int fq) const {
        asm volatile("" : "+v"(fr), "+v"(fq));
        unsigned char* ACT = ws + WS_ACT; const int e = u.aux, blk = u.aux2;
        f32x4 cb[2][2];
#pragma unroll
        for (int bj = 0; bj < 2; ++bj) { const int cl = 64 * wc + 32 * bj + 8 * fq;
            if (u.ord < MOE_MAXU) { const LAS float* bl = (const LAS float*)(lds + UB_OFF) + u.ord * 256 + cl; cb[bj][0] = *(const LAS f32x4*)bl; cb[bj][1] = *(const LAS f32x4*)(bl + 4); }
            else { const float* bg = b1 + (size_t)e * 2 * DFF + u.pn * 256 + cl; cb[bj][0] = *(const f32x4*)bg; cb[bj][1] = *(const f32x4*)(bg + 4); __builtin_amdgcn_s_waitcnt(0x0F70); } }
#pragma unroll
        for (int ai = 0; ai < 2; ++ai)
#pragma unroll
            for (int m = 0; m < 4; ++m) { const int row = ai * 128 + wr * 64 + m * 16 + fr; unsigned w[2];
#pragma unroll
                for (int bj = 0; bj < 2; ++bj) { const f32x4 h0 = acc[ai][bj][m][0] + cb[bj][0], h1 = acc[ai][bj][m][1] + cb[bj][1]; float o[4];
#pragma unroll
                    for (int q = 0; q < 4; ++q) { const float gr = q < 2 ? h0[2 * q] : h1[2 * q - 4], ur = q < 2 ? h0[2 * q + 1] : h1[2 * q - 3];
                        const float gate = fminf(gr, 7.f), up = fminf(fmaxf(ur, -7.f), 7.f); o[q] = (up + 1.f) * gate * sigmoid_f(1.702f * gate); }
                    w[bj] = pk4_fp8(o[0], o[1], o[2], o[3]); }
                unsigned char* rowp = ACT + ((size_t)blk * 256 + row) * DFF + ((u.pn * 256 + 64 * wc + 8 * fq) >> 1);
#if defined(PROBE_NOSTORE)
                if (nostore) { asm volatile("" :: "v"(w[0]), "v"(w[1])); } else
#endif
                { *(unsigned*)rowp = w[0]; *(unsigned*)(rowp + 16) = w[1]; } }
    }
};
struct EpiMoe2 : EpiBase {
    unsigned char* ws; const float* b2; LAS unsigned char* lds; bool nostore = false;
    __device__ __forceinline__ void operator()(Acc& acc, const EpiInfo& u, int wr, int wc, int fr, int fq) const {
        asm volatile("" : "+v"(fr), "+v"(fq));
        bf16_t* Y = (bf16_t*)(ws + WS_Y); const int e = u.aux, blk = u.aux2 & 0xffff;
        f32x4 cb[2][2];
#pragma unroll
        for (int bj = 0; bj < 2; ++bj) { const int cl = 64 * wc + 32 * bj + 8 * fq;
            if (u.ord < MOE_MAXU) { const LAS float* bl = (const LAS float*)(lds + UB_OFF) + u.ord * 256 + cl; cb[bj][0] = *(const LAS f32x4*)bl; cb[bj][1] = *(const LAS f32x4*)(bl + 4); }
            else { const float* bg = b2 + (size_t)e * D + u.pn * 256 + cl; cb[bj][0] = *(const f32x4*)bg; cb[bj][1] = *(const f32x4*)(bg + 4); __builtin_amdgcn_s_waitcnt(0x0F70); } }
#pragma unroll
        for (int ai = 0; ai < 2; ++ai)
#pragma unroll
            for (int m = 0; m < 4; ++m) { const int row = ai * 128 + wr * 64 + m * 16 + fr;
#pragma unroll
                for (int bj = 0; bj < 2; ++bj) { const int col = u.pn * 256 + 64 * wc + 32 * bj + 8 * fq;
                    const u32x4 w = pack8(acc[ai][bj][m][0] + cb[bj][0], acc[ai][bj][m][1] + cb[bj][1]);
#if defined(PROBE_NOSTORE)
                    if (nostore) { asm volatile("" :: "v"(w)); } else
#endif
                    store16(Y + ((size_t)blk * 256 + row) * D + col, w); } }
    }
};
}
namespace attn_body {
using bf16=__hip_bfloat16;
using bf16x8=__attribute__((ext_vector_type(8)))short;
using s16x4=__attribute__((ext_vector_type(4)))short;
using f32x16=__attribute__((ext_vector_type(16)))float;
using u32x4=__attribute__((ext_vector_type(4)))unsigned;
constexpr int SEQ=2048,D=64,DM=1024;
constexpr int NW=8,QBLK=32,QB=QBLK*NW,KVBLK=64,NQB=SEQ/QB;
constexpr int ATTN_PITCH=DM, ATTN_UNIT_ROWS=QB;
__device__ __forceinline__ int crow(int r,int hi){return (r&3)+8*(r>>2)+4*hi;}
#define SBAR() __builtin_amdgcn_sched_barrier(0)
__device__ __forceinline__ void cmask(f32x16&p0,f32x16&p1,int jb,int qrel,int hi){
  const float NEG=-INFINITY; int kb=64*jb+4*hi;
  #pragma unroll
  for(int r=0;r<16;++r){int kv=kb+(r&3)+8*(r>>2); if(kv>qrel)p0[r]=NEG; if(kv+32>qrel)p1[r]=NEG;}
}

constexpr int NSLOT=3, SLOTB=8192;
constexpr int LDS_K=0, LDS_V=NSLOT*SLOTB, LDS_WS=2*NSLOT*SLOTB, LDS_OST=LDS_WS+NW*64*4, ALDS_BYTES=LDS_OST+NW*4096;
constexpr float C2=0.125f*1.4426950408889634f;
__device__ __forceinline__ void glds16(const void*gsrc,unsigned lds_dst){unsigned keep;
  asm volatile("s_mov_b32 %0, m0\n\ts_mov_b32 m0, %2\n\ts_nop 0\n\tglobal_load_lds_dwordx4 %1, off\n\ts_mov_b32 m0, %0":"=&s"(keep):"v"(gsrc),"s"(lds_dst):"memory");}
__device__ __forceinline__ float max3f(float a,float b,float c){float r;asm("v_max3_f32 %0, %1, %2, %3":"=v"(r):"v"(a),"v"(b),"v"(c));return r;}
__device__ __forceinline__ float max2f(float a,float b){float r;asm("v_max_f32_e32 %0, %1, %2":"=v"(r):"v"(a),"v"(b));return r;}
__device__ __forceinline__ float fadd_s(float a,float b){float r;asm("v_add_f32_e32 %0, %1, %2":"=v"(r):"v"(a),"v"(b));return r;}
__device__ __forceinline__ float fsub_s(float a,float b){float r;asm("v_sub_f32_e32 %0, %1, %2":"=v"(r):"v"(a),"v"(b));return r;}
typedef float f32x2_t __attribute__((ext_vector_type(2))); typedef __bf16 bf16x2_t __attribute__((ext_vector_type(2)));
__device__ __forceinline__ unsigned cvtpk_s(float lo,float hi){f32x2_t v={lo,hi};bf16x2_t b=__builtin_convertvector(v,bf16x2_t);return __builtin_bit_cast(unsigned,b);}
#define WAIT_BAR(N) asm volatile("s_waitcnt vmcnt(" #N ") lgkmcnt(0)\n\ts_barrier":::"memory")

__device__ __forceinline__ void qkt(f32x16&p0,f32x16&p1,const char*Kslot,const bf16x8*qr,const f32x16&negm,int r32,int hi){
  const char*kb=Kslot+hi*1024+r32*16;
  #pragma unroll
  for(int d0=0;d0<4;++d0){
    const bf16x8 b0=*reinterpret_cast<const bf16x8*>(kb+d0*2048);
    const bf16x8 b1=*reinterpret_cast<const bf16x8*>(kb+d0*2048+512);
    if(d0==0){p0=__builtin_amdgcn_mfma_f32_32x32x16_bf16(b0,qr[0],negm,0,0,0);p1=__builtin_amdgcn_mfma_f32_32x32x16_bf16(b1,qr[0],negm,0,0,0);}
    else{p0=__builtin_amdgcn_mfma_f32_32x32x16_bf16(b0,qr[d0],p0,0,0,0);p1=__builtin_amdgcn_mfma_f32_32x32x16_bf16(b1,qr[d0],p1,0,0,0);}}
}
typedef __attribute__((address_space(3))) const char* lds_cptr;
typedef short v4i16_t __attribute__((ext_vector_type(4)));
__device__ __forceinline__ void kload8(bf16x8*kf,lds_cptr kp){
  kf[0]=*(const __attribute__((address_space(3))) bf16x8*)(kp);      kf[1]=*(const __attribute__((address_space(3))) bf16x8*)(kp+512);
  kf[2]=*(const __attribute__((address_space(3))) bf16x8*)(kp+2048); kf[3]=*(const __attribute__((address_space(3))) bf16x8*)(kp+2560);
  kf[4]=*(const __attribute__((address_space(3))) bf16x8*)(kp+4096); kf[5]=*(const __attribute__((address_space(3))) bf16x8*)(kp+4608);
  kf[6]=*(const __attribute__((address_space(3))) bf16x8*)(kp+6144); kf[7]=*(const __attribute__((address_space(3))) bf16x8*)(kp+6656);
}
__device__ __forceinline__ void kload2(bf16x8*kf,lds_cptr kp,int j){ kf[2*j]=*(const __attribute__((address_space(3))) bf16x8*)(kp+j*2048); kf[2*j+1]=*(const __attribute__((address_space(3))) bf16x8*)(kp+j*2048+512); }
__device__ __forceinline__ s16x4 vtr(lds_cptr p){ return __builtin_bit_cast(s16x4,__builtin_amdgcn_ds_read_tr16_b64_v4i16((__attribute__((address_space(3))) v4i16_t*)p)); }
__device__ __forceinline__ float rowmax(const f32x16&p0,const f32x16&p1){
  float a=max3f(p0[0],p0[1],p1[0]),b=max3f(p0[2],p0[3],p1[1]);a=max3f(a,p1[2],p1[3]);
  #pragma unroll
  for(int r=4;r<16;r+=4){a=max3f(a,p0[r],p0[r+1]);b=max3f(b,p0[r+2],p0[r+3]);a=max3f(a,p1[r],p1[r+1]);b=max3f(b,p1[r+2],p1[r+3]);}
  const float m=max2f(a,b);
  auto rr=__builtin_amdgcn_permlane32_swap(__float_as_uint(m),__float_as_uint(m),false,false);
  return max2f(__uint_as_float(rr[0]),__uint_as_float(rr[1]));
}
__device__ __forceinline__ void pv(f32x16*o,int vb,bf16x8 pa0,bf16x8 pa1,bf16x8 pa2,bf16x8 pa3){
  #pragma unroll
  for(int d0=0;d0<2;++d0){s16x4 lo[4],hi[4];
    #pragma unroll
    for(int ks=0;ks<4;++ks){
      asm volatile("ds_read_b64_tr_b16 %0,%1 offset:%c2":"=&v"(lo[ks]):"v"(vb),"i"(d0*4096+ks*1024):"memory");
      asm volatile("ds_read_b64_tr_b16 %0,%1 offset:%c2":"=&v"(hi[ks]):"v"(vb),"i"(d0*4096+ks*1024+512):"memory");}
    asm volatile("s_waitcnt lgkmcnt(0)":::"memory");SBAR();
    #define PK(k) (bf16x8){lo[k][0],lo[k][1],lo[k][2],lo[k][3],hi[k][0],hi[k][1],hi[k][2],hi[k][3]}
    o[d0]=__builtin_amdgcn_mfma_f32_32x32x16_bf16(pa0,PK(0),o[d0],0,0,0);
    o[d0]=__builtin_amdgcn_mfma_f32_32x32x16_bf16(pa1,PK(1),o[d0],0,0,0);
    o[d0]=__builtin_amdgcn_mfma_f32_32x32x16_bf16(pa2,PK(2),o[d0],0,0,0);
    o[d0]=__builtin_amdgcn_mfma_f32_32x32x16_bf16(pa3,PK(3),o[d0],0,0,0);
    #undef PK
  }
}

#ifndef ATTN_STORE16
#define ATTN_STORE16(p,v) (*(u32x4*)(p)=(v))
#endif
template<int THRL> __device__ __forceinline__ void attn_unit(int b,int qcol,int kcol,int vcol,int ocol,int qb,const bf16*Q,const bf16*__restrict__ K,const bf16*__restrict__ V,bf16*O,char*shm){
  int tid_=threadIdx.x; asm volatile("":"+v"(tid_));
  const int tid=tid_,lane=tid&63,r32=lane&31,hi=lane>>5; const int wid=__builtin_amdgcn_readfirstlane(tid>>6);
  const long rowbase=(long)b*SEQ; const int q0=qb*QB;
  const bf16*Qw=Q+(rowbase+q0+wid*QBLK)*DM+qcol;
  const bf16*Kh=K+rowbase*DM+kcol,*Vh=V+rowbase*DM+vcol;
  const unsigned lds0=(unsigned)(uintptr_t)shm;
  float*wsf=(float*)(shm+LDS_WS)+wid*64;
  const bf16*ksrc=Kh+(long)lane*DM+wid*8;
  const bf16*vsrc=Vh+(long)(16*(wid&3)+(lane>>2))*DM+(wid>>2)*32+(lane&3)*8;
  const unsigned kdst=lds0+LDS_K+wid*1024, vdst=lds0+LDS_V+wid*1024;
  #define DMA_K(t,slot) glds16(ksrc+(long)(t)*KVBLK*DM,(unsigned)__builtin_amdgcn_readfirstlane(kdst+(slot)))
  #define DMA_V(t,slot) glds16(vsrc+(long)(t)*KVBLK*DM,(unsigned)__builtin_amdgcn_readfirstlane(vdst+(slot)))
  const int vb0=(int)(lds0+LDS_V)+((lane>>4)&1)*32+(lane&3)*8+(4*hi+((lane&15)>>2))*64;
  const char*Kbase=shm+LDS_K; bf16x8 kf[8];
  const lds_cptr shm3=(lds_cptr)shm; const lds_cptr kp0=shm3+LDS_K+hi*1024+r32*16; const lds_cptr vp0=shm3+LDS_V+((lane>>4)&1)*32+(lane&3)*8+(4*hi+((lane&15)>>2))*64;
  const int NT=(q0+QB)/KVBLK;
  DMA_K(0,0);DMA_V(0,0);DMA_K(1,SLOTB);
  bf16x8 qr[4];
  #pragma unroll
  for(int d0=0;d0<4;++d0)qr[d0]=*reinterpret_cast<const bf16x8*>(&Qw[(long)r32*DM+d0*16+hi*8]);
  float l_reg=0.f;f32x16 o[2];o[0]=f32x16{};o[1]=f32x16{};const f32x16 negm=f32x16{};
  const int qrel=wid*QBLK+r32;
  #define CMASK(P0,P1,t) do{int jb_=(t)-(NT-4); if(jb_>=0)cmask(P0,P1,jb_,qrel,hi);}while(0)
  #define START(P0,P1) do{ _Pragma("unroll") for(int r=0;r<16;++r)P0[r]=__builtin_amdgcn_exp2f(P0[r]); }while(0)
  #define RESC() do{}while(0)
  f32x16 pA0,pA1,pB0,pB1;
  int sl_prev=0,sl_cur=0,sl_next=SLOTB;
  #define ROT() do{sl_prev=sl_cur;sl_cur=sl_next;sl_next=(sl_next==(NSLOT-1)*SLOTB)?0:sl_next+SLOTB;}while(0)
  DMA_K(2,2*SLOTB);
  WAIT_BAR(3);
  qkt(pA0,pA1,Kbase,qr,negm,r32,hi);asm volatile("s_nop 15\n\ts_nop 7":"+v"(pA0),"+v"(pA1));CMASK(pA0,pA1,0);
  START(pA0,pA1);
  _Pragma("unroll") for(int r=0;r<16;++r)pA1[r]=__builtin_amdgcn_exp2f(pA1[r]);
  WAIT_BAR(0);
  DMA_K(3,0);DMA_V(1,SLOTB);
  ROT();
  kload8(kf,kp0+sl_cur);
  WAIT_BAR(2);
  s16x4 vlo[8],vhi[8]; u32x4 pw0,pw1,pw2,pw3;
  #define PKW(P,B) cvtpk_s(P[B],P[B+1])
  #define PAF(k) __builtin_bit_cast(bf16x8,pw##k)
  #define VFR(i) (bf16x8){vlo[i][0],vlo[i][1],vlo[i][2],vlo[i][3],vhi[i][0],vhi[i][1],vhi[i][2],vhi[i][3]}
  #define PIN(x) asm volatile("":"+v"(x))
  #define MX3(a,b,c) __builtin_fmaxf(__builtin_fmaxf((a),(b)),(c))
  #define GAPA(MF,A0,A1,A2,A3,W0,W1,PW) do{ MF; sacc+=A0; sacc+=A1; sacc+=A2; sacc+=A3; PIN(sacc); W0; W1; PIN(PW); SBAR(); }while(0)
  #define EX(v) __builtin_amdgcn_exp2f(v)
  #define GAPB(MF,X,B) do{ MF; X[B]=EX(X[B]); X[B+1]=EX(X[B+1]); X[B+2]=EX(X[B+2]); X[B+3]=EX(X[B+3]); PIN(X); SBAR(); }while(0)
  #define VRD(i) do{ vlo[i]=vtr(vp_+(((i)>>2)*4096+((i)&3)*1024)); vhi[i]=vtr(vp_+(((i)>>2)*4096+((i)&3)*1024+512)); }while(0)
  #define KRD(G,j) do{ if(G){ kload2(kf,kp0+sl_next,j); SBAR(); } }while(0)
  #define STEP(C0,C1,P0,P1,t,GK,GV,GL) do{ SBAR(); \
    const lds_cptr vp_=vp0+sl_prev; \
    VRD(0); SBAR(); float sacc=(P0[0]+P0[1]); \
    GAPA(C0=__builtin_amdgcn_mfma_f32_32x32x16_bf16(kf[0],qr[0],negm,0,0,0), P0[2],P0[3],P0[4],P0[5],     pw0[0]=PKW(P0,0), pw0[1]=PKW(P0,2), pw0); \
    VRD(4); SBAR(); GAPA(C1=__builtin_amdgcn_mfma_f32_32x32x16_bf16(kf[1],qr[0],negm,0,0,0), P0[6],P0[7],P0[8],P0[9],     pw0[2]=PKW(P0,4), pw0[3]=PKW(P0,6), pw0); \
    VRD(1); SBAR(); GAPA(C0=__builtin_amdgcn_mfma_f32_32x32x16_bf16(kf[2],qr[1],C0,0,0,0),   P0[10],P0[11],P0[12],P0[13], pw1[0]=PKW(P0,8), pw1[1]=PKW(P0,10), pw1); \
    VRD(5); SBAR(); GAPA(C1=__builtin_amdgcn_mfma_f32_32x32x16_bf16(kf[3],qr[1],C1,0,0,0),   P0[14],P0[15],P1[0],P1[1],   pw1[2]=PKW(P0,12),pw1[3]=PKW(P0,14), pw1); \
    VRD(2); SBAR(); GAPA(C0=__builtin_amdgcn_mfma_f32_32x32x16_bf16(kf[4],qr[2],C0,0,0,0),   P1[2],P1[3],P1[4],P1[5],     pw2[0]=PKW(P1,0), pw2[1]=PKW(P1,2), pw2); \
    VRD(6); SBAR(); GAPA(C1=__builtin_amdgcn_mfma_f32_32x32x16_bf16(kf[5],qr[2],C1,0,0,0),   P1[6],P1[7],P1[8],P1[9],     pw2[2]=PKW(P1,4), pw2[3]=PKW(P1,6), pw2); \
    VRD(3); SBAR(); GAPA(C0=__builtin_amdgcn_mfma_f32_32x32x16_bf16(kf[6],qr[3],C0,0,0,0),   P1[10],P1[11],P1[12],P1[13], pw3[0]=PKW(P1,8), pw3[1]=PKW(P1,10), pw3); \
    VRD(7); SBAR(); GAPA(C1=__builtin_amdgcn_mfma_f32_32x32x16_bf16(kf[7],qr[3],C1,0,0,0),   P1[14],P1[15],0.f,0.f,       pw3[2]=PKW(P1,12),pw3[3]=PKW(P1,14), pw3); \
    l_reg+=sacc; \
    if(GK){DMA_K((t)+3,sl_cur);} if(GV){DMA_V((t)+1,sl_next);} \
    CMASK(C0,C1,t); \
    SBAR(); \
    GAPB(o[0]=__builtin_amdgcn_mfma_f32_32x32x16_bf16(PAF(0),VFR(0),o[0],0,0,0), C0,0); \
    GAPB(o[1]=__builtin_amdgcn_mfma_f32_32x32x16_bf16(PAF(0),VFR(4),o[1],0,0,0), C0,4); \
    KRD(GL,0); GAPB(o[0]=__builtin_amdgcn_mfma_f32_32x32x16_bf16(PAF(1),VFR(1),o[0],0,0,0), C0,8); \
    KRD(GL,1); GAPB(o[1]=__builtin_amdgcn_mfma_f32_32x32x16_bf16(PAF(1),VFR(5),o[1],0,0,0), C0,12); \
    KRD(GL,2); GAPB(o[0]=__builtin_amdgcn_mfma_f32_32x32x16_bf16(PAF(2),VFR(2),o[0],0,0,0), C1,0); \
    KRD(GL,3); GAPB(o[1]=__builtin_amdgcn_mfma_f32_32x32x16_bf16(PAF(2),VFR(6),o[1],0,0,0), C1,4); \
    GAPB(o[0]=__builtin_amdgcn_mfma_f32_32x32x16_bf16(PAF(3),VFR(3),o[0],0,0,0), C1,8); \
    GAPB(o[1]=__builtin_amdgcn_mfma_f32_32x32x16_bf16(PAF(3),VFR(7),o[1],0,0,0), C1,12); \
    }while(0)
  int t=1;
  #undef CMASK
  #define CMASK(P0,P1,t) do{}while(0)
  for(;t+5<NT;t+=2){
    STEP(pB0,pB1,pA0,pA1,t,true,true,true);     WAIT_BAR(2); RESC(); ROT();
    STEP(pA0,pA1,pB0,pB1,t+1,true,true,true);   WAIT_BAR(2); RESC(); ROT();
  }
  #undef CMASK
  #define CMASK(P0,P1,t) do{int jb_=(t)-(NT-4); if(jb_>=0)cmask(P0,P1,jb_,qrel,hi);}while(0)
  #define ENDW(tt) do{ if((tt)+3<NT){WAIT_BAR(2);} else if((tt)+2<NT){WAIT_BAR(1);} else {WAIT_BAR(0);} }while(0)
  for(;t+1<NT;t+=2){
    STEP(pB0,pB1,pA0,pA1,t,(t+3<NT),(t+1<NT),(t+1<NT));       ENDW(t);   RESC(); ROT();
    STEP(pA0,pA1,pB0,pB1,t+1,(t+4<NT),(t+2<NT),(t+2<NT));     ENDW(t+1); RESC(); ROT();
  }
  STEP(pB0,pB1,pA0,pA1,NT-1,false,false,false); RESC();
  { float sacc=pB0[0]+pB0[1]; _Pragma("unroll") for(int r=2;r<16;++r)sacc+=pB0[r]; _Pragma("unroll") for(int r=0;r<16;++r)sacc+=pB1[r]; l_reg+=sacc;
    pw0=(u32x4){PKW(pB0,0),PKW(pB0,2),PKW(pB0,4),PKW(pB0,6)};pw1=(u32x4){PKW(pB0,8),PKW(pB0,10),PKW(pB0,12),PKW(pB0,14)};pw2=(u32x4){PKW(pB1,0),PKW(pB1,2),PKW(pB1,4),PKW(pB1,6)};pw3=(u32x4){PKW(pB1,8),PKW(pB1,10),PKW(pB1,12),PKW(pB1,14)};
    SBAR(); pv(o,vb0+sl_cur,PAF(0),PAF(1),PAF(2),PAF(3)); }
  #undef PKW
  #undef PAF
  #undef VFR
  #undef PIN
  #undef MX3
  #undef GAPA
  #undef GAPB
  #undef EX
  #undef VRD
  #undef KRD
  #undef STEP
  #undef ENDW
  {auto rr=__builtin_amdgcn_permlane32_swap(__float_as_uint(l_reg),__float_as_uint(l_reg),false,false);l_reg=__uint_as_float(rr[0])+__uint_as_float(rr[1]);}
  if(hi==0)wsf[32+r32]=l_reg;asm volatile("s_waitcnt lgkmcnt(0)":::"memory");
  float rli[16];
  #pragma unroll
  for(int r=0;r<16;++r)rli[r]=__builtin_amdgcn_rcpf(wsf[32+crow(r,hi)]);
  bf16*Ow=O+(rowbase+q0+wid*QBLK)*DM+ocol;
  { bf16*stg=(bf16*)(shm+LDS_OST)+wid*2048;
    #pragma unroll
    for(int r=0;r<16;++r){const int orow=crow(r,hi);
      #pragma unroll
      for(int d0=0;d0<2;++d0)stg[orow*64+d0*32+r32]=__float2bfloat16(o[d0][r]*rli[r]);}
    asm volatile("s_waitcnt lgkmcnt(0)":::"memory");
    #pragma unroll
    for(int i=0;i<4;++i){const int row=i*8+(lane>>3),ch=lane&7; const u32x4 v=*(const u32x4*)(stg+row*64+ch*8); ATTN_STORE16(Ow+(long)row*DM+ch*8,v);} }
  asm volatile("s_waitcnt lgkmcnt(0)\n\ts_barrier":::"memory");
  #undef DMA_K
  #undef DMA_V
  #undef CMASK
  #undef START
  #undef RESC
  #undef ROT
}
constexpr int ATTN_LDS_BYTES=ALDS_BYTES;

#undef SBAR
#undef WAIT_BAR
#undef ATTN_STORE16
}
namespace attn128 {
using bf16=__hip_bfloat16;
using bf16x8=__attribute__((ext_vector_type(8)))short;
using s16x4=__attribute__((ext_vector_type(4)))short;
using f32x16=__attribute__((ext_vector_type(16)))float;
using u32x4=__attribute__((ext_vector_type(4)))unsigned;
constexpr int SEQ=2048,D=64,DM=1024;
constexpr int NW=8,QBLK=32,QB=QBLK*NW,KVBLK=64,NQB=SEQ/QB;
constexpr int ATTN_PITCH=DM, ATTN_UNIT_ROWS=QB;
__device__ __forceinline__ int crow(int r,int hi){return (r&3)+8*(r>>2)+4*hi;}
#define SBAR() __builtin_amdgcn_sched_barrier(0)
__device__ __forceinline__ void cmask(f32x16&p0,f32x16&p1,int jb,int qrel,int hi){
  const float NEG=-INFINITY; int kb=64*jb+4*hi;
  #pragma unroll
  for(int r=0;r<16;++r){int kv=kb+(r&3)+8*(r>>2); if(kv>qrel)p0[r]=NEG; if(kv+32>qrel)p1[r]=NEG;}
}

constexpr int NSLOT=3, SLOTB=8192;
constexpr int VSLOTB=2*SLOTB;
constexpr int LDS_K=0, LDS_V=NSLOT*SLOTB, LDS_WS=LDS_V+NSLOT*VSLOTB, LDS_OST=LDS_WS+NW*64*4, ALDS_BYTES=LDS_OST+NW*4096;
constexpr float C2=0.125f*1.4426950408889634f;
__device__ __forceinline__ void glds16(const void*gsrc,unsigned lds_dst){unsigned keep;
  asm volatile("s_mov_b32 %0, m0\n\ts_mov_b32 m0, %2\n\ts_nop 0\n\tglobal_load_lds_dwordx4 %1, off\n\ts_mov_b32 m0, %0":"=&s"(keep):"v"(gsrc),"s"(lds_dst):"memory");}
__device__ __forceinline__ float max3f(float a,float b,float c){float r;asm("v_max3_f32 %0, %1, %2, %3":"=v"(r):"v"(a),"v"(b),"v"(c));return r;}
__device__ __forceinline__ float max2f(float a,float b){float r;asm("v_max_f32_e32 %0, %1, %2":"=v"(r):"v"(a),"v"(b));return r;}
__device__ __forceinline__ float fadd_s(float a,float b){float r;asm("v_add_f32_e32 %0, %1, %2":"=v"(r):"v"(a),"v"(b));return r;}
__device__ __forceinline__ float fsub_s(float a,float b){float r;asm("v_sub_f32_e32 %0, %1, %2":"=v"(r):"v"(a),"v"(b));return r;}
typedef float f32x2_t __attribute__((ext_vector_type(2))); typedef __bf16 bf16x2_t __attribute__((ext_vector_type(2)));
__device__ __forceinline__ unsigned cvtpk_s(float lo,float hi){f32x2_t v={lo,hi};bf16x2_t b=__builtin_convertvector(v,bf16x2_t);return __builtin_bit_cast(unsigned,b);}
#define WAIT_BAR(N) asm volatile("s_waitcnt vmcnt(" #N ") lgkmcnt(0)\n\ts_barrier":::"memory")

__device__ __forceinline__ void qkt(f32x16&p0,f32x16&p1,const char*Kslot,const bf16x8*qr,const f32x16&negm,int r32,int hi){
  const char*kb=Kslot+hi*1024+r32*16;
  #pragma unroll
  for(int d0=0;d0<4;++d0){
    const bf16x8 b0=*reinterpret_cast<const bf16x8*>(kb+d0*2048);
    const bf16x8 b1=*reinterpret_cast<const bf16x8*>(kb+d0*2048+512);
    if(d0==0){p0=__builtin_amdgcn_mfma_f32_32x32x16_bf16(b0,qr[0],negm,0,0,0);p1=__builtin_amdgcn_mfma_f32_32x32x16_bf16(b1,qr[0],negm,0,0,0);}
    else{p0=__builtin_amdgcn_mfma_f32_32x32x16_bf16(b0,qr[d0],p0,0,0,0);p1=__builtin_amdgcn_mfma_f32_32x32x16_bf16(b1,qr[d0],p1,0,0,0);}}
}
typedef __attribute__((address_space(3))) const char* lds_cptr;
typedef short v4i16_t __attribute__((ext_vector_type(4)));
__device__ __forceinline__ void kload8(bf16x8*kf,lds_cptr kp){
  kf[0]=*(const __attribute__((address_space(3))) bf16x8*)(kp);      kf[1]=*(const __attribute__((address_space(3))) bf16x8*)(kp+512);
  kf[2]=*(const __attribute__((address_space(3))) bf16x8*)(kp+2048); kf[3]=*(const __attribute__((address_space(3))) bf16x8*)(kp+2560);
  kf[4]=*(const __attribute__((address_space(3))) bf16x8*)(kp+4096); kf[5]=*(const __attribute__((address_space(3))) bf16x8*)(kp+4608);
  kf[6]=*(const __attribute__((address_space(3))) bf16x8*)(kp+6144); kf[7]=*(const __attribute__((address_space(3))) bf16x8*)(kp+6656);
}
__device__ __forceinline__ void kload2(bf16x8*kf,lds_cptr kp,int j){ kf[2*j]=*(const __attribute__((address_space(3))) bf16x8*)(kp+j*2048); kf[2*j+1]=*(const __attribute__((address_space(3))) bf16x8*)(kp+j*2048+512); }
__device__ __forceinline__ s16x4 vtr(lds_cptr p){ return __builtin_bit_cast(s16x4,__builtin_amdgcn_ds_read_tr16_b64_v4i16((__attribute__((address_space(3))) v4i16_t*)p)); }
__device__ __forceinline__ float rowmax(const f32x16&p0,const f32x16&p1){
  float a=max3f(p0[0],p0[1],p1[0]),b=max3f(p0[2],p0[3],p1[1]);a=max3f(a,p1[2],p1[3]);
  #pragma unroll
  for(int r=4;r<16;r+=4){a=max3f(a,p0[r],p0[r+1]);b=max3f(b,p0[r+2],p0[r+3]);a=max3f(a,p1[r],p1[r+1]);b=max3f(b,p1[r+2],p1[r+3]);}
  const float m=max2f(a,b);
  auto rr=__builtin_amdgcn_permlane32_swap(__float_as_uint(m),__float_as_uint(m),false,false);
  return max2f(__uint_as_float(rr[0]),__uint_as_float(rr[1]));
}
__device__ __forceinline__ void pv(f32x16*o,int vb,bf16x8 pa0,bf16x8 pa1,bf16x8 pa2,bf16x8 pa3){
  #pragma unroll
  for(int d0=0;d0<4;++d0){s16x4 lo[4],hi[4];
    #pragma unroll
    for(int ks=0;ks<4;++ks){
      asm volatile("ds_read_b64_tr_b16 %0,%1 offset:%c2":"=&v"(lo[ks]):"v"(vb),"i"(d0*4096+ks*1024):"memory");
      asm volatile("ds_read_b64_tr_b16 %0,%1 offset:%c2":"=&v"(hi[ks]):"v"(vb),"i"(d0*4096+ks*1024+512):"memory");}
    asm volatile("s_waitcnt lgkmcnt(0)":::"memory");SBAR();
    #define PK(k) (bf16x8){lo[k][0],lo[k][1],lo[k][2],lo[k][3],hi[k][0],hi[k][1],hi[k][2],hi[k][3]}
    o[d0]=__builtin_amdgcn_mfma_f32_32x32x16_bf16(pa0,PK(0),o[d0],0,0,0);
    o[d0]=__builtin_amdgcn_mfma_f32_32x32x16_bf16(pa1,PK(1),o[d0],0,0,0);
    o[d0]=__builtin_amdgcn_mfma_f32_32x32x16_bf16(pa2,PK(2),o[d0],0,0,0);
    o[d0]=__builtin_amdgcn_mfma_f32_32x32x16_bf16(pa3,PK(3),o[d0],0,0,0);
    #undef PK
  }
}

#ifndef ATTN_STORE16
#define ATTN_STORE16(p,v) (*(u32x4*)(p)=(v))
#endif
template<int THRL> __device__ __forceinline__ void attn_unit(int b,int qcol,int kcol,int vcol,int ocol,int qb,const bf16*Q,const bf16*__restrict__ K,const bf16*__restrict__ V,bf16*O,char*shm){
  int tid_=threadIdx.x; asm volatile("":"+v"(tid_));
  const int tid=tid_,lane=tid&63,r32=lane&31,hi=lane>>5; const int wid=__builtin_amdgcn_readfirstlane(tid>>6);
  const long rowbase=(long)b*SEQ; const int q0=qb*QB;
  const bf16*Qw=Q+(rowbase+q0+wid*QBLK)*DM+qcol;
  const bf16*Kh=K+rowbase*DM+kcol,*Vh=V+rowbase*DM+vcol;
  const unsigned lds0=(unsigned)(uintptr_t)shm;
  float*wsf=(float*)(shm+LDS_WS)+wid*64;
  const bf16*ksrc=Kh+(long)lane*DM+wid*8;
  const bf16*vsrc=Vh+(long)(16*(wid&3)+(lane>>2))*DM+(wid>>2)*32+(lane&3)*8;
  const unsigned kdst=lds0+LDS_K+wid*1024, vdst=lds0+LDS_V+wid*1024;
  #define DMA_K(t,slot) glds16(ksrc+(long)(t)*KVBLK*DM,(unsigned)__builtin_amdgcn_readfirstlane(kdst+(slot)))
  #define DMA_V(t,slot) do{ glds16(vsrc+(long)(t)*KVBLK*DM,(unsigned)__builtin_amdgcn_readfirstlane(vdst+2*(slot))); glds16(vsrc+64+(long)(t)*KVBLK*DM,(unsigned)__builtin_amdgcn_readfirstlane(vdst+8192+2*(slot))); }while(0)
  const int vb0=(int)(lds0+LDS_V)+((lane>>4)&1)*32+(lane&3)*8+(4*hi+((lane&15)>>2))*64;
  const char*Kbase=shm+LDS_K; bf16x8 kf[8];
  const lds_cptr shm3=(lds_cptr)shm; const lds_cptr kp0=shm3+LDS_K+hi*1024+r32*16; const lds_cptr vp0=shm3+LDS_V+((lane>>4)&1)*32+(lane&3)*8+(4*hi+((lane&15)>>2))*64;
  const int NT=(q0+QB)/KVBLK;
  DMA_K(0,0);DMA_V(0,0);DMA_K(1,SLOTB);
  bf16x8 qr[4];
  #pragma unroll
  for(int d0=0;d0<4;++d0)qr[d0]=*reinterpret_cast<const bf16x8*>(&Qw[(long)r32*DM+d0*16+hi*8]);
  float l_reg=0.f;f32x16 o[4];o[0]=f32x16{};o[1]=f32x16{};o[2]=f32x16{};o[3]=f32x16{};const f32x16 negm=f32x16{};
  const int qrel=wid*QBLK+r32;
  #define CMASK(P0,P1,t) do{int jb_=(t)-(NT-4); if(jb_>=0)cmask(P0,P1,jb_,qrel,hi);}while(0)
  #define START(P0,P1) do{ _Pragma("unroll") for(int r=0;r<16;++r)P0[r]=__builtin_amdgcn_exp2f(P0[r]); }while(0)
  #define RESC() do{}while(0)
  f32x16 pA0,pA1,pB0,pB1;
  int sl_prev=0,sl_cur=0,sl_next=SLOTB;
  #define ROT() do{sl_prev=sl_cur;sl_cur=sl_next;sl_next=(sl_next==(NSLOT-1)*SLOTB)?0:sl_next+SLOTB;}while(0)
  DMA_K(2,2*SLOTB);
  WAIT_BAR(4);
  qkt(pA0,pA1,Kbase,qr,negm,r32,hi);asm volatile("s_nop 15\n\ts_nop 7":"+v"(pA0),"+v"(pA1));CMASK(pA0,pA1,0);
  START(pA0,pA1);
  _Pragma("unroll") for(int r=0;r<16;++r)pA1[r]=__builtin_amdgcn_exp2f(pA1[r]);
  WAIT_BAR(0);
  DMA_K(3,0);DMA_V(1,SLOTB);
  ROT();
  kload8(kf,kp0+sl_cur);
  WAIT_BAR(3);
  s16x4 vlo[8],vhi[8]; u32x4 pw0,pw1,pw2,pw3;
  #define PKW(P,B) cvtpk_s(P[B],P[B+1])
  #define PAF(k) __builtin_bit_cast(bf16x8,pw##k)
  #define VFR(i) (bf16x8){vlo[i][0],vlo[i][1],vlo[i][2],vlo[i][3],vhi[i][0],vhi[i][1],vhi[i][2],vhi[i][3]}
  #define PIN(x) asm volatile("":"+v"(x))
  #define MX3(a,b,c) __builtin_fmaxf(__builtin_fmaxf((a),(b)),(c))
  #define GAPA(MF,A0,A1,A2,A3,W0,W1,PW) do{ MF; sacc+=A0; sacc+=A1; sacc+=A2; sacc+=A3; PIN(sacc); W0; W1; PIN(PW); SBAR(); }while(0)
  #define EX(v) __builtin_amdgcn_exp2f(v)
  #define GAPB(MF,X,B) do{ MF; X[B]=EX(X[B]); X[B+1]=EX(X[B+1]); PIN(X); SBAR(); }while(0)
  #define VRD2(i) do{ vlo[i]=vtr(vp_+((((i)>>2)+2)*4096+((i)&3)*1024)); vhi[i]=vtr(vp_+((((i)>>2)+2)*4096+((i)&3)*1024+512)); }while(0)
  #define VRD(i) do{ vlo[i]=vtr(vp_+(((i)>>2)*4096+((i)&3)*1024)); vhi[i]=vtr(vp_+(((i)>>2)*4096+((i)&3)*1024+512)); }while(0)
  #define KRD(G,j) do{ if(G){ kload2(kf,kp0+sl_next,j); SBAR(); } }while(0)
  #define STEP(C0,C1,P0,P1,t,GK,GV,GL) do{ SBAR(); \
    const lds_cptr vp_=vp0+2*sl_prev; \
    VRD(0); SBAR(); float sacc=(P0[0]+P0[1]); \
    GAPA(C0=__builtin_amdgcn_mfma_f32_32x32x16_bf16(kf[0],qr[0],negm,0,0,0), P0[2],P0[3],P0[4],P0[5],     pw0[0]=PKW(P0,0), pw0[1]=PKW(P0,2), pw0); \
    VRD(4); SBAR(); GAPA(C1=__builtin_amdgcn_mfma_f32_32x32x16_bf16(kf[1],qr[0],negm,0,0,0), P0[6],P0[7],P0[8],P0[9],     pw0[2]=PKW(P0,4), pw0[3]=PKW(P0,6), pw0); \
    VRD(1); SBAR(); GAPA(C0=__builtin_amdgcn_mfma_f32_32x32x16_bf16(kf[2],qr[1],C0,0,0,0),   P0[10],P0[11],P0[12],P0[13], pw1[0]=PKW(P0,8), pw1[1]=PKW(P0,10), pw1); \
    VRD(5); SBAR(); GAPA(C1=__builtin_amdgcn_mfma_f32_32x32x16_bf16(kf[3],qr[1],C1,0,0,0),   P0[14],P0[15],P1[0],P1[1],   pw1[2]=PKW(P0,12),pw1[3]=PKW(P0,14), pw1); \
    VRD(2); SBAR(); GAPA(C0=__builtin_amdgcn_mfma_f32_32x32x16_bf16(kf[4],qr[2],C0,0,0,0),   P1[2],P1[3],P1[4],P1[5],     pw2[0]=PKW(P1,0), pw2[1]=PKW(P1,2), pw2); \
    VRD(6); SBAR(); GAPA(C1=__builtin_amdgcn_mfma_f32_32x32x16_bf16(kf[5],qr[2],C1,0,0,0),   P1[6],P1[7],P1[8],P1[9],     pw2[2]=PKW(P1,4), pw2[3]=PKW(P1,6), pw2); \
    VRD(3); SBAR(); GAPA(C0=__builtin_amdgcn_mfma_f32_32x32x16_bf16(kf[6],qr[3],C0,0,0,0),   P1[10],P1[11],P1[12],P1[13], pw3[0]=PKW(P1,8), pw3[1]=PKW(P1,10), pw3); \
    VRD(7); SBAR(); GAPA(C1=__builtin_amdgcn_mfma_f32_32x32x16_bf16(kf[7],qr[3],C1,0,0,0),   P1[14],P1[15],0.f,0.f,       pw3[2]=PKW(P1,12),pw3[3]=PKW(P1,14), pw3); \
    l_reg+=sacc; \
    if(GK){DMA_K((t)+3,sl_cur);} if(GV){DMA_V((t)+1,sl_next);} \
    CMASK(C0,C1,t); \
    SBAR(); \
    GAPB(o[0]=__builtin_amdgcn_mfma_f32_32x32x16_bf16(PAF(0),VFR(0),o[0],0,0,0), C0,0);  VRD2(0); SBAR(); \
    GAPB(o[1]=__builtin_amdgcn_mfma_f32_32x32x16_bf16(PAF(0),VFR(4),o[1],0,0,0), C0,2);  VRD2(4); SBAR(); \
    KRD(GL,0); GAPB(o[0]=__builtin_amdgcn_mfma_f32_32x32x16_bf16(PAF(1),VFR(1),o[0],0,0,0), C0,4);  VRD2(1); SBAR(); \
    KRD(GL,1); GAPB(o[1]=__builtin_amdgcn_mfma_f32_32x32x16_bf16(PAF(1),VFR(5),o[1],0,0,0), C0,6);  VRD2(5); SBAR(); \
    KRD(GL,2); GAPB(o[0]=__builtin_amdgcn_mfma_f32_32x32x16_bf16(PAF(2),VFR(2),o[0],0,0,0), C0,8);  VRD2(2); SBAR(); \
    KRD(GL,3); GAPB(o[1]=__builtin_amdgcn_mfma_f32_32x32x16_bf16(PAF(2),VFR(6),o[1],0,0,0), C0,10); VRD2(6); SBAR(); \
    GAPB(o[0]=__builtin_amdgcn_mfma_f32_32x32x16_bf16(PAF(3),VFR(3),o[0],0,0,0), C0,12); VRD2(3); SBAR(); \
    GAPB(o[1]=__builtin_amdgcn_mfma_f32_32x32x16_bf16(PAF(3),VFR(7),o[1],0,0,0), C0,14); VRD2(7); SBAR(); \
    GAPB(o[2]=__builtin_amdgcn_mfma_f32_32x32x16_bf16(PAF(0),VFR(0),o[2],0,0,0), C1,0); \
    GAPB(o[3]=__builtin_amdgcn_mfma_f32_32x32x16_bf16(PAF(0),VFR(4),o[3],0,0,0), C1,2); \
    GAPB(o[2]=__builtin_amdgcn_mfma_f32_32x32x16_bf16(PAF(1),VFR(1),o[2],0,0,0), C1,4); \
    GAPB(o[3]=__builtin_amdgcn_mfma_f32_32x32x16_bf16(PAF(1),VFR(5),o[3],0,0,0), C1,6); \
    GAPB(o[2]=__builtin_amdgcn_mfma_f32_32x32x16_bf16(PAF(2),VFR(2),o[2],0,0,0), C1,8); \
    GAPB(o[3]=__builtin_amdgcn_mfma_f32_32x32x16_bf16(PAF(2),VFR(6),o[3],0,0,0), C1,10); \
    GAPB(o[2]=__builtin_amdgcn_mfma_f32_32x32x16_bf16(PAF(3),VFR(3),o[2],0,0,0), C1,12); \
    GAPB(o[3]=__builtin_amdgcn_mfma_f32_32x32x16_bf16(PAF(3),VFR(7),o[3],0,0,0), C1,14); \
    }while(0)
  int t=1;
  #undef CMASK
  #define CMASK(P0,P1,t) do{}while(0)
  for(;t+5<NT;t+=2){
    STEP(pB0,pB1,pA0,pA1,t,true,true,true);     WAIT_BAR(3); RESC(); ROT();
    STEP(pA0,pA1,pB0,pB1,t+1,true,true,true);   WAIT_BAR(3); RESC(); ROT();
  }
  #undef CMASK
  #define CMASK(P0,P1,t) do{int jb_=(t)-(NT-4); if(jb_>=0)cmask(P0,P1,jb_,qrel,hi);}while(0)
  #define ENDW(tt) do{ if((tt)+3<NT){WAIT_BAR(3);} else if((tt)+2<NT){WAIT_BAR(2);} else {WAIT_BAR(0);} }while(0)
  for(;t+1<NT;t+=2){
    STEP(pB0,pB1,pA0,pA1,t,(t+3<NT),(t+1<NT),(t+1<NT));       ENDW(t);   RESC(); ROT();
    STEP(pA0,pA1,pB0,pB1,t+1,(t+4<NT),(t+2<NT),(t+2<NT));     ENDW(t+1); RESC(); ROT();
  }
  STEP(pB0,pB1,pA0,pA1,NT-1,false,false,false); RESC();
  { float sacc=pB0[0]+pB0[1]; _Pragma("unroll") for(int r=2;r<16;++r)sacc+=pB0[r]; _Pragma("unroll") for(int r=0;r<16;++r)sacc+=pB1[r]; l_reg+=sacc;
    pw0=(u32x4){PKW(pB0,0),PKW(pB0,2),PKW(pB0,4),PKW(pB0,6)};pw1=(u32x4){PKW(pB0,8),PKW(pB0,10),PKW(pB0,12),PKW(pB0,14)};pw2=(u32x4){PKW(pB1,0),PKW(pB1,2),PKW(pB1,4),PKW(pB1,6)};pw3=(u32x4){PKW(pB1,8),PKW(pB1,10),PKW(pB1,12),PKW(pB1,14)};
    SBAR(); pv(o,vb0+2*sl_cur,PAF(0),PAF(1),PAF(2),PAF(3)); }
  #undef PKW
  #undef PAF
  #undef VFR
  #undef PIN
  #undef MX3
  #undef GAPA
  #undef GAPB
  #undef EX
  #undef VRD
  #undef VRD2
  #undef KRD
  #undef STEP
  #undef ENDW
  {auto rr=__builtin_amdgcn_permlane32_swap(__float_as_uint(l_reg),__float_as_uint(l_reg),false,false);l_reg=__uint_as_float(rr[0])+__uint_as_float(rr[1]);}
  if(hi==0)wsf[32+r32]=l_reg;asm volatile("s_waitcnt lgkmcnt(0)":::"memory");
  float rli[16];
  #pragma unroll
  for(int r=0;r<16;++r)rli[r]=__builtin_amdgcn_rcpf(wsf[32+crow(r,hi)]);
  bf16*Ow=O+(rowbase+q0+wid*QBLK)*DM+ocol;
  { bf16*stg=(bf16*)(shm+LDS_OST)+wid*2048;
    #pragma unroll
    for(int hv=0;hv<2;++hv){
      #pragma unroll
      for(int r=0;r<16;++r){const int orow=crow(r,hi);
        #pragma unroll
        for(int d0=0;d0<2;++d0)stg[orow*64+d0*32+r32]=__float2bfloat16(o[2*hv+d0][r]*rli[r]);}
      asm volatile("s_waitcnt lgkmcnt(0)":::"memory");
      #pragma unroll
      for(int i=0;i<4;++i){const int row=i*8+(lane>>3),ch=lane&7; const u32x4 v=*(const u32x4*)(stg+row*64+ch*8); ATTN_STORE16(Ow+(long)row*DM+hv*64+ch*8,v);}
      asm volatile("s_waitcnt lgkmcnt(0)":::"memory"); } }
  asm volatile("s_waitcnt lgkmcnt(0)\n\ts_barrier":::"memory");
  #undef DMA_K
  #undef DMA_V
  #undef CMASK
  #undef START
  #undef RESC
  #undef ROT
}
constexpr int ATTN_LDS_BYTES=ALDS_BYTES;

#undef SBAR
#undef WAIT_BAR
#undef ATTN_STORE16
}
constexpr size_t WS_ATT0 = WS_ACT, WS_ATT1 = WS_ACT + 32 * MiB;

__device__ __forceinline__ void diff_combine(const Params& P, int b, int h, int qb) {
    int tid_ = threadIdx.x; asm volatile("" : "+v"(tid_));
    const int tid = tid_, lane = tid & 63, wid = tid >> 6;
    const float lam = __expf(wave_sum(P.in[I_LQ1][lane] * P.in[I_LK1][lane])) - __expf(wave_sum(P.in[I_LQ2][lane] * P.in[I_LK2][lane])) + 0.2f;
    const int ch = lane & 15;
    const f32x4 g0 = *(const f32x4*)(P.in[I_SG] + 8 * ch), g1 = *(const f32x4*)(P.in[I_SG] + 8 * ch + 4);
    const size_t row0 = (size_t)b * SEQ + qb * 256 + wid * 32 + (lane >> 4);
    const bf16_t* s0 = (const bf16_t*)(P.ws + WS_ATT0) + row0 * D + h * 128 + 8 * ch; const bf16_t* s1 = (const bf16_t*)(P.ws + WS_ATT1) + row0 * D + h * 128 + 8 * ch;
    bf16_t* dst = (bf16_t*)(P.ws + WS_MA) + row0 * MA_LD + h * 128 + 8 * ch;
#pragma unroll
    for (int it = 0; it < 8; ++it) {
        f32x4 a0, a1, b0, b1; pg::unpack8(*(const u32x4*)(s0 + (size_t)(4 * it) * D), a0, a1); pg::unpack8(*(const u32x4*)(s1 + (size_t)(4 * it) * D), b0, b1);
        const f32x4 o0 = a0 - lam * b0, o1 = a1 - lam * b1;
        float ss = (o0[0] * o0[0] + o0[1] * o0[1]) + (o0[2] * o0[2] + o0[3] * o0[3]) + (o1[0] * o1[0] + o1[1] * o1[1]) + (o1[2] * o1[2] + o1[3] * o1[3]);
        ss += __shfl_xor(ss, 1); ss += __shfl_xor(ss, 2); ss += __shfl_xor(ss, 4); ss += __shfl_xor(ss, 8);
        const float r = rsqrtf(ss * (1.f / 128.f) + EPS) * 0.8f;
        *(u32x4*)(dst + (size_t)(4 * it) * MA_LD) = pg::pack8(o0 * r * g0, o1 * r * g1);
    }
}
__device__ __forceinline__ void attn_phase(const Params& P, char* lds, int vcu, int G) {
    using attn_body::bf16;
    const bf16* Q = (const bf16*)(P.ws + WS_Q); const bf16* K = (const bf16*)(P.ws + WS_K); const bf16* V = (const bf16*)(P.ws + WS_V);
    for (int v = vcu; v < 256; v += G) {
        const int bh = v >> 2, b = bh >> 3, h = bh & 7, s = v & 3;
        for (int i = 0; i < 2; ++i) { const int qb = i == 0 ? 7 - s : s;
#ifndef ATTN_V128
#define ATTN_V128 1
#endif
#if ATTN_V128
            for (int m = 0; m < 2; ++m) {
#if EXPERTS_IN_ATTN
#ifndef CONV_SLOTS
#define CONV_SLOTS 4
#endif
#ifndef CONV_SPLIT
#define CONV_SPLIT 1
#endif
                if (CONV_SLOTS == 2 ? (i == 0 && m == ((v >> 2) & 1)) : ((i * 2 + m - (((v >> 2) + v) & 3)) & (CONV_SPLIT == 2 ? 1 : 3)) == 0) {
                    constexpr int per = (EXP_M10 - EXP_ATT0) / 256; const int hsel = CONV_SPLIT == 2 ? (((i * 2 + m - (((v >> 2) + v) & 3)) >> 1) & 1) : 0;
                    expert_convert_slice(P, (LAS unsigned char*)lds, EXP_ATT0 + v * per + hsel * (per / 2), CONV_SPLIT == 2 ? EXP_ATT0 + v * per + (hsel + 1) * (per / 2) : EXP_ATT0 + (v + 1) * per);
#if defined(PROBE_CONV2)
                    asm volatile("s_waitcnt vmcnt(0) lgkmcnt(0)" ::: "memory"); __syncthreads(); expert_convert_slice(P, (LAS unsigned char*)lds, EXP_ATT0 + v * per, EXP_ATT0 + (v + 1) * per, true);
#endif
                    asm volatile("s_waitcnt vmcnt(0) lgkmcnt(0)" ::: "memory"); __syncthreads(); }
#endif
                attn128::attn_unit<8>(b, h * 128 + m * 64, h * 128 + m * 64, h * 128, h * 128, qb, (const attn128::bf16*)Q, (const attn128::bf16*)K, (const attn128::bf16*)V, (attn128::bf16*)(P.ws + (m == 0 ? WS_ATT0 : WS_ATT1)), lds); }
#else
            for (int pass = 0; pass < 4; ++pass) { const int m = pass >> 1, vh = pass & 1;
#if EXPERTS_IN_ATTN
                if (i * 4 + pass == (((v >> 2) + v) & 3)) {
                    constexpr int per = (EXP_M10 - EXP_ATT0) / 256; expert_convert_slice(P, (LAS unsigned char*)lds, EXP_ATT0 + v * per, EXP_ATT0 + (v + 1) * per);
                    asm volatile("s_waitcnt vmcnt(0) lgkmcnt(0)" ::: "memory"); __syncthreads(); }
#endif
                attn_body::attn_unit<8>(b, h * 128 + m * 64, h * 128 + m * 64, h * 128 + vh * 64, h * 128 + vh * 64, qb, Q, K, V, (bf16*)(P.ws + (m == 0 ? WS_ATT0 : WS_ATT1)), lds); }
#endif
            asm volatile("s_waitcnt vmcnt(0)" ::: "memory");
            diff_combine(P, b, h, qb);
        }
    }
}

__device__ __forceinline__ void ssm1_phase(const Params& P, LAS unsigned char* lds, int vcu, int G) {
    const int tid = opaque_tid(), lane = tid & 63, wid = __builtin_amdgcn_readfirstlane(tid >> 6), fr = lane & 15, fq = lane >> 4;
    LAS float* Sl = (LAS float*)lds;
    for (int u = vcu; u < SSM_G * BATCH; u += G) {
        const int g = u >> 3, b = u & 7;
        bf16_t* A = (bf16_t*)(P.ws + WS_ACAT) + (size_t)(g * ACAT_ROWS + b * NCH) * ACAT_LD;
        const bf16_t* Bw = (const bf16_t*)(P.ws + WS_WS_T) + (size_t)(g * 128 + 16 * wid + fr) * 512 + fq * 8;
        f32x4 acc[4];
#pragma unroll
        for (int m = 0; m < 4; ++m) acc[m] = (f32x4){0.f, 0.f, 0.f, 0.f};
#pragma unroll 4
        for (int ks = 0; ks < 16; ++ks) {
            const bf16x8 bf = *(const bf16x8*)(Bw + ks * 32);
#pragma unroll
            for (int m = 0; m < 4; ++m) { const bf16x8 af = *(const bf16x8*)(A + (size_t)(16 * m + fr) * ACAT_LD + ks * 32 + fq * 8);
                acc[m] = __builtin_amdgcn_mfma_f32_16x16x32_bf16(af, bf, acc[m], 0, 0, 0); }
        }
#pragma unroll
        for (int m = 0; m < 4; ++m)
#pragma unroll
            for (int q = 0; q < 4; ++q) Sl[(16 * m + 4 * fq + q) * 129 + 16 * wid + fr] = acc[m][q];
        __syncthreads();
        if (tid < SSM_P) {
            const int p = tid; const SsmGP gp = ssm_gp(P, g, p); float aLr, aLi; ssm_pow(gp, CH_L, aLr, aLi);
            float xr = 0.f, xi = 0.f;
            bf16_t* xp = A + 512 + p;
            for (int c = 0; c < NCH; ++c) {
                xp[(size_t)c * ACAT_LD] = (bf16_t)f2bf(xr); xp[(size_t)c * ACAT_LD + 64] = (bf16_t)f2bf(xi);
                const float sr = Sl[c * 129 + p], si = Sl[c * 129 + 64 + p];
                const float nr = aLr * xr - aLi * xi + sr, ni = aLr * xi + aLi * xr + si; xr = nr; xi = ni;
            }
        }
        __syncthreads();
    }
}
namespace pg {
struct Ssm2Sched {
    unsigned char* ws; int G, c;
    __device__ __forceinline__ void init(unsigned char* ws_, int G_, int c_) { ws = ws_; G = G_; c = c_; }
    __device__ __forceinline__ bool next(int i, Unit& u) const {
        const int L = i * G + c; if (L >= SSM_G * 4) return false;
        const int g = L >> 2; u.pm = (L >> 1) & 1; u.pn = L & 1; u.aux = g; u.aux2 = 0; u.ord = i; const LaneRC rc;
        u.A = (const char*)((const bf16_t*)(ws + WS_ACAT) + (size_t)g * ACAT_ROWS * ACAT_LD); u.B = (const char*)((const bf16_t*)(ws + WS_BT_SSM) + ((size_t)g * 512 + u.pn * BM) * ACAT_LD);
#pragma unroll
        for (int h = 0; h < 2; ++h)
#pragma unroll
            for (int j = 0; j < 2; ++j) u.aoff[h][j] = (unsigned)(((u.pm * BM + 128 * h + rc.R[j]) * ACAT_LD + rc.C[j]) * 2);
        return true;
    }
};
}

constexpr int RT_LG_OFF = RING_BYTES + 2048;
constexpr int RT_HIST_OFF = RT_LG_OFF + 64 * 33 * 4;
__device__ __forceinline__ void router_phase(const Params& P, LAS unsigned char* lds, int vcu, int G) {
    const int tid = opaque_tid(), lane = tid & 63, wid = __builtin_amdgcn_readfirstlane(tid >> 6);
    const float* wrt = (const float*)(P.ws + WS_WR_T);
#pragma unroll 4
    for (int i = 0; i < 16; ++i) ((LAS f32x4*)lds)[tid + NTHREADS * i] = ((const f32x4*)wrt)[tid + NTHREADS * i];
    LAS float* lg = (LAS float*)(lds + RT_LG_OFF); LAS int* hist = (LAS int*)(lds + RT_HIST_OFF);
    unsigned* cnt = (unsigned*)(P.ws + WS_CTL) + CW_CNT;
    int* slot_tok = (int*)(P.ws + WS_SLOT_TOK); float* slot_gate = (float*)(P.ws + WS_SLOT_GATE); int* tok_ep = (int*)(P.ws + WS_TOK_EP);
    unsigned char* H2 = P.ws + WS_H2;
    f32x4 g2v[4];
#pragma unroll
    for (int j = 0; j < 4; ++j) g2v[j] = ((const f32x4*)P.in[I_G2])[lane + 64 * j];
    for (int tb = vcu; tb < T / 64; tb += G) {
        if (tid < 64) hist[tid] = 0;
        __syncthreads();
        f32x4 n0[4], n1[4];
#pragma unroll
        for (int j = 0; j < 4; ++j) { const int tn = tb * 64 + wid * 8; n0[j] = NT_LOAD((const f32x4*)((const float*)(P.ws + WS_X1) + (size_t)tn * D) + lane + 64 * j); n1[j] = NT_LOAD((const f32x4*)((const float*)(P.ws + WS_X1) + (size_t)(tn + 1) * D) + lane + 64 * j); }
        for (int pass = 0; pass < 4; ++pass) {
            const int t0 = tb * 64 + wid * 8 + pass * 2;
            f32x4 h0[4], h1[4]; float s0 = 0.f, s1 = 0.f;
#pragma unroll
            for (int j = 0; j < 4; ++j) { h0[j] = n0[j]; h1[j] = n1[j]; }
#pragma unroll
            for (int j = 0; j < 4; ++j) { const int tn = tb * 64 + wid * 8 + min(pass + 1, 3) * 2; n0[j] = NT_LOAD((const f32x4*)((const float*)(P.ws + WS_X1) + (size_t)tn * D) + lane + 64 * j); n1[j] = NT_LOAD((const f32x4*)((const float*)(P.ws + WS_X1) + (size_t)(tn + 1) * D) + lane + 64 * j); }
#pragma unroll
            for (int j = 0; j < 4; ++j) {
                s0 += (h0[j].x * h0[j].x + h0[j].y * h0[j].y) + (h0[j].z * h0[j].z + h0[j].w * h0[j].w); s1 += (h1[j].x * h1[j].x + h1[j].y * h1[j].y) + (h1[j].z * h1[j].z + h1[j].w * h1[j].w); }
            const float r0 = rsqrtf(wave_sum(s0) * (1.f / D) + EPS), r1 = rsqrtf(wave_sum(s1) * (1.f / D) + EPS);
#pragma unroll
            for (int j = 0; j < 4; ++j) { h0[j] = h0[j] * r0 * g2v[j]; h1[j] = h1[j] * r1 * g2v[j];
                ((unsigned*)(H2 + (size_t)t0 * D))[lane + 64 * j] = pk4_fp8(h0[j].x, h0[j].y, h0[j].z, h0[j].w);
                ((unsigned*)(H2 + (size_t)(t0 + 1) * D))[lane + 64 * j] = pk4_fp8(h1[j].x, h1[j].y, h1[j].z, h1[j].w); }
            float v[64];
#pragma unroll
            for (int e = 0; e < NE; ++e) { float a0 = 0.f, a1 = 0.f;
#pragma unroll
                for (int j = 0; j < 4; ++j) { const f32x4 w = ((const LAS f32x4*)(lds + e * 4096))[lane + 64 * j];
                    a0 += (h0[j].x * w.x + h0[j].y * w.y) + (h0[j].z * w.z + h0[j].w * w.w); a1 += (h1[j].x * w.x + h1[j].y * w.y) + (h1[j].z * w.z + h1[j].w * w.w); }
                v[e] = a0; v[32 + e] = a1; }
#pragma unroll
            for (int half = 32; half >= 1; half >>= 1) { const bool upper = (lane & half) != 0;
#pragma unroll
                for (int i = 0; i < half; ++i) { const float send = upper ? v[i] : v[i + half], keep = upper ? v[i + half] : v[i]; v[i] = keep + __shfl_xor(send, half); } }
            lg[(wid * 8 + pass * 2 + (lane >> 5)) * 33 + (lane & 31)] = v[0] + P.in[I_BR][lane & 31];
        }
        __syncthreads();
        if (wid == 0) {
            const int tok = tb * 64 + lane;
            float tv[4]; int ti[4];
#pragma unroll
            for (int k = 0; k < 4; ++k) { tv[k] = -INFINITY; ti[k] = 0; }
            for (int e = 0; e < NE; ++e) { const float x = lg[lane * 33 + e];
                if (x > tv[3]) { if (x > tv[2]) { tv[3] = tv[2]; ti[3] = ti[2]; if (x > tv[1]) { tv[2] = tv[1]; ti[2] = ti[1]; if (x > tv[0]) { tv[1] = tv[0]; ti[1] = ti[0]; tv[0] = x; ti[0] = e; } else { tv[1] = x; ti[1] = e; } } else { tv[2] = x; ti[2] = e; } } else { tv[3] = x; ti[3] = e; } } }
            const float e1 = __expf(tv[1] - tv[0]), e2 = __expf(tv[2] - tv[0]), e3 = __expf(tv[3] - tv[0]); const float inv = 1.f / (1.f + e1 + e2 + e3);
            const float gk[4] = {inv, e1 * inv, e2 * inv, e3 * inv};
            int lp[4];
#pragma unroll
            for (int k = 0; k < 4; ++k) lp[k] = atomicAdd((int*)&hist[ti[k]], 1);
            asm volatile("s_waitcnt lgkmcnt(0)" ::: "memory");
            if (lane < NE) { const int n = hist[lane]; hist[32 + lane] = n ? (int)atomicAdd(&cnt[lane], (unsigned)n) : 0; }
            asm volatile("s_waitcnt vmcnt(0) lgkmcnt(0)" ::: "memory");
#pragma unroll
            for (int k = 0; k < 4; ++k) { const int e = ti[k], pos = hist[32 + e] + lp[k];
                slot_tok[(size_t)e * CAP + pos] = tok; slot_gate[(size_t)e * CAP + pos] = gk[k]; tok_ep[tok * 4 + k] = (e << 16) | pos; }
        }
        __syncthreads();
    }
}

#ifndef COMB_Y_DEFAULT
#define COMB_Y_LOAD(p) NT_LOAD(p)
#else
#define COMB_Y_LOAD(p) (*(p))
#endif
__device__ __forceinline__ void combine_phase(const Params& P, LAS unsigned char* lds, int vcu, int G) {
    const int tid = opaque_tid(), lane = tid & 63, wid = __builtin_amdgcn_readfirstlane(tid >> 6);
    const LAS int* tab = (const LAS int*)(lds + pg::TAB_OFF);
    const int* tok_ep = (const int*)(P.ws + WS_TOK_EP); const bf16_t* Y = (const bf16_t*)(P.ws + WS_Y); const float* sgate = (const float*)(P.ws + WS_SLOT_GATE);
    for (int tok = vcu * NWAVES + wid; tok < T; tok += G * NWAVES) {
        f32x4 a[4];
#pragma unroll
        for (int j = 0; j < 4; ++j) a[j] = NT_LOAD((const f32x4*)((const float*)(P.ws + WS_X1) + (size_t)tok * D) + lane + 64 * j);
#pragma unroll
        for (int k = 0; k < 4; ++k) { const int ep = tok_ep[tok * 4 + k]; const int slot = tab[ep >> 16] * 256 + (ep & 0xffff); const float gk = sgate[(size_t)(ep >> 16) * CAP + (ep & 0xffff)];
#pragma unroll
            for (int j = 0; j < 4; ++j) { const u32x2 w = COMB_Y_LOAD((const u32x2*)(Y + (size_t)slot * D) + lane + 64 * j); a[j] += gk * (f32x4){bflo(w.x), bfhi(w.x), bflo(w.y), bfhi(w.y)}; } }
#pragma unroll
        for (int j = 0; j < 4; ++j) NT_STORE(a[j], (f32x4*)(P.out + (size_t)tok * D) + lane + 64 * j);
    }
}
#define XB_TMO      128
#define XB_XCNT(j)  (256  + 64 * (j))
#define XB_XSUB(j)  (1280 + 64 * (j))
#define XB_XGEN(j)  (2304 + 64 * (j))
#define XB_TOP      3328
#define XB_TOPGEN   3392
#define XCD_BAR_WORDS 3456
#define XB_SPIN_CAP (1u << 18)
__device__ __forceinline__ unsigned xb_ld(unsigned* p)              { return __hip_atomic_load(p, __ATOMIC_RELAXED, __HIP_MEMORY_SCOPE_AGENT); }
__device__ __forceinline__ unsigned xb_add(unsigned* p, unsigned v) { return __hip_atomic_fetch_add(p, v, __ATOMIC_RELAXED, __HIP_MEMORY_SCOPE_AGENT); }
__device__ __forceinline__ unsigned xb_xcc_id() { return (unsigned)__builtin_amdgcn_s_getreg((3 << 11) | 20) & 0xFu; }
#define XB_SPIN(cond, bar) do { unsigned _sp = 0; while (cond) { __builtin_amdgcn_s_sleep(1); \
    if ((++_sp & 255u) == 0u) { if (xb_ld(&(bar)[XB_TMO])) break; if (_sp > XB_SPIN_CAP) { atomicAdd(&(bar)[XB_TMO], 1u); break; } } } } while (0)
struct XcdBarrier { unsigned* bar; unsigned x; volatile LAS unsigned* st; };
__device__ __forceinline__ XcdBarrier xcd_barrier_post(unsigned* bar, volatile LAS unsigned* st) {
    XcdBarrier b; b.bar = bar; b.x = xb_xcc_id(); b.st = st;
    if (threadIdx.x == 0) (void)xb_add(&bar[XB_XCNT(b.x)], 1u);
    return b;
}
__device__ __forceinline__ void xcd_barrier_complete(unsigned* bar, unsigned x, unsigned& nloc, unsigned& nx) {
    const unsigned G = gridDim.x * gridDim.y * gridDim.z;
    unsigned sum, cnt, mine, sp = 0u;
    for (;;) {
        sum = 0u; cnt = 0u; mine = 0u;
#pragma unroll
        for (unsigned j = 0; j < 16; ++j) { const unsigned c = xb_ld(&bar[XB_XCNT(j)]); sum += c; cnt += (c > 0u) ? 1u : 0u; mine = (j == x) ? c : mine; }
        if (sum == G) break;
        __builtin_amdgcn_s_sleep(1);
        if ((++sp & 255u) == 0u) { if (xb_ld(&bar[XB_TMO])) break; if (sp > XB_SPIN_CAP) { atomicAdd(&bar[XB_TMO], 1u); break; } }
    }
    nloc = mine > 0u ? mine : 1u; nx = cnt > 0u ? cnt : 1u;
}
__device__ __forceinline__ void xcd_barrier(const XcdBarrier& b) {
    asm volatile("s_waitcnt vmcnt(0)" ::: "memory");
    __syncthreads();
    if (threadIdx.x == 0) {
        unsigned* bar = b.bar;
        __builtin_amdgcn_s_waitcnt(0);
        unsigned nloc = b.st[0], nx = b.st[1];
        if (nloc == 0u) { xcd_barrier_complete(bar, b.x, nloc, nx); b.st[0] = nloc; b.st[1] = nx; }
        const unsigned old = xb_add(&bar[XB_XSUB(b.x)], 1u);
        const unsigned gen = old / nloc;
        if (old + 1u == (gen + 1u) * nloc) {
            __builtin_amdgcn_fence(__ATOMIC_RELEASE, "agent");
            asm volatile("s_waitcnt vmcnt(0)" ::: "memory");
            const unsigned og = xb_add(&bar[XB_TOP], 1u);
            const unsigned tg = og / nx;
            if (og + 1u == (tg + 1u) * nx) xb_add(&bar[XB_TOPGEN], 1u);
            else XB_SPIN(xb_ld(&bar[XB_TOPGEN]) == tg, bar);
            __builtin_amdgcn_fence(__ATOMIC_ACQUIRE, "agent");
            xb_add(&bar[XB_XGEN(b.x)], 1u);
            asm volatile("s_waitcnt vmcnt(0)" ::: "memory");
        } else {
            XB_SPIN(xb_ld(&bar[XB_XGEN(b.x)]) == gen, bar);
            __builtin_amdgcn_fence(__ATOMIC_ACQUIRE, "agent");
            asm volatile("s_waitcnt vmcnt(0)" ::: "memory");
        }
    }
    __syncthreads();
}
#ifndef PH_MASK
#define PH_MASK 0xffffffffu
#endif
__global__ void __launch_bounds__(NTHREADS, 2) mega_fwd(Params P) {
    extern __shared__ __attribute__((aligned(16))) unsigned char lds_[];
    LAS unsigned char* lds = (LAS unsigned char*)lds_;
    const int tid = threadIdx.x;
    const int G = gridDim.x, bx = blockIdx.x, vcu = (G % 8 == 0) ? (bx % 8) * (G / 8) + bx / 8 : bx;
    for (int u = tid; u < (LDS_BYTES - RING_BYTES) / 4; u += NTHREADS) ((LAS unsigned*)(lds + RING_BYTES))[u] = 0u;
    __syncthreads();
    unsigned* ctl = (unsigned*)(P.ws + WS_CTL);
    const XcdBarrier bar = xcd_barrier_post(ctl + CW_BAR, (volatile LAS unsigned*)(lds + MISC_OFF) + 8);
#ifndef PH_REP
#define PH_REP 0u
#endif
#ifndef BAR_REP
#define BAR_REP 1
#endif
#define GRID_BAR() do { for (int b_ = 0; b_ < BAR_REP; ++b_) xcd_barrier(bar); } while (0)
#define ON(k) for (int r_ = 0; r_ < 1 + (int)((PH_REP >> (k)) & 1u); ++r_) if ((PH_MASK >> (k)) & 1u)
#ifndef FWD_REP
#define FWD_REP 1
#endif
    for (int fwd_ = 0; fwd_ < FWD_REP; ++fwd_) {
    if (fwd_ > 0) { GRID_BAR(); if (bx == 0 && tid < 64) ctl[CW_CNT + tid] = 0u; }
    ON(0) p0_prologue(P, lds, vcu, G);
    GRID_BAR();
    ON(1) { pg::DenseSched S; S.init((const bf16_t*)(P.ws + WS_XN), D, (const bf16_t*)(P.ws + WS_WIN_T), D, T, IN_W, G, bx);
        pg::EpiInProj E; E.ws = P.ws; E.qg = P.in[I_QG]; E.kg = P.in[I_KG];
#if defined(PROBE_NULL_EPI)
        if (r_ == 1) { pg::EpiNull EN; pg::gemm_phase(lds, S, EN, D / 64, D); } else
#endif
#ifndef INPROJ_BAUX
#define INPROJ_BAUX 0
#endif
        pg::gemm_phase<false, INPROJ_BAUX>(lds, S, E, D / 64, D);
#if EXPERTS_IN_ATTN
        if (r_ == 0 && G == 256 && bx >= 128) expert_convert_slice(P, lds, EXP_IN0 + (bx - 128) * EXP_N_IN, EXP_IN0 + (bx - 127) * EXP_N_IN);
        __syncthreads();
#endif
    }
    GRID_BAR();
    ON(2) { ssm_toeplitz_expand(P, vcu, G); ssm1_phase(P, lds, vcu, G); }
    ON(3) attn_phase(P, (char*)lds_, vcu, G);
    GRID_BAR();
    ON(4) { pg::Ssm2Sched S; S.init(P.ws, G, bx); pg::EpiSsm2 E; E.ws = P.ws; pg::gemm_phase(lds, S, E, ACAT_LD / 64, ACAT_LD);
#if EXPERTS_IN_ATTN
        if (r_ == 0 && G == 256 && bx >= 128) expert_convert_slice(P, lds, EXP_S20 + (bx - 128) * EXP_N_S2, EXP_S20 + (bx - 127) * EXP_N_S2);
        __syncthreads();
#endif
    }
    GRID_BAR();
    ON(5) { pg::DenseSched S; S.init((const bf16_t*)(P.ws + WS_Z), SSM_W, (const bf16_t*)(P.ws + WS_WGLU_T), SSM_W, T, SSM_W, G, bx);
        pg::EpiGlu E; E.ws = P.ws; E.bglu = P.in[I_BGLU]; pg::gemm_phase(lds, S, E, SSM_W / 64, SSM_W);
#if EXPERTS_IN_ATTN
        if (r_ == 0 && G == 256 && bx >= 128) expert_convert_slice(P, lds, EXP_GLU0 + (bx - 128) * EXP_N_GLU, EXP_GLU0 + (bx - 127) * EXP_N_GLU);
        __syncthreads();
#endif
    }
    GRID_BAR();
    ON(6) { pg::DenseSched S; S.init((const bf16_t*)(P.ws + WS_MA), MA_LD, (const bf16_t*)(P.ws + WS_WP_T), MA_LD, T, D, G, bx);
        pg::EpiMerged E; E.ws = P.ws; pg::gemm_phase(lds, S, E, MA_LD / 64, MA_LD); }
    GRID_BAR();
    ON(7) { pg::DenseSched S; S.init((const bf16_t*)(P.ws + WS_MERGED), D, (const bf16_t*)(P.ws + WS_WOUT_T), D, T, D, G, bx);
        pg::EpiWout E; E.x = P.in[I_X]; E.out = (float*)(P.ws + WS_X1); pg::gemm_phase(lds, S, E, D / 64, D); }
    GRID_BAR();
    ON(8) router_phase(P, lds, vcu, G);
    GRID_BAR();
    pg::moe_build_tab(lds, (const unsigned*)(P.ws + WS_CTL) + CW_CNT);
    ON(9) { pg::MoeSched<1> S; S.init(P.ws, lds, G, bx, P.in[I_B1]); pg::EpiMoe1 E; E.ws = P.ws; E.b1 = P.in[I_B1]; E.lds = lds; E.nostore = (r_ == 1);
#if defined(PROBE_MOE_NT)
        if (r_ == 1) { pg::EpiNull EN; pg::gemm_phase<true>(lds, S, EN, PROBE_MOE_NT, D / 2, 7); } else
#endif
        pg::gemm_phase<true>(lds, S, E, D / 128, D / 2);
#if EXPERTS_IN_ATTN
        if (r_ == 0 && G == 256 && (bx >> 3) >= 16) { const int k_ = (bx & 7) * 16 + (bx >> 3) - 16; expert_convert_slice(P, lds, EXP_M10 + k_ * EXP_N_M1, EXP_M10 + (k_ + 1) * EXP_N_M1); }
        __syncthreads();
#endif
    }
    GRID_BAR();
    ON(10) { pg::MoeSched<2> S; S.init(P.ws, lds, G, bx, P.in[I_B2]);
#if defined(PROBE_FREEZE)
        S.freeze = (r_ == 1);
#endif
 pg::EpiMoe2 E; E.ws = P.ws; E.b2 = P.in[I_B2]; E.lds = lds; E.nostore = (r_ == 1);
#if defined(PROBE_MOE_NT)
        if (r_ == 1) { pg::EpiNull EN; pg::gemm_phase<true>(lds, S, EN, PROBE_MOE_NT, DFF / 2, 7); } else
#endif
        pg::gemm_phase<true>(lds, S, E, DFF / 128, DFF / 2); }
    GRID_BAR();
    ON(11) combine_phase(P, lds, vcu, G);
    }
#undef ON
}

extern "C" void kernel_launch(void* const* d_in, const int* in_sizes, int n_in, void* d_out, int out_size, void* d_ws, size_t ws_size, hipStream_t stream) {
    static int grid = 0;
    if (grid == 0) {
        int dev = 0, cus = 0, per_cu = 0;
        if (hipGetDevice(&dev) != hipSuccess || hipDeviceGetAttribute(&cus, hipDeviceAttributeMultiprocessorCount, dev) != hipSuccess) { fprintf(stderr, "kernel_launch: device query failed\n"); grid = -1; return; }
        if (hipFuncSetAttribute((const void*)mega_fwd, hipFuncAttributeMaxDynamicSharedMemorySize, LDS_BYTES) != hipSuccess) { fprintf(stderr, "kernel_launch: hipFuncSetAttribute failed\n"); grid = -1; return; }
        if (hipOccupancyMaxActiveBlocksPerMultiprocessor(&per_cu, (const void*)mega_fwd, NTHREADS, LDS_BYTES) != hipSuccess || per_cu < 1) { fprintf(stderr, "kernel_launch: occupancy query reports %d workgroups per CU\n", per_cu); per_cu = 1; }
        (void)hipGetLastError();
        grid = cus;
        if (ws_size < WS_END) { fprintf(stderr, "kernel_launch: workspace too small\n"); grid = -1; return; }
    }
    if (grid < 0) return;
    hipMemsetAsync((char*)d_ws + WS_CTL, 0, CTL_ZERO_BYTES, stream);
    Params P{};
    for (int i = 0; i < 30; ++i) P.in[i] = (const float*)d_in[i];
    P.out = (float*)d_out; P.ws = (unsigned char*)d_ws;
    hipLaunchKernelGGL(mega_fwd, dim3(grid), dim3(NTHREADS), LDS_BYTES, stream, P);
#if defined(PROBE_TWO_LAUNCHES)
    hipMemsetAsync((char*)d_ws + WS_CTL, 0, CTL_ZERO_BYTES, stream);
    hipLaunchKernelGGL(mega_fwd, dim3(grid), dim3(NTHREADS), LDS_BYTES, stream, P);
#endif
}
```

```cpp
#include <hip/hip_runtime.h>
#include <hip/hip_bf16.h>
#include <stdint.h>
#include <math.h>
#include <cstdio>

constexpr int D = 1024, BATCH = 8, SEQ = 2048, T = BATCH * SEQ;
constexpr int SSM_W = 512, SSM_H = 16, SSM_G = 32, SSM_P = 64;
constexpr int CH_L = 32, NCH = SEQ / CH_L;
constexpr int ACAT_ROWS = BATCH * NCH;
constexpr int ACAT_LD = CH_L * SSM_H + 2 * SSM_P;
constexpr int AH = 8, AW = 1024;
constexpr int IN_W = 5632;
constexpr int NE = 32, DFF = 1024;
constexpr float EPS = 1e-5f;
constexpr int OFF_U = 0, OFF_Q = 512, OFF_K = 1536, OFF_V = 2560, OFF_GS = 3584, OFF_GA = 4608;
constexpr int CAP = T;
constexpr int MAXBLK = 288;
constexpr float QC2 = 0.125f * 1.4426950408889634f;
constexpr int MA_LD = 1536;

constexpr size_t MiB = 1u << 20;
constexpr size_t WS_CTL = 0, CTL_ZERO_BYTES = 64 * 1024;
constexpr size_t WS_WIN_T = 2 * MiB;
constexpr size_t WS_WGLU_T = 13 * MiB;
constexpr size_t WS_WP_T = 14 * MiB;
constexpr size_t WS_WOUT_T = 17 * MiB;
constexpr size_t WS_WR_T = 19 * MiB;
constexpr size_t WS_KJ = 21 * MiB;
constexpr size_t WS_WS_T = 22 * MiB;
constexpr size_t WS_BT_SSM = 26 * MiB;
constexpr size_t WS_W1_T = 48 * MiB;
constexpr size_t WS_W2_T = 176 * MiB;
constexpr size_t WS_XN = 240 * MiB;
constexpr size_t WS_ACAT = 272 * MiB;
constexpr size_t WS_Q = 292 * MiB, WS_K = 324 * MiB, WS_V = 356 * MiB;
constexpr size_t WS_GS = 388 * MiB, WS_GA = 420 * MiB;
constexpr size_t WS_X1 = 292 * MiB;
constexpr size_t WS_Z = 452 * MiB;
constexpr size_t WS_MA = 468 * MiB;
constexpr size_t WS_MERGED = 516 * MiB;
constexpr size_t WS_H2 = 548 * MiB;
constexpr size_t WS_SLOT_TOK = 582 * MiB;
constexpr size_t WS_SLOT_GATE = 584 * MiB;
constexpr size_t WS_TOK_EP = 586 * MiB;
constexpr size_t WS_ACT = 588 * MiB;
constexpr size_t WS_Y = 732 * MiB;
constexpr size_t WS_END = 876 * MiB;
constexpr int CW_CNT = 64;
constexpr int CW_BAR = 4096;

typedef unsigned short bf16_t;
typedef short bf16x8 __attribute__((ext_vector_type(8)));
typedef float f32x4 __attribute__((ext_vector_type(4)));
typedef float f32x2 __attribute__((ext_vector_type(2)));
typedef unsigned u32x4 __attribute__((ext_vector_type(4)));
typedef unsigned u32x2 __attribute__((ext_vector_type(2)));
#define LAS __attribute__((address_space(3)))
#define GAS __attribute__((address_space(1)))

__device__ __forceinline__ float wave_sum(float v) {
#pragma unroll
    for (int o = 1; o < 64; o <<= 1) v += __shfl_xor(v, o);
    return v;
}
typedef __bf16 bf16x2_hw __attribute__((ext_vector_type(2)));
__device__ __forceinline__ unsigned pk2(float lo, float hi) { const f32x2 v = {lo, hi}; return __builtin_bit_cast(unsigned, __builtin_convertvector(v, bf16x2_hw)); }
__device__ __forceinline__ unsigned f2bf(float f) { return pk2(f, 0.f) & 0xffffu; }
__device__ __forceinline__ float bf2f(unsigned short b) { return __builtin_bit_cast(float, (unsigned)b << 16); }
__device__ __forceinline__ float bflo(unsigned w) { return __builtin_bit_cast(float, w << 16); }
__device__ __forceinline__ float bfhi(unsigned w) { return __builtin_bit_cast(float, w & 0xffff0000u); }
__device__ __forceinline__ float sigmoid_f(float x) { return __builtin_amdgcn_rcpf(1.f + __expf(-x)); }
__device__ __forceinline__ float sigmoid_c(float x) { x = fminf(fmaxf(x, -30.f), 30.f); return __builtin_amdgcn_rcpf(1.f + __expf(-x)); }
__device__ __forceinline__ float gelu_tanh(float x) { const float u = 0.7978845608028654f * (x + 0.044715f * x * x * x); return x * sigmoid_f(2.f * u); }

__device__ __forceinline__ unsigned pk4_fp8(float a, float b, float cc, float d) { int w = 0; w = __builtin_amdgcn_cvt_pk_fp8_f32(a, b, w, false); w = __builtin_amdgcn_cvt_pk_fp8_f32(cc, d, w, true); return (unsigned)w; }
__device__ __forceinline__ void unpk4_fp8(unsigned w, float& a, float& b, float& cc, float& d) { const f32x2 lo = __builtin_amdgcn_cvt_pk_f32_fp8((int)w, false), hi = __builtin_amdgcn_cvt_pk_f32_fp8((int)w, true); a = lo.x; b = lo.y; cc = hi.x; d = hi.y; }
constexpr float W8_SCALE = 64.f;
#ifndef WT_STORES
#define WT_STORES 0
#endif
__device__ __forceinline__ void store16(void* p, const u32x4 v) {
#if WT_STORES
    asm volatile("global_store_dwordx4 %0, %1, off sc1\n\ts_nop 1" :: "v"(p), "v"(v) : "memory");
#else
    *(u32x4*)p = v;
#endif
}
#ifndef NT_STREAMS
#define NT_STREAMS 1
#endif
#if NT_STREAMS
#define NT_LOAD(p) __builtin_nontemporal_load(p)
#define NT_STORE(v, p) __builtin_nontemporal_store((v), (p))
#else
#define NT_LOAD(p) (*(p))
#define NT_STORE(v, p) (*(p) = (v))
#endif
__device__ __forceinline__ int opaque_tid() { int t = threadIdx.x; asm volatile("" : "+v"(t)); return t; }

struct Params {
    const float* in[30];
    float* out;
    unsigned char* ws;
};
enum { I_X = 0, I_G1, I_WIN, I_LRE, I_LIM, I_LOGDT, I_BRE, I_BIM, I_CRE, I_CIM, I_DSK, I_WGLU, I_BGLU, I_QG, I_KG, I_LQ1, I_LK1, I_LQ2, I_LK2, I_SG, I_WPS, I_WPA, I_WOUT, I_G2, I_WR, I_BR, I_W1, I_B1, I_W2, I_B2 };

constexpr int NWAVES = 8, NTHREADS = 512;
constexpr int LDS_BYTES = 147456;
constexpr int RING_BYTES = 131072;
constexpr int MISC_OFF = RING_BYTES + 320;

__device__ __forceinline__ void p0_transpose_item(const float* __restrict__ W, int N, bf16_t* __restrict__ WT, int ldo, int k_off, LAS float* scr, int kb, int nb, int lane) {
    const int k0 = 64 * kb, n0 = 32 * nb;
    { f32x4 v[8];
#pragma unroll
        for (int i = 0; i < 8; ++i) v[i] = NT_LOAD((const f32x4*)(W + (size_t)(k0 + 8 * i + (lane >> 3)) * N + n0 + (lane & 7) * 4));
#pragma unroll
        for (int i = 0; i < 8; ++i) { LAS float* d = scr + (8 * i + (lane >> 3)) * 33 + (lane & 7) * 4; d[0] = v[i].x; d[1] = v[i].y; d[2] = v[i].z; d[3] = v[i].w; } }
    asm volatile("s_waitcnt lgkmcnt(0)" ::: "memory");
    const int c = lane & 7;
#pragma unroll
    for (int j = 0; j < 4; ++j) { const int n = (lane >> 3) + 8 * j; const LAS float* s = scr + (8 * c) * 33 + n;
        u32x4 o; o.x = pk2(s[0 * 33], s[1 * 33]); o.y = pk2(s[2 * 33], s[3 * 33]); o.z = pk2(s[4 * 33], s[5 * 33]); o.w = pk2(s[6 * 33], s[7 * 33]);
        *(u32x4*)(WT + (size_t)(n0 + n) * ldo + k_off + k0 + 8 * c) = o; }
    asm volatile("s_waitcnt lgkmcnt(0)" ::: "memory");
}
__device__ __forceinline__ void p0_transpose_item_fp8(const float* __restrict__ W, int N, unsigned char* __restrict__ WT, int ldo, LAS float* scr, int kb, int nb, int lane) {
    const int k0 = 64 * kb, n0 = 32 * nb;
    { f32x4 v[8];
#pragma unroll
        for (int i = 0; i < 8; ++i) v[i] = NT_LOAD((const f32x4*)(W + (size_t)(k0 + 8 * i + (lane >> 3)) * N + n0 + (lane & 7) * 4));
#pragma unroll
        for (int i = 0; i < 8; ++i) { LAS float* d = scr + (8 * i + (lane >> 3)) * 33 + (lane & 7) * 4; d[0] = v[i].x; d[1] = v[i].y; d[2] = v[i].z; d[3] = v[i].w; } }
    asm volatile("s_waitcnt lgkmcnt(0)" ::: "memory");
    const int n = lane >> 1, half = lane & 1; const LAS float* s = scr + (32 * half) * 33 + n;
    unsigned o[8];
#pragma unroll
    for (int q = 0; q < 8; ++q) o[q] = pk4_fp8(s[(4 * q) * 33] * W8_SCALE, s[(4 * q + 1) * 33] * W8_SCALE, s[(4 * q + 2) * 33] * W8_SCALE, s[(4 * q + 3) * 33] * W8_SCALE);
    u32x4* dst = (u32x4*)(WT + (size_t)(n0 + n) * ldo + k0 + 32 * half);
    dst[0] = (u32x4){o[0], o[1], o[2], o[3]}; dst[1] = (u32x4){o[4], o[5], o[6], o[7]};
    asm volatile("s_waitcnt lgkmcnt(0)" ::: "memory");
}
__device__ __forceinline__ void p0_transpose_f32_item(const float* __restrict__ W, float* __restrict__ WT, int K, LAS float* scr, int kb, int lane) {
    const int k0 = 64 * kb;
#pragma unroll 8
    for (int i = 0; i < 32; ++i) { const int kk = 2 * i + (lane >> 5); scr[kk * 33 + (lane & 31)] = W[(size_t)(k0 + kk) * 32 + (lane & 31)]; }
    asm volatile("s_waitcnt lgkmcnt(0)" ::: "memory");
#pragma unroll 8
    for (int n = 0; n < 32; ++n) WT[(size_t)n * K + k0 + lane] = scr[lane * 33 + n];
    asm volatile("s_waitcnt lgkmcnt(0)" ::: "memory");
}
__device__ __forceinline__ void rms_row_to_bf16(const float* __restrict__ xrow, const float* __restrict__ g, bf16_t* __restrict__ orow, int lane) {
    const f32x4* xr = (const f32x4*)xrow + lane; const f32x4* gr = (const f32x4*)g + lane;
    f32x4 v[4]; float s = 0.f;
#pragma unroll
    for (int j = 0; j < 4; ++j) { v[j] = NT_LOAD(xr + 64 * j); s += (v[j].x * v[j].x + v[j].y * v[j].y) + (v[j].z * v[j].z + v[j].w * v[j].w); }
    const float r = rsqrtf(wave_sum(s) * (1.f / D) + EPS);
    u32x2* o8 = (u32x2*)orow + lane;
#pragma unroll
    for (int j = 0; j < 4; ++j) { const f32x4 gg = gr[64 * j]; u32x2 w; w.x = pk2(v[j].x * r * gg.x, v[j].y * r * gg.y); w.y = pk2(v[j].z * r * gg.z, v[j].w * r * gg.w); o8[64 * j] = w; }
}
struct SsmGP { float lrdt, lidt, cr, ci; };
__device__ __forceinline__ SsmGP ssm_gp(const Params& P, int g, int p) {
    const float dt = expf(P.in[I_LOGDT][g]);
    const float lr = fminf(P.in[I_LRE][g * SSM_P + p], -1e-4f), li = P.in[I_LIM][g * SSM_P + p];
    const float mag = expf(lr * dt);
    float sn, cs; sincosf(li * dt, &sn, &cs);
    const float ar = mag * cs, ai = mag * sn;
    const float den = lr * lr + li * li, nr = ar - 1.f;
    SsmGP r; r.lrdt = lr * dt; r.lidt = li * dt; r.cr = (nr * lr + ai * li) / den; r.ci = (ai * lr - nr * li) / den;
    return r;
}
__device__ __forceinline__ void ssm_pow(const SsmGP& q, int j, float& pr, float& pi) {
    const float m = expf((float)j * q.lrdt); float sn, cs; sincosf((float)j * q.lidt, &sn, &cs); pr = m * cs; pi = m * sn;
}

#ifndef EXP_DMA_AUX
#define EXP_DMA_AUX 2
#endif
struct ExpItem { const float* W; unsigned char* WT; int N, ldo, kb, nb; };
__device__ __forceinline__ ExpItem exp_item(const Params& P, int it) {
    constexpr int I_E1 = (1024 / 128) * (2048 / 32), I_E2 = (1024 / 128) * (1024 / 32);
    ExpItem x;
    if (it < NE * I_E1) { const int e = it / I_E1, q = it % I_E1; x.W = P.in[I_W1] + (size_t)e * D * 2 * DFF; x.WT = P.ws + WS_W1_T + (size_t)e * 2 * DFF * D; x.N = 2 * DFF; x.ldo = D; x.kb = q / 64; x.nb = q % 64; }
    else { const int r = it - NE * I_E1, e = r / I_E2, q = r % I_E2; x.W = P.in[I_W2] + (size_t)e * DFF * D; x.WT = P.ws + WS_W2_T + (size_t)e * D * DFF; x.N = D; x.ldo = DFF; x.kb = q / 32; x.nb = q % 32; }
    return x;
}
__device__ __forceinline__ void exp_dma(const ExpItem& x, int lane, LAS unsigned char* buf) {
    const float* src = x.W + (size_t)(128 * x.kb + (lane >> 3)) * x.N + 32 * x.nb;
#pragma unroll
    for (int i = 0; i < 16; ++i) __builtin_amdgcn_global_load_lds((const unsigned*)(src + (size_t)(8 * i) * x.N + ((((lane & 7) ^ (lane >> 3) ^ (i >> 1)) & 7) << 2)), (LAS unsigned*)(buf + i * 1024), 16, 0, EXP_DMA_AUX);
}
#if defined(PROBE_CONV_NOSTORE)
#define g_conv_nostore nostore_
__device__ __forceinline__ void exp_finish_lds(const ExpItem& x, int lane, const LAS unsigned char* buf, bool nostore_ = false) {
#else
__device__ __forceinline__ void exp_finish_lds(const ExpItem& x, int lane, const LAS unsigned char* buf) {
#endif
    const int c = lane & 7;
#pragma unroll
    for (int pass = 0; pass < 4; ++pass) {
        const int n = 8 * pass + (lane >> 3), q0 = (n >> 2) ^ c;
        const LAS unsigned char* rb = buf + c * 2048 + ((n & 3) << 2);
        float f[16];
#pragma unroll
        for (int j = 0; j < 16; ++j) f[j] = *(const LAS float*)(rb + j * 128 + (((q0 ^ j) & 7) << 4)) * W8_SCALE;
        const u32x4 o = (u32x4){pk4_fp8(f[0], f[1], f[2], f[3]), pk4_fp8(f[4], f[5], f[6], f[7]), pk4_fp8(f[8], f[9], f[10], f[11]), pk4_fp8(f[12], f[13], f[14], f[15])};
#if defined(PROBE_CONV_NOSTORE)
        if (g_conv_nostore) { asm volatile("" :: "v"(o)); } else
#endif
#if NT_STREAMS && !defined(CONV_ST_DEFAULT)
        __builtin_nontemporal_store(o, (u32x4*)(x.WT + (size_t)(32 * x.nb + n) * x.ldo + 128 * x.kb + 16 * c));
#else
        *(u32x4*)(x.WT + (size_t)(32 * x.nb + n) * x.ldo + 128 * x.kb + 16 * c) = o;
#endif
    }
    asm volatile("s_waitcnt lgkmcnt(0)" ::: "memory");
}
constexpr int EXP_ITEMS = NE * ((1024 / 128) * (2048 / 32) + (1024 / 128) * (1024 / 32));
constexpr int EXP_N_IN = 32, EXP_N_S2 = 20, EXP_N_GLU = 20, EXP_N_M1 = 0;
constexpr int EXP_IN0 = 0, EXP_S20 = 128 * EXP_N_IN, EXP_GLU0 = EXP_S20 + 128 * EXP_N_S2, EXP_ATT0 = EXP_GLU0 + 128 * EXP_N_GLU, EXP_M10 = EXP_ITEMS - 128 * EXP_N_M1;
static_assert((EXP_M10 - EXP_ATT0) % 256 == 0 && EXP_M10 >= NE * (1024 / 128) * (2048 / 32), "item split (the expert-GEMM-1 tail share must be W2 items only)");
__device__ __forceinline__ void expert_convert_slice(const Params& P, LAS unsigned char* lds, int i0, int i1, bool probe_nostore = false) {
    const int tid = opaque_tid(), lane = tid & 63, wave = __builtin_amdgcn_readfirstlane(tid >> 6);
    LAS unsigned char* b0 = lds + wave * 16384;
    for (int it = i0 + wave; it < i1; it += NWAVES) {
        const ExpItem c0 = exp_item(P, it);
        exp_dma(c0, lane, b0);
        asm volatile("s_waitcnt vmcnt(0)" ::: "memory");
#if defined(PROBE_CONV_NOSTORE)
        exp_finish_lds(c0, lane, b0, probe_nostore);
#else
        exp_finish_lds(c0, lane, b0);
#endif
    }
}
__device__ __forceinline__ void p0_prologue(const Params& P, LAS unsigned char* lds, int vcu, int G) {
    const int tid = opaque_tid(), lane = tid & 63, wave = __builtin_amdgcn_readfirstlane(tid >> 6);
    LAS float* scr = (LAS float*)(lds + wave * 16384);
    unsigned char* ws = P.ws;
    const int gw = vcu * NWAVES + wave, NGW = G * NWAVES;
    constexpr int I_IN = (D / 64) * (IN_W / 32);
    constexpr int I_GLU = (512 / 64) * (512 / 32);
    constexpr int I_PS = (512 / 64) * (1024 / 32);
    constexpr int I_PA = (1024 / 64) * (1024 / 32);
    constexpr int I_OUT = I_PA;
    constexpr int I_R = 1024 / 64;
    constexpr int I_E1 = (1024 / 64) * (2048 / 32);
    constexpr int I_E2 = (1024 / 64) * (1024 / 32);
#ifndef EXPERTS_IN_ATTN
#define EXPERTS_IN_ATTN 1
#endif
    constexpr int NITEMS = I_IN + I_GLU + I_PS + I_PA + I_OUT + I_R + (EXPERTS_IN_ATTN ? 0 : NE * I_E1 + NE * I_E2);
    for (int it = gw; it < NITEMS; it += NGW) {
        int r = it;
        if (r < I_IN) { const int nblk = IN_W / 32; p0_transpose_item(P.in[I_WIN], IN_W, (bf16_t*)(ws + WS_WIN_T), D, 0, scr, r / nblk, r % nblk, lane); continue; } r -= I_IN;
        if (r < I_GLU) { const int nblk = 512 / 32; p0_transpose_item(P.in[I_WGLU], 512, (bf16_t*)(ws + WS_WGLU_T), 512, 0, scr, r / nblk, r % nblk, lane); continue; } r -= I_GLU;
        if (r < I_PS) { const int nblk = 1024 / 32; p0_transpose_item(P.in[I_WPS], 1024, (bf16_t*)(ws + WS_WP_T), MA_LD, 1024, scr, r / nblk, r % nblk, lane); continue; } r -= I_PS;
        if (r < I_PA) { const int nblk = 1024 / 32; p0_transpose_item(P.in[I_WPA], 1024, (bf16_t*)(ws + WS_WP_T), MA_LD, 0, scr, r / nblk, r % nblk, lane); continue; } r -= I_PA;
        if (r < I_OUT) { const int nblk = 1024 / 32; p0_transpose_item(P.in[I_WOUT], 1024, (bf16_t*)(ws + WS_WOUT_T), D, 0, scr, r / nblk, r % nblk, lane); continue; } r -= I_OUT;
        if (r < I_R) { p0_transpose_f32_item(P.in[I_WR], (float*)(ws + WS_WR_T), D, scr, r, lane); continue; } r -= I_R;
        if (EXPERTS_IN_ATTN) continue;
        if (r < NE * I_E1) { const int e = r / I_E1, q = r % I_E1, nblk = 2048 / 32;
            p0_transpose_item_fp8(P.in[I_W1] + (size_t)e * D * 2 * DFF, 2 * DFF, ws + WS_W1_T + (size_t)e * 2 * DFF * D, D, scr, q / nblk, q % nblk, lane); continue; } r -= NE * I_E1;
        { const int e = r / I_E2, q = r % I_E2, nblk = 1024 / 32;
            p0_transpose_item_fp8(P.in[I_W2] + (size_t)e * DFF * D, D, ws + WS_W2_T + (size_t)e * D * DFF, DFF, scr, q / nblk, q % nblk, lane); }
    }
#if EXPERTS_IN_ATTN
    if (G != 256) { __syncthreads(); for (int c0 = vcu * 64; c0 < EXP_ATT0; c0 += G * 64) expert_convert_slice(P, lds, c0, min(EXP_ATT0, c0 + 64));
        for (int c0 = EXP_M10 + vcu * 64; c0 < EXP_ITEMS; c0 += G * 64) expert_convert_slice(P, lds, c0, min(EXP_ITEMS, c0 + 64)); __syncthreads(); }
#endif
    for (int m = gw; m < T; m += NGW) rms_row_to_bf16(P.in[I_X] + (size_t)m * D, P.in[I_G1], (bf16_t*)(ws + WS_XN) + (size_t)m * D, lane);
    if (gw == 0) { u32x4* z = (u32x4*)(ws + WS_H2 + (size_t)T * D); z[lane] = (u32x4){0u, 0u, 0u, 0u}; }
    const int gt = vcu * NTHREADS + tid, NGT = G * NTHREADS;
    for (int it = gw; it < SSM_G * CH_L; it += NGW) {
        const int g = it / CH_L, j = it % CH_L, h = lane >> 2, hq = (lane & 3) * 4;
        { const SsmGP q = ssm_gp(P, g, lane); float pr, pi; ssm_pow(q, j, pr, pi); scr[2 * lane] = pr * q.cr - pi * q.ci; scr[2 * lane + 1] = pr * q.ci + pi * q.cr; }
        asm volatile("s_waitcnt lgkmcnt(0)" ::: "memory");
        float a0 = 0.f, a1 = 0.f, a2 = 0.f, a3 = 0.f;
#pragma unroll 4
        for (int p = 0; p < SSM_P; ++p) {
            const float wr = scr[2 * p], wi = scr[2 * p + 1];
            const float cre = P.in[I_CRE][(g * SSM_H + h) * SSM_P + p], cim = P.in[I_CIM][(g * SSM_H + h) * SSM_P + p];
            const float mr = cre * wr - cim * wi, mi = cre * wi + cim * wr;
            const f32x4 br = *(const f32x4*)(P.in[I_BRE] + (g * SSM_P + p) * SSM_H + hq), bi = *(const f32x4*)(P.in[I_BIM] + (g * SSM_P + p) * SSM_H + hq);
            a0 += mr * br.x - mi * bi.x; a1 += mr * br.y - mi * bi.y; a2 += mr * br.z - mi * bi.z; a3 += mr * br.w - mi * bi.w;
        }
        if (j == 0) { const float dsk = P.in[I_DSK][g * SSM_H + h]; if (hq == (h & 12)) { const int w = h & 3; if (w == 0) a0 += dsk; else if (w == 1) a1 += dsk; else if (w == 2) a2 += dsk; else a3 += dsk; } }
        *(f32x4*)((float*)(ws + WS_KJ) + ((size_t)(g * CH_L + j) * SSM_H + h) * SSM_H + hq) = (f32x4){a0, a1, a2, a3};
        asm volatile("s_waitcnt lgkmcnt(0)" ::: "memory");
    }
    for (int it = gt; it < SSM_G * 128 * CH_L; it += NGT) {
        const int s = it % CH_L, n = (it / CH_L) % 128, g = it / (CH_L * 128), p = n & 63, part = n >> 6;
        const SsmGP q = ssm_gp(P, g, p); float pr, pi; ssm_pow(q, CH_L - 1 - s, pr, pi);
        const float wr = pr * q.cr - pi * q.ci, wi = pr * q.ci + pi * q.cr;
        const float* br = P.in[I_BRE] + (g * SSM_P + p) * SSM_H; const float* bi = P.in[I_BIM] + (g * SSM_P + p) * SSM_H;
        unsigned o[8];
#pragma unroll
        for (int h2 = 0; h2 < 8; ++h2) {
            float v0, v1;
            if (part == 0) { v0 = wr * br[2 * h2] - wi * bi[2 * h2]; v1 = wr * br[2 * h2 + 1] - wi * bi[2 * h2 + 1]; }
            else { v0 = wr * bi[2 * h2] + wi * br[2 * h2]; v1 = wr * bi[2 * h2 + 1] + wi * br[2 * h2 + 1]; }
            o[h2] = pk2(v0, v1);
        }
        u32x4* dst = (u32x4*)((bf16_t*)(ws + WS_WS_T) + ((size_t)(g * 128 + n) * 512 + s * 16));
        dst[0] = (u32x4){o[0], o[1], o[2], o[3]}; dst[1] = (u32x4){o[4], o[5], o[6], o[7]};
    }
    for (int it = gt; it < SSM_G * CH_L * SSM_P; it += NGT) {
        const int p = it % SSM_P, t = (it / SSM_P) % CH_L, g = it / (SSM_P * CH_L);
        const SsmGP q = ssm_gp(P, g, p); float pr, pi; ssm_pow(q, t + 1, pr, pi);
        bf16_t* base = (bf16_t*)(ws + WS_BT_SSM) + ((size_t)(g * 512 + t * 16)) * ACAT_LD + 512 + p;
#pragma unroll 4
        for (int h = 0; h < SSM_H; ++h) {
            const float cre = P.in[I_CRE][(g * SSM_H + h) * SSM_P + p], cim = P.in[I_CIM][(g * SSM_H + h) * SSM_P + p];
            base[(size_t)h * ACAT_LD] = (bf16_t)f2bf(cre * pr - cim * pi);
            base[(size_t)h * ACAT_LD + 64] = (bf16_t)f2bf(-(cre * pi + cim * pr));
        }
    }
}
__device__ __forceinline__ void ssm_toeplitz_expand(const Params& P, int vcu, int G) {
    const int gt = vcu * NTHREADS + opaque_tid(), NGT = G * NTHREADS;
    unsigned char* ws = P.ws;
    for (int it = gt; it < SSM_G * 512 * 64; it += NGT) {
        const int kc = it & 63, n = (it >> 6) & 511, g = it >> 15;
        const int s = kc >> 1, hq = (kc & 1) * 8, t = n >> 4, h = n & 15;
        u32x4 o = (u32x4){0u, 0u, 0u, 0u};
        if (s <= t) { const float* kj = (const float*)(ws + WS_KJ) + ((size_t)(g * CH_L + (t - s)) * SSM_H + h) * SSM_H + hq;
            const f32x4 a = *(const f32x4*)kj, b = *(const f32x4*)(kj + 4);
            o.x = pk2(a.x, a.y); o.y = pk2(a.z, a.w); o.z = pk2(b.x, b.y); o.w = pk2(b.z, b.w); }
        *(u32x4*)((bf16_t*)(ws + WS_BT_SSM) + ((size_t)(g * 512 + n)) * ACAT_LD + kc * 8) = o;
    }
}
#ifndef PG_WGM
#define PG_WGM 8
#endif
namespace pg {
constexpr int BM = 256, BK = 64, HALF = 128, HTB = HALF * BK * 2, STAGE_BYTES = 8 * HTB;
__host__ __device__ __forceinline__ int lds_byte(int r, int c) { const int st = (r >> 4) * 2 + (c >> 5), rr = r & 15, cc = c & 31, ob = rr * 64 + cc * 2; return st * 1024 + (ob ^ (((ob >> 9) & 1) << 5)); }
__host__ __device__ __forceinline__ void stage_rc(int b, int& R, int& C) { const int st = b / 1024, sb = b % 1024, swz = sb ^ (((sb >> 9) & 1) << 5); R = (st >> 1) * 16 + swz / 64; C = (st & 1) * 32 + (swz % 64) / 2; }
__host__ __device__ __forceinline__ int perm32(int rho) { const int n = rho >> 4, i = rho & 15; return 8 * (i >> 2) + 4 * n + (i & 3); }

struct Unit {
    const char* A;
    const char* B;
    unsigned aoff[2][2];
    int pm, pn, aux, aux2;
    int ord;
};
struct EpiInfo { int pm, pn, aux, aux2, ord; };
typedef f32x4 Acc[2][2][4][2];

typedef int v8i_t __attribute__((ext_vector_type(8)));
typedef int v4i_t __attribute__((ext_vector_type(4)));
template <bool FP8 = false, int BAUX = 0  , class Sched, class Epi>
__device__ __forceinline__ void gemm_phase(LAS unsigned char* lds, const Sched& S, const Epi& E, const int nt, const int ldb, const int ktm = -1  ) {
    const int tid = opaque_tid(), wid = __builtin_amdgcn_readfirstlane(tid >> 6), lane = tid & 63, wr = wid >> 2, wc = wid & 3, fr = lane & 15, fq = lane >> 4;
    unsigned voffB[2];
#pragma unroll
    for (int i = 0; i < 2; ++i) { int R, C; stage_rc(tid * 16 + i * 8192, R, C); voffB[i] = (unsigned)((64 * (R >> 5) + perm32(R & 31)) * ldb + C) * 2u; }
    const unsigned hB = (unsigned)(32 * ldb * 2);
    const unsigned ldsw = (unsigned)wid * 1024u;
    const int aoffl = lds_byte(wr * 64 + fr, fq * 8), boffl = lds_byte(wc * 32 + fr, fq * 8);
#define PG_SA(b, h) (((b) * 2 + (h)) * pg::HTB)
#define PG_SB(b, h) ((4 + (b) * 2 + (h)) * pg::HTB)
#define PG_GLDS(gp, bufoff, i) __builtin_amdgcn_global_load_lds((const unsigned*)(gp), (LAS unsigned*)(lds + (bufoff) + ldsw + (i) * 8192), 16, 0, 0)
#define PG_STAGE_A(bufoff, Ab, o0, o1, kt) do { const char* _b = (Ab) + (size_t)((kt) & ktm) * 128; PG_GLDS(_b + (o0), bufoff, 0); PG_GLDS(_b + (o1), bufoff, 1); } while (0)
#define PG_GLDSB(gp, bufoff, i) __builtin_amdgcn_global_load_lds((const unsigned*)(gp), (LAS unsigned*)(lds + (bufoff) + ldsw + (i) * 8192), 16, 0, BAUX)
#define PG_STAGE_B(bufoff, Bb, h, kt) do { const char* _b = (Bb) + (size_t)((kt) & ktm) * 128 + (h) * hB; PG_GLDSB(_b + voffB[0], bufoff, 0); PG_GLDSB(_b + voffB[1], bufoff, 1); } while (0)
#define PG_LDA(dst, b, h) do { _Pragma("unroll") for (int m = 0; m < 4; ++m) _Pragma("unroll") for (int k = 0; k < 2; ++k) dst[m][k] = *(const LAS bf16x8*)(lds + PG_SA(b, h) + aoffl + m * 2048 + k * 1024); } while (0)
#define PG_LDB(dst, b, h) do { _Pragma("unroll") for (int n = 0; n < 2; ++n) _Pragma("unroll") for (int k = 0; k < 2; ++k) dst[n][k] = *(const LAS bf16x8*)(lds + PG_SB(b, h) + boffl + n * 2048 + k * 1024); } while (0)
#define PG_CAT8(lo, hi) __builtin_shufflevector(__builtin_bit_cast(v4i_t, lo), __builtin_bit_cast(v4i_t, hi), 0, 1, 2, 3, 4, 5, 6, 7)
#define PG_MMA(ai, bj, At, Bt) do { __builtin_amdgcn_s_setprio(1); if constexpr (FP8) { _Pragma("unroll") for (int m = 0; m < 4; ++m) _Pragma("unroll") for (int n = 0; n < 2; ++n) \
            acc[ai][bj][m][n] = __builtin_amdgcn_mfma_scale_f32_16x16x128_f8f6f4(PG_CAT8(Bt[n][0], Bt[n][1]), PG_CAT8(At[m][0], At[m][1]), acc[ai][bj][m][n], 0, 0, 0, 0x79797979, 0, 0x7f7f7f7f); } \
        else { _Pragma("unroll") for (int m = 0; m < 4; ++m) _Pragma("unroll") for (int n = 0; n < 2; ++n) _Pragma("unroll") for (int k = 0; k < 2; ++k) \
        acc[ai][bj][m][n] = __builtin_amdgcn_mfma_f32_16x16x32_bf16(Bt[n][k], At[m][k], acc[ai][bj][m][n], 0, 0, 0); } __builtin_amdgcn_s_setprio(0); } while (0)
#define PG_WAIT_V(n) asm volatile("s_waitcnt vmcnt(" #n ")" ::: "memory")
#define PG_WAIT_L(n) asm volatile("s_waitcnt lgkmcnt(" #n ")" ::: "memory")
#define PG_BAR __builtin_amdgcn_s_barrier()
#define PG_SCHED __builtin_amdgcn_sched_barrier(0)
#define PG_KLOOP(T0, T1) _Pragma("clang loop unroll(disable)") for (int t = (T0); t < (T1); t += 2) { \
            const bool last = (t == nt - 2); \
            PG_LDB(B0, 0, 0); PG_LDB(B1, 0, 1); PG_SCHED; PG_LDA(At, 0, 0); PG_STAGE_A(PG_SA(1, 1), st.A, st.aoff[1][0], st.aoff[1][1], t + 1); \
            if (last) { Unit nu_; has_next = S.next(ui + 1, nu_); if (has_next) { st = nu_; } } \
            const int k2 = last ? 0 : t + 2, k3 = k2 + 1; \
            PG_WAIT_V(8); PG_WAIT_L(0); PG_BAR; PG_MMA(0, 0, At, B0); PG_MMA(0, 1, At, B1); PG_BAR; PG_SCHED; \
            PG_LDA(At, 0, 1); PG_STAGE_B(PG_SB(0, 0), st.B, 0, k2); PG_STAGE_B(PG_SB(0, 1), st.B, 1, k2); PG_STAGE_A(PG_SA(0, 0), st.A, st.aoff[0][0], st.aoff[0][1], k2); \
            PG_WAIT_V(8); PG_WAIT_L(0); PG_BAR; PG_MMA(1, 0, At, B0); PG_MMA(1, 1, At, B1); PG_BAR; PG_SCHED; \
            PG_LDB(B0, 1, 0); PG_LDB(B1, 1, 1); PG_SCHED; PG_LDA(At, 1, 0); PG_STAGE_A(PG_SA(0, 1), st.A, st.aoff[1][0], st.aoff[1][1], k2); \
            PG_WAIT_V(8); PG_WAIT_L(0); PG_BAR; PG_MMA(0, 0, At, B0); PG_MMA(0, 1, At, B1); PG_BAR; PG_SCHED; \
            PG_LDA(At, 1, 1); PG_STAGE_B(PG_SB(1, 0), st.B, 0, k3); PG_STAGE_B(PG_SB(1, 1), st.B, 1, k3); PG_STAGE_A(PG_SA(1, 0), st.A, st.aoff[0][0], st.aoff[0][1], k3); \
            PG_WAIT_V(8); PG_WAIT_L(0); PG_BAR; PG_MMA(1, 0, At, B0); PG_MMA(1, 1, At, B1); PG_BAR; PG_SCHED; \
        }
    Unit st; int ui = 0;
    if (!S.next(0, st)) return;
    EpiInfo cur; cur.pm = st.pm; cur.pn = st.pn; cur.aux = st.aux; cur.aux2 = st.aux2; cur.ord = st.ord;
    Acc acc;
#pragma unroll
    for (int a = 0; a < 2; ++a)
#pragma unroll
        for (int b = 0; b < 2; ++b)
#pragma unroll
            for (int m = 0; m < 4; ++m)
#pragma unroll
                for (int n = 0; n < 2; ++n) acc[a][b][m][n] = (f32x4){0.f, 0.f, 0.f, 0.f};
    bf16x8 At[4][2], B0[2][2], B1[2][2];
    PG_STAGE_B(PG_SB(0, 0), st.B, 0, 0); PG_STAGE_B(PG_SB(0, 1), st.B, 1, 0); PG_STAGE_A(PG_SA(0, 0), st.A, st.aoff[0][0], st.aoff[0][1], 0); PG_STAGE_A(PG_SA(0, 1), st.A, st.aoff[1][0], st.aoff[1][1], 0);
    if (wr == 1) PG_BAR;
    PG_WAIT_V(2); PG_BAR;
    PG_STAGE_B(PG_SB(1, 0), st.B, 0, 1); PG_STAGE_A(PG_SA(1, 0), st.A, st.aoff[0][0], st.aoff[0][1], 1); PG_STAGE_B(PG_SB(1, 1), st.B, 1, 1);
    PG_WAIT_V(6); PG_BAR;
    for (;;) {
        bool has_next = false;
        if constexpr (Epi::HAS_MID) { PG_KLOOP(0, Epi::MID_T) E.mid(acc, cur, wr, wc, fr, fq); PG_KLOOP(Epi::MID_T, nt) } else { PG_KLOOP(0, nt) }
        if (wr == 0) PG_BAR;
        E(acc, cur, wr, wc, fr, fq);
        if (!has_next) break;
#pragma unroll
        for (int a = 0; a < 2; ++a)
#pragma unroll
            for (int b = 0; b < 2; ++b)
#pragma unroll
                for (int m = 0; m < 4; ++m)
#pragma unroll
                    for (int n = 0; n < 2; ++n) acc[a][b][m][n] = (f32x4){0.f, 0.f, 0.f, 0.f};
        cur.pm = st.pm; cur.pn = st.pn; cur.aux = st.aux; cur.aux2 = st.aux2; cur.ord = st.ord; ++ui;
        if (wr == 1) PG_BAR;
    }
    PG_WAIT_V(0);
    PG_BAR;
#undef PG_SA
#undef PG_SB
#undef PG_GLDS
#undef PG_GLDSB
#undef PG_STAGE_A
#undef PG_STAGE_B
#undef PG_LDA
#undef PG_LDB
#undef PG_MMA
#undef PG_WAIT_V
#undef PG_WAIT_L
#undef PG_BAR
#undef PG_SCHED
#undef PG_KLOOP
}

struct LaneRC { int R[2], C[2]; __device__ __forceinline__ LaneRC() { const int t = opaque_tid(); stage_rc(t * 16, R[0], C[0]); stage_rc(t * 16 + 8192, R[1], C[1]); } };

struct DenseSched {
    const bf16_t* A; const bf16_t* Bt; int lda, ldb, nM, nN, nwg, G, c;
    __device__ __forceinline__ void init(const bf16_t* A_, int lda_, const bf16_t* Bt_, int ldb_, int M, int N, int G_, int c_) { A = A_; Bt = Bt_; lda = lda_; ldb = ldb_; nM = M / BM; nN = N / BM; nwg = nM * nN; G = G_; c = c_; }
    __device__ __forceinline__ bool next(int i, Unit& u) const {
        const long L = (long)i * G + c; if (L >= nwg) return false;
        int wgid = (int)L; { const int q = nwg / 8, r = nwg % 8, xcd = wgid % 8, off = wgid / 8; wgid = (xcd < r ? xcd * (q + 1) : r * (q + 1) + (xcd - r) * q) + off; }
        const int WGM = PG_WGM, nig = WGM * nN, gid = wgid / nig, fm = gid * WGM, gsz = (nM - fm) < WGM ? (nM - fm) : WGM;
        u.pm = fm + ((wgid % nig) % gsz); u.pn = (wgid % nig) / gsz; u.aux = 0; u.aux2 = 0; u.ord = i;
        u.A = (const char*)A; u.B = (const char*)(Bt + (size_t)u.pn * BM * ldb); const LaneRC rc;
#pragma unroll
        for (int h = 0; h < 2; ++h)
#pragma unroll
            for (int j = 0; j < 2; ++j) u.aoff[h][j] = (unsigned)(((u.pm * BM + 128 * h + rc.R[j]) * lda + rc.C[j]) * 2);
        return true;
    }
};
}
namespace pg {
constexpr int TAB_OFF = RING_BYTES + 1024;
__device__ __forceinline__ void moe_build_tab(LAS unsigned char* lds, const unsigned* cnt) {
    LAS int* tab = (LAS int*)(lds + TAB_OFF);
    if (threadIdx.x == 0) { int acc = 0; for (int e = 0; e < NE; ++e) { const int n = (int)__hip_atomic_load(cnt + e, __ATOMIC_RELAXED, __HIP_MEMORY_SCOPE_AGENT); tab[e] = acc; tab[40 + e] = n; acc += (n + 255) >> 8; } tab[NE] = acc; }
    __syncthreads();
}
#ifndef MOE_MAXU_OVERRIDE
#define MOE_MAXU_OVERRIDE 9
#endif
constexpr int MOE_MAXU = MOE_MAXU_OVERRIDE;
constexpr int UT_OFF = RING_BYTES + 1536;
constexpr int UB_OFF = UT_OFF + MOE_MAXU * 512;
static_assert(UB_OFF + MOE_MAXU * 1024 <= LDS_BYTES, "LDS map");
template <int KIND>
struct MoeSched {
    static constexpr int NPN = KIND == 1 ? 8 : 4;
    unsigned char* ws; const LAS int* tab; LAS unsigned char* lds; int G, c; bool freeze = false;
    __device__ __forceinline__ bool unit(int i, int& e, int& rb, int& pn) const {
        const int x = c & 7, j = c >> 3, NJ = G >> 3;
        int L = i * NJ + j; e = -1; rb = 0; pn = 0;
#pragma unroll
        for (int q = 0; q < NE / 8; ++q) { const int eq = x + 8 * q, uq = (tab[eq + 1] - tab[eq]) * NPN;
            if (e < 0) { if (L < uq) { e = eq; rb = L / NPN; pn = L % NPN; } else L -= uq; } }
        if (e < 0) return false;
        e = __builtin_amdgcn_readfirstlane(e); rb = __builtin_amdgcn_readfirstlane(rb); pn = __builtin_amdgcn_readfirstlane(pn);
        return true;
    }
    __device__ __forceinline__ void init(unsigned char* ws_, LAS unsigned char* lds_, int G_, int c_, const float* bias) {
        ws = ws_; lds = lds_; tab = (const LAS int*)(lds_ + TAB_OFF); G = G_; c = c_;
        const int tid = opaque_tid();
        for (int i = 0; i < MOE_MAXU; ++i) { int e, rb, pn; if (!unit(i, e, rb, pn)) break;
            if (tid < 256) { if (KIND == 1) { const int nvalid = min(256, tab[40 + e] - rb * 256); const int tok = tid < nvalid ? ((const int*)(ws + WS_SLOT_TOK))[(size_t)e * CAP + rb * 256 + tid] : T;
                    ((LAS unsigned short*)(lds + UT_OFF))[i * 256 + tid] = (unsigned short)tok; } }
            else ((LAS float*)(lds + UB_OFF))[i * 256 + tid - 256] = bias[(size_t)e * (NPN * 256) + pn * 256 + tid - 256]; }
        __syncthreads();
    }
    __device__ __forceinline__ bool next(int i, Unit& u) const {
        int e, rb, pn; if (!unit(i, e, rb, pn)) return false;
#if defined(PROBE_FREEZE)
        if (freeze) { int e0, r0, p0; unit(0, e0, r0, p0); e = e0; rb = r0; pn = p0; }
#endif
        const int blk = tab[e] + rb, nvalid = min(256, tab[40 + e] - rb * 256);
        u.pm = rb; u.pn = pn; u.aux = e; u.ord = i; const LaneRC rc;
        if (KIND == 1) {
            u.aux2 = blk; u.A = (const char*)(ws + WS_H2); u.B = (const char*)(ws + WS_W1_T + ((size_t)e * 2 * DFF + (size_t)pn * BM) * D);
#pragma unroll
            for (int h = 0; h < 2; ++h)
#pragma unroll
                for (int jj = 0; jj < 2; ++jj) { const int r = 128 * h + rc.R[jj]; int tok;
                    if (i < MOE_MAXU) tok = ((const LAS unsigned short*)(lds + UT_OFF))[i * 256 + r];
                    else { tok = r < nvalid ? ((const int*)(ws + WS_SLOT_TOK))[(size_t)e * CAP + rb * 256 + r] : T; __builtin_amdgcn_s_waitcnt(0x0F70); }
                    u.aoff[h][jj] = (unsigned)(tok * D + rc.C[jj] * 2); }
        } else {
            u.aux2 = blk | (nvalid << 16); u.A = (const char*)(ws + WS_ACT); u.B = (const char*)(ws + WS_W2_T + ((size_t)e * D + (size_t)pn * BM) * DFF);
#pragma unroll
            for (int h = 0; h < 2; ++h)
#pragma unroll
                for (int jj = 0; jj < 2; ++jj) u.aoff[h][jj] = (unsigned)((blk * 256 + 128 * h + rc.R[jj]) * DFF + rc.C[jj] * 2);
        }
        return true;
    }
};
}
namespace pg {
struct EpiBase { static constexpr bool HAS_MID = false; static constexpr int MID_T = -1; __device__ __forceinline__ void mid(Acc&, const EpiInfo&, int, int, int, int) const {} };
__device__ __forceinline__ u32x4 pack8(const f32x4 a, const f32x4 b) { u32x4 w; w.x = pk2(a[0], a[1]); w.y = pk2(a[2], a[3]); w.z = pk2(b[0], b[1]); w.w = pk2(b[2], b[3]); return w; }
__device__ __forceinline__ void unpack8(const u32x4 w, f32x4& a, f32x4& b) { a = (f32x4){bflo(w.x), bfhi(w.x), bflo(w.y), bfhi(w.y)}; b = (f32x4){bflo(w.z), bfhi(w.z), bflo(w.w), bfhi(w.w)}; }

struct EpiNull : EpiBase {
    __device__ __forceinline__ void operator()(Acc& acc, const EpiInfo&, int, int, int, int) const {
#pragma unroll
        for (int a = 0; a < 2; ++a)
#pragma unroll
            for (int b = 0; b < 2; ++b)
#pragma unroll
                for (int m = 0; m < 4; ++m)
#pragma unroll
                    for (int n = 0; n < 2; ++n) asm volatile("" :: "v"(acc[a][b][m][n]));
    }
};
struct EpiInProj : EpiBase {
    unsigned char* ws; const float* qg; const float* kg;
    __device__ __forceinline__ void operator()(Acc& acc, const EpiInfo& u, int wr, int wc, int fr, int fq) const {
        const int pn = u.pn, row0 = u.pm * BM + wr * 64 + fr, colw = 64 * wc + 8 * fq;
        if (pn < 2) {
            bf16_t* acat = (bf16_t*)(ws + WS_ACAT);
#pragma unroll
            for (int ai = 0; ai < 2; ++ai)
#pragma unroll
                for (int m = 0; m < 4; ++m) { const int tok = row0 + ai * 128 + m * 16;
#pragma unroll
                    for (int bj = 0; bj < 2; ++bj) { const int cu = pn * 256 + colw + 32 * bj, g = cu >> 4, h0 = cu & 15;
                        *(u32x4*)(acat + ((size_t)(g * ACAT_ROWS + (tok >> 5))) * ACAT_LD + (tok & 31) * 16 + h0) = pack8(acc[ai][bj][m][0], acc[ai][bj][m][1]); } }
        } else if (pn < 10) {
            const bool isq = pn < 6; const float* gain = isq ? qg : kg; const float sc = isq ? QC2 : 1.f;
            bf16_t* dst = (bf16_t*)(ws + (isq ? WS_Q : WS_K)) + (size_t)(pn - (isq ? 2 : 6)) * 256 + colw;
            f32x4 gv[2][2];
#pragma unroll
            for (int bj = 0; bj < 2; ++bj)
#pragma unroll
                for (int n = 0; n < 2; ++n) gv[bj][n] = *(const f32x4*)(gain + 32 * bj + 8 * fq + 4 * n);
#pragma unroll
            for (int ai = 0; ai < 2; ++ai)
#pragma unroll
                for (int m = 0; m < 4; ++m) { const int tok = row0 + ai * 128 + m * 16; float ss = 0.f;
#pragma unroll
                    for (int bj = 0; bj < 2; ++bj)
#pragma unroll
                        for (int n = 0; n < 2; ++n) { const f32x4 v = acc[ai][bj][m][n]; ss += (v[0] * v[0] + v[1] * v[1]) + (v[2] * v[2] + v[3] * v[3]); }
                    ss += __shfl_xor(ss, 16); ss += __shfl_xor(ss, 32);
                    const float r = rsqrtf(ss * (1.f / 64.f) + EPS) * sc;
#pragma unroll
                    for (int bj = 0; bj < 2; ++bj) store16(dst + (size_t)tok * D + 32 * bj, pack8(acc[ai][bj][m][0] * r * gv[bj][0], acc[ai][bj][m][1] * r * gv[bj][1])); }
        } else {
            const size_t base = pn < 14 ? WS_V : (pn < 18 ? WS_GS : WS_GA); const int t0 = pn < 14 ? 10 : (pn < 18 ? 14 : 18); const bool ntst = pn >= 14;
            bf16_t* dst = (bf16_t*)(ws + base) + (size_t)(pn - t0) * 256 + colw;
#pragma unroll
            for (int ai = 0; ai < 2; ++ai)
#pragma unroll
                for (int m = 0; m < 4; ++m) { const int tok = row0 + ai * 128 + m * 16;
#pragma unroll
                    for (int bj = 0; bj < 2; ++bj) { const u32x4 w = pack8(acc[ai][bj][m][0], acc[ai][bj][m][1]); if (ntst) NT_STORE(w, (u32x4*)(dst + (size_t)tok * D + 32 * bj)); else store16(dst + (size_t)tok * D + 32 * bj, w); } }
        }
    }
};
struct EpiSsm2 : EpiBase {
    unsigned char* ws;
    __device__ __forceinline__ void operator()(Acc& acc, const EpiInfo& u, int wr, int wc, int fr, int fq) const {
        bf16_t* Z = (bf16_t*)(ws + WS_Z); const int g = u.aux;
#pragma unroll
        for (int ai = 0; ai < 2; ++ai)
#pragma unroll
            for (int m = 0; m < 4; ++m) { const int r = u.pm * BM + ai * 128 + wr * 64 + m * 16 + fr, b = r >> 6, c = r & 63;
#pragma unroll
                for (int bj = 0; bj < 2; ++bj) { const int n_ = u.pn * 256 + 64 * wc + 32 * bj + 8 * fq, t = n_ >> 4, h0 = n_ & 15; const int tok = b * SEQ + c * CH_L + t;
                    f32x4 a = acc[ai][bj][m][0], bb = acc[ai][bj][m][1];
#pragma unroll
                    for (int q = 0; q < 4; ++q) { a[q] = gelu_tanh(a[q]); bb[q] = gelu_tanh(bb[q]); }
                    *(u32x4*)(Z + (size_t)tok * SSM_W + 16 * g + h0) = pack8(a, bb); } }
    }
};
struct EpiGlu : EpiBase {
    unsigned char* ws; const float* bglu;
    __device__ __forceinline__ void operator()(Acc& acc, const EpiInfo& u, int wr, int wc, int fr, int fq) const {
        asm volatile("" : "+v"(fr), "+v"(fq));
        const bf16_t* Z = (const bf16_t*)(ws + WS_Z); bf16_t* MA = (bf16_t*)(ws + WS_MA);
        const int col0 = u.pn * 256 + 64 * wc + 8 * fq;
        f32x4 cb[2][2];
#pragma unroll
        for (int bj = 0; bj < 2; ++bj) { cb[bj][0] = *(const f32x4*)(bglu + col0 + 32 * bj); cb[bj][1] = *(const f32x4*)(bglu + col0 + 32 * bj + 4); }
#pragma unroll
        for (int ai = 0; ai < 2; ++ai) { u32x4 zz[4][2];
#pragma unroll
            for (int m = 0; m < 4; ++m) { const int tok = u.pm * BM + ai * 128 + wr * 64 + m * 16 + fr;
#pragma unroll
                for (int bj = 0; bj < 2; ++bj) zz[m][bj] = *(const u32x4*)(Z + (size_t)tok * SSM_W + col0 + 32 * bj); }
            asm volatile("" ::: "memory");
#pragma unroll
            for (int m = 0; m < 4; ++m) { const int tok = u.pm * BM + ai * 128 + wr * 64 + m * 16 + fr;
#pragma unroll
                for (int bj = 0; bj < 2; ++bj) { f32x4 z0, z1; unpack8(zz[m][bj], z0, z1);
                    f32x4 a = acc[ai][bj][m][0] + cb[bj][0], bb = acc[ai][bj][m][1] + cb[bj][1];
#pragma unroll
                    for (int q = 0; q < 4; ++q) { a[q] = z0[q] * sigmoid_f(a[q]); bb[q] = z1[q] * sigmoid_f(bb[q]); }
                    *(u32x4*)(MA + (size_t)tok * MA_LD + 1024 + col0 + 32 * bj) = pack8(a, bb); } }
            asm volatile("" ::: "memory"); }
    }
};
struct EpiMerged : EpiBase {
    static constexpr bool HAS_MID = true; static constexpr int MID_T = 16;
    unsigned char* ws;
    __device__ __forceinline__ float ratio(float a, float s) const { a = fminf(fmaxf(a, -30.f), 30.f); s = fminf(fmaxf(s, -30.f), 30.f); return (1.f + __expf(-s)) * __builtin_amdgcn_rcpf(1.f + __expf(-a)); }
    __device__ __forceinline__ void mid(Acc& acc, const EpiInfo& u, int wr, int wc, int fr, int fq) const {
        asm volatile("" : "+v"(fr), "+v"(fq));
        const bf16_t* GS = (const bf16_t*)(ws + WS_GS); const bf16_t* GA = (const bf16_t*)(ws + WS_GA);
        const int col0 = u.pn * 256 + 64 * wc + 8 * fq;
#pragma unroll
        for (int ai = 0; ai < 2; ++ai)
#pragma unroll
            for (int mp = 0; mp < 2; ++mp) { u32x4 gs_[2][2], ga_[2][2];
#pragma unroll
                for (int mm = 0; mm < 2; ++mm) { const int tok = u.pm * BM + ai * 128 + wr * 64 + (2 * mp + mm) * 16 + fr;
#pragma unroll
                    for (int bj = 0; bj < 2; ++bj) { gs_[mm][bj] = *(const u32x4*)(GS + (size_t)tok * D + col0 + 32 * bj); ga_[mm][bj] = *(const u32x4*)(GA + (size_t)tok * D + col0 + 32 * bj); } }
#pragma unroll
                for (int mm = 0; mm < 2; ++mm)
#pragma unroll
                    for (int bj = 0; bj < 2; ++bj) { const int m = 2 * mp + mm; const u32x4 ws_ = gs_[mm][bj], wa_ = ga_[mm][bj];
                        acc[ai][bj][m][0][0] *= ratio(bflo(wa_.x), bflo(ws_.x)); acc[ai][bj][m][0][1] *= ratio(bfhi(wa_.x), bfhi(ws_.x));
                        acc[ai][bj][m][0][2] *= ratio(bflo(wa_.y), bflo(ws_.y)); acc[ai][bj][m][0][3] *= ratio(bfhi(wa_.y), bfhi(ws_.y));
                        acc[ai][bj][m][1][0] *= ratio(bflo(wa_.z), bflo(ws_.z)); acc[ai][bj][m][1][1] *= ratio(bfhi(wa_.z), bfhi(ws_.z));
                        acc[ai][bj][m][1][2] *= ratio(bflo(wa_.w), bflo(ws_.w)); acc[ai][bj][m][1][3] *= ratio(bfhi(wa_.w), bfhi(ws_.w)); }
                asm volatile("" ::: "memory"); }
    }
    __device__ __forceinline__ void operator()(Acc& acc, const EpiInfo& u, int wr, int wc, int fr, int fq) const {
        asm volatile("" : "+v"(fr), "+v"(fq));
        const bf16_t* GS = (const bf16_t*)(ws + WS_GS); bf16_t* O = (bf16_t*)(ws + WS_MERGED);
        const int col0 = u.pn * 256 + 64 * wc + 8 * fq;
#pragma unroll
        for (int ai = 0; ai < 2; ++ai) { u32x4 gs_[4][2];
#pragma unroll
            for (int m = 0; m < 4; ++m) { const int tok = u.pm * BM + ai * 128 + wr * 64 + m * 16 + fr;
#pragma unroll
                for (int bj = 0; bj < 2; ++bj) gs_[m][bj] = *(const u32x4*)(GS + (size_t)tok * D + col0 + 32 * bj); }
#pragma unroll
            for (int m = 0; m < 4; ++m) { const int tok = u.pm * BM + ai * 128 + wr * 64 + m * 16 + fr;
#pragma unroll
                for (int bj = 0; bj < 2; ++bj) { f32x4 s0, s1; unpack8(gs_[m][bj], s0, s1);
                    f32x4 a = acc[ai][bj][m][0], bb = acc[ai][bj][m][1];
#pragma unroll
                    for (int q = 0; q < 4; ++q) { a[q] *= sigmoid_c(s0[q]); bb[q] *= sigmoid_c(s1[q]); }
                    *(u32x4*)(O + (size_t)tok * D + col0 + 32 * bj) = pack8(a, bb); } }
            asm volatile("" ::: "memory"); }
    }
};
struct EpiWout : EpiBase {
    const float* x; float* out;
    __device__ __forceinline__ void operator()(Acc& acc, const EpiInfo& u, int wr, int wc, int fr, int fq) const {
        asm volatile("" : "+v"(fr), "+v"(fq));
        const int col0 = u.pn * 256 + 64 * wc + 8 * fq;
#pragma unroll
        for (int ai = 0; ai < 2; ++ai)
#pragma unroll
            for (int mp = 0; mp < 2; ++mp) { f32x4 xv[2][2][2];
#pragma unroll
                for (int mm = 0; mm < 2; ++mm) { const int tok = u.pm * BM + ai * 128 + wr * 64 + (2 * mp + mm) * 16 + fr;
#pragma unroll
                    for (int bj = 0; bj < 2; ++bj) { const size_t o = (size_t)tok * D + col0 + 32 * bj; xv[mm][bj][0] = NT_LOAD((const f32x4*)(x + o)); xv[mm][bj][1] = NT_LOAD((const f32x4*)(x + o + 4)); } }
                asm volatile("" ::: "memory");
#pragma unroll
                for (int mm = 0; mm < 2; ++mm) { const int m = 2 * mp + mm, tok = u.pm * BM + ai * 128 + wr * 64 + m * 16 + fr;
#pragma unroll
                    for (int bj = 0; bj < 2; ++bj) { const size_t o = (size_t)tok * D + col0 + 32 * bj;
                        *(f32x4*)(out + o) = xv[mm][bj][0] + acc[ai][bj][m][0]; *(f32x4*)(out + o + 4) = xv[mm][bj][1] + acc[ai][bj][m][1]; } }
                asm volatile("" ::: "memory"); }
    }
};
struct EpiMoe1 : EpiBase {
    unsigned char* ws; const float* b1; LAS unsigned char* lds; bool nostore = false;
    __device__ __forceinline__ void operator()(Acc& acc, const EpiInfo& u, int wr, int wc, int fr, int fq) const {
        asm volatile("" : "+v"(fr), "+v"(fq));
        unsigned char* ACT = ws + WS_ACT; const int e = u.aux, blk = u.aux2;
        f32x4 cb[2][2];
#pragma unroll
        for (int bj = 0; bj < 2; ++bj) { const int cl = 64 * wc + 32 * bj + 8 * fq;
            if (u.ord < MOE_MAXU) { const LAS float* bl = (const LAS float*)(lds + UB_OFF) + u.ord * 256 + cl; cb[bj][0] = *(const LAS f32x4*)bl; cb[bj][1] = *(const LAS f32x4*)(bl + 4); }
            else { const float* bg = b1 + (size_t)e * 2 * DFF + u.pn * 256 + cl; cb[bj][0] = *(const f32x4*)bg; cb[bj][1] = *(const f32x4*)(bg + 4); __builtin_amdgcn_s_waitcnt(0x0F70); } }
#pragma unroll
        for (int ai = 0; ai < 2; ++ai)
#pragma unroll
            for (int m = 0; m < 4; ++m) { const int row = ai * 128 + wr * 64 + m * 16 + fr; unsigned w[2];
#pragma unroll
                for (int bj = 0; bj < 2; ++bj) { const f32x4 h0 = acc[ai][bj][m][0] + cb[bj][0], h1 = acc[ai][bj][m][1] + cb[bj][1]; float o[4];
#pragma unroll
                    for (int q = 0; q < 4; ++q) { const float gr = q < 2 ? h0[2 * q] : h1[2 * q - 4], ur = q < 2 ? h0[2 * q + 1] : h1[2 * q - 3];
                        const float gate = fminf(gr, 7.f), up = fminf(fmaxf(ur, -7.f), 7.f); o[q] = (up + 1.f) * gate * sigmoid_f(1.702f * gate); }
                    w[bj] = pk4_fp8(o[0], o[1], o[2], o[3]); }
                unsigned char* rowp = ACT + ((size_t)blk * 256 + row) * DFF + ((u.pn * 256 + 64 * wc + 8 * fq) >> 1);
#if defined(PROBE_NOSTORE)
                if (nostore) { asm volatile("" :: "v"(w[0]), "v"(w[1])); } else
#endif
                { *(unsigned*)rowp = w[0]; *(unsigned*)(rowp + 16) = w[1]; } }
    }
};
struct EpiMoe2 : EpiBase {
    unsigned char* ws; const float* b2; LAS unsigned char* lds; bool nostore = false;
    __device__ __forceinline__ void operator()(Acc& acc, const EpiInfo& u, int wr, int wc, int fr, int fq) const {
        asm volatile("" : "+v"(fr), "+v"(fq));
        bf16_t* Y = (bf16_t*)(ws + WS_Y); const int e = u.aux, blk = u.aux2 & 0xffff;
        f32x4 cb[2][2];
#pragma unroll
        for (int bj = 0; bj < 2; ++bj) { const int cl = 64 * wc + 32 * bj + 8 * fq;
            if (u.ord < MOE_MAXU) { const LAS float* bl = (const LAS float*)(lds + UB_OFF) + u.ord * 256 + cl; cb[bj][0] = *(const LAS f32x4*)bl; cb[bj][1] = *(const LAS f32x4*)(bl + 4); }
            else { const float* bg = b2 + (size_t)e * D + u.pn * 256 + cl; cb[bj][0] = *(const f32x4*)bg; cb[bj][1] = *(const f32x4*)(bg + 4); __builtin_amdgcn_s_waitcnt(0x0F70); } }
#pragma unroll
        for (int ai = 0; ai < 2; ++ai)
#pragma unroll
            for (int m = 0; m < 4; ++m) { const int row = ai * 128 + wr * 64 + m * 16 + fr;
#pragma unroll
                for (int bj = 0; bj < 2; ++bj) { const int col = u.pn * 256 + 64 * wc + 32 * bj + 8 * fq;
                    const u32x4 w = pack8(acc[ai][bj][m][0] + cb[bj][0], acc[ai][bj][m][1] + cb[bj][1]);
#if defined(PROBE_NOSTORE)
                    if (nostore) { asm volatile("" :: "v"(w)); } else
#endif
                    store16(Y + ((size_t)blk * 256 + row) * D + col, w); } }
    }
};
}
namespace attn_body {
using bf16=__hip_bfloat16;
using bf16x8=__attribute__((ext_vector_type(8)))short;
using s16x4=__attribute__((ext_vector_type(4)))short;
using f32x16=__attribute__((ext_vector_type(16)))float;
using u32x4=__attribute__((ext_vector_type(4)))unsigned;
constexpr int SEQ=2048,D=64,DM=1024;
constexpr int NW=8,QBLK=32,QB=QBLK*NW,KVBLK=64,NQB=SEQ/QB;
constexpr int ATTN_PITCH=DM, ATTN_UNIT_ROWS=QB;
__device__ __forceinline__ int crow(int r,int hi){return (r&3)+8*(r>>2)+4*hi;}
#define SBAR() __builtin_amdgcn_sched_barrier(0)
__device__ __forceinline__ void cmask(f32x16&p0,f32x16&p1,int jb,int qrel,int hi){
  const float NEG=-INFINITY; int kb=64*jb+4*hi;
  #pragma unroll
  for(int r=0;r<16;++r){int kv=kb+(r&3)+8*(r>>2); if(kv>qrel)p0[r]=NEG; if(kv+32>qrel)p1[r]=NEG;}
}

constexpr int NSLOT=3, SLOTB=8192;
constexpr int LDS_K=0, LDS_V=NSLOT*SLOTB, LDS_WS=2*NSLOT*SLOTB, LDS_OST=LDS_WS+NW*64*4, ALDS_BYTES=LDS_OST+NW*4096;
constexpr float C2=0.125f*1.4426950408889634f;
__device__ __forceinline__ void glds16(const void*gsrc,unsigned lds_dst){unsigned keep;
  asm volatile("s_mov_b32 %0, m0\n\ts_mov_b32 m0, %2\n\ts_nop 0\n\tglobal_load_lds_dwordx4 %1, off\n\ts_mov_b32 m0, %0":"=&s"(keep):"v"(gsrc),"s"(lds_dst):"memory");}
__device__ __forceinline__ float max3f(float a,float b,float c){float r;asm("v_max3_f32 %0, %1, %2, %3":"=v"(r):"v"(a),"v"(b),"v"(c));return r;}
__device__ __forceinline__ float max2f(float a,float b){float r;asm("v_max_f32_e32 %0, %1, %2":"=v"(r):"v"(a),"v"(b));return r;}
__device__ __forceinline__ float fadd_s(float a,float b){float r;asm("v_add_f32_e32 %0, %1, %2":"=v"(r):"v"(a),"v"(b));return r;}
__device__ __forceinline__ float fsub_s(float a,float b){float r;asm("v_sub_f32_e32 %0, %1, %2":"=v"(r):"v"(a),"v"(b));return r;}
typedef float f32x2_t __attribute__((ext_vector_type(2))); typedef __bf16 bf16x2_t __attribute__((ext_vector_type(2)));
__device__ __forceinline__ unsigned cvtpk_s(float lo,float hi){f32x2_t v={lo,hi};bf16x2_t b=__builtin_convertvector(v,bf16x2_t);return __builtin_bit_cast(unsigned,b);}
#define WAIT_BAR(N) asm volatile("s_waitcnt vmcnt(" #N ") lgkmcnt(0)\n\ts_barrier":::"memory")

__device__ __forceinline__ void qkt(f32x16&p0,f32x16&p1,const char*Kslot,const bf16x8*qr,const f32x16&negm,int r32,int hi){
  const char*kb=Kslot+hi*1024+r32*16;
  #pragma unroll
  for(int d0=0;d0<4;++d0){
    const bf16x8 b0=*reinterpret_cast<const bf16x8*>(kb+d0*2048);
    const bf16x8 b1=*reinterpret_cast<const bf16x8*>(kb+d0*2048+512);
    if(d0==0){p0=__builtin_amdgcn_mfma_f32_32x32x16_bf16(b0,qr[0],negm,0,0,0);p1=__builtin_amdgcn_mfma_f32_32x32x16_bf16(b1,qr[0],negm,0,0,0);}
    else{p0=__builtin_amdgcn_mfma_f32_32x32x16_bf16(b0,qr[d0],p0,0,0,0);p1=__builtin_amdgcn_mfma_f32_32x32x16_bf16(b1,qr[d0],p1,0,0,0);}}
}
typedef __attribute__((address_space(3))) const char* lds_cptr;
typedef short v4i16_t __attribute__((ext_vector_type(4)));
__device__ __forceinline__ void kload8(bf16x8*kf,lds_cptr kp){
  kf[0]=*(const __attribute__((address_space(3))) bf16x8*)(kp);      kf[1]=*(const __attribute__((address_space(3))) bf16x8*)(kp+512);
  kf[2]=*(const __attribute__((address_space(3))) bf16x8*)(kp+2048); kf[3]=*(const __attribute__((address_space(3))) bf16x8*)(kp+2560);
  kf[4]=*(const __attribute__((address_space(3))) bf16x8*)(kp+4096); kf[5]=*(const __attribute__((address_space(3))) bf16x8*)(kp+4608);
  kf[6]=*(const __attribute__((address_space(3))) bf16x8*)(kp+6144); kf[7]=*(const __attribute__((address_space(3))) bf16x8*)(kp+6656);
}
__device__ __forceinline__ void kload2(bf16x8*kf,lds_cptr kp,int j){ kf[2*j]=*(const __attribute__((address_space(3))) bf16x8*)(kp+j*2048); kf[2*j+1]=*(const __attribute__((address_space(3))) bf16x8*)(kp+j*2048+512); }
__device__ __forceinline__ s16x4 vtr(lds_cptr p){ return __builtin_bit_cast(s16x4,__builtin_amdgcn_ds_read_tr16_b64_v4i16((__attribute__((address_space(3))) v4i16_t*)p)); }
__device__ __forceinline__ float rowmax(const f32x16&p0,const f32x16&p1){
  float a=max3f(p0[0],p0[1],p1[0]),b=max3f(p0[2],p0[3],p1[1]);a=max3f(a,p1[2],p1[3]);
  #pragma unroll
  for(int r=4;r<16;r+=4){a=max3f(a,p0[r],p0[r+1]);b=max3f(b,p0[r+2],p0[r+3]);a=max3f(a,p1[r],p1[r+1]);b=max3f(b,p1[r+2],p1[r+3]);}
  const float m=max2f(a,b);
  auto rr=__builtin_amdgcn_permlane32_swap(__float_as_uint(m),__float_as_uint(m),false,false);
  return max2f(__uint_as_float(rr[0]),__uint_as_float(rr[1]));
}
__device__ __forceinline__ void pv(f32x16*o,int vb,bf16x8 pa0,bf16x8 pa1,bf16x8 pa2,bf16x8 pa3){
  #pragma unroll
  for(int d0=0;d0<2;++d0){s16x4 lo[4],hi[4];
    #pragma unroll
    for(int ks=0;ks<4;++ks){
      asm volatile("ds_read_b64_tr_b16 %0,%1 offset:%c2":"=&v"(lo[ks]):"v"(vb),"i"(d0*4096+ks*1024):"memory");
      asm volatile("ds_read_b64_tr_b16 %0,%1 offset:%c2":"=&v"(hi[ks]):"v"(vb),"i"(d0*4096+ks*1024+512):"memory");}
    asm volatile("s_waitcnt lgkmcnt(0)":::"memory");SBAR();
    #define PK(k) (bf16x8){lo[k][0],lo[k][1],lo[k][2],lo[k][3],hi[k][0],hi[k][1],hi[k][2],hi[k][3]}
    o[d0]=__builtin_amdgcn_mfma_f32_32x32x16_bf16(pa0,PK(0),o[d0],0,0,0);
    o[d0]=__builtin_amdgcn_mfma_f32_32x32x16_bf16(pa1,PK(1),o[d0],0,0,0);
    o[d0]=__builtin_amdgcn_mfma_f32_32x32x16_bf16(pa2,PK(2),o[d0],0,0,0);
    o[d0]=__builtin_amdgcn_mfma_f32_32x32x16_bf16(pa3,PK(3),o[d0],0,0,0);
    #undef PK
  }
}

#ifndef ATTN_STORE16
#define ATTN_STORE16(p,v) (*(u32x4*)(p)=(v))
#endif
template<int THRL> __device__ __forceinline__ void attn_unit(int b,int qcol,int kcol,int vcol,int ocol,int qb,const bf16*Q,const bf16*__restrict__ K,const bf16*__restrict__ V,bf16*O,char*shm){
  int tid_=threadIdx.x; asm volatile("":"+v"(tid_));
  const int tid=tid_,lane=tid&63,r32=lane&31,hi=lane>>5; const int wid=__builtin_amdgcn_readfirstlane(tid>>6);
  const long rowbase=(long)b*SEQ; const int q0=qb*QB;
  const bf16*Qw=Q+(rowbase+q0+wid*QBLK)*DM+qcol;
  const bf16*Kh=K+rowbase*DM+kcol,*Vh=V+rowbase*DM+vcol;
  const unsigned lds0=(unsigned)(uintptr_t)shm;
  float*wsf=(float*)(shm+LDS_WS)+wid*64;
  const bf16*ksrc=Kh+(long)lane*DM+wid*8;
  const bf16*vsrc=Vh+(long)(16*(wid&3)+(lane>>2))*DM+(wid>>2)*32+(lane&3)*8;
  const unsigned kdst=lds0+LDS_K+wid*1024, vdst=lds0+LDS_V+wid*1024;
  #define DMA_K(t,slot) glds16(ksrc+(long)(t)*KVBLK*DM,(unsigned)__builtin_amdgcn_readfirstlane(kdst+(slot)))
  #define DMA_V(t,slot) glds16(vsrc+(long)(t)*KVBLK*DM,(unsigned)__builtin_amdgcn_readfirstlane(vdst+(slot)))
  const int vb0=(int)(lds0+LDS_V)+((lane>>4)&1)*32+(lane&3)*8+(4*hi+((lane&15)>>2))*64;
  const char*Kbase=shm+LDS_K; bf16x8 kf[8];
  const lds_cptr shm3=(lds_cptr)shm; const lds_cptr kp0=shm3+LDS_K+hi*1024+r32*16; const lds_cptr vp0=shm3+LDS_V+((lane>>4)&1)*32+(lane&3)*8+(4*hi+((lane&15)>>2))*64;
  const int NT=(q0+QB)/KVBLK;
  DMA_K(0,0);DMA_V(0,0);DMA_K(1,SLOTB);
  bf16x8 qr[4];
  #pragma unroll
  for(int d0=0;d0<4;++d0)qr[d0]=*reinterpret_cast<const bf16x8*>(&Qw[(long)r32*DM+d0*16+hi*8]);
  float l_reg=0.f;f32x16 o[2];o[0]=f32x16{};o[1]=f32x16{};const f32x16 negm=f32x16{};
  const int qrel=wid*QBLK+r32;
  #define CMASK(P0,P1,t) do{int jb_=(t)-(NT-4); if(jb_>=0)cmask(P0,P1,jb_,qrel,hi);}while(0)
  #define START(P0,P1) do{ _Pragma("unroll") for(int r=0;r<16;++r)P0[r]=__builtin_amdgcn_exp2f(P0[r]); }while(0)
  #define RESC() do{}while(0)
  f32x16 pA0,pA1,pB0,pB1;
  int sl_prev=0,sl_cur=0,sl_next=SLOTB;
  #define ROT() do{sl_prev=sl_cur;sl_cur=sl_next;sl_next=(sl_next==(NSLOT-1)*SLOTB)?0:sl_next+SLOTB;}while(0)
  DMA_K(2,2*SLOTB);
  WAIT_BAR(3);
  qkt(pA0,pA1,Kbase,qr,negm,r32,hi);asm volatile("s_nop 15\n\ts_nop 7":"+v"(pA0),"+v"(pA1));CMASK(pA0,pA1,0);
  START(pA0,pA1);
  _Pragma("unroll") for(int r=0;r<16;++r)pA1[r]=__builtin_amdgcn_exp2f(pA1[r]);
  WAIT_BAR(0);
  DMA_K(3,0);DMA_V(1,SLOTB);
  ROT();
  kload8(kf,kp0+sl_cur);
  WAIT_BAR(2);
  s16x4 vlo[8],vhi[8]; u32x4 pw0,pw1,pw2,pw3;
  #define PKW(P,B) cvtpk_s(P[B],P[B+1])
  #define PAF(k) __builtin_bit_cast(bf16x8,pw##k)
  #define VFR(i) (bf16x8){vlo[i][0],vlo[i][1],vlo[i][2],vlo[i][3],vhi[i][0],vhi[i][1],vhi[i][2],vhi[i][3]}
  #define PIN(x) asm volatile("":"+v"(x))
  #define MX3(a,b,c) __builtin_fmaxf(__builtin_fmaxf((a),(b)),(c))
  #define GAPA(MF,A0,A1,A2,A3,W0,W1,PW) do{ MF; sacc+=A0; sacc+=A1; sacc+=A2; sacc+=A3; PIN(sacc); W0; W1; PIN(PW); SBAR(); }while(0)
  #define EX(v) __builtin_amdgcn_exp2f(v)
  #define GAPB(MF,X,B) do{ MF; X[B]=EX(X[B]); X[B+1]=EX(X[B+1]); X[B+2]=EX(X[B+2]); X[B+3]=EX(X[B+3]); PIN(X); SBAR(); }while(0)
  #define VRD(i) do{ vlo[i]=vtr(vp_+(((i)>>2)*4096+((i)&3)*1024)); vhi[i]=vtr(vp_+(((i)>>2)*4096+((i)&3)*1024+512)); }while(0)
  #define KRD(G,j) do{ if(G){ kload2(kf,kp0+sl_next,j); SBAR(); } }while(0)
  #define STEP(C0,C1,P0,P1,t,GK,GV,GL) do{ SBAR(); \
    const lds_cptr vp_=vp0+sl_prev; \
    VRD(0); SBAR(); float sacc=(P0[0]+P0[1]); \
    GAPA(C0=__builtin_amdgcn_mfma_f32_32x32x16_bf16(kf[0],qr[0],negm,0,0,0), P0[2],P0[3],P0[4],P0[5],     pw0[0]=PKW(P0,0), pw0[1]=PKW(P0,2), pw0); \
    VRD(4); SBAR(); GAPA(C1=__builtin_amdgcn_mfma_f32_32x32x16_bf16(kf[1],qr[0],negm,0,0,0), P0[6],P0[7],P0[8],P0[9],     pw0[2]=PKW(P0,4), pw0[3]=PKW(P0,6), pw0); \
    VRD(1); SBAR(); GAPA(C0=__builtin_amdgcn_mfma_f32_32x32x16_bf16(kf[2],qr[1],C0,0,0,0),   P0[10],P0[11],P0[12],P0[13], pw1[0]=PKW(P0,8), pw1[1]=PKW(P0,10), pw1); \
    VRD(5); SBAR(); GAPA(C1=__builtin_amdgcn_mfma_f32_32x32x16_bf16(kf[3],qr[1],C1,0,0,0),   P0[14],P0[15],P1[0],P1[1],   pw1[2]=PKW(P0,12),pw1[3]=PKW(P0,14), pw1); \
    VRD(2); SBAR(); GAPA(C0=__builtin_amdgcn_mfma_f32_32x32x16_bf16(kf[4],qr[2],C0,0,0,0),   P1[2],P1[3],P1[4],P1[5],     pw2[0]=PKW(P1,0), pw2[1]=PKW(P1,2), pw2); \
    VRD(6); SBAR(); GAPA(C1=__builtin_amdgcn_mfma_f32_32x32x16_bf16(kf[5],qr[2],C1,0,0,0),   P1[6],P1[7],P1[8],P1[9],     pw2[2]=PKW(P1,4), pw2[3]=PKW(P1,6), pw2); \
    VRD(3); SBAR(); GAPA(C0=__builtin_amdgcn_mfma_f32_32x32x16_bf16(kf[6],qr[3],C0,0,0,0),   P1[10],P1[11],P1[12],P1[13], pw3[0]=PKW(P1,8), pw3[1]=PKW(P1,10), pw3); \
    VRD(7); SBAR(); GAPA(C1=__builtin_amdgcn_mfma_f32_32x32x16_bf16(kf[7],qr[3],C1,0,0,0),   P1[14],P1[15],0.f,0.f,       pw3[2]=PKW(P1,12),pw3[3]=PKW(P1,14), pw3); \
    l_reg+=sacc; \
    if(GK){DMA_K((t)+3,sl_cur);} if(GV){DMA_V((t)+1,sl_next);} \
    CMASK(C0,C1,t); \
    SBAR(); \
    GAPB(o[0]=__builtin_amdgcn_mfma_f32_32x32x16_bf16(PAF(0),VFR(0),o[0],0,0,0), C0,0); \
    GAPB(o[1]=__builtin_amdgcn_mfma_f32_32x32x16_bf16(PAF(0),VFR(4),o[1],0,0,0), C0,4); \
    KRD(GL,0); GAPB(o[0]=__builtin_amdgcn_mfma_f32_32x32x16_bf16(PAF(1),VFR(1),o[0],0,0,0), C0,8); \
    KRD(GL,1); GAPB(o[1]=__builtin_amdgcn_mfma_f32_32x32x16_bf16(PAF(1),VFR(5),o[1],0,0,0), C0,12); \
    KRD(GL,2); GAPB(o[0]=__builtin_amdgcn_mfma_f32_32x32x16_bf16(PAF(2),VFR(2),o[0],0,0,0), C1,0); \
    KRD(GL,3); GAPB(o[1]=__builtin_amdgcn_mfma_f32_32x32x16_bf16(PAF(2),VFR(6),o[1],0,0,0), C1,4); \
    GAPB(o[0]=__builtin_amdgcn_mfma_f32_32x32x16_bf16(PAF(3),VFR(3),o[0],0,0,0), C1,8); \
    GAPB(o[1]=__builtin_amdgcn_mfma_f32_32x32x16_bf16(PAF(3),VFR(7),o[1],0,0,0), C1,12); \
    }while(0)
  int t=1;
  #undef CMASK
  #define CMASK(P0,P1,t) do{}while(0)
  for(;t+5<NT;t+=2){
    STEP(pB0,pB1,pA0,pA1,t,true,true,true);     WAIT_BAR(2); RESC(); ROT();
    STEP(pA0,pA1,pB0,pB1,t+1,true,true,true);   WAIT_BAR(2); RESC(); ROT();
  }
  #undef CMASK
  #define CMASK(P0,P1,t) do{int jb_=(t)-(NT-4); if(jb_>=0)cmask(P0,P1,jb_,qrel,hi);}while(0)
  #define ENDW(tt) do{ if((tt)+3<NT){WAIT_BAR(2);} else if((tt)+2<NT){WAIT_BAR(1);} else {WAIT_BAR(0);} }while(0)
  for(;t+1<NT;t+=2){
    STEP(pB0,pB1,pA0,pA1,t,(t+3<NT),(t+1<NT),(t+1<NT));       ENDW(t);   RESC(); ROT();
    STEP(pA0,pA1,pB0,pB1,t+1,(t+4<NT),(t+2<NT),(t+2<NT));     ENDW(t+1); RESC(); ROT();
  }
  STEP(pB0,pB1,pA0,pA1,NT-1,false,false,false); RESC();
  { float sacc=pB0[0]+pB0[1]; _Pragma("unroll") for(int r=2;r<16;++r)sacc+=pB0[r]; _Pragma("unroll") for(int r=0;r<16;++r)sacc+=pB1[r]; l_reg+=sacc;
    pw0=(u32x4){PKW(pB0,0),PKW(pB0,2),PKW(pB0,4),PKW(pB0,6)};pw1=(u32x4){PKW(pB0,8),PKW(pB0,10),PKW(pB0,12),PKW(pB0,14)};pw2=(u32x4){PKW(pB1,0),PKW(pB1,2),PKW(pB1,4),PKW(pB1,6)};pw3=(u32x4){PKW(pB1,8),PKW(pB1,10),PKW(pB1,12),PKW(pB1,14)};
    SBAR(); pv(o,vb0+sl_cur,PAF(0),PAF(1),PAF(2),PAF(3)); }
  #undef PKW
  #undef PAF
  #undef VFR
  #undef PIN
  #undef MX3
  #undef GAPA
  #undef GAPB
  #undef EX
  #undef VRD
  #undef KRD
  #undef STEP
  #undef ENDW
  {auto rr=__builtin_amdgcn_permlane32_swap(__float_as_uint(l_reg),__float_as_uint(l_reg),false,false);l_reg=__uint_as_float(rr[0])+__uint_as_float(rr[1]);}
  if(hi==0)wsf[32+r32]=l_reg;asm volatile("s_waitcnt lgkmcnt(0)":::"memory");
  float rli[16];
  #pragma unroll
  for(int r=0;r<16;++r)rli[r]=__builtin_amdgcn_rcpf(wsf[32+crow(r,hi)]);
  bf16*Ow=O+(rowbase+q0+wid*QBLK)*DM+ocol;
  { bf16*stg=(bf16*)(shm+LDS_OST)+wid*2048;
    #pragma unroll
    for(int r=0;r<16;++r){const int orow=crow(r,hi);
      #pragma unroll
      for(int d0=0;d0<2;++d0)stg[orow*64+d0*32+r32]=__float2bfloat16(o[d0][r]*rli[r]);}
    asm volatile("s_waitcnt lgkmcnt(0)":::"memory");
    #pragma unroll
    for(int i=0;i<4;++i){const int row=i*8+(lane>>3),ch=lane&7; const u32x4 v=*(const u32x4*)(stg+row*64+ch*8); ATTN_STORE16(Ow+(long)row*DM+ch*8,v);} }
  asm volatile("s_waitcnt lgkmcnt(0)\n\ts_barrier":::"memory");
  #undef DMA_K
  #undef DMA_V
  #undef CMASK
  #undef START
  #undef RESC
  #undef ROT
}
constexpr int ATTN_LDS_BYTES=ALDS_BYTES;

#undef SBAR
#undef WAIT_BAR
#undef ATTN_STORE16
}
namespace attn128 {
using bf16=__hip_bfloat16;
using bf16x8=__attribute__((ext_vector_type(8)))short;
using s16x4=__attribute__((ext_vector_type(4)))short;
using f32x16=__attribute__((ext_vector_type(16)))float;
using u32x4=__attribute__((ext_vector_type(4)))unsigned;
constexpr int SEQ=2048,D=64,DM=1024;
constexpr int NW=8,QBLK=32,QB=QBLK*NW,KVBLK=64,NQB=SEQ/QB;
constexpr int ATTN_PITCH=DM, ATTN_UNIT_ROWS=QB;
__device__ __forceinline__ int crow(int r,int hi){return (r&3)+8*(r>>2)+4*hi;}
#define SBAR() __builtin_amdgcn_sched_barrier(0)
__device__ __forceinline__ void cmask(f32x16&p0,f32x16&p1,int jb,int qrel,int hi){
  const float NEG=-INFINITY; int kb=64*jb+4*hi;
  #pragma unroll
  for(int r=0;r<16;++r){int kv=kb+(r&3)+8*(r>>2); if(kv>qrel)p0[r]=NEG; if(kv+32>qrel)p1[r]=NEG;}
}

constexpr int NSLOT=3, SLOTB=8192;
constexpr int VSLOTB=2*SLOTB;
constexpr int LDS_K=0, LDS_V=NSLOT*SLOTB, LDS_WS=LDS_V+NSLOT*VSLOTB, LDS_OST=LDS_WS+NW*64*4, ALDS_BYTES=LDS_OST+NW*4096;
constexpr float C2=0.125f*1.4426950408889634f;
__device__ __forceinline__ void glds16(const void*gsrc,unsigned lds_dst){unsigned keep;
  asm volatile("s_mov_b32 %0, m0\n\ts_mov_b32 m0, %2\n\ts_nop 0\n\tglobal_load_lds_dwordx4 %1, off\n\ts_mov_b32 m0, %0":"=&s"(keep):"v"(gsrc),"s"(lds_dst):"memory");}
__device__ __forceinline__ float max3f(float a,float b,float c){float r;asm("v_max3_f32 %0, %1, %2, %3":"=v"(r):"v"(a),"v"(b),"v"(c));return r;}
__device__ __forceinline__ float max2f(float a,float b){float r;asm("v_max_f32_e32 %0, %1, %2":"=v"(r):"v"(a),"v"(b));return r;}
__device__ __forceinline__ float fadd_s(float a,float b){float r;asm("v_add_f32_e32 %0, %1, %2":"=v"(r):"v"(a),"v"(b));return r;}
__device__ __forceinline__ float fsub_s(float a,float b){float r;asm("v_sub_f32_e32 %0, %1, %2":"=v"(r):"v"(a),"v"(b));return r;}
typedef float f32x2_t __attribute__((ext_vector_type(2))); typedef __bf16 bf16x2_t __attribute__((ext_vector_type(2)));
__device__ __forceinline__ unsigned cvtpk_s(float lo,float hi){f32x2_t v={lo,hi};bf16x2_t b=__builtin_convertvector(v,bf16x2_t);return __builtin_bit_cast(unsigned,b);}
#define WAIT_BAR(N) asm volatile("s_waitcnt vmcnt(" #N ") lgkmcnt(0)\n\ts_barrier":::"memory")

__device__ __forceinline__ void qkt(f32x16&p0,f32x16&p1,const char*Kslot,const bf16x8*qr,const f32x16&negm,int r32,int hi){
  const char*kb=Kslot+hi*1024+r32*16;
  #pragma unroll
  for(int d0=0;d0<4;++d0){
    const bf16x8 b0=*reinterpret_cast<const bf16x8*>(kb+d0*2048);
    const bf16x8 b1=*reinterpret_cast<const bf16x8*>(kb+d0*2048+512);
    if(d0==0){p0=__builtin_amdgcn_mfma_f32_32x32x16_bf16(b0,qr[0],negm,0,0,0);p1=__builtin_amdgcn_mfma_f32_32x32x16_bf16(b1,qr[0],negm,0,0,0);}
    else{p0=__builtin_amdgcn_mfma_f32_32x32x16_bf16(b0,qr[d0],p0,0,0,0);p1=__builtin_amdgcn_mfma_f32_32x32x16_bf16(b1,qr[d0],p1,0,0,0);}}
}
typedef __attribute__((address_space(3))) const char* lds_cptr;
typedef short v4i16_t __attribute__((ext_vector_type(4)));
__device__ __forceinline__ void kload8(bf16x8*kf,lds_cptr kp){
  kf[0]=*(const __attribute__((address_space(3))) bf16x8*)(kp);      kf[1]=*(const __attribute__((address_space(3))) bf16x8*)(kp+512);
  kf[2]=*(const __attribute__((address_space(3))) bf16x8*)(kp+2048); kf[3]=*(const __attribute__((address_space(3))) bf16x8*)(kp+2560);
  kf[4]=*(const __attribute__((address_space(3))) bf16x8*)(kp+4096); kf[5]=*(const __attribute__((address_space(3))) bf16x8*)(kp+4608);
  kf[6]=*(const __attribute__((address_space(3))) bf16x8*)(kp+6144); kf[7]=*(const __attribute__((address_space(3))) bf16x8*)(kp+6656);
}
__device__ __forceinline__ void kload2(bf16x8*kf,lds_cptr kp,int j){ kf[2*j]=*(const __attribute__((address_space(3))) bf16x8*)(kp+j*2048); kf[2*j+1]=*(const __attribute__((address_space(3))) bf16x8*)(kp+j*2048+512); }
__device__ __forceinline__ s16x4 vtr(lds_cptr p){ return __builtin_bit_cast(s16x4,__builtin_amdgcn_ds_read_tr16_b64_v4i16((__attribute__((address_space(3))) v4i16_t*)p)); }
__device__ __forceinline__ float rowmax(const f32x16&p0,const f32x16&p1){
  float a=max3f(p0[0],p0[1],p1[0]),b=max3f(p0[2],p0[3],p1[1]);a=max3f(a,p1[2],p1[3]);
  #pragma unroll
  for(int r=4;r<16;r+=4){a=max3f(a,p0[r],p0[r+1]);b=max3f(b,p0[r+2],p0[r+3]);a=max3f(a,p1[r],p1[r+1]);b=max3f(b,p1[r+2],p1[r+3]);}
  const float m=max2f(a,b);
  auto rr=__builtin_amdgcn_permlane32_swap(__float_as_uint(m),__float_as_uint(m),false,false);
  return max2f(__uint_as_float(rr[0]),__uint_as_float(rr[1]));
}
__device__ __forceinline__ void pv(f32x16*o,int vb,bf16x8 pa0,bf16x8 pa1,bf16x8 pa2,bf16x8 pa3){
  #pragma unroll
  for(int d0=0;d0<4;++d0){s16x4 lo[4],hi[4];
    #pragma unroll
    for(int ks=0;ks<4;++ks){
      asm volatile("ds_read_b64_tr_b16 %0,%1 offset:%c2":"=&v"(lo[ks]):"v"(vb),"i"(d0*4096+ks*1024):"memory");
      asm volatile("ds_read_b64_tr_b16 %0,%1 offset:%c2":"=&v"(hi[ks]):"v"(vb),"i"(d0*4096+ks*1024+512):"memory");}
    asm volatile("s_waitcnt lgkmcnt(0)":::"memory");SBAR();
    #define PK(k) (bf16x8){lo[k][0],lo[k][1],lo[k][2],lo[k][3],hi[k][0],hi[k][1],hi[k][2],hi[k][3]}
    o[d0]=__builtin_amdgcn_mfma_f32_32x32x16_bf16(pa0,PK(0),o[d0],0,0,0);
    o[d0]=__builtin_amdgcn_mfma_f32_32x32x16_bf16(pa1,PK(1),o[d0],0,0,0);
    o[d0]=__builtin_amdgcn_mfma_f32_32x32x16_bf16(pa2,PK(2),o[d0],0,0,0);
    o[d0]=__builtin_amdgcn_mfma_f32_32x32x16_bf16(pa3,PK(3),o[d0],0,0,0);
    #undef PK
  }
}

#ifndef ATTN_STORE16
#define ATTN_STORE16(p,v) (*(u32x4*)(p)=(v))
#endif
template<int THRL> __device__ __forceinline__ void attn_unit(int b,int qcol,int kcol,int vcol,int ocol,int qb,const bf16*Q,const bf16*__restrict__ K,const bf16*__restrict__ V,bf16*O,char*shm){
  int tid_=threadIdx.x; asm volatile("":"+v"(tid_));
  const int tid=tid_,lane=tid&63,r32=lane&31,hi=lane>>5; const int wid=__builtin_amdgcn_readfirstlane(tid>>6);
  const long rowbase=(long)b*SEQ; const int q0=qb*QB;
  const bf16*Qw=Q+(rowbase+q0+wid*QBLK)*DM+qcol;
  const bf16*Kh=K+rowbase*DM+kcol,*Vh=V+rowbase*DM+vcol;
  const unsigned lds0=(unsigned)(uintptr_t)shm;
  float*wsf=(float*)(shm+LDS_WS)+wid*64;
  const bf16*ksrc=Kh+(long)lane*DM+wid*8;
  const bf16*vsrc=Vh+(long)(16*(wid&3)+(lane>>2))*DM+(wid>>2)*32+(lane&3)*8;
  const unsigned kdst=lds0+LDS_K+wid*1024, vdst=lds0+LDS_V+wid*1024;
  #define DMA_K(t,slot) glds16(ksrc+(long)(t)*KVBLK*DM,(unsigned)__builtin_amdgcn_readfirstlane(kdst+(slot)))
  #define DMA_V(t,slot) do{ glds16(vsrc+(long)(t)*KVBLK*DM,(unsigned)__builtin_amdgcn_readfirstlane(vdst+2*(slot))); glds16(vsrc+64+(long)(t)*KVBLK*DM,(unsigned)__builtin_amdgcn_readfirstlane(vdst+8192+2*(slot))); }while(0)
  const int vb0=(int)(lds0+LDS_V)+((lane>>4)&1)*32+(lane&3)*8+(4*hi+((lane&15)>>2))*64;
  const char*Kbase=shm+LDS_K; bf16x8 kf[8];
  const lds_cptr shm3=(lds_cptr)shm; const lds_cptr kp0=shm3+LDS_K+hi*1024+r32*16; const lds_cptr vp0=shm3+LDS_V+((lane>>4)&1)*32+(lane&3)*8+(4*hi+((lane&15)>>2))*64;
  const int NT=(q0+QB)/KVBLK;
  DMA_K(0,0);DMA_V(0,0);DMA_K(1,SLOTB);
  bf16x8 qr[4];
  #pragma unroll
  for(int d0=0;d0<4;++d0)qr[d0]=*reinterpret_cast<const bf16x8*>(&Qw[(long)r32*DM+d0*16+hi*8]);
  float l_reg=0.f;f32x16 o[4];o[0]=f32x16{};o[1]=f32x16{};o[2]=f32x16{};o[3]=f32x16{};const f32x16 negm=f32x16{};
  const int qrel=wid*QBLK+r32;
  #define CMASK(P0,P1,t) do{int jb_=(t)-(NT-4); if(jb_>=0)cmask(P0,P1,jb_,qrel,hi);}while(0)
  #define START(P0,P1) do{ _Pragma("unroll") for(int r=0;r<16;++r)P0[r]=__builtin_amdgcn_exp2f(P0[r]); }while(0)
  #define RESC() do{}while(0)
  f32x16 pA0,pA1,pB0,pB1;
  int sl_prev=0,sl_cur=0,sl_next=SLOTB;
  #define ROT() do{sl_prev=sl_cur;sl_cur=sl_next;sl_next=(sl_next==(NSLOT-1)*SLOTB)?0:sl_next+SLOTB;}while(0)
  DMA_K(2,2*SLOTB);
  WAIT_BAR(4);
  qkt(pA0,pA1,Kbase,qr,negm,r32,hi);asm volatile("s_nop 15\n\ts_nop 7":"+v"(pA0),"+v"(pA1));CMASK(pA0,pA1,0);
  START(pA0,pA1);
  _Pragma("unroll") for(int r=0;r<16;++r)pA1[r]=__builtin_amdgcn_exp2f(pA1[r]);
  WAIT_BAR(0);
  DMA_K(3,0);DMA_V(1,SLOTB);
  ROT();
  kload8(kf,kp0+sl_cur);
  WAIT_BAR(3);
  s16x4 vlo[8],vhi[8]; u32x4 pw0,pw1,pw2,pw3;
  #define PKW(P,B) cvtpk_s(P[B],P[B+1])
  #define PAF(k) __builtin_bit_cast(bf16x8,pw##k)
  #define VFR(i) (bf16x8){vlo[i][0],vlo[i][1],vlo[i][2],vlo[i][3],vhi[i][0],vhi[i][1],vhi[i][2],vhi[i][3]}
  #define PIN(x) asm volatile("":"+v"(x))
  #define MX3(a,b,c) __builtin_fmaxf(__builtin_fmaxf((a),(b)),(c))
  #define GAPA(MF,A0,A1,A2,A3,W0,W1,PW) do{ MF; sacc+=A0; sacc+=A1; sacc+=A2; sacc+=A3; PIN(sacc); W0; W1; PIN(PW); SBAR(); }while(0)
  #define EX(v) __builtin_amdgcn_exp2f(v)
  #define GAPB(MF,X,B) do{ MF; X[B]=EX(X[B]); X[B+1]=EX(X[B+1]); PIN(X); SBAR(); }while(0)
  #define VRD2(i) do{ vlo[i]=vtr(vp_+((((i)>>2)+2)*4096+((i)&3)*1024)); vhi[i]=vtr(vp_+((((i)>>2)+2)*4096+((i)&3)*1024+512)); }while(0)
  #define VRD(i) do{ vlo[i]=vtr(vp_+(((i)>>2)*4096+((i)&3)*1024)); vhi[i]=vtr(vp_+(((i)>>2)*4096+((i)&3)*1024+512)); }while(0)
  #define KRD(G,j) do{ if(G){ kload2(kf,kp0+sl_next,j); SBAR(); } }while(0)
  #define STEP(C0,C1,P0,P1,t,GK,GV,GL) do{ SBAR(); \
    const lds_cptr vp_=vp0+2*sl_prev; \
    VRD(0); SBAR(); float sacc=(P0[0]+P0[1]); \
    GAPA(C0=__builtin_amdgcn_mfma_f32_32x32x16_bf16(kf[0],qr[0],negm,0,0,0), P0[2],P0[3],P0[4],P0[5],     pw0[0]=PKW(P0,0), pw0[1]=PKW(P0,2), pw0); \
    VRD(4); SBAR(); GAPA(C1=__builtin_amdgcn_mfma_f32_32x32x16_bf16(kf[1],qr[0],negm,0,0,0), P0[6],P0[7],P0[8],P0[9],     pw0[2]=PKW(P0,4), pw0[3]=PKW(P0,6), pw0); \
    VRD(1); SBAR(); GAPA(C0=__builtin_amdgcn_mfma_f32_32x32x16_bf16(kf[2],qr[1],C0,0,0,0),   P0[10],P0[11],P0[12],P0[13], pw1[0]=PKW(P0,8), pw1[1]=PKW(P0,10), pw1); \
    VRD(5); SBAR(); GAPA(C1=__builtin_amdgcn_mfma_f32_32x32x16_bf16(kf[3],qr[1],C1,0,0,0),   P0[14],P0[15],P1[0],P1[1],   pw1[2]=PKW(P0,12),pw1[3]=PKW(P0,14), pw1); \
    VRD(2); SBAR(); GAPA(C0=__builtin_amdgcn_mfma_f32_32x32x16_bf16(kf[4],qr[2],C0,0,0,0),   P1[2],P1[3],P1[4],P1[5],     pw2[0]=PKW(P1,0), pw2[1]=PKW(P1,2), pw2); \
    VRD(6); SBAR(); GAPA(C1=__builtin_amdgcn_mfma_f32_32x32x16_bf16(kf[5],qr[2],C1,0,0,0),   P1[6],P1[7],P1[8],P1[9],     pw2[2]=PKW(P1,4), pw2[3]=PKW(P1,6), pw2); \
    VRD(3); SBAR(); GAPA(C0=__builtin_amdgcn_mfma_f32_32x32x16_bf16(kf[6],qr[3],C0,0,0,0),   P1[10],P1[11],P1[12],P1[13], pw3[0]=PKW(P1,8), pw3[1]=PKW(P1,10), pw3); \
    VRD(7); SBAR(); GAPA(C1=__builtin_amdgcn_mfma_f32_32x32x16_bf16(kf[7],qr[3],C1,0,0,0),   P1[14],P1[15],0.f,0.f,       pw3[2]=PKW(P1,12),pw3[3]=PKW(P1,14), pw3); \
    l_reg+=sacc; \
    if(GK){DMA_K((t)+3,sl_cur);} if(GV){DMA_V((t)+1,sl_next);} \
    CMASK(C0,C1,t); \
    SBAR(); \
    GAPB(o[0]=__builtin_amdgcn_mfma_f32_32x32x16_bf16(PAF(0),VFR(0),o[0],0,0,0), C0,0);  VRD2(0); SBAR(); \
    GAPB(o[1]=__builtin_amdgcn_mfma_f32_32x32x16_bf16(PAF(0),VFR(4),o[1],0,0,0), C0,2);  VRD2(4); SBAR(); \
    KRD(GL,0); GAPB(o[0]=__builtin_amdgcn_mfma_f32_32x32x16_bf16(PAF(1),VFR(1),o[0],0,0,0), C0,4);  VRD2(1); SBAR(); \
    KRD(GL,1); GAPB(o[1]=__builtin_amdgcn_mfma_f32_32x32x16_bf16(PAF(1),VFR(5),o[1],0,0,0), C0,6);  VRD2(5); SBAR(); \
    KRD(GL,2); GAPB(o[0]=__builtin_amdgcn_mfma_f32_32x32x16_bf16(PAF(2),VFR(2),o[0],0,0,0), C0,8);  VRD2(2); SBAR(); \
    KRD(GL,3); GAPB(o[1]=__builtin_amdgcn_mfma_f32_32x32x16_bf16(PAF(2),VFR(6),o[1],0,0,0), C0,10); VRD2(6); SBAR(); \
    GAPB(o[0]=__builtin_amdgcn_mfma_f32_32x32x16_bf16(PAF(3),VFR(3),o[0],0,0,0), C0,12); VRD2(3); SBAR(); \
    GAPB(o[1]=__builtin_amdgcn_mfma_f32_32x32x16_bf16(PAF(3),VFR(7),o[1],0,0,0), C0,14); VRD2(7); SBAR(); \
    GAPB(o[2]=__builtin_amdgcn_mfma_f32_32x32x16_bf16(PAF(0),VFR(0),o[2],0,0,0), C1,0); \
    GAPB(o[3]=__builtin_amdgcn_mfma_f32_32x32x16_bf16(PAF(0),VFR(4),o[3],0,0,0), C1,2); \
    GAPB(o[2]=__builtin_amdgcn_mfma_f32_32x32x16_bf16(PAF(1),VFR(1),o[2],0,0,0), C1,4); \
    GAPB(o[3]=__builtin_amdgcn_mfma_f32_32x32x16_bf16(PAF(1),VFR(5),o[3],0,0,0), C1,6); \
    GAPB(o[2]=__builtin_amdgcn_mfma_f32_32x32x16_bf16(PAF(2),VFR(2),o[2],0,0,0), C1,8); \
    GAPB(o[3]=__builtin_amdgcn_mfma_f32_32x32x16_bf16(PAF(2),VFR(6),o[3],0,0,0), C1,10); \
    GAPB(o[2]=__builtin_amdgcn_mfma_f32_32x32x16_bf16(PAF(3),VFR(3),o[2],0,0,0), C1,12); \
    GAPB(o[3]=__builtin_amdgcn_mfma_f32_32x32x16_bf16(PAF(3),VFR(7),o[3],0,0,0), C1,14); \
    }while(0)
  int t=1;
  #undef CMASK
  #define CMASK(P0,P1,t) do{}while(0)
  for(;t+5<NT;t+=2){
    STEP(pB0,pB1,pA0,pA1,t,true,true,true);     WAIT_BAR(3); RESC(); ROT();
    STEP(pA0,pA1,pB0,pB1,t+1,true,true,true);   WAIT_BAR(3); RESC(); ROT();
  }
  #undef CMASK
  #define CMASK(P0,P1,t) do{int jb_=(t)-(NT-4); if(jb_>=0)cmask(P0,P1,jb_,qrel,hi);}while(0)
  #define ENDW(tt) do{ if((tt)+3<NT){WAIT_BAR(3);} else if((tt)+2<NT){WAIT_BAR(2);} else {WAIT_BAR(0);} }while(0)
  for(;t+1<NT;t+=2){
    STEP(pB0,pB1,pA0,pA1,t,(t+3<NT),(t+1<NT),(t+1<NT));       ENDW(t);   RESC(); ROT();
    STEP(pA0,pA1,pB0,pB1,t+1,(t+4<NT),(t+2<NT),(t+2<NT));     ENDW(t+1); RESC(); ROT();
  }
  STEP(pB0,pB1,pA0,pA1,NT-1,false,false,false); RESC();
  { float sacc=pB0[0]+pB0[1]; _Pragma("unroll") for(int r=2;r<16;++r)sacc+=pB0[r]; _Pragma("unroll") for(int r=0;r<16;++r)sacc+=pB1[r]; l_reg+=sacc;
    pw0=(u32x4){PKW(pB0,0),PKW(pB0,2),PKW(pB0,4),PKW(pB0,6)};pw1=(u32x4){PKW(pB0,8),PKW(pB0,10),PKW(pB0,12),PKW(pB0,14)};pw2=(u32x4){PKW(pB1,0),PKW(pB1,2),PKW(pB1,4),PKW(pB1,6)};pw3=(u32x4){PKW(pB1,8),PKW(pB1,10),PKW(pB1,12),PKW(pB1,14)};
    SBAR(); pv(o,vb0+2*sl_cur,PAF(0),PAF(1),PAF(2),PAF(3)); }
  #undef PKW
  #undef PAF
  #undef VFR
  #undef PIN
  #undef MX3
  #undef GAPA
  #undef GAPB
  #undef EX
  #undef VRD
  #undef VRD2
  #undef KRD
  #undef STEP
  #undef ENDW
  {auto rr=__builtin_amdgcn_permlane32_swap(__float_as_uint(l_reg),__float_as_uint(l_reg),false,false);l_reg=__uint_as_float(rr[0])+__uint_as_float(rr[1]);}
  if(hi==0)wsf[32+r32]=l_reg;asm volatile("s_waitcnt lgkmcnt(0)":::"memory");
  float rli[16];
  #pragma unroll
  for(int r=0;r<16;++r)rli[r]=__builtin_amdgcn_rcpf(wsf[32+crow(r,hi)]);
  bf16*Ow=O+(rowbase+q0+wid*QBLK)*DM+ocol;
  { bf16*stg=(bf16*)(shm+LDS_OST)+wid*2048;
    #pragma unroll
    for(int hv=0;hv<2;++hv){
      #pragma unroll
      for(int r=0;r<16;++r){const int orow=crow(r,hi);
        #pragma unroll
        for(int d0=0;d0<2;++d0)stg[orow*64+d0*32+r32]=__float2bfloat16(o[2*hv+d0][r]*rli[r]);}
      asm volatile("s_waitcnt lgkmcnt(0)":::"memory");
      #pragma unroll
      for(int i=0;i<4;++i){const int row=i*8+(lane>>3),ch=lane&7; const u32x4 v=*(const u32x4*)(stg+row*64+ch*8); ATTN_STORE16(Ow+(long)row*DM+hv*64+ch*8,v);}
      asm volatile("s_waitcnt lgkmcnt(0)":::"memory"); } }
  asm volatile("s_waitcnt lgkmcnt(0)\n\ts_barrier":::"memory");
  #undef DMA_K
  #undef DMA_V
  #undef CMASK
  #undef START
  #undef RESC
  #undef ROT
}
constexpr int ATTN_LDS_BYTES=ALDS_BYTES;

#undef SBAR
#undef WAIT_BAR
#undef ATTN_STORE16
}
constexpr size_t WS_ATT0 = WS_ACT, WS_ATT1 = WS_ACT + 32 * MiB;

__device__ __forceinline__ void diff_combine(const Params& P, int b, int h, int qb) {
    int tid_ = threadIdx.x; asm volatile("" : "+v"(tid_));
    const int tid = tid_, lane = tid & 63, wid = tid >> 6;
    const float lam = __expf(wave_sum(P.in[I_LQ1][lane] * P.in[I_LK1][lane])) - __expf(wave_sum(P.in[I_LQ2][lane] * P.in[I_LK2][lane])) + 0.2f;
    const int ch = lane & 15;
    const f32x4 g0 = *(const f32x4*)(P.in[I_SG] + 8 * ch), g1 = *(const f32x4*)(P.in[I_SG] + 8 * ch + 4);
    const size_t row0 = (size_t)b * SEQ + qb * 256 + wid * 32 + (lane >> 4);
    const bf16_t* s0 = (const bf16_t*)(P.ws + WS_ATT0) + row0 * D + h * 128 + 8 * ch; const bf16_t* s1 = (const bf16_t*)(P.ws + WS_ATT1) + row0 * D + h * 128 + 8 * ch;
    bf16_t* dst = (bf16_t*)(P.ws + WS_MA) + row0 * MA_LD + h * 128 + 8 * ch;
#pragma unroll
    for (int hb = 0; hb < 2; ++hb) { u32x4 ra[4], rb[4];
#pragma unroll
        for (int q = 0; q < 4; ++q) { const int it = 4 * hb + q; ra[q] = *(const u32x4*)(s0 + (size_t)(4 * it) * D); rb[q] = *(const u32x4*)(s1 + (size_t)(4 * it) * D); }
        asm volatile("" ::: "memory");
#pragma unroll
        for (int q = 0; q < 4; ++q) { const int it = 4 * hb + q;
            f32x4 a0, a1, b0, b1; pg::unpack8(ra[q], a0, a1); pg::unpack8(rb[q], b0, b1);
            const f32x4 o0 = a0 - lam * b0, o1 = a1 - lam * b1;
            float ss = (o0[0] * o0[0] + o0[1] * o0[1]) + (o0[2] * o0[2] + o0[3] * o0[3]) + (o1[0] * o1[0] + o1[1] * o1[1]) + (o1[2] * o1[2] + o1[3] * o1[3]);
            ss += __shfl_xor(ss, 1); ss += __shfl_xor(ss, 2); ss += __shfl_xor(ss, 4); ss += __shfl_xor(ss, 8);
            const float r = rsqrtf(ss * (1.f / 128.f) + EPS) * 0.8f;
            *(u32x4*)(dst + (size_t)(4 * it) * MA_LD) = pg::pack8(o0 * r * g0, o1 * r * g1); }
        asm volatile("" ::: "memory"); }
}
__device__ __forceinline__ void attn_phase(const Params& P, char* lds, int vcu, int G) {
    using attn_body::bf16;
    const bf16* Q = (const bf16*)(P.ws + WS_Q); const bf16* K = (const bf16*)(P.ws + WS_K); const bf16* V = (const bf16*)(P.ws + WS_V);
    for (int v = vcu; v < 256; v += G) {
        const int bh = v >> 2, b = bh >> 3, h = bh & 7, s = v & 3;
        for (int i = 0; i < 2; ++i) { const int qb = i == 0 ? 7 - s : s;
#ifndef ATTN_V128
#define ATTN_V128 1
#endif
#if ATTN_V128
            for (int m = 0; m < 2; ++m) {
#if EXPERTS_IN_ATTN
#ifndef CONV_SLOTS
#define CONV_SLOTS 4
#endif
#ifndef CONV_SPLIT
#define CONV_SPLIT 1
#endif
                if (CONV_SLOTS == 2 ? (i == 0 && m == ((v >> 2) & 1)) : ((i * 2 + m - (((v >> 2) + v) & 3)) & (CONV_SPLIT == 2 ? 1 : 3)) == 0) {
                    constexpr int per = (EXP_M10 - EXP_ATT0) / 256; const int hsel = CONV_SPLIT == 2 ? (((i * 2 + m - (((v >> 2) + v) & 3)) >> 1) & 1) : 0;
                    expert_convert_slice(P, (LAS unsigned char*)lds, EXP_ATT0 + v * per + hsel * (per / 2), CONV_SPLIT == 2 ? EXP_ATT0 + v * per + (hsel + 1) * (per / 2) : EXP_ATT0 + (v + 1) * per);
#if defined(PROBE_CONV2)
                    asm volatile("s_waitcnt vmcnt(0) lgkmcnt(0)" ::: "memory"); __syncthreads(); expert_convert_slice(P, (LAS unsigned char*)lds, EXP_ATT0 + v * per, EXP_ATT0 + (v + 1) * per, true);
#endif
                    asm volatile("s_waitcnt vmcnt(0) lgkmcnt(0)" ::: "memory"); __syncthreads(); }
#endif
                attn128::attn_unit<8>(b, h * 128 + m * 64, h * 128 + m * 64, h * 128, h * 128, qb, (const attn128::bf16*)Q, (const attn128::bf16*)K, (const attn128::bf16*)V, (attn128::bf16*)(P.ws + (m == 0 ? WS_ATT0 : WS_ATT1)), lds); }
#else
            for (int pass = 0; pass < 4; ++pass) { const int m = pass >> 1, vh = pass & 1;
#if EXPERTS_IN_ATTN
                if (i * 4 + pass == (((v >> 2) + v) & 3)) {
                    constexpr int per = (EXP_M10 - EXP_ATT0) / 256; expert_convert_slice(P, (LAS unsigned char*)lds, EXP_ATT0 + v * per, EXP_ATT0 + (v + 1) * per);
                    asm volatile("s_waitcnt vmcnt(0) lgkmcnt(0)" ::: "memory"); __syncthreads(); }
#endif
                attn_body::attn_unit<8>(b, h * 128 + m * 64, h * 128 + m * 64, h * 128 + vh * 64, h * 128 + vh * 64, qb, Q, K, V, (bf16*)(P.ws + (m == 0 ? WS_ATT0 : WS_ATT1)), lds); }
#endif
            asm volatile("s_waitcnt vmcnt(0)" ::: "memory");
            diff_combine(P, b, h, qb);
        }
    }
}

__device__ __forceinline__ void ssm1_phase(const Params& P, LAS unsigned char* lds, int vcu, int G) {
    const int tid = opaque_tid(), lane = tid & 63, wid = __builtin_amdgcn_readfirstlane(tid >> 6), fr = lane & 15, fq = lane >> 4;
    LAS float* Sl = (LAS float*)lds;
    for (int u = vcu; u < SSM_G * BATCH; u += G) {
        const int g = u >> 3, b = u & 7;
        bf16_t* A = (bf16_t*)(P.ws + WS_ACAT) + (size_t)(g * ACAT_ROWS + b * NCH) * ACAT_LD;
        const bf16_t* Bw = (const bf16_t*)(P.ws + WS_WS_T) + (size_t)(g * 128 + 16 * wid + fr) * 512 + fq * 8;
        f32x4 acc[4];
#pragma unroll
        for (int m = 0; m < 4; ++m) acc[m] = (f32x4){0.f, 0.f, 0.f, 0.f};
#pragma unroll 4
        for (int ks = 0; ks < 16; ++ks) {
            const bf16x8 bf = *(const bf16x8*)(Bw + ks * 32);
#pragma unroll
            for (int m = 0; m < 4; ++m) { const bf16x8 af = *(const bf16x8*)(A + (size_t)(16 * m + fr) * ACAT_LD + ks * 32 + fq * 8);
                acc[m] = __builtin_amdgcn_mfma_f32_16x16x32_bf16(af, bf, acc[m], 0, 0, 0); }
        }
#pragma unroll
        for (int m = 0; m < 4; ++m)
#pragma unroll
            for (int q = 0; q < 4; ++q) Sl[(16 * m + 4 * fq + q) * 129 + 16 * wid + fr] = acc[m][q];
        __syncthreads();
        if (tid < SSM_P) {
            const int p = tid; const SsmGP gp = ssm_gp(P, g, p); float aLr, aLi; ssm_pow(gp, CH_L, aLr, aLi);
            float xr = 0.f, xi = 0.f;
            bf16_t* xp = A + 512 + p;
            for (int c = 0; c < NCH; ++c) {
                xp[(size_t)c * ACAT_LD] = (bf16_t)f2bf(xr); xp[(size_t)c * ACAT_LD + 64] = (bf16_t)f2bf(xi);
                const float sr = Sl[c * 129 + p], si = Sl[c * 129 + 64 + p];
                const float nr = aLr * xr - aLi * xi + sr, ni = aLr * xi + aLi * xr + si; xr = nr; xi = ni;
            }
        }
        __syncthreads();
    }
}
namespace pg {
struct Ssm2Sched {
    unsigned char* ws; int G, c;
    __device__ __forceinline__ void init(unsigned char* ws_, int G_, int c_) { ws = ws_; G = G_; c = c_; }
    __device__ __forceinline__ bool next(int i, Unit& u) const {
        const int L = i * G + c; if (L >= SSM_G * 4) return false;
        const int g = L >> 2; u.pm = (L >> 1) & 1; u.pn = L & 1; u.aux = g; u.aux2 = 0; u.ord = i; const LaneRC rc;
        u.A = (const char*)((const bf16_t*)(ws + WS_ACAT) + (size_t)g * ACAT_ROWS * ACAT_LD); u.B = (const char*)((const bf16_t*)(ws + WS_BT_SSM) + ((size_t)g * 512 + u.pn * BM) * ACAT_LD);
#pragma unroll
        for (int h = 0; h < 2; ++h)
#pragma unroll
            for (int j = 0; j < 2; ++j) u.aoff[h][j] = (unsigned)(((u.pm * BM + 128 * h + rc.R[j]) * ACAT_LD + rc.C[j]) * 2);
        return true;
    }
};
}

constexpr int RT_LG_OFF = RING_BYTES + 2048;
constexpr int RT_HIST_OFF = RT_LG_OFF + 64 * 33 * 4;
__device__ __forceinline__ void router_phase(const Params& P, LAS unsigned char* lds, int vcu, int G) {
    const int tid = opaque_tid(), lane = tid & 63, wid = __builtin_amdgcn_readfirstlane(tid >> 6);
    const float* wrt = (const float*)(P.ws + WS_WR_T);
#pragma unroll 4
    for (int i = 0; i < 16; ++i) ((LAS f32x4*)lds)[tid + NTHREADS * i] = ((const f32x4*)wrt)[tid + NTHREADS * i];
    LAS float* lg = (LAS float*)(lds + RT_LG_OFF); LAS int* hist = (LAS int*)(lds + RT_HIST_OFF);
    unsigned* cnt = (unsigned*)(P.ws + WS_CTL) + CW_CNT;
    int* slot_tok = (int*)(P.ws + WS_SLOT_TOK); float* slot_gate = (float*)(P.ws + WS_SLOT_GATE); int* tok_ep = (int*)(P.ws + WS_TOK_EP);
    unsigned char* H2 = P.ws + WS_H2;
    f32x4 g2v[4];
#pragma unroll
    for (int j = 0; j < 4; ++j) g2v[j] = ((const f32x4*)P.in[I_G2])[lane + 64 * j];
    for (int tb = vcu; tb < T / 64; tb += G) {
        if (tid < 64) hist[tid] = 0;
        __syncthreads();
        f32x4 n0[4], n1[4];
#pragma unroll
        for (int j = 0; j < 4; ++j) { const int tn = tb * 64 + wid * 8; n0[j] = NT_LOAD((const f32x4*)((const float*)(P.ws + WS_X1) + (size_t)tn * D) + lane + 64 * j); n1[j] = NT_LOAD((const f32x4*)((const float*)(P.ws + WS_X1) + (size_t)(tn + 1) * D) + lane + 64 * j); }
        for (int pass = 0; pass < 4; ++pass) {
            const int t0 = tb * 64 + wid * 8 + pass * 2;
            f32x4 h0[4], h1[4]; float s0 = 0.f, s1 = 0.f;
#pragma unroll
            for (int j = 0; j < 4; ++j) { h0[j] = n0[j]; h1[j] = n1[j]; }
#pragma unroll
            for (int j = 0; j < 4; ++j) { const int tn = tb * 64 + wid * 8 + min(pass + 1, 3) * 2; n0[j] = NT_LOAD((const f32x4*)((const float*)(P.ws + WS_X1) + (size_t)tn * D) + lane + 64 * j); n1[j] = NT_LOAD((const f32x4*)((const float*)(P.ws + WS_X1) + (size_t)(tn + 1) * D) + lane + 64 * j); }
#pragma unroll
            for (int j = 0; j < 4; ++j) {
                s0 += (h0[j].x * h0[j].x + h0[j].y * h0[j].y) + (h0[j].z * h0[j].z + h0[j].w * h0[j].w); s1 += (h1[j].x * h1[j].x + h1[j].y * h1[j].y) + (h1[j].z * h1[j].z + h1[j].w * h1[j].w); }
            const float r0 = rsqrtf(wave_sum(s0) * (1.f / D) + EPS), r1 = rsqrtf(wave_sum(s1) * (1.f / D) + EPS);
#pragma unroll
            for (int j = 0; j < 4; ++j) { h0[j] = h0[j] * r0 * g2v[j]; h1[j] = h1[j] * r1 * g2v[j];
                ((unsigned*)(H2 + (size_t)t0 * D))[lane + 64 * j] = pk4_fp8(h0[j].x, h0[j].y, h0[j].z, h0[j].w);
                ((unsigned*)(H2 + (size_t)(t0 + 1) * D))[lane + 64 * j] = pk4_fp8(h1[j].x, h1[j].y, h1[j].z, h1[j].w); }
            float v[64];
#pragma unroll
            for (int e = 0; e < NE; ++e) { float a0 = 0.f, a1 = 0.f;
#pragma unroll
                for (int j = 0; j < 4; ++j) { const f32x4 w = ((const LAS f32x4*)(lds + e * 4096))[lane + 64 * j];
                    a0 += (h0[j].x * w.x + h0[j].y * w.y) + (h0[j].z * w.z + h0[j].w * w.w); a1 += (h1[j].x * w.x + h1[j].y * w.y) + (h1[j].z * w.z + h1[j].w * w.w); }
                v[e] = a0; v[32 + e] = a1; }
#pragma unroll
            for (int half = 32; half >= 1; half >>= 1) { const bool upper = (lane & half) != 0;
#pragma unroll
                for (int i = 0; i < half; ++i) { const float send = upper ? v[i] : v[i + half], keep = upper ? v[i + half] : v[i]; v[i] = keep + __shfl_xor(send, half); } }
            lg[(wid * 8 + pass * 2 + (lane >> 5)) * 33 + (lane & 31)] = v[0] + P.in[I_BR][lane & 31];
        }
        __syncthreads();
        if (wid == 0) {
            const int tok = tb * 64 + lane;
            float tv[4]; int ti[4];
#pragma unroll
            for (int k = 0; k < 4; ++k) { tv[k] = -INFINITY; ti[k] = 0; }
            for (int e = 0; e < NE; ++e) { const float x = lg[lane * 33 + e];
                if (x > tv[3]) { if (x > tv[2]) { tv[3] = tv[2]; ti[3] = ti[2]; if (x > tv[1]) { tv[2] = tv[1]; ti[2] = ti[1]; if (x > tv[0]) { tv[1] = tv[0]; ti[1] = ti[0]; tv[0] = x; ti[0] = e; } else { tv[1] = x; ti[1] = e; } } else { tv[2] = x; ti[2] = e; } } else { tv[3] = x; ti[3] = e; } } }
            const float e1 = __expf(tv[1] - tv[0]), e2 = __expf(tv[2] - tv[0]), e3 = __expf(tv[3] - tv[0]); const float inv = 1.f / (1.f + e1 + e2 + e3);
            const float gk[4] = {inv, e1 * inv, e2 * inv, e3 * inv};
            int lp[4];
#pragma unroll
            for (int k = 0; k < 4; ++k) lp[k] = atomicAdd((int*)&hist[ti[k]], 1);
            asm volatile("s_waitcnt lgkmcnt(0)" ::: "memory");
            if (lane < NE) { const int n = hist[lane]; hist[32 + lane] = n ? (int)atomicAdd(&cnt[lane], (unsigned)n) : 0; }
            asm volatile("s_waitcnt vmcnt(0) lgkmcnt(0)" ::: "memory");
#pragma unroll
            for (int k = 0; k < 4; ++k) { const int e = ti[k], pos = hist[32 + e] + lp[k];
                slot_tok[(size_t)e * CAP + pos] = tok; slot_gate[(size_t)e * CAP + pos] = gk[k]; tok_ep[tok * 4 + k] = (e << 16) | pos; }
        }
        __syncthreads();
    }
}

#ifndef COMB_Y_DEFAULT
#define COMB_Y_LOAD(p) NT_LOAD(p)
#else
#define COMB_Y_LOAD(p) (*(p))
#endif
__device__ __forceinline__ void combine_phase(const Params& P, LAS unsigned char* lds, int vcu, int G) {
    const int tid = opaque_tid(), lane = tid & 63, wid = __builtin_amdgcn_readfirstlane(tid >> 6);
    const LAS int* tab = (const LAS int*)(lds + pg::TAB_OFF);
    const int* tok_ep = (const int*)(P.ws + WS_TOK_EP); const bf16_t* Y = (const bf16_t*)(P.ws + WS_Y); const float* sgate = (const float*)(P.ws + WS_SLOT_GATE);
    for (int tok = (vcu * NWAVES + wid) * 2; tok < T; tok += G * NWAVES * 2) {
        f32x4 a[2][4]; u32x2 yv[2][4][4]; float gk[2][4];
#pragma unroll
        for (int tt = 0; tt < 2; ++tt) {
#pragma unroll
            for (int j = 0; j < 4; ++j) a[tt][j] = NT_LOAD((const f32x4*)((const float*)(P.ws + WS_X1) + (size_t)(tok + tt) * D) + lane + 64 * j);
#pragma unroll
            for (int k = 0; k < 4; ++k) { const int ep = tok_ep[(tok + tt) * 4 + k]; const int slot = tab[ep >> 16] * 256 + (ep & 0xffff); gk[tt][k] = sgate[(size_t)(ep >> 16) * CAP + (ep & 0xffff)];
#pragma unroll
                for (int j = 0; j < 4; ++j) yv[tt][k][j] = COMB_Y_LOAD((const u32x2*)(Y + (size_t)slot * D) + lane + 64 * j); } }
        asm volatile("" ::: "memory");
#pragma unroll
        for (int tt = 0; tt < 2; ++tt) {
#pragma unroll
            for (int k = 0; k < 4; ++k)
#pragma unroll
                for (int j = 0; j < 4; ++j) { const u32x2 w = yv[tt][k][j]; a[tt][j] += gk[tt][k] * (f32x4){bflo(w.x), bfhi(w.x), bflo(w.y), bfhi(w.y)}; }
#pragma unroll
            for (int j = 0; j < 4; ++j) NT_STORE(a[tt][j], (f32x4*)(P.out + (size_t)(tok + tt) * D) + lane + 64 * j); }
    }
}
#define XB_TMO      128
#define XB_XCNT(j)  (256  + 64 * (j))
#define XB_XSUB(j)  (1280 + 64 * (j))
#define XB_XGEN(j)  (2304 + 64 * (j))
#define XB_TOP      3328
#define XB_TOPGEN   3392
#define XCD_BAR_WORDS 3456
#define XB_SPIN_CAP (1u << 18)
__device__ __forceinline__ unsigned xb_ld(unsigned* p)              { return __hip_atomic_load(p, __ATOMIC_RELAXED, __HIP_MEMORY_SCOPE_AGENT); }
__device__ __forceinline__ unsigned xb_add(unsigned* p, unsigned v) { return __hip_atomic_fetch_add(p, v, __ATOMIC_RELAXED, __HIP_MEMORY_SCOPE_AGENT); }
__device__ __forceinline__ unsigned xb_xcc_id() { return (unsigned)__builtin_amdgcn_s_getreg((3 << 11) | 20) & 0xFu; }
#define XB_SPIN(cond, bar) do { unsigned _sp = 0; while (cond) { __builtin_amdgcn_s_sleep(1); \
    if ((++_sp & 255u) == 0u) { if (xb_ld(&(bar)[XB_TMO])) break; if (_sp > XB_SPIN_CAP) { atomicAdd(&(bar)[XB_TMO], 1u); break; } } } } while (0)
struct XcdBarrier { unsigned* bar; unsigned x; volatile LAS unsigned* st; };
__device__ __forceinline__ XcdBarrier xcd_barrier_post(unsigned* bar, volatile LAS unsigned* st) {
    XcdBarrier b; b.bar = bar; b.x = xb_xcc_id(); b.st = st;
    if (threadIdx.x == 0) (void)xb_add(&bar[XB_XCNT(b.x)], 1u);
    return b;
}
__device__ __forceinline__ void xcd_barrier_complete(unsigned* bar, unsigned x, unsigned& nloc, unsigned& nx) {
    const unsigned G = gridDim.x * gridDim.y * gridDim.z;
    unsigned sum, cnt, mine, sp = 0u;
    for (;;) {
        sum = 0u; cnt = 0u; mine = 0u;
#pragma unroll
        for (unsigned j = 0; j < 16; ++j) { const unsigned c = xb_ld(&bar[XB_XCNT(j)]); sum += c; cnt += (c > 0u) ? 1u : 0u; mine = (j == x) ? c : mine; }
        if (sum == G) break;
        __builtin_amdgcn_s_sleep(1);
        if ((++sp & 255u) == 0u) { if (xb_ld(&bar[XB_TMO])) break; if (sp > XB_SPIN_CAP) { atomicAdd(&bar[XB_TMO], 1u); break; } }
    }
    nloc = mine > 0u ? mine : 1u; nx = cnt > 0u ? cnt : 1u;
}
__device__ __forceinline__ void xcd_barrier(const XcdBarrier& b) {
    asm volatile("s_waitcnt vmcnt(0)" ::: "memory");
    __syncthreads();
    if (threadIdx.x == 0) {
        unsigned* bar = b.bar;
        __builtin_amdgcn_s_waitcnt(0);
        unsigned nloc = b.st[0], nx = b.st[1];
        if (nloc == 0u) { xcd_barrier_complete(bar, b.x, nloc, nx); b.st[0] = nloc; b.st[1] = nx; }
        const unsigned old = xb_add(&bar[XB_XSUB(b.x)], 1u);
        const unsigned gen = old / nloc;
        if (old + 1u == (gen + 1u) * nloc) {
            __builtin_amdgcn_fence(__ATOMIC_RELEASE, "agent");
            asm volatile("s_waitcnt vmcnt(0)" ::: "memory");
            const unsigned og = xb_add(&bar[XB_TOP], 1u);
            const unsigned tg = og / nx;
            if (og + 1u == (tg + 1u) * nx) xb_add(&bar[XB_TOPGEN], 1u);
            else XB_SPIN(xb_ld(&bar[XB_TOPGEN]) == tg, bar);
            __builtin_amdgcn_fence(__ATOMIC_ACQUIRE, "agent");
            xb_add(&bar[XB_XGEN(b.x)], 1u);
            asm volatile("s_waitcnt vmcnt(0)" ::: "memory");
        } else {
            XB_SPIN(xb_ld(&bar[XB_XGEN(b.x)]) == gen, bar);
            __builtin_amdgcn_fence(__ATOMIC_ACQUIRE, "agent");
            asm volatile("s_waitcnt vmcnt(0)" ::: "memory");
        }
    }
    __syncthreads();
}
#ifndef PH_MASK
#define PH_MASK 0xffffffffu
#endif
__global__ void __launch_bounds__(NTHREADS, 2) mega_fwd(Params P) {
    extern __shared__ __attribute__((aligned(16))) unsigned char lds_[];
    LAS unsigned char* lds = (LAS unsigned char*)lds_;
    const int tid = threadIdx.x;
    const int G = gridDim.x, bx = blockIdx.x, vcu = (G % 8 == 0) ? (bx % 8) * (G / 8) + bx / 8 : bx;
    for (int u = tid; u < (LDS_BYTES - RING_BYTES) / 4; u += NTHREADS) ((LAS unsigned*)(lds + RING_BYTES))[u] = 0u;
    __syncthreads();
    unsigned* ctl = (unsigned*)(P.ws + WS_CTL);
    const XcdBarrier bar = xcd_barrier_post(ctl + CW_BAR, (volatile LAS unsigned*)(lds + MISC_OFF) + 8);
#ifndef PH_REP
#define PH_REP 0u
#endif
#ifndef BAR_REP
#define BAR_REP 1
#endif
#define GRID_BAR() do { for (int b_ = 0; b_ < BAR_REP; ++b_) xcd_barrier(bar); } while (0)
#define ON(k) for (int r_ = 0; r_ < 1 + (int)((PH_REP >> (k)) & 1u); ++r_) if ((PH_MASK >> (k)) & 1u)
#ifndef FWD_REP
#define FWD_REP 1
#endif
    for (int fwd_ = 0; fwd_ < FWD_REP; ++fwd_) {
    if (fwd_ > 0) { GRID_BAR(); if (bx == 0 && tid < 64) ctl[CW_CNT + tid] = 0u; }
    ON(0) p0_prologue(P, lds, vcu, G);
    GRID_BAR();
    ON(1) { pg::DenseSched S; S.init((const bf16_t*)(P.ws + WS_XN), D, (const bf16_t*)(P.ws + WS_WIN_T), D, T, IN_W, G, bx);
        pg::EpiInProj E; E.ws = P.ws; E.qg = P.in[I_QG]; E.kg = P.in[I_KG];
#if defined(PROBE_NULL_EPI)
        if (r_ == 1) { pg::EpiNull EN; pg::gemm_phase(lds, S, EN, D / 64, D); } else
#endif
#ifndef INPROJ_BAUX
#define INPROJ_BAUX 0
#endif
        pg::gemm_phase<false, INPROJ_BAUX>(lds, S, E, D / 64, D);
#if EXPERTS_IN_ATTN
        if (r_ == 0 && G == 256 && bx >= 128) expert_convert_slice(P, lds, EXP_IN0 + (bx - 128) * EXP_N_IN, EXP_IN0 + (bx - 127) * EXP_N_IN);
        __syncthreads();
#endif
    }
    GRID_BAR();
    ON(2) { ssm_toeplitz_expand(P, vcu, G); ssm1_phase(P, lds, vcu, G); }
    ON(3) attn_phase(P, (char*)lds_, vcu, G);
    GRID_BAR();
    ON(4) { pg::Ssm2Sched S; S.init(P.ws, G, bx); pg::EpiSsm2 E; E.ws = P.ws; pg::gemm_phase(lds, S, E, ACAT_LD / 64, ACAT_LD);
#if EXPERTS_IN_ATTN
        if (r_ == 0 && G == 256 && bx >= 128) expert_convert_slice(P, lds, EXP_S20 + (bx - 128) * EXP_N_S2, EXP_S20 + (bx - 127) * EXP_N_S2);
        __syncthreads();
#endif
    }
    GRID_BAR();
    ON(5) { pg::DenseSched S; S.init((const bf16_t*)(P.ws + WS_Z), SSM_W, (const bf16_t*)(P.ws + WS_WGLU_T), SSM_W, T, SSM_W, G, bx);
        pg::EpiGlu E; E.ws = P.ws; E.bglu = P.in[I_BGLU]; pg::gemm_phase(lds, S, E, SSM_W / 64, SSM_W);
#if EXPERTS_IN_ATTN
        if (r_ == 0 && G == 256 && bx >= 128) expert_convert_slice(P, lds, EXP_GLU0 + (bx - 128) * EXP_N_GLU, EXP_GLU0 + (bx - 127) * EXP_N_GLU);
        __syncthreads();
#endif
    }
    GRID_BAR();
    ON(6) { pg::DenseSched S; S.init((const bf16_t*)(P.ws + WS_MA), MA_LD, (const bf16_t*)(P.ws + WS_WP_T), MA_LD, T, D, G, bx);
        pg::EpiMerged E; E.ws = P.ws; pg::gemm_phase(lds, S, E, MA_LD / 64, MA_LD); }
    GRID_BAR();
    ON(7) { pg::DenseSched S; S.init((const bf16_t*)(P.ws + WS_MERGED), D, (const bf16_t*)(P.ws + WS_WOUT_T), D, T, D, G, bx);
        pg::EpiWout E; E.x = P.in[I_X]; E.out = (float*)(P.ws + WS_X1); pg::gemm_phase(lds, S, E, D / 64, D); }
    GRID_BAR();
    ON(8) router_phase(P, lds, vcu, G);
    GRID_BAR();
    pg::moe_build_tab(lds, (const unsigned*)(P.ws + WS_CTL) + CW_CNT);
    ON(9) { pg::MoeSched<1> S; S.init(P.ws, lds, G, bx, P.in[I_B1]); pg::EpiMoe1 E; E.ws = P.ws; E.b1 = P.in[I_B1]; E.lds = lds; E.nostore = (r_ == 1);
#if defined(PROBE_MOE_NT)
        if (r_ == 1) { pg::EpiNull EN; pg::gemm_phase<true>(lds, S, EN, PROBE_MOE_NT, D / 2, 7); } else
#endif
        pg::gemm_phase<true>(lds, S, E, D / 128, D / 2);
#if EXPERTS_IN_ATTN
        if (r_ == 0 && G == 256 && (bx >> 3) >= 16) { const int k_ = (bx & 7) * 16 + (bx >> 3) - 16; expert_convert_slice(P, lds, EXP_M10 + k_ * EXP_N_M1, EXP_M10 + (k_ + 1) * EXP_N_M1); }
        __syncthreads();
#endif
    }
    GRID_BAR();
    ON(10) { pg::MoeSched<2> S; S.init(P.ws, lds, G, bx, P.in[I_B2]);
#if defined(PROBE_FREEZE)
        S.freeze = (r_ == 1);
#endif
 pg::EpiMoe2 E; E.ws = P.ws; E.b2 = P.in[I_B2]; E.lds = lds; E.nostore = (r_ == 1);
#if defined(PROBE_MOE_NT)
        if (r_ == 1) { pg::EpiNull EN; pg::gemm_phase<true>(lds, S, EN, PROBE_MOE_NT, DFF / 2, 7); } else
#endif
        pg::gemm_phase<true>(lds, S, E, DFF / 128, DFF / 2); }
    GRID_BAR();
    ON(11) combine_phase(P, lds, vcu, G);
    }
#undef ON
}

extern "C" void kernel_launch(void* const* d_in, const int* in_sizes, int n_in, void* d_out, int out_size, void* d_ws, size_t ws_size, hipStream_t stream) {
    static int grid = 0;
    if (grid == 0) {
        int dev = 0, cus = 0, per_cu = 0;
        if (hipGetDevice(&dev) != hipSuccess || hipDeviceGetAttribute(&cus, hipDeviceAttributeMultiprocessorCount, dev) != hipSuccess) { fprintf(stderr, "kernel_launch: device query failed\n"); grid = -1; return; }
        if (hipFuncSetAttribute((const void*)mega_fwd, hipFuncAttributeMaxDynamicSharedMemorySize, LDS_BYTES) != hipSuccess) { fprintf(stderr, "kernel_launch: hipFuncSetAttribute failed\n"); grid = -1; return; }
        if (hipOccupancyMaxActiveBlocksPerMultiprocessor(&per_cu, (const void*)mega_fwd, NTHREADS, LDS_BYTES) != hipSuccess || per_cu < 1) { fprintf(stderr, "kernel_launch: occupancy query reports %d workgroups per CU\n", per_cu); per_cu = 1; }
        (void)hipGetLastError();
        grid = cus;
        if (ws_size < WS_END) { fprintf(stderr, "kernel_launch: workspace too small\n"); grid = -1; return; }
    }
    if (grid < 0) return;
    hipMemsetAsync((char*)d_ws + WS_CTL, 0, CTL_ZERO_BYTES, stream);
    Params P{};
    for (int i = 0; i < 30; ++i) P.in[i] = (const float*)d_in[i];
    P.out = (float*)d_out; P.ws = (unsigned char*)d_ws;
    hipLaunchKernelGGL(mega_fwd, dim3(grid), dim3(NTHREADS), LDS_BYTES, stream, P);
#if defined(PROBE_TWO_LAUNCHES)
    hipMemsetAsync((char*)d_ws + WS_CTL, 0, CTL_ZERO_BYTES, stream);
    hipLaunchKernelGGL(mega_fwd, dim3(grid), dim3(NTHREADS), LDS_BYTES, stream, P);
#endif
}
```

```cpp
#include <hip/hip_runtime.h>
#include <hip/hip_bf16.h>
#include <stdint.h>
#include <math.h>
#include <cstdio>

constexpr int D = 1024, BATCH = 8, SEQ = 2048, T = BATCH * SEQ;
constexpr int SSM_W = 512, SSM_H = 16, SSM_G = 32, SSM_P = 64;
constexpr int CH_L = 32, NCH = SEQ / CH_L;
constexpr int ACAT_ROWS = BATCH * NCH;
constexpr int ACAT_LD = CH_L * SSM_H + 2 * SSM_P;
constexpr int AH = 8, AW = 1024;
constexpr int IN_W = 5632;
constexpr int NE = 32, DFF = 1024;
constexpr float EPS = 1e-5f;
constexpr int OFF_U = 0, OFF_Q = 512, OFF_K = 1536, OFF_V = 2560, OFF_GS = 3584, OFF_GA = 4608;
constexpr int CAP = T;
constexpr int MAXBLK = 288;
constexpr float QC2 = 0.125f * 1.4426950408889634f;
constexpr int MA_LD = 1536;

constexpr size_t MiB = 1u << 20;
constexpr size_t WS_CTL = 0, CTL_ZERO_BYTES = 64 * 1024;
constexpr size_t WS_WIN_T = 2 * MiB;
constexpr size_t WS_WGLU_T = 13 * MiB;
constexpr size_t WS_WP_T = 14 * MiB;
constexpr size_t WS_WOUT_T = 17 * MiB;
constexpr size_t WS_WR_T = 19 * MiB;
constexpr size_t WS_KJ = 21 * MiB;
constexpr size_t WS_WS_T = 22 * MiB;
constexpr size_t WS_BT_SSM = 26 * MiB;
constexpr size_t WS_W1_T = 48 * MiB;
constexpr size_t WS_W2_T = 176 * MiB;
constexpr size_t WS_XN = 240 * MiB;
constexpr size_t WS_ACAT = 272 * MiB;
constexpr size_t WS_Q = 292 * MiB, WS_K = 324 * MiB, WS_V = 356 * MiB;
constexpr size_t WS_GS = 388 * MiB, WS_GA = 420 * MiB;
constexpr size_t WS_X1 = 292 * MiB;
constexpr size_t WS_Z = 452 * MiB;
constexpr size_t WS_MA = 468 * MiB;
constexpr size_t WS_MERGED = 516 * MiB;
constexpr size_t WS_H2 = 548 * MiB;
constexpr size_t WS_SLOT_TOK = 582 * MiB;
constexpr size_t WS_SLOT_GATE = 584 * MiB;
constexpr size_t WS_TOK_EP = 586 * MiB;
constexpr size_t WS_ACT = 588 * MiB;
constexpr size_t WS_Y = 732 * MiB;
constexpr size_t WS_END = 876 * MiB;
constexpr int CW_CNT = 64;
constexpr int CW_BAR = 4096;

typedef unsigned short bf16_t;
typedef short bf16x8 __attribute__((ext_vector_type(8)));
typedef float f32x4 __attribute__((ext_vector_type(4)));
typedef float f32x2 __attribute__((ext_vector_type(2)));
typedef unsigned u32x4 __attribute__((ext_vector_type(4)));
typedef unsigned u32x2 __attribute__((ext_vector_type(2)));
#define LAS __attribute__((address_space(3)))
#define GAS __attribute__((address_space(1)))

__device__ __forceinline__ float wave_sum(float v) {
#pragma unroll
    for (int o = 1; o < 64; o <<= 1) v += __shfl_xor(v, o);
    return v;
}
typedef __bf16 bf16x2_hw __attribute__((ext_vector_type(2)));
__device__ __forceinline__ unsigned pk2(float lo, float hi) { const f32x2 v = {lo, hi}; return __builtin_bit_cast(unsigned, __builtin_convertvector(v, bf16x2_hw)); }
__device__ __forceinline__ unsigned f2bf(float f) { return pk2(f, 0.f) & 0xffffu; }
__device__ __forceinline__ float bf2f(unsigned short b) { return __builtin_bit_cast(float, (unsigned)b << 16); }
__device__ __forceinline__ float bflo(unsigned w) { return __builtin_bit_cast(float, w << 16); }
__device__ __forceinline__ float bfhi(unsigned w) { return __builtin_bit_cast(float, w & 0xffff0000u); }
__device__ __forceinline__ float sigmoid_f(float x) { return __builtin_amdgcn_rcpf(1.f + __expf(-x)); }
__device__ __forceinline__ float sigmoid_c(float x) { x = fminf(fmaxf(x, -30.f), 30.f); return __builtin_amdgcn_rcpf(1.f + __expf(-x)); }
__device__ __forceinline__ float gelu_tanh(float x) { const float u = 0.7978845608028654f * (x + 0.044715f * x * x * x); return x * sigmoid_f(2.f * u); }

__device__ __forceinline__ unsigned pk4_fp8(float a, float b, float cc, float d) { int w = 0; w = __builtin_amdgcn_cvt_pk_fp8_f32(a, b, w, false); w = __builtin_amdgcn_cvt_pk_fp8_f32(cc, d, w, true); return (unsigned)w; }
__device__ __forceinline__ void unpk4_fp8(unsigned w, float& a, float& b, float& cc, float& d) { const f32x2 lo = __builtin_amdgcn_cvt_pk_f32_fp8((int)w, false), hi = __builtin_amdgcn_cvt_pk_f32_fp8((int)w, true); a = lo.x; b = lo.y; cc = hi.x; d = hi.y; }
constexpr float W8_SCALE = 64.f;
#ifndef WT_STORES
#define WT_STORES 0
#endif
__device__ __forceinline__ void store16(void* p, const u32x4 v) {
#if WT_STORES
    asm volatile("global_store_dwordx4 %0, %1, off sc1\n\ts_nop 1" :: "v"(p), "v"(v) : "memory");
#else
    *(u32x4*)p = v;
#endif
}
#ifndef NT_STREAMS
#define NT_STREAMS 1
#endif
#if NT_STREAMS
#define NT_LOAD(p) __builtin_nontemporal_load(p)
#define NT_STORE(v, p) __builtin_nontemporal_store((v), (p))
#else
#define NT_LOAD(p) (*(p))
#define NT_STORE(v, p) (*(p) = (v))
#endif
__device__ __forceinline__ int opaque_tid() { int t = threadIdx.x; asm volatile("" : "+v"(t)); return t; }

struct Params {
    const float* in[30];
    float* out;
    unsigned char* ws;
};
enum { I_X = 0, I_G1, I_WIN, I_LRE, I_LIM, I_LOGDT, I_BRE, I_BIM, I_CRE, I_CIM, I_DSK, I_WGLU, I_BGLU, I_QG, I_KG, I_LQ1, I_LK1, I_LQ2, I_LK2, I_SG, I_WPS, I_WPA, I_WOUT, I_G2, I_WR, I_BR, I_W1, I_B1, I_W2, I_B2 };

constexpr int NWAVES = 8, NTHREADS = 512;
constexpr int LDS_BYTES = 147456;
constexpr int RING_BYTES = 131072;
constexpr int MISC_OFF = RING_BYTES + 320;
__device__ __forceinline__ void p0_transpose_item(const float* __restrict__ W, int N, bf16_t* __restrict__ WT, int ldo, int k_off, LAS float* scr, int kb, int nb, int lane) {
    const int k0 = 64 * kb, n0 = 32 * nb;
    { f32x4 v[8];
#pragma unroll
        for (int i = 0; i < 8; ++i) v[i] = NT_LOAD((const f32x4*)(W + (size_t)(k0 + 8 * i + (lane >> 3)) * N + n0 + (lane & 7) * 4));
#pragma unroll
        for (int i = 0; i < 8; ++i) { LAS float* d = scr + (8 * i + (lane >> 3)) * 33 + (lane & 7) * 4; d[0] = v[i].x; d[1] = v[i].y; d[2] = v[i].z; d[3] = v[i].w; } }
    asm volatile("s_waitcnt lgkmcnt(0)" ::: "memory");
    const int c = lane & 7;
#pragma unroll
    for (int j = 0; j < 4; ++j) { const int n = (lane >> 3) + 8 * j; const LAS float* s = scr + (8 * c) * 33 + n;
        u32x4 o; o.x = pk2(s[0 * 33], s[1 * 33]); o.y = pk2(s[2 * 33], s[3 * 33]); o.z = pk2(s[4 * 33], s[5 * 33]); o.w = pk2(s[6 * 33], s[7 * 33]);
        *(u32x4*)(WT + (size_t)(n0 + n) * ldo + k_off + k0 + 8 * c) = o; }
    asm volatile("s_waitcnt lgkmcnt(0)" ::: "memory");
}
__device__ __forceinline__ void p0_transpose_item_fp8(const float* __restrict__ W, int N, unsigned char* __restrict__ WT, int ldo, LAS float* scr, int kb, int nb, int lane) {
    const int k0 = 64 * kb, n0 = 32 * nb;
    { f32x4 v[8];
#pragma unroll
        for (int i = 0; i < 8; ++i) v[i] = NT_LOAD((const f32x4*)(W + (size_t)(k0 + 8 * i + (lane >> 3)) * N + n0 + (lane & 7) * 4));
#pragma unroll
        for (int i = 0; i < 8; ++i) { LAS float* d = scr + (8 * i + (lane >> 3)) * 33 + (lane & 7) * 4; d[0] = v[i].x; d[1] = v[i].y; d[2] = v[i].z; d[3] = v[i].w; } }
    asm volatile("s_waitcnt lgkmcnt(0)" ::: "memory");
    const int n = lane >> 1, half = lane & 1; const LAS float* s = scr + (32 * half) * 33 + n;
    unsigned o[8];
#pragma unroll
    for (int q = 0; q < 8; ++q) o[q] = pk4_fp8(s[(4 * q) * 33] * W8_SCALE, s[(4 * q + 1) * 33] * W8_SCALE, s[(4 * q + 2) * 33] * W8_SCALE, s[(4 * q + 3) * 33] * W8_SCALE);
    u32x4* dst = (u32x4*)(WT + (size_t)(n0 + n) * ldo + k0 + 32 * half);
    dst[0] = (u32x4){o[0], o[1], o[2], o[3]}; dst[1] = (u32x4){o[4], o[5], o[6], o[7]};
    asm volatile("s_waitcnt lgkmcnt(0)" ::: "memory");
}
__device__ __forceinline__ void p0_transpose_f32_item(const float* __restrict__ W, float* __restrict__ WT, int K, LAS float* scr, int kb, int lane) {
    const int k0 = 64 * kb;
#pragma unroll 8
    for (int i = 0; i < 32; ++i) { const int kk = 2 * i + (lane >> 5); scr[kk * 33 + (lane & 31)] = W[(size_t)(k0 + kk) * 32 + (lane & 31)]; }
    asm volatile("s_waitcnt lgkmcnt(0)" ::: "memory");
#pragma unroll 8
    for (int n = 0; n < 32; ++n) WT[(size_t)n * K + k0 + lane] = scr[lane * 33 + n];
    asm volatile("s_waitcnt lgkmcnt(0)" ::: "memory");
}
__device__ __forceinline__ void rms_row_to_bf16(const float* __restrict__ xrow, const float* __restrict__ g, bf16_t* __restrict__ orow, int lane) {
    const f32x4* xr = (const f32x4*)xrow + lane; const f32x4* gr = (const f32x4*)g + lane;
    f32x4 v[4]; float s = 0.f;
#pragma unroll
    for (int j = 0; j < 4; ++j) { v[j] = NT_LOAD(xr + 64 * j); s += (v[j].x * v[j].x + v[j].y * v[j].y) + (v[j].z * v[j].z + v[j].w * v[j].w); }
    const float r = rsqrtf(wave_sum(s) * (1.f / D) + EPS);
    u32x2* o8 = (u32x2*)orow + lane;
#pragma unroll
    for (int j = 0; j < 4; ++j) { const f32x4 gg = gr[64 * j]; u32x2 w; w.x = pk2(v[j].x * r * gg.x, v[j].y * r * gg.y); w.y = pk2(v[j].z * r * gg.z, v[j].w * r * gg.w); o8[64 * j] = w; }
}
struct SsmGP { float lrdt, lidt, cr, ci; };
__device__ __forceinline__ SsmGP ssm_gp(const Params& P, int g, int p) {
    const float dt = expf(P.in[I_LOGDT][g]);
    const float lr = fminf(P.in[I_LRE][g * SSM_P + p], -1e-4f), li = P.in[I_LIM][g * SSM_P + p];
    const float mag = expf(lr * dt);
    float sn, cs; sincosf(li * dt, &sn, &cs);
    const float ar = mag * cs, ai = mag * sn;
    const float den = lr * lr + li * li, nr = ar - 1.f;
    SsmGP r; r.lrdt = lr * dt; r.lidt = li * dt; r.cr = (nr * lr + ai * li) / den; r.ci = (ai * lr - nr * li) / den;
    return r;
}
__device__ __forceinline__ void ssm_pow(const SsmGP& q, int j, float& pr, float& pi) {
    const float m = expf((float)j * q.lrdt); float sn, cs; sincosf((float)j * q.lidt, &sn, &cs); pr = m * cs; pi = m * sn;
}

#ifndef EXP_DMA_AUX
#define EXP_DMA_AUX 2
#endif
struct ExpItem { const float* W; unsigned char* WT; int N, ldo, kb, nb, sw; };
__device__ __forceinline__ ExpItem exp_item(const Params& P, int it) {
    constexpr int I_E1 = (1024 / 128) * (2048 / 32), I_E2 = (1024 / 128) * (1024 / 32);
    ExpItem x;
    if (it < NE * I_E1) { const int e = it / I_E1, q = it % I_E1; x.W = P.in[I_W1] + (size_t)e * D * 2 * DFF; x.WT = P.ws + WS_W1_T + (size_t)e * 2 * DFF * D; x.N = 2 * DFF; x.ldo = D; x.kb = q / 64; x.nb = q % 64; x.sw = 3; }
    else { const int r = it - NE * I_E1, e = r / I_E2, q = r % I_E2; x.W = P.in[I_W2] + (size_t)e * DFF * D; x.WT = P.ws + WS_W2_T + (size_t)e * D * DFF; x.N = D; x.ldo = DFF; x.kb = q / 32; x.nb = q % 32; x.sw = 0; }
    return x;
}
__device__ __forceinline__ void exp_dma(const ExpItem& x, int lane, LAS unsigned char* buf) {
    const float* src = x.W + (size_t)(128 * x.kb + (lane >> 3)) * x.N + 32 * x.nb;
#pragma unroll
    for (int i = 0; i < 16; ++i) __builtin_amdgcn_global_load_lds((const unsigned*)(src + (size_t)(8 * i) * x.N + ((((lane & 7) ^ (lane >> 3) ^ (i >> 1)) & 7) << 2)), (LAS unsigned*)(buf + i * 1024), 16, 0, EXP_DMA_AUX);
}
#if defined(PROBE_CONV_NOSTORE)
#define g_conv_nostore nostore_
__device__ __forceinline__ void exp_finish_lds(const ExpItem& x, int lane, const LAS unsigned char* buf, bool nostore_ = false) {
#else
__device__ __forceinline__ void exp_finish_lds(const ExpItem& x, int lane, const LAS unsigned char* buf) {
#endif
    const int c = lane & 7;
#pragma unroll
    for (int pass = 0; pass < 4; ++pass) {
        const int n = 8 * pass + (lane >> 3), q0 = (n >> 2) ^ c;
        const int no = n ^ ((((n >> 1) ^ n) & 1) ? x.sw : 0);
        const LAS unsigned char* rb = buf + c * 2048 + ((n & 3) << 2);
        float f[16];
#pragma unroll
        for (int j = 0; j < 16; ++j) f[j] = *(const LAS float*)(rb + j * 128 + (((q0 ^ j) & 7) << 4)) * W8_SCALE;
        const u32x4 o = (u32x4){pk4_fp8(f[0], f[1], f[2], f[3]), pk4_fp8(f[4], f[5], f[6], f[7]), pk4_fp8(f[8], f[9], f[10], f[11]), pk4_fp8(f[12], f[13], f[14], f[15])};
#if defined(PROBE_CONV_NOSTORE)
        if (g_conv_nostore) { asm volatile("" :: "v"(o)); } else
#endif
#if NT_STREAMS && !defined(CONV_ST_DEFAULT)
        __builtin_nontemporal_store(o, (u32x4*)(x.WT + (size_t)(32 * x.nb + no) * x.ldo + 128 * x.kb + 16 * c));
#else
        *(u32x4*)(x.WT + (size_t)(32 * x.nb + no) * x.ldo + 128 * x.kb + 16 * c) = o;
#endif
    }
    asm volatile("s_waitcnt lgkmcnt(0)" ::: "memory");
}
constexpr int EXP_ITEMS = NE * ((1024 / 128) * (2048 / 32) + (1024 / 128) * (1024 / 32));
constexpr int EXP_N_IN = 32, EXP_N_S2 = 20, EXP_N_GLU = 20, EXP_N_M1 = 0;
constexpr int EXP_IN0 = 0, EXP_S20 = 128 * EXP_N_IN, EXP_GLU0 = EXP_S20 + 128 * EXP_N_S2, EXP_ATT0 = EXP_GLU0 + 128 * EXP_N_GLU, EXP_M10 = EXP_ITEMS - 128 * EXP_N_M1;
static_assert((EXP_M10 - EXP_ATT0) % 256 == 0 && EXP_M10 >= NE * (1024 / 128) * (2048 / 32), "item split (the expert-GEMM-1 tail share must be W2 items only)");
__device__ __forceinline__ void expert_convert_slice(const Params& P, LAS unsigned char* lds, int i0, int i1, bool probe_nostore = false) {
    const int tid = opaque_tid(), lane = tid & 63, wave = __builtin_amdgcn_readfirstlane(tid >> 6);
    LAS unsigned char* b0 = lds + wave * 16384;
    for (int it = i0 + wave; it < i1; it += NWAVES) {
        const ExpItem c0 = exp_item(P, it);
        exp_dma(c0, lane, b0);
        asm volatile("s_waitcnt vmcnt(0)" ::: "memory");
#if defined(PROBE_CONV_NOSTORE)
        exp_finish_lds(c0, lane, b0, probe_nostore);
#else
        exp_finish_lds(c0, lane, b0);
#endif
    }
}
__device__ __forceinline__ void p0_prologue(const Params& P, LAS unsigned char* lds, int vcu, int G) {
    const int tid = opaque_tid(), lane = tid & 63, wave = __builtin_amdgcn_readfirstlane(tid >> 6);
    LAS float* scr = (LAS float*)(lds + wave * 16384);
    unsigned char* ws = P.ws;
    const int gw = vcu * NWAVES + wave, NGW = G * NWAVES;
    constexpr int I_IN = (D / 64) * (IN_W / 32);
    constexpr int I_GLU = (512 / 64) * (512 / 32);
    constexpr int I_PS = (512 / 64) * (1024 / 32);
    constexpr int I_PA = (1024 / 64) * (1024 / 32);
    constexpr int I_OUT = I_PA;
    constexpr int I_R = 1024 / 64;
    constexpr int I_E1 = (1024 / 64) * (2048 / 32);
    constexpr int I_E2 = (1024 / 64) * (1024 / 32);
#ifndef EXPERTS_IN_ATTN
#define EXPERTS_IN_ATTN 1
#endif
    constexpr int NITEMS = I_IN + I_GLU + I_PS + I_PA + I_OUT + I_R + (EXPERTS_IN_ATTN ? 0 : NE * I_E1 + NE * I_E2);
    for (int it = gw; it < NITEMS; it += NGW) {
        int r = it;
        if (r < I_IN) { const int nblk = IN_W / 32; p0_transpose_item(P.in[I_WIN], IN_W, (bf16_t*)(ws + WS_WIN_T), D, 0, scr, r / nblk, r % nblk, lane); continue; } r -= I_IN;
        if (r < I_GLU) { const int nblk = 512 / 32; p0_transpose_item(P.in[I_WGLU], 512, (bf16_t*)(ws + WS_WGLU_T), 512, 0, scr, r / nblk, r % nblk, lane); continue; } r -= I_GLU;
        if (r < I_PS) { const int nblk = 1024 / 32; p0_transpose_item(P.in[I_WPS], 1024, (bf16_t*)(ws + WS_WP_T), MA_LD, 1024, scr, r / nblk, r % nblk, lane); continue; } r -= I_PS;
        if (r < I_PA) { const int nblk = 1024 / 32; p0_transpose_item(P.in[I_WPA], 1024, (bf16_t*)(ws + WS_WP_T), MA_LD, 0, scr, r / nblk, r % nblk, lane); continue; } r -= I_PA;
        if (r < I_OUT) { const int nblk = 1024 / 32; p0_transpose_item(P.in[I_WOUT], 1024, (bf16_t*)(ws + WS_WOUT_T), D, 0, scr, r / nblk, r % nblk, lane); continue; } r -= I_OUT;
        if (r < I_R) { p0_transpose_f32_item(P.in[I_WR], (float*)(ws + WS_WR_T), D, scr, r, lane); continue; } r -= I_R;
        if (EXPERTS_IN_ATTN) continue;
        if (r < NE * I_E1) { const int e = r / I_E1, q = r % I_E1, nblk = 2048 / 32;
            p0_transpose_item_fp8(P.in[I_W1] + (size_t)e * D * 2 * DFF, 2 * DFF, ws + WS_W1_T + (size_t)e * 2 * DFF * D, D, scr, q / nblk, q % nblk, lane); continue; } r -= NE * I_E1;
        { const int e = r / I_E2, q = r % I_E2, nblk = 1024 / 32;
            p0_transpose_item_fp8(P.in[I_W2] + (size_t)e * DFF * D, D, ws + WS_W2_T + (size_t)e * D * DFF, DFF, scr, q / nblk, q % nblk, lane); }
    }
#if EXPERTS_IN_ATTN
    if (G != 256) { __syncthreads(); for (int c0 = vcu * 64; c0 < EXP_ATT0; c0 += G * 64) expert_convert_slice(P, lds, c0, min(EXP_ATT0, c0 + 64));
        for (int c0 = EXP_M10 + vcu * 64; c0 < EXP_ITEMS; c0 += G * 64) expert_convert_slice(P, lds, c0, min(EXP_ITEMS, c0 + 64)); __syncthreads(); }
#endif
    for (int m = gw; m < T; m += NGW) rms_row_to_bf16(P.in[I_X] + (size_t)m * D, P.in[I_G1], (bf16_t*)(ws + WS_XN) + (size_t)m * D, lane);
    if (gw == 0) { u32x4* z = (u32x4*)(ws + WS_H2 + (size_t)T * D); z[lane] = (u32x4){0u, 0u, 0u, 0u}; }
    const int gt = vcu * NTHREADS + tid, NGT = G * NTHREADS;
    for (int it = gw; it < SSM_G * CH_L; it += NGW) {
        const int g = it / CH_L, j = it % CH_L, h = lane >> 2, hq = (lane & 3) * 4;
        { const SsmGP q = ssm_gp(P, g, lane); float pr, pi; ssm_pow(q, j, pr, pi); scr[2 * lane] = pr * q.cr - pi * q.ci; scr[2 * lane + 1] = pr * q.ci + pi * q.cr; }
        asm volatile("s_waitcnt lgkmcnt(0)" ::: "memory");
        float a0 = 0.f, a1 = 0.f, a2 = 0.f, a3 = 0.f;
#pragma unroll 4
        for (int p = 0; p < SSM_P; ++p) {
            const float wr = scr[2 * p], wi = scr[2 * p + 1];
            const float cre = P.in[I_CRE][(g * SSM_H + h) * SSM_P + p], cim = P.in[I_CIM][(g * SSM_H + h) * SSM_P + p];
            const float mr = cre * wr - cim * wi, mi = cre * wi + cim * wr;
            const f32x4 br = *(const f32x4*)(P.in[I_BRE] + (g * SSM_P + p) * SSM_H + hq), bi = *(const f32x4*)(P.in[I_BIM] + (g * SSM_P + p) * SSM_H + hq);
            a0 += mr * br.x - mi * bi.x; a1 += mr * br.y - mi * bi.y; a2 += mr * br.z - mi * bi.z; a3 += mr * br.w - mi * bi.w;
        }
        if (j == 0) { const float dsk = P.in[I_DSK][g * SSM_H + h]; if (hq == (h & 12)) { const int w = h & 3; if (w == 0) a0 += dsk; else if (w == 1) a1 += dsk; else if (w == 2) a2 += dsk; else a3 += dsk; } }
        *(f32x4*)((float*)(ws + WS_KJ) + ((size_t)(g * CH_L + j) * SSM_H + h) * SSM_H + hq) = (f32x4){a0, a1, a2, a3};
        asm volatile("s_waitcnt lgkmcnt(0)" ::: "memory");
    }
    for (int it = gt; it < SSM_G * 128 * CH_L; it += NGT) {
        const int s = it % CH_L, n = (it / CH_L) % 128, g = it / (CH_L * 128), p = n & 63, part = n >> 6;
        const SsmGP q = ssm_gp(P, g, p); float pr, pi; ssm_pow(q, CH_L - 1 - s, pr, pi);
        const float wr = pr * q.cr - pi * q.ci, wi = pr * q.ci + pi * q.cr;
        const float* br = P.in[I_BRE] + (g * SSM_P + p) * SSM_H; const float* bi = P.in[I_BIM] + (g * SSM_P + p) * SSM_H;
        unsigned o[8];
#pragma unroll
        for (int h2 = 0; h2 < 8; ++h2) {
            float v0, v1;
            if (part == 0) { v0 = wr * br[2 * h2] - wi * bi[2 * h2]; v1 = wr * br[2 * h2 + 1] - wi * bi[2 * h2 + 1]; }
            else { v0 = wr * bi[2 * h2] + wi * br[2 * h2]; v1 = wr * bi[2 * h2 + 1] + wi * br[2 * h2 + 1]; }
            o[h2] = pk2(v0, v1);
        }
        u32x4* dst = (u32x4*)((bf16_t*)(ws + WS_WS_T) + ((size_t)(g * 128 + n) * 512 + s * 16));
        dst[0] = (u32x4){o[0], o[1], o[2], o[3]}; dst[1] = (u32x4){o[4], o[5], o[6], o[7]};
    }
    for (int it = gt; it < SSM_G * CH_L * SSM_P; it += NGT) {
        const int p = it % SSM_P, t = (it / SSM_P) % CH_L, g = it / (SSM_P * CH_L);
        const SsmGP q = ssm_gp(P, g, p); float pr, pi; ssm_pow(q, t + 1, pr, pi);
        bf16_t* base = (bf16_t*)(ws + WS_BT_SSM) + ((size_t)(g * 512 + t * 16)) * ACAT_LD + 512 + p;
#pragma unroll 4
        for (int h = 0; h < SSM_H; ++h) {
            const float cre = P.in[I_CRE][(g * SSM_H + h) * SSM_P + p], cim = P.in[I_CIM][(g * SSM_H + h) * SSM_P + p];
            base[(size_t)h * ACAT_LD] = (bf16_t)f2bf(cre * pr - cim * pi);
            base[(size_t)h * ACAT_LD + 64] = (bf16_t)f2bf(-(cre * pi + cim * pr));
        }
    }
}
__device__ __forceinline__ void ssm_toeplitz_expand(const Params& P, int vcu, int G) {
    const int gt = vcu * NTHREADS + opaque_tid(), NGT = G * NTHREADS;
    unsigned char* ws = P.ws;
    for (int it = gt; it < SSM_G * 512 * 64; it += NGT) {
        const int kc = it & 63, n = (it >> 6) & 511, g = it >> 15;
        const int s = kc >> 1, hq = (kc & 1) * 8, t = n >> 4, h = n & 15;
        u32x4 o = (u32x4){0u, 0u, 0u, 0u};
        if (s <= t) { const float* kj = (const float*)(ws + WS_KJ) + ((size_t)(g * CH_L + (t - s)) * SSM_H + h) * SSM_H + hq;
            const f32x4 a = *(const f32x4*)kj, b = *(const f32x4*)(kj + 4);
            o.x = pk2(a.x, a.y); o.y = pk2(a.z, a.w); o.z = pk2(b.x, b.y); o.w = pk2(b.z, b.w); }
        *(u32x4*)((bf16_t*)(ws + WS_BT_SSM) + ((size_t)(g * 512 + n)) * ACAT_LD + kc * 8) = o;
    }
}
#ifndef PG_WGM
#define PG_WGM 8
#endif
namespace pg {
constexpr int BM = 256, BK = 64, HALF = 128, HTB = HALF * BK * 2, STAGE_BYTES = 8 * HTB;
__host__ __device__ __forceinline__ int lds_byte(int r, int c) { const int st = (r >> 4) * 2 + (c >> 5), rr = r & 15, cc = c & 31, ob = rr * 64 + cc * 2; return st * 1024 + (ob ^ (((ob >> 9) & 1) << 5)); }
__host__ __device__ __forceinline__ void stage_rc(int b, int& R, int& C) { const int st = b / 1024, sb = b % 1024, swz = sb ^ (((sb >> 9) & 1) << 5); R = (st >> 1) * 16 + swz / 64; C = (st & 1) * 32 + (swz % 64) / 2; }
__host__ __device__ __forceinline__ int perm32(int rho) { const int n = rho >> 4, i = rho & 15; return 8 * (i >> 2) + 4 * n + (i & 3); }

struct Unit {
    const char* A;
    const char* B;
    unsigned aoff[2][2];
    int pm, pn, aux, aux2;
    int ord;
};
struct EpiInfo { int pm, pn, aux, aux2, ord; };
typedef f32x4 Acc[2][2][4][2];

typedef int v8i_t __attribute__((ext_vector_type(8)));
typedef int v4i_t __attribute__((ext_vector_type(4)));
template <bool FP8 = false, int BAUX = 0  , class Sched, class Epi>
__device__ __forceinline__ void gemm_phase(LAS unsigned char* lds, const Sched& S, const Epi& E, const int nt, const int ldb, const int ktm = -1  ) {
    const int tid = opaque_tid(), wid = __builtin_amdgcn_readfirstlane(tid >> 6), lane = tid & 63, wr = wid >> 2, wc = wid & 3, fr = lane & 15, fq = lane >> 4;
    unsigned voffB[2];
#pragma unroll
    for (int i = 0; i < 2; ++i) { int R, C; stage_rc(tid * 16 + i * 8192, R, C); voffB[i] = (unsigned)((64 * (R >> 5) + perm32(R & 31)) * ldb + C) * 2u; }
    const unsigned hB = (unsigned)(32 * ldb * 2);
    const unsigned ldsw = (unsigned)wid * 1024u;
    const int aoffl = lds_byte(wr * 64 + fr, fq * 8), boffl = lds_byte(wc * 32 + fr, fq * 8);
#define PG_SA(b, h) (((b) * 2 + (h)) * pg::HTB)
#define PG_SB(b, h) ((4 + (b) * 2 + (h)) * pg::HTB)
#define PG_GLDS(gp, bufoff, i) __builtin_amdgcn_global_load_lds((const unsigned*)(gp), (LAS unsigned*)(lds + (bufoff) + ldsw + (i) * 8192), 16, 0, 0)
#define PG_STAGE_A(bufoff, Ab, o0, o1, kt) do { const char* _b = (Ab) + (size_t)((kt) & ktm) * 128; PG_GLDS(_b + (o0), bufoff, 0); PG_GLDS(_b + (o1), bufoff, 1); } while (0)
#define PG_GLDSB(gp, bufoff, i) __builtin_amdgcn_global_load_lds((const unsigned*)(gp), (LAS unsigned*)(lds + (bufoff) + ldsw + (i) * 8192), 16, 0, BAUX)
#define PG_STAGE_B(bufoff, Bb, h, kt) do { const char* _b = (Bb) + (size_t)((kt) & ktm) * 128 + (h) * hB; PG_GLDSB(_b + voffB[0], bufoff, 0); PG_GLDSB(_b + voffB[1], bufoff, 1); } while (0)
#define PG_LDA(dst, b, h) do { _Pragma("unroll") for (int m = 0; m < 4; ++m) _Pragma("unroll") for (int k = 0; k < 2; ++k) dst[m][k] = *(const LAS bf16x8*)(lds + PG_SA(b, h) + aoffl + m * 2048 + k * 1024); } while (0)
#define PG_LDB(dst, b, h) do { _Pragma("unroll") for (int n = 0; n < 2; ++n) _Pragma("unroll") for (int k = 0; k < 2; ++k) dst[n][k] = *(const LAS bf16x8*)(lds + PG_SB(b, h) + boffl + n * 2048 + k * 1024); } while (0)
#define PG_CAT8(lo, hi) __builtin_shufflevector(__builtin_bit_cast(v4i_t, lo), __builtin_bit_cast(v4i_t, hi), 0, 1, 2, 3, 4, 5, 6, 7)
#define PG_MMA(ai, bj, At, Bt) do { __builtin_amdgcn_s_setprio(1); if constexpr (FP8) { _Pragma("unroll") for (int m = 0; m < 4; ++m) _Pragma("unroll") for (int n = 0; n < 2; ++n) \
            acc[ai][bj][m][n] = __builtin_amdgcn_mfma_scale_f32_16x16x128_f8f6f4(PG_CAT8(Bt[n][0], Bt[n][1]), PG_CAT8(At[m][0], At[m][1]), acc[ai][bj][m][n], 0, 0, 0, 0x79797979, 0, 0x7f7f7f7f); } \
        else { _Pragma("unroll") for (int m = 0; m < 4; ++m) _Pragma("unroll") for (int n = 0; n < 2; ++n) _Pragma("unroll") for (int k = 0; k < 2; ++k) \
        acc[ai][bj][m][n] = __builtin_amdgcn_mfma_f32_16x16x32_bf16(Bt[n][k], At[m][k], acc[ai][bj][m][n], 0, 0, 0); } __builtin_amdgcn_s_setprio(0); } while (0)
#define PG_WAIT_V(n) asm volatile("s_waitcnt vmcnt(" #n ")" ::: "memory")
#define PG_WAIT_L(n) asm volatile("s_waitcnt lgkmcnt(" #n ")" ::: "memory")
#define PG_BAR __builtin_amdgcn_s_barrier()
#define PG_SCHED __builtin_amdgcn_sched_barrier(0)
#define PG_KLOOP(T0, T1) _Pragma("clang loop unroll(disable)") for (int t = (T0); t < (T1); t += 2) { \
            const bool last = (t == nt - 2); \
            PG_LDB(B0, 0, 0); PG_LDB(B1, 0, 1); PG_SCHED; PG_LDA(At, 0, 0); PG_STAGE_A(PG_SA(1, 1), st.A, st.aoff[1][0], st.aoff[1][1], t + 1); \
            if (last) { Unit nu_; has_next = S.next(ui + 1, nu_); if (has_next) { st = nu_; } } \
            const int k2 = last ? 0 : t + 2, k3 = k2 + 1; \
            PG_WAIT_V(8); PG_WAIT_L(0); PG_BAR; PG_MMA(0, 0, At, B0); PG_MMA(0, 1, At, B1); PG_BAR; PG_SCHED; \
            PG_LDA(At, 0, 1); PG_STAGE_B(PG_SB(0, 0), st.B, 0, k2); PG_STAGE_B(PG_SB(0, 1), st.B, 1, k2); PG_STAGE_A(PG_SA(0, 0), st.A, st.aoff[0][0], st.aoff[0][1], k2); \
            PG_WAIT_V(8); PG_WAIT_L(0); PG_BAR; PG_MMA(1, 0, At, B0); PG_MMA(1, 1, At, B1); PG_BAR; PG_SCHED; \
            PG_LDB(B0, 1, 0); PG_LDB(B1, 1, 1); PG_SCHED; PG_LDA(At, 1, 0); PG_STAGE_A(PG_SA(0, 1), st.A, st.aoff[1][0], st.aoff[1][1], k2); \
            PG_WAIT_V(8); PG_WAIT_L(0); PG_BAR; PG_MMA(0, 0, At, B0); PG_MMA(0, 1, At, B1); PG_BAR; PG_SCHED; \
            PG_LDA(At, 1, 1); PG_STAGE_B(PG_SB(1, 0), st.B, 0, k3); PG_STAGE_B(PG_SB(1, 1), st.B, 1, k3); PG_STAGE_A(PG_SA(1, 0), st.A, st.aoff[0][0], st.aoff[0][1], k3); \
            PG_WAIT_V(8); PG_WAIT_L(0); PG_BAR; PG_MMA(1, 0, At, B0); PG_MMA(1, 1, At, B1); PG_BAR; PG_SCHED; \
        }
    Unit st; int ui = 0;
    if (!S.next(0, st)) return;
    EpiInfo cur; cur.pm = st.pm; cur.pn = st.pn; cur.aux = st.aux; cur.aux2 = st.aux2; cur.ord = st.ord;
    Acc acc;
#pragma unroll
    for (int a = 0; a < 2; ++a)
#pragma unroll
        for (int b = 0; b < 2; ++b)
#pragma unroll
            for (int m = 0; m < 4; ++m)
#pragma unroll
                for (int n = 0; n < 2; ++n) acc[a][b][m][n] = (f32x4){0.f, 0.f, 0.f, 0.f};
    bf16x8 At[4][2], B0[2][2], B1[2][2];
    PG_STAGE_B(PG_SB(0, 0), st.B, 0, 0); PG_STAGE_B(PG_SB(0, 1), st.B, 1, 0); PG_STAGE_A(PG_SA(0, 0), st.A, st.aoff[0][0], st.aoff[0][1], 0); PG_STAGE_A(PG_SA(0, 1), st.A, st.aoff[1][0], st.aoff[1][1], 0);
    if (wr == 1) PG_BAR;
    PG_WAIT_V(2); PG_BAR;
    PG_STAGE_B(PG_SB(1, 0), st.B, 0, 1); PG_STAGE_A(PG_SA(1, 0), st.A, st.aoff[0][0], st.aoff[0][1], 1); PG_STAGE_B(PG_SB(1, 1), st.B, 1, 1);
    PG_WAIT_V(6); PG_BAR;
    for (;;) {
        bool has_next = false;
        if constexpr (Epi::HAS_MID) { PG_KLOOP(0, Epi::MID_T) E.mid(acc, cur, wr, wc, fr, fq); PG_KLOOP(Epi::MID_T, nt) } else { PG_KLOOP(0, nt) }
        if (wr == 0) PG_BAR;
        E(acc, cur, wr, wc, fr, fq);
        if (!has_next) break;
#pragma unroll
        for (int a = 0; a < 2; ++a)
#pragma unroll
            for (int b = 0; b < 2; ++b)
#pragma unroll
                for (int m = 0; m < 4; ++m)
#pragma unroll
                    for (int n = 0; n < 2; ++n) acc[a][b][m][n] = (f32x4){0.f, 0.f, 0.f, 0.f};
        cur.pm = st.pm; cur.pn = st.pn; cur.aux = st.aux; cur.aux2 = st.aux2; cur.ord = st.ord; ++ui;
        if (wr == 1) PG_BAR;
    }
    PG_WAIT_V(0);
    PG_BAR;
#undef PG_SA
#undef PG_SB
#undef PG_GLDS
#undef PG_GLDSB
#undef PG_STAGE_A
#undef PG_STAGE_B
#undef PG_LDA
#undef PG_LDB
#undef PG_MMA
#undef PG_WAIT_V
#undef PG_WAIT_L
#undef PG_BAR
#undef PG_SCHED
#undef PG_KLOOP
}

struct LaneRC { int R[2], C[2]; __device__ __forceinline__ LaneRC() { const int t = opaque_tid(); stage_rc(t * 16, R[0], C[0]); stage_rc(t * 16 + 8192, R[1], C[1]); } };

struct DenseSched {
    const bf16_t* A; const bf16_t* Bt; int lda, ldb, nM, nN, nwg, G, c;
    __device__ __forceinline__ void init(const bf16_t* A_, int lda_, const bf16_t* Bt_, int ldb_, int M, int N, int G_, int c_) { A = A_; Bt = Bt_; lda = lda_; ldb = ldb_; nM = M / BM; nN = N / BM; nwg = nM * nN; G = G_; c = c_; }
    __device__ __forceinline__ bool next(int i, Unit& u) const {
        const long L = (long)i * G + c; if (L >= nwg) return false;
        int wgid = (int)L; { const int q = nwg / 8, r = nwg % 8, xcd = wgid % 8, off = wgid / 8; wgid = (xcd < r ? xcd * (q + 1) : r * (q + 1) + (xcd - r) * q) + off; }
        const int WGM = PG_WGM, nig = WGM * nN, gid = wgid / nig, fm = gid * WGM, gsz = (nM - fm) < WGM ? (nM - fm) : WGM;
        u.pm = fm + ((wgid % nig) % gsz); u.pn = (wgid % nig) / gsz; u.aux = 0; u.aux2 = 0; u.ord = i;
        u.A = (const char*)A; u.B = (const char*)(Bt + (size_t)u.pn * BM * ldb); const LaneRC rc;
#pragma unroll
        for (int h = 0; h < 2; ++h)
#pragma unroll
            for (int j = 0; j < 2; ++j) u.aoff[h][j] = (unsigned)(((u.pm * BM + 128 * h + rc.R[j]) * lda + rc.C[j]) * 2);
        return true;
    }
};
}
namespace pg {
constexpr int TAB_OFF = RING_BYTES + 1024;
__device__ __forceinline__ void moe_build_tab(LAS unsigned char* lds, const unsigned* cnt) {
    LAS int* tab = (LAS int*)(lds + TAB_OFF);
    if (threadIdx.x == 0) { int acc = 0; for (int e = 0; e < NE; ++e) { const int n = (int)__hip_atomic_load(cnt + e, __ATOMIC_RELAXED, __HIP_MEMORY_SCOPE_AGENT); tab[e] = acc; tab[40 + e] = n; acc += (n + 255) >> 8; } tab[NE] = acc; }
    __syncthreads();
}
#ifndef MOE_MAXU_OVERRIDE
#define MOE_MAXU_OVERRIDE 9
#endif
constexpr int MOE_MAXU = MOE_MAXU_OVERRIDE;
constexpr int UT_OFF = RING_BYTES + 1536;
constexpr int UB_OFF = UT_OFF + MOE_MAXU * 512;
static_assert(UB_OFF + MOE_MAXU * 1024 <= LDS_BYTES, "LDS map");
template <int KIND>
struct MoeSched {
    static constexpr int NPN = KIND == 1 ? 8 : 4;
    unsigned char* ws; const LAS int* tab; LAS unsigned char* lds; int G, c; bool freeze = false;
    __device__ __forceinline__ bool unit(int i, int& e, int& rb, int& pn) const {
        const int x = c & 7, j = c >> 3, NJ = G >> 3;
        int L = i * NJ + j; e = -1; rb = 0; pn = 0;
#pragma unroll
        for (int q = 0; q < NE / 8; ++q) { const int eq = x + 8 * q, uq = (tab[eq + 1] - tab[eq]) * NPN;
            if (e < 0) { if (L < uq) { e = eq; rb = L / NPN; pn = L % NPN; } else L -= uq; } }
        if (e < 0) return false;
        e = __builtin_amdgcn_readfirstlane(e); rb = __builtin_amdgcn_readfirstlane(rb); pn = __builtin_amdgcn_readfirstlane(pn);
        return true;
    }
    __device__ __forceinline__ void init(unsigned char* ws_, LAS unsigned char* lds_, int G_, int c_, const float* bias) {
        ws = ws_; lds = lds_; tab = (const LAS int*)(lds_ + TAB_OFF); G = G_; c = c_;
        const int tid = opaque_tid();
        for (int i = 0; i < MOE_MAXU; ++i) { int e, rb, pn; if (!unit(i, e, rb, pn)) break;
            if (tid < 256) { if (KIND == 1) { const int nvalid = min(256, tab[40 + e] - rb * 256); const int tok = tid < nvalid ? ((const int*)(ws + WS_SLOT_TOK))[(size_t)e * CAP + rb * 256 + tid] : T;
                    ((LAS unsigned short*)(lds + UT_OFF))[i * 256 + tid] = (unsigned short)tok; } }
            else ((LAS float*)(lds + UB_OFF))[i * 256 + tid - 256] = bias[(size_t)e * (NPN * 256) + pn * 256 + tid - 256]; }
        __syncthreads();
    }
    __device__ __forceinline__ bool next(int i, Unit& u) const {
        int e, rb, pn; if (!unit(i, e, rb, pn)) return false;
#if defined(PROBE_FREEZE)
        if (freeze) { int e0, r0, p0; unit(0, e0, r0, p0); e = e0; rb = r0; pn = p0; }
#endif
        const int blk = tab[e] + rb, nvalid = min(256, tab[40 + e] - rb * 256);
        u.pm = rb; u.pn = pn; u.aux = e; u.ord = i; const LaneRC rc;
        if (KIND == 1) {
            u.aux2 = blk; u.A = (const char*)(ws + WS_H2); u.B = (const char*)(ws + WS_W1_T + ((size_t)e * 2 * DFF + (size_t)pn * BM) * D);
#pragma unroll
            for (int h = 0; h < 2; ++h)
#pragma unroll
                for (int jj = 0; jj < 2; ++jj) { const int r = 128 * h + rc.R[jj]; int tok;
                    if (i < MOE_MAXU) tok = ((const LAS unsigned short*)(lds + UT_OFF))[i * 256 + r];
                    else { tok = r < nvalid ? ((const int*)(ws + WS_SLOT_TOK))[(size_t)e * CAP + rb * 256 + r] : T; __builtin_amdgcn_s_waitcnt(0x0F70); }
                    u.aoff[h][jj] = (unsigned)(tok * D + rc.C[jj] * 2); }
        } else {
            u.aux2 = blk | (nvalid << 16); u.A = (const char*)(ws + WS_ACT); u.B = (const char*)(ws + WS_W2_T + ((size_t)e * D + (size_t)pn * BM) * DFF);
#pragma unroll
            for (int h = 0; h < 2; ++h)
#pragma unroll
                for (int jj = 0; jj < 2; ++jj) u.aoff[h][jj] = (unsigned)((blk * 256 + 128 * h + rc.R[jj]) * DFF + rc.C[jj] * 2);
        }
        return true;
    }
};
}
namespace pg {
struct EpiBase { static constexpr bool HAS_MID = false; static constexpr int MID_T = -1; __device__ __forceinline__ void mid(Acc&, const EpiInfo&, int, int, int, int) const {} };
__device__ __forceinline__ u32x4 pack8(const f32x4 a, const f32x4 b) { u32x4 w; w.x = pk2(a[0], a[1]); w.y = pk2(a[2], a[3]); w.z = pk2(b[0], b[1]); w.w = pk2(b[2], b[3]); return w; }
__device__ __forceinline__ void unpack8(const u32x4 w, f32x4& a, f32x4& b) { a = (f32x4){bflo(w.x), bfhi(w.x), bflo(w.y), bfhi(w.y)}; b = (f32x4){bflo(w.z), bfhi(w.z), bflo(w.w), bfhi(w.w)}; }

struct EpiNull : EpiBase {
    __device__ __forceinline__ void operator()(Acc& acc, const EpiInfo&, int, int, int, int) const {
#pragma unroll
        for (int a = 0; a < 2; ++a)
#pragma unroll
            for (int b = 0; b < 2; ++b)
#pragma unroll
                for (int m = 0; m < 4; ++m)
#pragma unroll
                    for (int n = 0; n < 2; ++n) asm volatile("" :: "v"(acc[a][b][m][n]));
    }
};
struct EpiInProj : EpiBase {
    unsigned char* ws; const float* qg; const float* kg;
    __device__ __forceinline__ void operator()(Acc& acc, const EpiInfo& u, int wr, int wc, int fr, int fq) const {
        const int pn = u.pn, row0 = u.pm * BM + wr * 64 + fr, colw = 64 * wc + 8 * fq;
        if (pn < 2) {
            bf16_t* acat = (bf16_t*)(ws + WS_ACAT);
#pragma unroll
            for (int ai = 0; ai < 2; ++ai)
#pragma unroll
                for (int m = 0; m < 4; ++m) { const int tok = row0 + ai * 128 + m * 16;
#pragma unroll
                    for (int bj = 0; bj < 2; ++bj) { const int cu = pn * 256 + colw + 32 * bj, g = cu >> 4, h0 = cu & 15;
                        *(u32x4*)(acat + ((size_t)(g * ACAT_ROWS + (tok >> 5))) * ACAT_LD + (tok & 31) * 16 + h0) = pack8(acc[ai][bj][m][0], acc[ai][bj][m][1]); } }
        } else if (pn < 10) {
            const bool isq = pn < 6; const float* gain = isq ? qg : kg; const float sc = isq ? QC2 : 1.f;
            bf16_t* dst = (bf16_t*)(ws + (isq ? WS_Q : WS_K)) + (size_t)(pn - (isq ? 2 : 6)) * 256 + colw;
            f32x4 gv[2][2];
#pragma unroll
            for (int bj = 0; bj < 2; ++bj)
#pragma unroll
                for (int n = 0; n < 2; ++n) gv[bj][n] = *(const f32x4*)(gain + 32 * bj + 8 * fq + 4 * n);
#pragma unroll
            for (int ai = 0; ai < 2; ++ai)
#pragma unroll
                for (int m = 0; m < 4; ++m) { const int tok = row0 + ai * 128 + m * 16; float ss = 0.f;
#pragma unroll
                    for (int bj = 0; bj < 2; ++bj)
#pragma unroll
                        for (int n = 0; n < 2; ++n) { const f32x4 v = acc[ai][bj][m][n]; ss += (v[0] * v[0] + v[1] * v[1]) + (v[2] * v[2] + v[3] * v[3]); }
                    ss += __shfl_xor(ss, 16); ss += __shfl_xor(ss, 32);
                    const float r = rsqrtf(ss * (1.f / 64.f) + EPS) * sc;
#pragma unroll
                    for (int bj = 0; bj < 2; ++bj) store16(dst + (size_t)tok * D + 32 * bj, pack8(acc[ai][bj][m][0] * r * gv[bj][0], acc[ai][bj][m][1] * r * gv[bj][1])); }
        } else {
            const size_t base = pn < 14 ? WS_V : (pn < 18 ? WS_GS : WS_GA); const int t0 = pn < 14 ? 10 : (pn < 18 ? 14 : 18); const bool ntst = pn >= 14;
            bf16_t* dst = (bf16_t*)(ws + base) + (size_t)(pn - t0) * 256 + colw;
#pragma unroll
            for (int ai = 0; ai < 2; ++ai)
#pragma unroll
                for (int m = 0; m < 4; ++m) { const int tok = row0 + ai * 128 + m * 16;
#pragma unroll
                    for (int bj = 0; bj < 2; ++bj) { const u32x4 w = pack8(acc[ai][bj][m][0], acc[ai][bj][m][1]); if (ntst) NT_STORE(w, (u32x4*)(dst + (size_t)tok * D + 32 * bj)); else store16(dst + (size_t)tok * D + 32 * bj, w); } }
        }
    }
};
struct EpiSsm2 : EpiBase {
    unsigned char* ws;
    __device__ __forceinline__ void operator()(Acc& acc, const EpiInfo& u, int wr, int wc, int fr, int fq) const {
        bf16_t* Z = (bf16_t*)(ws + WS_Z); const int g = u.aux;
#pragma unroll
        for (int ai = 0; ai < 2; ++ai)
#pragma unroll
            for (int m = 0; m < 4; ++m) { const int r = u.pm * BM + ai * 128 + wr * 64 + m * 16 + fr, b = r >> 6, c = r & 63;
#pragma unroll
                for (int bj = 0; bj < 2; ++bj) { const int n_ = u.pn * 256 + 64 * wc + 32 * bj + 8 * fq, t = n_ >> 4, h0 = n_ & 15; const int tok = b * SEQ + c * CH_L + t;
                    f32x4 a = acc[ai][bj][m][0], bb = acc[ai][bj][m][1];
#pragma unroll
                    for (int q = 0; q < 4; ++q) { a[q] = gelu_tanh(a[q]); bb[q] = gelu_tanh(bb[q]); }
                    *(u32x4*)(Z + (size_t)tok * SSM_W + 16 * g + h0) = pack8(a, bb); } }
    }
};
struct EpiGlu : EpiBase {
    unsigned char* ws; const float* bglu;
    __device__ __forceinline__ void operator()(Acc& acc, const EpiInfo& u, int wr, int wc, int fr, int fq) const {
        asm volatile("" : "+v"(fr), "+v"(fq));
        const bf16_t* Z = (const bf16_t*)(ws + WS_Z); bf16_t* MA = (bf16_t*)(ws + WS_MA);
        const int col0 = u.pn * 256 + 64 * wc + 8 * fq;
        f32x4 cb[2][2];
#pragma unroll
        for (int bj = 0; bj < 2; ++bj) { cb[bj][0] = *(const f32x4*)(bglu + col0 + 32 * bj); cb[bj][1] = *(const f32x4*)(bglu + col0 + 32 * bj + 4); }
#pragma unroll
        for (int ai = 0; ai < 2; ++ai) { u32x4 zz[4][2];
#pragma unroll
            for (int m = 0; m < 4; ++m) { const int tok = u.pm * BM + ai * 128 + wr * 64 + m * 16 + fr;
#pragma unroll
                for (int bj = 0; bj < 2; ++bj) zz[m][bj] = *(const u32x4*)(Z + (size_t)tok * SSM_W + col0 + 32 * bj); }
            asm volatile("" ::: "memory");
#pragma unroll
            for (int m = 0; m < 4; ++m) { const int tok = u.pm * BM + ai * 128 + wr * 64 + m * 16 + fr;
#pragma unroll
                for (int bj = 0; bj < 2; ++bj) { f32x4 z0, z1; unpack8(zz[m][bj], z0, z1);
                    f32x4 a = acc[ai][bj][m][0] + cb[bj][0], bb = acc[ai][bj][m][1] + cb[bj][1];
#pragma unroll
                    for (int q = 0; q < 4; ++q) { a[q] = z0[q] * sigmoid_f(a[q]); bb[q] = z1[q] * sigmoid_f(bb[q]); }
                    *(u32x4*)(MA + (size_t)tok * MA_LD + 1024 + col0 + 32 * bj) = pack8(a, bb); } }
            asm volatile("" ::: "memory"); }
    }
};
struct EpiMerged : EpiBase {
    static constexpr bool HAS_MID = true; static constexpr int MID_T = 16;
    unsigned char* ws;
    __device__ __forceinline__ float ratio(float a, float s) const { a = fminf(fmaxf(a, -30.f), 30.f); s = fminf(fmaxf(s, -30.f), 30.f); return (1.f + __expf(-s)) * __builtin_amdgcn_rcpf(1.f + __expf(-a)); }
    __device__ __forceinline__ void mid(Acc& acc, const EpiInfo& u, int wr, int wc, int fr, int fq) const {
        asm volatile("" : "+v"(fr), "+v"(fq));
        const bf16_t* GS = (const bf16_t*)(ws + WS_GS); const bf16_t* GA = (const bf16_t*)(ws + WS_GA);
        const int col0 = u.pn * 256 + 64 * wc + 8 * fq;
#pragma unroll
        for (int ai = 0; ai < 2; ++ai)
#pragma unroll
            for (int mp = 0; mp < 2; ++mp) { u32x4 gs_[2][2], ga_[2][2];
#pragma unroll
                for (int mm = 0; mm < 2; ++mm) { const int tok = u.pm * BM + ai * 128 + wr * 64 + (2 * mp + mm) * 16 + fr;
#pragma unroll
                    for (int bj = 0; bj < 2; ++bj) { gs_[mm][bj] = *(const u32x4*)(GS + (size_t)tok * D + col0 + 32 * bj); ga_[mm][bj] = *(const u32x4*)(GA + (size_t)tok * D + col0 + 32 * bj); } }
#pragma unroll
                for (int mm = 0; mm < 2; ++mm)
#pragma unroll
                    for (int bj = 0; bj < 2; ++bj) { const int m = 2 * mp + mm; const u32x4 ws_ = gs_[mm][bj], wa_ = ga_[mm][bj];
                        acc[ai][bj][m][0][0] *= ratio(bflo(wa_.x), bflo(ws_.x)); acc[ai][bj][m][0][1] *= ratio(bfhi(wa_.x), bfhi(ws_.x));
                        acc[ai][bj][m][0][2] *= ratio(bflo(wa_.y), bflo(ws_.y)); acc[ai][bj][m][0][3] *= ratio(bfhi(wa_.y), bfhi(ws_.y));
                        acc[ai][bj][m][1][0] *= ratio(bflo(wa_.z), bflo(ws_.z)); acc[ai][bj][m][1][1] *= ratio(bfhi(wa_.z), bfhi(ws_.z));
                        acc[ai][bj][m][1][2] *= ratio(bflo(wa_.w), bflo(ws_.w)); acc[ai][bj][m][1][3] *= ratio(bfhi(wa_.w), bfhi(ws_.w)); }
                asm volatile("" ::: "memory"); }
    }
    __device__ __forceinline__ void operator()(Acc& acc, const EpiInfo& u, int wr, int wc, int fr, int fq) const {
        asm volatile("" : "+v"(fr), "+v"(fq));
        const bf16_t* GS = (const bf16_t*)(ws + WS_GS); bf16_t* O = (bf16_t*)(ws + WS_MERGED);
        const int col0 = u.pn * 256 + 64 * wc + 8 * fq;
#pragma unroll
        for (int ai = 0; ai < 2; ++ai) { u32x4 gs_[4][2];
#pragma unroll
            for (int m = 0; m < 4; ++m) { const int tok = u.pm * BM + ai * 128 + wr * 64 + m * 16 + fr;
#pragma unroll
                for (int bj = 0; bj < 2; ++bj) gs_[m][bj] = *(const u32x4*)(GS + (size_t)tok * D + col0 + 32 * bj); }
#pragma unroll
            for (int m = 0; m < 4; ++m) { const int tok = u.pm * BM + ai * 128 + wr * 64 + m * 16 + fr;
#pragma unroll
                for (int bj = 0; bj < 2; ++bj) { f32x4 s0, s1; unpack8(gs_[m][bj], s0, s1);
                    f32x4 a = acc[ai][bj][m][0], bb = acc[ai][bj][m][1];
#pragma unroll
                    for (int q = 0; q < 4; ++q) { a[q] *= sigmoid_c(s0[q]); bb[q] *= sigmoid_c(s1[q]); }
                    *(u32x4*)(O + (size_t)tok * D + col0 + 32 * bj) = pack8(a, bb); } }
            asm volatile("" ::: "memory"); }
    }
};
struct EpiWout : EpiBase {
    const float* x; float* out;
    __device__ __forceinline__ void operator()(Acc& acc, const EpiInfo& u, int wr, int wc, int fr, int fq) const {
        asm volatile("" : "+v"(fr), "+v"(fq));
        const int col0 = u.pn * 256 + 64 * wc + 8 * fq;
#pragma unroll
        for (int ai = 0; ai < 2; ++ai)
#pragma unroll
            for (int mp = 0; mp < 2; ++mp) { f32x4 xv[2][2][2];
#pragma unroll
                for (int mm = 0; mm < 2; ++mm) { const int tok = u.pm * BM + ai * 128 + wr * 64 + (2 * mp + mm) * 16 + fr;
#pragma unroll
                    for (int bj = 0; bj < 2; ++bj) { const size_t o = (size_t)tok * D + col0 + 32 * bj; xv[mm][bj][0] = NT_LOAD((const f32x4*)(x + o)); xv[mm][bj][1] = NT_LOAD((const f32x4*)(x + o + 4)); } }
                asm volatile("" ::: "memory");
#pragma unroll
                for (int mm = 0; mm < 2; ++mm) { const int m = 2 * mp + mm, tok = u.pm * BM + ai * 128 + wr * 64 + m * 16 + fr;
#pragma unroll
                    for (int bj = 0; bj < 2; ++bj) { const size_t o = (size_t)tok * D + col0 + 32 * bj;
                        *(f32x4*)(out + o) = xv[mm][bj][0] + acc[ai][bj][m][0]; *(f32x4*)(out + o + 4) = xv[mm][bj][1] + acc[ai][bj][m][1]; } }
                asm volatile("" ::: "memory"); }
    }
};
struct EpiMoe1 : EpiBase {
    unsigned char* ws; const float* b1; LAS unsigned char* lds; bool nostore = false;
    __device__ __forceinline__ void operator()(Acc& acc, const EpiInfo& u, int wr, int wc, int fr, int fq) const {
        asm volatile("" : "+v"(fr), "+v"(fq));
        unsigned char* ACT = ws + WS_ACT; const int e = u.aux, blk = u.aux2;
        f32x4 cb[2][2];
#pragma unroll
        for (int bj = 0; bj < 2; ++bj) { const int cl = 64 * wc + 32 * bj + 8 * fq; f32x4 r0, r1;
            if (u.ord < MOE_MAXU) { const LAS float* bl = (const LAS float*)(lds + UB_OFF) + u.ord * 256 + cl; r0 = *(const LAS f32x4*)bl; r1 = *(const LAS f32x4*)(bl + 4); }
            else { const float* bg = b1 + (size_t)e * 2 * DFF + u.pn * 256 + cl; r0 = *(const f32x4*)bg; r1 = *(const f32x4*)(bg + 4); __builtin_amdgcn_s_waitcnt(0x0F70); }
            cb[bj][0] = __builtin_shufflevector(r0, r0, 0, 2, 1, 3); cb[bj][1] = __builtin_shufflevector(r1, r1, 0, 2, 1, 3); }
        const f32x2 c7 = {7.f, 7.f}, one = {1.f, 1.f}, cexp = {-1.702f * 1.4426950408889634f, -1.702f * 1.4426950408889634f};
#pragma unroll
        for (int ai = 0; ai < 2; ++ai)
#pragma unroll
            for (int m = 0; m < 4; ++m) { const int row = ai * 128 + wr * 64 + m * 16 + fr; unsigned w[2];
#pragma unroll
                for (int bj = 0; bj < 2; ++bj) { f32x2 r[2];
#pragma unroll
                    for (int n = 0; n < 2; ++n) { const f32x4 h = acc[ai][bj][m][n] + cb[bj][n];
                        f32x2 g = {fminf(h[0], 7.f), fminf(h[1], 7.f)}; const f32x2 up = {fminf(fmaxf(h[2], -7.f), 7.f), fminf(fmaxf(h[3], -7.f), 7.f)};
                        const f32x2 x = g * cexp; f32x2 ex = {__builtin_amdgcn_exp2f(x[0]), __builtin_amdgcn_exp2f(x[1])};
                        ex = ex + one; const f32x2 s = {__builtin_amdgcn_rcpf(ex[0]), __builtin_amdgcn_rcpf(ex[1])};
                        r[n] = (up * g + g) * s; }
                    w[bj] = pk4_fp8(r[0][0], r[0][1], r[1][0], r[1][1]); }
                unsigned char* rowp = ACT + ((size_t)blk * 256 + row) * DFF + ((u.pn * 256 + 64 * wc + 8 * fq) >> 1);
#if defined(PROBE_NOSTORE)
                if (nostore) { asm volatile("" :: "v"(w[0]), "v"(w[1])); } else
#endif
                { *(unsigned*)rowp = w[0]; *(unsigned*)(rowp + 16) = w[1]; } }
        (void)c7;
    }
};
struct EpiMoe2 : EpiBase {
    unsigned char* ws; const float* b2; LAS unsigned char* lds; bool nostore = false;
    __device__ __forceinline__ void operator()(Acc& acc, const EpiInfo& u, int wr, int wc, int fr, int fq) const {
        asm volatile("" : "+v"(fr), "+v"(fq));
        bf16_t* Y = (bf16_t*)(ws + WS_Y); const int e = u.aux, blk = u.aux2 & 0xffff;
        f32x4 cb[2][2];
#pragma unroll
        for (int bj = 0; bj < 2; ++bj) { const int cl = 64 * wc + 32 * bj + 8 * fq;
            if (u.ord < MOE_MAXU) { const LAS float* bl = (const LAS float*)(lds + UB_OFF) + u.ord * 256 + cl; cb[bj][0] = *(const LAS f32x4*)bl; cb[bj][1] = *(const LAS f32x4*)(bl + 4); }
            else { const float* bg = b2 + (size_t)e * D + u.pn * 256 + cl; cb[bj][0] = *(const f32x4*)bg; cb[bj][1] = *(const f32x4*)(bg + 4); __builtin_amdgcn_s_waitcnt(0x0F70); } }
#pragma unroll
        for (int ai = 0; ai < 2; ++ai)
#pragma unroll
            for (int m = 0; m < 4; ++m) { const int row = ai * 128 + wr * 64 + m * 16 + fr;
#pragma unroll
                for (int bj = 0; bj < 2; ++bj) { const int col = u.pn * 256 + 64 * wc + 32 * bj + 8 * fq;
                    const u32x4 w = pack8(acc[ai][bj][m][0] + cb[bj][0], acc[ai][bj][m][1] + cb[bj][1]);
#if defined(PROBE_NOSTORE)
                    if (nostore) { asm volatile("" :: "v"(w)); } else
#endif
                    store16(Y + ((size_t)blk * 256 + row) * D + col, w); } }
    }
};
}
namespace attn_body {
using bf16=__hip_bfloat16;
using bf16x8=__attribute__((ext_vector_type(8)))short;
using s16x4=__attribute__((ext_vector_type(4)))short;
using f32x16=__attribute__((ext_vector_type(16)))float;
using u32x4=__attribute__((ext_vector_type(4)))unsigned;
constexpr int SEQ=2048,D=64,DM=1024;
constexpr int NW=8,QBLK=32,QB=QBLK*NW,KVBLK=64,NQB=SEQ/QB;
constexpr int ATTN_PITCH=DM, ATTN_UNIT_ROWS=QB;
__device__ __forceinline__ int crow(int r,int hi){return (r&3)+8*(r>>2)+4*hi;}
#define SBAR() __builtin_amdgcn_sched_barrier(0)
__device__ __forceinline__ void cmask(f32x16&p0,f32x16&p1,int jb,int qrel,int hi){
  const float NEG=-INFINITY; int kb=64*jb+4*hi;
  #pragma unroll
  for(int r=0;r<16;++r){int kv=kb+(r&3)+8*(r>>2); if(kv>qrel)p0[r]=NEG; if(kv+32>qrel)p1[r]=NEG;}
}

constexpr int NSLOT=3, SLOTB=8192;
constexpr int LDS_K=0, LDS_V=NSLOT*SLOTB, LDS_WS=2*NSLOT*SLOTB, LDS_OST=LDS_WS+NW*64*4, ALDS_BYTES=LDS_OST+NW*4096;
constexpr float C2=0.125f*1.4426950408889634f;
__device__ __forceinline__ void glds16(const void*gsrc,unsigned lds_dst){unsigned keep;
  asm volatile("s_mov_b32 %0, m0\n\ts_mov_b32 m0, %2\n\ts_nop 0\n\tglobal_load_lds_dwordx4 %1, off\n\ts_mov_b32 m0, %0":"=&s"(keep):"v"(gsrc),"s"(lds_dst):"memory");}
__device__ __forceinline__ float max3f(float a,float b,float c){float r;asm("v_max3_f32 %0, %1, %2, %3":"=v"(r):"v"(a),"v"(b),"v"(c));return r;}
__device__ __forceinline__ float max2f(float a,float b){float r;asm("v_max_f32_e32 %0, %1, %2":"=v"(r):"v"(a),"v"(b));return r;}
__device__ __forceinline__ float fadd_s(float a,float b){float r;asm("v_add_f32_e32 %0, %1, %2":"=v"(r):"v"(a),"v"(b));return r;}
__device__ __forceinline__ float fsub_s(float a,float b){float r;asm("v_sub_f32_e32 %0, %1, %2":"=v"(r):"v"(a),"v"(b));return r;}
typedef float f32x2_t __attribute__((ext_vector_type(2))); typedef __bf16 bf16x2_t __attribute__((ext_vector_type(2)));
__device__ __forceinline__ unsigned cvtpk_s(float lo,float hi){f32x2_t v={lo,hi};bf16x2_t b=__builtin_convertvector(v,bf16x2_t);return __builtin_bit_cast(unsigned,b);}
#define WAIT_BAR(N) asm volatile("s_waitcnt vmcnt(" #N ") lgkmcnt(0)\n\ts_barrier":::"memory")

__device__ __forceinline__ void qkt(f32x16&p0,f32x16&p1,const char*Kslot,const bf16x8*qr,const f32x16&negm,int r32,int hi){
  const char*kb=Kslot+hi*1024+r32*16;
  #pragma unroll
  for(int d0=0;d0<4;++d0){
    const bf16x8 b0=*reinterpret_cast<const bf16x8*>(kb+d0*2048);
    const bf16x8 b1=*reinterpret_cast<const bf16x8*>(kb+d0*2048+512);
    if(d0==0){p0=__builtin_amdgcn_mfma_f32_32x32x16_bf16(b0,qr[0],negm,0,0,0);p1=__builtin_amdgcn_mfma_f32_32x32x16_bf16(b1,qr[0],negm,0,0,0);}
    else{p0=__builtin_amdgcn_mfma_f32_32x32x16_bf16(b0,qr[d0],p0,0,0,0);p1=__builtin_amdgcn_mfma_f32_32x32x16_bf16(b1,qr[d0],p1,0,0,0);}}
}
typedef __attribute__((address_space(3))) const char* lds_cptr;
typedef short v4i16_t __attribute__((ext_vector_type(4)));
__device__ __forceinline__ void kload8(bf16x8*kf,lds_cptr kp){
  kf[0]=*(const __attribute__((address_space(3))) bf16x8*)(kp);      kf[1]=*(const __attribute__((address_space(3))) bf16x8*)(kp+512);
  kf[2]=*(const __attribute__((address_space(3))) bf16x8*)(kp+2048); kf[3]=*(const __attribute__((address_space(3))) bf16x8*)(kp+2560);
  kf[4]=*(const __attribute__((address_space(3))) bf16x8*)(kp+4096); kf[5]=*(const __attribute__((address_space(3))) bf16x8*)(kp+4608);
  kf[6]=*(const __attribute__((address_space(3))) bf16x8*)(kp+6144); kf[7]=*(const __attribute__((address_space(3))) bf16x8*)(kp+6656);
}
__device__ __forceinline__ void kload2(bf16x8*kf,lds_cptr kp,int j){ kf[2*j]=*(const __attribute__((address_space(3))) bf16x8*)(kp+j*2048); kf[2*j+1]=*(const __attribute__((address_space(3))) bf16x8*)(kp+j*2048+512); }
__device__ __forceinline__ s16x4 vtr(lds_cptr p){ return __builtin_bit_cast(s16x4,__builtin_amdgcn_ds_read_tr16_b64_v4i16((__attribute__((address_space(3))) v4i16_t*)p)); }
__device__ __forceinline__ float rowmax(const f32x16&p0,const f32x16&p1){
  float a=max3f(p0[0],p0[1],p1[0]),b=max3f(p0[2],p0[3],p1[1]);a=max3f(a,p1[2],p1[3]);
  #pragma unroll
  for(int r=4;r<16;r+=4){a=max3f(a,p0[r],p0[r+1]);b=max3f(b,p0[r+2],p0[r+3]);a=max3f(a,p1[r],p1[r+1]);b=max3f(b,p1[r+2],p1[r+3]);}
  const float m=max2f(a,b);
  auto rr=__builtin_amdgcn_permlane32_swap(__float_as_uint(m),__float_as_uint(m),false,false);
  return max2f(__uint_as_float(rr[0]),__uint_as_float(rr[1]));
}
__device__ __forceinline__ void pv(f32x16*o,int vb,bf16x8 pa0,bf16x8 pa1,bf16x8 pa2,bf16x8 pa3){
  #pragma unroll
  for(int d0=0;d0<2;++d0){s16x4 lo[4],hi[4];
    #pragma unroll
    for(int ks=0;ks<4;++ks){
      asm volatile("ds_read_b64_tr_b16 %0,%1 offset:%c2":"=&v"(lo[ks]):"v"(vb),"i"(d0*4096+ks*1024):"memory");
      asm volatile("ds_read_b64_tr_b16 %0,%1 offset:%c2":"=&v"(hi[ks]):"v"(vb),"i"(d0*4096+ks*1024+512):"memory");}
    asm volatile("s_waitcnt lgkmcnt(0)":::"memory");SBAR();
    #define PK(k) (bf16x8){lo[k][0],lo[k][1],lo[k][2],lo[k][3],hi[k][0],hi[k][1],hi[k][2],hi[k][3]}
    o[d0]=__builtin_amdgcn_mfma_f32_32x32x16_bf16(pa0,PK(0),o[d0],0,0,0);
    o[d0]=__builtin_amdgcn_mfma_f32_32x32x16_bf16(pa1,PK(1),o[d0],0,0,0);
    o[d0]=__builtin_amdgcn_mfma_f32_32x32x16_bf16(pa2,PK(2),o[d0],0,0,0);
    o[d0]=__builtin_amdgcn_mfma_f32_32x32x16_bf16(pa3,PK(3),o[d0],0,0,0);
    #undef PK
  }
}

#ifndef ATTN_STORE16
#define ATTN_STORE16(p,v) (*(u32x4*)(p)=(v))
#endif
template<int THRL> __device__ __forceinline__ void attn_unit(int b,int qcol,int kcol,int vcol,int ocol,int qb,const bf16*Q,const bf16*__restrict__ K,const bf16*__restrict__ V,bf16*O,char*shm){
  int tid_=threadIdx.x; asm volatile("":"+v"(tid_));
  const int tid=tid_,lane=tid&63,r32=lane&31,hi=lane>>5; const int wid=__builtin_amdgcn_readfirstlane(tid>>6);
  const long rowbase=(long)b*SEQ; const int q0=qb*QB;
  const bf16*Qw=Q+(rowbase+q0+wid*QBLK)*DM+qcol;
  const bf16*Kh=K+rowbase*DM+kcol,*Vh=V+rowbase*DM+vcol;
  const unsigned lds0=(unsigned)(uintptr_t)shm;
  float*wsf=(float*)(shm+LDS_WS)+wid*64;
  const bf16*ksrc=Kh+(long)lane*DM+wid*8;
  const bf16*vsrc=Vh+(long)(16*(wid&3)+(lane>>2))*DM+(wid>>2)*32+(lane&3)*8;
  const unsigned kdst=lds0+LDS_K+wid*1024, vdst=lds0+LDS_V+wid*1024;
  #define DMA_K(t,slot) glds16(ksrc+(long)(t)*KVBLK*DM,(unsigned)__builtin_amdgcn_readfirstlane(kdst+(slot)))
  #define DMA_V(t,slot) glds16(vsrc+(long)(t)*KVBLK*DM,(unsigned)__builtin_amdgcn_readfirstlane(vdst+(slot)))
  const int vb0=(int)(lds0+LDS_V)+((lane>>4)&1)*32+(lane&3)*8+(4*hi+((lane&15)>>2))*64;
  const char*Kbase=shm+LDS_K; bf16x8 kf[8];
  const lds_cptr shm3=(lds_cptr)shm; const lds_cptr kp0=shm3+LDS_K+hi*1024+r32*16; const lds_cptr vp0=shm3+LDS_V+((lane>>4)&1)*32+(lane&3)*8+(4*hi+((lane&15)>>2))*64;
  const int NT=(q0+QB)/KVBLK;
  DMA_K(0,0);DMA_V(0,0);DMA_K(1,SLOTB);
  bf16x8 qr[4];
  #pragma unroll
  for(int d0=0;d0<4;++d0)qr[d0]=*reinterpret_cast<const bf16x8*>(&Qw[(long)r32*DM+d0*16+hi*8]);
  float l_reg=0.f;f32x16 o[2];o[0]=f32x16{};o[1]=f32x16{};const f32x16 negm=f32x16{};
  const int qrel=wid*QBLK+r32;
  #define CMASK(P0,P1,t) do{int jb_=(t)-(NT-4); if(jb_>=0)cmask(P0,P1,jb_,qrel,hi);}while(0)
  #define START(P0,P1) do{ _Pragma("unroll") for(int r=0;r<16;++r)P0[r]=__builtin_amdgcn_exp2f(P0[r]); }while(0)
  #define RESC() do{}while(0)
  f32x16 pA0,pA1,pB0,pB1;
  int sl_prev=0,sl_cur=0,sl_next=SLOTB;
  #define ROT() do{sl_prev=sl_cur;sl_cur=sl_next;sl_next=(sl_next==(NSLOT-1)*SLOTB)?0:sl_next+SLOTB;}while(0)
  DMA_K(2,2*SLOTB);
  WAIT_BAR(3);
  qkt(pA0,pA1,Kbase,qr,negm,r32,hi);asm volatile("s_nop 15\n\ts_nop 7":"+v"(pA0),"+v"(pA1));CMASK(pA0,pA1,0);
  START(pA0,pA1);
  _Pragma("unroll") for(int r=0;r<16;++r)pA1[r]=__builtin_amdgcn_exp2f(pA1[r]);
  WAIT_BAR(0);
  DMA_K(3,0);DMA_V(1,SLOTB);
  ROT();
  kload8(kf,kp0+sl_cur);
  WAIT_BAR(2);
  s16x4 vlo[8],vhi[8]; u32x4 pw0,pw1,pw2,pw3;
  #define PKW(P,B) cvtpk_s(P[B],P[B+1])
  #define PAF(k) __builtin_bit_cast(bf16x8,pw##k)
  #define VFR(i) (bf16x8){vlo[i][0],vlo[i][1],vlo[i][2],vlo[i][3],vhi[i][0],vhi[i][1],vhi[i][2],vhi[i][3]}
  #define PIN(x) asm volatile("":"+v"(x))
  #define MX3(a,b,c) __builtin_fmaxf(__builtin_fmaxf((a),(b)),(c))
  #define GAPA(MF,A0,A1,A2,A3,W0,W1,PW) do{ MF; sacc+=A0; sacc+=A1; sacc+=A2; sacc+=A3; PIN(sacc); W0; W1; PIN(PW); SBAR(); }while(0)
  #define EX(v) __builtin_amdgcn_exp2f(v)
  #define GAPB(MF,X,B) do{ MF; X[B]=EX(X[B]); X[B+1]=EX(X[B+1]); X[B+2]=EX(X[B+2]); X[B+3]=EX(X[B+3]); PIN(X); SBAR(); }while(0)
  #define VRD(i) do{ vlo[i]=vtr(vp_+(((i)>>2)*4096+((i)&3)*1024)); vhi[i]=vtr(vp_+(((i)>>2)*4096+((i)&3)*1024+512)); }while(0)
  #define KRD(G,j) do{ if(G){ kload2(kf,kp0+sl_next,j); SBAR(); } }while(0)
  #define STEP(C0,C1,P0,P1,t,GK,GV,GL) do{ SBAR(); \
    const lds_cptr vp_=vp0+sl_prev; \
    VRD(0); SBAR(); float sacc=(P0[0]+P0[1]); \
    GAPA(C0=__builtin_amdgcn_mfma_f32_32x32x16_bf16(kf[0],qr[0],negm,0,0,0), P0[2],P0[3],P0[4],P0[5],     pw0[0]=PKW(P0,0), pw0[1]=PKW(P0,2), pw0); \
    VRD(4); SBAR(); GAPA(C1=__builtin_amdgcn_mfma_f32_32x32x16_bf16(kf[1],qr[0],negm,0,0,0), P0[6],P0[7],P0[8],P0[9],     pw0[2]=PKW(P0,4), pw0[3]=PKW(P0,6), pw0); \
    VRD(1); SBAR(); GAPA(C0=__builtin_amdgcn_mfma_f32_32x32x16_bf16(kf[2],qr[1],C0,0,0,0),   P0[10],P0[11],P0[12],P0[13], pw1[0]=PKW(P0,8), pw1[1]=PKW(P0,10), pw1); \
    VRD(5); SBAR(); GAPA(C1=__builtin_amdgcn_mfma_f32_32x32x16_bf16(kf[3],qr[1],C1,0,0,0),   P0[14],P0[15],P1[0],P1[1],   pw1[2]=PKW(P0,12),pw1[3]=PKW(P0,14), pw1); \
    VRD(2); SBAR(); GAPA(C0=__builtin_amdgcn_mfma_f32_32x32x16_bf16(kf[4],qr[2],C0,0,0,0),   P1[2],P1[3],P1[4],P1[5],     pw2[0]=PKW(P1,0), pw2[1]=PKW(P1,2), pw2); \
    VRD(6); SBAR(); GAPA(C1=__builtin_amdgcn_mfma_f32_32x32x16_bf16(kf[5],qr[2],C1,0,0,0),   P1[6],P1[7],P1[8],P1[9],     pw2[2]=PKW(P1,4), pw2[3]=PKW(P1,6), pw2); \
    VRD(3); SBAR(); GAPA(C0=__builtin_amdgcn_mfma_f32_32x32x16_bf16(kf[6],qr[3],C0,0,0,0),   P1[10],P1[11],P1[12],P1[13], pw3[0]=PKW(P1,8), pw3[1]=PKW(P1,10), pw3); \
    VRD(7); SBAR(); GAPA(C1=__builtin_amdgcn_mfma_f32_32x32x16_bf16(kf[7],qr[3],C1,0,0,0),   P1[14],P1[15],0.f,0.f,       pw3[2]=PKW(P1,12),pw3[3]=PKW(P1,14), pw3); \
    l_reg+=sacc; \
    if(GK){DMA_K((t)+3,sl_cur);} if(GV){DMA_V((t)+1,sl_next);} \
    CMASK(C0,C1,t); \
    SBAR(); \
    GAPB(o[0]=__builtin_amdgcn_mfma_f32_32x32x16_bf16(PAF(0),VFR(0),o[0],0,0,0), C0,0); \
    GAPB(o[1]=__builtin_amdgcn_mfma_f32_32x32x16_bf16(PAF(0),VFR(4),o[1],0,0,0), C0,4); \
    KRD(GL,0); GAPB(o[0]=__builtin_amdgcn_mfma_f32_32x32x16_bf16(PAF(1),VFR(1),o[0],0,0,0), C0,8); \
    KRD(GL,1); GAPB(o[1]=__builtin_amdgcn_mfma_f32_32x32x16_bf16(PAF(1),VFR(5),o[1],0,0,0), C0,12); \
    KRD(GL,2); GAPB(o[0]=__builtin_amdgcn_mfma_f32_32x32x16_bf16(PAF(2),VFR(2),o[0],0,0,0), C1,0); \
    KRD(GL,3); GAPB(o[1]=__builtin_amdgcn_mfma_f32_32x32x16_bf16(PAF(2),VFR(6),o[1],0,0,0), C1,4); \
    GAPB(o[0]=__builtin_amdgcn_mfma_f32_32x32x16_bf16(PAF(3),VFR(3),o[0],0,0,0), C1,8); \
    GAPB(o[1]=__builtin_amdgcn_mfma_f32_32x32x16_bf16(PAF(3),VFR(7),o[1],0,0,0), C1,12); \
    }while(0)
  int t=1;
  #undef CMASK
  #define CMASK(P0,P1,t) do{}while(0)
  for(;t+5<NT;t+=2){
    STEP(pB0,pB1,pA0,pA1,t,true,true,true);     WAIT_BAR(2); RESC(); ROT();
    STEP(pA0,pA1,pB0,pB1,t+1,true,true,true);   WAIT_BAR(2); RESC(); ROT();
  }
  #undef CMASK
  #define CMASK(P0,P1,t) do{int jb_=(t)-(NT-4); if(jb_>=0)cmask(P0,P1,jb_,qrel,hi);}while(0)
  #define ENDW(tt) do{ if((tt)+3<NT){WAIT_BAR(2);} else if((tt)+2<NT){WAIT_BAR(1);} else {WAIT_BAR(0);} }while(0)
  for(;t+1<NT;t+=2){
    STEP(pB0,pB1,pA0,pA1,t,(t+3<NT),(t+1<NT),(t+1<NT));       ENDW(t);   RESC(); ROT();
    STEP(pA0,pA1,pB0,pB1,t+1,(t+4<NT),(t+2<NT),(t+2<NT));     ENDW(t+1); RESC(); ROT();
  }
  STEP(pB0,pB1,pA0,pA1,NT-1,false,false,false); RESC();
  { float sacc=pB0[0]+pB0[1]; _Pragma("unroll") for(int r=2;r<16;++r)sacc+=pB0[r]; _Pragma("unroll") for(int r=0;r<16;++r)sacc+=pB1[r]; l_reg+=sacc;
    pw0=(u32x4){PKW(pB0,0),PKW(pB0,2),PKW(pB0,4),PKW(pB0,6)};pw1=(u32x4){PKW(pB0,8),PKW(pB0,10),PKW(pB0,12),PKW(pB0,14)};pw2=(u32x4){PKW(pB1,0),PKW(pB1,2),PKW(pB1,4),PKW(pB1,6)};pw3=(u32x4){PKW(pB1,8),PKW(pB1,10),PKW(pB1,12),PKW(pB1,14)};
    SBAR(); pv(o,vb0+sl_cur,PAF(0),PAF(1),PAF(2),PAF(3)); }
  #undef PKW
  #undef PAF
  #undef VFR
  #undef PIN
  #undef MX3
  #undef GAPA
  #undef GAPB
  #undef EX
  #undef VRD
  #undef KRD
  #undef STEP
  #undef ENDW
  {auto rr=__builtin_amdgcn_permlane32_swap(__float_as_uint(l_reg),__float_as_uint(l_reg),false,false);l_reg=__uint_as_float(rr[0])+__uint_as_float(rr[1]);}
  if(hi==0)wsf[32+r32]=l_reg;asm volatile("s_waitcnt lgkmcnt(0)":::"memory");
  float rli[16];
  #pragma unroll
  for(int r=0;r<16;++r)rli[r]=__builtin_amdgcn_rcpf(wsf[32+crow(r,hi)]);
  bf16*Ow=O+(rowbase+q0+wid*QBLK)*DM+ocol;
  { bf16*stg=(bf16*)(shm+LDS_OST)+wid*2048;
    #pragma unroll
    for(int r=0;r<16;++r){const int orow=crow(r,hi);
      #pragma unroll
      for(int d0=0;d0<2;++d0)stg[orow*64+d0*32+r32]=__float2bfloat16(o[d0][r]*rli[r]);}
    asm volatile("s_waitcnt lgkmcnt(0)":::"memory");
    #pragma unroll
    for(int i=0;i<4;++i){const int row=i*8+(lane>>3),ch=lane&7; const u32x4 v=*(const u32x4*)(stg+row*64+ch*8); ATTN_STORE16(Ow+(long)row*DM+ch*8,v);} }
  asm volatile("s_waitcnt lgkmcnt(0)\n\ts_barrier":::"memory");
  #undef DMA_K
  #undef DMA_V
  #undef CMASK
  #undef START
  #undef RESC
  #undef ROT
}
constexpr int ATTN_LDS_BYTES=ALDS_BYTES;

#undef SBAR
#undef WAIT_BAR
#undef ATTN_STORE16
}
namespace attn128 {
using bf16=__hip_bfloat16;
using bf16x8=__attribute__((ext_vector_type(8)))short;
using s16x4=__attribute__((ext_vector_type(4)))short;
using f32x16=__attribute__((ext_vector_type(16)))float;
using u32x4=__attribute__((ext_vector_type(4)))unsigned;
constexpr int SEQ=2048,D=64,DM=1024;
constexpr int NW=8,QBLK=32,QB=QBLK*NW,KVBLK=64,NQB=SEQ/QB;
constexpr int ATTN_PITCH=DM, ATTN_UNIT_ROWS=QB;
__device__ __forceinline__ int crow(int r,int hi){return (r&3)+8*(r>>2)+4*hi;}
#define SBAR() __builtin_amdgcn_sched_barrier(0)
__device__ __forceinline__ void cmask(f32x16&p0,f32x16&p1,int jb,int qrel,int hi){
  const float NEG=-INFINITY; int kb=64*jb+4*hi;
  #pragma unroll
  for(int r=0;r<16;++r){int kv=kb+(r&3)+8*(r>>2); if(kv>qrel)p0[r]=NEG; if(kv+32>qrel)p1[r]=NEG;}
}

constexpr int NSLOT=3, SLOTB=8192;
constexpr int VSLOTB=2*SLOTB;
constexpr int LDS_K=0, LDS_V=NSLOT*SLOTB, LDS_WS=LDS_V+NSLOT*VSLOTB, LDS_OST=LDS_WS+NW*64*4, ALDS_BYTES=LDS_OST+NW*4096;
constexpr float C2=0.125f*1.4426950408889634f;
__device__ __forceinline__ void glds16(const void*gsrc,unsigned lds_dst){unsigned keep;
  asm volatile("s_mov_b32 %0, m0\n\ts_mov_b32 m0, %2\n\ts_nop 0\n\tglobal_load_lds_dwordx4 %1, off\n\ts_mov_b32 m0, %0":"=&s"(keep):"v"(gsrc),"s"(lds_dst):"memory");}
__device__ __forceinline__ float max3f(float a,float b,float c){float r;asm("v_max3_f32 %0, %1, %2, %3":"=v"(r):"v"(a),"v"(b),"v"(c));return r;}
__device__ __forceinline__ float max2f(float a,float b){float r;asm("v_max_f32_e32 %0, %1, %2":"=v"(r):"v"(a),"v"(b));return r;}
__device__ __forceinline__ float fadd_s(float a,float b){float r;asm("v_add_f32_e32 %0, %1, %2":"=v"(r):"v"(a),"v"(b));return r;}
__device__ __forceinline__ float fsub_s(float a,float b){float r;asm("v_sub_f32_e32 %0, %1, %2":"=v"(r):"v"(a),"v"(b));return r;}
typedef float f32x2_t __attribute__((ext_vector_type(2))); typedef __bf16 bf16x2_t __attribute__((ext_vector_type(2)));
__device__ __forceinline__ unsigned cvtpk_s(float lo,float hi){f32x2_t v={lo,hi};bf16x2_t b=__builtin_convertvector(v,bf16x2_t);return __builtin_bit_cast(unsigned,b);}
#define WAIT_BAR(N) asm volatile("s_waitcnt vmcnt(" #N ") lgkmcnt(0)\n\ts_barrier":::"memory")

__device__ __forceinline__ void qkt(f32x16&p0,f32x16&p1,const char*Kslot,const bf16x8*qr,const f32x16&negm,int r32,int hi){
  const char*kb=Kslot+hi*1024+r32*16;
  #pragma unroll
  for(int d0=0;d0<4;++d0){
    const bf16x8 b0=*reinterpret_cast<const bf16x8*>(kb+d0*2048);
    const bf16x8 b1=*reinterpret_cast<const bf16x8*>(kb+d0*2048+512);
    if(d0==0){p0=__builtin_amdgcn_mfma_f32_32x32x16_bf16(b0,qr[0],negm,0,0,0);p1=__builtin_amdgcn_mfma_f32_32x32x16_bf16(b1,qr[0],negm,0,0,0);}
    else{p0=__builtin_amdgcn_mfma_f32_32x32x16_bf16(b0,qr[d0],p0,0,0,0);p1=__builtin_amdgcn_mfma_f32_32x32x16_bf16(b1,qr[d0],p1,0,0,0);}}
}
typedef __attribute__((address_space(3))) const char* lds_cptr;
typedef short v4i16_t __attribute__((ext_vector_type(4)));
__device__ __forceinline__ void kload8(bf16x8*kf,lds_cptr kp){
  kf[0]=*(const __attribute__((address_space(3))) bf16x8*)(kp);      kf[1]=*(const __attribute__((address_space(3))) bf16x8*)(kp+512);
  kf[2]=*(const __attribute__((address_space(3))) bf16x8*)(kp+2048); kf[3]=*(const __attribute__((address_space(3))) bf16x8*)(kp+2560);
  kf[4]=*(const __attribute__((address_space(3))) bf16x8*)(kp+4096); kf[5]=*(const __attribute__((address_space(3))) bf16x8*)(kp+4608);
  kf[6]=*(const __attribute__((address_space(3))) bf16x8*)(kp+6144); kf[7]=*(const __attribute__((address_space(3))) bf16x8*)(kp+6656);
}
__device__ __forceinline__ void kload2(bf16x8*kf,lds_cptr kp,int j){ kf[2*j]=*(const __attribute__((address_space(3))) bf16x8*)(kp+j*2048); kf[2*j+1]=*(const __attribute__((address_space(3))) bf16x8*)(kp+j*2048+512); }
__device__ __forceinline__ s16x4 vtr(lds_cptr p){ return __builtin_bit_cast(s16x4,__builtin_amdgcn_ds_read_tr16_b64_v4i16((__attribute__((address_space(3))) v4i16_t*)p)); }
__device__ __forceinline__ float rowmax(const f32x16&p0,const f32x16&p1){
  float a=max3f(p0[0],p0[1],p1[0]),b=max3f(p0[2],p0[3],p1[1]);a=max3f(a,p1[2],p1[3]);
  #pragma unroll
  for(int r=4;r<16;r+=4){a=max3f(a,p0[r],p0[r+1]);b=max3f(b,p0[r+2],p0[r+3]);a=max3f(a,p1[r],p1[r+1]);b=max3f(b,p1[r+2],p1[r+3]);}
  const float m=max2f(a,b);
  auto rr=__builtin_amdgcn_permlane32_swap(__float_as_uint(m),__float_as_uint(m),false,false);
  return max2f(__uint_as_float(rr[0]),__uint_as_float(rr[1]));
}
__device__ __forceinline__ void pv(f32x16*o,int vb,bf16x8 pa0,bf16x8 pa1,bf16x8 pa2,bf16x8 pa3){
  #pragma unroll
  for(int d0=0;d0<4;++d0){s16x4 lo[4],hi[4];
    #pragma unroll
    for(int ks=0;ks<4;++ks){
      asm volatile("ds_read_b64_tr_b16 %0,%1 offset:%c2":"=&v"(lo[ks]):"v"(vb),"i"(d0*4096+ks*1024):"memory");
      asm volatile("ds_read_b64_tr_b16 %0,%1 offset:%c2":"=&v"(hi[ks]):"v"(vb),"i"(d0*4096+ks*1024+512):"memory");}
    asm volatile("s_waitcnt lgkmcnt(0)":::"memory");SBAR();
    #define PK(k) (bf16x8){lo[k][0],lo[k][1],lo[k][2],lo[k][3],hi[k][0],hi[k][1],hi[k][2],hi[k][3]}
    o[d0]=__builtin_amdgcn_mfma_f32_32x32x16_bf16(pa0,PK(0),o[d0],0,0,0);
    o[d0]=__builtin_amdgcn_mfma_f32_32x32x16_bf16(pa1,PK(1),o[d0],0,0,0);
    o[d0]=__builtin_amdgcn_mfma_f32_32x32x16_bf16(pa2,PK(2),o[d0],0,0,0);
    o[d0]=__builtin_amdgcn_mfma_f32_32x32x16_bf16(pa3,PK(3),o[d0],0,0,0);
    #undef PK
  }
}

#ifndef ATTN_STORE16
#define ATTN_STORE16(p,v) (*(u32x4*)(p)=(v))
#endif
template<int THRL> __device__ __forceinline__ void attn_unit(int b,int qcol,int kcol,int vcol,int ocol,int qb,const bf16*Q,const bf16*__restrict__ K,const bf16*__restrict__ V,bf16*O,char*shm){
  int tid_=threadIdx.x; asm volatile("":"+v"(tid_));
  const int tid=tid_,lane=tid&63,r32=lane&31,hi=lane>>5; const int wid=__builtin_amdgcn_readfirstlane(tid>>6);
  const long rowbase=(long)b*SEQ; const int q0=qb*QB;
  const bf16*Qw=Q+(rowbase+q0+wid*QBLK)*DM+qcol;
  const bf16*Kh=K+rowbase*DM+kcol,*Vh=V+rowbase*DM+vcol;
  const unsigned lds0=(unsigned)(uintptr_t)shm;
  float*wsf=(float*)(shm+LDS_WS)+wid*64;
  const bf16*ksrc=Kh+(long)lane*DM+wid*8;
  const bf16*vsrc=Vh+(long)(16*(wid&3)+(lane>>2))*DM+(wid>>2)*32+(lane&3)*8;
  const unsigned kdst=lds0+LDS_K+wid*1024, vdst=lds0+LDS_V+wid*1024;
  #define DMA_K(t,slot) glds16(ksrc+(long)(t)*KVBLK*DM,(unsigned)__builtin_amdgcn_readfirstlane(kdst+(slot)))
  #define DMA_V(t,slot) do{ glds16(vsrc+(long)(t)*KVBLK*DM,(unsigned)__builtin_amdgcn_readfirstlane(vdst+2*(slot))); glds16(vsrc+64+(long)(t)*KVBLK*DM,(unsigned)__builtin_amdgcn_readfirstlane(vdst+8192+2*(slot))); }while(0)
  const int vb0=(int)(lds0+LDS_V)+((lane>>4)&1)*32+(lane&3)*8+(4*hi+((lane&15)>>2))*64;
  const char*Kbase=shm+LDS_K; bf16x8 kf[8];
  const lds_cptr shm3=(lds_cptr)shm; const lds_cptr kp0=shm3+LDS_K+hi*1024+r32*16; const lds_cptr vp0=shm3+LDS_V+((lane>>4)&1)*32+(lane&3)*8+(4*hi+((lane&15)>>2))*64;
  const int NT=(q0+QB)/KVBLK;
  DMA_K(0,0);DMA_V(0,0);DMA_K(1,SLOTB);
  bf16x8 qr[4];
  #pragma unroll
  for(int d0=0;d0<4;++d0)qr[d0]=*reinterpret_cast<const bf16x8*>(&Qw[(long)r32*DM+d0*16+hi*8]);
  float l_reg=0.f;f32x16 o[4];o[0]=f32x16{};o[1]=f32x16{};o[2]=f32x16{};o[3]=f32x16{};const f32x16 negm=f32x16{};
  const int qrel=wid*QBLK+r32;
  #define CMASK(P0,P1,t) do{int jb_=(t)-(NT-4); if(jb_>=0)cmask(P0,P1,jb_,qrel,hi);}while(0)
  #define START(P0,P1) do{ _Pragma("unroll") for(int r=0;r<16;++r)P0[r]=__builtin_amdgcn_exp2f(P0[r]); }while(0)
  #define RESC() do{}while(0)
  f32x16 pA0,pA1,pB0,pB1;
  int sl_prev=0,sl_cur=0,sl_next=SLOTB;
  #define ROT() do{sl_prev=sl_cur;sl_cur=sl_next;sl_next=(sl_next==(NSLOT-1)*SLOTB)?0:sl_next+SLOTB;}while(0)
  DMA_K(2,2*SLOTB);
  WAIT_BAR(4);
  qkt(pA0,pA1,Kbase,qr,negm,r32,hi);asm volatile("s_nop 15\n\ts_nop 7":"+v"(pA0),"+v"(pA1));CMASK(pA0,pA1,0);
  START(pA0,pA1);
  _Pragma("unroll") for(int r=0;r<16;++r)pA1[r]=__builtin_amdgcn_exp2f(pA1[r]);
  WAIT_BAR(0);
  DMA_K(3,0);DMA_V(1,SLOTB);
  ROT();
  kload8(kf,kp0+sl_cur);
  WAIT_BAR(3);
  s16x4 vlo[8],vhi[8]; u32x4 pw0,pw1,pw2,pw3;
  #define PKW(P,B) cvtpk_s(P[B],P[B+1])
  #define PAF(k) __builtin_bit_cast(bf16x8,pw##k)
  #define VFR(i) (bf16x8){vlo[i][0],vlo[i][1],vlo[i][2],vlo[i][3],vhi[i][0],vhi[i][1],vhi[i][2],vhi[i][3]}
  #define PIN(x) asm volatile("":"+v"(x))
  #define MX3(a,b,c) __builtin_fmaxf(__builtin_fmaxf((a),(b)),(c))
  #define GAPA(MF,A0,A1,A2,A3,W0,W1,PW) do{ MF; sacc+=A0; sacc+=A1; sacc+=A2; sacc+=A3; PIN(sacc); W0; W1; PIN(PW); SBAR(); }while(0)
  #define EX(v) __builtin_amdgcn_exp2f(v)
  #define GAPB(MF,X,B) do{ MF; X[B]=EX(X[B]); X[B+1]=EX(X[B+1]); PIN(X); SBAR(); }while(0)
  #define VRD2(i) do{ vlo[i]=vtr(vp_+((((i)>>2)+2)*4096+((i)&3)*1024)); vhi[i]=vtr(vp_+((((i)>>2)+2)*4096+((i)&3)*1024+512)); }while(0)
  #define VRD(i) do{ vlo[i]=vtr(vp_+(((i)>>2)*4096+((i)&3)*1024)); vhi[i]=vtr(vp_+(((i)>>2)*4096+((i)&3)*1024+512)); }while(0)
  #define KRD(G,j) do{ if(G){ kload2(kf,kp0+sl_next,j); SBAR(); } }while(0)
  #define STEP(C0,C1,P0,P1,t,GK,GV,GL) do{ SBAR(); \
    const lds_cptr vp_=vp0+2*sl_prev; \
    VRD(0); SBAR(); float sacc=(P0[0]+P0[1]); \
    GAPA(C0=__builtin_amdgcn_mfma_f32_32x32x16_bf16(kf[0],qr[0],negm,0,0,0), P0[2],P0[3],P0[4],P0[5],     pw0[0]=PKW(P0,0), pw0[1]=PKW(P0,2), pw0); \
    VRD(4); SBAR(); GAPA(C1=__builtin_amdgcn_mfma_f32_32x32x16_bf16(kf[1],qr[0],negm,0,0,0), P0[6],P0[7],P0[8],P0[9],     pw0[2]=PKW(P0,4), pw0[3]=PKW(P0,6), pw0); \
    VRD(1); SBAR(); GAPA(C0=__builtin_amdgcn_mfma_f32_32x32x16_bf16(kf[2],qr[1],C0,0,0,0),   P0[10],P0[11],P0[12],P0[13], pw1[0]=PKW(P0,8), pw1[1]=PKW(P0,10), pw1); \
    VRD(5); SBAR(); GAPA(C1=__builtin_amdgcn_mfma_f32_32x32x16_bf16(kf[3],qr[1],C1,0,0,0),   P0[14],P0[15],P1[0],P1[1],   pw1[2]=PKW(P0,12),pw1[3]=PKW(P0,14), pw1); \
    VRD(2); SBAR(); GAPA(C0=__builtin_amdgcn_mfma_f32_32x32x16_bf16(kf[4],qr[2],C0,0,0,0),   P1[2],P1[3],P1[4],P1[5],     pw2[0]=PKW(P1,0), pw2[1]=PKW(P1,2), pw2); \
    VRD(6); SBAR(); GAPA(C1=__builtin_amdgcn_mfma_f32_32x32x16_bf16(kf[5],qr[2],C1,0,0,0),   P1[6],P1[7],P1[8],P1[9],     pw2[2]=PKW(P1,4), pw2[3]=PKW(P1,6), pw2); \
    VRD(3); SBAR(); GAPA(C0=__builtin_amdgcn_mfma_f32_32x32x16_bf16(kf[6],qr[3],C0,0,0,0),   P1[10],P1[11],P1[12],P1[13], pw3[0]=PKW(P1,8), pw3[1]=PKW(P1,10), pw3); \
    VRD(7); SBAR(); GAPA(C1=__builtin_amdgcn_mfma_f32_32x32x16_bf16(kf[7],qr[3],C1,0,0,0),   P1[14],P1[15],0.f,0.f,       pw3[2]=PKW(P1,12),pw3[3]=PKW(P1,14), pw3); \
    l_reg+=sacc; \
    if(GK){DMA_K((t)+3,sl_cur);} if(GV){DMA_V((t)+1,sl_next);} \
    CMASK(C0,C1,t); \
    SBAR(); \
    GAPB(o[0]=__builtin_amdgcn_mfma_f32_32x32x16_bf16(PAF(0),VFR(0),o[0],0,0,0), C0,0);  VRD2(0); SBAR(); \
    GAPB(o[1]=__builtin_amdgcn_mfma_f32_32x32x16_bf16(PAF(0),VFR(4),o[1],0,0,0), C0,2);  VRD2(4); SBAR(); \
    KRD(GL,0); GAPB(o[0]=__builtin_amdgcn_mfma_f32_32x32x16_bf16(PAF(1),VFR(1),o[0],0,0,0), C0,4);  VRD2(1); SBAR(); \
    KRD(GL,1); GAPB(o[1]=__builtin_amdgcn_mfma_f32_32x32x16_bf16(PAF(1),VFR(5),o[1],0,0,0), C0,6);  VRD2(5); SBAR(); \
    KRD(GL,2); GAPB(o[0]=__builtin_amdgcn_mfma_f32_32x32x16_bf16(PAF(2),VFR(2),o[0],0,0,0), C0,8);  VRD2(2); SBAR(); \
    KRD(GL,3); GAPB(o[1]=__builtin_amdgcn_mfma_f32_32x32x16_bf16(PAF(2),VFR(6),o[1],0,0,0), C0,10); VRD2(6); SBAR(); \
    GAPB(o[0]=__builtin_amdgcn_mfma_f32_32x32x16_bf16(PAF(3),VFR(3),o[0],0,0,0), C0,12); VRD2(3); SBAR(); \
    GAPB(o[1]=__builtin_amdgcn_mfma_f32_32x32x16_bf16(PAF(3),VFR(7),o[1],0,0,0), C0,14); VRD2(7); SBAR(); \
    GAPB(o[2]=__builtin_amdgcn_mfma_f32_32x32x16_bf16(PAF(0),VFR(0),o[2],0,0,0), C1,0); \
    GAPB(o[3]=__builtin_amdgcn_mfma_f32_32x32x16_bf16(PAF(0),VFR(4),o[3],0,0,0), C1,2); \
    GAPB(o[2]=__builtin_amdgcn_mfma_f32_32x32x16_bf16(PAF(1),VFR(1),o[2],0,0,0), C1,4); \
    GAPB(o[3]=__builtin_amdgcn_mfma_f32_32x32x16_bf16(PAF(1),VFR(5),o[3],0,0,0), C1,6); \
    GAPB(o[2]=__builtin_amdgcn_mfma_f32_32x32x16_bf16(PAF(2),VFR(2),o[2],0,0,0), C1,8); \
    GAPB(o[3]=__builtin_amdgcn_mfma_f32_32x32x16_bf16(PAF(2),VFR(6),o[3],0,0,0), C1,10); \
    GAPB(o[2]=__builtin_amdgcn_mfma_f32_32x32x16_bf16(PAF(3),VFR(3),o[2],0,0,0), C1,12); \
    GAPB(o[3]=__builtin_amdgcn_mfma_f32_32x32x16_bf16(PAF(3),VFR(7),o[3],0,0,0), C1,14); \
    }while(0)
  int t=1;
  #undef CMASK
  #define CMASK(P0,P1,t) do{}while(0)
  for(;t+5<NT;t+=2){
    STEP(pB0,pB1,pA0,pA1,t,true,true,true);     WAIT_BAR(3); RESC(); ROT();
    STEP(pA0,pA1,pB0,pB1,t+1,true,true,true);   WAIT_BAR(3); RESC(); ROT();
  }
  #undef CMASK
  #define CMASK(P0,P1,t) do{int jb_=(t)-(NT-4); if(jb_>=0)cmask(P0,P1,jb_,qrel,hi);}while(0)
  #define ENDW(tt) do{ if((tt)+3<NT){WAIT_BAR(3);} else if((tt)+2<NT){WAIT_BAR(2);} else {WAIT_BAR(0);} }while(0)
  for(;t+1<NT;t+=2){
    STEP(pB0,pB1,pA0,pA1,t,(t+3<NT),(t+1<NT),(t+1<NT));       ENDW(t);   RESC(); ROT();
    STEP(pA0,pA1,pB0,pB1,t+1,(t+4<NT),(t+2<NT),(t+2<NT));     ENDW(t+1); RESC(); ROT();
  }
  STEP(pB0,pB1,pA0,pA1,NT-1,false,false,false); RESC();
  { float sacc=pB0[0]+pB0[1]; _Pragma("unroll") for(int r=2;r<16;++r)sacc+=pB0[r]; _Pragma("unroll") for(int r=0;r<16;++r)sacc+=pB1[r]; l_reg+=sacc;
    pw0=(u32x4){PKW(pB0,0),PKW(pB0,2),PKW(pB0,4),PKW(pB0,6)};pw1=(u32x4){PKW(pB0,8),PKW(pB0,10),PKW(pB0,12),PKW(pB0,14)};pw2=(u32x4){PKW(pB1,0),PKW(pB1,2),PKW(pB1,4),PKW(pB1,6)};pw3=(u32x4){PKW(pB1,8),PKW(pB1,10),PKW(pB1,12),PKW(pB1,14)};
    SBAR(); pv(o,vb0+2*sl_cur,PAF(0),PAF(1),PAF(2),PAF(3)); }
  #undef PKW
  #undef PAF
  #undef VFR
  #undef PIN
  #undef MX3
  #undef GAPA
  #undef GAPB
  #undef EX
  #undef VRD
  #undef VRD2
  #undef KRD
  #undef STEP
  #undef ENDW
  {auto rr=__builtin_amdgcn_permlane32_swap(__float_as_uint(l_reg),__float_as_uint(l_reg),false,false);l_reg=__uint_as_float(rr[0])+__uint_as_float(rr[1]);}
  if(hi==0)wsf[32+r32]=l_reg;asm volatile("s_waitcnt lgkmcnt(0)":::"memory");
  float rli[16];
  #pragma unroll
  for(int r=0;r<16;++r)rli[r]=__builtin_amdgcn_rcpf(wsf[32+crow(r,hi)]);
  bf16*Ow=O+(rowbase+q0+wid*QBLK)*DM+ocol;
  { bf16*stg=(bf16*)(shm+LDS_OST)+wid*2048;
    #pragma unroll
    for(int hv=0;hv<2;++hv){
      #pragma unroll
      for(int r=0;r<16;++r){const int orow=crow(r,hi);
        #pragma unroll
        for(int d0=0;d0<2;++d0)stg[orow*64+d0*32+r32]=__float2bfloat16(o[2*hv+d0][r]*rli[r]);}
      asm volatile("s_waitcnt lgkmcnt(0)":::"memory");
      #pragma unroll
      for(int i=0;i<4;++i){const int row=i*8+(lane>>3),ch=lane&7; const u32x4 v=*(const u32x4*)(stg+row*64+ch*8); ATTN_STORE16(Ow+(long)row*DM+hv*64+ch*8,v);}
      asm volatile("s_waitcnt lgkmcnt(0)":::"memory"); } }
  asm volatile("s_waitcnt lgkmcnt(0)\n\ts_barrier":::"memory");
  #undef DMA_K
  #undef DMA_V
  #undef CMASK
  #undef START
  #undef RESC
  #undef ROT
}
constexpr int ATTN_LDS_BYTES=ALDS_BYTES;

#undef SBAR
#undef WAIT_BAR
#undef ATTN_STORE16
}
constexpr size_t WS_ATT0 = WS_ACT, WS_ATT1 = WS_ACT + 32 * MiB;

__device__ __forceinline__ void diff_combine(const Params& P, int b, int h, int qb) {
    int tid_ = threadIdx.x; asm volatile("" : "+v"(tid_));
    const int tid = tid_, lane = tid & 63, wid = tid >> 6;
    const float lam = __expf(wave_sum(P.in[I_LQ1][lane] * P.in[I_LK1][lane])) - __expf(wave_sum(P.in[I_LQ2][lane] * P.in[I_LK2][lane])) + 0.2f;
    const int ch = lane & 15;
    const f32x4 g0 = *(const f32x4*)(P.in[I_SG] + 8 * ch), g1 = *(const f32x4*)(P.in[I_SG] + 8 * ch + 4);
    const size_t row0 = (size_t)b * SEQ + qb * 256 + wid * 32 + (lane >> 4);
    const bf16_t* s0 = (const bf16_t*)(P.ws + WS_ATT0) + row0 * D + h * 128 + 8 * ch; const bf16_t* s1 = (const bf16_t*)(P.ws + WS_ATT1) + row0 * D + h * 128 + 8 * ch;
    bf16_t* dst = (bf16_t*)(P.ws + WS_MA) + row0 * MA_LD + h * 128 + 8 * ch;
#pragma unroll
    for (int hb = 0; hb < 2; ++hb) { u32x4 ra[4], rb[4];
#pragma unroll
        for (int q = 0; q < 4; ++q) { const int it = 4 * hb + q; ra[q] = *(const u32x4*)(s0 + (size_t)(4 * it) * D); rb[q] = *(const u32x4*)(s1 + (size_t)(4 * it) * D); }
        asm volatile("" ::: "memory");
#pragma unroll
        for (int q = 0; q < 4; ++q) { const int it = 4 * hb + q;
            f32x4 a0, a1, b0, b1; pg::unpack8(ra[q], a0, a1); pg::unpack8(rb[q], b0, b1);
            const f32x4 o0 = a0 - lam * b0, o1 = a1 - lam * b1;
            float ss = (o0[0] * o0[0] + o0[1] * o0[1]) + (o0[2] * o0[2] + o0[3] * o0[3]) + (o1[0] * o1[0] + o1[1] * o1[1]) + (o1[2] * o1[2] + o1[3] * o1[3]);
            ss += __shfl_xor(ss, 1); ss += __shfl_xor(ss, 2); ss += __shfl_xor(ss, 4); ss += __shfl_xor(ss, 8);
            const float r = rsqrtf(ss * (1.f / 128.f) + EPS) * 0.8f;
            *(u32x4*)(dst + (size_t)(4 * it) * MA_LD) = pg::pack8(o0 * r * g0, o1 * r * g1); }
        asm volatile("" ::: "memory"); }
}
__device__ __forceinline__ void attn_phase(const Params& P, char* lds, int vcu, int G) {
    using attn_body::bf16;
    const bf16* Q = (const bf16*)(P.ws + WS_Q); const bf16* K = (const bf16*)(P.ws + WS_K); const bf16* V = (const bf16*)(P.ws + WS_V);
    for (int v = vcu; v < 256; v += G) {
        const int bh = v >> 2, b = bh >> 3, h = bh & 7, s = v & 3;
        for (int i = 0; i < 2; ++i) { const int qb = i == 0 ? 7 - s : s;
#ifndef ATTN_V128
#define ATTN_V128 1
#endif
#if ATTN_V128
            for (int m = 0; m < 2; ++m) {
#if EXPERTS_IN_ATTN
#ifndef CONV_SLOTS
#define CONV_SLOTS 4
#endif
#ifndef CONV_SPLIT
#define CONV_SPLIT 1
#endif
                if (CONV_SLOTS == 2 ? (i == 0 && m == ((v >> 2) & 1)) : ((i * 2 + m - (((v >> 2) + v) & 3)) & (CONV_SPLIT == 2 ? 1 : 3)) == 0) {
                    constexpr int per = (EXP_M10 - EXP_ATT0) / 256; const int hsel = CONV_SPLIT == 2 ? (((i * 2 + m - (((v >> 2) + v) & 3)) >> 1) & 1) : 0;
                    expert_convert_slice(P, (LAS unsigned char*)lds, EXP_ATT0 + v * per + hsel * (per / 2), CONV_SPLIT == 2 ? EXP_ATT0 + v * per + (hsel + 1) * (per / 2) : EXP_ATT0 + (v + 1) * per);
#if defined(PROBE_CONV2)
                    asm volatile("s_waitcnt vmcnt(0) lgkmcnt(0)" ::: "memory"); __syncthreads(); expert_convert_slice(P, (LAS unsigned char*)lds, EXP_ATT0 + v * per, EXP_ATT0 + (v + 1) * per, true);
#endif
                    asm volatile("s_waitcnt vmcnt(0) lgkmcnt(0)" ::: "memory"); __syncthreads(); }
#endif
                attn128::attn_unit<8>(b, h * 128 + m * 64, h * 128 + m * 64, h * 128, h * 128, qb, (const attn128::bf16*)Q, (const attn128::bf16*)K, (const attn128::bf16*)V, (attn128::bf16*)(P.ws + (m == 0 ? WS_ATT0 : WS_ATT1)), lds); }
#else
            for (int pass = 0; pass < 4; ++pass) { const int m = pass >> 1, vh = pass & 1;
#if EXPERTS_IN_ATTN
                if (i * 4 + pass == (((v >> 2) + v) & 3)) {
                    constexpr int per = (EXP_M10 - EXP_ATT0) / 256; expert_convert_slice(P, (LAS unsigned char*)lds, EXP_ATT0 + v * per, EXP_ATT0 + (v + 1) * per);
                    asm volatile("s_waitcnt vmcnt(0) lgkmcnt(0)" ::: "memory"); __syncthreads(); }
#endif
                attn_body::attn_unit<8>(b, h * 128 + m * 64, h * 128 + m * 64, h * 128 + vh * 64, h * 128 + vh * 64, qb, Q, K, V, (bf16*)(P.ws + (m == 0 ? WS_ATT0 : WS_ATT1)), lds); }
#endif
            asm volatile("s_waitcnt vmcnt(0)" ::: "memory");
            diff_combine(P, b, h, qb);
        }
    }
}

__device__ __forceinline__ void ssm1_phase(const Params& P, LAS unsigned char* lds, int vcu, int G) {
    const int tid = opaque_tid(), lane = tid & 63, wid = __builtin_amdgcn_readfirstlane(tid >> 6), fr = lane & 15, fq = lane >> 4;
    LAS float* Sl = (LAS float*)lds;
    for (int u = vcu; u < SSM_G * BATCH; u += G) {
        const int g = u >> 3, b = u & 7;
        bf16_t* A = (bf16_t*)(P.ws + WS_ACAT) + (size_t)(g * ACAT_ROWS + b * NCH) * ACAT_LD;
        const bf16_t* Bw = (const bf16_t*)(P.ws + WS_WS_T) + (size_t)(g * 128 + 16 * wid + fr) * 512 + fq * 8;
        f32x4 acc[4];
#pragma unroll
        for (int m = 0; m < 4; ++m) acc[m] = (f32x4){0.f, 0.f, 0.f, 0.f};
#pragma unroll 4
        for (int ks = 0; ks < 16; ++ks) {
            const bf16x8 bf = *(const bf16x8*)(Bw + ks * 32);
#pragma unroll
            for (int m = 0; m < 4; ++m) { const bf16x8 af = *(const bf16x8*)(A + (size_t)(16 * m + fr) * ACAT_LD + ks * 32 + fq * 8);
                acc[m] = __builtin_amdgcn_mfma_f32_16x16x32_bf16(af, bf, acc[m], 0, 0, 0); }
        }
#pragma unroll
        for (int m = 0; m < 4; ++m)
#pragma unroll
            for (int q = 0; q < 4; ++q) Sl[(16 * m + 4 * fq + q) * 129 + 16 * wid + fr] = acc[m][q];
        __syncthreads();
        if (tid < SSM_P) {
            const int p = tid; const SsmGP gp = ssm_gp(P, g, p); float aLr, aLi; ssm_pow(gp, CH_L, aLr, aLi);
            float xr = 0.f, xi = 0.f;
            bf16_t* xp = A + 512 + p;
            for (int c = 0; c < NCH; ++c) {
                xp[(size_t)c * ACAT_LD] = (bf16_t)f2bf(xr); xp[(size_t)c * ACAT_LD + 64] = (bf16_t)f2bf(xi);
                const float sr = Sl[c * 129 + p], si = Sl[c * 129 + 64 + p];
                const float nr = aLr * xr - aLi * xi + sr, ni = aLr * xi + aLi * xr + si; xr = nr; xi = ni;
            }
        }
        __syncthreads();
    }
}
namespace pg {
struct Ssm2Sched {
    unsigned char* ws; int G, c;
    __device__ __forceinline__ void init(unsigned char* ws_, int G_, int c_) { ws = ws_; G = G_; c = c_; }
    __device__ __forceinline__ bool next(int i, Unit& u) const {
        const int L = i * G + c; if (L >= SSM_G * 4) return false;
        const int g = L >> 2; u.pm = (L >> 1) & 1; u.pn = L & 1; u.aux = g; u.aux2 = 0; u.ord = i; const LaneRC rc;
        u.A = (const char*)((const bf16_t*)(ws + WS_ACAT) + (size_t)g * ACAT_ROWS * ACAT_LD); u.B = (const char*)((const bf16_t*)(ws + WS_BT_SSM) + ((size_t)g * 512 + u.pn * BM) * ACAT_LD);
#pragma unroll
        for (int h = 0; h < 2; ++h)
#pragma unroll
            for (int j = 0; j < 2; ++j) u.aoff[h][j] = (unsigned)(((u.pm * BM + 128 * h + rc.R[j]) * ACAT_LD + rc.C[j]) * 2);
        return true;
    }
};
}

constexpr int RT_LG_OFF = RING_BYTES + 2048;
constexpr int RT_HIST_OFF = RT_LG_OFF + 64 * 33 * 4;
__device__ __forceinline__ void router_phase(const Params& P, LAS unsigned char* lds, int vcu, int G) {
    const int tid = opaque_tid(), lane = tid & 63, wid = __builtin_amdgcn_readfirstlane(tid >> 6);
    const float* wrt = (const float*)(P.ws + WS_WR_T);
#pragma unroll 4
    for (int i = 0; i < 16; ++i) ((LAS f32x4*)lds)[tid + NTHREADS * i] = ((const f32x4*)wrt)[tid + NTHREADS * i];
    LAS float* lg = (LAS float*)(lds + RT_LG_OFF); LAS int* hist = (LAS int*)(lds + RT_HIST_OFF);
    unsigned* cnt = (unsigned*)(P.ws + WS_CTL) + CW_CNT;
    int* slot_tok = (int*)(P.ws + WS_SLOT_TOK); float* slot_gate = (float*)(P.ws + WS_SLOT_GATE); int* tok_ep = (int*)(P.ws + WS_TOK_EP);
    unsigned char* H2 = P.ws + WS_H2;
    f32x4 g2v[4];
#pragma unroll
    for (int j = 0; j < 4; ++j) g2v[j] = ((const f32x4*)P.in[I_G2])[lane + 64 * j];
    for (int tb = vcu; tb < T / 64; tb += G) {
        if (tid < 64) hist[tid] = 0;
        __syncthreads();
        f32x4 n0[4], n1[4];
#pragma unroll
        for (int j = 0; j < 4; ++j) { const int tn = tb * 64 + wid * 8; n0[j] = NT_LOAD((const f32x4*)((const float*)(P.ws + WS_X1) + (size_t)tn * D) + lane + 64 * j); n1[j] = NT_LOAD((const f32x4*)((const float*)(P.ws + WS_X1) + (size_t)(tn + 1) * D) + lane + 64 * j); }
        for (int pass = 0; pass < 4; ++pass) {
            const int t0 = tb * 64 + wid * 8 + pass * 2;
            f32x4 h0[4], h1[4]; float s0 = 0.f, s1 = 0.f;
#pragma unroll
            for (int j = 0; j < 4; ++j) { h0[j] = n0[j]; h1[j] = n1[j]; }
#pragma unroll
            for (int j = 0; j < 4; ++j) { const int tn = tb * 64 + wid * 8 + min(pass + 1, 3) * 2; n0[j] = NT_LOAD((const f32x4*)((const float*)(P.ws + WS_X1) + (size_t)tn * D) + lane + 64 * j); n1[j] = NT_LOAD((const f32x4*)((const float*)(P.ws + WS_X1) + (size_t)(tn + 1) * D) + lane + 64 * j); }
#pragma unroll
            for (int j = 0; j < 4; ++j) {
                s0 += (h0[j].x * h0[j].x + h0[j].y * h0[j].y) + (h0[j].z * h0[j].z + h0[j].w * h0[j].w); s1 += (h1[j].x * h1[j].x + h1[j].y * h1[j].y) + (h1[j].z * h1[j].z + h1[j].w * h1[j].w); }
            const float r0 = rsqrtf(wave_sum(s0) * (1.f / D) + EPS), r1 = rsqrtf(wave_sum(s1) * (1.f / D) + EPS);
#pragma unroll
            for (int j = 0; j < 4; ++j) { h0[j] = h0[j] * r0 * g2v[j]; h1[j] = h1[j] * r1 * g2v[j];
                ((unsigned*)(H2 + (size_t)t0 * D))[lane + 64 * j] = pk4_fp8(h0[j].x, h0[j].y, h0[j].z, h0[j].w);
                ((unsigned*)(H2 + (size_t)(t0 + 1) * D))[lane + 64 * j] = pk4_fp8(h1[j].x, h1[j].y, h1[j].z, h1[j].w); }
            float v[64];
#pragma unroll
            for (int e = 0; e < NE; ++e) { float a0 = 0.f, a1 = 0.f;
#pragma unroll
                for (int j = 0; j < 4; ++j) { const f32x4 w = ((const LAS f32x4*)(lds + e * 4096))[lane + 64 * j];
                    a0 += (h0[j].x * w.x + h0[j].y * w.y) + (h0[j].z * w.z + h0[j].w * w.w); a1 += (h1[j].x * w.x + h1[j].y * w.y) + (h1[j].z * w.z + h1[j].w * w.w); }
                v[e] = a0; v[32 + e] = a1; }
#pragma unroll
            for (int half = 32; half >= 1; half >>= 1) { const bool upper = (lane & half) != 0;
#pragma unroll
                for (int i = 0; i < half; ++i) { const float send = upper ? v[i] : v[i + half], keep = upper ? v[i + half] : v[i]; v[i] = keep + __shfl_xor(send, half); } }
            lg[(wid * 8 + pass * 2 + (lane >> 5)) * 33 + (lane & 31)] = v[0] + P.in[I_BR][lane & 31];
        }
        __syncthreads();
        if (wid == 0) {
            const int tok = tb * 64 + lane;
            float tv[4]; int ti[4];
#pragma unroll
            for (int k = 0; k < 4; ++k) { tv[k] = -INFINITY; ti[k] = 0; }
            for (int e = 0; e < NE; ++e) { const float x = lg[lane * 33 + e];
                if (x > tv[3]) { if (x > tv[2]) { tv[3] = tv[2]; ti[3] = ti[2]; if (x > tv[1]) { tv[2] = tv[1]; ti[2] = ti[1]; if (x > tv[0]) { tv[1] = tv[0]; ti[1] = ti[0]; tv[0] = x; ti[0] = e; } else { tv[1] = x; ti[1] = e; } } else { tv[2] = x; ti[2] = e; } } else { tv[3] = x; ti[3] = e; } } }
            const float e1 = __expf(tv[1] - tv[0]), e2 = __expf(tv[2] - tv[0]), e3 = __expf(tv[3] - tv[0]); const float inv = 1.f / (1.f + e1 + e2 + e3);
            const float gk[4] = {inv, e1 * inv, e2 * inv, e3 * inv};
            int lp[4];
#pragma unroll
            for (int k = 0; k < 4; ++k) lp[k] = atomicAdd((int*)&hist[ti[k]], 1);
            asm volatile("s_waitcnt lgkmcnt(0)" ::: "memory");
            if (lane < NE) { const int n = hist[lane]; hist[32 + lane] = n ? (int)atomicAdd(&cnt[lane], (unsigned)n) : 0; }
            asm volatile("s_waitcnt vmcnt(0) lgkmcnt(0)" ::: "memory");
#pragma unroll
            for (int k = 0; k < 4; ++k) { const int e = ti[k], pos = hist[32 + e] + lp[k];
                slot_tok[(size_t)e * CAP + pos] = tok; slot_gate[(size_t)e * CAP + pos] = gk[k]; tok_ep[tok * 4 + k] = (e << 16) | pos; }
        }
        __syncthreads();
    }
}

#ifndef COMB_Y_DEFAULT
#define COMB_Y_LOAD(p) NT_LOAD(p)
#else
#define COMB_Y_LOAD(p) (*(p))
#endif
__device__ __forceinline__ void combine_phase(const Params& P, LAS unsigned char* lds, int vcu, int G) {
    const int tid = opaque_tid(), lane = tid & 63, wid = __builtin_amdgcn_readfirstlane(tid >> 6);
    const LAS int* tab = (const LAS int*)(lds + pg::TAB_OFF);
    const int* tok_ep = (const int*)(P.ws + WS_TOK_EP); const bf16_t* Y = (const bf16_t*)(P.ws + WS_Y); const float* sgate = (const float*)(P.ws + WS_SLOT_GATE);
    for (int tok = (vcu * NWAVES + wid) * 2; tok < T; tok += G * NWAVES * 2) {
        f32x4 a[2][4]; u32x2 yv[2][4][4]; float gk[2][4];
#pragma unroll
        for (int tt = 0; tt < 2; ++tt) {
#pragma unroll
            for (int j = 0; j < 4; ++j) a[tt][j] = NT_LOAD((const f32x4*)((const float*)(P.ws + WS_X1) + (size_t)(tok + tt) * D) + lane + 64 * j);
#pragma unroll
            for (int k = 0; k < 4; ++k) { const int ep = tok_ep[(tok + tt) * 4 + k]; const int slot = tab[ep >> 16] * 256 + (ep & 0xffff); gk[tt][k] = sgate[(size_t)(ep >> 16) * CAP + (ep & 0xffff)];
#pragma unroll
                for (int j = 0; j < 4; ++j) yv[tt][k][j] = COMB_Y_LOAD((const u32x2*)(Y + (size_t)slot * D) + lane + 64 * j); } }
        asm volatile("" ::: "memory");
#pragma unroll
        for (int tt = 0; tt < 2; ++tt) {
#pragma unroll
            for (int k = 0; k < 4; ++k)
#pragma unroll
                for (int j = 0; j < 4; ++j) { const u32x2 w = yv[tt][k][j]; a[tt][j] += gk[tt][k] * (f32x4){bflo(w.x), bfhi(w.x), bflo(w.y), bfhi(w.y)}; }
#pragma unroll
            for (int j = 0; j < 4; ++j) NT_STORE(a[tt][j], (f32x4*)(P.out + (size_t)(tok + tt) * D) + lane + 64 * j); }
    }
}
#define XB_TMO      128
#define XB_XCNT(j)  (256  + 64 * (j))
#define XB_XSUB(j)  (1280 + 64 * (j))
#define XB_XGEN(j)  (2304 + 64 * (j))
#define XB_TOP      3328
#define XB_TOPGEN   3392
#define XCD_BAR_WORDS 3456
#define XB_SPIN_CAP (1u << 18)
__device__ __forceinline__ unsigned xb_ld(unsigned* p)              { return __hip_atomic_load(p, __ATOMIC_RELAXED, __HIP_MEMORY_SCOPE_AGENT); }
__device__ __forceinline__ unsigned xb_add(unsigned* p, unsigned v) { return __hip_atomic_fetch_add(p, v, __ATOMIC_RELAXED, __HIP_MEMORY_SCOPE_AGENT); }
__device__ __forceinline__ unsigned xb_xcc_id() { return (unsigned)__builtin_amdgcn_s_getreg((3 << 11) | 20) & 0xFu; }
#define XB_SPIN(cond, bar) do { unsigned _sp = 0; while (cond) { __builtin_amdgcn_s_sleep(1); \
    if ((++_sp & 255u) == 0u) { if (xb_ld(&(bar)[XB_TMO])) break; if (_sp > XB_SPIN_CAP) { atomicAdd(&(bar)[XB_TMO], 1u); break; } } } } while (0)
struct XcdBarrier { unsigned* bar; unsigned x; volatile LAS unsigned* st; };
__device__ __forceinline__ XcdBarrier xcd_barrier_post(unsigned* bar, volatile LAS unsigned* st) {
    XcdBarrier b; b.bar = bar; b.x = xb_xcc_id(); b.st = st;
    if (threadIdx.x == 0) (void)xb_add(&bar[XB_XCNT(b.x)], 1u);
    return b;
}
__device__ __forceinline__ void xcd_barrier_complete(unsigned* bar, unsigned x, unsigned& nloc, unsigned& nx) {
    const unsigned G = gridDim.x * gridDim.y * gridDim.z;
    unsigned sum, cnt, mine, sp = 0u;
    for (;;) {
        sum = 0u; cnt = 0u; mine = 0u;
#pragma unroll
        for (unsigned j = 0; j < 16; ++j) { const unsigned c = xb_ld(&bar[XB_XCNT(j)]); sum += c; cnt += (c > 0u) ? 1u : 0u; mine = (j == x) ? c : mine; }
        if (sum == G) break;
        __builtin_amdgcn_s_sleep(1);
        if ((++sp & 255u) == 0u) { if (xb_ld(&bar[XB_TMO])) break; if (sp > XB_SPIN_CAP) { atomicAdd(&bar[XB_TMO], 1u); break; } }
    }
    nloc = mine > 0u ? mine : 1u; nx = cnt > 0u ? cnt : 1u;
}
__device__ __forceinline__ void xcd_barrier(const XcdBarrier& b) {
    asm volatile("s_waitcnt vmcnt(0)" ::: "memory");
    __syncthreads();
    if (threadIdx.x == 0) {
        unsigned* bar = b.bar;
        __builtin_amdgcn_s_waitcnt(0);
        unsigned nloc = b.st[0], nx = b.st[1];
        if (nloc == 0u) { xcd_barrier_complete(bar, b.x, nloc, nx); b.st[0] = nloc; b.st[1] = nx; }
        const unsigned old = xb_add(&bar[XB_XSUB(b.x)], 1u);
        const unsigned gen = old / nloc;
        if (old + 1u == (gen + 1u) * nloc) {
            __builtin_amdgcn_fence(__ATOMIC_RELEASE, "agent");
            asm volatile("s_waitcnt vmcnt(0)" ::: "memory");
            const unsigned og = xb_add(&bar[XB_TOP], 1u);
            const unsigned tg = og / nx;
            if (og + 1u == (tg + 1u) * nx) xb_add(&bar[XB_TOPGEN], 1u);
            else XB_SPIN(xb_ld(&bar[XB_TOPGEN]) == tg, bar);
            __builtin_amdgcn_fence(__ATOMIC_ACQUIRE, "agent");
            xb_add(&bar[XB_XGEN(b.x)], 1u);
            asm volatile("s_waitcnt vmcnt(0)" ::: "memory");
        } else {
            XB_SPIN(xb_ld(&bar[XB_XGEN(b.x)]) == gen, bar);
            __builtin_amdgcn_fence(__ATOMIC_ACQUIRE, "agent");
            asm volatile("s_waitcnt vmcnt(0)" ::: "memory");
        }
    }
    __syncthreads();
}
#ifndef PH_MASK
#define PH_MASK 0xffffffffu
#endif
__global__ void __launch_bounds__(NTHREADS, 2) mega_fwd(Params P) {
    extern __shared__ __attribute__((aligned(16))) unsigned char lds_[];
    LAS unsigned char* lds = (LAS unsigned char*)lds_;
    const int tid = threadIdx.x;
    const int G = gridDim.x, bx = blockIdx.x, vcu = (G % 8 == 0) ? (bx % 8) * (G / 8) + bx / 8 : bx;
    for (int u = tid; u < (LDS_BYTES - RING_BYTES) / 4; u += NTHREADS) ((LAS unsigned*)(lds + RING_BYTES))[u] = 0u;
    __syncthreads();
    unsigned* ctl = (unsigned*)(P.ws + WS_CTL);
    const XcdBarrier bar = xcd_barrier_post(ctl + CW_BAR, (volatile LAS unsigned*)(lds + MISC_OFF) + 8);
#ifndef PH_REP
#define PH_REP 0u
#endif
#ifndef BAR_REP
#define BAR_REP 1
#endif
#define GRID_BAR() do { for (int b_ = 0; b_ < BAR_REP; ++b_) xcd_barrier(bar); } while (0)
#define ON(k) for (int r_ = 0; r_ < 1 + (int)((PH_REP >> (k)) & 1u); ++r_) if ((PH_MASK >> (k)) & 1u)
#ifndef FWD_REP
#define FWD_REP 1
#endif
    for (int fwd_ = 0; fwd_ < FWD_REP; ++fwd_) {
    if (fwd_ > 0) { GRID_BAR(); if (bx == 0 && tid < 64) ctl[CW_CNT + tid] = 0u; }
    ON(0) p0_prologue(P, lds, vcu, G);
    GRID_BAR();
    ON(1) { pg::DenseSched S; S.init((const bf16_t*)(P.ws + WS_XN), D, (const bf16_t*)(P.ws + WS_WIN_T), D, T, IN_W, G, bx);
        pg::EpiInProj E; E.ws = P.ws; E.qg = P.in[I_QG]; E.kg = P.in[I_KG];
#if defined(PROBE_NULL_EPI)
        if (r_ == 1) { pg::EpiNull EN; pg::gemm_phase(lds, S, EN, D / 64, D); } else
#endif
#ifndef INPROJ_BAUX
#define INPROJ_BAUX 0
#endif
        pg::gemm_phase<false, INPROJ_BAUX>(lds, S, E, D / 64, D);
#if EXPERTS_IN_ATTN
        if (r_ == 0 && G == 256 && bx >= 128) expert_convert_slice(P, lds, EXP_IN0 + (bx - 128) * EXP_N_IN, EXP_IN0 + (bx - 127) * EXP_N_IN);
        __syncthreads();
#endif
    }
    GRID_BAR();
    ON(2) { ssm_toeplitz_expand(P, vcu, G); ssm1_phase(P, lds, vcu, G); }
    ON(3) attn_phase(P, (char*)lds_, vcu, G);
    GRID_BAR();
    ON(4) { pg::Ssm2Sched S; S.init(P.ws, G, bx); pg::EpiSsm2 E; E.ws = P.ws; pg::gemm_phase(lds, S, E, ACAT_LD / 64, ACAT_LD);
#if EXPERTS_IN_ATTN
        if (r_ == 0 && G == 256 && bx >= 128) expert_convert_slice(P, lds, EXP_S20 + (bx - 128) * EXP_N_S2, EXP_S20 + (bx - 127) * EXP_N_S2);
        __syncthreads();
#endif
    }
    GRID_BAR();
    ON(5) { pg::DenseSched S; S.init((const bf16_t*)(P.ws + WS_Z), SSM_W, (const bf16_t*)(P.ws + WS_WGLU_T), SSM_W, T, SSM_W, G, bx);
        pg::EpiGlu E; E.ws = P.ws; E.bglu = P.in[I_BGLU]; pg::gemm_phase(lds, S, E, SSM_W / 64, SSM_W);
#if EXPERTS_IN_ATTN
        if (r_ == 0 && G == 256 && bx >= 128) expert_convert_slice(P, lds, EXP_GLU0 + (bx - 128) * EXP_N_GLU, EXP_GLU0 + (bx - 127) * EXP_N_GLU);
        __syncthreads();
#endif
    }
    GRID_BAR();
    ON(6) { pg::DenseSched S; S.init((const bf16_t*)(P.ws + WS_MA), MA_LD, (const bf16_t*)(P.ws + WS_WP_T), MA_LD, T, D, G, bx);
        pg::EpiMerged E; E.ws = P.ws; pg::gemm_phase(lds, S, E, MA_LD / 64, MA_LD); }
    GRID_BAR();
    ON(7) { pg::DenseSched S; S.init((const bf16_t*)(P.ws + WS_MERGED), D, (const bf16_t*)(P.ws + WS_WOUT_T), D, T, D, G, bx);
        pg::EpiWout E; E.x = P.in[I_X]; E.out = (float*)(P.ws + WS_X1); pg::gemm_phase(lds, S, E, D / 64, D); }
    GRID_BAR();
    ON(8) router_phase(P, lds, vcu, G);
    GRID_BAR();
    pg::moe_build_tab(lds, (const unsigned*)(P.ws + WS_CTL) + CW_CNT);
    ON(9) { pg::MoeSched<1> S; S.init(P.ws, lds, G, bx, P.in[I_B1]); pg::EpiMoe1 E; E.ws = P.ws; E.b1 = P.in[I_B1]; E.lds = lds; E.nostore = (r_ == 1);
#if defined(PROBE_MOE_NT)
        if (r_ == 1) { pg::EpiNull EN; pg::gemm_phase<true>(lds, S, EN, PROBE_MOE_NT, D / 2, 7); } else
#endif
        pg::gemm_phase<true>(lds, S, E, D / 128, D / 2);
#if EXPERTS_IN_ATTN
        if (r_ == 0 && G == 256 && (bx >> 3) >= 16) { const int k_ = (bx & 7) * 16 + (bx >> 3) - 16; expert_convert_slice(P, lds, EXP_M10 + k_ * EXP_N_M1, EXP_M10 + (k_ + 1) * EXP_N_M1); }
        __syncthreads();
#endif
    }
    GRID_BAR();
    ON(10) { pg::MoeSched<2> S; S.init(P.ws, lds, G, bx, P.in[I_B2]);
#if defined(PROBE_FREEZE)
        S.freeze = (r_ == 1);
#endif
 pg::EpiMoe2 E; E.ws = P.ws; E.b2 = P.in[I_B2]; E.lds = lds; E.nostore = (r_ == 1);
#if defined(PROBE_MOE_NT)
        if (r_ == 1) { pg::EpiNull EN; pg::gemm_phase<true>(lds, S, EN, PROBE_MOE_NT, DFF / 2, 7); } else
#endif
        pg::gemm_phase<true>(lds, S, E, DFF / 128, DFF / 2); }
    GRID_BAR();
    ON(11) combine_phase(P, lds, vcu, G);
    }
#undef ON
}

extern "C" void kernel_launch(void* const* d_in, const int* in_sizes, int n_in, void* d_out, int out_size, void* d_ws, size_t ws_size, hipStream_t stream) {
    static int grid = 0;
    if (grid == 0) {
        int dev = 0, cus = 0, per_cu = 0;
        if (hipGetDevice(&dev) != hipSuccess || hipDeviceGetAttribute(&cus, hipDeviceAttributeMultiprocessorCount, dev) != hipSuccess) { fprintf(stderr, "kernel_launch: device query failed\n"); grid = -1; return; }
        if (hipFuncSetAttribute((const void*)mega_fwd, hipFuncAttributeMaxDynamicSharedMemorySize, LDS_BYTES) != hipSuccess) { fprintf(stderr, "kernel_launch: hipFuncSetAttribute failed\n"); grid = -1; return; }
        if (hipOccupancyMaxActiveBlocksPerMultiprocessor(&per_cu, (const void*)mega_fwd, NTHREADS, LDS_BYTES) != hipSuccess || per_cu < 1) { fprintf(stderr, "kernel_launch: occupancy query reports %d workgroups per CU\n", per_cu); per_cu = 1; }
        (void)hipGetLastError();
        grid = cus;
        if (ws_size < WS_END) { fprintf(stderr, "kernel_launch: workspace too small\n"); grid = -1; return; }
    }
    if (grid < 0) return;
    hipMemsetAsync((char*)d_ws + WS_CTL, 0, CTL_ZERO_BYTES, stream);
    Params P{};
    for (int i = 0; i < 30; ++i) P.in[i] = (const float*)d_in[i];
    P.out = (float*)d_out; P.ws = (unsigned char*)d_ws;
    hipLaunchKernelGGL(mega_fwd, dim3(grid), dim3(NTHREADS), LDS_BYTES, stream, P);
#if defined(PROBE_TWO_LAUNCHES)
    hipMemsetAsync((char*)d_ws + WS_CTL, 0, CTL_ZERO_BYTES, stream);
    hipLaunchKernelGGL(mega_fwd, dim3(grid), dim3(NTHREADS), LDS_BYTES, stream, P);
#endif
}
```

```cpp
#include <hip/hip_runtime.h>
#include <hip/hip_bf16.h>
#include <stdint.h>
#include <math.h>
#include <cstdio>

constexpr int D = 1024, BATCH = 8, SEQ = 2048, T = BATCH * SEQ;
constexpr int SSM_W = 512, SSM_H = 16, SSM_G = 32, SSM_P = 64;
constexpr int CH_L = 32, NCH = SEQ / CH_L;
constexpr int ACAT_ROWS = BATCH * NCH;
constexpr int ACAT_LD = CH_L * SSM_H + 2 * SSM_P;
constexpr int AH = 8, AW = 1024;
constexpr int IN_W = 5632;
constexpr int NE = 32, DFF = 1024;
constexpr float EPS = 1e-5f;
constexpr int OFF_U = 0, OFF_Q = 512, OFF_K = 1536, OFF_V = 2560, OFF_GS = 3584, OFF_GA = 4608;
constexpr int CAP = T;
constexpr int MAXBLK = 288;
constexpr float QC2 = 0.125f * 1.4426950408889634f;
constexpr int MA_LD = 1536;

constexpr size_t MiB = 1u << 20;
constexpr size_t WS_CTL = 0, CTL_ZERO_BYTES = 64 * 1024;
constexpr size_t WS_WIN_T = 2 * MiB;
constexpr size_t WS_WGLU_T = 13 * MiB;
constexpr size_t WS_WP_T = 14 * MiB;
constexpr size_t WS_WOUT_T = 17 * MiB;
constexpr size_t WS_WR_T = 19 * MiB;
constexpr size_t WS_KJ = 21 * MiB;
constexpr size_t WS_WS_T = 22 * MiB;
constexpr size_t WS_BT_SSM = 26 * MiB;
constexpr size_t WS_W1_T = 48 * MiB;
constexpr size_t WS_W2_T = 176 * MiB;
constexpr size_t WS_XN = 240 * MiB;
constexpr size_t WS_ACAT = 272 * MiB;
constexpr size_t WS_Q = 292 * MiB, WS_K = 324 * MiB, WS_V = 356 * MiB;
constexpr size_t WS_GS = 388 * MiB, WS_GA = 420 * MiB;
constexpr size_t WS_X1 = 292 * MiB;
constexpr size_t WS_Z = 452 * MiB;
constexpr size_t WS_MA = 468 * MiB;
constexpr size_t WS_MERGED = 516 * MiB;
constexpr size_t WS_H2 = 548 * MiB;
constexpr size_t WS_SLOT_TOK = 582 * MiB;
constexpr size_t WS_SLOT_GATE = 584 * MiB;
constexpr size_t WS_TOK_EP = 586 * MiB;
constexpr size_t WS_ACT = 588 * MiB;
constexpr size_t WS_Y = 732 * MiB;
constexpr size_t WS_END = 876 * MiB;
constexpr int CW_CNT = 64;
constexpr int CW_BAR = 4096;

typedef unsigned short bf16_t;
typedef short bf16x8 __attribute__((ext_vector_type(8)));
typedef float f32x4 __attribute__((ext_vector_type(4)));
typedef float f32x2 __attribute__((ext_vector_type(2)));
typedef unsigned u32x4 __attribute__((ext_vector_type(4)));
typedef unsigned u32x2 __attribute__((ext_vector_type(2)));
#define LAS __attribute__((address_space(3)))
#define GAS __attribute__((address_space(1)))

__device__ __forceinline__ float wave_sum(float v) {
#pragma unroll
    for (int o = 1; o < 64; o <<= 1) v += __shfl_xor(v, o);
    return v;
}
typedef __bf16 bf16x2_hw __attribute__((ext_vector_type(2)));
__device__ __forceinline__ unsigned pk2(float lo, float hi) { const f32x2 v = {lo, hi}; return __builtin_bit_cast(unsigned, __builtin_convertvector(v, bf16x2_hw)); }
__device__ __forceinline__ unsigned f2bf(float f) { return pk2(f, 0.f) & 0xffffu; }
__device__ __forceinline__ float bf2f(unsigned short b) { return __builtin_bit_cast(float, (unsigned)b << 16); }
__device__ __forceinline__ float bflo(unsigned w) { return __builtin_bit_cast(float, w << 16); }
__device__ __forceinline__ float bfhi(unsigned w) { return __builtin_bit_cast(float, w & 0xffff0000u); }
__device__ __forceinline__ float sigmoid_f(float x) { return __builtin_amdgcn_rcpf(1.f + __expf(-x)); }
__device__ __forceinline__ float sigmoid_c(float x) { x = fminf(fmaxf(x, -30.f), 30.f); return __builtin_amdgcn_rcpf(1.f + __expf(-x)); }
__device__ __forceinline__ float gelu_tanh(float x) { const float u = 0.7978845608028654f * (x + 0.044715f * x * x * x); return x * sigmoid_f(2.f * u); }

__device__ __forceinline__ unsigned pk4_fp8(float a, float b, float cc, float d) { int w = 0; w = __builtin_amdgcn_cvt_pk_fp8_f32(a, b, w, false); w = __builtin_amdgcn_cvt_pk_fp8_f32(cc, d, w, true); return (unsigned)w; }
__device__ __forceinline__ void unpk4_fp8(unsigned w, float& a, float& b, float& cc, float& d) { const f32x2 lo = __builtin_amdgcn_cvt_pk_f32_fp8((int)w, false), hi = __builtin_amdgcn_cvt_pk_f32_fp8((int)w, true); a = lo.x; b = lo.y; cc = hi.x; d = hi.y; }
constexpr float W8_SCALE = 64.f;
#ifndef WT_STORES
#define WT_STORES 0
#endif
__device__ __forceinline__ void store16(void* p, const u32x4 v) {
#if WT_STORES
    asm volatile("global_store_dwordx4 %0, %1, off sc1\n\ts_nop 1" :: "v"(p), "v"(v) : "memory");
#else
    *(u32x4*)p = v;
#endif
}
#ifndef NT_STREAMS
#define NT_STREAMS 1
#endif
#if NT_STREAMS
#define NT_LOAD(p) __builtin_nontemporal_load(p)
#define NT_STORE(v, p) __builtin_nontemporal_store((v), (p))
#else
#define NT_LOAD(p) (*(p))
#define NT_STORE(v, p) (*(p) = (v))
#endif
__device__ __forceinline__ int opaque_tid() { int t = threadIdx.x; asm volatile("" : "+v"(t)); return t; }

struct Params {
    const float* in[30];
    float* out;
    unsigned char* ws;
};
enum { I_X = 0, I_G1, I_WIN, I_LRE, I_LIM, I_LOGDT, I_BRE, I_BIM, I_CRE, I_CIM, I_DSK, I_WGLU, I_BGLU, I_QG, I_KG, I_LQ1, I_LK1, I_LQ2, I_LK2, I_SG, I_WPS, I_WPA, I_WOUT, I_G2, I_WR, I_BR, I_W1, I_B1, I_W2, I_B2 };

constexpr int NWAVES = 8, NTHREADS = 512;
constexpr int LDS_BYTES = 147456;
constexpr int RING_BYTES = 131072;
constexpr int MISC_OFF = RING_BYTES + 320;
__device__ __forceinline__ void p0_transpose_item(const float* __restrict__ W, int N, bf16_t* __restrict__ WT, int ldo, int k_off, LAS float* scr, int kb, int nb, int lane) {
    const int k0 = 64 * kb, n0 = 32 * nb;
    { f32x4 v[8];
#pragma unroll
        for (int i = 0; i < 8; ++i) v[i] = NT_LOAD((const f32x4*)(W + (size_t)(k0 + 8 * i + (lane >> 3)) * N + n0 + (lane & 7) * 4));
#pragma unroll
        for (int i = 0; i < 8; ++i) { LAS float* d = scr + (8 * i + (lane >> 3)) * 33 + (lane & 7) * 4; d[0] = v[i].x; d[1] = v[i].y; d[2] = v[i].z; d[3] = v[i].w; } }
    asm volatile("s_waitcnt lgkmcnt(0)" ::: "memory");
    const int c = lane & 7;
#pragma unroll
    for (int j = 0; j < 4; ++j) { const int n = (lane >> 3) + 8 * j; const LAS float* s = scr + (8 * c) * 33 + n;
        u32x4 o; o.x = pk2(s[0 * 33], s[1 * 33]); o.y = pk2(s[2 * 33], s[3 * 33]); o.z = pk2(s[4 * 33], s[5 * 33]); o.w = pk2(s[6 * 33], s[7 * 33]);
        *(u32x4*)(WT + (size_t)(n0 + n) * ldo + k_off + k0 + 8 * c) = o; }
    asm volatile("s_waitcnt lgkmcnt(0)" ::: "memory");
}
__device__ __forceinline__ void p0_transpose_item_fp8(const float* __restrict__ W, int N, unsigned char* __restrict__ WT, int ldo, LAS float* scr, int kb, int nb, int lane) {
    const int k0 = 64 * kb, n0 = 32 * nb;
    { f32x4 v[8];
#pragma unroll
        for (int i = 0; i < 8; ++i) v[i] = NT_LOAD((const f32x4*)(W + (size_t)(k0 + 8 * i + (lane >> 3)) * N + n0 + (lane & 7) * 4));
#pragma unroll
        for (int i = 0; i < 8; ++i) { LAS float* d = scr + (8 * i + (lane >> 3)) * 33 + (lane & 7) * 4; d[0] = v[i].x; d[1] = v[i].y; d[2] = v[i].z; d[3] = v[i].w; } }
    asm volatile("s_waitcnt lgkmcnt(0)" ::: "memory");
    const int n = lane >> 1, half = lane & 1; const LAS float* s = scr + (32 * half) * 33 + n;
    unsigned o[8];
#pragma unroll
    for (int q = 0; q < 8; ++q) o[q] = pk4_fp8(s[(4 * q) * 33] * W8_SCALE, s[(4 * q + 1) * 33] * W8_SCALE, s[(4 * q + 2) * 33] * W8_SCALE, s[(4 * q + 3) * 33] * W8_SCALE);
    u32x4* dst = (u32x4*)(WT + (size_t)(n0 + n) * ldo + k0 + 32 * half);
    dst[0] = (u32x4){o[0], o[1], o[2], o[3]}; dst[1] = (u32x4){o[4], o[5], o[6], o[7]};
    asm volatile("s_waitcnt lgkmcnt(0)" ::: "memory");
}
__device__ __forceinline__ void p0_transpose_f32_item(const float* __restrict__ W, float* __restrict__ WT, int K, LAS float* scr, int kb, int lane) {
    const int k0 = 64 * kb;
#pragma unroll 8
    for (int i = 0; i < 32; ++i) { const int kk = 2 * i + (lane >> 5); scr[kk * 33 + (lane & 31)] = W[(size_t)(k0 + kk) * 32 + (lane & 31)]; }
    asm volatile("s_waitcnt lgkmcnt(0)" ::: "memory");
#pragma unroll 8
    for (int n = 0; n < 32; ++n) WT[(size_t)n * K + k0 + lane] = scr[lane * 33 + n];
    asm volatile("s_waitcnt lgkmcnt(0)" ::: "memory");
}
__device__ __forceinline__ void rms_row_to_bf16(const float* __restrict__ xrow, const float* __restrict__ g, bf16_t* __restrict__ orow, int lane) {
    const f32x4* xr = (const f32x4*)xrow + lane; const f32x4* gr = (const f32x4*)g + lane;
    f32x4 v[4]; float s = 0.f;
#pragma unroll
    for (int j = 0; j < 4; ++j) { v[j] = NT_LOAD(xr + 64 * j); s += (v[j].x * v[j].x + v[j].y * v[j].y) + (v[j].z * v[j].z + v[j].w * v[j].w); }
    const float r = rsqrtf(wave_sum(s) * (1.f / D) + EPS);
    u32x2* o8 = (u32x2*)orow + lane;
#pragma unroll
    for (int j = 0; j < 4; ++j) { const f32x4 gg = gr[64 * j]; u32x2 w; w.x = pk2(v[j].x * r * gg.x, v[j].y * r * gg.y); w.y = pk2(v[j].z * r * gg.z, v[j].w * r * gg.w); o8[64 * j] = w; }
}
struct SsmGP { float lrdt, lidt, cr, ci; };
__device__ __forceinline__ SsmGP ssm_gp(const Params& P, int g, int p) {
    const float dt = expf(P.in[I_LOGDT][g]);
    const float lr = fminf(P.in[I_LRE][g * SSM_P + p], -1e-4f), li = P.in[I_LIM][g * SSM_P + p];
    const float mag = expf(lr * dt);
    float sn, cs; sincosf(li * dt, &sn, &cs);
    const float ar = mag * cs, ai = mag * sn;
    const float den = lr * lr + li * li, nr = ar - 1.f;
    SsmGP r; r.lrdt = lr * dt; r.lidt = li * dt; r.cr = (nr * lr + ai * li) / den; r.ci = (ai * lr - nr * li) / den;
    return r;
}
__device__ __forceinline__ void ssm_pow(const SsmGP& q, int j, float& pr, float& pi) {
    const float m = expf((float)j * q.lrdt); float sn, cs; sincosf((float)j * q.lidt, &sn, &cs); pr = m * cs; pi = m * sn;
}

#ifndef EXP_DMA_AUX
#define EXP_DMA_AUX 2
#endif
struct ExpItem { const float* W; unsigned char* WT; int N, ldo, kb, nb, sw; };
__device__ __forceinline__ ExpItem exp_item(const Params& P, int it) {
    constexpr int I_E1 = (1024 / 128) * (2048 / 32), I_E2 = (1024 / 128) * (1024 / 32);
    ExpItem x;
    if (it < NE * I_E1) { const int e = it / I_E1, q = it % I_E1; x.W = P.in[I_W1] + (size_t)e * D * 2 * DFF; x.WT = P.ws + WS_W1_T + (size_t)e * 2 * DFF * D; x.N = 2 * DFF; x.ldo = D; x.kb = q / 64; x.nb = q % 64; x.sw = 3; }
    else { const int r = it - NE * I_E1, e = r / I_E2, q = r % I_E2; x.W = P.in[I_W2] + (size_t)e * DFF * D; x.WT = P.ws + WS_W2_T + (size_t)e * D * DFF; x.N = D; x.ldo = DFF; x.kb = q / 32; x.nb = q % 32; x.sw = 0; }
    return x;
}
__device__ __forceinline__ void exp_dma(const ExpItem& x, int lane, LAS unsigned char* buf) {
    const float* src = x.W + (size_t)(128 * x.kb + (lane >> 3)) * x.N + 32 * x.nb;
#pragma unroll
    for (int i = 0; i < 16; ++i) __builtin_amdgcn_global_load_lds((const unsigned*)(src + (size_t)(8 * i) * x.N + ((((lane & 7) ^ (lane >> 3) ^ (i >> 1)) & 7) << 2)), (LAS unsigned*)(buf + i * 1024), 16, 0, EXP_DMA_AUX);
}
#if defined(PROBE_CONV_NOSTORE)
#define g_conv_nostore nostore_
__device__ __forceinline__ void exp_finish_lds(const ExpItem& x, int lane, const LAS unsigned char* buf, bool nostore_ = false) {
#else
__device__ __forceinline__ void exp_finish_lds(const ExpItem& x, int lane, const LAS unsigned char* buf) {
#endif
    const int c = lane & 7;
#pragma unroll
    for (int pass = 0; pass < 4; ++pass) {
        const int n = 8 * pass + (lane >> 3), q0 = (n >> 2) ^ c;
        const int no = n ^ ((((n >> 1) ^ n) & 1) ? x.sw : 0);
        const LAS unsigned char* rb = buf + c * 2048 + ((n & 3) << 2);
        float f[16];
#pragma unroll
        for (int j = 0; j < 16; ++j) f[j] = *(const LAS float*)(rb + j * 128 + (((q0 ^ j) & 7) << 4)) * W8_SCALE;
        const u32x4 o = (u32x4){pk4_fp8(f[0], f[1], f[2], f[3]), pk4_fp8(f[4], f[5], f[6], f[7]), pk4_fp8(f[8], f[9], f[10], f[11]), pk4_fp8(f[12], f[13], f[14], f[15])};
#if defined(PROBE_CONV_NOSTORE)
        if (g_conv_nostore) { asm volatile("" :: "v"(o)); } else
#endif
#if NT_STREAMS && !defined(CONV_ST_DEFAULT)
        __builtin_nontemporal_store(o, (u32x4*)(x.WT + (size_t)(32 * x.nb + no) * x.ldo + 128 * x.kb + 16 * c));
#else
        *(u32x4*)(x.WT + (size_t)(32 * x.nb + no) * x.ldo + 128 * x.kb + 16 * c) = o;
#endif
    }
    asm volatile("s_waitcnt lgkmcnt(0)" ::: "memory");
}
constexpr int EXP_ITEMS = NE * ((1024 / 128) * (2048 / 32) + (1024 / 128) * (1024 / 32));
constexpr int EXP_N_IN = 32, EXP_N_S2 = 20, EXP_N_GLU = 20, EXP_N_M1 = 0;
constexpr int EXP_IN0 = 0, EXP_S20 = 128 * EXP_N_IN, EXP_GLU0 = EXP_S20 + 128 * EXP_N_S2, EXP_ATT0 = EXP_GLU0 + 128 * EXP_N_GLU, EXP_M10 = EXP_ITEMS - 128 * EXP_N_M1;
static_assert((EXP_M10 - EXP_ATT0) % 256 == 0 && EXP_M10 >= NE * (1024 / 128) * (2048 / 32), "item split (the expert-GEMM-1 tail share must be W2 items only)");
__device__ __forceinline__ void expert_convert_slice(const Params& P, LAS unsigned char* lds, int i0, int i1, bool probe_nostore = false) {
    const int tid = opaque_tid(), lane = tid & 63, wave = __builtin_amdgcn_readfirstlane(tid >> 6);
    LAS unsigned char* b0 = lds + wave * 16384;
    for (int it = i0 + wave; it < i1; it += NWAVES) {
        const ExpItem c0 = exp_item(P, it);
        exp_dma(c0, lane, b0);
        asm volatile("s_waitcnt vmcnt(0)" ::: "memory");
#if defined(PROBE_CONV_NOSTORE)
        exp_finish_lds(c0, lane, b0, probe_nostore);
#else
        exp_finish_lds(c0, lane, b0);
#endif
    }
}
__device__ __forceinline__ void p0_prologue(const Params& P, LAS unsigned char* lds, int vcu, int G) {
    const int tid = opaque_tid(), lane = tid & 63, wave = __builtin_amdgcn_readfirstlane(tid >> 6);
    LAS float* scr = (LAS float*)(lds + wave * 16384);
    unsigned char* ws = P.ws;
    const int gw = vcu * NWAVES + wave, NGW = G * NWAVES;
    constexpr int I_IN = (D / 64) * (IN_W / 32);
    constexpr int I_GLU = (512 / 64) * (512 / 32);
    constexpr int I_PS = (512 / 64) * (1024 / 32);
    constexpr int I_PA = (1024 / 64) * (1024 / 32);
    constexpr int I_OUT = I_PA;
    constexpr int I_R = 1024 / 64;
    constexpr int I_E1 = (1024 / 64) * (2048 / 32);
    constexpr int I_E2 = (1024 / 64) * (1024 / 32);
#ifndef EXPERTS_IN_ATTN
#define EXPERTS_IN_ATTN 1
#endif
    constexpr int NITEMS = I_IN + I_GLU + I_PS + I_PA + I_OUT + I_R + (EXPERTS_IN_ATTN ? 0 : NE * I_E1 + NE * I_E2);
    for (int it = gw; it < NITEMS; it += NGW) {
        int r = it;
        if (r < I_IN) { const int nblk = IN_W / 32; p0_transpose_item(P.in[I_WIN], IN_W, (bf16_t*)(ws + WS_WIN_T), D, 0, scr, r / nblk, r % nblk, lane); continue; } r -= I_IN;
        if (r < I_GLU) { const int nblk = 512 / 32; p0_transpose_item(P.in[I_WGLU], 512, (bf16_t*)(ws + WS_WGLU_T), 512, 0, scr, r / nblk, r % nblk, lane); continue; } r -= I_GLU;
        if (r < I_PS) { const int nblk = 1024 / 32; p0_transpose_item(P.in[I_WPS], 1024, (bf16_t*)(ws + WS_WP_T), MA_LD, 1024, scr, r / nblk, r % nblk, lane); continue; } r -= I_PS;
        if (r < I_PA) { const int nblk = 1024 / 32; p0_transpose_item(P.in[I_WPA], 1024, (bf16_t*)(ws + WS_WP_T), MA_LD, 0, scr, r / nblk, r % nblk, lane); continue; } r -= I_PA;
        if (r < I_OUT) { const int nblk = 1024 / 32; p0_transpose_item(P.in[I_WOUT], 1024, (bf16_t*)(ws + WS_WOUT_T), D, 0, scr, r / nblk, r % nblk, lane); continue; } r -= I_OUT;
        if (r < I_R) { p0_transpose_f32_item(P.in[I_WR], (float*)(ws + WS_WR_T), D, scr, r, lane); continue; } r -= I_R;
        if (EXPERTS_IN_ATTN) continue;
        if (r < NE * I_E1) { const int e = r / I_E1, q = r % I_E1, nblk = 2048 / 32;
            p0_transpose_item_fp8(P.in[I_W1] + (size_t)e * D * 2 * DFF, 2 * DFF, ws + WS_W1_T + (size_t)e * 2 * DFF * D, D, scr, q / nblk, q % nblk, lane); continue; } r -= NE * I_E1;
        { const int e = r / I_E2, q = r % I_E2, nblk = 1024 / 32;
            p0_transpose_item_fp8(P.in[I_W2] + (size_t)e * DFF * D, D, ws + WS_W2_T + (size_t)e * D * DFF, DFF, scr, q / nblk, q % nblk, lane); }
    }
#if EXPERTS_IN_ATTN
    if (G != 256) { __syncthreads(); for (int c0 = vcu * 64; c0 < EXP_ATT0; c0 += G * 64) expert_convert_slice(P, lds, c0, min(EXP_ATT0, c0 + 64));
        for (int c0 = EXP_M10 + vcu * 64; c0 < EXP_ITEMS; c0 += G * 64) expert_convert_slice(P, lds, c0, min(EXP_ITEMS, c0 + 64)); __syncthreads(); }
#endif
    for (int m = gw; m < T; m += NGW) rms_row_to_bf16(P.in[I_X] + (size_t)m * D, P.in[I_G1], (bf16_t*)(ws + WS_XN) + (size_t)m * D, lane);
    if (gw == 0) { u32x4* z = (u32x4*)(ws + WS_H2 + (size_t)T * D); z[lane] = (u32x4){0u, 0u, 0u, 0u}; }
    const int gt = vcu * NTHREADS + tid, NGT = G * NTHREADS;
    for (int it = gw; it < SSM_G * CH_L; it += NGW) {
        const int g = it / CH_L, j = it % CH_L, h = lane >> 2, hq = (lane & 3) * 4;
        { const SsmGP q = ssm_gp(P, g, lane); float pr, pi; ssm_pow(q, j, pr, pi); scr[2 * lane] = pr * q.cr - pi * q.ci; scr[2 * lane + 1] = pr * q.ci + pi * q.cr; }
        asm volatile("s_waitcnt lgkmcnt(0)" ::: "memory");
        float a0 = 0.f, a1 = 0.f, a2 = 0.f, a3 = 0.f;
#pragma unroll 4
        for (int p = 0; p < SSM_P; ++p) {
            const float wr = scr[2 * p], wi = scr[2 * p + 1];
            const float cre = P.in[I_CRE][(g * SSM_H + h) * SSM_P + p], cim = P.in[I_CIM][(g * SSM_H + h) * SSM_P + p];
            const float mr = cre * wr - cim * wi, mi = cre * wi + cim * wr;
            const f32x4 br = *(const f32x4*)(P.in[I_BRE] + (g * SSM_P + p) * SSM_H + hq), bi = *(const f32x4*)(P.in[I_BIM] + (g * SSM_P + p) * SSM_H + hq);
            a0 += mr * br.x - mi * bi.x; a1 += mr * br.y - mi * bi.y; a2 += mr * br.z - mi * bi.z; a3 += mr * br.w - mi * bi.w;
        }
        if (j == 0) { const float dsk = P.in[I_DSK][g * SSM_H + h]; if (hq == (h & 12)) { const int w = h & 3; if (w == 0) a0 += dsk; else if (w == 1) a1 += dsk; else if (w == 2) a2 += dsk; else a3 += dsk; } }
        *(f32x4*)((float*)(ws + WS_KJ) + ((size_t)(g * CH_L + j) * SSM_H + h) * SSM_H + hq) = (f32x4){a0, a1, a2, a3};
        asm volatile("s_waitcnt lgkmcnt(0)" ::: "memory");
    }
    for (int it = gt; it < SSM_G * 128 * CH_L; it += NGT) {
        const int s = it % CH_L, n = (it / CH_L) % 128, g = it / (CH_L * 128), p = n & 63, part = n >> 6;
        const SsmGP q = ssm_gp(P, g, p); float pr, pi; ssm_pow(q, CH_L - 1 - s, pr, pi);
        const float wr = pr * q.cr - pi * q.ci, wi = pr * q.ci + pi * q.cr;
        const float* br = P.in[I_BRE] + (g * SSM_P + p) * SSM_H; const float* bi = P.in[I_BIM] + (g * SSM_P + p) * SSM_H;
        unsigned o[8];
#pragma unroll
        for (int h2 = 0; h2 < 8; ++h2) {
            float v0, v1;
            if (part == 0) { v0 = wr * br[2 * h2] - wi * bi[2 * h2]; v1 = wr * br[2 * h2 + 1] - wi * bi[2 * h2 + 1]; }
            else { v0 = wr * bi[2 * h2] + wi * br[2 * h2]; v1 = wr * bi[2 * h2 + 1] + wi * br[2 * h2 + 1]; }
            o[h2] = pk2(v0, v1);
        }
        u32x4* dst = (u32x4*)((bf16_t*)(ws + WS_WS_T) + ((size_t)(g * 128 + n) * 512 + s * 16));
        dst[0] = (u32x4){o[0], o[1], o[2], o[3]}; dst[1] = (u32x4){o[4], o[5], o[6], o[7]};
    }
    for (int it = gt; it < SSM_G * CH_L * SSM_P; it += NGT) {
        const int p = it % SSM_P, t = (it / SSM_P) % CH_L, g = it / (SSM_P * CH_L);
        const SsmGP q = ssm_gp(P, g, p); float pr, pi; ssm_pow(q, t + 1, pr, pi);
        bf16_t* base = (bf16_t*)(ws + WS_BT_SSM) + ((size_t)(g * 512 + t * 16)) * ACAT_LD + 512 + p;
#pragma unroll 4
        for (int h = 0; h < SSM_H; ++h) {
            const float cre = P.in[I_CRE][(g * SSM_H + h) * SSM_P + p], cim = P.in[I_CIM][(g * SSM_H + h) * SSM_P + p];
            base[(size_t)h * ACAT_LD] = (bf16_t)f2bf(cre * pr - cim * pi);
            base[(size_t)h * ACAT_LD + 64] = (bf16_t)f2bf(-(cre * pi + cim * pr));
        }
    }
}
__device__ __forceinline__ void ssm_toeplitz_expand(const Params& P, int vcu, int G) {
    const int gt = vcu * NTHREADS + opaque_tid(), NGT = G * NTHREADS;
    unsigned char* ws = P.ws;
    for (int it = gt; it < SSM_G * 512 * 64; it += NGT) {
        const int kc = it & 63, n = (it >> 6) & 511, g = it >> 15;
        const int s = kc >> 1, hq = (kc & 1) * 8, t = n >> 4, h = n & 15;
        u32x4 o = (u32x4){0u, 0u, 0u, 0u};
        if (s <= t) { const float* kj = (const float*)(ws + WS_KJ) + ((size_t)(g * CH_L + (t - s)) * SSM_H + h) * SSM_H + hq;
            const f32x4 a = *(const f32x4*)kj, b = *(const f32x4*)(kj + 4);
            o.x = pk2(a.x, a.y); o.y = pk2(a.z, a.w); o.z = pk2(b.x, b.y); o.w = pk2(b.z, b.w); }
        *(u32x4*)((bf16_t*)(ws + WS_BT_SSM) + ((size_t)(g * 512 + n)) * ACAT_LD + kc * 8) = o;
    }
}
#ifndef PG_WGM
#define PG_WGM 8
#endif
namespace pg {
constexpr int BM = 256, BK = 64, HALF = 128, HTB = HALF * BK * 2, STAGE_BYTES = 8 * HTB;
__host__ __device__ __forceinline__ int lds_byte(int r, int c) { const int st = (r >> 4) * 2 + (c >> 5), rr = r & 15, cc = c & 31, ob = rr * 64 + cc * 2; return st * 1024 + (ob ^ (((ob >> 9) & 1) << 5)); }
__host__ __device__ __forceinline__ void stage_rc(int b, int& R, int& C) { const int st = b / 1024, sb = b % 1024, swz = sb ^ (((sb >> 9) & 1) << 5); R = (st >> 1) * 16 + swz / 64; C = (st & 1) * 32 + (swz % 64) / 2; }
__host__ __device__ __forceinline__ int perm32(int rho) { const int n = rho >> 4, i = rho & 15; return 8 * (i >> 2) + 4 * n + (i & 3); }

struct Unit {
    const char* A;
    const char* B;
    unsigned aoff[2][2];
    int pm, pn, aux, aux2;
    int ord;
};
struct EpiInfo { int pm, pn, aux, aux2, ord; };
typedef f32x4 Acc[2][2][4][2];

typedef int v8i_t __attribute__((ext_vector_type(8)));
typedef int v4i_t __attribute__((ext_vector_type(4)));
template <bool FP8 = false, int BAUX = 0  , class Sched, class Epi>
__device__ __forceinline__ void gemm_phase(LAS unsigned char* lds, const Sched& S, const Epi& E, const int nt, const int ldb, const int ktm = -1  ) {
    const int tid = opaque_tid(), wid = __builtin_amdgcn_readfirstlane(tid >> 6), lane = tid & 63, wr = wid >> 2, wc = wid & 3, fr = lane & 15, fq = lane >> 4;
    unsigned voffB[2];
#pragma unroll
    for (int i = 0; i < 2; ++i) { int R, C; stage_rc(tid * 16 + i * 8192, R, C); voffB[i] = (unsigned)((64 * (R >> 5) + perm32(R & 31)) * ldb + C) * 2u; }
    const unsigned hB = (unsigned)(32 * ldb * 2);
    const unsigned ldsw = (unsigned)wid * 1024u;
    const int aoffl = lds_byte(wr * 64 + fr, fq * 8), boffl = lds_byte(wc * 32 + fr, fq * 8);
#define PG_SA(b, h) (((b) * 2 + (h)) * pg::HTB)
#define PG_SB(b, h) ((4 + (b) * 2 + (h)) * pg::HTB)
#define PG_GLDS(gp, bufoff, i) __builtin_amdgcn_global_load_lds((const unsigned*)(gp), (LAS unsigned*)(lds + (bufoff) + ldsw + (i) * 8192), 16, 0, 0)
#define PG_STAGE_A(bufoff, Ab, o0, o1, kt) do { const char* _b = (Ab) + (size_t)((kt) & ktm) * 128; PG_GLDS(_b + (o0), bufoff, 0); PG_GLDS(_b + (o1), bufoff, 1); } while (0)
#define PG_GLDSB(gp, bufoff, i) __builtin_amdgcn_global_load_lds((const unsigned*)(gp), (LAS unsigned*)(lds + (bufoff) + ldsw + (i) * 8192), 16, 0, BAUX)
#define PG_STAGE_B(bufoff, Bb, h, kt) do { const char* _b = (Bb) + (size_t)((kt) & ktm) * 128 + (h) * hB; PG_GLDSB(_b + voffB[0], bufoff, 0); PG_GLDSB(_b + voffB[1], bufoff, 1); } while (0)
#define PG_LDA(dst, b, h) do { _Pragma("unroll") for (int m = 0; m < 4; ++m) _Pragma("unroll") for (int k = 0; k < 2; ++k) dst[m][k] = *(const LAS bf16x8*)(lds + PG_SA(b, h) + aoffl + m * 2048 + k * 1024); } while (0)
#define PG_LDB(dst, b, h) do { _Pragma("unroll") for (int n = 0; n < 2; ++n) _Pragma("unroll") for (int k = 0; k < 2; ++k) dst[n][k] = *(const LAS bf16x8*)(lds + PG_SB(b, h) + boffl + n * 2048 + k * 1024); } while (0)
#define PG_CAT8(lo, hi) __builtin_shufflevector(__builtin_bit_cast(v4i_t, lo), __builtin_bit_cast(v4i_t, hi), 0, 1, 2, 3, 4, 5, 6, 7)
#define PG_MMA(ai, bj, At, Bt) do { __builtin_amdgcn_s_setprio(1); if constexpr (FP8) { _Pragma("unroll") for (int m = 0; m < 4; ++m) _Pragma("unroll") for (int n = 0; n < 2; ++n) \
            acc[ai][bj][m][n] = __builtin_amdgcn_mfma_scale_f32_16x16x128_f8f6f4(PG_CAT8(Bt[n][0], Bt[n][1]), PG_CAT8(At[m][0], At[m][1]), acc[ai][bj][m][n], 0, 0, 0, 0x79797979, 0, 0x7f7f7f7f); } \
        else { _Pragma("unroll") for (int m = 0; m < 4; ++m) _Pragma("unroll") for (int n = 0; n < 2; ++n) _Pragma("unroll") for (int k = 0; k < 2; ++k) \
        acc[ai][bj][m][n] = __builtin_amdgcn_mfma_f32_16x16x32_bf16(Bt[n][k], At[m][k], acc[ai][bj][m][n], 0, 0, 0); } __builtin_amdgcn_s_setprio(0); } while (0)
#define PG_WAIT_V(n) asm volatile("s_waitcnt vmcnt(" #n ")" ::: "memory")
#define PG_WAIT_L(n) asm volatile("s_waitcnt lgkmcnt(" #n ")" ::: "memory")
#define PG_BAR __builtin_amdgcn_s_barrier()
#define PG_SCHED __builtin_amdgcn_sched_barrier(0)
#define PG_KLOOP(T0, T1) _Pragma("clang loop unroll(disable)") for (int t = (T0); t < (T1); t += 2) { \
            const bool last = (t == nt - 2); \
            PG_LDB(B0, 0, 0); PG_LDB(B1, 0, 1); PG_SCHED; PG_LDA(At, 0, 0); PG_STAGE_A(PG_SA(1, 1), st.A, st.aoff[1][0], st.aoff[1][1], t + 1); \
            if (last) { Unit nu_; has_next = S.next(ui + 1, nu_); if (has_next) { st = nu_; } } \
            const int k2 = last ? 0 : t + 2, k3 = k2 + 1; \
            PG_WAIT_V(8); PG_WAIT_L(0); PG_BAR; PG_MMA(0, 0, At, B0); PG_MMA(0, 1, At, B1); PG_BAR; PG_SCHED; \
            PG_LDA(At, 0, 1); PG_STAGE_B(PG_SB(0, 0), st.B, 0, k2); PG_STAGE_B(PG_SB(0, 1), st.B, 1, k2); PG_STAGE_A(PG_SA(0, 0), st.A, st.aoff[0][0], st.aoff[0][1], k2); \
            PG_WAIT_V(8); PG_WAIT_L(0); PG_BAR; PG_MMA(1, 0, At, B0); PG_MMA(1, 1, At, B1); PG_BAR; PG_SCHED; \
            PG_LDB(B0, 1, 0); PG_LDB(B1, 1, 1); PG_SCHED; PG_LDA(At, 1, 0); PG_STAGE_A(PG_SA(0, 1), st.A, st.aoff[1][0], st.aoff[1][1], k2); \
            PG_WAIT_V(8); PG_WAIT_L(0); PG_BAR; PG_MMA(0, 0, At, B0); PG_MMA(0, 1, At, B1); PG_BAR; PG_SCHED; \
            PG_LDA(At, 1, 1); PG_STAGE_B(PG_SB(1, 0), st.B, 0, k3); PG_STAGE_B(PG_SB(1, 1), st.B, 1, k3); PG_STAGE_A(PG_SA(1, 0), st.A, st.aoff[0][0], st.aoff[0][1], k3); \
            PG_WAIT_V(8); PG_WAIT_L(0); PG_BAR; PG_MMA(1, 0, At, B0); PG_MMA(1, 1, At, B1); PG_BAR; PG_SCHED; \
        }
    Unit st; int ui = 0;
    if (!S.next(0, st)) return;
    EpiInfo cur; cur.pm = st.pm; cur.pn = st.pn; cur.aux = st.aux; cur.aux2 = st.aux2; cur.ord = st.ord;
    Acc acc;
#pragma unroll
    for (int a = 0; a < 2; ++a)
#pragma unroll
        for (int b = 0; b < 2; ++b)
#pragma unroll
            for (int m = 0; m < 4; ++m)
#pragma unroll
                for (int n = 0; n < 2; ++n) acc[a][b][m][n] = (f32x4){0.f, 0.f, 0.f, 0.f};
    bf16x8 At[4][2], B0[2][2], B1[2][2];
    PG_STAGE_B(PG_SB(0, 0), st.B, 0, 0); PG_STAGE_B(PG_SB(0, 1), st.B, 1, 0); PG_STAGE_A(PG_SA(0, 0), st.A, st.aoff[0][0], st.aoff[0][1], 0); PG_STAGE_A(PG_SA(0, 1), st.A, st.aoff[1][0], st.aoff[1][1], 0);
    if (wr == 1) PG_BAR;
    PG_WAIT_V(2); PG_BAR;
    PG_STAGE_B(PG_SB(1, 0), st.B, 0, 1); PG_STAGE_A(PG_SA(1, 0), st.A, st.aoff[0][0], st.aoff[0][1], 1); PG_STAGE_B(PG_SB(1, 1), st.B, 1, 1);
    PG_WAIT_V(6); PG_BAR;
    for (;;) {
        bool has_next = false;
        if constexpr (Epi::HAS_MID) { PG_KLOOP(0, Epi::MID_T) E.mid(acc, cur, wr, wc, fr, fq); PG_KLOOP(Epi::MID_T, nt) } else { PG_KLOOP(0, nt) }
        if (wr == 0) PG_BAR;
        E(acc, cur, wr, wc, fr, fq);
        if (!has_next) break;
#pragma unroll
        for (int a = 0; a < 2; ++a)
#pragma unroll
            for (int b = 0; b < 2; ++b)
#pragma unroll
                for (int m = 0; m < 4; ++m)
#pragma unroll
                    for (int n = 0; n < 2; ++n) acc[a][b][m][n] = (f32x4){0.f, 0.f, 0.f, 0.f};
        cur.pm = st.pm; cur.pn = st.pn; cur.aux = st.aux; cur.aux2 = st.aux2; cur.ord = st.ord; ++ui;
        if (wr == 1) PG_BAR;
    }
    PG_WAIT_V(0);
    PG_BAR;
#undef PG_SA
#undef PG_SB
#undef PG_GLDS
#undef PG_GLDSB
#undef PG_STAGE_A
#undef PG_STAGE_B
#undef PG_LDA
#undef PG_LDB
#undef PG_MMA
#undef PG_WAIT_V
#undef PG_WAIT_L
#undef PG_BAR
#undef PG_SCHED
#undef PG_KLOOP
}

struct LaneRC { int R[2], C[2]; __device__ __forceinline__ LaneRC() { const int t = opaque_tid(); stage_rc(t * 16, R[0], C[0]); stage_rc(t * 16 + 8192, R[1], C[1]); } };

struct DenseSched {
    const bf16_t* A; const bf16_t* Bt; int lda, ldb, nM, nN, nwg, G, c;
    __device__ __forceinline__ void init(const bf16_t* A_, int lda_, const bf16_t* Bt_, int ldb_, int M, int N, int G_, int c_) { A = A_; Bt = Bt_; lda = lda_; ldb = ldb_; nM = M / BM; nN = N / BM; nwg = nM * nN; G = G_; c = c_; }
    __device__ __forceinline__ bool next(int i, Unit& u) const {
        const long L = (long)i * G + c; if (L >= nwg) return false;
        int wgid = (int)L; { const int q = nwg / 8, r = nwg % 8, xcd = wgid % 8, off = wgid / 8; wgid = (xcd < r ? xcd * (q + 1) : r * (q + 1) + (xcd - r) * q) + off; }
        const int WGM = PG_WGM, nig = WGM * nN, gid = wgid / nig, fm = gid * WGM, gsz = (nM - fm) < WGM ? (nM - fm) : WGM;
        u.pm = fm + ((wgid % nig) % gsz); u.pn = (wgid % nig) / gsz; u.aux = 0; u.aux2 = 0; u.ord = i;
        u.A = (const char*)A; u.B = (const char*)(Bt + (size_t)u.pn * BM * ldb); const LaneRC rc;
#pragma unroll
        for (int h = 0; h < 2; ++h)
#pragma unroll
            for (int j = 0; j < 2; ++j) u.aoff[h][j] = (unsigned)(((u.pm * BM + 128 * h + rc.R[j]) * lda + rc.C[j]) * 2);
        return true;
    }
};
}
namespace pg {
constexpr int TAB_OFF = RING_BYTES + 1024;
__device__ __forceinline__ void moe_build_tab(LAS unsigned char* lds, const unsigned* cnt) {
    LAS int* tab = (LAS int*)(lds + TAB_OFF);
    if (threadIdx.x == 0) { int acc = 0; for (int e = 0; e < NE; ++e) { const int n = (int)__hip_atomic_load(cnt + e, __ATOMIC_RELAXED, __HIP_MEMORY_SCOPE_AGENT); tab[e] = acc; tab[40 + e] = n; acc += (n + 255) >> 8; } tab[NE] = acc; }
    __syncthreads();
}
#ifndef MOE_MAXU_OVERRIDE
#define MOE_MAXU_OVERRIDE 9
#endif
constexpr int MOE_MAXU = MOE_MAXU_OVERRIDE;
constexpr int UT_OFF = RING_BYTES + 1536;
constexpr int UB_OFF = UT_OFF + MOE_MAXU * 512;
static_assert(UB_OFF + MOE_MAXU * 1024 <= LDS_BYTES, "LDS map");
template <int KIND>
struct MoeSched {
    static constexpr int NPN = KIND == 1 ? 8 : 4;
    unsigned char* ws; const LAS int* tab; LAS unsigned char* lds; int G, c; bool freeze = false;
    __device__ __forceinline__ bool unit(int i, int& e, int& rb, int& pn) const {
        const int x = c & 7, j = c >> 3, NJ = G >> 3;
        int L = i * NJ + j; e = -1; rb = 0; pn = 0;
#pragma unroll
        for (int q = 0; q < NE / 8; ++q) { const int eq = x + 8 * q, uq = (tab[eq + 1] - tab[eq]) * NPN;
            if (e < 0) { if (L < uq) { e = eq; rb = L / NPN; pn = L % NPN; } else L -= uq; } }
        if (e < 0) return false;
        e = __builtin_amdgcn_readfirstlane(e); rb = __builtin_amdgcn_readfirstlane(rb); pn = __builtin_amdgcn_readfirstlane(pn);
        return true;
    }
    __device__ __forceinline__ void init(unsigned char* ws_, LAS unsigned char* lds_, int G_, int c_, const float* bias) {
        ws = ws_; lds = lds_; tab = (const LAS int*)(lds_ + TAB_OFF); G = G_; c = c_;
        const int tid = opaque_tid();
        for (int i = 0; i < MOE_MAXU; ++i) { int e, rb, pn; if (!unit(i, e, rb, pn)) break;
            if (tid < 256) { if (KIND == 1) { const int nvalid = min(256, tab[40 + e] - rb * 256); const int tok = tid < nvalid ? ((const int*)(ws + WS_SLOT_TOK))[(size_t)e * CAP + rb * 256 + tid] : T;
                    ((LAS unsigned short*)(lds + UT_OFF))[i * 256 + tid] = (unsigned short)tok; } }
            else ((LAS float*)(lds + UB_OFF))[i * 256 + tid - 256] = bias[(size_t)e * (NPN * 256) + pn * 256 + tid - 256]; }
        __syncthreads();
    }
    __device__ __forceinline__ bool next(int i, Unit& u) const {
        int e, rb, pn; if (!unit(i, e, rb, pn)) return false;
#if defined(PROBE_FREEZE)
        if (freeze) { int e0, r0, p0; unit(0, e0, r0, p0); e = e0; rb = r0; pn = p0; }
#endif
        const int blk = tab[e] + rb, nvalid = min(256, tab[40 + e] - rb * 256);
        u.pm = rb; u.pn = pn; u.aux = e; u.ord = i; const LaneRC rc;
        if (KIND == 1) {
            u.aux2 = blk; u.A = (const char*)(ws + WS_H2); u.B = (const char*)(ws + WS_W1_T + ((size_t)e * 2 * DFF + (size_t)pn * BM) * D);
#pragma unroll
            for (int h = 0; h < 2; ++h)
#pragma unroll
                for (int jj = 0; jj < 2; ++jj) { const int r = 128 * h + rc.R[jj]; int tok;
                    if (i < MOE_MAXU) tok = ((const LAS unsigned short*)(lds + UT_OFF))[i * 256 + r];
                    else { tok = r < nvalid ? ((const int*)(ws + WS_SLOT_TOK))[(size_t)e * CAP + rb * 256 + r] : T; __builtin_amdgcn_s_waitcnt(0x0F70); }
                    u.aoff[h][jj] = (unsigned)(tok * D + rc.C[jj] * 2); }
        } else {
            u.aux2 = blk | (nvalid << 16); u.A = (const char*)(ws + WS_ACT); u.B = (const char*)(ws + WS_W2_T + ((size_t)e * D + (size_t)pn * BM) * DFF);
#pragma unroll
            for (int h = 0; h < 2; ++h)
#pragma unroll
                for (int jj = 0; jj < 2; ++jj) u.aoff[h][jj] = (unsigned)((blk * 256 + 128 * h + rc.R[jj]) * DFF + rc.C[jj] * 2);
        }
        return true;
    }
};
}
namespace pg {
struct EpiBase { static constexpr bool HAS_MID = false; static constexpr int MID_T = -1; __device__ __forceinline__ void mid(Acc&, const EpiInfo&, int, int, int, int) const {} };
__device__ __forceinline__ u32x4 pack8(const f32x4 a, const f32x4 b) { u32x4 w; w.x = pk2(a[0], a[1]); w.y = pk2(a[2], a[3]); w.z = pk2(b[0], b[1]); w.w = pk2(b[2], b[3]); return w; }
__device__ __forceinline__ void unpack8(const u32x4 w, f32x4& a, f32x4& b) { a = (f32x4){bflo(w.x), bfhi(w.x), bflo(w.y), bfhi(w.y)}; b = (f32x4){bflo(w.z), bfhi(w.z), bflo(w.w), bfhi(w.w)}; }

struct EpiNull : EpiBase {
    __device__ __forceinline__ void operator()(Acc& acc, const EpiInfo&, int, int, int, int) const {
#pragma unroll
        for (int a = 0; a < 2; ++a)
#pragma unroll
            for (int b = 0; b < 2; ++b)
#pragma unroll
                for (int m = 0; m < 4; ++m)
#pragma unroll
                    for (int n = 0; n < 2; ++n) asm volatile("" :: "v"(acc[a][b][m][n]));
    }
};
struct EpiInProj : EpiBase {
    unsigned char* ws; const float* qg; const float* kg;
    __device__ __forceinline__ void operator()(Acc& acc, const EpiInfo& u, int wr, int wc, int fr, int fq) const {
        const int pn = u.pn, row0 = u.pm * BM + wr * 64 + fr, colw = 64 * wc + 8 * fq;
        if (pn < 2) {
            bf16_t* acat = (bf16_t*)(ws + WS_ACAT);
#pragma unroll
            for (int ai = 0; ai < 2; ++ai)
#pragma unroll
                for (int m = 0; m < 4; ++m) { const int tok = row0 + ai * 128 + m * 16;
#pragma unroll
                    for (int bj = 0; bj < 2; ++bj) { const int cu = pn * 256 + colw + 32 * bj, g = cu >> 4, h0 = cu & 15;
                        *(u32x4*)(acat + ((size_t)(g * ACAT_ROWS + (tok >> 5))) * ACAT_LD + (tok & 31) * 16 + h0) = pack8(acc[ai][bj][m][0], acc[ai][bj][m][1]); } }
        } else if (pn < 10) {
            const bool isq = pn < 6; const float* gain = isq ? qg : kg; const float sc = isq ? QC2 : 1.f;
            bf16_t* dst = (bf16_t*)(ws + (isq ? WS_Q : WS_K)) + (size_t)(pn - (isq ? 2 : 6)) * 256 + colw;
            f32x4 gv[2][2];
#pragma unroll
            for (int bj = 0; bj < 2; ++bj)
#pragma unroll
                for (int n = 0; n < 2; ++n) gv[bj][n] = *(const f32x4*)(gain + 32 * bj + 8 * fq + 4 * n);
#pragma unroll
            for (int ai = 0; ai < 2; ++ai)
#pragma unroll
                for (int m = 0; m < 4; ++m) { const int tok = row0 + ai * 128 + m * 16; float ss = 0.f;
#pragma unroll
                    for (int bj = 0; bj < 2; ++bj)
#pragma unroll
                        for (int n = 0; n < 2; ++n) { const f32x4 v = acc[ai][bj][m][n]; ss += (v[0] * v[0] + v[1] * v[1]) + (v[2] * v[2] + v[3] * v[3]); }
                    ss += __shfl_xor(ss, 16); ss += __shfl_xor(ss, 32);
                    const float r = rsqrtf(ss * (1.f / 64.f) + EPS) * sc;
#pragma unroll
                    for (int bj = 0; bj < 2; ++bj) store16(dst + (size_t)tok * D + 32 * bj, pack8(acc[ai][bj][m][0] * r * gv[bj][0], acc[ai][bj][m][1] * r * gv[bj][1])); }
        } else {
            const size_t base = pn < 14 ? WS_V : (pn < 18 ? WS_GS : WS_GA); const int t0 = pn < 14 ? 10 : (pn < 18 ? 14 : 18); const bool ntst = pn >= 14;
            bf16_t* dst = (bf16_t*)(ws + base) + (size_t)(pn - t0) * 256 + colw;
#pragma unroll
            for (int ai = 0; ai < 2; ++ai)
#pragma unroll
                for (int m = 0; m < 4; ++m) { const int tok = row0 + ai * 128 + m * 16;
#pragma unroll
                    for (int bj = 0; bj < 2; ++bj) { const u32x4 w = pack8(acc[ai][bj][m][0], acc[ai][bj][m][1]); if (ntst) NT_STORE(w, (u32x4*)(dst + (size_t)tok * D + 32 * bj)); else store16(dst + (size_t)tok * D + 32 * bj, w); } }
        }
    }
};
struct EpiSsm2 : EpiBase {
    unsigned char* ws;
    __device__ __forceinline__ void operator()(Acc& acc, const EpiInfo& u, int wr, int wc, int fr, int fq) const {
        bf16_t* Z = (bf16_t*)(ws + WS_Z); const int g = u.aux;
#pragma unroll
        for (int ai = 0; ai < 2; ++ai)
#pragma unroll
            for (int m = 0; m < 4; ++m) { const int r = u.pm * BM + ai * 128 + wr * 64 + m * 16 + fr, b = r >> 6, c = r & 63;
#pragma unroll
                for (int bj = 0; bj < 2; ++bj) { const int n_ = u.pn * 256 + 64 * wc + 32 * bj + 8 * fq, t = n_ >> 4, h0 = n_ & 15; const int tok = b * SEQ + c * CH_L + t;
                    f32x4 a = acc[ai][bj][m][0], bb = acc[ai][bj][m][1];
#pragma unroll
                    for (int q = 0; q < 4; ++q) { a[q] = gelu_tanh(a[q]); bb[q] = gelu_tanh(bb[q]); }
                    *(u32x4*)(Z + (size_t)tok * SSM_W + 16 * g + h0) = pack8(a, bb); } }
    }
};
struct EpiGlu : EpiBase {
    unsigned char* ws; const float* bglu;
    __device__ __forceinline__ void operator()(Acc& acc, const EpiInfo& u, int wr, int wc, int fr, int fq) const {
        asm volatile("" : "+v"(fr), "+v"(fq));
        const bf16_t* Z = (const bf16_t*)(ws + WS_Z); bf16_t* MA = (bf16_t*)(ws + WS_MA);
        const int col0 = u.pn * 256 + 64 * wc + 8 * fq;
        f32x4 cb[2][2];
#pragma unroll
        for (int bj = 0; bj < 2; ++bj) { cb[bj][0] = *(const f32x4*)(bglu + col0 + 32 * bj); cb[bj][1] = *(const f32x4*)(bglu + col0 + 32 * bj + 4); }
#pragma unroll
        for (int ai = 0; ai < 2; ++ai) { u32x4 zz[4][2];
#pragma unroll
            for (int m = 0; m < 4; ++m) { const int tok = u.pm * BM + ai * 128 + wr * 64 + m * 16 + fr;
#pragma unroll
                for (int bj = 0; bj < 2; ++bj) zz[m][bj] = *(const u32x4*)(Z + (size_t)tok * SSM_W + col0 + 32 * bj); }
            asm volatile("" ::: "memory");
#pragma unroll
            for (int m = 0; m < 4; ++m) { const int tok = u.pm * BM + ai * 128 + wr * 64 + m * 16 + fr;
#pragma unroll
                for (int bj = 0; bj < 2; ++bj) { f32x4 z0, z1; unpack8(zz[m][bj], z0, z1);
                    f32x4 a = acc[ai][bj][m][0] + cb[bj][0], bb = acc[ai][bj][m][1] + cb[bj][1];
#pragma unroll
                    for (int q = 0; q < 4; ++q) { a[q] = z0[q] * sigmoid_f(a[q]); bb[q] = z1[q] * sigmoid_f(bb[q]); }
                    *(u32x4*)(MA + (size_t)tok * MA_LD + 1024 + col0 + 32 * bj) = pack8(a, bb); } }
            asm volatile("" ::: "memory"); }
    }
};
struct EpiMerged : EpiBase {
    static constexpr bool HAS_MID = true; static constexpr int MID_T = 16;
    unsigned char* ws;
    __device__ __forceinline__ float ratio(float a, float s) const { a = fminf(fmaxf(a, -30.f), 30.f); s = fminf(fmaxf(s, -30.f), 30.f); return (1.f + __expf(-s)) * __builtin_amdgcn_rcpf(1.f + __expf(-a)); }
    __device__ __forceinline__ void mid(Acc& acc, const EpiInfo& u, int wr, int wc, int fr, int fq) const {
        asm volatile("" : "+v"(fr), "+v"(fq));
        const bf16_t* GS = (const bf16_t*)(ws + WS_GS); const bf16_t* GA = (const bf16_t*)(ws + WS_GA);
        const int col0 = u.pn * 256 + 64 * wc + 8 * fq;
#pragma unroll
        for (int ai = 0; ai < 2; ++ai)
#pragma unroll
            for (int mp = 0; mp < 2; ++mp) { u32x4 gs_[2][2], ga_[2][2];
#pragma unroll
                for (int mm = 0; mm < 2; ++mm) { const int tok = u.pm * BM + ai * 128 + wr * 64 + (2 * mp + mm) * 16 + fr;
#pragma unroll
                    for (int bj = 0; bj < 2; ++bj) { gs_[mm][bj] = *(const u32x4*)(GS + (size_t)tok * D + col0 + 32 * bj); ga_[mm][bj] = *(const u32x4*)(GA + (size_t)tok * D + col0 + 32 * bj); } }
#pragma unroll
                for (int mm = 0; mm < 2; ++mm)
#pragma unroll
                    for (int bj = 0; bj < 2; ++bj) { const int m = 2 * mp + mm; const u32x4 ws_ = gs_[mm][bj], wa_ = ga_[mm][bj];
                        acc[ai][bj][m][0][0] *= ratio(bflo(wa_.x), bflo(ws_.x)); acc[ai][bj][m][0][1] *= ratio(bfhi(wa_.x), bfhi(ws_.x));
                        acc[ai][bj][m][0][2] *= ratio(bflo(wa_.y), bflo(ws_.y)); acc[ai][bj][m][0][3] *= ratio(bfhi(wa_.y), bfhi(ws_.y));
                        acc[ai][bj][m][1][0] *= ratio(bflo(wa_.z), bflo(ws_.z)); acc[ai][bj][m][1][1] *= ratio(bfhi(wa_.z), bfhi(ws_.z));
                        acc[ai][bj][m][1][2] *= ratio(bflo(wa_.w), bflo(ws_.w)); acc[ai][bj][m][1][3] *= ratio(bfhi(wa_.w), bfhi(ws_.w)); }
                asm volatile("" ::: "memory"); }
    }
    __device__ __forceinline__ void operator()(Acc& acc, const EpiInfo& u, int wr, int wc, int fr, int fq) const {
        asm volatile("" : "+v"(fr), "+v"(fq));
        const bf16_t* GS = (const bf16_t*)(ws + WS_GS); bf16_t* O = (bf16_t*)(ws + WS_MERGED);
        const int col0 = u.pn * 256 + 64 * wc + 8 * fq;
#pragma unroll
        for (int ai = 0; ai < 2; ++ai) { u32x4 gs_[4][2];
#pragma unroll
            for (int m = 0; m < 4; ++m) { const int tok = u.pm * BM + ai * 128 + wr * 64 + m * 16 + fr;
#pragma unroll
                for (int bj = 0; bj < 2; ++bj) gs_[m][bj] = *(const u32x4*)(GS + (size_t)tok * D + col0 + 32 * bj); }
#pragma unroll
            for (int m = 0; m < 4; ++m) { const int tok = u.pm * BM + ai * 128 + wr * 64 + m * 16 + fr;
#pragma unroll
                for (int bj = 0; bj < 2; ++bj) { f32x4 s0, s1; unpack8(gs_[m][bj], s0, s1);
                    f32x4 a = acc[ai][bj][m][0], bb = acc[ai][bj][m][1];
#pragma unroll
                    for (int q = 0; q < 4; ++q) { a[q] *= sigmoid_c(s0[q]); bb[q] *= sigmoid_c(s1[q]); }
                    *(u32x4*)(O + (size_t)tok * D + col0 + 32 * bj) = pack8(a, bb); } }
            asm volatile("" ::: "memory"); }
    }
};
struct EpiWout : EpiBase {
    const float* x; float* out;
    __device__ __forceinline__ void operator()(Acc& acc, const EpiInfo& u, int wr, int wc, int fr, int fq) const {
        asm volatile("" : "+v"(fr), "+v"(fq));
        const int col0 = u.pn * 256 + 64 * wc + 8 * fq;
#pragma unroll
        for (int ai = 0; ai < 2; ++ai)
#pragma unroll
            for (int mp = 0; mp < 2; ++mp) { f32x4 xv[2][2][2];
#pragma unroll
                for (int mm = 0; mm < 2; ++mm) { const int tok = u.pm * BM + ai * 128 + wr * 64 + (2 * mp + mm) * 16 + fr;
#pragma unroll
                    for (int bj = 0; bj < 2; ++bj) { const size_t o = (size_t)tok * D + col0 + 32 * bj; xv[mm][bj][0] = NT_LOAD((const f32x4*)(x + o)); xv[mm][bj][1] = NT_LOAD((const f32x4*)(x + o + 4)); } }
                asm volatile("" ::: "memory");
#pragma unroll
                for (int mm = 0; mm < 2; ++mm) { const int m = 2 * mp + mm, tok = u.pm * BM + ai * 128 + wr * 64 + m * 16 + fr;
#pragma unroll
                    for (int bj = 0; bj < 2; ++bj) { const size_t o = (size_t)tok * D + col0 + 32 * bj;
                        *(f32x4*)(out + o) = xv[mm][bj][0] + acc[ai][bj][m][0]; *(f32x4*)(out + o + 4) = xv[mm][bj][1] + acc[ai][bj][m][1]; } }
                asm volatile("" ::: "memory"); }
    }
};
struct EpiMoe1 : EpiBase {
    unsigned char* ws; const float* b1; LAS unsigned char* lds; bool nostore = false;
    __device__ __forceinline__ void operator()(Acc& acc, const EpiInfo& u, int wr, int wc, int fr, int fq) const {
        asm volatile("" : "+v"(fr), "+v"(fq));
        unsigned char* ACT = ws + WS_ACT; const int e = u.aux, blk = u.aux2;
        f32x4 cb[2][2];
#pragma unroll
        for (int bj = 0; bj < 2; ++bj) { const int cl = 64 * wc + 32 * bj + 8 * fq; f32x4 r0, r1;
            if (u.ord < MOE_MAXU) { const LAS float* bl = (const LAS float*)(lds + UB_OFF) + u.ord * 256 + cl; r0 = *(const LAS f32x4*)bl; r1 = *(const LAS f32x4*)(bl + 4); }
            else { const float* bg = b1 + (size_t)e * 2 * DFF + u.pn * 256 + cl; r0 = *(const f32x4*)bg; r1 = *(const f32x4*)(bg + 4); __builtin_amdgcn_s_waitcnt(0x0F70); }
            cb[bj][0] = __builtin_shufflevector(r0, r0, 0, 2, 1, 3); cb[bj][1] = __builtin_shufflevector(r1, r1, 0, 2, 1, 3); }
        const f32x2 c7 = {7.f, 7.f}, one = {1.f, 1.f}, cexp = {-1.702f * 1.4426950408889634f, -1.702f * 1.4426950408889634f};
#pragma unroll
        for (int ai = 0; ai < 2; ++ai)
#pragma unroll
            for (int m = 0; m < 4; ++m) { const int row = ai * 128 + wr * 64 + m * 16 + fr; unsigned w[2];
#pragma unroll
                for (int bj = 0; bj < 2; ++bj) { f32x2 r[2];
#pragma unroll
                    for (int n = 0; n < 2; ++n) { const f32x4 h = acc[ai][bj][m][n] + cb[bj][n];
                        f32x2 g = {fminf(h[0], 7.f), fminf(h[1], 7.f)}; const f32x2 up = {fminf(fmaxf(h[2], -7.f), 7.f), fminf(fmaxf(h[3], -7.f), 7.f)};
                        const f32x2 x = g * cexp; f32x2 ex = {__builtin_amdgcn_exp2f(x[0]), __builtin_amdgcn_exp2f(x[1])};
                        ex = ex + one; const f32x2 s = {__builtin_amdgcn_rcpf(ex[0]), __builtin_amdgcn_rcpf(ex[1])};
                        r[n] = (up * g + g) * s; }
                    w[bj] = pk4_fp8(r[0][0], r[0][1], r[1][0], r[1][1]); }
                unsigned char* rowp = ACT + ((size_t)blk * 256 + row) * DFF + ((u.pn * 256 + 64 * wc + 8 * fq) >> 1);
#if defined(PROBE_NOSTORE)
                if (nostore) { asm volatile("" :: "v"(w[0]), "v"(w[1])); } else
#endif
                { *(unsigned*)rowp = w[0]; *(unsigned*)(rowp + 16) = w[1]; } }
        (void)c7;
    }
};
struct EpiMoe2 : EpiBase {
    unsigned char* ws; const float* b2; LAS unsigned char* lds; bool nostore = false;
    __device__ __forceinline__ void operator()(Acc& acc, const EpiInfo& u, int wr, int wc, int fr, int fq) const {
        asm volatile("" : "+v"(fr), "+v"(fq));
        bf16_t* Y = (bf16_t*)(ws + WS_Y); const int e = u.aux, blk = u.aux2 & 0xffff;
        f32x4 cb[2][2];
#pragma unroll
        for (int bj = 0; bj < 2; ++bj) { const int cl = 64 * wc + 32 * bj + 8 * fq;
            if (u.ord < MOE_MAXU) { const LAS float* bl = (const LAS float*)(lds + UB_OFF) + u.ord * 256 + cl; cb[bj][0] = *(const LAS f32x4*)bl; cb[bj][1] = *(const LAS f32x4*)(bl + 4); }
            else { const float* bg = b2 + (size_t)e * D + u.pn * 256 + cl; cb[bj][0] = *(const f32x4*)bg; cb[bj][1] = *(const f32x4*)(bg + 4); __builtin_amdgcn_s_waitcnt(0x0F70); } }
#pragma unroll
        for (int ai = 0; ai < 2; ++ai)
#pragma unroll
            for (int m = 0; m < 4; ++m) { const int row = ai * 128 + wr * 64 + m * 16 + fr;
#pragma unroll
                for (int bj = 0; bj < 2; ++bj) { const int col = u.pn * 256 + 64 * wc + 32 * bj + 8 * fq;
                    const u32x4 w = pack8(acc[ai][bj][m][0] + cb[bj][0], acc[ai][bj][m][1] + cb[bj][1]);
#if defined(PROBE_NOSTORE)
                    if (nostore) { asm volatile("" :: "v"(w)); } else
#endif
                    store16(Y + ((size_t)blk * 256 + row) * D + col, w); } }
    }
};
}
namespace attn_body {
using bf16=__hip_bfloat16;
using bf16x8=__attribute__((ext_vector_type(8)))short;
using s16x4=__attribute__((ext_vector_type(4)))short;
using f32x16=__attribute__((ext_vector_type(16)))float;
using u32x4=__attribute__((ext_vector_type(4)))unsigned;
constexpr int SEQ=2048,D=64,DM=1024;
constexpr int NW=8,QBLK=32,QB=QBLK*NW,KVBLK=64,NQB=SEQ/QB;
constexpr int ATTN_PITCH=DM, ATTN_UNIT_ROWS=QB;
__device__ __forceinline__ int crow(int r,int hi){return (r&3)+8*(r>>2)+4*hi;}
#define SBAR() __builtin_amdgcn_sched_barrier(0)
__device__ __forceinline__ void cmask(f32x16&p0,f32x16&p1,int jb,int qrel,int hi){
  const float NEG=-INFINITY; int kb=64*jb+4*hi;
  #pragma unroll
  for(int r=0;r<16;++r){int kv=kb+(r&3)+8*(r>>2); if(kv>qrel)p0[r]=NEG; if(kv+32>qrel)p1[r]=NEG;}
}

constexpr int NSLOT=3, SLOTB=8192;
constexpr int LDS_K=0, LDS_V=NSLOT*SLOTB, LDS_WS=2*NSLOT*SLOTB, LDS_OST=LDS_WS+NW*64*4, ALDS_BYTES=LDS_OST+NW*4096;
constexpr float C2=0.125f*1.4426950408889634f;
__device__ __forceinline__ void glds16(const void*gsrc,unsigned lds_dst){unsigned keep;
  asm volatile("s_mov_b32 %0, m0\n\ts_mov_b32 m0, %2\n\ts_nop 0\n\tglobal_load_lds_dwordx4 %1, off\n\ts_mov_b32 m0, %0":"=&s"(keep):"v"(gsrc),"s"(lds_dst):"memory");}
__device__ __forceinline__ float max3f(float a,float b,float c){float r;asm("v_max3_f32 %0, %1, %2, %3":"=v"(r):"v"(a),"v"(b),"v"(c));return r;}
__device__ __forceinline__ float max2f(float a,float b){float r;asm("v_max_f32_e32 %0, %1, %2":"=v"(r):"v"(a),"v"(b));return r;}
__device__ __forceinline__ float fadd_s(float a,float b){float r;asm("v_add_f32_e32 %0, %1, %2":"=v"(r):"v"(a),"v"(b));return r;}
__device__ __forceinline__ float fsub_s(float a,float b){float r;asm("v_sub_f32_e32 %0, %1, %2":"=v"(r):"v"(a),"v"(b));return r;}
typedef float f32x2_t __attribute__((ext_vector_type(2))); typedef __bf16 bf16x2_t __attribute__((ext_vector_type(2)));
__device__ __forceinline__ unsigned cvtpk_s(float lo,float hi){f32x2_t v={lo,hi};bf16x2_t b=__builtin_convertvector(v,bf16x2_t);return __builtin_bit_cast(unsigned,b);}
#define WAIT_BAR(N) asm volatile("s_waitcnt vmcnt(" #N ") lgkmcnt(0)\n\ts_barrier":::"memory")

__device__ __forceinline__ void qkt(f32x16&p0,f32x16&p1,const char*Kslot,const bf16x8*qr,const f32x16&negm,int r32,int hi){
  const char*kb=Kslot+hi*1024+r32*16;
  #pragma unroll
  for(int d0=0;d0<4;++d0){
    const bf16x8 b0=*reinterpret_cast<const bf16x8*>(kb+d0*2048);
    const bf16x8 b1=*reinterpret_cast<const bf16x8*>(kb+d0*2048+512);
    if(d0==0){p0=__builtin_amdgcn_mfma_f32_32x32x16_bf16(b0,qr[0],negm,0,0,0);p1=__builtin_amdgcn_mfma_f32_32x32x16_bf16(b1,qr[0],negm,0,0,0);}
    else{p0=__builtin_amdgcn_mfma_f32_32x32x16_bf16(b0,qr[d0],p0,0,0,0);p1=__builtin_amdgcn_mfma_f32_32x32x16_bf16(b1,qr[d0],p1,0,0,0);}}
}
typedef __attribute__((address_space(3))) const char* lds_cptr;
typedef short v4i16_t __attribute__((ext_vector_type(4)));
__device__ __forceinline__ void kload8(bf16x8*kf,lds_cptr kp){
  kf[0]=*(const __attribute__((address_space(3))) bf16x8*)(kp);      kf[1]=*(const __attribute__((address_space(3))) bf16x8*)(kp+512);
  kf[2]=*(const __attribute__((address_space(3))) bf16x8*)(kp+2048); kf[3]=*(const __attribute__((address_space(3))) bf16x8*)(kp+2560);
  kf[4]=*(const __attribute__((address_space(3))) bf16x8*)(kp+4096); kf[5]=*(const __attribute__((address_space(3))) bf16x8*)(kp+4608);
  kf[6]=*(const __attribute__((address_space(3))) bf16x8*)(kp+6144); kf[7]=*(const __attribute__((address_space(3))) bf16x8*)(kp+6656);
}
__device__ __forceinline__ void kload2(bf16x8*kf,lds_cptr kp,int j){ kf[2*j]=*(const __attribute__((address_space(3))) bf16x8*)(kp+j*2048); kf[2*j+1]=*(const __attribute__((address_space(3))) bf16x8*)(kp+j*2048+512); }
__device__ __forceinline__ s16x4 vtr(lds_cptr p){ return __builtin_bit_cast(s16x4,__builtin_amdgcn_ds_read_tr16_b64_v4i16((__attribute__((address_space(3))) v4i16_t*)p)); }
__device__ __forceinline__ float rowmax(const f32x16&p0,const f32x16&p1){
  float a=max3f(p0[0],p0[1],p1[0]),b=max3f(p0[2],p0[3],p1[1]);a=max3f(a,p1[2],p1[3]);
  #pragma unroll
  for(int r=4;r<16;r+=4){a=max3f(a,p0[r],p0[r+1]);b=max3f(b,p0[r+2],p0[r+3]);a=max3f(a,p1[r],p1[r+1]);b=max3f(b,p1[r+2],p1[r+3]);}
  const float m=max2f(a,b);
  auto rr=__builtin_amdgcn_permlane32_swap(__float_as_uint(m),__float_as_uint(m),false,false);
  return max2f(__uint_as_float(rr[0]),__uint_as_float(rr[1]));
}
__device__ __forceinline__ void pv(f32x16*o,int vb,bf16x8 pa0,bf16x8 pa1,bf16x8 pa2,bf16x8 pa3){
  #pragma unroll
  for(int d0=0;d0<2;++d0){s16x4 lo[4],hi[4];
    #pragma unroll
    for(int ks=0;ks<4;++ks){
      asm volatile("ds_read_b64_tr_b16 %0,%1 offset:%c2":"=&v"(lo[ks]):"v"(vb),"i"(d0*4096+ks*1024):"memory");
      asm volatile("ds_read_b64_tr_b16 %0,%1 offset:%c2":"=&v"(hi[ks]):"v"(vb),"i"(d0*4096+ks*1024+512):"memory");}
    asm volatile("s_waitcnt lgkmcnt(0)":::"memory");SBAR();
    #define PK(k) (bf16x8){lo[k][0],lo[k][1],lo[k][2],lo[k][3],hi[k][0],hi[k][1],hi[k][2],hi[k][3]}
    o[d0]=__builtin_amdgcn_mfma_f32_32x32x16_bf16(pa0,PK(0),o[d0],0,0,0);
    o[d0]=__builtin_amdgcn_mfma_f32_32x32x16_bf16(pa1,PK(1),o[d0],0,0,0);
    o[d0]=__builtin_amdgcn_mfma_f32_32x32x16_bf16(pa2,PK(2),o[d0],0,0,0);
    o[d0]=__builtin_amdgcn_mfma_f32_32x32x16_bf16(pa3,PK(3),o[d0],0,0,0);
    #undef PK
  }
}

#ifndef ATTN_STORE16
#define ATTN_STORE16(p,v) (*(u32x4*)(p)=(v))
#endif
template<int THRL> __device__ __forceinline__ void attn_unit(int b,int qcol,int kcol,int vcol,int ocol,int qb,const bf16*Q,const bf16*__restrict__ K,const bf16*__restrict__ V,bf16*O,char*shm){
  int tid_=threadIdx.x; asm volatile("":"+v"(tid_));
  const int tid=tid_,lane=tid&63,r32=lane&31,hi=lane>>5; const int wid=__builtin_amdgcn_readfirstlane(tid>>6);
  const long rowbase=(long)b*SEQ; const int q0=qb*QB;
  const bf16*Qw=Q+(rowbase+q0+wid*QBLK)*DM+qcol;
  const bf16*Kh=K+rowbase*DM+kcol,*Vh=V+rowbase*DM+vcol;
  const unsigned lds0=(unsigned)(uintptr_t)shm;
  float*wsf=(float*)(shm+LDS_WS)+wid*64;
  const bf16*ksrc=Kh+(long)lane*DM+wid*8;
  const bf16*vsrc=Vh+(long)(16*(wid&3)+(lane>>2))*DM+(wid>>2)*32+(lane&3)*8;
  const unsigned kdst=lds0+LDS_K+wid*1024, vdst=lds0+LDS_V+wid*1024;
  #define DMA_K(t,slot) glds16(ksrc+(long)(t)*KVBLK*DM,(unsigned)__builtin_amdgcn_readfirstlane(kdst+(slot)))
  #define DMA_V(t,slot) glds16(vsrc+(long)(t)*KVBLK*DM,(unsigned)__builtin_amdgcn_readfirstlane(vdst+(slot)))
  const int vb0=(int)(lds0+LDS_V)+((lane>>4)&1)*32+(lane&3)*8+(4*hi+((lane&15)>>2))*64;
  const char*Kbase=shm+LDS_K; bf16x8 kf[8];
  const lds_cptr shm3=(lds_cptr)shm; const lds_cptr kp0=shm3+LDS_K+hi*1024+r32*16; const lds_cptr vp0=shm3+LDS_V+((lane>>4)&1)*32+(lane&3)*8+(4*hi+((lane&15)>>2))*64;
  const int NT=(q0+QB)/KVBLK;
  DMA_K(0,0);DMA_V(0,0);DMA_K(1,SLOTB);
  bf16x8 qr[4];
  #pragma unroll
  for(int d0=0;d0<4;++d0)qr[d0]=*reinterpret_cast<const bf16x8*>(&Qw[(long)r32*DM+d0*16+hi*8]);
  float l_reg=0.f;f32x16 o[2];o[0]=f32x16{};o[1]=f32x16{};const f32x16 negm=f32x16{};
  const int qrel=wid*QBLK+r32;
  #define CMASK(P0,P1,t) do{int jb_=(t)-(NT-4); if(jb_>=0)cmask(P0,P1,jb_,qrel,hi);}while(0)
  #define START(P0,P1) do{ _Pragma("unroll") for(int r=0;r<16;++r)P0[r]=__builtin_amdgcn_exp2f(P0[r]); }while(0)
  #define RESC() do{}while(0)
  f32x16 pA0,pA1,pB0,pB1;
  int sl_prev=0,sl_cur=0,sl_next=SLOTB;
  #define ROT() do{sl_prev=sl_cur;sl_cur=sl_next;sl_next=(sl_next==(NSLOT-1)*SLOTB)?0:sl_next+SLOTB;}while(0)
  DMA_K(2,2*SLOTB);
  WAIT_BAR(3);
  qkt(pA0,pA1,Kbase,qr,negm,r32,hi);asm volatile("s_nop 15\n\ts_nop 7":"+v"(pA0),"+v"(pA1));CMASK(pA0,pA1,0);
  START(pA0,pA1);
  _Pragma("unroll") for(int r=0;r<16;++r)pA1[r]=__builtin_amdgcn_exp2f(pA1[r]);
  WAIT_BAR(0);
  DMA_K(3,0);DMA_V(1,SLOTB);
  ROT();
  kload8(kf,kp0+sl_cur);
  WAIT_BAR(2);
  s16x4 vlo[8],vhi[8]; u32x4 pw0,pw1,pw2,pw3;
  #define PKW(P,B) cvtpk_s(P[B],P[B+1])
  #define PAF(k) __builtin_bit_cast(bf16x8,pw##k)
  #define VFR(i) (bf16x8){vlo[i][0],vlo[i][1],vlo[i][2],vlo[i][3],vhi[i][0],vhi[i][1],vhi[i][2],vhi[i][3]}
  #define PIN(x) asm volatile("":"+v"(x))
  #define MX3(a,b,c) __builtin_fmaxf(__builtin_fmaxf((a),(b)),(c))
  #define GAPA(MF,A0,A1,A2,A3,W0,W1,PW) do{ MF; sacc+=A0; sacc+=A1; sacc+=A2; sacc+=A3; PIN(sacc); W0; W1; PIN(PW); SBAR(); }while(0)
  #define EX(v) __builtin_amdgcn_exp2f(v)
  #define GAPB(MF,X,B) do{ MF; X[B]=EX(X[B]); X[B+1]=EX(X[B+1]); X[B+2]=EX(X[B+2]); X[B+3]=EX(X[B+3]); PIN(X); SBAR(); }while(0)
  #define VRD(i) do{ vlo[i]=vtr(vp_+(((i)>>2)*4096+((i)&3)*1024)); vhi[i]=vtr(vp_+(((i)>>2)*4096+((i)&3)*1024+512)); }while(0)
  #define KRD(G,j) do{ if(G){ kload2(kf,kp0+sl_next,j); SBAR(); } }while(0)
  #define STEP(C0,C1,P0,P1,t,GK,GV,GL) do{ SBAR(); \
    const lds_cptr vp_=vp0+sl_prev; \
    VRD(0); SBAR(); float sacc=(P0[0]+P0[1]); \
    GAPA(C0=__builtin_amdgcn_mfma_f32_32x32x16_bf16(kf[0],qr[0],negm,0,0,0), P0[2],P0[3],P0[4],P0[5],     pw0[0]=PKW(P0,0), pw0[1]=PKW(P0,2), pw0); \
    VRD(4); SBAR(); GAPA(C1=__builtin_amdgcn_mfma_f32_32x32x16_bf16(kf[1],qr[0],negm,0,0,0), P0[6],P0[7],P0[8],P0[9],     pw0[2]=PKW(P0,4), pw0[3]=PKW(P0,6), pw0); \
    VRD(1); SBAR(); GAPA(C0=__builtin_amdgcn_mfma_f32_32x32x16_bf16(kf[2],qr[1],C0,0,0,0),   P0[10],P0[11],P0[12],P0[13], pw1[0]=PKW(P0,8), pw1[1]=PKW(P0,10), pw1); \
    VRD(5); SBAR(); GAPA(C1=__builtin_amdgcn_mfma_f32_32x32x16_bf16(kf[3],qr[1],C1,0,0,0),   P0[14],P0[15],P1[0],P1[1],   pw1[2]=PKW(P0,12),pw1[3]=PKW(P0,14), pw1); \
    VRD(2); SBAR(); GAPA(C0=__builtin_amdgcn_mfma_f32_32x32x16_bf16(kf[4],qr[2],C0,0,0,0),   P1[2],P1[3],P1[4],P1[5],     pw2[0]=PKW(P1,0), pw2[1]=PKW(P1,2), pw2); \
    VRD(6); SBAR(); GAPA(C1=__builtin_amdgcn_mfma_f32_32x32x16_bf16(kf[5],qr[2],C1,0,0,0),   P1[6],P1[7],P1[8],P1[9],     pw2[2]=PKW(P1,4), pw2[3]=PKW(P1,6), pw2); \
    VRD(3); SBAR(); GAPA(C0=__builtin_amdgcn_mfma_f32_32x32x16_bf16(kf[6],qr[3],C0,0,0,0),   P1[10],P1[11],P1[12],P1[13], pw3[0]=PKW(P1,8), pw3[1]=PKW(P1,10), pw3); \
    VRD(7); SBAR(); GAPA(C1=__builtin_amdgcn_mfma_f32_32x32x16_bf16(kf[7],qr[3],C1,0,0,0),   P1[14],P1[15],0.f,0.f,       pw3[2]=PKW(P1,12),pw3[3]=PKW(P1,14), pw3); \
    l_reg+=sacc; \
    if(GK){DMA_K((t)+3,sl_cur);} if(GV){DMA_V((t)+1,sl_next);} \
    CMASK(C0,C1,t); \
    SBAR(); \
    GAPB(o[0]=__builtin_amdgcn_mfma_f32_32x32x16_bf16(PAF(0),VFR(0),o[0],0,0,0), C0,0); \
    GAPB(o[1]=__builtin_amdgcn_mfma_f32_32x32x16_bf16(PAF(0),VFR(4),o[1],0,0,0), C0,4); \
    KRD(GL,0); GAPB(o[0]=__builtin_amdgcn_mfma_f32_32x32x16_bf16(PAF(1),VFR(1),o[0],0,0,0), C0,8); \
    KRD(GL,1); GAPB(o[1]=__builtin_amdgcn_mfma_f32_32x32x16_bf16(PAF(1),VFR(5),o[1],0,0,0), C0,12); \
    KRD(GL,2); GAPB(o[0]=__builtin_amdgcn_mfma_f32_32x32x16_bf16(PAF(2),VFR(2),o[0],0,0,0), C1,0); \
    KRD(GL,3); GAPB(o[1]=__builtin_amdgcn_mfma_f32_32x32x16_bf16(PAF(2),VFR(6),o[1],0,0,0), C1,4); \
    GAPB(o[0]=__builtin_amdgcn_mfma_f32_32x32x16_bf16(PAF(3),VFR(3),o[0],0,0,0), C1,8); \
    GAPB(o[1]=__builtin_amdgcn_mfma_f32_32x32x16_bf16(PAF(3),VFR(7),o[1],0,0,0), C1,12); \
    }while(0)
  int t=1;
  #undef CMASK
  #define CMASK(P0,P1,t) do{}while(0)
  for(;t+5<NT;t+=2){
    STEP(pB0,pB1,pA0,pA1,t,true,true,true);     WAIT_BAR(2); RESC(); ROT();
    STEP(pA0,pA1,pB0,pB1,t+1,true,true,true);   WAIT_BAR(2); RESC(); ROT();
  }
  #undef CMASK
  #define CMASK(P0,P1,t) do{int jb_=(t)-(NT-4); if(jb_>=0)cmask(P0,P1,jb_,qrel,hi);}while(0)
  #define ENDW(tt) do{ if((tt)+3<NT){WAIT_BAR(2);} else if((tt)+2<NT){WAIT_BAR(1);} else {WAIT_BAR(0);} }while(0)
  for(;t+1<NT;t+=2){
    STEP(pB0,pB1,pA0,pA1,t,(t+3<NT),(t+1<NT),(t+1<NT));       ENDW(t);   RESC(); ROT();
    STEP(pA0,pA1,pB0,pB1,t+1,(t+4<NT),(t+2<NT),(t+2<NT));     ENDW(t+1); RESC(); ROT();
  }
  STEP(pB0,pB1,pA0,pA1,NT-1,false,false,false); RESC();
  { float sacc=pB0[0]+pB0[1]; _Pragma("unroll") for(int r=2;r<16;++r)sacc+=pB0[r]; _Pragma("unroll") for(int r=0;r<16;++r)sacc+=pB1[r]; l_reg+=sacc;
    pw0=(u32x4){PKW(pB0,0),PKW(pB0,2),PKW(pB0,4),PKW(pB0,6)};pw1=(u32x4){PKW(pB0,8),PKW(pB0,10),PKW(pB0,12),PKW(pB0,14)};pw2=(u32x4){PKW(pB1,0),PKW(pB1,2),PKW(pB1,4),PKW(pB1,6)};pw3=(u32x4){PKW(pB1,8),PKW(pB1,10),PKW(pB1,12),PKW(pB1,14)};
    SBAR(); pv(o,vb0+sl_cur,PAF(0),PAF(1),PAF(2),PAF(3)); }
  #undef PKW
  #undef PAF
  #undef VFR
  #undef PIN
  #undef MX3
  #undef GAPA
  #undef GAPB
  #undef EX
  #undef VRD
  #undef KRD
  #undef STEP
  #undef ENDW
  {auto rr=__builtin_amdgcn_permlane32_swap(__float_as_uint(l_reg),__float_as_uint(l_reg),false,false);l_reg=__uint_as_float(rr[0])+__uint_as_float(rr[1]);}
  if(hi==0)wsf[32+r32]=l_reg;asm volatile("s_waitcnt lgkmcnt(0)":::"memory");
  float rli[16];
  #pragma unroll
  for(int r=0;r<16;++r)rli[r]=__builtin_amdgcn_rcpf(wsf[32+crow(r,hi)]);
  bf16*Ow=O+(rowbase+q0+wid*QBLK)*DM+ocol;
  { bf16*stg=(bf16*)(shm+LDS_OST)+wid*2048;
    #pragma unroll
    for(int r=0;r<16;++r){const int orow=crow(r,hi);
      #pragma unroll
      for(int d0=0;d0<2;++d0)stg[orow*64+d0*32+r32]=__float2bfloat16(o[d0][r]*rli[r]);}
    asm volatile("s_waitcnt lgkmcnt(0)":::"memory");
    #pragma unroll
    for(int i=0;i<4;++i){const int row=i*8+(lane>>3),ch=lane&7; const u32x4 v=*(const u32x4*)(stg+row*64+ch*8); ATTN_STORE16(Ow+(long)row*DM+ch*8,v);} }
  asm volatile("s_waitcnt lgkmcnt(0)\n\ts_barrier":::"memory");
  #undef DMA_K
  #undef DMA_V
  #undef CMASK
  #undef START
  #undef RESC
  #undef ROT
}
constexpr int ATTN_LDS_BYTES=ALDS_BYTES;

#undef SBAR
#undef WAIT_BAR
#undef ATTN_STORE16
}
namespace attn128 {
using bf16=__hip_bfloat16;
using bf16x8=__attribute__((ext_vector_type(8)))short;
using s16x4=__attribute__((ext_vector_type(4)))short;
using f32x16=__attribute__((ext_vector_type(16)))float;
using u32x4=__attribute__((ext_vector_type(4)))unsigned;
constexpr int SEQ=2048,D=64,DM=1024;
constexpr int NW=8,QBLK=32,QB=QBLK*NW,KVBLK=64,NQB=SEQ/QB;
constexpr int ATTN_PITCH=DM, ATTN_UNIT_ROWS=QB;
__device__ __forceinline__ int crow(int r,int hi){return (r&3)+8*(r>>2)+4*hi;}
#define SBAR() __builtin_amdgcn_sched_barrier(0)
__device__ __forceinline__ void cmask(f32x16&p0,f32x16&p1,int jb,int qrel,int hi){
  const float NEG=-INFINITY; int kb=64*jb+4*hi;
  #pragma unroll
  for(int r=0;r<16;++r){int kv=kb+(r&3)+8*(r>>2); if(kv>qrel)p0[r]=NEG; if(kv+32>qrel)p1[r]=NEG;}
}

constexpr int NSLOT=3, SLOTB=8192;
constexpr int VSLOTB=2*SLOTB;
constexpr int LDS_K=0, LDS_V=NSLOT*SLOTB, LDS_WS=LDS_V+NSLOT*VSLOTB, LDS_OST=LDS_WS+NW*64*4, ALDS_BYTES=LDS_OST+NW*4096;
constexpr float C2=0.125f*1.4426950408889634f;
__device__ __forceinline__ void glds16(const void*gsrc,unsigned lds_dst){unsigned keep;
  asm volatile("s_mov_b32 %0, m0\n\ts_mov_b32 m0, %2\n\ts_nop 0\n\tglobal_load_lds_dwordx4 %1, off\n\ts_mov_b32 m0, %0":"=&s"(keep):"v"(gsrc),"s"(lds_dst):"memory");}
__device__ __forceinline__ float max3f(float a,float b,float c){float r;asm("v_max3_f32 %0, %1, %2, %3":"=v"(r):"v"(a),"v"(b),"v"(c));return r;}
__device__ __forceinline__ float max2f(float a,float b){float r;asm("v_max_f32_e32 %0, %1, %2":"=v"(r):"v"(a),"v"(b));return r;}
__device__ __forceinline__ float fadd_s(float a,float b){float r;asm("v_add_f32_e32 %0, %1, %2":"=v"(r):"v"(a),"v"(b));return r;}
__device__ __forceinline__ float fsub_s(float a,float b){float r;asm("v_sub_f32_e32 %0, %1, %2":"=v"(r):"v"(a),"v"(b));return r;}
typedef float f32x2_t __attribute__((ext_vector_type(2))); typedef __bf16 bf16x2_t __attribute__((ext_vector_type(2)));
__device__ __forceinline__ unsigned cvtpk_s(float lo,float hi){f32x2_t v={lo,hi};bf16x2_t b=__builtin_convertvector(v,bf16x2_t);return __builtin_bit_cast(unsigned,b);}
#define WAIT_BAR(N) asm volatile("s_waitcnt vmcnt(" #N ") lgkmcnt(0)\n\ts_barrier":::"memory")

__device__ __forceinline__ void qkt(f32x16&p0,f32x16&p1,const char*Kslot,const bf16x8*qr,const f32x16&negm,int r32,int hi){
  const char*kb=Kslot+hi*1024+r32*16;
  #pragma unroll
  for(int d0=0;d0<4;++d0){
    const bf16x8 b0=*reinterpret_cast<const bf16x8*>(kb+d0*2048);
    const bf16x8 b1=*reinterpret_cast<const bf16x8*>(kb+d0*2048+512);
    if(d0==0){p0=__builtin_amdgcn_mfma_f32_32x32x16_bf16(b0,qr[0],negm,0,0,0);p1=__builtin_amdgcn_mfma_f32_32x32x16_bf16(b1,qr[0],negm,0,0,0);}
    else{p0=__builtin_amdgcn_mfma_f32_32x32x16_bf16(b0,qr[d0],p0,0,0,0);p1=__builtin_amdgcn_mfma_f32_32x32x16_bf16(b1,qr[d0],p1,0,0,0);}}
}
typedef __attribute__((address_space(3))) const char* lds_cptr;
typedef short v4i16_t __attribute__((ext_vector_type(4)));
__device__ __forceinline__ void kload8(bf16x8*kf,lds_cptr kp){
  kf[0]=*(const __attribute__((address_space(3))) bf16x8*)(kp);      kf[1]=*(const __attribute__((address_space(3))) bf16x8*)(kp+512);
  kf[2]=*(const __attribute__((address_space(3))) bf16x8*)(kp+2048); kf[3]=*(const __attribute__((address_space(3))) bf16x8*)(kp+2560);
  kf[4]=*(const __attribute__((address_space(3))) bf16x8*)(kp+4096); kf[5]=*(const __attribute__((address_space(3))) bf16x8*)(kp+4608);
  kf[6]=*(const __attribute__((address_space(3))) bf16x8*)(kp+6144); kf[7]=*(const __attribute__((address_space(3))) bf16x8*)(kp+6656);
}
__device__ __forceinline__ void kload2(bf16x8*kf,lds_cptr kp,int j){ kf[2*j]=*(const __attribute__((address_space(3))) bf16x8*)(kp+j*2048); kf[2*j+1]=*(const __attribute__((address_space(3))) bf16x8*)(kp+j*2048+512); }
__device__ __forceinline__ s16x4 vtr(lds_cptr p){ return __builtin_bit_cast(s16x4,__builtin_amdgcn_ds_read_tr16_b64_v4i16((__attribute__((address_space(3))) v4i16_t*)p)); }
__device__ __forceinline__ float rowmax(const f32x16&p0,const f32x16&p1){
  float a=max3f(p0[0],p0[1],p1[0]),b=max3f(p0[2],p0[3],p1[1]);a=max3f(a,p1[2],p1[3]);
  #pragma unroll
  for(int r=4;r<16;r+=4){a=max3f(a,p0[r],p0[r+1]);b=max3f(b,p0[r+2],p0[r+3]);a=max3f(a,p1[r],p1[r+1]);b=max3f(b,p1[r+2],p1[r+3]);}
  const float m=max2f(a,b);
  auto rr=__builtin_amdgcn_permlane32_swap(__float_as_uint(m),__float_as_uint(m),false,false);
  return max2f(__uint_as_float(rr[0]),__uint_as_float(rr[1]));
}
__device__ __forceinline__ void pv(f32x16*o,int vb,bf16x8 pa0,bf16x8 pa1,bf16x8 pa2,bf16x8 pa3){
  #pragma unroll
  for(int d0=0;d0<4;++d0){s16x4 lo[4],hi[4];
    #pragma unroll
    for(int ks=0;ks<4;++ks){
      asm volatile("ds_read_b64_tr_b16 %0,%1 offset:%c2":"=&v"(lo[ks]):"v"(vb),"i"(d0*4096+ks*1024):"memory");
      asm volatile("ds_read_b64_tr_b16 %0,%1 offset:%c2":"=&v"(hi[ks]):"v"(vb),"i"(d0*4096+ks*1024+512):"memory");}
    asm volatile("s_waitcnt lgkmcnt(0)":::"memory");SBAR();
    #define PK(k) (bf16x8){lo[k][0],lo[k][1],lo[k][2],lo[k][3],hi[k][0],hi[k][1],hi[k][2],hi[k][3]}
    o[d0]=__builtin_amdgcn_mfma_f32_32x32x16_bf16(pa0,PK(0),o[d0],0,0,0);
    o[d0]=__builtin_amdgcn_mfma_f32_32x32x16_bf16(pa1,PK(1),o[d0],0,0,0);
    o[d0]=__builtin_amdgcn_mfma_f32_32x32x16_bf16(pa2,PK(2),o[d0],0,0,0);
    o[d0]=__builtin_amdgcn_mfma_f32_32x32x16_bf16(pa3,PK(3),o[d0],0,0,0);
    #undef PK
  }
}

#ifndef ATTN_STORE16
#define ATTN_STORE16(p,v) (*(u32x4*)(p)=(v))
#endif
template<int THRL> __device__ __forceinline__ void attn_unit(int b,int qcol,int kcol,int vcol,int ocol,int qb,const bf16*Q,const bf16*__restrict__ K,const bf16*__restrict__ V,bf16*O,char*shm){
  int tid_=threadIdx.x; asm volatile("":"+v"(tid_));
  const int tid=tid_,lane=tid&63,r32=lane&31,hi=lane>>5; const int wid=__builtin_amdgcn_readfirstlane(tid>>6);
  const long rowbase=(long)b*SEQ; const int q0=qb*QB;
  const bf16*Qw=Q+(rowbase+q0+wid*QBLK)*DM+qcol;
  const bf16*Kh=K+rowbase*DM+kcol,*Vh=V+rowbase*DM+vcol;
  const unsigned lds0=(unsigned)(uintptr_t)shm;
  float*wsf=(float*)(shm+LDS_WS)+wid*64;
  const bf16*ksrc=Kh+(long)lane*DM+wid*8;
  const bf16*vsrc=Vh+(long)(16*(wid&3)+(lane>>2))*DM+(wid>>2)*32+(lane&3)*8;
  const unsigned kdst=lds0+LDS_K+wid*1024, vdst=lds0+LDS_V+wid*1024;
  #define DMA_K(t,slot) glds16(ksrc+(long)(t)*KVBLK*DM,(unsigned)__builtin_amdgcn_readfirstlane(kdst+(slot)))
  #define DMA_V(t,slot) do{ glds16(vsrc+(long)(t)*KVBLK*DM,(unsigned)__builtin_amdgcn_readfirstlane(vdst+2*(slot))); glds16(vsrc+64+(long)(t)*KVBLK*DM,(unsigned)__builtin_amdgcn_readfirstlane(vdst+8192+2*(slot))); }while(0)
  const int vb0=(int)(lds0+LDS_V)+((lane>>4)&1)*32+(lane&3)*8+(4*hi+((lane&15)>>2))*64;
  const char*Kbase=shm+LDS_K; bf16x8 kf[8];
  const lds_cptr shm3=(lds_cptr)shm; const lds_cptr kp0=shm3+LDS_K+hi*1024+r32*16; const lds_cptr vp0=shm3+LDS_V+((lane>>4)&1)*32+(lane&3)*8+(4*hi+((lane&15)>>2))*64;
  const int NT=(q0+QB)/KVBLK;
  DMA_K(0,0);DMA_V(0,0);DMA_K(1,SLOTB);
  bf16x8 qr[4];
  #pragma unroll
  for(int d0=0;d0<4;++d0)qr[d0]=*reinterpret_cast<const bf16x8*>(&Qw[(long)r32*DM+d0*16+hi*8]);
  float l_reg=0.f;f32x16 o[4];o[0]=f32x16{};o[1]=f32x16{};o[2]=f32x16{};o[3]=f32x16{};const f32x16 negm=f32x16{};
  const int qrel=wid*QBLK+r32;
  #define CMASK(P0,P1,t) do{int jb_=(t)-(NT-4); if(jb_>=0)cmask(P0,P1,jb_,qrel,hi);}while(0)
  #define START(P0,P1) do{ _Pragma("unroll") for(int r=0;r<16;++r)P0[r]=__builtin_amdgcn_exp2f(P0[r]); }while(0)
  #define RESC() do{}while(0)
  f32x16 pA0,pA1,pB0,pB1;
  int sl_prev=0,sl_cur=0,sl_next=SLOTB;
  #define ROT() do{sl_prev=sl_cur;sl_cur=sl_next;sl_next=(sl_next==(NSLOT-1)*SLOTB)?0:sl_next+SLOTB;}while(0)
  DMA_K(2,2*SLOTB);
  WAIT_BAR(4);
  qkt(pA0,pA1,Kbase,qr,negm,r32,hi);asm volatile("s_nop 15\n\ts_nop 7":"+v"(pA0),"+v"(pA1));CMASK(pA0,pA1,0);
  START(pA0,pA1);
  _Pragma("unroll") for(int r=0;r<16;++r)pA1[r]=__builtin_amdgcn_exp2f(pA1[r]);
  WAIT_BAR(0);
  DMA_K(3,0);DMA_V(1,SLOTB);
  ROT();
  kload8(kf,kp0+sl_cur);
  WAIT_BAR(3);
  s16x4 vlo[8],vhi[8]; u32x4 pw0,pw1,pw2,pw3;
  #define PKW(P,B) cvtpk_s(P[B],P[B+1])
  #define PAF(k) __builtin_bit_cast(bf16x8,pw##k)
  #define VFR(i) (bf16x8){vlo[i][0],vlo[i][1],vlo[i][2],vlo[i][3],vhi[i][0],vhi[i][1],vhi[i][2],vhi[i][3]}
  #define PIN(x) asm volatile("":"+v"(x))
  #define MX3(a,b,c) __builtin_fmaxf(__builtin_fmaxf((a),(b)),(c))
  #define GAPA(MF,A0,A1,A2,A3,W0,W1,PW) do{ MF; sacc+=A0; sacc+=A1; sacc+=A2; sacc+=A3; PIN(sacc); W0; W1; PIN(PW); SBAR(); }while(0)
  #define EX(v) __builtin_amdgcn_exp2f(v)
  #define GAPB(MF,X,B) do{ MF; X[B]=EX(X[B]); X[B+1]=EX(X[B+1]); PIN(X); SBAR(); }while(0)
  #define VRD2(i) do{ vlo[i]=vtr(vp_+((((i)>>2)+2)*4096+((i)&3)*1024)); vhi[i]=vtr(vp_+((((i)>>2)+2)*4096+((i)&3)*1024+512)); }while(0)
  #define VRD(i) do{ vlo[i]=vtr(vp_+(((i)>>2)*4096+((i)&3)*1024)); vhi[i]=vtr(vp_+(((i)>>2)*4096+((i)&3)*1024+512)); }while(0)
  #define KRD(G,j) do{ if(G){ kload2(kf,kp0+sl_next,j); SBAR(); } }while(0)
  #define STEP(C0,C1,P0,P1,t,GK,GV,GL) do{ SBAR(); \
    const lds_cptr vp_=vp0+2*sl_prev; \
    VRD(0); SBAR(); float sacc=(P0[0]+P0[1]); \
    GAPA(C0=__builtin_amdgcn_mfma_f32_32x32x16_bf16(kf[0],qr[0],negm,0,0,0), P0[2],P0[3],P0[4],P0[5],     pw0[0]=PKW(P0,0), pw0[1]=PKW(P0,2), pw0); \
    VRD(4); SBAR(); GAPA(C1=__builtin_amdgcn_mfma_f32_32x32x16_bf16(kf[1],qr[0],negm,0,0,0), P0[6],P0[7],P0[8],P0[9],     pw0[2]=PKW(P0,4), pw0[3]=PKW(P0,6), pw0); \
    VRD(1); SBAR(); GAPA(C0=__builtin_amdgcn_mfma_f32_32x32x16_bf16(kf[2],qr[1],C0,0,0,0),   P0[10],P0[11],P0[12],P0[13], pw1[0]=PKW(P0,8), pw1[1]=PKW(P0,10), pw1); \
    VRD(5); SBAR(); GAPA(C1=__builtin_amdgcn_mfma_f32_32x32x16_bf16(kf[3],qr[1],C1,0,0,0),   P0[14],P0[15],P1[0],P1[1],   pw1[2]=PKW(P0,12),pw1[3]=PKW(P0,14), pw1); \
    VRD(2); SBAR(); GAPA(C0=__builtin_amdgcn_mfma_f32_32x32x16_bf16(kf[4],qr[2],C0,0,0,0),   P1[2],P1[3],P1[4],P1[5],     pw2[0]=PKW(P1,0), pw2[1]=PKW(P1,2), pw2); \
    VRD(6); SBAR(); GAPA(C1=__builtin_amdgcn_mfma_f32_32x32x16_bf16(kf[5],qr[2],C1,0,0,0),   P1[6],P1[7],P1[8],P1[9],     pw2[2]=PKW(P1,4), pw2[3]=PKW(P1,6), pw2); \
    VRD(3); SBAR(); GAPA(C0=__builtin_amdgcn_mfma_f32_32x32x16_bf16(kf[6],qr[3],C0,0,0,0),   P1[10],P1[11],P1[12],P1[13], pw3[0]=PKW(P1,8), pw3[1]=PKW(P1,10), pw3); \
    VRD(7); SBAR(); GAPA(C1=__builtin_amdgcn_mfma_f32_32x32x16_bf16(kf[7],qr[3],C1,0,0,0),   P1[14],P1[15],0.f,0.f,       pw3[2]=PKW(P1,12),pw3[3]=PKW(P1,14), pw3); \
    l_reg+=sacc; \
    if(GK){DMA_K((t)+3,sl_cur);} if(GV){DMA_V((t)+1,sl_next);} \
    CMASK(C0,C1,t); \
    SBAR(); \
    GAPB(o[0]=__builtin_amdgcn_mfma_f32_32x32x16_bf16(PAF(0),VFR(0),o[0],0,0,0), C0,0);  VRD2(0); SBAR(); \
    GAPB(o[1]=__builtin_amdgcn_mfma_f32_32x32x16_bf16(PAF(0),VFR(4),o[1],0,0,0), C0,2);  VRD2(4); SBAR(); \
    KRD(GL,0); GAPB(o[0]=__builtin_amdgcn_mfma_f32_32x32x16_bf16(PAF(1),VFR(1),o[0],0,0,0), C0,4);  VRD2(1); SBAR(); \
    KRD(GL,1); GAPB(o[1]=__builtin_amdgcn_mfma_f32_32x32x16_bf16(PAF(1),VFR(5),o[1],0,0,0), C0,6);  VRD2(5); SBAR(); \
    KRD(GL,2); GAPB(o[0]=__builtin_amdgcn_mfma_f32_32x32x16_bf16(PAF(2),VFR(2),o[0],0,0,0), C0,8);  VRD2(2); SBAR(); \
    KRD(GL,3); GAPB(o[1]=__builtin_amdgcn_mfma_f32_32x32x16_bf16(PAF(2),VFR(6),o[1],0,0,0), C0,10); VRD2(6); SBAR(); \
    GAPB(o[0]=__builtin_amdgcn_mfma_f32_32x32x16_bf16(PAF(3),VFR(3),o[0],0,0,0), C0,12); VRD2(3); SBAR(); \
    GAPB(o[1]=__builtin_amdgcn_mfma_f32_32x32x16_bf16(PAF(3),VFR(7),o[1],0,0,0), C0,14); VRD2(7); SBAR(); \
    GAPB(o[2]=__builtin_amdgcn_mfma_f32_32x32x16_bf16(PAF(0),VFR(0),o[2],0,0,0), C1,0); \
    GAPB(o[3]=__builtin_amdgcn_mfma_f32_32x32x16_bf16(PAF(0),VFR(4),o[3],0,0,0), C1,2); \
    GAPB(o[2]=__builtin_amdgcn_mfma_f32_32x32x16_bf16(PAF(1),VFR(1),o[2],0,0,0), C1,4); \
    GAPB(o[3]=__builtin_amdgcn_mfma_f32_32x32x16_bf16(PAF(1),VFR(5),o[3],0,0,0), C1,6); \
    GAPB(o[2]=__builtin_amdgcn_mfma_f32_32x32x16_bf16(PAF(2),VFR(2),o[2],0,0,0), C1,8); \
    GAPB(o[3]=__builtin_amdgcn_mfma_f32_32x32x16_bf16(PAF(2),VFR(6),o[3],0,0,0), C1,10); \
    GAPB(o[2]=__builtin_amdgcn_mfma_f32_32x32x16_bf16(PAF(3),VFR(3),o[2],0,0,0), C1,12); \
    GAPB(o[3]=__builtin_amdgcn_mfma_f32_32x32x16_bf16(PAF(3),VFR(7),o[3],0,0,0), C1,14); \
    }while(0)
  int t=1;
  #undef CMASK
  #define CMASK(P0,P1,t) do{}while(0)
  for(;t+5<NT;t+=2){
    STEP(pB0,pB1,pA0,pA1,t,true,true,true);     WAIT_BAR(3); RESC(); ROT();
    STEP(pA0,pA1,pB0,pB1,t+1,true,true,true);   WAIT_BAR(3); RESC(); ROT();
  }
  #undef CMASK
  #define CMASK(P0,P1,t) do{int jb_=(t)-(NT-4); if(jb_>=0)cmask(P0,P1,jb_,qrel,hi);}while(0)
  #define ENDW(tt) do{ if((tt)+3<NT){WAIT_BAR(3);} else if((tt)+2<NT){WAIT_BAR(2);} else {WAIT_BAR(0);} }while(0)
  for(;t+1<NT;t+=2){
    STEP(pB0,pB1,pA0,pA1,t,(t+3<NT),(t+1<NT),(t+1<NT));       ENDW(t);   RESC(); ROT();
    STEP(pA0,pA1,pB0,pB1,t+1,(t+4<NT),(t+2<NT),(t+2<NT));     ENDW(t+1); RESC(); ROT();
  }
  STEP(pB0,pB1,pA0,pA1,NT-1,false,false,false); RESC();
  { float sacc=pB0[0]+pB0[1]; _Pragma("unroll") for(int r=2;r<16;++r)sacc+=pB0[r]; _Pragma("unroll") for(int r=0;r<16;++r)sacc+=pB1[r]; l_reg+=sacc;
    pw0=(u32x4){PKW(pB0,0),PKW(pB0,2),PKW(pB0,4),PKW(pB0,6)};pw1=(u32x4){PKW(pB0,8),PKW(pB0,10),PKW(pB0,12),PKW(pB0,14)};pw2=(u32x4){PKW(pB1,0),PKW(pB1,2),PKW(pB1,4),PKW(pB1,6)};pw3=(u32x4){PKW(pB1,8),PKW(pB1,10),PKW(pB1,12),PKW(pB1,14)};
    SBAR(); pv(o,vb0+2*sl_cur,PAF(0),PAF(1),PAF(2),PAF(3)); }
  #undef PKW
  #undef PAF
  #undef VFR
  #undef PIN
  #undef MX3
  #undef GAPA
  #undef GAPB
  #undef EX
  #undef VRD
  #undef VRD2
  #undef KRD
  #undef STEP
  #undef ENDW
  {auto rr=__builtin_amdgcn_permlane32_swap(__float_as_uint(l_reg),__float_as_uint(l_reg),false,false);l_reg=__uint_as_float(rr[0])+__uint_as_float(rr[1]);}
  if(hi==0)wsf[32+r32]=l_reg;asm volatile("s_waitcnt lgkmcnt(0)":::"memory");
  float rli[16];
  #pragma unroll
  for(int r=0;r<16;++r)rli[r]=__builtin_amdgcn_rcpf(wsf[32+crow(r,hi)]);
  bf16*Ow=O+(rowbase+q0+wid*QBLK)*DM+ocol;
  { bf16*stg=(bf16*)(shm+LDS_OST)+wid*2048;
    #pragma unroll
    for(int hv=0;hv<2;++hv){
      #pragma unroll
      for(int r=0;r<16;++r){const int orow=crow(r,hi);
        #pragma unroll
        for(int d0=0;d0<2;++d0)stg[orow*64+d0*32+r32]=__float2bfloat16(o[2*hv+d0][r]*rli[r]);}
      asm volatile("s_waitcnt lgkmcnt(0)":::"memory");
      #pragma unroll
      for(int i=0;i<4;++i){const int row=i*8+(lane>>3),ch=lane&7; const u32x4 v=*(const u32x4*)(stg+row*64+ch*8); ATTN_STORE16(Ow+(long)row*DM+hv*64+ch*8,v);}
      asm volatile("s_waitcnt lgkmcnt(0)":::"memory"); } }
  asm volatile("s_waitcnt lgkmcnt(0)\n\ts_barrier":::"memory");
  #undef DMA_K
  #undef DMA_V
  #undef CMASK
  #undef START
  #undef RESC
  #undef ROT
}
constexpr int ATTN_LDS_BYTES=ALDS_BYTES;

#undef SBAR
#undef WAIT_BAR
#undef ATTN_STORE16
}
constexpr size_t WS_ATT0 = WS_ACT, WS_ATT1 = WS_ACT + 32 * MiB;

__device__ __forceinline__ void diff_combine(const Params& P, int b, int h, int qb) {
    int tid_ = threadIdx.x; asm volatile("" : "+v"(tid_));
    const int tid = tid_, lane = tid & 63, wid = tid >> 6;
    const float lam = __expf(wave_sum(P.in[I_LQ1][lane] * P.in[I_LK1][lane])) - __expf(wave_sum(P.in[I_LQ2][lane] * P.in[I_LK2][lane])) + 0.2f;
    const int ch = lane & 15;
    const f32x4 g0 = *(const f32x4*)(P.in[I_SG] + 8 * ch), g1 = *(const f32x4*)(P.in[I_SG] + 8 * ch + 4);
    const size_t row0 = (size_t)b * SEQ + qb * 256 + wid * 32 + (lane >> 4);
    const bf16_t* s0 = (const bf16_t*)(P.ws + WS_ATT0) + row0 * D + h * 128 + 8 * ch; const bf16_t* s1 = (const bf16_t*)(P.ws + WS_ATT1) + row0 * D + h * 128 + 8 * ch;
    bf16_t* dst = (bf16_t*)(P.ws + WS_MA) + row0 * MA_LD + h * 128 + 8 * ch;
#pragma unroll
    for (int hb = 0; hb < 2; ++hb) { u32x4 ra[4], rb[4];
#pragma unroll
        for (int q = 0; q < 4; ++q) { const int it = 4 * hb + q; ra[q] = *(const u32x4*)(s0 + (size_t)(4 * it) * D); rb[q] = *(const u32x4*)(s1 + (size_t)(4 * it) * D); }
        asm volatile("" ::: "memory");
#pragma unroll
        for (int q = 0; q < 4; ++q) { const int it = 4 * hb + q;
            f32x4 a0, a1, b0, b1; pg::unpack8(ra[q], a0, a1); pg::unpack8(rb[q], b0, b1);
            const f32x4 o0 = a0 - lam * b0, o1 = a1 - lam * b1;
            float ss = (o0[0] * o0[0] + o0[1] * o0[1]) + (o0[2] * o0[2] + o0[3] * o0[3]) + (o1[0] * o1[0] + o1[1] * o1[1]) + (o1[2] * o1[2] + o1[3] * o1[3]);
            ss += __shfl_xor(ss, 1); ss += __shfl_xor(ss, 2); ss += __shfl_xor(ss, 4); ss += __shfl_xor(ss, 8);
            const float r = rsqrtf(ss * (1.f / 128.f) + EPS) * 0.8f;
            *(u32x4*)(dst + (size_t)(4 * it) * MA_LD) = pg::pack8(o0 * r * g0, o1 * r * g1); }
        asm volatile("" ::: "memory"); }
}
__device__ __forceinline__ void attn_phase(const Params& P, char* lds, int vcu, int G) {
    using attn_body::bf16;
    const bf16* Q = (const bf16*)(P.ws + WS_Q); const bf16* K = (const bf16*)(P.ws + WS_K); const bf16* V = (const bf16*)(P.ws + WS_V);
    for (int v = vcu; v < 256; v += G) {
        const int bh = v >> 2, b = bh >> 3, h = bh & 7, s = v & 3;
        for (int i = 0; i < 2; ++i) { const int qb = i == 0 ? 7 - s : s;
#ifndef ATTN_V128
#define ATTN_V128 1
#endif
#if ATTN_V128
            for (int m = 0; m < 2; ++m) {
#if EXPERTS_IN_ATTN
#ifndef CONV_SLOTS
#define CONV_SLOTS 4
#endif
#ifndef CONV_SPLIT
#define CONV_SPLIT 1
#endif
                if (CONV_SLOTS == 2 ? (i == 0 && m == ((v >> 2) & 1)) : ((i * 2 + m - (((v >> 2) + v) & 3)) & (CONV_SPLIT == 2 ? 1 : 3)) == 0) {
                    constexpr int per = (EXP_M10 - EXP_ATT0) / 256; const int hsel = CONV_SPLIT == 2 ? (((i * 2 + m - (((v >> 2) + v) & 3)) >> 1) & 1) : 0;
                    expert_convert_slice(P, (LAS unsigned char*)lds, EXP_ATT0 + v * per + hsel * (per / 2), CONV_SPLIT == 2 ? EXP_ATT0 + v * per + (hsel + 1) * (per / 2) : EXP_ATT0 + (v + 1) * per);
#if defined(PROBE_CONV2)
                    asm volatile("s_waitcnt vmcnt(0) lgkmcnt(0)" ::: "memory"); __syncthreads(); expert_convert_slice(P, (LAS unsigned char*)lds, EXP_ATT0 + v * per, EXP_ATT0 + (v + 1) * per, true);
#endif
                    asm volatile("s_waitcnt vmcnt(0) lgkmcnt(0)" ::: "memory"); __syncthreads(); }
#endif
                attn128::attn_unit<8>(b, h * 128 + m * 64, h * 128 + m * 64, h * 128, h * 128, qb, (const attn128::bf16*)Q, (const attn128::bf16*)K, (const attn128::bf16*)V, (attn128::bf16*)(P.ws + (m == 0 ? WS_ATT0 : WS_ATT1)), lds); }
#else
            for (int pass = 0; pass < 4; ++pass) { const int m = pass >> 1, vh = pass & 1;
#if EXPERTS_IN_ATTN
                if (i * 4 + pass == (((v >> 2) + v) & 3)) {
                    constexpr int per = (EXP_M10 - EXP_ATT0) / 256; expert_convert_slice(P, (LAS unsigned char*)lds, EXP_ATT0 + v * per, EXP_ATT0 + (v + 1) * per);
                    asm volatile("s_waitcnt vmcnt(0) lgkmcnt(0)" ::: "memory"); __syncthreads(); }
#endif
                attn_body::attn_unit<8>(b, h * 128 + m * 64, h * 128 + m * 64, h * 128 + vh * 64, h * 128 + vh * 64, qb, Q, K, V, (bf16*)(P.ws + (m == 0 ? WS_ATT0 : WS_ATT1)), lds); }
#endif
            asm volatile("s_waitcnt vmcnt(0)" ::: "memory");
            diff_combine(P, b, h, qb);
        }
    }
}

__device__ __forceinline__ void ssm1_phase(const Params& P, LAS unsigned char* lds, int vcu, int G) {
    const int tid = opaque_tid(), lane = tid & 63, wid = __builtin_amdgcn_readfirstlane(tid >> 6), fr = lane & 15, fq = lane >> 4;
    LAS float* Sl = (LAS float*)lds;
    for (int u = vcu; u < SSM_G * BATCH; u += G) {
        const int g = u >> 3, b = u & 7;
        bf16_t* A = (bf16_t*)(P.ws + WS_ACAT) + (size_t)(g * ACAT_ROWS + b * NCH) * ACAT_LD;
        const bf16_t* Bw = (const bf16_t*)(P.ws + WS_WS_T) + (size_t)(g * 128 + 16 * wid + fr) * 512 + fq * 8;
        f32x4 acc[4];
#pragma unroll
        for (int m = 0; m < 4; ++m) acc[m] = (f32x4){0.f, 0.f, 0.f, 0.f};
#pragma unroll 4
        for (int ks = 0; ks < 16; ++ks) {
            const bf16x8 bf = *(const bf16x8*)(Bw + ks * 32);
#pragma unroll
            for (int m = 0; m < 4; ++m) { const bf16x8 af = *(const bf16x8*)(A + (size_t)(16 * m + fr) * ACAT_LD + ks * 32 + fq * 8);
                acc[m] = __builtin_amdgcn_mfma_f32_16x16x32_bf16(af, bf, acc[m], 0, 0, 0); }
        }
#pragma unroll
        for (int m = 0; m < 4; ++m)
#pragma unroll
            for (int q = 0; q < 4; ++q) Sl[(16 * m + 4 * fq + q) * 129 + 16 * wid + fr] = acc[m][q];
        __syncthreads();
        if (tid < SSM_P) {
            const int p = tid; const SsmGP gp = ssm_gp(P, g, p); float aLr, aLi; ssm_pow(gp, CH_L, aLr, aLi);
            float xr = 0.f, xi = 0.f;
            bf16_t* xp = A + 512 + p;
            for (int c = 0; c < NCH; ++c) {
                xp[(size_t)c * ACAT_LD] = (bf16_t)f2bf(xr); xp[(size_t)c * ACAT_LD + 64] = (bf16_t)f2bf(xi);
                const float sr = Sl[c * 129 + p], si = Sl[c * 129 + 64 + p];
                const float nr = aLr * xr - aLi * xi + sr, ni = aLr * xi + aLi * xr + si; xr = nr; xi = ni;
            }
        }
        __syncthreads();
    }
}
namespace pg {
struct Ssm2Sched {
    unsigned char* ws; int G, c;
    __device__ __forceinline__ void init(unsigned char* ws_, int G_, int c_) { ws = ws_; G = G_; c = c_; }
    __device__ __forceinline__ bool next(int i, Unit& u) const {
        const int L = i * G + c; if (L >= SSM_G * 4) return false;
        const int g = L >> 2; u.pm = (L >> 1) & 1; u.pn = L & 1; u.aux = g; u.aux2 = 0; u.ord = i; const LaneRC rc;
        u.A = (const char*)((const bf16_t*)(ws + WS_ACAT) + (size_t)g * ACAT_ROWS * ACAT_LD); u.B = (const char*)((const bf16_t*)(ws + WS_BT_SSM) + ((size_t)g * 512 + u.pn * BM) * ACAT_LD);
#pragma unroll
        for (int h = 0; h < 2; ++h)
#pragma unroll
            for (int j = 0; j < 2; ++j) u.aoff[h][j] = (unsigned)(((u.pm * BM + 128 * h + rc.R[j]) * ACAT_LD + rc.C[j]) * 2);
        return true;
    }
};
}

constexpr int RT_LG_OFF = RING_BYTES + 2048;
constexpr int RT_HIST_OFF = RT_LG_OFF + 64 * 33 * 4;
__device__ __forceinline__ void router_phase(const Params& P, LAS unsigned char* lds, int vcu, int G) {
    const int tid = opaque_tid(), lane = tid & 63, wid = __builtin_amdgcn_readfirstlane(tid >> 6);
    const float* wrt = (const float*)(P.ws + WS_WR_T);
#pragma unroll 4
    for (int i = 0; i < 16; ++i) ((LAS f32x4*)lds)[tid + NTHREADS * i] = ((const f32x4*)wrt)[tid + NTHREADS * i];
    LAS float* lg = (LAS float*)(lds + RT_LG_OFF); LAS int* hist = (LAS int*)(lds + RT_HIST_OFF);
    int* slot_tok = (int*)(P.ws + WS_SLOT_TOK); float* slot_gate = (float*)(P.ws + WS_SLOT_GATE); int* tok_ep = (int*)(P.ws + WS_TOK_EP);
    unsigned char* H2 = P.ws + WS_H2;
    for (int tb = vcu; tb < T / 64; tb += G) {
        if (tid < 64) hist[tid] = 0;
        __syncthreads();
        for (int pass = 0; pass < 2; ++pass) {
            const int t0 = tb * 64 + wid * 8 + pass * 4;
            f32x4 h[4][4];
#pragma unroll
            for (int t = 0; t < 4; ++t)
#pragma unroll
                for (int j = 0; j < 4; ++j) h[t][j] = NT_LOAD((const f32x4*)((const float*)(P.ws + WS_X1) + (size_t)(t0 + t) * D) + lane + 64 * j);
            f32x2 ha[4][4], hb[4][4];
#pragma unroll
            for (int tp = 0; tp < 2; ++tp) {
                float s0 = 0.f, s1 = 0.f;
#pragma unroll
                for (int j = 0; j < 4; ++j) { const f32x4 a = h[2 * tp][j], b = h[2 * tp + 1][j]; s0 += (a.x * a.x + a.y * a.y) + (a.z * a.z + a.w * a.w); s1 += (b.x * b.x + b.y * b.y) + (b.z * b.z + b.w * b.w); }
                const float r0 = rsqrtf(wave_sum(s0) * (1.f / D) + EPS), r1 = rsqrtf(wave_sum(s1) * (1.f / D) + EPS);
#pragma unroll
                for (int j = 0; j < 4; ++j) { const f32x4 g2 = ((const f32x4*)P.in[I_G2])[lane + 64 * j]; const f32x4 a = h[2 * tp][j] * r0 * g2, b = h[2 * tp + 1][j] * r1 * g2;
                    ((unsigned*)(H2 + (size_t)(t0 + 2 * tp) * D))[lane + 64 * j] = pk4_fp8(a.x, a.y, a.z, a.w);
                    ((unsigned*)(H2 + (size_t)(t0 + 2 * tp + 1) * D))[lane + 64 * j] = pk4_fp8(b.x, b.y, b.z, b.w);
#pragma unroll
                    for (int c = 0; c < 4; ++c) { const f32x2 pr = {a[c], b[c]}; if (tp == 0) ha[j][c] = pr; else hb[j][c] = pr; } }
            }
            f32x2 v[64];
#pragma unroll
            for (int e = 0; e < NE; ++e) { f32x2 a0 = {0.f, 0.f}, a1 = {0.f, 0.f};
#pragma unroll
                for (int j = 0; j < 4; ++j) { const f32x4 w = ((const LAS f32x4*)(lds + e * 4096))[lane + 64 * j];
#pragma unroll
                    for (int c = 0; c < 4; ++c) { const f32x2 ww = {w[c], w[c]}; a0 += ha[j][c] * ww; a1 += hb[j][c] * ww; } }
                v[e] = a0; v[32 + e] = a1; }
#pragma unroll
            for (int half = 32; half >= 1; half >>= 1) { const bool upper = (lane & half) != 0;
#pragma unroll
                for (int i = 0; i < half; ++i) { const f32x2 send = upper ? v[i] : v[i + half], keep = upper ? v[i + half] : v[i]; const f32x2 got = {__shfl_xor(send.x, half), __shfl_xor(send.y, half)}; v[i] = keep + got; } }
            const float br = P.in[I_BR][lane & 31]; const int tl = wid * 8 + pass * 4 + 2 * (lane >> 5);
            lg[tl * 33 + (lane & 31)] = v[0].x + br; lg[(tl + 1) * 33 + (lane & 31)] = v[0].y + br;
        }
        __syncthreads();
        if (wid == 0) {
            const int tok = tb * 64 + lane;
            float tv[4]; int ti[4];
#pragma unroll
            for (int k = 0; k < 4; ++k) { tv[k] = -INFINITY; ti[k] = 0; }
            for (int e = 0; e < NE; ++e) { const float x = lg[lane * 33 + e];
                if (x > tv[3]) { if (x > tv[2]) { tv[3] = tv[2]; ti[3] = ti[2]; if (x > tv[1]) { tv[2] = tv[1]; ti[2] = ti[1]; if (x > tv[0]) { tv[1] = tv[0]; ti[1] = ti[0]; tv[0] = x; ti[0] = e; } else { tv[1] = x; ti[1] = e; } } else { tv[2] = x; ti[2] = e; } } else { tv[3] = x; ti[3] = e; } } }
            const float e1 = __expf(tv[1] - tv[0]), e2 = __expf(tv[2] - tv[0]), e3 = __expf(tv[3] - tv[0]); const float inv = 1.f / (1.f + e1 + e2 + e3);
            const float gk[4] = {inv, e1 * inv, e2 * inv, e3 * inv};
            int lp[4];
#pragma unroll
            for (int k = 0; k < 4; ++k) lp[k] = atomicAdd((int*)&hist[ti[k]], 1);
            asm volatile("s_waitcnt lgkmcnt(0)" ::: "memory");
            { const int l2 = opaque_tid() & 63;
              if (l2 < NE) { const int n = hist[l2]; hist[32 + l2] = n ? (int)atomicAdd((unsigned*)(P.ws + WS_CTL) + CW_CNT + l2, (unsigned)n) : 0; } }
            asm volatile("s_waitcnt vmcnt(0) lgkmcnt(0)" ::: "memory");
#pragma unroll
            for (int k = 0; k < 4; ++k) { const int e = ti[k], pos = hist[32 + e] + lp[k];
                slot_tok[(size_t)e * CAP + pos] = tok; slot_gate[(size_t)e * CAP + pos] = gk[k]; tok_ep[tok * 4 + k] = (e << 16) | pos; }
        }
        __syncthreads();
    }
}

#ifndef COMB_Y_DEFAULT
#define COMB_Y_LOAD(p) NT_LOAD(p)
#else
#define COMB_Y_LOAD(p) (*(p))
#endif
__device__ __forceinline__ void combine_phase(const Params& P, LAS unsigned char* lds, int vcu, int G) {
    const int tid = opaque_tid(), lane = tid & 63, wid = __builtin_amdgcn_readfirstlane(tid >> 6);
    const LAS int* tab = (const LAS int*)(lds + pg::TAB_OFF);
    const int* tok_ep = (const int*)(P.ws + WS_TOK_EP); const bf16_t* Y = (const bf16_t*)(P.ws + WS_Y); const float* sgate = (const float*)(P.ws + WS_SLOT_GATE);
    for (int tok = (vcu * NWAVES + wid) * 2; tok < T; tok += G * NWAVES * 2) {
        f32x4 a[2][4]; u32x2 yv[2][4][4]; float gk[2][4];
#pragma unroll
        for (int tt = 0; tt < 2; ++tt) {
#pragma unroll
            for (int j = 0; j < 4; ++j) a[tt][j] = NT_LOAD((const f32x4*)((const float*)(P.ws + WS_X1) + (size_t)(tok + tt) * D) + lane + 64 * j);
#pragma unroll
            for (int k = 0; k < 4; ++k) { const int ep = tok_ep[(tok + tt) * 4 + k]; const int slot = tab[ep >> 16] * 256 + (ep & 0xffff); gk[tt][k] = sgate[(size_t)(ep >> 16) * CAP + (ep & 0xffff)];
#pragma unroll
                for (int j = 0; j < 4; ++j) yv[tt][k][j] = COMB_Y_LOAD((const u32x2*)(Y + (size_t)slot * D) + lane + 64 * j); } }
        asm volatile("" ::: "memory");
#pragma unroll
        for (int tt = 0; tt < 2; ++tt) {
#pragma unroll
            for (int k = 0; k < 4; ++k)
#pragma unroll
                for (int j = 0; j < 4; ++j) { const u32x2 w = yv[tt][k][j]; a[tt][j] += gk[tt][k] * (f32x4){bflo(w.x), bfhi(w.x), bflo(w.y), bfhi(w.y)}; }
#pragma unroll
            for (int j = 0; j < 4; ++j) NT_STORE(a[tt][j], (f32x4*)(P.out + (size_t)(tok + tt) * D) + lane + 64 * j); }
    }
}
#define XB_TMO      128
#define XB_XCNT(j)  (256  + 64 * (j))
#define XB_XSUB(j)  (1280 + 64 * (j))
#define XB_XGEN(j)  (2304 + 64 * (j))
#define XB_TOP      3328
#define XB_TOPGEN   3392
#define XCD_BAR_WORDS 3456
#define XB_SPIN_CAP (1u << 18)
__device__ __forceinline__ unsigned xb_ld(unsigned* p)              { return __hip_atomic_load(p, __ATOMIC_RELAXED, __HIP_MEMORY_SCOPE_AGENT); }
__device__ __forceinline__ unsigned xb_add(unsigned* p, unsigned v) { return __hip_atomic_fetch_add(p, v, __ATOMIC_RELAXED, __HIP_MEMORY_SCOPE_AGENT); }
__device__ __forceinline__ unsigned xb_xcc_id() { return (unsigned)__builtin_amdgcn_s_getreg((3 << 11) | 20) & 0xFu; }
#define XB_SPIN(cond, bar) do { unsigned _sp = 0; while (cond) { __builtin_amdgcn_s_sleep(1); \
    if ((++_sp & 255u) == 0u) { if (xb_ld(&(bar)[XB_TMO])) break; if (_sp > XB_SPIN_CAP) { atomicAdd(&(bar)[XB_TMO], 1u); break; } } } } while (0)
struct XcdBarrier { unsigned* bar; unsigned x; volatile LAS unsigned* st; };
__device__ __forceinline__ XcdBarrier xcd_barrier_post(unsigned* bar, volatile LAS unsigned* st) {
    XcdBarrier b; b.bar = bar; b.x = xb_xcc_id(); b.st = st;
    if (threadIdx.x == 0) (void)xb_add(&bar[XB_XCNT(b.x)], 1u);
    return b;
}
__device__ __forceinline__ void xcd_barrier_complete(unsigned* bar, unsigned x, unsigned& nloc, unsigned& nx) {
    const unsigned G = gridDim.x * gridDim.y * gridDim.z;
    unsigned sum, cnt, mine, sp = 0u;
    for (;;) {
        sum = 0u; cnt = 0u; mine = 0u;
#pragma unroll
        for (unsigned j = 0; j < 16; ++j) { const unsigned c = xb_ld(&bar[XB_XCNT(j)]); sum += c; cnt += (c > 0u) ? 1u : 0u; mine = (j == x) ? c : mine; }
        if (sum == G) break;
        __builtin_amdgcn_s_sleep(1);
        if ((++sp & 255u) == 0u) { if (xb_ld(&bar[XB_TMO])) break; if (sp > XB_SPIN_CAP) { atomicAdd(&bar[XB_TMO], 1u); break; } }
    }
    nloc = mine > 0u ? mine : 1u; nx = cnt > 0u ? cnt : 1u;
}
__device__ __forceinline__ void xcd_barrier(const XcdBarrier& b) {
    asm volatile("s_waitcnt vmcnt(0)" ::: "memory");
    __syncthreads();
    if (threadIdx.x == 0) {
        unsigned* bar = b.bar;
        __builtin_amdgcn_s_waitcnt(0);
        unsigned nloc = b.st[0], nx = b.st[1];
        if (nloc == 0u) { xcd_barrier_complete(bar, b.x, nloc, nx); b.st[0] = nloc; b.st[1] = nx; }
        const unsigned old = xb_add(&bar[XB_XSUB(b.x)], 1u);
        const unsigned gen = old / nloc;
        if (old + 1u == (gen + 1u) * nloc) {
            __builtin_amdgcn_fence(__ATOMIC_RELEASE, "agent");
            asm volatile("s_waitcnt vmcnt(0)" ::: "memory");
            const unsigned og = xb_add(&bar[XB_TOP], 1u);
            const unsigned tg = og / nx;
            if (og + 1u == (tg + 1u) * nx) xb_add(&bar[XB_TOPGEN], 1u);
            else XB_SPIN(xb_ld(&bar[XB_TOPGEN]) == tg, bar);
            __builtin_amdgcn_fence(__ATOMIC_ACQUIRE, "agent");
            xb_add(&bar[XB_XGEN(b.x)], 1u);
            asm volatile("s_waitcnt vmcnt(0)" ::: "memory");
        } else {
            XB_SPIN(xb_ld(&bar[XB_XGEN(b.x)]) == gen, bar);
            __builtin_amdgcn_fence(__ATOMIC_ACQUIRE, "agent");
            asm volatile("s_waitcnt vmcnt(0)" ::: "memory");
        }
    }
    __syncthreads();
}
#ifndef PH_MASK
#define PH_MASK 0xffffffffu
#endif
__global__ void __launch_bounds__(NTHREADS, 2) mega_fwd(Params P) {
    extern __shared__ __attribute__((aligned(16))) unsigned char lds_[];
    LAS unsigned char* lds = (LAS unsigned char*)lds_;
    const int tid = threadIdx.x;
    const int G = gridDim.x, bx = blockIdx.x, vcu = (G % 8 == 0) ? (bx % 8) * (G / 8) + bx / 8 : bx;
    for (int u = tid; u < (LDS_BYTES - RING_BYTES) / 4; u += NTHREADS) ((LAS unsigned*)(lds + RING_BYTES))[u] = 0u;
    __syncthreads();
    unsigned* ctl = (unsigned*)(P.ws + WS_CTL);
    const XcdBarrier bar = xcd_barrier_post(ctl + CW_BAR, (volatile LAS unsigned*)(lds + MISC_OFF) + 8);
#ifndef PH_REP
#define PH_REP 0u
#endif
#ifndef BAR_REP
#define BAR_REP 1
#endif
#define GRID_BAR() do { for (int b_ = 0; b_ < BAR_REP; ++b_) xcd_barrier(bar); } while (0)
#define ON(k) for (int r_ = 0; r_ < 1 + (int)((PH_REP >> (k)) & 1u); ++r_) if ((PH_MASK >> (k)) & 1u)
#ifndef FWD_REP
#define FWD_REP 1
#endif
    for (int fwd_ = 0; fwd_ < FWD_REP; ++fwd_) {
    if (fwd_ > 0) { GRID_BAR(); if (bx == 0 && tid < 64) ctl[CW_CNT + tid] = 0u; }
    ON(0) p0_prologue(P, lds, vcu, G);
    GRID_BAR();
    ON(1) { pg::DenseSched S; S.init((const bf16_t*)(P.ws + WS_XN), D, (const bf16_t*)(P.ws + WS_WIN_T), D, T, IN_W, G, bx);
        pg::EpiInProj E; E.ws = P.ws; E.qg = P.in[I_QG]; E.kg = P.in[I_KG];
#if defined(PROBE_NULL_EPI)
        if (r_ == 1) { pg::EpiNull EN; pg::gemm_phase(lds, S, EN, D / 64, D); } else
#endif
#ifndef INPROJ_BAUX
#define INPROJ_BAUX 0
#endif
        pg::gemm_phase<false, INPROJ_BAUX>(lds, S, E, D / 64, D);
#if EXPERTS_IN_ATTN
        if (r_ == 0 && G == 256 && bx >= 128) expert_convert_slice(P, lds, EXP_IN0 + (bx - 128) * EXP_N_IN, EXP_IN0 + (bx - 127) * EXP_N_IN);
        __syncthreads();
#endif
    }
    GRID_BAR();
    ON(2) { ssm_toeplitz_expand(P, vcu, G); ssm1_phase(P, lds, vcu, G); }
    ON(3) attn_phase(P, (char*)lds_, vcu, G);
    GRID_BAR();
    ON(4) { pg::Ssm2Sched S; S.init(P.ws, G, bx); pg::EpiSsm2 E; E.ws = P.ws; pg::gemm_phase(lds, S, E, ACAT_LD / 64, ACAT_LD);
#if EXPERTS_IN_ATTN
        if (r_ == 0 && G == 256 && bx >= 128) expert_convert_slice(P, lds, EXP_S20 + (bx - 128) * EXP_N_S2, EXP_S20 + (bx - 127) * EXP_N_S2);
        __syncthreads();
#endif
    }
    GRID_BAR();
    ON(5) { pg::DenseSched S; S.init((const bf16_t*)(P.ws + WS_Z), SSM_W, (const bf16_t*)(P.ws + WS_WGLU_T), SSM_W, T, SSM_W, G, bx);
        pg::EpiGlu E; E.ws = P.ws; E.bglu = P.in[I_BGLU]; pg::gemm_phase(lds, S, E, SSM_W / 64, SSM_W);
#if EXPERTS_IN_ATTN
        if (r_ == 0 && G == 256 && bx >= 128) expert_convert_slice(P, lds, EXP_GLU0 + (bx - 128) * EXP_N_GLU, EXP_GLU0 + (bx - 127) * EXP_N_GLU);
        __syncthreads();
#endif
    }
    GRID_BAR();
    ON(6) { pg::DenseSched S; S.init((const bf16_t*)(P.ws + WS_MA), MA_LD, (const bf16_t*)(P.ws + WS_WP_T), MA_LD, T, D, G, bx);
        pg::EpiMerged E; E.ws = P.ws; pg::gemm_phase(lds, S, E, MA_LD / 64, MA_LD); }
    GRID_BAR();
    ON(7) { pg::DenseSched S; S.init((const bf16_t*)(P.ws + WS_MERGED), D, (const bf16_t*)(P.ws + WS_WOUT_T), D, T, D, G, bx);
        pg::EpiWout E; E.x = P.in[I_X]; E.out = (float*)(P.ws + WS_X1); pg::gemm_phase(lds, S, E, D / 64, D); }
    GRID_BAR();
    ON(8) router_phase(P, lds, vcu, G);
    GRID_BAR();
    pg::moe_build_tab(lds, (const unsigned*)(P.ws + WS_CTL) + CW_CNT);
    ON(9) { pg::MoeSched<1> S; S.init(P.ws, lds, G, bx, P.in[I_B1]); pg::EpiMoe1 E; E.ws = P.ws; E.b1 = P.in[I_B1]; E.lds = lds; E.nostore = (r_ == 1);
#if defined(PROBE_MOE_NT)
        if (r_ == 1) { pg::EpiNull EN; pg::gemm_phase<true>(lds, S, EN, PROBE_MOE_NT, D / 2, 7); } else
#endif
        pg::gemm_phase<true>(lds, S, E, D / 128, D / 2);
#if EXPERTS_IN_ATTN
        if (r_ == 0 && G == 256 && (bx >> 3) >= 16) { const int k_ = (bx & 7) * 16 + (bx >> 3) - 16; expert_convert_slice(P, lds, EXP_M10 + k_ * EXP_N_M1, EXP_M10 + (k_ + 1) * EXP_N_M1); }
        __syncthreads();
#endif
    }
    GRID_BAR();
    ON(10) { pg::MoeSched<2> S; S.init(P.ws, lds, G, bx, P.in[I_B2]);
#if defined(PROBE_FREEZE)
        S.freeze = (r_ == 1);
#endif
 pg::EpiMoe2 E; E.ws = P.ws; E.b2 = P.in[I_B2]; E.lds = lds; E.nostore = (r_ == 1);
#if defined(PROBE_MOE_NT)
        if (r_ == 1) { pg::EpiNull EN; pg::gemm_phase<true>(lds, S, EN, PROBE_MOE_NT, DFF / 2, 7); } else
#endif
        pg::gemm_phase<true>(lds, S, E, DFF / 128, DFF / 2); }
    GRID_BAR();
    ON(11) combine_phase(P, lds, vcu, G);
    }
#undef ON
}

extern "C" void kernel_launch(void* const* d_in, const int* in_sizes, int n_in, void* d_out, int out_size, void* d_ws, size_t ws_size, hipStream_t stream) {
    static int grid = 0;
    if (grid == 0) {
        int dev = 0, cus = 0, per_cu = 0;
        if (hipGetDevice(&dev) != hipSuccess || hipDeviceGetAttribute(&cus, hipDeviceAttributeMultiprocessorCount, dev) != hipSuccess) { fprintf(stderr, "kernel_launch: device query failed\n"); grid = -1; return; }
        if (hipFuncSetAttribute((const void*)mega_fwd, hipFuncAttributeMaxDynamicSharedMemorySize, LDS_BYTES) != hipSuccess) { fprintf(stderr, "kernel_launch: hipFuncSetAttribute failed\n"); grid = -1; return; }
        if (hipOccupancyMaxActiveBlocksPerMultiprocessor(&per_cu, (const void*)mega_fwd, NTHREADS, LDS_BYTES) != hipSuccess || per_cu < 1) { fprintf(stderr, "kernel_launch: occupancy query reports %d workgroups per CU\n", per_cu); per_cu = 1; }
        (void)hipGetLastError();
        grid = cus;
        if (ws_size < WS_END) { fprintf(stderr, "kernel_launch: workspace too small\n"); grid = -1; return; }
    }
    if (grid < 0) return;
    hipMemsetAsync((char*)d_ws + WS_CTL, 0, CTL_ZERO_BYTES, stream);
    Params P{};
    for (int i = 0; i < 30; ++i) P.in[i] = (const float*)d_in[i];
    P.out = (float*)d_out; P.ws = (unsigned char*)d_ws;
    hipLaunchKernelGGL(mega_fwd, dim3(grid), dim3(NTHREADS), LDS_BYTES, stream, P);
#if defined(PROBE_TWO_LAUNCHES)
    hipMemsetAsync((char*)d_ws + WS_CTL, 0, CTL_ZERO_BYTES, stream);
    hipLaunchKernelGGL(mega_fwd, dim3(grid), dim3(NTHREADS), LDS_BYTES, stream, P);
#endif
}
```

```cpp
#include <hip/hip_runtime.h>
#include <hip/hip_bf16.h>
#include <stdint.h>
#include <math.h>
#include <cstdio>

constexpr int D = 1024, BATCH = 8, SEQ = 2048, T = BATCH * SEQ;
constexpr int SSM_W = 512, SSM_H = 16, SSM_G = 32, SSM_P = 64;
constexpr int CH_L = 32, NCH = SEQ / CH_L;
constexpr int ACAT_ROWS = BATCH * NCH;
constexpr int ACAT_LD = CH_L * SSM_H + 2 * SSM_P;
constexpr int AH = 8, AW = 1024;
constexpr int IN_W = 5632;
constexpr int NE = 32, DFF = 1024;
constexpr float EPS = 1e-5f;
constexpr int OFF_U = 0, OFF_Q = 512, OFF_K = 1536, OFF_V = 2560, OFF_GS = 3584, OFF_GA = 4608;
constexpr int CAP = T;
constexpr int MAXBLK = 288;
constexpr float QC2 = 0.125f * 1.4426950408889634f;
constexpr int MA_LD = 1536;

constexpr size_t MiB = 1u << 20;
constexpr size_t WS_CTL = 0, CTL_ZERO_BYTES = 64 * 1024;
constexpr size_t WS_WIN_T = 2 * MiB;
constexpr size_t WS_WGLU_T = 13 * MiB;
constexpr size_t WS_WP_T = 14 * MiB;
constexpr size_t WS_WOUT_T = 17 * MiB;
constexpr size_t WS_WR_T = 19 * MiB;
constexpr size_t WS_KJ = 21 * MiB;
constexpr size_t WS_WS_T = 22 * MiB;
constexpr size_t WS_BT_SSM = 26 * MiB;
constexpr size_t WS_W1_T = 48 * MiB;
constexpr size_t WS_W2_T = 176 * MiB;
constexpr size_t WS_XN = 240 * MiB;
constexpr size_t WS_ACAT = 272 * MiB;
constexpr size_t WS_Q = 292 * MiB, WS_K = 324 * MiB, WS_V = 356 * MiB;
constexpr size_t WS_GS = 388 * MiB, WS_GA = 420 * MiB;
constexpr size_t WS_X1 = 292 * MiB;
constexpr size_t WS_Z = 452 * MiB;
constexpr size_t WS_MA = 468 * MiB;
constexpr size_t WS_MERGED = 516 * MiB;
constexpr size_t WS_H2 = 548 * MiB;
constexpr size_t WS_SLOT_TOK = 582 * MiB;
constexpr size_t WS_SLOT_GATE = 584 * MiB;
constexpr size_t WS_TOK_EP = 586 * MiB;
constexpr size_t WS_ACT = 588 * MiB;
constexpr size_t WS_Y = 732 * MiB;
constexpr size_t WS_END = 876 * MiB;
constexpr int CW_CNT = 64;
constexpr int CW_BAR = 4096;

typedef unsigned short bf16_t;
typedef short bf16x8 __attribute__((ext_vector_type(8)));
typedef float f32x4 __attribute__((ext_vector_type(4)));
typedef float f32x2 __attribute__((ext_vector_type(2)));
typedef unsigned u32x4 __attribute__((ext_vector_type(4)));
typedef unsigned u32x2 __attribute__((ext_vector_type(2)));
#define LAS __attribute__((address_space(3)))
#define GAS __attribute__((address_space(1)))

__device__ __forceinline__ float wave_sum(float v) {
#pragma unroll
    for (int o = 1; o < 64; o <<= 1) v += __shfl_xor(v, o);
    return v;
}
typedef __bf16 bf16x2_hw __attribute__((ext_vector_type(2)));
__device__ __forceinline__ unsigned pk2(float lo, float hi) { const f32x2 v = {lo, hi}; return __builtin_bit_cast(unsigned, __builtin_convertvector(v, bf16x2_hw)); }
__device__ __forceinline__ unsigned f2bf(float f) { return pk2(f, 0.f) & 0xffffu; }
__device__ __forceinline__ float bf2f(unsigned short b) { return __builtin_bit_cast(float, (unsigned)b << 16); }
__device__ __forceinline__ float bflo(unsigned w) { return __builtin_bit_cast(float, w << 16); }
__device__ __forceinline__ float bfhi(unsigned w) { return __builtin_bit_cast(float, w & 0xffff0000u); }
__device__ __forceinline__ float sigmoid_f(float x) { return __builtin_amdgcn_rcpf(1.f + __expf(-x)); }
__device__ __forceinline__ float sigmoid_c(float x) { x = fminf(fmaxf(x, -30.f), 30.f); return __builtin_amdgcn_rcpf(1.f + __expf(-x)); }
__device__ __forceinline__ float gelu_tanh(float x) { const float u = 0.7978845608028654f * (x + 0.044715f * x * x * x); return x * sigmoid_f(2.f * u); }

__device__ __forceinline__ unsigned pk4_fp8(float a, float b, float cc, float d) { int w = 0; w = __builtin_amdgcn_cvt_pk_fp8_f32(a, b, w, false); w = __builtin_amdgcn_cvt_pk_fp8_f32(cc, d, w, true); return (unsigned)w; }
__device__ __forceinline__ void unpk4_fp8(unsigned w, float& a, float& b, float& cc, float& d) { const f32x2 lo = __builtin_amdgcn_cvt_pk_f32_fp8((int)w, false), hi = __builtin_amdgcn_cvt_pk_f32_fp8((int)w, true); a = lo.x; b = lo.y; cc = hi.x; d = hi.y; }
constexpr float W8_SCALE = 64.f;
#ifndef WT_STORES
#define WT_STORES 0
#endif
__device__ __forceinline__ void store16(void* p, const u32x4 v) {
#if WT_STORES
    asm volatile("global_store_dwordx4 %0, %1, off sc1\n\ts_nop 1" :: "v"(p), "v"(v) : "memory");
#else
    *(u32x4*)p = v;
#endif
}
#ifndef NT_STREAMS
#define NT_STREAMS 1
#endif
#if NT_STREAMS
#define NT_LOAD(p) __builtin_nontemporal_load(p)
#define NT_STORE(v, p) __builtin_nontemporal_store((v), (p))
#else
#define NT_LOAD(p) (*(p))
#define NT_STORE(v, p) (*(p) = (v))
#endif
__device__ __forceinline__ int opaque_tid() { int t = threadIdx.x; asm volatile("" : "+v"(t)); return t; }

struct Params {
    const float* in[30];
    float* out;
    unsigned char* ws;
};
enum { I_X = 0, I_G1, I_WIN, I_LRE, I_LIM, I_LOGDT, I_BRE, I_BIM, I_CRE, I_CIM, I_DSK, I_WGLU, I_BGLU, I_QG, I_KG, I_LQ1, I_LK1, I_LQ2, I_LK2, I_SG, I_WPS, I_WPA, I_WOUT, I_G2, I_WR, I_BR, I_W1, I_B1, I_W2, I_B2 };

constexpr int NWAVES = 8, NTHREADS = 512;
constexpr int LDS_BYTES = 147456;
constexpr int RING_BYTES = 131072;
constexpr int MISC_OFF = RING_BYTES + 320;
__device__ __forceinline__ void p0_transpose_item(const float* __restrict__ W, int N, bf16_t* __restrict__ WT, int ldo, int k_off, LAS float* scr, int kb, int nb, int lane) {
    const int k0 = 64 * kb, n0 = 32 * nb;
    { f32x4 v[8];
#pragma unroll
        for (int i = 0; i < 8; ++i) v[i] = NT_LOAD((const f32x4*)(W + (size_t)(k0 + 8 * i + (lane >> 3)) * N + n0 + (lane & 7) * 4));
#pragma unroll
        for (int i = 0; i < 8; ++i) { LAS float* d = scr + (8 * i + (lane >> 3)) * 33 + (lane & 7) * 4; d[0] = v[i].x; d[1] = v[i].y; d[2] = v[i].z; d[3] = v[i].w; } }
    asm volatile("s_waitcnt lgkmcnt(0)" ::: "memory");
    const int c = lane & 7;
#pragma unroll
    for (int j = 0; j < 4; ++j) { const int n = (lane >> 3) + 8 * j; const LAS float* s = scr + (8 * c) * 33 + n;
        u32x4 o; o.x = pk2(s[0 * 33], s[1 * 33]); o.y = pk2(s[2 * 33], s[3 * 33]); o.z = pk2(s[4 * 33], s[5 * 33]); o.w = pk2(s[6 * 33], s[7 * 33]);
        *(u32x4*)(WT + (size_t)(n0 + n) * ldo + k_off + k0 + 8 * c) = o; }
    asm volatile("s_waitcnt lgkmcnt(0)" ::: "memory");
}
__device__ __forceinline__ void p0_transpose_item_fp8(const float* __restrict__ W, int N, unsigned char* __restrict__ WT, int ldo, LAS float* scr, int kb, int nb, int lane) {
    const int k0 = 64 * kb, n0 = 32 * nb;
    { f32x4 v[8];
#pragma unroll
        for (int i = 0; i < 8; ++i) v[i] = NT_LOAD((const f32x4*)(W + (size_t)(k0 + 8 * i + (lane >> 3)) * N + n0 + (lane & 7) * 4));
#pragma unroll
        for (int i = 0; i < 8; ++i) { LAS float* d = scr + (8 * i + (lane >> 3)) * 33 + (lane & 7) * 4; d[0] = v[i].x; d[1] = v[i].y; d[2] = v[i].z; d[3] = v[i].w; } }
    asm volatile("s_waitcnt lgkmcnt(0)" ::: "memory");
    const int n = lane >> 1, half = lane & 1; const LAS float* s = scr + (32 * half) * 33 + n;
    unsigned o[8];
#pragma unroll
    for (int q = 0; q < 8; ++q) o[q] = pk4_fp8(s[(4 * q) * 33] * W8_SCALE, s[(4 * q + 1) * 33] * W8_SCALE, s[(4 * q + 2) * 33] * W8_SCALE, s[(4 * q + 3) * 33] * W8_SCALE);
    u32x4* dst = (u32x4*)(WT + (size_t)(n0 + n) * ldo + k0 + 32 * half);
    dst[0] = (u32x4){o[0], o[1], o[2], o[3]}; dst[1] = (u32x4){o[4], o[5], o[6], o[7]};
    asm volatile("s_waitcnt lgkmcnt(0)" ::: "memory");
}
__device__ __forceinline__ void p0_transpose_f32_item(const float* __restrict__ W, float* __restrict__ WT, int K, LAS float* scr, int kb, int lane) {
    const int k0 = 64 * kb;
#pragma unroll 8
    for (int i = 0; i < 32; ++i) { const int kk = 2 * i + (lane >> 5); scr[kk * 33 + (lane & 31)] = W[(size_t)(k0 + kk) * 32 + (lane & 31)]; }
    asm volatile("s_waitcnt lgkmcnt(0)" ::: "memory");
#pragma unroll 8
    for (int n = 0; n < 32; ++n) WT[(size_t)n * K + k0 + lane] = scr[lane * 33 + n];
    asm volatile("s_waitcnt lgkmcnt(0)" ::: "memory");
}
__device__ __forceinline__ void rms_row_to_bf16(const float* __restrict__ xrow, const float* __restrict__ g, bf16_t* __restrict__ orow, int lane) {
    const f32x4* xr = (const f32x4*)xrow + lane; const f32x4* gr = (const f32x4*)g + lane;
    f32x4 v[4]; float s = 0.f;
#pragma unroll
    for (int j = 0; j < 4; ++j) { v[j] = NT_LOAD(xr + 64 * j); s += (v[j].x * v[j].x + v[j].y * v[j].y) + (v[j].z * v[j].z + v[j].w * v[j].w); }
    const float r = rsqrtf(wave_sum(s) * (1.f / D) + EPS);
    u32x2* o8 = (u32x2*)orow + lane;
#pragma unroll
    for (int j = 0; j < 4; ++j) { const f32x4 gg = gr[64 * j]; u32x2 w; w.x = pk2(v[j].x * r * gg.x, v[j].y * r * gg.y); w.y = pk2(v[j].z * r * gg.z, v[j].w * r * gg.w); o8[64 * j] = w; }
}
struct SsmGP { float lrdt, lidt, cr, ci; };
__device__ __forceinline__ SsmGP ssm_gp(const Params& P, int g, int p) {
    const float dt = expf(P.in[I_LOGDT][g]);
    const float lr = fminf(P.in[I_LRE][g * SSM_P + p], -1e-4f), li = P.in[I_LIM][g * SSM_P + p];
    const float mag = expf(lr * dt);
    float sn, cs; sincosf(li * dt, &sn, &cs);
    const float ar = mag * cs, ai = mag * sn;
    const float den = lr * lr + li * li, nr = ar - 1.f;
    SsmGP r; r.lrdt = lr * dt; r.lidt = li * dt; r.cr = (nr * lr + ai * li) / den; r.ci = (ai * lr - nr * li) / den;
    return r;
}
__device__ __forceinline__ void ssm_pow(const SsmGP& q, int j, float& pr, float& pi) {
    const float m = expf((float)j * q.lrdt); float sn, cs; sincosf((float)j * q.lidt, &sn, &cs); pr = m * cs; pi = m * sn;
}

#ifndef EXP_DMA_AUX
#define EXP_DMA_AUX 2
#endif
struct ExpItem { const float* W; unsigned char* WT; int N, ldo, kb, nb, sw; };
__device__ __forceinline__ ExpItem exp_item(const Params& P, int it) {
    constexpr int I_E1 = (1024 / 128) * (2048 / 32), I_E2 = (1024 / 128) * (1024 / 32);
    ExpItem x;
    if (it < NE * I_E1) { const int e = it / I_E1, q = it % I_E1; x.W = P.in[I_W1] + (size_t)e * D * 2 * DFF; x.WT = P.ws + WS_W1_T + (size_t)e * 2 * DFF * D; x.N = 2 * DFF; x.ldo = D; x.kb = q / 64; x.nb = q % 64; x.sw = 3; }
    else { const int r = it - NE * I_E1, e = r / I_E2, q = r % I_E2; x.W = P.in[I_W2] + (size_t)e * DFF * D; x.WT = P.ws + WS_W2_T + (size_t)e * D * DFF; x.N = D; x.ldo = DFF; x.kb = q / 32; x.nb = q % 32; x.sw = 0; }
    return x;
}
__device__ __forceinline__ void exp_dma(const ExpItem& x, int lane, LAS unsigned char* buf) {
    const float* src = x.W + (size_t)(128 * x.kb + (lane >> 3)) * x.N + 32 * x.nb;
#pragma unroll
    for (int i = 0; i < 16; ++i) __builtin_amdgcn_global_load_lds((const unsigned*)(src + (size_t)(8 * i) * x.N + ((((lane & 7) ^ (lane >> 3) ^ (i >> 1)) & 7) << 2)), (LAS unsigned*)(buf + i * 1024), 16, 0, EXP_DMA_AUX);
}
#if defined(PROBE_CONV_NOSTORE)
#define g_conv_nostore nostore_
__device__ __forceinline__ void exp_finish_lds(const ExpItem& x, int lane, const LAS unsigned char* buf, bool nostore_ = false) {
#else
__device__ __forceinline__ void exp_finish_lds(const ExpItem& x, int lane, const LAS unsigned char* buf) {
#endif
    const int c = lane & 7;
#pragma unroll
    for (int pass = 0; pass < 4; ++pass) {
        const int n = 8 * pass + (lane >> 3), q0 = (n >> 2) ^ c;
        const int no = n ^ ((((n >> 1) ^ n) & 1) ? x.sw : 0);
        const LAS unsigned char* rb = buf + c * 2048 + ((n & 3) << 2);
        float f[16];
#pragma unroll
        for (int j = 0; j < 16; ++j) f[j] = *(const LAS float*)(rb + j * 128 + (((q0 ^ j) & 7) << 4)) * W8_SCALE;
        const u32x4 o = (u32x4){pk4_fp8(f[0], f[1], f[2], f[3]), pk4_fp8(f[4], f[5], f[6], f[7]), pk4_fp8(f[8], f[9], f[10], f[11]), pk4_fp8(f[12], f[13], f[14], f[15])};
#if defined(PROBE_CONV_NOSTORE)
        if (g_conv_nostore) { asm volatile("" :: "v"(o)); } else
#endif
#if NT_STREAMS && !defined(CONV_ST_DEFAULT)
        __builtin_nontemporal_store(o, (u32x4*)(x.WT + (size_t)(32 * x.nb + no) * x.ldo + 128 * x.kb + 16 * c));
#else
        *(u32x4*)(x.WT + (size_t)(32 * x.nb + no) * x.ldo + 128 * x.kb + 16 * c) = o;
#endif
    }
    asm volatile("s_waitcnt lgkmcnt(0)" ::: "memory");
}
constexpr int EXP_ITEMS = NE * ((1024 / 128) * (2048 / 32) + (1024 / 128) * (1024 / 32));
constexpr int EXP_N_IN = 32, EXP_N_S2 = 20, EXP_N_GLU = 20, EXP_N_M1 = 0;
constexpr int EXP_IN0 = 0, EXP_S20 = 128 * EXP_N_IN, EXP_GLU0 = EXP_S20 + 128 * EXP_N_S2, EXP_ATT0 = EXP_GLU0 + 128 * EXP_N_GLU, EXP_M10 = EXP_ITEMS - 128 * EXP_N_M1;
static_assert((EXP_M10 - EXP_ATT0) % 256 == 0 && EXP_M10 >= NE * (1024 / 128) * (2048 / 32), "item split (the expert-GEMM-1 tail share must be W2 items only)");
__device__ __forceinline__ void expert_convert_slice(const Params& P, LAS unsigned char* lds, int i0, int i1, bool probe_nostore = false) {
    const int tid = opaque_tid(), lane = tid & 63, wave = __builtin_amdgcn_readfirstlane(tid >> 6);
    LAS unsigned char* b0 = lds + wave * 16384;
    for (int it = i0 + wave; it < i1; it += NWAVES) {
        const ExpItem c0 = exp_item(P, it);
        exp_dma(c0, lane, b0);
        asm volatile("s_waitcnt vmcnt(0)" ::: "memory");
#if defined(PROBE_CONV_NOSTORE)
        exp_finish_lds(c0, lane, b0, probe_nostore);
#else
        exp_finish_lds(c0, lane, b0);
#endif
    }
}
__device__ __forceinline__ void p0_prologue(const Params& P, LAS unsigned char* lds, int vcu, int G) {
    const int tid = opaque_tid(), lane = tid & 63, wave = __builtin_amdgcn_readfirstlane(tid >> 6);
    LAS float* scr = (LAS float*)(lds + wave * 16384);
    unsigned char* ws = P.ws;
    const int gw = vcu * NWAVES + wave, NGW = G * NWAVES;
    constexpr int I_IN = (D / 64) * (IN_W / 32);
    constexpr int I_GLU = (512 / 64) * (512 / 32);
    constexpr int I_PS = (512 / 64) * (1024 / 32);
    constexpr int I_PA = (1024 / 64) * (1024 / 32);
    constexpr int I_OUT = I_PA;
    constexpr int I_R = 1024 / 64;
    constexpr int I_E1 = (1024 / 64) * (2048 / 32);
    constexpr int I_E2 = (1024 / 64) * (1024 / 32);
#ifndef EXPERTS_IN_ATTN
#define EXPERTS_IN_ATTN 1
#endif
    constexpr int NITEMS = I_IN + I_GLU + I_PS + I_PA + I_OUT + I_R + (EXPERTS_IN_ATTN ? 0 : NE * I_E1 + NE * I_E2);
    for (int it = gw; it < NITEMS; it += NGW) {
        int r = it;
        if (r < I_IN) { const int nblk = IN_W / 32; p0_transpose_item(P.in[I_WIN], IN_W, (bf16_t*)(ws + WS_WIN_T), D, 0, scr, r / nblk, r % nblk, lane); continue; } r -= I_IN;
        if (r < I_GLU) { const int nblk = 512 / 32; p0_transpose_item(P.in[I_WGLU], 512, (bf16_t*)(ws + WS_WGLU_T), 512, 0, scr, r / nblk, r % nblk, lane); continue; } r -= I_GLU;
        if (r < I_PS) { const int nblk = 1024 / 32; p0_transpose_item(P.in[I_WPS], 1024, (bf16_t*)(ws + WS_WP_T), MA_LD, 1024, scr, r / nblk, r % nblk, lane); continue; } r -= I_PS;
        if (r < I_PA) { const int nblk = 1024 / 32; p0_transpose_item(P.in[I_WPA], 1024, (bf16_t*)(ws + WS_WP_T), MA_LD, 0, scr, r / nblk, r % nblk, lane); continue; } r -= I_PA;
        if (r < I_OUT) { const int nblk = 1024 / 32; p0_transpose_item(P.in[I_WOUT], 1024, (bf16_t*)(ws + WS_WOUT_T), D, 0, scr, r / nblk, r % nblk, lane); continue; } r -= I_OUT;
        if (r < I_R) { p0_transpose_f32_item(P.in[I_WR], (float*)(ws + WS_WR_T), D, scr, r, lane); continue; } r -= I_R;
        if (EXPERTS_IN_ATTN) continue;
        if (r < NE * I_E1) { const int e = r / I_E1, q = r % I_E1, nblk = 2048 / 32;
            p0_transpose_item_fp8(P.in[I_W1] + (size_t)e * D * 2 * DFF, 2 * DFF, ws + WS_W1_T + (size_t)e * 2 * DFF * D, D, scr, q / nblk, q % nblk, lane); continue; } r -= NE * I_E1;
        { const int e = r / I_E2, q = r % I_E2, nblk = 1024 / 32;
            p0_transpose_item_fp8(P.in[I_W2] + (size_t)e * DFF * D, D, ws + WS_W2_T + (size_t)e * D * DFF, DFF, scr, q / nblk, q % nblk, lane); }
    }
#if EXPERTS_IN_ATTN
    if (G != 256) { __syncthreads(); for (int c0 = vcu * 64; c0 < EXP_ATT0; c0 += G * 64) expert_convert_slice(P, lds, c0, min(EXP_ATT0, c0 + 64));
        for (int c0 = EXP_M10 + vcu * 64; c0 < EXP_ITEMS; c0 += G * 64) expert_convert_slice(P, lds, c0, min(EXP_ITEMS, c0 + 64)); __syncthreads(); }
#endif
    for (int m = gw; m < T; m += NGW) rms_row_to_bf16(P.in[I_X] + (size_t)m * D, P.in[I_G1], (bf16_t*)(ws + WS_XN) + (size_t)m * D, lane);
    if (gw == 0) { u32x4* z = (u32x4*)(ws + WS_H2 + (size_t)T * D); z[lane] = (u32x4){0u, 0u, 0u, 0u}; }
    const int gt = vcu * NTHREADS + tid, NGT = G * NTHREADS;
    for (int it = gw; it < SSM_G * CH_L; it += NGW) {
        const int g = it / CH_L, j = it % CH_L, h = lane >> 2, hq = (lane & 3) * 4;
        { const SsmGP q = ssm_gp(P, g, lane); float pr, pi; ssm_pow(q, j, pr, pi); scr[2 * lane] = pr * q.cr - pi * q.ci; scr[2 * lane + 1] = pr * q.ci + pi * q.cr; }
        asm volatile("s_waitcnt lgkmcnt(0)" ::: "memory");
        float a0 = 0.f, a1 = 0.f, a2 = 0.f, a3 = 0.f;
#pragma unroll 4
        for (int p = 0; p < SSM_P; ++p) {
            const float wr = scr[2 * p], wi = scr[2 * p + 1];
            const float cre = P.in[I_CRE][(g * SSM_H + h) * SSM_P + p], cim = P.in[I_CIM][(g * SSM_H + h) * SSM_P + p];
            const float mr = cre * wr - cim * wi, mi = cre * wi + cim * wr;
            const f32x4 br = *(const f32x4*)(P.in[I_BRE] + (g * SSM_P + p) * SSM_H + hq), bi = *(const f32x4*)(P.in[I_BIM] + (g * SSM_P + p) * SSM_H + hq);
            a0 += mr * br.x - mi * bi.x; a1 += mr * br.y - mi * bi.y; a2 += mr * br.z - mi * bi.z; a3 += mr * br.w - mi * bi.w;
        }
        if (j == 0) { const float dsk = P.in[I_DSK][g * SSM_H + h]; if (hq == (h & 12)) { const int w = h & 3; if (w == 0) a0 += dsk; else if (w == 1) a1 += dsk; else if (w == 2) a2 += dsk; else a3 += dsk; } }
        *(f32x4*)((float*)(ws + WS_KJ) + ((size_t)(g * CH_L + j) * SSM_H + h) * SSM_H + hq) = (f32x4){a0, a1, a2, a3};
        asm volatile("s_waitcnt lgkmcnt(0)" ::: "memory");
    }
    for (int it = gt; it < SSM_G * 128 * CH_L; it += NGT) {
        const int s = it % CH_L, n = (it / CH_L) % 128, g = it / (CH_L * 128), p = n & 63, part = n >> 6;
        const SsmGP q = ssm_gp(P, g, p); float pr, pi; ssm_pow(q, CH_L - 1 - s, pr, pi);
        const float wr = pr * q.cr - pi * q.ci, wi = pr * q.ci + pi * q.cr;
        const float* br = P.in[I_BRE] + (g * SSM_P + p) * SSM_H; const float* bi = P.in[I_BIM] + (g * SSM_P + p) * SSM_H;
        unsigned o[8];
#pragma unroll
        for (int h2 = 0; h2 < 8; ++h2) {
            float v0, v1;
            if (part == 0) { v0 = wr * br[2 * h2] - wi * bi[2 * h2]; v1 = wr * br[2 * h2 + 1] - wi * bi[2 * h2 + 1]; }
            else { v0 = wr * bi[2 * h2] + wi * br[2 * h2]; v1 = wr * bi[2 * h2 + 1] + wi * br[2 * h2 + 1]; }
            o[h2] = pk2(v0, v1);
        }
        u32x4* dst = (u32x4*)((bf16_t*)(ws + WS_WS_T) + ((size_t)(g * 128 + n) * 512 + s * 16));
        dst[0] = (u32x4){o[0], o[1], o[2], o[3]}; dst[1] = (u32x4){o[4], o[5], o[6], o[7]};
    }
    for (int it = gt; it < SSM_G * CH_L * SSM_P; it += NGT) {
        const int p = it % SSM_P, t = (it / SSM_P) % CH_L, g = it / (SSM_P * CH_L);
        const SsmGP q = ssm_gp(P, g, p); float pr, pi; ssm_pow(q, t + 1, pr, pi);
        bf16_t* base = (bf16_t*)(ws + WS_BT_SSM) + ((size_t)(g * 512 + t * 16)) * ACAT_LD + 512 + p;
#pragma unroll 4
        for (int h = 0; h < SSM_H; ++h) {
            const float cre = P.in[I_CRE][(g * SSM_H + h) * SSM_P + p], cim = P.in[I_CIM][(g * SSM_H + h) * SSM_P + p];
            base[(size_t)h * ACAT_LD] = (bf16_t)f2bf(cre * pr - cim * pi);
            base[(size_t)h * ACAT_LD + 64] = (bf16_t)f2bf(-(cre * pi + cim * pr));
        }
    }
}
__device__ __forceinline__ void ssm_toeplitz_expand(const Params& P, int vcu, int G) {
    const int gt = vcu * NTHREADS + opaque_tid(), NGT = G * NTHREADS;
    unsigned char* ws = P.ws;
    for (int it = gt; it < SSM_G * 512 * 64; it += NGT) {
        const int kc = it & 63, n = (it >> 6) & 511, g = it >> 15;
        const int s = kc >> 1, hq = (kc & 1) * 8, t = n >> 4, h = n & 15;
        u32x4 o = (u32x4){0u, 0u, 0u, 0u};
        if (s <= t) { const float* kj = (const float*)(ws + WS_KJ) + ((size_t)(g * CH_L + (t - s)) * SSM_H + h) * SSM_H + hq;
            const f32x4 a = *(const f32x4*)kj, b = *(const f32x4*)(kj + 4);
            o.x = pk2(a.x, a.y); o.y = pk2(a.z, a.w); o.z = pk2(b.x, b.y); o.w = pk2(b.z, b.w); }
        *(u32x4*)((bf16_t*)(ws + WS_BT_SSM) + ((size_t)(g * 512 + n)) * ACAT_LD + kc * 8) = o;
    }
}
#ifndef PG_WGM
#define PG_WGM 8
#endif
namespace pg {
constexpr int BM = 256, BK = 64, HALF = 128, HTB = HALF * BK * 2, STAGE_BYTES = 8 * HTB;
__host__ __device__ __forceinline__ int lds_byte(int r, int c) { const int st = (r >> 4) * 2 + (c >> 5), rr = r & 15, cc = c & 31, ob = rr * 64 + cc * 2; return st * 1024 + (ob ^ (((ob >> 9) & 1) << 5)); }
__host__ __device__ __forceinline__ void stage_rc(int b, int& R, int& C) { const int st = b / 1024, sb = b % 1024, swz = sb ^ (((sb >> 9) & 1) << 5); R = (st >> 1) * 16 + swz / 64; C = (st & 1) * 32 + (swz % 64) / 2; }
__host__ __device__ __forceinline__ int perm32(int rho) { const int n = rho >> 4, i = rho & 15; return 8 * (i >> 2) + 4 * n + (i & 3); }

struct Unit {
    const char* A;
    const char* B;
    unsigned aoff[2][2];
    int pm, pn, aux, aux2;
    int ord;
};
struct EpiInfo { int pm, pn, aux, aux2, ord; };
typedef f32x4 Acc[2][2][4][2];

typedef int v8i_t __attribute__((ext_vector_type(8)));
typedef int v4i_t __attribute__((ext_vector_type(4)));
template <bool FP8 = false, int BAUX = 0  , class Sched, class Epi>
__device__ __forceinline__ void gemm_phase(LAS unsigned char* lds, const Sched& S, const Epi& E, const int nt, const int ldb, const int ktm = -1  ) {
    const int tid = opaque_tid(), wid = __builtin_amdgcn_readfirstlane(tid >> 6), lane = tid & 63, wr = wid >> 2, wc = wid & 3, fr = lane & 15, fq = lane >> 4;
    unsigned voffB[2];
#pragma unroll
    for (int i = 0; i < 2; ++i) { int R, C; stage_rc(tid * 16 + i * 8192, R, C); voffB[i] = (unsigned)((64 * (R >> 5) + perm32(R & 31)) * ldb + C) * 2u; }
    const unsigned hB = (unsigned)(32 * ldb * 2);
    const unsigned ldsw = (unsigned)wid * 1024u;
    const int aoffl = lds_byte(wr * 64 + fr, fq * 8), boffl = lds_byte(wc * 32 + fr, fq * 8);
#define PG_SA(b, h) (((b) * 2 + (h)) * pg::HTB)
#define PG_SB(b, h) ((4 + (b) * 2 + (h)) * pg::HTB)
#define PG_GLDS(gp, bufoff, i) __builtin_amdgcn_global_load_lds((const unsigned*)(gp), (LAS unsigned*)(lds + (bufoff) + ldsw + (i) * 8192), 16, 0, 0)
#define PG_STAGE_A(bufoff, Ab, o0, o1, kt) do { const char* _b = (Ab) + (size_t)((kt) & ktm) * 128; PG_GLDS(_b + (o0), bufoff, 0); PG_GLDS(_b + (o1), bufoff, 1); } while (0)
#define PG_GLDSB(gp, bufoff, i) __builtin_amdgcn_global_load_lds((const unsigned*)(gp), (LAS unsigned*)(lds + (bufoff) + ldsw + (i) * 8192), 16, 0, BAUX)
#define PG_STAGE_B(bufoff, Bb, h, kt) do { const char* _b = (Bb) + (size_t)((kt) & ktm) * 128 + (h) * hB; PG_GLDSB(_b + voffB[0], bufoff, 0); PG_GLDSB(_b + voffB[1], bufoff, 1); } while (0)
#define PG_LDA(dst, b, h) do { _Pragma("unroll") for (int m = 0; m < 4; ++m) _Pragma("unroll") for (int k = 0; k < 2; ++k) dst[m][k] = *(const LAS bf16x8*)(lds + PG_SA(b, h) + aoffl + m * 2048 + k * 1024); } while (0)
#define PG_LDB(dst, b, h) do { _Pragma("unroll") for (int n = 0; n < 2; ++n) _Pragma("unroll") for (int k = 0; k < 2; ++k) dst[n][k] = *(const LAS bf16x8*)(lds + PG_SB(b, h) + boffl + n * 2048 + k * 1024); } while (0)
#define PG_CAT8(lo, hi) __builtin_shufflevector(__builtin_bit_cast(v4i_t, lo), __builtin_bit_cast(v4i_t, hi), 0, 1, 2, 3, 4, 5, 6, 7)
#define PG_MMA(ai, bj, At, Bt) do { __builtin_amdgcn_s_setprio(1); if constexpr (FP8) { _Pragma("unroll") for (int m = 0; m < 4; ++m) _Pragma("unroll") for (int n = 0; n < 2; ++n) \
            acc[ai][bj][m][n] = __builtin_amdgcn_mfma_scale_f32_16x16x128_f8f6f4(PG_CAT8(Bt[n][0], Bt[n][1]), PG_CAT8(At[m][0], At[m][1]), acc[ai][bj][m][n], 0, 0, 0, 0x79797979, 0, 0x7f7f7f7f); } \
        else { _Pragma("unroll") for (int m = 0; m < 4; ++m) _Pragma("unroll") for (int n = 0; n < 2; ++n) _Pragma("unroll") for (int k = 0; k < 2; ++k) \
        acc[ai][bj][m][n] = __builtin_amdgcn_mfma_f32_16x16x32_bf16(Bt[n][k], At[m][k], acc[ai][bj][m][n], 0, 0, 0); } __builtin_amdgcn_s_setprio(0); } while (0)
#define PG_WAIT_V(n) asm volatile("s_waitcnt vmcnt(" #n ")" ::: "memory")
#define PG_WAIT_L(n) asm volatile("s_waitcnt lgkmcnt(" #n ")" ::: "memory")
#define PG_BAR __builtin_amdgcn_s_barrier()
#define PG_SCHED __builtin_amdgcn_sched_barrier(0)
#define PG_KLOOP(T0, T1) _Pragma("clang loop unroll(disable)") for (int t = (T0); t < (T1); t += 2) { \
            const bool last = (t == nt - 2); \
            PG_LDB(B0, 0, 0); PG_LDB(B1, 0, 1); PG_SCHED; PG_LDA(At, 0, 0); PG_STAGE_A(PG_SA(1, 1), st.A, st.aoff[1][0], st.aoff[1][1], t + 1); \
            if (last) { Unit nu_; has_next = S.next(ui + 1, nu_); if (has_next) { st = nu_; } } \
            const int k2 = last ? 0 : t + 2, k3 = k2 + 1; \
            PG_WAIT_V(8); PG_WAIT_L(0); PG_BAR; PG_MMA(0, 0, At, B0); PG_MMA(0, 1, At, B1); PG_BAR; PG_SCHED; \
            PG_LDA(At, 0, 1); PG_STAGE_B(PG_SB(0, 0), st.B, 0, k2); PG_STAGE_B(PG_SB(0, 1), st.B, 1, k2); PG_STAGE_A(PG_SA(0, 0), st.A, st.aoff[0][0], st.aoff[0][1], k2); \
            PG_WAIT_V(8); PG_WAIT_L(0); PG_BAR; PG_MMA(1, 0, At, B0); PG_MMA(1, 1, At, B1); PG_BAR; PG_SCHED; \
            PG_LDB(B0, 1, 0); PG_LDB(B1, 1, 1); PG_SCHED; PG_LDA(At, 1, 0); PG_STAGE_A(PG_SA(0, 1), st.A, st.aoff[1][0], st.aoff[1][1], k2); \
            PG_WAIT_V(8); PG_WAIT_L(0); PG_BAR; PG_MMA(0, 0, At, B0); PG_MMA(0, 1, At, B1); PG_BAR; PG_SCHED; \
            PG_LDA(At, 1, 1); PG_STAGE_B(PG_SB(1, 0), st.B, 0, k3); PG_STAGE_B(PG_SB(1, 1), st.B, 1, k3); PG_STAGE_A(PG_SA(1, 0), st.A, st.aoff[0][0], st.aoff[0][1], k3); \
            PG_WAIT_V(8); PG_WAIT_L(0); PG_BAR; PG_MMA(1, 0, At, B0); PG_MMA(1, 1, At, B1); PG_BAR; PG_SCHED; \
        }
    Unit st; int ui = 0;
    if (!S.next(0, st)) return;
    EpiInfo cur; cur.pm = st.pm; cur.pn = st.pn; cur.aux = st.aux; cur.aux2 = st.aux2; cur.ord = st.ord;
    Acc acc;
#pragma unroll
    for (int a = 0; a < 2; ++a)
#pragma unroll
        for (int b = 0; b < 2; ++b)
#pragma unroll
            for (int m = 0; m < 4; ++m)
#pragma unroll
                for (int n = 0; n < 2; ++n) acc[a][b][m][n] = (f32x4){0.f, 0.f, 0.f, 0.f};
    bf16x8 At[4][2], B0[2][2], B1[2][2];
    PG_STAGE_B(PG_SB(0, 0), st.B, 0, 0); PG_STAGE_B(PG_SB(0, 1), st.B, 1, 0); PG_STAGE_A(PG_SA(0, 0), st.A, st.aoff[0][0], st.aoff[0][1], 0); PG_STAGE_A(PG_SA(0, 1), st.A, st.aoff[1][0], st.aoff[1][1], 0);
    if (wr == 1) PG_BAR;
    PG_WAIT_V(2); PG_BAR;
    PG_STAGE_B(PG_SB(1, 0), st.B, 0, 1); PG_STAGE_A(PG_SA(1, 0), st.A, st.aoff[0][0], st.aoff[0][1], 1); PG_STAGE_B(PG_SB(1, 1), st.B, 1, 1);
    PG_WAIT_V(6); PG_BAR;
    for (;;) {
        bool has_next = false;
        if constexpr (Epi::HAS_MID) { PG_KLOOP(0, Epi::MID_T) E.mid(acc, cur, wr, wc, fr, fq); PG_KLOOP(Epi::MID_T, nt) } else { PG_KLOOP(0, nt) }
        if (wr == 0) PG_BAR;
        E(acc, cur, wr, wc, fr, fq);
        if (!has_next) break;
#pragma unroll
        for (int a = 0; a < 2; ++a)
#pragma unroll
            for (int b = 0; b < 2; ++b)
#pragma unroll
                for (int m = 0; m < 4; ++m)
#pragma unroll
                    for (int n = 0; n < 2; ++n) acc[a][b][m][n] = (f32x4){0.f, 0.f, 0.f, 0.f};
        cur.pm = st.pm; cur.pn = st.pn; cur.aux = st.aux; cur.aux2 = st.aux2; cur.ord = st.ord; ++ui;
        if (wr == 1) PG_BAR;
    }
    PG_WAIT_V(0);
    PG_BAR;
#undef PG_SA
#undef PG_SB
#undef PG_GLDS
#undef PG_GLDSB
#undef PG_STAGE_A
#undef PG_STAGE_B
#undef PG_LDA
#undef PG_LDB
#undef PG_MMA
#undef PG_WAIT_V
#undef PG_WAIT_L
#undef PG_BAR
#undef PG_SCHED
#undef PG_KLOOP
}

struct LaneRC { int R[2], C[2]; __device__ __forceinline__ LaneRC() { const int t = opaque_tid(); stage_rc(t * 16, R[0], C[0]); stage_rc(t * 16 + 8192, R[1], C[1]); } };

struct DenseSched {
    const bf16_t* A; const bf16_t* Bt; int lda, ldb, nM, nN, nwg, G, c;
    __device__ __forceinline__ void init(const bf16_t* A_, int lda_, const bf16_t* Bt_, int ldb_, int M, int N, int G_, int c_) { A = A_; Bt = Bt_; lda = lda_; ldb = ldb_; nM = M / BM; nN = N / BM; nwg = nM * nN; G = G_; c = c_; }
    __device__ __forceinline__ bool next(int i, Unit& u) const {
        const long L = (long)i * G + c; if (L >= nwg) return false;
        int wgid = (int)L; { const int q = nwg / 8, r = nwg % 8, xcd = wgid % 8, off = wgid / 8; wgid = (xcd < r ? xcd * (q + 1) : r * (q + 1) + (xcd - r) * q) + off; }
        const int WGM = PG_WGM, nig = WGM * nN, gid = wgid / nig, fm = gid * WGM, gsz = (nM - fm) < WGM ? (nM - fm) : WGM;
        u.pm = fm + ((wgid % nig) % gsz); u.pn = (wgid % nig) / gsz; u.aux = 0; u.aux2 = 0; u.ord = i;
        u.A = (const char*)A; u.B = (const char*)(Bt + (size_t)u.pn * BM * ldb); const LaneRC rc;
#pragma unroll
        for (int h = 0; h < 2; ++h)
#pragma unroll
            for (int j = 0; j < 2; ++j) u.aoff[h][j] = (unsigned)(((u.pm * BM + 128 * h + rc.R[j]) * lda + rc.C[j]) * 2);
        return true;
    }
};
}
namespace pg {
constexpr int TAB_OFF = RING_BYTES + 1024;
__device__ __forceinline__ void moe_build_tab(LAS unsigned char* lds, const unsigned* cnt) {
    LAS int* tab = (LAS int*)(lds + TAB_OFF);
    if (threadIdx.x == 0) { int acc = 0; for (int e = 0; e < NE; ++e) { const int n = (int)__hip_atomic_load(cnt + e, __ATOMIC_RELAXED, __HIP_MEMORY_SCOPE_AGENT); tab[e] = acc; tab[40 + e] = n; acc += (n + 255) >> 8; } tab[NE] = acc; }
    __syncthreads();
}
#ifndef MOE_MAXU_OVERRIDE
#define MOE_MAXU_OVERRIDE 9
#endif
constexpr int MOE_MAXU = MOE_MAXU_OVERRIDE;
constexpr int UT_OFF = RING_BYTES + 1536;
constexpr int UB_OFF = UT_OFF + MOE_MAXU * 512;
static_assert(UB_OFF + MOE_MAXU * 1024 <= LDS_BYTES, "LDS map");
template <int KIND>
struct MoeSched {
    static constexpr int NPN = KIND == 1 ? 8 : 4;
    unsigned char* ws; const LAS int* tab; LAS unsigned char* lds; int G, c; bool freeze = false;
    __device__ __forceinline__ bool unit(int i, int& e, int& rb, int& pn) const {
        const int x = c & 7, j = c >> 3, NJ = G >> 3;
        int L = i * NJ + j; e = -1; rb = 0; pn = 0;
#pragma unroll
        for (int q = 0; q < NE / 8; ++q) { const int eq = x + 8 * q, uq = (tab[eq + 1] - tab[eq]) * NPN;
            if (e < 0) { if (L < uq) { e = eq; rb = L / NPN; pn = L % NPN; } else L -= uq; } }
        if (e < 0) return false;
        e = __builtin_amdgcn_readfirstlane(e); rb = __builtin_amdgcn_readfirstlane(rb); pn = __builtin_amdgcn_readfirstlane(pn);
        return true;
    }
    __device__ __forceinline__ void init(unsigned char* ws_, LAS unsigned char* lds_, int G_, int c_, const float* bias) {
        ws = ws_; lds = lds_; tab = (const LAS int*)(lds_ + TAB_OFF); G = G_; c = c_;
        const int tid = opaque_tid();
        for (int i = 0; i < MOE_MAXU; ++i) { int e, rb, pn; if (!unit(i, e, rb, pn)) break;
            if (tid < 256) { if (KIND == 1) { const int nvalid = min(256, tab[40 + e] - rb * 256); const int tok = tid < nvalid ? ((const int*)(ws + WS_SLOT_TOK))[(size_t)e * CAP + rb * 256 + tid] : T;
                    ((LAS unsigned short*)(lds + UT_OFF))[i * 256 + tid] = (unsigned short)tok; } }
            else ((LAS float*)(lds + UB_OFF))[i * 256 + tid - 256] = bias[(size_t)e * (NPN * 256) + pn * 256 + tid - 256]; }
        __syncthreads();
    }
    __device__ __forceinline__ bool next(int i, Unit& u) const {
        int e, rb, pn; if (!unit(i, e, rb, pn)) return false;
#if defined(PROBE_FREEZE)
        if (freeze) { int e0, r0, p0; unit(0, e0, r0, p0); e = e0; rb = r0; pn = p0; }
#endif
        const int blk = tab[e] + rb, nvalid = min(256, tab[40 + e] - rb * 256);
        u.pm = rb; u.pn = pn; u.aux = e; u.ord = i; const LaneRC rc;
        if (KIND == 1) {
            u.aux2 = blk; u.A = (const char*)(ws + WS_H2); u.B = (const char*)(ws + WS_W1_T + ((size_t)e * 2 * DFF + (size_t)pn * BM) * D);
#pragma unroll
            for (int h = 0; h < 2; ++h)
#pragma unroll
                for (int jj = 0; jj < 2; ++jj) { const int r = 128 * h + rc.R[jj]; int tok;
                    if (i < MOE_MAXU) tok = ((const LAS unsigned short*)(lds + UT_OFF))[i * 256 + r];
                    else { tok = r < nvalid ? ((const int*)(ws + WS_SLOT_TOK))[(size_t)e * CAP + rb * 256 + r] : T; __builtin_amdgcn_s_waitcnt(0x0F70); }
                    u.aoff[h][jj] = (unsigned)(tok * D + rc.C[jj] * 2); }
        } else {
            u.aux2 = blk | (nvalid << 16); u.A = (const char*)(ws + WS_ACT); u.B = (const char*)(ws + WS_W2_T + ((size_t)e * D + (size_t)pn * BM) * DFF);
#pragma unroll
            for (int h = 0; h < 2; ++h)
#pragma unroll
                for (int jj = 0; jj < 2; ++jj) u.aoff[h][jj] = (unsigned)((blk * 256 + 128 * h + rc.R[jj]) * DFF + rc.C[jj] * 2);
        }
        return true;
    }
};
}
namespace pg {
struct EpiBase { static constexpr bool HAS_MID = false; static constexpr int MID_T = -1; __device__ __forceinline__ void mid(Acc&, const EpiInfo&, int, int, int, int) const {} };
__device__ __forceinline__ u32x4 pack8(const f32x4 a, const f32x4 b) { u32x4 w; w.x = pk2(a[0], a[1]); w.y = pk2(a[2], a[3]); w.z = pk2(b[0], b[1]); w.w = pk2(b[2], b[3]); return w; }
__device__ __forceinline__ void unpack8(const u32x4 w, f32x4& a, f32x4& b) { a = (f32x4){bflo(w.x), bfhi(w.x), bflo(w.y), bfhi(w.y)}; b = (f32x4){bflo(w.z), bfhi(w.z), bflo(w.w), bfhi(w.w)}; }

struct EpiNull : EpiBase {
    __device__ __forceinline__ void operator()(Acc& acc, const EpiInfo&, int, int, int, int) const {
#pragma unroll
        for (int a = 0; a < 2; ++a)
#pragma unroll
            for (int b = 0; b < 2; ++b)
#pragma unroll
                for (int m = 0; m < 4; ++m)
#pragma unroll
                    for (int n = 0; n < 2; ++n) asm volatile("" :: "v"(acc[a][b][m][n]));
    }
};
struct EpiInProj : EpiBase {
    unsigned char* ws; const float* qg; const float* kg;
    __device__ __forceinline__ void operator()(Acc& acc, const EpiInfo& u, int wr, int wc, int fr, int fq) const {
        const int pn = u.pn, row0 = u.pm * BM + wr * 64 + fr, colw = 64 * wc + 8 * fq;
        if (pn < 2) {
            bf16_t* acat = (bf16_t*)(ws + WS_ACAT);
#pragma unroll
            for (int ai = 0; ai < 2; ++ai)
#pragma unroll
                for (int m = 0; m < 4; ++m) { const int tok = row0 + ai * 128 + m * 16;
#pragma unroll
                    for (int bj = 0; bj < 2; ++bj) { const int cu = pn * 256 + colw + 32 * bj, g = cu >> 4, h0 = cu & 15;
                        *(u32x4*)(acat + ((size_t)(g * ACAT_ROWS + (tok >> 5))) * ACAT_LD + (tok & 31) * 16 + h0) = pack8(acc[ai][bj][m][0], acc[ai][bj][m][1]); } }
        } else if (pn < 10) {
            const bool isq = pn < 6; const float* gain = isq ? qg : kg; const float sc = isq ? QC2 : 1.f;
            bf16_t* dst = (bf16_t*)(ws + (isq ? WS_Q : WS_K)) + (size_t)(pn - (isq ? 2 : 6)) * 256 + colw;
            f32x4 gv[2][2];
#pragma unroll
            for (int bj = 0; bj < 2; ++bj)
#pragma unroll
                for (int n = 0; n < 2; ++n) gv[bj][n] = *(const f32x4*)(gain + 32 * bj + 8 * fq + 4 * n);
#pragma unroll
            for (int ai = 0; ai < 2; ++ai)
#pragma unroll
                for (int m = 0; m < 4; ++m) { const int tok = row0 + ai * 128 + m * 16; float ss = 0.f;
#pragma unroll
                    for (int bj = 0; bj < 2; ++bj)
#pragma unroll
                        for (int n = 0; n < 2; ++n) { const f32x4 v = acc[ai][bj][m][n]; ss += (v[0] * v[0] + v[1] * v[1]) + (v[2] * v[2] + v[3] * v[3]); }
                    ss += __shfl_xor(ss, 16); ss += __shfl_xor(ss, 32);
                    const float r = rsqrtf(ss * (1.f / 64.f) + EPS) * sc;
#pragma unroll
                    for (int bj = 0; bj < 2; ++bj) store16(dst + (size_t)tok * D + 32 * bj, pack8(acc[ai][bj][m][0] * r * gv[bj][0], acc[ai][bj][m][1] * r * gv[bj][1])); }
        } else {
            const size_t base = pn < 14 ? WS_V : (pn < 18 ? WS_GS : WS_GA); const int t0 = pn < 14 ? 10 : (pn < 18 ? 14 : 18); const bool ntst = pn >= 14;
            bf16_t* dst = (bf16_t*)(ws + base) + (size_t)(pn - t0) * 256 + colw;
#pragma unroll
            for (int ai = 0; ai < 2; ++ai)
#pragma unroll
                for (int m = 0; m < 4; ++m) { const int tok = row0 + ai * 128 + m * 16;
#pragma unroll
                    for (int bj = 0; bj < 2; ++bj) { const u32x4 w = pack8(acc[ai][bj][m][0], acc[ai][bj][m][1]); if (ntst) NT_STORE(w, (u32x4*)(dst + (size_t)tok * D + 32 * bj)); else store16(dst + (size_t)tok * D + 32 * bj, w); } }
        }
    }
};
struct EpiSsm2 : EpiBase {
    unsigned char* ws;
    __device__ __forceinline__ void operator()(Acc& acc, const EpiInfo& u, int wr, int wc, int fr, int fq) const {
        bf16_t* Z = (bf16_t*)(ws + WS_Z); const int g = u.aux;
#pragma unroll
        for (int ai = 0; ai < 2; ++ai)
#pragma unroll
            for (int m = 0; m < 4; ++m) { const int r = u.pm * BM + ai * 128 + wr * 64 + m * 16 + fr, b = r >> 6, c = r & 63;
#pragma unroll
                for (int bj = 0; bj < 2; ++bj) { const int n_ = u.pn * 256 + 64 * wc + 32 * bj + 8 * fq, t = n_ >> 4, h0 = n_ & 15; const int tok = b * SEQ + c * CH_L + t;
                    f32x4 a = acc[ai][bj][m][0], bb = acc[ai][bj][m][1];
#pragma unroll
                    for (int q = 0; q < 4; ++q) { a[q] = gelu_tanh(a[q]); bb[q] = gelu_tanh(bb[q]); }
                    *(u32x4*)(Z + (size_t)tok * SSM_W + 16 * g + h0) = pack8(a, bb); } }
    }
};
struct EpiGlu : EpiBase {
    unsigned char* ws; const float* bglu;
    __device__ __forceinline__ void operator()(Acc& acc, const EpiInfo& u, int wr, int wc, int fr, int fq) const {
        asm volatile("" : "+v"(fr), "+v"(fq));
        const bf16_t* Z = (const bf16_t*)(ws + WS_Z); bf16_t* MA = (bf16_t*)(ws + WS_MA);
        const int col0 = u.pn * 256 + 64 * wc + 8 * fq;
        f32x4 cb[2][2];
#pragma unroll
        for (int bj = 0; bj < 2; ++bj) { cb[bj][0] = *(const f32x4*)(bglu + col0 + 32 * bj); cb[bj][1] = *(const f32x4*)(bglu + col0 + 32 * bj + 4); }
#pragma unroll
        for (int ai = 0; ai < 2; ++ai) { u32x4 zz[4][2];
#pragma unroll
            for (int m = 0; m < 4; ++m) { const int tok = u.pm * BM + ai * 128 + wr * 64 + m * 16 + fr;
#pragma unroll
                for (int bj = 0; bj < 2; ++bj) zz[m][bj] = *(const u32x4*)(Z + (size_t)tok * SSM_W + col0 + 32 * bj); }
            asm volatile("" ::: "memory");
#pragma unroll
            for (int m = 0; m < 4; ++m) { const int tok = u.pm * BM + ai * 128 + wr * 64 + m * 16 + fr;
#pragma unroll
                for (int bj = 0; bj < 2; ++bj) { f32x4 z0, z1; unpack8(zz[m][bj], z0, z1);
                    f32x4 a = acc[ai][bj][m][0] + cb[bj][0], bb = acc[ai][bj][m][1] + cb[bj][1];
#pragma unroll
                    for (int q = 0; q < 4; ++q) { a[q] = z0[q] * sigmoid_f(a[q]); bb[q] = z1[q] * sigmoid_f(bb[q]); }
                    *(u32x4*)(MA + (size_t)tok * MA_LD + 1024 + col0 + 32 * bj) = pack8(a, bb); } }
            asm volatile("" ::: "memory"); }
    }
};
struct EpiMerged : EpiBase {
    static constexpr bool HAS_MID = true; static constexpr int MID_T = 16;
    unsigned char* ws;
    __device__ __forceinline__ float ratio(float a, float s) const { a = fminf(fmaxf(a, -30.f), 30.f); s = fminf(fmaxf(s, -30.f), 30.f); return (1.f + __expf(-s)) * __builtin_amdgcn_rcpf(1.f + __expf(-a)); }
    __device__ __forceinline__ void mid(Acc& acc, const EpiInfo& u, int wr, int wc, int fr, int fq) const {
        asm volatile("" : "+v"(fr), "+v"(fq));
        const bf16_t* GS = (const bf16_t*)(ws + WS_GS); const bf16_t* GA = (const bf16_t*)(ws + WS_GA);
        const int col0 = u.pn * 256 + 64 * wc + 8 * fq;
#pragma unroll
        for (int ai = 0; ai < 2; ++ai)
#pragma unroll
            for (int mp = 0; mp < 2; ++mp) { u32x4 gs_[2][2], ga_[2][2];
#pragma unroll
                for (int mm = 0; mm < 2; ++mm) { const int tok = u.pm * BM + ai * 128 + wr * 64 + (2 * mp + mm) * 16 + fr;
#pragma unroll
                    for (int bj = 0; bj < 2; ++bj) { gs_[mm][bj] = *(const u32x4*)(GS + (size_t)tok * D + col0 + 32 * bj); ga_[mm][bj] = *(const u32x4*)(GA + (size_t)tok * D + col0 + 32 * bj); } }
#pragma unroll
                for (int mm = 0; mm < 2; ++mm)
#pragma unroll
                    for (int bj = 0; bj < 2; ++bj) { const int m = 2 * mp + mm; const u32x4 ws_ = gs_[mm][bj], wa_ = ga_[mm][bj];
                        acc[ai][bj][m][0][0] *= ratio(bflo(wa_.x), bflo(ws_.x)); acc[ai][bj][m][0][1] *= ratio(bfhi(wa_.x), bfhi(ws_.x));
                        acc[ai][bj][m][0][2] *= ratio(bflo(wa_.y), bflo(ws_.y)); acc[ai][bj][m][0][3] *= ratio(bfhi(wa_.y), bfhi(ws_.y));
                        acc[ai][bj][m][1][0] *= ratio(bflo(wa_.z), bflo(ws_.z)); acc[ai][bj][m][1][1] *= ratio(bfhi(wa_.z), bfhi(ws_.z));
                        acc[ai][bj][m][1][2] *= ratio(bflo(wa_.w), bflo(ws_.w)); acc[ai][bj][m][1][3] *= ratio(bfhi(wa_.w), bfhi(ws_.w)); }
                asm volatile("" ::: "memory"); }
    }
    __device__ __forceinline__ void operator()(Acc& acc, const EpiInfo& u, int wr, int wc, int fr, int fq) const {
        asm volatile("" : "+v"(fr), "+v"(fq));
        const bf16_t* GS = (const bf16_t*)(ws + WS_GS); bf16_t* O = (bf16_t*)(ws + WS_MERGED);
        const int col0 = u.pn * 256 + 64 * wc + 8 * fq;
#pragma unroll
        for (int ai = 0; ai < 2; ++ai) { u32x4 gs_[4][2];
#pragma unroll
            for (int m = 0; m < 4; ++m) { const int tok = u.pm * BM + ai * 128 + wr * 64 + m * 16 + fr;
#pragma unroll
                for (int bj = 0; bj < 2; ++bj) gs_[m][bj] = *(const u32x4*)(GS + (size_t)tok * D + col0 + 32 * bj); }
#pragma unroll
            for (int m = 0; m < 4; ++m) { const int tok = u.pm * BM + ai * 128 + wr * 64 + m * 16 + fr;
#pragma unroll
                for (int bj = 0; bj < 2; ++bj) { f32x4 s0, s1; unpack8(gs_[m][bj], s0, s1);
                    f32x4 a = acc[ai][bj][m][0], bb = acc[ai][bj][m][1];
#pragma unroll
                    for (int q = 0; q < 4; ++q) { a[q] *= sigmoid_c(s0[q]); bb[q] *= sigmoid_c(s1[q]); }
                    *(u32x4*)(O + (size_t)tok * D + col0 + 32 * bj) = pack8(a, bb); } }
            asm volatile("" ::: "memory"); }
    }
};
struct EpiWout : EpiBase {
    const float* x; float* out;
    __device__ __forceinline__ void operator()(Acc& acc, const EpiInfo& u, int wr, int wc, int fr, int fq) const {
        asm volatile("" : "+v"(fr), "+v"(fq));
        const int col0 = u.pn * 256 + 64 * wc + 8 * fq;
#pragma unroll
        for (int ai = 0; ai < 2; ++ai)
#pragma unroll
            for (int mp = 0; mp < 2; ++mp) { f32x4 xv[2][2][2];
#pragma unroll
                for (int mm = 0; mm < 2; ++mm) { const int tok = u.pm * BM + ai * 128 + wr * 64 + (2 * mp + mm) * 16 + fr;
#pragma unroll
                    for (int bj = 0; bj < 2; ++bj) { const size_t o = (size_t)tok * D + col0 + 32 * bj; xv[mm][bj][0] = NT_LOAD((const f32x4*)(x + o)); xv[mm][bj][1] = NT_LOAD((const f32x4*)(x + o + 4)); } }
                asm volatile("" ::: "memory");
#pragma unroll
                for (int mm = 0; mm < 2; ++mm) { const int m = 2 * mp + mm, tok = u.pm * BM + ai * 128 + wr * 64 + m * 16 + fr;
#pragma unroll
                    for (int bj = 0; bj < 2; ++bj) { const size_t o = (size_t)tok * D + col0 + 32 * bj;
                        *(f32x4*)(out + o) = xv[mm][bj][0] + acc[ai][bj][m][0]; *(f32x4*)(out + o + 4) = xv[mm][bj][1] + acc[ai][bj][m][1]; } }
                asm volatile("" ::: "memory"); }
    }
};
struct EpiMoe1 : EpiBase {
    unsigned char* ws; const float* b1; LAS unsigned char* lds; bool nostore = false;
    __device__ __forceinline__ void operator()(Acc& acc, const EpiInfo& u, int wr, int wc, int fr, int fq) const {
        asm volatile("" : "+v"(fr), "+v"(fq));
        unsigned char* ACT = ws + WS_ACT; const int e = u.aux, blk = u.aux2;
        f32x4 cb[2][2];
#pragma unroll
        for (int bj = 0; bj < 2; ++bj) { const int cl = 64 * wc + 32 * bj + 8 * fq; f32x4 r0, r1;
            if (u.ord < MOE_MAXU) { const LAS float* bl = (const LAS float*)(lds + UB_OFF) + u.ord * 256 + cl; r0 = *(const LAS f32x4*)bl; r1 = *(const LAS f32x4*)(bl + 4); }
            else { const float* bg = b1 + (size_t)e * 2 * DFF + u.pn * 256 + cl; r0 = *(const f32x4*)bg; r1 = *(const f32x4*)(bg + 4); __builtin_amdgcn_s_waitcnt(0x0F70); }
            cb[bj][0] = __builtin_shufflevector(r0, r0, 0, 2, 1, 3); cb[bj][1] = __builtin_shufflevector(r1, r1, 0, 2, 1, 3); }
        const f32x2 c7 = {7.f, 7.f}, one = {1.f, 1.f}, cexp = {-1.702f * 1.4426950408889634f, -1.702f * 1.4426950408889634f};
#pragma unroll
        for (int ai = 0; ai < 2; ++ai)
#pragma unroll
            for (int m = 0; m < 4; ++m) { const int row = ai * 128 + wr * 64 + m * 16 + fr; unsigned w[2];
#pragma unroll
                for (int bj = 0; bj < 2; ++bj) { f32x2 r[2];
#pragma unroll
                    for (int n = 0; n < 2; ++n) { const f32x4 h = acc[ai][bj][m][n] + cb[bj][n];
                        f32x2 g = {fminf(h[0], 7.f), fminf(h[1], 7.f)}; const f32x2 up = {fminf(fmaxf(h[2], -7.f), 7.f), fminf(fmaxf(h[3], -7.f), 7.f)};
                        const f32x2 x = g * cexp; f32x2 ex = {__builtin_amdgcn_exp2f(x[0]), __builtin_amdgcn_exp2f(x[1])};
                        ex = ex + one; const f32x2 s = {__builtin_amdgcn_rcpf(ex[0]), __builtin_amdgcn_rcpf(ex[1])};
                        r[n] = (up * g + g) * s; }
                    w[bj] = pk4_fp8(r[0][0], r[0][1], r[1][0], r[1][1]); }
                unsigned char* rowp = ACT + ((size_t)blk * 256 + row) * DFF + ((u.pn * 256 + 64 * wc + 8 * fq) >> 1);
#if defined(PROBE_NOSTORE)
                if (nostore) { asm volatile("" :: "v"(w[0]), "v"(w[1])); } else
#endif
                { *(unsigned*)rowp = w[0]; *(unsigned*)(rowp + 16) = w[1]; } }
        (void)c7;
    }
};
struct EpiMoe2 : EpiBase {
    unsigned char* ws; const float* b2; LAS unsigned char* lds; bool nostore = false;
    __device__ __forceinline__ void operator()(Acc& acc, const EpiInfo& u, int wr, int wc, int fr, int fq) const {
        asm volatile("" : "+v"(fr), "+v"(fq));
        bf16_t* Y = (bf16_t*)(ws + WS_Y); const int e = u.aux, blk = u.aux2 & 0xffff;
        f32x4 cb[2][2];
#pragma unroll
        for (int bj = 0; bj < 2; ++bj) { const int cl = 64 * wc + 32 * bj + 8 * fq;
            if (u.ord < MOE_MAXU) { const LAS float* bl = (const LAS float*)(lds + UB_OFF) + u.ord * 256 + cl; cb[bj][0] = *(const LAS f32x4*)bl; cb[bj][1] = *(const LAS f32x4*)(bl + 4); }
            else { const float* bg = b2 + (size_t)e * D + u.pn * 256 + cl; cb[bj][0] = *(const f32x4*)bg; cb[bj][1] = *(const f32x4*)(bg + 4); __builtin_amdgcn_s_waitcnt(0x0F70); } }
#pragma unroll
        for (int ai = 0; ai < 2; ++ai)
#pragma unroll
            for (int m = 0; m < 4; ++m) { const int row = ai * 128 + wr * 64 + m * 16 + fr;
#pragma unroll
                for (int bj = 0; bj < 2; ++bj) { const int col = u.pn * 256 + 64 * wc + 32 * bj + 8 * fq;
                    const u32x4 w = pack8(acc[ai][bj][m][0] + cb[bj][0], acc[ai][bj][m][1] + cb[bj][1]);
#if defined(PROBE_NOSTORE)
                    if (nostore) { asm volatile("" :: "v"(w)); } else
#endif
                    store16(Y + ((size_t)blk * 256 + row) * D + col, w); } }
    }
};
}
namespace attn_body {
using bf16=__hip_bfloat16;
using bf16x8=__attribute__((ext_vector_type(8)))short;
using s16x4=__attribute__((ext_vector_type(4)))short;
using f32x16=__attribute__((ext_vector_type(16)))float;
using u32x4=__attribute__((ext_vector_type(4)))unsigned;
constexpr int SEQ=2048,D=64,DM=1024;
constexpr int NW=8,QBLK=32,QB=QBLK*NW,KVBLK=64,NQB=SEQ/QB;
constexpr int ATTN_PITCH=DM, ATTN_UNIT_ROWS=QB;
__device__ __forceinline__ int crow(int r,int hi){return (r&3)+8*(r>>2)+4*hi;}
#define SBAR() __builtin_amdgcn_sched_barrier(0)
__device__ __forceinline__ void cmask(f32x16&p0,f32x16&p1,int jb,int qrel,int hi){
  const float NEG=-INFINITY; int kb=64*jb+4*hi;
  #pragma unroll
  for(int r=0;r<16;++r){int kv=kb+(r&3)+8*(r>>2); if(kv>qrel)p0[r]=NEG; if(kv+32>qrel)p1[r]=NEG;}
}

constexpr int NSLOT=3, SLOTB=8192;
constexpr int LDS_K=0, LDS_V=NSLOT*SLOTB, LDS_WS=2*NSLOT*SLOTB, LDS_OST=LDS_WS+NW*64*4, ALDS_BYTES=LDS_OST+NW*4096;
constexpr float C2=0.125f*1.4426950408889634f;
__device__ __forceinline__ void glds16(const void*gsrc,unsigned lds_dst){unsigned keep;
  asm volatile("s_mov_b32 %0, m0\n\ts_mov_b32 m0, %2\n\ts_nop 0\n\tglobal_load_lds_dwordx4 %1, off\n\ts_mov_b32 m0, %0":"=&s"(keep):"v"(gsrc),"s"(lds_dst):"memory");}
__device__ __forceinline__ float max3f(float a,float b,float c){float r;asm("v_max3_f32 %0, %1, %2, %3":"=v"(r):"v"(a),"v"(b),"v"(c));return r;}
__device__ __forceinline__ float max2f(float a,float b){float r;asm("v_max_f32_e32 %0, %1, %2":"=v"(r):"v"(a),"v"(b));return r;}
__device__ __forceinline__ float fadd_s(float a,float b){float r;asm("v_add_f32_e32 %0, %1, %2":"=v"(r):"v"(a),"v"(b));return r;}
__device__ __forceinline__ float fsub_s(float a,float b){float r;asm("v_sub_f32_e32 %0, %1, %2":"=v"(r):"v"(a),"v"(b));return r;}
typedef float f32x2_t __attribute__((ext_vector_type(2))); typedef __bf16 bf16x2_t __attribute__((ext_vector_type(2)));
__device__ __forceinline__ unsigned cvtpk_s(float lo,float hi){f32x2_t v={lo,hi};bf16x2_t b=__builtin_convertvector(v,bf16x2_t);return __builtin_bit_cast(unsigned,b);}
#define WAIT_BAR(N) asm volatile("s_waitcnt vmcnt(" #N ") lgkmcnt(0)\n\ts_barrier":::"memory")

__device__ __forceinline__ void qkt(f32x16&p0,f32x16&p1,const char*Kslot,const bf16x8*qr,const f32x16&negm,int r32,int hi){
  const char*kb=Kslot+hi*1024+r32*16;
  #pragma unroll
  for(int d0=0;d0<4;++d0){
    const bf16x8 b0=*reinterpret_cast<const bf16x8*>(kb+d0*2048);
    const bf16x8 b1=*reinterpret_cast<const bf16x8*>(kb+d0*2048+512);
    if(d0==0){p0=__builtin_amdgcn_mfma_f32_32x32x16_bf16(b0,qr[0],negm,0,0,0);p1=__builtin_amdgcn_mfma_f32_32x32x16_bf16(b1,qr[0],negm,0,0,0);}
    else{p0=__builtin_amdgcn_mfma_f32_32x32x16_bf16(b0,qr[d0],p0,0,0,0);p1=__builtin_amdgcn_mfma_f32_32x32x16_bf16(b1,qr[d0],p1,0,0,0);}}
}
typedef __attribute__((address_space(3))) const char* lds_cptr;
typedef short v4i16_t __attribute__((ext_vector_type(4)));
__device__ __forceinline__ void kload8(bf16x8*kf,lds_cptr kp){
  kf[0]=*(const __attribute__((address_space(3))) bf16x8*)(kp);      kf[1]=*(const __attribute__((address_space(3))) bf16x8*)(kp+512);
  kf[2]=*(const __attribute__((address_space(3))) bf16x8*)(kp+2048); kf[3]=*(const __attribute__((address_space(3))) bf16x8*)(kp+2560);
  kf[4]=*(const __attribute__((address_space(3))) bf16x8*)(kp+4096); kf[5]=*(const __attribute__((address_space(3))) bf16x8*)(kp+4608);
  kf[6]=*(const __attribute__((address_space(3))) bf16x8*)(kp+6144); kf[7]=*(const __attribute__((address_space(3))) bf16x8*)(kp+6656);
}
__device__ __forceinline__ void kload2(bf16x8*kf,lds_cptr kp,int j){ kf[2*j]=*(const __attribute__((address_space(3))) bf16x8*)(kp+j*2048); kf[2*j+1]=*(const __attribute__((address_space(3))) bf16x8*)(kp+j*2048+512); }
__device__ __forceinline__ s16x4 vtr(lds_cptr p){ return __builtin_bit_cast(s16x4,__builtin_amdgcn_ds_read_tr16_b64_v4i16((__attribute__((address_space(3))) v4i16_t*)p)); }
__device__ __forceinline__ float rowmax(const f32x16&p0,const f32x16&p1){
  float a=max3f(p0[0],p0[1],p1[0]),b=max3f(p0[2],p0[3],p1[1]);a=max3f(a,p1[2],p1[3]);
  #pragma unroll
  for(int r=4;r<16;r+=4){a=max3f(a,p0[r],p0[r+1]);b=max3f(b,p0[r+2],p0[r+3]);a=max3f(a,p1[r],p1[r+1]);b=max3f(b,p1[r+2],p1[r+3]);}
  const float m=max2f(a,b);
  auto rr=__builtin_amdgcn_permlane32_swap(__float_as_uint(m),__float_as_uint(m),false,false);
  return max2f(__uint_as_float(rr[0]),__uint_as_float(rr[1]));
}
__device__ __forceinline__ void pv(f32x16*o,int vb,bf16x8 pa0,bf16x8 pa1,bf16x8 pa2,bf16x8 pa3){
  #pragma unroll
  for(int d0=0;d0<2;++d0){s16x4 lo[4],hi[4];
    #pragma unroll
    for(int ks=0;ks<4;++ks){
      asm volatile("ds_read_b64_tr_b16 %0,%1 offset:%c2":"=&v"(lo[ks]):"v"(vb),"i"(d0*4096+ks*1024):"memory");
      asm volatile("ds_read_b64_tr_b16 %0,%1 offset:%c2":"=&v"(hi[ks]):"v"(vb),"i"(d0*4096+ks*1024+512):"memory");}
    asm volatile("s_waitcnt lgkmcnt(0)":::"memory");SBAR();
    #define PK(k) (bf16x8){lo[k][0],lo[k][1],lo[k][2],lo[k][3],hi[k][0],hi[k][1],hi[k][2],hi[k][3]}
    o[d0]=__builtin_amdgcn_mfma_f32_32x32x16_bf16(pa0,PK(0),o[d0],0,0,0);
    o[d0]=__builtin_amdgcn_mfma_f32_32x32x16_bf16(pa1,PK(1),o[d0],0,0,0);
    o[d0]=__builtin_amdgcn_mfma_f32_32x32x16_bf16(pa2,PK(2),o[d0],0,0,0);
    o[d0]=__builtin_amdgcn_mfma_f32_32x32x16_bf16(pa3,PK(3),o[d0],0,0,0);
    #undef PK
  }
}

#ifndef ATTN_STORE16
#define ATTN_STORE16(p,v) (*(u32x4*)(p)=(v))
#endif
template<int THRL> __device__ __forceinline__ void attn_unit(int b,int qcol,int kcol,int vcol,int ocol,int qb,const bf16*Q,const bf16*__restrict__ K,const bf16*__restrict__ V,bf16*O,char*shm){
  int tid_=threadIdx.x; asm volatile("":"+v"(tid_));
  const int tid=tid_,lane=tid&63,r32=lane&31,hi=lane>>5; const int wid=__builtin_amdgcn_readfirstlane(tid>>6);
  const long rowbase=(long)b*SEQ; const int q0=qb*QB;
  const bf16*Qw=Q+(rowbase+q0+wid*QBLK)*DM+qcol;
  const bf16*Kh=K+rowbase*DM+kcol,*Vh=V+rowbase*DM+vcol;
  const unsigned lds0=(unsigned)(uintptr_t)shm;
  float*wsf=(float*)(shm+LDS_WS)+wid*64;
  const bf16*ksrc=Kh+(long)lane*DM+wid*8;
  const bf16*vsrc=Vh+(long)(16*(wid&3)+(lane>>2))*DM+(wid>>2)*32+(lane&3)*8;
  const unsigned kdst=lds0+LDS_K+wid*1024, vdst=lds0+LDS_V+wid*1024;
  #define DMA_K(t,slot) glds16(ksrc+(long)(t)*KVBLK*DM,(unsigned)__builtin_amdgcn_readfirstlane(kdst+(slot)))
  #define DMA_V(t,slot) glds16(vsrc+(long)(t)*KVBLK*DM,(unsigned)__builtin_amdgcn_readfirstlane(vdst+(slot)))
  const int vb0=(int)(lds0+LDS_V)+((lane>>4)&1)*32+(lane&3)*8+(4*hi+((lane&15)>>2))*64;
  const char*Kbase=shm+LDS_K; bf16x8 kf[8];
  const lds_cptr shm3=(lds_cptr)shm; const lds_cptr kp0=shm3+LDS_K+hi*1024+r32*16; const lds_cptr vp0=shm3+LDS_V+((lane>>4)&1)*32+(lane&3)*8+(4*hi+((lane&15)>>2))*64;
  const int NT=(q0+QB)/KVBLK;
  DMA_K(0,0);DMA_V(0,0);DMA_K(1,SLOTB);
  bf16x8 qr[4];
  #pragma unroll
  for(int d0=0;d0<4;++d0)qr[d0]=*reinterpret_cast<const bf16x8*>(&Qw[(long)r32*DM+d0*16+hi*8]);
  float l_reg=0.f;f32x16 o[2];o[0]=f32x16{};o[1]=f32x16{};const f32x16 negm=f32x16{};
  const int qrel=wid*QBLK+r32;
  #define CMASK(P0,P1,t) do{int jb_=(t)-(NT-4); if(jb_>=0)cmask(P0,P1,jb_,qrel,hi);}while(0)
  #define START(P0,P1) do{ _Pragma("unroll") for(int r=0;r<16;++r)P0[r]=__builtin_amdgcn_exp2f(P0[r]); }while(0)
  #define RESC() do{}while(0)
  f32x16 pA0,pA1,pB0,pB1;
  int sl_prev=0,sl_cur=0,sl_next=SLOTB;
  #define ROT() do{sl_prev=sl_cur;sl_cur=sl_next;sl_next=(sl_next==(NSLOT-1)*SLOTB)?0:sl_next+SLOTB;}while(0)
  DMA_K(2,2*SLOTB);
  WAIT_BAR(3);
  qkt(pA0,pA1,Kbase,qr,negm,r32,hi);asm volatile("s_nop 15\n\ts_nop 7":"+v"(pA0),"+v"(pA1));CMASK(pA0,pA1,0);
  START(pA0,pA1);
  _Pragma("unroll") for(int r=0;r<16;++r)pA1[r]=__builtin_amdgcn_exp2f(pA1[r]);
  WAIT_BAR(0);
  DMA_K(3,0);DMA_V(1,SLOTB);
  ROT();
  kload8(kf,kp0+sl_cur);
  WAIT_BAR(2);
  s16x4 vlo[8],vhi[8]; u32x4 pw0,pw1,pw2,pw3;
  #define PKW(P,B) cvtpk_s(P[B],P[B+1])
  #define PAF(k) __builtin_bit_cast(bf16x8,pw##k)
  #define VFR(i) (bf16x8){vlo[i][0],vlo[i][1],vlo[i][2],vlo[i][3],vhi[i][0],vhi[i][1],vhi[i][2],vhi[i][3]}
  #define PIN(x) asm volatile("":"+v"(x))
  #define MX3(a,b,c) __builtin_fmaxf(__builtin_fmaxf((a),(b)),(c))
  #define GAPA(MF,A0,A1,A2,A3,W0,W1,PW) do{ MF; sacc+=A0; sacc+=A1; sacc+=A2; sacc+=A3; PIN(sacc); W0; W1; PIN(PW); SBAR(); }while(0)
  #define EX(v) __builtin_amdgcn_exp2f(v)
  #define GAPB(MF,X,B) do{ MF; X[B]=EX(X[B]); X[B+1]=EX(X[B+1]); X[B+2]=EX(X[B+2]); X[B+3]=EX(X[B+3]); PIN(X); SBAR(); }while(0)
  #define VRD(i) do{ vlo[i]=vtr(vp_+(((i)>>2)*4096+((i)&3)*1024)); vhi[i]=vtr(vp_+(((i)>>2)*4096+((i)&3)*1024+512)); }while(0)
  #define KRD(G,j) do{ if(G){ kload2(kf,kp0+sl_next,j); SBAR(); } }while(0)
  #define STEP(C0,C1,P0,P1,t,GK,GV,GL) do{ SBAR(); \
    const lds_cptr vp_=vp0+sl_prev; \
    VRD(0); SBAR(); float sacc=(P0[0]+P0[1]); \
    GAPA(C0=__builtin_amdgcn_mfma_f32_32x32x16_bf16(kf[0],qr[0],negm,0,0,0), P0[2],P0[3],P0[4],P0[5],     pw0[0]=PKW(P0,0), pw0[1]=PKW(P0,2), pw0); \
    VRD(4); SBAR(); GAPA(C1=__builtin_amdgcn_mfma_f32_32x32x16_bf16(kf[1],qr[0],negm,0,0,0), P0[6],P0[7],P0[8],P0[9],     pw0[2]=PKW(P0,4), pw0[3]=PKW(P0,6), pw0); \
    VRD(1); SBAR(); GAPA(C0=__builtin_amdgcn_mfma_f32_32x32x16_bf16(kf[2],qr[1],C0,0,0,0),   P0[10],P0[11],P0[12],P0[13], pw1[0]=PKW(P0,8), pw1[1]=PKW(P0,10), pw1); \
    VRD(5); SBAR(); GAPA(C1=__builtin_amdgcn_mfma_f32_32x32x16_bf16(kf[3],qr[1],C1,0,0,0),   P0[14],P0[15],P1[0],P1[1],   pw1[2]=PKW(P0,12),pw1[3]=PKW(P0,14), pw1); \
    VRD(2); SBAR(); GAPA(C0=__builtin_amdgcn_mfma_f32_32x32x16_bf16(kf[4],qr[2],C0,0,0,0),   P1[2],P1[3],P1[4],P1[5],     pw2[0]=PKW(P1,0), pw2[1]=PKW(P1,2), pw2); \
    VRD(6); SBAR(); GAPA(C1=__builtin_amdgcn_mfma_f32_32x32x16_bf16(kf[5],qr[2],C1,0,0,0),   P1[6],P1[7],P1[8],P1[9],     pw2[2]=PKW(P1,4), pw2[3]=PKW(P1,6), pw2); \
    VRD(3); SBAR(); GAPA(C0=__builtin_amdgcn_mfma_f32_32x32x16_bf16(kf[6],qr[3],C0,0,0,0),   P1[10],P1[11],P1[12],P1[13], pw3[0]=PKW(P1,8), pw3[1]=PKW(P1,10), pw3); \
    VRD(7); SBAR(); GAPA(C1=__builtin_amdgcn_mfma_f32_32x32x16_bf16(kf[7],qr[3],C1,0,0,0),   P1[14],P1[15],0.f,0.f,       pw3[2]=PKW(P1,12),pw3[3]=PKW(P1,14), pw3); \
    l_reg+=sacc; \
    if(GK){DMA_K((t)+3,sl_cur);} if(GV){DMA_V((t)+1,sl_next);} \
    CMASK(C0,C1,t); \
    SBAR(); \
    GAPB(o[0]=__builtin_amdgcn_mfma_f32_32x32x16_bf16(PAF(0),VFR(0),o[0],0,0,0), C0,0); \
    GAPB(o[1]=__builtin_amdgcn_mfma_f32_32x32x16_bf16(PAF(0),VFR(4),o[1],0,0,0), C0,4); \
    KRD(GL,0); GAPB(o[0]=__builtin_amdgcn_mfma_f32_32x32x16_bf16(PAF(1),VFR(1),o[0],0,0,0), C0,8); \
    KRD(GL,1); GAPB(o[1]=__builtin_amdgcn_mfma_f32_32x32x16_bf16(PAF(1),VFR(5),o[1],0,0,0), C0,12); \
    KRD(GL,2); GAPB(o[0]=__builtin_amdgcn_mfma_f32_32x32x16_bf16(PAF(2),VFR(2),o[0],0,0,0), C1,0); \
    KRD(GL,3); GAPB(o[1]=__builtin_amdgcn_mfma_f32_32x32x16_bf16(PAF(2),VFR(6),o[1],0,0,0), C1,4); \
    GAPB(o[0]=__builtin_amdgcn_mfma_f32_32x32x16_bf16(PAF(3),VFR(3),o[0],0,0,0), C1,8); \
    GAPB(o[1]=__builtin_amdgcn_mfma_f32_32x32x16_bf16(PAF(3),VFR(7),o[1],0,0,0), C1,12); \
    }while(0)
  int t=1;
  #undef CMASK
  #define CMASK(P0,P1,t) do{}while(0)
  for(;t+5<NT;t+=2){
    STEP(pB0,pB1,pA0,pA1,t,true,true,true);     WAIT_BAR(2); RESC(); ROT();
    STEP(pA0,pA1,pB0,pB1,t+1,true,true,true);   WAIT_BAR(2); RESC(); ROT();
  }
  #undef CMASK
  #define CMASK(P0,P1,t) do{int jb_=(t)-(NT-4); if(jb_>=0)cmask(P0,P1,jb_,qrel,hi);}while(0)
  #define ENDW(tt) do{ if((tt)+3<NT){WAIT_BAR(2);} else if((tt)+2<NT){WAIT_BAR(1);} else {WAIT_BAR(0);} }while(0)
  for(;t+1<NT;t+=2){
    STEP(pB0,pB1,pA0,pA1,t,(t+3<NT),(t+1<NT),(t+1<NT));       ENDW(t);   RESC(); ROT();
    STEP(pA0,pA1,pB0,pB1,t+1,(t+4<NT),(t+2<NT),(t+2<NT));     ENDW(t+1); RESC(); ROT();
  }
  STEP(pB0,pB1,pA0,pA1,NT-1,false,false,false); RESC();
  { float sacc=pB0[0]+pB0[1]; _Pragma("unroll") for(int r=2;r<16;++r)sacc+=pB0[r]; _Pragma("unroll") for(int r=0;r<16;++r)sacc+=pB1[r]; l_reg+=sacc;
    pw0=(u32x4){PKW(pB0,0),PKW(pB0,2),PKW(pB0,4),PKW(pB0,6)};pw1=(u32x4){PKW(pB0,8),PKW(pB0,10),PKW(pB0,12),PKW(pB0,14)};pw2=(u32x4){PKW(pB1,0),PKW(pB1,2),PKW(pB1,4),PKW(pB1,6)};pw3=(u32x4){PKW(pB1,8),PKW(pB1,10),PKW(pB1,12),PKW(pB1,14)};
    SBAR(); pv(o,vb0+sl_cur,PAF(0),PAF(1),PAF(2),PAF(3)); }
  #undef PKW
  #undef PAF
  #undef VFR
  #undef PIN
  #undef MX3
  #undef GAPA
  #undef GAPB
  #undef EX
  #undef VRD
  #undef KRD
  #undef STEP
  #undef ENDW
  {auto rr=__builtin_amdgcn_permlane32_swap(__float_as_uint(l_reg),__float_as_uint(l_reg),false,false);l_reg=__uint_as_float(rr[0])+__uint_as_float(rr[1]);}
  if(hi==0)wsf[32+r32]=l_reg;asm volatile("s_waitcnt lgkmcnt(0)":::"memory");
  float rli[16];
  #pragma unroll
  for(int r=0;r<16;++r)rli[r]=__builtin_amdgcn_rcpf(wsf[32+crow(r,hi)]);
  bf16*Ow=O+(rowbase+q0+wid*QBLK)*DM+ocol;
  { bf16*stg=(bf16*)(shm+LDS_OST)+wid*2048;
    #pragma unroll
    for(int r=0;r<16;++r){const int orow=crow(r,hi);
      #pragma unroll
      for(int d0=0;d0<2;++d0)stg[orow*64+d0*32+r32]=__float2bfloat16(o[d0][r]*rli[r]);}
    asm volatile("s_waitcnt lgkmcnt(0)":::"memory");
    #pragma unroll
    for(int i=0;i<4;++i){const int row=i*8+(lane>>3),ch=lane&7; const u32x4 v=*(const u32x4*)(stg+row*64+ch*8); ATTN_STORE16(Ow+(long)row*DM+ch*8,v);} }
  asm volatile("s_waitcnt lgkmcnt(0)\n\ts_barrier":::"memory");
  #undef DMA_K
  #undef DMA_V
  #undef CMASK
  #undef START
  #undef RESC
  #undef ROT
}
constexpr int ATTN_LDS_BYTES=ALDS_BYTES;

#undef SBAR
#undef WAIT_BAR
#undef ATTN_STORE16
}
namespace attn128 {
using bf16=__hip_bfloat16;
using bf16x8=__attribute__((ext_vector_type(8)))short;
using s16x4=__attribute__((ext_vector_type(4)))short;
using f32x16=__attribute__((ext_vector_type(16)))float;
using u32x4=__attribute__((ext_vector_type(4)))unsigned;
constexpr int SEQ=2048,D=64,DM=1024;
constexpr int NW=8,QBLK=32,QB=QBLK*NW,KVBLK=64,NQB=SEQ/QB;
constexpr int ATTN_PITCH=DM, ATTN_UNIT_ROWS=QB;
__device__ __forceinline__ int crow(int r,int hi){return (r&3)+8*(r>>2)+4*hi;}
#define SBAR() __builtin_amdgcn_sched_barrier(0)
__device__ __forceinline__ void cmask(f32x16&p0,f32x16&p1,int jb,int qrel,int hi){
  const float NEG=-INFINITY; int kb=64*jb+4*hi;
  #pragma unroll
  for(int r=0;r<16;++r){int kv=kb+(r&3)+8*(r>>2); if(kv>qrel)p0[r]=NEG; if(kv+32>qrel)p1[r]=NEG;}
}

constexpr int NSLOT=3, SLOTB=8192;
constexpr int VSLOTB=2*SLOTB;
constexpr int LDS_K=0, LDS_V=NSLOT*SLOTB, LDS_WS=LDS_V+NSLOT*VSLOTB, LDS_OST=LDS_WS+NW*64*4, ALDS_BYTES=LDS_OST+NW*4096;
constexpr float C2=0.125f*1.4426950408889634f;
__device__ __forceinline__ void glds16(const void*gsrc,unsigned lds_dst){unsigned keep;
  asm volatile("s_mov_b32 %0, m0\n\ts_mov_b32 m0, %2\n\ts_nop 0\n\tglobal_load_lds_dwordx4 %1, off\n\ts_mov_b32 m0, %0":"=&s"(keep):"v"(gsrc),"s"(lds_dst):"memory");}
__device__ __forceinline__ float max3f(float a,float b,float c){float r;asm("v_max3_f32 %0, %1, %2, %3":"=v"(r):"v"(a),"v"(b),"v"(c));return r;}
__device__ __forceinline__ float max2f(float a,float b){float r;asm("v_max_f32_e32 %0, %1, %2":"=v"(r):"v"(a),"v"(b));return r;}
__device__ __forceinline__ float fadd_s(float a,float b){float r;asm("v_add_f32_e32 %0, %1, %2":"=v"(r):"v"(a),"v"(b));return r;}
__device__ __forceinline__ float fsub_s(float a,float b){float r;asm("v_sub_f32_e32 %0, %1, %2":"=v"(r):"v"(a),"v"(b));return r;}
typedef float f32x2_t __attribute__((ext_vector_type(2))); typedef __bf16 bf16x2_t __attribute__((ext_vector_type(2)));
__device__ __forceinline__ unsigned cvtpk_s(float lo,float hi){f32x2_t v={lo,hi};bf16x2_t b=__builtin_convertvector(v,bf16x2_t);return __builtin_bit_cast(unsigned,b);}
#define WAIT_BAR(N) asm volatile("s_waitcnt vmcnt(" #N ") lgkmcnt(0)\n\ts_barrier":::"memory")

__device__ __forceinline__ void qkt(f32x16&p0,f32x16&p1,const char*Kslot,const bf16x8*qr,const f32x16&negm,int r32,int hi){
  const char*kb=Kslot+hi*1024+r32*16;
  #pragma unroll
  for(int d0=0;d0<4;++d0){
    const bf16x8 b0=*reinterpret_cast<const bf16x8*>(kb+d0*2048);
    const bf16x8 b1=*reinterpret_cast<const bf16x8*>(kb+d0*2048+512);
    if(d0==0){p0=__builtin_amdgcn_mfma_f32_32x32x16_bf16(b0,qr[0],negm,0,0,0);p1=__builtin_amdgcn_mfma_f32_32x32x16_bf16(b1,qr[0],negm,0,0,0);}
    else{p0=__builtin_amdgcn_mfma_f32_32x32x16_bf16(b0,qr[d0],p0,0,0,0);p1=__builtin_amdgcn_mfma_f32_32x32x16_bf16(b1,qr[d0],p1,0,0,0);}}
}
typedef __attribute__((address_space(3))) const char* lds_cptr;
typedef short v4i16_t __attribute__((ext_vector_type(4)));
__device__ __forceinline__ void kload8(bf16x8*kf,lds_cptr kp){
  kf[0]=*(const __attribute__((address_space(3))) bf16x8*)(kp);      kf[1]=*(const __attribute__((address_space(3))) bf16x8*)(kp+512);
  kf[2]=*(const __attribute__((address_space(3))) bf16x8*)(kp+2048); kf[3]=*(const __attribute__((address_space(3))) bf16x8*)(kp+2560);
  kf[4]=*(const __attribute__((address_space(3))) bf16x8*)(kp+4096); kf[5]=*(const __attribute__((address_space(3))) bf16x8*)(kp+4608);
  kf[6]=*(const __attribute__((address_space(3))) bf16x8*)(kp+6144); kf[7]=*(const __attribute__((address_space(3))) bf16x8*)(kp+6656);
}
__device__ __forceinline__ void kload2(bf16x8*kf,lds_cptr kp,int j){ kf[2*j]=*(const __attribute__((address_space(3))) bf16x8*)(kp+j*2048); kf[2*j+1]=*(const __attribute__((address_space(3))) bf16x8*)(kp+j*2048+512); }
__device__ __forceinline__ s16x4 vtr(lds_cptr p){ return __builtin_bit_cast(s16x4,__builtin_amdgcn_ds_read_tr16_b64_v4i16((__attribute__((address_space(3))) v4i16_t*)p)); }
__device__ __forceinline__ float rowmax(const f32x16&p0,const f32x16&p1){
  float a=max3f(p0[0],p0[1],p1[0]),b=max3f(p0[2],p0[3],p1[1]);a=max3f(a,p1[2],p1[3]);
  #pragma unroll
  for(int r=4;r<16;r+=4){a=max3f(a,p0[r],p0[r+1]);b=max3f(b,p0[r+2],p0[r+3]);a=max3f(a,p1[r],p1[r+1]);b=max3f(b,p1[r+2],p1[r+3]);}
  const float m=max2f(a,b);
  auto rr=__builtin_amdgcn_permlane32_swap(__float_as_uint(m),__float_as_uint(m),false,false);
  return max2f(__uint_as_float(rr[0]),__uint_as_float(rr[1]));
}
__device__ __forceinline__ void pv(f32x16*o,int vb,bf16x8 pa0,bf16x8 pa1,bf16x8 pa2,bf16x8 pa3){
  #pragma unroll
  for(int d0=0;d0<4;++d0){s16x4 lo[4],hi[4];
    #pragma unroll
    for(int ks=0;ks<4;++ks){
      asm volatile("ds_read_b64_tr_b16 %0,%1 offset:%c2":"=&v"(lo[ks]):"v"(vb),"i"(d0*4096+ks*1024):"memory");
      asm volatile("ds_read_b64_tr_b16 %0,%1 offset:%c2":"=&v"(hi[ks]):"v"(vb),"i"(d0*4096+ks*1024+512):"memory");}
    asm volatile("s_waitcnt lgkmcnt(0)":::"memory");SBAR();
    #define PK(k) (bf16x8){lo[k][0],lo[k][1],lo[k][2],lo[k][3],hi[k][0],hi[k][1],hi[k][2],hi[k][3]}
    o[d0]=__builtin_amdgcn_mfma_f32_32x32x16_bf16(pa0,PK(0),o[d0],0,0,0);
    o[d0]=__builtin_amdgcn_mfma_f32_32x32x16_bf16(pa1,PK(1),o[d0],0,0,0);
    o[d0]=__builtin_amdgcn_mfma_f32_32x32x16_bf16(pa2,PK(2),o[d0],0,0,0);
    o[d0]=__builtin_amdgcn_mfma_f32_32x32x16_bf16(pa3,PK(3),o[d0],0,0,0);
    #undef PK
  }
}

#ifndef ATTN_STORE16
#define ATTN_STORE16(p,v) (*(u32x4*)(p)=(v))
#endif
template<int THRL> __device__ __forceinline__ void attn_unit(int b,int qcol,int kcol,int vcol,int ocol,int qb,const bf16*Q,const bf16*__restrict__ K,const bf16*__restrict__ V,bf16*O,char*shm){
  int tid_=threadIdx.x; asm volatile("":"+v"(tid_));
  const int tid=tid_,lane=tid&63,r32=lane&31,hi=lane>>5; const int wid=__builtin_amdgcn_readfirstlane(tid>>6);
  const long rowbase=(long)b*SEQ; const int q0=qb*QB;
  const bf16*Qw=Q+(rowbase+q0+wid*QBLK)*DM+qcol;
  const bf16*Kh=K+rowbase*DM+kcol,*Vh=V+rowbase*DM+vcol;
  const unsigned lds0=(unsigned)(uintptr_t)shm;
  float*wsf=(float*)(shm+LDS_WS)+wid*64;
  const bf16*ksrc=Kh+(long)lane*DM+wid*8;
  const bf16*vsrc=Vh+(long)(16*(wid&3)+(lane>>2))*DM+(wid>>2)*32+(lane&3)*8;
  const unsigned kdst=lds0+LDS_K+wid*1024, vdst=lds0+LDS_V+wid*1024;
  #define DMA_K(t,slot) glds16(ksrc+(long)(t)*KVBLK*DM,(unsigned)__builtin_amdgcn_readfirstlane(kdst+(slot)))
  #define DMA_V(t,slot) do{ glds16(vsrc+(long)(t)*KVBLK*DM,(unsigned)__builtin_amdgcn_readfirstlane(vdst+2*(slot))); glds16(vsrc+64+(long)(t)*KVBLK*DM,(unsigned)__builtin_amdgcn_readfirstlane(vdst+8192+2*(slot))); }while(0)
  const int vb0=(int)(lds0+LDS_V)+((lane>>4)&1)*32+(lane&3)*8+(4*hi+((lane&15)>>2))*64;
  const char*Kbase=shm+LDS_K; bf16x8 kf[8];
  const lds_cptr shm3=(lds_cptr)shm; const lds_cptr kp0=shm3+LDS_K+hi*1024+r32*16; const lds_cptr vp0=shm3+LDS_V+((lane>>4)&1)*32+(lane&3)*8+(4*hi+((lane&15)>>2))*64;
  const int NT=(q0+QB)/KVBLK;
  DMA_K(0,0);DMA_V(0,0);DMA_K(1,SLOTB);
  bf16x8 qr[4];
  #pragma unroll
  for(int d0=0;d0<4;++d0)qr[d0]=*reinterpret_cast<const bf16x8*>(&Qw[(long)r32*DM+d0*16+hi*8]);
  float l_reg=0.f;f32x16 o[4];o[0]=f32x16{};o[1]=f32x16{};o[2]=f32x16{};o[3]=f32x16{};const f32x16 negm=f32x16{};
  const int qrel=wid*QBLK+r32;
  #define CMASK(P0,P1,t) do{int jb_=(t)-(NT-4); if(jb_>=0)cmask(P0,P1,jb_,qrel,hi);}while(0)
  #define START(P0,P1) do{ _Pragma("unroll") for(int r=0;r<16;++r)P0[r]=__builtin_amdgcn_exp2f(P0[r]); }while(0)
  #define RESC() do{}while(0)
  f32x16 pA0,pA1,pB0,pB1;
  int sl_prev=0,sl_cur=0,sl_next=SLOTB;
  #define ROT() do{sl_prev=sl_cur;sl_cur=sl_next;sl_next=(sl_next==(NSLOT-1)*SLOTB)?0:sl_next+SLOTB;}while(0)
  DMA_K(2,2*SLOTB);
  WAIT_BAR(4);
  qkt(pA0,pA1,Kbase,qr,negm,r32,hi);asm volatile("s_nop 15\n\ts_nop 7":"+v"(pA0),"+v"(pA1));CMASK(pA0,pA1,0);
  START(pA0,pA1);
  _Pragma("unroll") for(int r=0;r<16;++r)pA1[r]=__builtin_amdgcn_exp2f(pA1[r]);
  WAIT_BAR(0);
  DMA_K(3,0);DMA_V(1,SLOTB);
  ROT();
  kload8(kf,kp0+sl_cur);
  WAIT_BAR(3);
  s16x4 vlo[8],vhi[8]; u32x4 pw0,pw1,pw2,pw3;
  #define PKW(P,B) cvtpk_s(P[B],P[B+1])
  #define PAF(k) __builtin_bit_cast(bf16x8,pw##k)
  #define VFR(i) (bf16x8){vlo[i][0],vlo[i][1],vlo[i][2],vlo[i][3],vhi[i][0],vhi[i][1],vhi[i][2],vhi[i][3]}
  #define PIN(x) asm volatile("":"+v"(x))
  #define MX3(a,b,c) __builtin_fmaxf(__builtin_fmaxf((a),(b)),(c))
  #define GAPA(MF,A0,A1,A2,A3,W0,W1,PW) do{ MF; sacc+=A0; sacc+=A1; sacc+=A2; sacc+=A3; PIN(sacc); W0; W1; PIN(PW); SBAR(); }while(0)
  #define EX(v) __builtin_amdgcn_exp2f(v)
  #define GAPB(MF,X,B) do{ MF; X[B]=EX(X[B]); X[B+1]=EX(X[B+1]); PIN(X); SBAR(); }while(0)
  #define VRD2(i) do{ vlo[i]=vtr(vp_+((((i)>>2)+2)*4096+((i)&3)*1024)); vhi[i]=vtr(vp_+((((i)>>2)+2)*4096+((i)&3)*1024+512)); }while(0)
  #define VRD(i) do{ vlo[i]=vtr(vp_+(((i)>>2)*4096+((i)&3)*1024)); vhi[i]=vtr(vp_+(((i)>>2)*4096+((i)&3)*1024+512)); }while(0)
  #define KRD(G,j) do{ if(G){ kload2(kf,kp0+sl_next,j); SBAR(); } }while(0)
  #define STEP(C0,C1,P0,P1,t,GK,GV,GL) do{ SBAR(); \
    const lds_cptr vp_=vp0+2*sl_prev; \
    VRD(0); SBAR(); float sacc=(P0[0]+P0[1]); \
    GAPA(C0=__builtin_amdgcn_mfma_f32_32x32x16_bf16(kf[0],qr[0],negm,0,0,0), P0[2],P0[3],P0[4],P0[5],     pw0[0]=PKW(P0,0), pw0[1]=PKW(P0,2), pw0); \
    VRD(4); SBAR(); GAPA(C1=__builtin_amdgcn_mfma_f32_32x32x16_bf16(kf[1],qr[0],negm,0,0,0), P0[6],P0[7],P0[8],P0[9],     pw0[2]=PKW(P0,4), pw0[3]=PKW(P0,6), pw0); \
    VRD(1); SBAR(); GAPA(C0=__builtin_amdgcn_mfma_f32_32x32x16_bf16(kf[2],qr[1],C0,0,0,0),   P0[10],P0[11],P0[12],P0[13], pw1[0]=PKW(P0,8), pw1[1]=PKW(P0,10), pw1); \
    VRD(5); SBAR(); GAPA(C1=__builtin_amdgcn_mfma_f32_32x32x16_bf16(kf[3],qr[1],C1,0,0,0),   P0[14],P0[15],P1[0],P1[1],   pw1[2]=PKW(P0,12),pw1[3]=PKW(P0,14), pw1); \
    VRD(2); SBAR(); GAPA(C0=__builtin_amdgcn_mfma_f32_32x32x16_bf16(kf[4],qr[2],C0,0,0,0),   P1[2],P1[3],P1[4],P1[5],     pw2[0]=PKW(P1,0), pw2[1]=PKW(P1,2), pw2); \
    VRD(6); SBAR(); GAPA(C1=__builtin_amdgcn_mfma_f32_32x32x16_bf16(kf[5],qr[2],C1,0,0,0),   P1[6],P1[7],P1[8],P1[9],     pw2[2]=PKW(P1,4), pw2[3]=PKW(P1,6), pw2); \
    VRD(3); SBAR(); GAPA(C0=__builtin_amdgcn_mfma_f32_32x32x16_bf16(kf[6],qr[3],C0,0,0,0),   P1[10],P1[11],P1[12],P1[13], pw3[0]=PKW(P1,8), pw3[1]=PKW(P1,10), pw3); \
    VRD(7); SBAR(); GAPA(C1=__builtin_amdgcn_mfma_f32_32x32x16_bf16(kf[7],qr[3],C1,0,0,0),   P1[14],P1[15],0.f,0.f,       pw3[2]=PKW(P1,12),pw3[3]=PKW(P1,14), pw3); \
    l_reg+=sacc; \
    if(GK){DMA_K((t)+3,sl_cur);} if(GV){DMA_V((t)+1,sl_next);} \
    CMASK(C0,C1,t); \
    SBAR(); \
    GAPB(o[0]=__builtin_amdgcn_mfma_f32_32x32x16_bf16(PAF(0),VFR(0),o[0],0,0,0), C0,0);  VRD2(0); SBAR(); \
    GAPB(o[1]=__builtin_amdgcn_mfma_f32_32x32x16_bf16(PAF(0),VFR(4),o[1],0,0,0), C0,2);  VRD2(4); SBAR(); \
    KRD(GL,0); GAPB(o[0]=__builtin_amdgcn_mfma_f32_32x32x16_bf16(PAF(1),VFR(1),o[0],0,0,0), C0,4);  VRD2(1); SBAR(); \
    KRD(GL,1); GAPB(o[1]=__builtin_amdgcn_mfma_f32_32x32x16_bf16(PAF(1),VFR(5),o[1],0,0,0), C0,6);  VRD2(5); SBAR(); \
    KRD(GL,2); GAPB(o[0]=__builtin_amdgcn_mfma_f32_32x32x16_bf16(PAF(2),VFR(2),o[0],0,0,0), C0,8);  VRD2(2); SBAR(); \
    KRD(GL,3); GAPB(o[1]=__builtin_amdgcn_mfma_f32_32x32x16_bf16(PAF(2),VFR(6),o[1],0,0,0), C0,10); VRD2(6); SBAR(); \
    GAPB(o[0]=__builtin_amdgcn_mfma_f32_32x32x16_bf16(PAF(3),VFR(3),o[0],0,0,0), C0,12); VRD2(3); SBAR(); \
    GAPB(o[1]=__builtin_amdgcn_mfma_f32_32x32x16_bf16(PAF(3),VFR(7),o[1],0,0,0), C0,14); VRD2(7); SBAR(); \
    GAPB(o[2]=__builtin_amdgcn_mfma_f32_32x32x16_bf16(PAF(0),VFR(0),o[2],0,0,0), C1,0); \
    GAPB(o[3]=__builtin_amdgcn_mfma_f32_32x32x16_bf16(PAF(0),VFR(4),o[3],0,0,0), C1,2); \
    GAPB(o[2]=__builtin_amdgcn_mfma_f32_32x32x16_bf16(PAF(1),VFR(1),o[2],0,0,0), C1,4); \
    GAPB(o[3]=__builtin_amdgcn_mfma_f32_32x32x16_bf16(PAF(1),VFR(5),o[3],0,0,0), C1,6); \
    GAPB(o[2]=__builtin_amdgcn_mfma_f32_32x32x16_bf16(PAF(2),VFR(2),o[2],0,0,0), C1,8); \
    GAPB(o[3]=__builtin_amdgcn_mfma_f32_32x32x16_bf16(PAF(2),VFR(6),o[3],0,0,0), C1,10); \
    GAPB(o[2]=__builtin_amdgcn_mfma_f32_32x32x16_bf16(PAF(3),VFR(3),o[2],0,0,0), C1,12); \
    GAPB(o[3]=__builtin_amdgcn_mfma_f32_32x32x16_bf16(PAF(3),VFR(7),o[3],0,0,0), C1,14); \
    }while(0)
  int t=1;
  #undef CMASK
  #define CMASK(P0,P1,t) do{}while(0)
  for(;t+5<NT;t+=2){
    STEP(pB0,pB1,pA0,pA1,t,true,true,true);     WAIT_BAR(3); RESC(); ROT();
    STEP(pA0,pA1,pB0,pB1,t+1,true,true,true);   WAIT_BAR(3); RESC(); ROT();
  }
  #undef CMASK
  #define CMASK(P0,P1,t) do{int jb_=(t)-(NT-4); if(jb_>=0)cmask(P0,P1,jb_,qrel,hi);}while(0)
  #define ENDW(tt) do{ if((tt)+3<NT){WAIT_BAR(3);} else if((tt)+2<NT){WAIT_BAR(2);} else {WAIT_BAR(0);} }while(0)
  for(;t+1<NT;t+=2){
    STEP(pB0,pB1,pA0,pA1,t,(t+3<NT),(t+1<NT),(t+1<NT));       ENDW(t);   RESC(); ROT();
    STEP(pA0,pA1,pB0,pB1,t+1,(t+4<NT),(t+2<NT),(t+2<NT));     ENDW(t+1); RESC(); ROT();
  }
  STEP(pB0,pB1,pA0,pA1,NT-1,false,false,false); RESC();
  { float sacc=pB0[0]+pB0[1]; _Pragma("unroll") for(int r=2;r<16;++r)sacc+=pB0[r]; _Pragma("unroll") for(int r=0;r<16;++r)sacc+=pB1[r]; l_reg+=sacc;
    pw0=(u32x4){PKW(pB0,0),PKW(pB0,2),PKW(pB0,4),PKW(pB0,6)};pw1=(u32x4){PKW(pB0,8),PKW(pB0,10),PKW(pB0,12),PKW(pB0,14)};pw2=(u32x4){PKW(pB1,0),PKW(pB1,2),PKW(pB1,4),PKW(pB1,6)};pw3=(u32x4){PKW(pB1,8),PKW(pB1,10),PKW(pB1,12),PKW(pB1,14)};
    SBAR(); pv(o,vb0+2*sl_cur,PAF(0),PAF(1),PAF(2),PAF(3)); }
  #undef PKW
  #undef PAF
  #undef VFR
  #undef PIN
  #undef MX3
  #undef GAPA
  #undef GAPB
  #undef EX
  #undef VRD
  #undef VRD2
  #undef KRD
  #undef STEP
  #undef ENDW
  {auto rr=__builtin_amdgcn_permlane32_swap(__float_as_uint(l_reg),__float_as_uint(l_reg),false,false);l_reg=__uint_as_float(rr[0])+__uint_as_float(rr[1]);}
  if(hi==0)wsf[32+r32]=l_reg;asm volatile("s_waitcnt lgkmcnt(0)":::"memory");
  float rli[16];
  #pragma unroll
  for(int r=0;r<16;++r)rli[r]=__builtin_amdgcn_rcpf(wsf[32+crow(r,hi)]);
  bf16*Ow=O+(rowbase+q0+wid*QBLK)*DM+ocol;
  { bf16*stg=(bf16*)(shm+LDS_OST)+wid*2048;
    #pragma unroll
    for(int hv=0;hv<2;++hv){
      #pragma unroll
      for(int r=0;r<16;++r){const int orow=crow(r,hi);
        #pragma unroll
        for(int d0=0;d0<2;++d0)stg[orow*64+d0*32+r32]=__float2bfloat16(o[2*hv+d0][r]*rli[r]);}
      asm volatile("s_waitcnt lgkmcnt(0)":::"memory");
      #pragma unroll
      for(int i=0;i<4;++i){const int row=i*8+(lane>>3),ch=lane&7; const u32x4 v=*(const u32x4*)(stg+row*64+ch*8); ATTN_STORE16(Ow+(long)row*DM+hv*64+ch*8,v);}
      asm volatile("s_waitcnt lgkmcnt(0)":::"memory"); } }
  asm volatile("s_waitcnt lgkmcnt(0)\n\ts_barrier":::"memory");
  #undef DMA_K
  #undef DMA_V
  #undef CMASK
  #undef START
  #undef RESC
  #undef ROT
}
constexpr int ATTN_LDS_BYTES=ALDS_BYTES;

#undef SBAR
#undef WAIT_BAR
#undef ATTN_STORE16
}
constexpr size_t WS_ATT0 = WS_ACT, WS_ATT1 = WS_ACT + 32 * MiB;

__device__ __forceinline__ void diff_combine(const Params& P, int b, int h, int qb) {
    int tid_ = threadIdx.x; asm volatile("" : "+v"(tid_));
    const int tid = tid_, lane = tid & 63, wid = tid >> 6;
    const float lam = __expf(wave_sum(P.in[I_LQ1][lane] * P.in[I_LK1][lane])) - __expf(wave_sum(P.in[I_LQ2][lane] * P.in[I_LK2][lane])) + 0.2f;
    const int ch = lane & 15;
    const f32x4 g0 = *(const f32x4*)(P.in[I_SG] + 8 * ch), g1 = *(const f32x4*)(P.in[I_SG] + 8 * ch + 4);
    const size_t row0 = (size_t)b * SEQ + qb * 256 + wid * 32 + (lane >> 4);
    const bf16_t* s0 = (const bf16_t*)(P.ws + WS_ATT0) + row0 * D + h * 128 + 8 * ch; const bf16_t* s1 = (const bf16_t*)(P.ws + WS_ATT1) + row0 * D + h * 128 + 8 * ch;
    bf16_t* dst = (bf16_t*)(P.ws + WS_MA) + row0 * MA_LD + h * 128 + 8 * ch;
#pragma unroll
    for (int hb = 0; hb < 2; ++hb) { u32x4 ra[4], rb[4];
#pragma unroll
        for (int q = 0; q < 4; ++q) { const int it = 4 * hb + q; ra[q] = *(const u32x4*)(s0 + (size_t)(4 * it) * D); rb[q] = *(const u32x4*)(s1 + (size_t)(4 * it) * D); }
        asm volatile("" ::: "memory");
#pragma unroll
        for (int q = 0; q < 4; ++q) { const int it = 4 * hb + q;
            f32x4 a0, a1, b0, b1; pg::unpack8(ra[q], a0, a1); pg::unpack8(rb[q], b0, b1);
            const f32x4 o0 = a0 - lam * b0, o1 = a1 - lam * b1;
            float ss = (o0[0] * o0[0] + o0[1] * o0[1]) + (o0[2] * o0[2] + o0[3] * o0[3]) + (o1[0] * o1[0] + o1[1] * o1[1]) + (o1[2] * o1[2] + o1[3] * o1[3]);
            ss += __shfl_xor(ss, 1); ss += __shfl_xor(ss, 2); ss += __shfl_xor(ss, 4); ss += __shfl_xor(ss, 8);
            const float r = rsqrtf(ss * (1.f / 128.f) + EPS) * 0.8f;
            *(u32x4*)(dst + (size_t)(4 * it) * MA_LD) = pg::pack8(o0 * r * g0, o1 * r * g1); }
        asm volatile("" ::: "memory"); }
}
__device__ __forceinline__ void attn_phase(const Params& P, char* lds, int vcu, int G) {
    using attn_body::bf16;
    const bf16* Q = (const bf16*)(P.ws + WS_Q); const bf16* K = (const bf16*)(P.ws + WS_K); const bf16* V = (const bf16*)(P.ws + WS_V);
    for (int v = vcu; v < 256; v += G) {
        const int bh = v >> 2, b = bh >> 3, h = bh & 7, s = v & 3;
        for (int i = 0; i < 2; ++i) { const int qb = i == 0 ? 7 - s : s;
#ifndef ATTN_V128
#define ATTN_V128 1
#endif
#if ATTN_V128
            for (int m = 0; m < 2; ++m) {
#if EXPERTS_IN_ATTN
#ifndef CONV_SLOTS
#define CONV_SLOTS 4
#endif
#ifndef CONV_SPLIT
#define CONV_SPLIT 1
#endif
                if (CONV_SLOTS == 2 ? (i == 0 && m == ((v >> 2) & 1)) : ((i * 2 + m - (((v >> 2) + v) & 3)) & (CONV_SPLIT == 2 ? 1 : 3)) == 0) {
                    constexpr int per = (EXP_M10 - EXP_ATT0) / 256; const int hsel = CONV_SPLIT == 2 ? (((i * 2 + m - (((v >> 2) + v) & 3)) >> 1) & 1) : 0;
                    expert_convert_slice(P, (LAS unsigned char*)lds, EXP_ATT0 + v * per + hsel * (per / 2), CONV_SPLIT == 2 ? EXP_ATT0 + v * per + (hsel + 1) * (per / 2) : EXP_ATT0 + (v + 1) * per);
#if defined(PROBE_CONV2)
                    asm volatile("s_waitcnt vmcnt(0) lgkmcnt(0)" ::: "memory"); __syncthreads(); expert_convert_slice(P, (LAS unsigned char*)lds, EXP_ATT0 + v * per, EXP_ATT0 + (v + 1) * per, true);
#endif
                    asm volatile("s_waitcnt vmcnt(0) lgkmcnt(0)" ::: "memory"); __syncthreads(); }
#endif
                attn128::attn_unit<8>(b, h * 128 + m * 64, h * 128 + m * 64, h * 128, h * 128, qb, (const attn128::bf16*)Q, (const attn128::bf16*)K, (const attn128::bf16*)V, (attn128::bf16*)(P.ws + (m == 0 ? WS_ATT0 : WS_ATT1)), lds); }
#else
            for (int pass = 0; pass < 4; ++pass) { const int m = pass >> 1, vh = pass & 1;
#if EXPERTS_IN_ATTN
                if (i * 4 + pass == (((v >> 2) + v) & 3)) {
                    constexpr int per = (EXP_M10 - EXP_ATT0) / 256; expert_convert_slice(P, (LAS unsigned char*)lds, EXP_ATT0 + v * per, EXP_ATT0 + (v + 1) * per);
                    asm volatile("s_waitcnt vmcnt(0) lgkmcnt(0)" ::: "memory"); __syncthreads(); }
#endif
                attn_body::attn_unit<8>(b, h * 128 + m * 64, h * 128 + m * 64, h * 128 + vh * 64, h * 128 + vh * 64, qb, Q, K, V, (bf16*)(P.ws + (m == 0 ? WS_ATT0 : WS_ATT1)), lds); }
#endif
            asm volatile("s_waitcnt vmcnt(0)" ::: "memory");
            diff_combine(P, b, h, qb);
        }
    }
}

__device__ __forceinline__ void ssm1_phase(const Params& P, LAS unsigned char* lds, int vcu, int G) {
    const int tid = opaque_tid(), lane = tid & 63, wid = __builtin_amdgcn_readfirstlane(tid >> 6), fr = lane & 15, fq = lane >> 4;
    LAS float* Sl = (LAS float*)lds;
    for (int u = vcu; u < SSM_G * BATCH; u += G) {
        const int g = u >> 3, b = u & 7;
        bf16_t* A = (bf16_t*)(P.ws + WS_ACAT) + (size_t)(g * ACAT_ROWS + b * NCH) * ACAT_LD;
        const bf16_t* Bw = (const bf16_t*)(P.ws + WS_WS_T) + (size_t)(g * 128 + 16 * wid + fr) * 512 + fq * 8;
        f32x4 acc[4];
#pragma unroll
        for (int m = 0; m < 4; ++m) acc[m] = (f32x4){0.f, 0.f, 0.f, 0.f};
#pragma unroll 4
        for (int ks = 0; ks < 16; ++ks) {
            const bf16x8 bf = *(const bf16x8*)(Bw + ks * 32);
#pragma unroll
            for (int m = 0; m < 4; ++m) { const bf16x8 af = *(const bf16x8*)(A + (size_t)(16 * m + fr) * ACAT_LD + ks * 32 + fq * 8);
                acc[m] = __builtin_amdgcn_mfma_f32_16x16x32_bf16(af, bf, acc[m], 0, 0, 0); }
        }
#pragma unroll
        for (int m = 0; m < 4; ++m)
#pragma unroll
            for (int q = 0; q < 4; ++q) Sl[(16 * m + 4 * fq + q) * 129 + 16 * wid + fr] = acc[m][q];
        __syncthreads();
        if (tid < SSM_P) {
            const int p = tid; const SsmGP gp = ssm_gp(P, g, p); float aLr, aLi; ssm_pow(gp, CH_L, aLr, aLi);
            float xr = 0.f, xi = 0.f;
            bf16_t* xp = A + 512 + p;
            for (int c = 0; c < NCH; ++c) {
                xp[(size_t)c * ACAT_LD] = (bf16_t)f2bf(xr); xp[(size_t)c * ACAT_LD + 64] = (bf16_t)f2bf(xi);
                const float sr = Sl[c * 129 + p], si = Sl[c * 129 + 64 + p];
                const float nr = aLr * xr - aLi * xi + sr, ni = aLr * xi + aLi * xr + si; xr = nr; xi = ni;
            }
        }
        __syncthreads();
    }
}
namespace pg {
struct Ssm2Sched {
    unsigned char* ws; int G, c;
    __device__ __forceinline__ void init(unsigned char* ws_, int G_, int c_) { ws = ws_; G = G_; c = c_; }
    __device__ __forceinline__ bool next(int i, Unit& u) const {
        const int L = i * G + c; if (L >= SSM_G * 4) return false;
        const int g = L >> 2; u.pm = (L >> 1) & 1; u.pn = L & 1; u.aux = g; u.aux2 = 0; u.ord = i; const LaneRC rc;
        u.A = (const char*)((const bf16_t*)(ws + WS_ACAT) + (size_t)g * ACAT_ROWS * ACAT_LD); u.B = (const char*)((const bf16_t*)(ws + WS_BT_SSM) + ((size_t)g * 512 + u.pn * BM) * ACAT_LD);
#pragma unroll
        for (int h = 0; h < 2; ++h)
#pragma unroll
            for (int j = 0; j < 2; ++j) u.aoff[h][j] = (unsigned)(((u.pm * BM + 128 * h + rc.R[j]) * ACAT_LD + rc.C[j]) * 2);
        return true;
    }
};
}

constexpr int RT_LG_OFF = RING_BYTES + 2048;
constexpr int RT_HIST_OFF = RT_LG_OFF + 64 * 33 * 4;
__device__ __forceinline__ void router_phase(const Params& P, LAS unsigned char* lds, int vcu, int G) {
    const int tid = opaque_tid(), lane = tid & 63, wid = __builtin_amdgcn_readfirstlane(tid >> 6);
    const float* wrt = (const float*)(P.ws + WS_WR_T);
#pragma unroll
    for (int i = 0; i < 16; ++i) __builtin_amdgcn_global_load_lds((const unsigned*)(wrt + (size_t)(tid + NTHREADS * i) * 4), (LAS unsigned*)(lds + wid * 1024 + i * 8192), 16, 0, 0);
    LAS float* lg = (LAS float*)(lds + RT_LG_OFF); LAS int* hist = (LAS int*)(lds + RT_HIST_OFF);
    int* slot_tok = (int*)(P.ws + WS_SLOT_TOK); float* slot_gate = (float*)(P.ws + WS_SLOT_GATE); int* tok_ep = (int*)(P.ws + WS_TOK_EP);
    unsigned char* H2 = P.ws + WS_H2;
    for (int tb = vcu; tb < T / 64; tb += G) {
        if (tid < 64) hist[tid] = 0;
        _Pragma("clang loop unroll(disable)") for (int pass = 0; pass < 2; ++pass) {
            const int t0 = tb * 64 + wid * 8 + pass * 4;
            f32x4 h[4][4];
#pragma unroll
            for (int t = 0; t < 4; ++t)
#pragma unroll
                for (int j = 0; j < 4; ++j) h[t][j] = NT_LOAD((const f32x4*)((const float*)(P.ws + WS_X1) + (size_t)(t0 + t) * D) + lane + 64 * j);
            if (pass == 0) { asm volatile("s_waitcnt vmcnt(0)" ::: "memory"); __syncthreads(); }
            f32x2 ha[4][4], hb[4][4];
#pragma unroll
            for (int tp = 0; tp < 2; ++tp) {
                float s0 = 0.f, s1 = 0.f;
#pragma unroll
                for (int j = 0; j < 4; ++j) { const f32x4 a = h[2 * tp][j], b = h[2 * tp + 1][j]; s0 += (a.x * a.x + a.y * a.y) + (a.z * a.z + a.w * a.w); s1 += (b.x * b.x + b.y * b.y) + (b.z * b.z + b.w * b.w); }
                const float r0 = rsqrtf(wave_sum(s0) * (1.f / D) + EPS), r1 = rsqrtf(wave_sum(s1) * (1.f / D) + EPS);
#pragma unroll
                for (int j = 0; j < 4; ++j) { const f32x4 g2 = ((const f32x4*)P.in[I_G2])[lane + 64 * j]; const f32x4 a = h[2 * tp][j] * r0 * g2, b = h[2 * tp + 1][j] * r1 * g2;
                    ((unsigned*)(H2 + (size_t)(t0 + 2 * tp) * D))[lane + 64 * j] = pk4_fp8(a.x, a.y, a.z, a.w);
                    ((unsigned*)(H2 + (size_t)(t0 + 2 * tp + 1) * D))[lane + 64 * j] = pk4_fp8(b.x, b.y, b.z, b.w);
#pragma unroll
                    for (int c = 0; c < 4; ++c) { const f32x2 pr = {a[c], b[c]}; if (tp == 0) ha[j][c] = pr; else hb[j][c] = pr; } }
            }
            f32x2 v[64];
#pragma unroll
            for (int e = 0; e < NE; ++e) { f32x2 a0 = {0.f, 0.f}, a1 = {0.f, 0.f};
                f32x4 w[4];
#pragma unroll
                for (int j = 0; j < 4; ++j) w[j] = ((const LAS f32x4*)(lds + e * 4096))[lane + 64 * j];
#pragma unroll
                for (int j = 0; j < 4; ++j)
#pragma unroll
                    for (int c = 0; c < 4; ++c) { const f32x2 ww = {w[j][c], w[j][c]}; a0 += ha[j][c] * ww; a1 += hb[j][c] * ww; }
                v[e] = a0; v[32 + e] = a1; }
#pragma unroll
            for (int half = 32; half >= 1; half >>= 1) { const bool upper = (lane & half) != 0;
#pragma unroll
                for (int i = 0; i < half; ++i) { const f32x2 send = upper ? v[i] : v[i + half], keep = upper ? v[i + half] : v[i]; const f32x2 got = {__shfl_xor(send.x, half), __shfl_xor(send.y, half)}; v[i] = keep + got; } }
            const float br = P.in[I_BR][lane & 31]; const int tl = wid * 8 + pass * 4 + 2 * (lane >> 5);
            lg[tl * 33 + (lane & 31)] = v[0].x + br; lg[(tl + 1) * 33 + (lane & 31)] = v[0].y + br;
        }
        __syncthreads();
        if (wid == 0) {
            const int tok = tb * 64 + lane;
            float tv[4]; int ti[4];
#pragma unroll
            for (int k = 0; k < 4; ++k) { tv[k] = -INFINITY; ti[k] = 0; }
            for (int e = 0; e < NE; ++e) { const float x = lg[lane * 33 + e];
                if (x > tv[3]) { if (x > tv[2]) { tv[3] = tv[2]; ti[3] = ti[2]; if (x > tv[1]) { tv[2] = tv[1]; ti[2] = ti[1]; if (x > tv[0]) { tv[1] = tv[0]; ti[1] = ti[0]; tv[0] = x; ti[0] = e; } else { tv[1] = x; ti[1] = e; } } else { tv[2] = x; ti[2] = e; } } else { tv[3] = x; ti[3] = e; } } }
            const float e1 = __expf(tv[1] - tv[0]), e2 = __expf(tv[2] - tv[0]), e3 = __expf(tv[3] - tv[0]); const float inv = 1.f / (1.f + e1 + e2 + e3);
            const float gk[4] = {inv, e1 * inv, e2 * inv, e3 * inv};
            int lp[4];
#pragma unroll
            for (int k = 0; k < 4; ++k) lp[k] = atomicAdd((int*)&hist[ti[k]], 1);
            asm volatile("s_waitcnt lgkmcnt(0)" ::: "memory");
            { const int l2 = opaque_tid() & 63;
              if (l2 < NE) { const int n = hist[l2]; hist[32 + l2] = n ? (int)atomicAdd((unsigned*)(P.ws + WS_CTL) + CW_CNT + l2, (unsigned)n) : 0; } }
            asm volatile("s_waitcnt vmcnt(0) lgkmcnt(0)" ::: "memory");
#pragma unroll
            for (int k = 0; k < 4; ++k) { const int e = ti[k], pos = hist[32 + e] + lp[k];
                slot_tok[(size_t)e * CAP + pos] = tok; slot_gate[(size_t)e * CAP + pos] = gk[k]; tok_ep[tok * 4 + k] = (e << 16) | pos; }
        }
        __syncthreads();
    }
}

#ifndef COMB_Y_DEFAULT
#define COMB_Y_LOAD(p) NT_LOAD(p)
#else
#define COMB_Y_LOAD(p) (*(p))
#endif
__device__ __forceinline__ void combine_phase(const Params& P, LAS unsigned char* lds, int vcu, int G) {
    const int tid = opaque_tid(), lane = tid & 63, wid = __builtin_amdgcn_readfirstlane(tid >> 6);
    const LAS int* tab = (const LAS int*)(lds + pg::TAB_OFF);
    const int* tok_ep = (const int*)(P.ws + WS_TOK_EP); const bf16_t* Y = (const bf16_t*)(P.ws + WS_Y); const float* sgate = (const float*)(P.ws + WS_SLOT_GATE);
    for (int tok = (vcu * NWAVES + wid) * 2; tok < T; tok += G * NWAVES * 2) {
        f32x4 a[2][4]; u32x2 yv[2][4][4]; float gk[2][4];
#pragma unroll
        for (int tt = 0; tt < 2; ++tt) {
#pragma unroll
            for (int j = 0; j < 4; ++j) a[tt][j] = NT_LOAD((const f32x4*)((const float*)(P.ws + WS_X1) + (size_t)(tok + tt) * D) + lane + 64 * j);
#pragma unroll
            for (int k = 0; k < 4; ++k) { const int ep = tok_ep[(tok + tt) * 4 + k]; const int slot = tab[ep >> 16] * 256 + (ep & 0xffff); gk[tt][k] = sgate[(size_t)(ep >> 16) * CAP + (ep & 0xffff)];
#pragma unroll
                for (int j = 0; j < 4; ++j) yv[tt][k][j] = COMB_Y_LOAD((const u32x2*)(Y + (size_t)slot * D) + lane + 64 * j); } }
        asm volatile("" ::: "memory");
#pragma unroll
        for (int tt = 0; tt < 2; ++tt) {
#pragma unroll
            for (int k = 0; k < 4; ++k)
#pragma unroll
                for (int j = 0; j < 4; ++j) { const u32x2 w = yv[tt][k][j]; a[tt][j] += gk[tt][k] * (f32x4){bflo(w.x), bfhi(w.x), bflo(w.y), bfhi(w.y)}; }
#pragma unroll
            for (int j = 0; j < 4; ++j) NT_STORE(a[tt][j], (f32x4*)(P.out + (size_t)(tok + tt) * D) + lane + 64 * j); }
    }
}
#define XB_TMO      128
#define XB_XCNT(j)  (256  + 64 * (j))
#define XB_XSUB(j)  (1280 + 64 * (j))
#define XB_XGEN(j)  (2304 + 64 * (j))
#define XB_TOP      3328
#define XB_TOPGEN   3392
#define XCD_BAR_WORDS 3456
#define XB_SPIN_CAP (1u << 18)
__device__ __forceinline__ unsigned xb_ld(unsigned* p)              { return __hip_atomic_load(p, __ATOMIC_RELAXED, __HIP_MEMORY_SCOPE_AGENT); }
__device__ __forceinline__ unsigned xb_add(unsigned* p, unsigned v) { return __hip_atomic_fetch_add(p, v, __ATOMIC_RELAXED, __HIP_MEMORY_SCOPE_AGENT); }
__device__ __forceinline__ unsigned xb_xcc_id() { return (unsigned)__builtin_amdgcn_s_getreg((3 << 11) | 20) & 0xFu; }
#define XB_SPIN(cond, bar) do { unsigned _sp = 0; while (cond) { __builtin_amdgcn_s_sleep(1); \
    if ((++_sp & 255u) == 0u) { if (xb_ld(&(bar)[XB_TMO])) break; if (_sp > XB_SPIN_CAP) { atomicAdd(&(bar)[XB_TMO], 1u); break; } } } } while (0)
struct XcdBarrier { unsigned* bar; unsigned x; volatile LAS unsigned* st; };
__device__ __forceinline__ XcdBarrier xcd_barrier_post(unsigned* bar, volatile LAS unsigned* st) {
    XcdBarrier b; b.bar = bar; b.x = xb_xcc_id(); b.st = st;
    if (threadIdx.x == 0) (void)xb_add(&bar[XB_XCNT(b.x)], 1u);
    return b;
}
__device__ __forceinline__ void xcd_barrier_complete(unsigned* bar, unsigned x, unsigned& nloc, unsigned& nx) {
    const unsigned G = gridDim.x * gridDim.y * gridDim.z;
    unsigned sum, cnt, mine, sp = 0u;
    for (;;) {
        sum = 0u; cnt = 0u; mine = 0u;
#pragma unroll
        for (unsigned j = 0; j < 16; ++j) { const unsigned c = xb_ld(&bar[XB_XCNT(j)]); sum += c; cnt += (c > 0u) ? 1u : 0u; mine = (j == x) ? c : mine; }
        if (sum == G) break;
        __builtin_amdgcn_s_sleep(1);
        if ((++sp & 255u) == 0u) { if (xb_ld(&bar[XB_TMO])) break; if (sp > XB_SPIN_CAP) { atomicAdd(&bar[XB_TMO], 1u); break; } }
    }
    nloc = mine > 0u ? mine : 1u; nx = cnt > 0u ? cnt : 1u;
}
__device__ __forceinline__ void xcd_barrier(const XcdBarrier& b) {
    asm volatile("s_waitcnt vmcnt(0)" ::: "memory");
    __syncthreads();
    if (threadIdx.x == 0) {
        unsigned* bar = b.bar;
        __builtin_amdgcn_s_waitcnt(0);
        unsigned nloc = b.st[0], nx = b.st[1];
        if (nloc == 0u) { xcd_barrier_complete(bar, b.x, nloc, nx); b.st[0] = nloc; b.st[1] = nx; }
        const unsigned old = xb_add(&bar[XB_XSUB(b.x)], 1u);
        const unsigned gen = old / nloc;
        if (old + 1u == (gen + 1u) * nloc) {
            __builtin_amdgcn_fence(__ATOMIC_RELEASE, "agent");
            asm volatile("s_waitcnt vmcnt(0)" ::: "memory");
            const unsigned og = xb_add(&bar[XB_TOP], 1u);
            const unsigned tg = og / nx;
            if (og + 1u == (tg + 1u) * nx) xb_add(&bar[XB_TOPGEN], 1u);
            else XB_SPIN(xb_ld(&bar[XB_TOPGEN]) == tg, bar);
            __builtin_amdgcn_fence(__ATOMIC_ACQUIRE, "agent");
            xb_add(&bar[XB_XGEN(b.x)], 1u);
            asm volatile("s_waitcnt vmcnt(0)" ::: "memory");
        } else {
            XB_SPIN(xb_ld(&bar[XB_XGEN(b.x)]) == gen, bar);
            __builtin_amdgcn_fence(__ATOMIC_ACQUIRE, "agent");
            asm volatile("s_waitcnt vmcnt(0)" ::: "memory");
        }
    }
    __syncthreads();
}
#ifndef PH_MASK
#define PH_MASK 0xffffffffu
#endif
__global__ void __launch_bounds__(NTHREADS, 2) mega_fwd(Params P) {
    extern __shared__ __attribute__((aligned(16))) unsigned char lds_[];
    LAS unsigned char* lds = (LAS unsigned char*)lds_;
    const int tid = threadIdx.x;
    const int G = gridDim.x, bx = blockIdx.x, vcu = (G % 8 == 0) ? (bx % 8) * (G / 8) + bx / 8 : bx;
    for (int u = tid; u < (LDS_BYTES - RING_BYTES) / 4; u += NTHREADS) ((LAS unsigned*)(lds + RING_BYTES))[u] = 0u;
    __syncthreads();
    unsigned* ctl = (unsigned*)(P.ws + WS_CTL);
    const XcdBarrier bar = xcd_barrier_post(ctl + CW_BAR, (volatile LAS unsigned*)(lds + MISC_OFF) + 8);
#ifndef PH_REP
#define PH_REP 0u
#endif
#ifndef BAR_REP
#define BAR_REP 1
#endif
#define GRID_BAR() do { for (int b_ = 0; b_ < BAR_REP; ++b_) xcd_barrier(bar); } while (0)
#define ON(k) for (int r_ = 0; r_ < 1 + (int)((PH_REP >> (k)) & 1u); ++r_) if ((PH_MASK >> (k)) & 1u)
#ifndef FWD_REP
#define FWD_REP 1
#endif
    for (int fwd_ = 0; fwd_ < FWD_REP; ++fwd_) {
    if (fwd_ > 0) { GRID_BAR(); if (bx == 0 && tid < 64) ctl[CW_CNT + tid] = 0u; }
    ON(0) p0_prologue(P, lds, vcu, G);
    GRID_BAR();
    ON(1) { pg::DenseSched S; S.init((const bf16_t*)(P.ws + WS_XN), D, (const bf16_t*)(P.ws + WS_WIN_T), D, T, IN_W, G, bx);
        pg::EpiInProj E; E.ws = P.ws; E.qg = P.in[I_QG]; E.kg = P.in[I_KG];
#if defined(PROBE_NULL_EPI)
        if (r_ == 1) { pg::EpiNull EN; pg::gemm_phase(lds, S, EN, D / 64, D); } else
#endif
#ifndef INPROJ_BAUX
#define INPROJ_BAUX 0
#endif
        pg::gemm_phase<false, INPROJ_BAUX>(lds, S, E, D / 64, D);
#if EXPERTS_IN_ATTN
        if (r_ == 0 && G == 256 && bx >= 128) expert_convert_slice(P, lds, EXP_IN0 + (bx - 128) * EXP_N_IN, EXP_IN0 + (bx - 127) * EXP_N_IN);
        __syncthreads();
#endif
    }
    GRID_BAR();
    ON(2) { ssm_toeplitz_expand(P, vcu, G); ssm1_phase(P, lds, vcu, G); }
    ON(3) attn_phase(P, (char*)lds_, vcu, G);
    GRID_BAR();
    ON(4) { pg::Ssm2Sched S; S.init(P.ws, G, bx); pg::EpiSsm2 E; E.ws = P.ws; pg::gemm_phase(lds, S, E, ACAT_LD / 64, ACAT_LD);
#if EXPERTS_IN_ATTN
        if (r_ == 0 && G == 256 && bx >= 128) expert_convert_slice(P, lds, EXP_S20 + (bx - 128) * EXP_N_S2, EXP_S20 + (bx - 127) * EXP_N_S2);
        __syncthreads();
#endif
    }
    GRID_BAR();
    ON(5) { pg::DenseSched S; S.init((const bf16_t*)(P.ws + WS_Z), SSM_W, (const bf16_t*)(P.ws + WS_WGLU_T), SSM_W, T, SSM_W, G, bx);
        pg::EpiGlu E; E.ws = P.ws; E.bglu = P.in[I_BGLU]; pg::gemm_phase(lds, S, E, SSM_W / 64, SSM_W);
#if EXPERTS_IN_ATTN
        if (r_ == 0 && G == 256 && bx >= 128) expert_convert_slice(P, lds, EXP_GLU0 + (bx - 128) * EXP_N_GLU, EXP_GLU0 + (bx - 127) * EXP_N_GLU);
        __syncthreads();
#endif
    }
    GRID_BAR();
    ON(6) { pg::DenseSched S; S.init((const bf16_t*)(P.ws + WS_MA), MA_LD, (const bf16_t*)(P.ws + WS_WP_T), MA_LD, T, D, G, bx);
        pg::EpiMerged E; E.ws = P.ws; pg::gemm_phase(lds, S, E, MA_LD / 64, MA_LD); }
    GRID_BAR();
    ON(7) { pg::DenseSched S; S.init((const bf16_t*)(P.ws + WS_MERGED), D, (const bf16_t*)(P.ws + WS_WOUT_T), D, T, D, G, bx);
        pg::EpiWout E; E.x = P.in[I_X]; E.out = (float*)(P.ws + WS_X1); pg::gemm_phase(lds, S, E, D / 64, D); }
    GRID_BAR();
    ON(8) router_phase(P, lds, vcu, G);
    GRID_BAR();
    pg::moe_build_tab(lds, (const unsigned*)(P.ws + WS_CTL) + CW_CNT);
    ON(9) { pg::MoeSched<1> S; S.init(P.ws, lds, G, bx, P.in[I_B1]); pg::EpiMoe1 E; E.ws = P.ws; E.b1 = P.in[I_B1]; E.lds = lds; E.nostore = (r_ == 1);
#if defined(PROBE_MOE_NT)
        if (r_ == 1) { pg::EpiNull EN; pg::gemm_phase<true>(lds, S, EN, PROBE_MOE_NT, D / 2, 7); } else
#endif
        pg::gemm_phase<true>(lds, S, E, D / 128, D / 2);
#if EXPERTS_IN_ATTN
        if (r_ == 0 && G == 256 && (bx >> 3) >= 16) { const int k_ = (bx & 7) * 16 + (bx >> 3) - 16; expert_convert_slice(P, lds, EXP_M10 + k_ * EXP_N_M1, EXP_M10 + (k_ + 1) * EXP_N_M1); }
        __syncthreads();
#endif
    }
    GRID_BAR();
    ON(10) { pg::MoeSched<2> S; S.init(P.ws, lds, G, bx, P.in[I_B2]);
#if defined(PROBE_FREEZE)
        S.freeze = (r_ == 1);
#endif
 pg::EpiMoe2 E; E.ws = P.ws; E.b2 = P.in[I_B2]; E.lds = lds; E.nostore = (r_ == 1);
#if defined(PROBE_MOE_NT)
        if (r_ == 1) { pg::EpiNull EN; pg::gemm_phase<true>(lds, S, EN, PROBE_MOE_NT, DFF / 2, 7); } else
#endif
        pg::gemm_phase<true>(lds, S, E, DFF / 128, DFF / 2); }
    GRID_BAR();
    ON(11) combine_phase(P, lds, vcu, G);
    }
#undef ON
}

extern "C" void kernel_launch(void* const* d_in, const int* in_sizes, int n_in, void* d_out, int out_size, void* d_ws, size_t ws_size, hipStream_t stream) {
    static int grid = 0;
    if (grid == 0) {
        int dev = 0, cus = 0, per_cu = 0;
        if (hipGetDevice(&dev) != hipSuccess || hipDeviceGetAttribute(&cus, hipDeviceAttributeMultiprocessorCount, dev) != hipSuccess) { fprintf(stderr, "kernel_launch: device query failed\n"); grid = -1; return; }
        if (hipFuncSetAttribute((const void*)mega_fwd, hipFuncAttributeMaxDynamicSharedMemorySize, LDS_BYTES) != hipSuccess) { fprintf(stderr, "kernel_launch: hipFuncSetAttribute failed\n"); grid = -1; return; }
        if (hipOccupancyMaxActiveBlocksPerMultiprocessor(&per_cu, (const void*)mega_fwd, NTHREADS, LDS_BYTES) != hipSuccess || per_cu < 1) { fprintf(stderr, "kernel_launch: occupancy query reports %d workgroups per CU\n", per_cu); per_cu = 1; }
        (void)hipGetLastError();
        grid = cus;
        if (ws_size < WS_END) { fprintf(stderr, "kernel_launch: workspace too small\n"); grid = -1; return; }
    }
    if (grid < 0) return;
    hipMemsetAsync((char*)d_ws + WS_CTL, 0, CTL_ZERO_BYTES, stream);
    Params P{};
    for (int i = 0; i < 30; ++i) P.in[i] = (const float*)d_in[i];
    P.out = (float*)d_out; P.ws = (unsigned char*)d_ws;
    hipLaunchKernelGGL(mega_fwd, dim3(grid), dim3(NTHREADS), LDS_BYTES, stream, P);
#if defined(PROBE_TWO_LAUNCHES)
    hipMemsetAsync((char*)d_ws + WS_CTL, 0, CTL_ZERO_BYTES, stream);
    hipLaunchKernelGGL(mega_fwd, dim3(grid), dim3(NTHREADS), LDS_BYTES, stream, P);
#endif
}
```

```cpp
#include <hip/hip_runtime.h>
#include <hip/hip_bf16.h>
#include <stdint.h>
#include <math.h>
#include <cstdio>

constexpr int D = 1024, BATCH = 8, SEQ = 2048, T = BATCH * SEQ;
constexpr int SSM_W = 512, SSM_H = 16, SSM_G = 32, SSM_P = 64;
constexpr int CH_L = 32, NCH = SEQ / CH_L;
constexpr int ACAT_ROWS = BATCH * NCH;
constexpr int ACAT_LD = CH_L * SSM_H + 2 * SSM_P;
constexpr int AH = 8, AW = 1024;
constexpr int IN_W = 5632;
constexpr int NE = 32, DFF = 1024;
constexpr float EPS = 1e-5f;
constexpr int OFF_U = 0, OFF_Q = 512, OFF_K = 1536, OFF_V = 2560, OFF_GS = 3584, OFF_GA = 4608;
constexpr int CAP = T;
constexpr int MAXBLK = 288;
constexpr float QC2 = 0.125f * 1.4426950408889634f;
constexpr int MA_LD = 1536;

constexpr size_t MiB = 1u << 20;
constexpr size_t WS_CTL = 0, CTL_ZERO_BYTES = 64 * 1024;
constexpr size_t WS_WIN_T = 2 * MiB;
constexpr size_t WS_WGLU_T = 13 * MiB;
constexpr size_t WS_WP_T = 14 * MiB;
constexpr size_t WS_WOUT_T = 17 * MiB;
constexpr size_t WS_WR_T = 19 * MiB;
constexpr size_t WS_KJ = 21 * MiB;
constexpr size_t WS_WS_T = 22 * MiB;
constexpr size_t WS_BT_SSM = 26 * MiB;
constexpr size_t WS_W1_T = 48 * MiB;
constexpr size_t WS_W2_T = 176 * MiB;
constexpr size_t WS_XN = 240 * MiB;
constexpr size_t WS_ACAT = 272 * MiB;
constexpr size_t WS_Q = 292 * MiB, WS_K = 324 * MiB, WS_V = 356 * MiB;
constexpr size_t WS_GS = 388 * MiB, WS_GA = 420 * MiB;
constexpr size_t WS_X1 = 292 * MiB;
constexpr size_t WS_Z = 452 * MiB;
constexpr size_t WS_MA = 468 * MiB;
constexpr size_t WS_MERGED = 516 * MiB;
constexpr size_t WS_H2 = 548 * MiB;
constexpr size_t WS_SLOT_TOK = 582 * MiB;
constexpr size_t WS_SLOT_GATE = 584 * MiB;
constexpr size_t WS_TOK_EP = 586 * MiB;
constexpr size_t WS_ACT = 588 * MiB;
constexpr size_t WS_Y = 732 * MiB;
constexpr size_t WS_END = 876 * MiB;
constexpr int CW_CNT = 64;
constexpr int CW_BAR = 4096;

typedef unsigned short bf16_t;
typedef short bf16x8 __attribute__((ext_vector_type(8)));
typedef float f32x4 __attribute__((ext_vector_type(4)));
typedef float f32x2 __attribute__((ext_vector_type(2)));
typedef unsigned u32x4 __attribute__((ext_vector_type(4)));
typedef unsigned u32x2 __attribute__((ext_vector_type(2)));
#define LAS __attribute__((address_space(3)))
#define GAS __attribute__((address_space(1)))

__device__ __forceinline__ float wave_sum(float v) {
#pragma unroll
    for (int o = 1; o < 64; o <<= 1) v += __shfl_xor(v, o);
    return v;
}
typedef __bf16 bf16x2_hw __attribute__((ext_vector_type(2)));
__device__ __forceinline__ unsigned pk2(float lo, float hi) { const f32x2 v = {lo, hi}; return __builtin_bit_cast(unsigned, __builtin_convertvector(v, bf16x2_hw)); }
__device__ __forceinline__ unsigned f2bf(float f) { return pk2(f, 0.f) & 0xffffu; }
__device__ __forceinline__ float bf2f(unsigned short b) { return __builtin_bit_cast(float, (unsigned)b << 16); }
__device__ __forceinline__ float bflo(unsigned w) { return __builtin_bit_cast(float, w << 16); }
__device__ __forceinline__ float bfhi(unsigned w) { return __builtin_bit_cast(float, w & 0xffff0000u); }
__device__ __forceinline__ float sigmoid_f(float x) { return __builtin_amdgcn_rcpf(1.f + __expf(-x)); }
__device__ __forceinline__ float sigmoid_c(float x) { x = fminf(fmaxf(x, -30.f), 30.f); return __builtin_amdgcn_rcpf(1.f + __expf(-x)); }
__device__ __forceinline__ float gelu_tanh(float x) { const float u = 0.7978845608028654f * (x + 0.044715f * x * x * x); return x * sigmoid_f(2.f * u); }

__device__ __forceinline__ unsigned pk4_fp8(float a, float b, float cc, float d) { int w = 0; w = __builtin_amdgcn_cvt_pk_fp8_f32(a, b, w, false); w = __builtin_amdgcn_cvt_pk_fp8_f32(cc, d, w, true); return (unsigned)w; }
__device__ __forceinline__ void unpk4_fp8(unsigned w, float& a, float& b, float& cc, float& d) { const f32x2 lo = __builtin_amdgcn_cvt_pk_f32_fp8((int)w, false), hi = __builtin_amdgcn_cvt_pk_f32_fp8((int)w, true); a = lo.x; b = lo.y; cc = hi.x; d = hi.y; }
constexpr float W8_SCALE = 64.f;
#ifndef WT_STORES
#define WT_STORES 0
#endif
__device__ __forceinline__ void store16(void* p, const u32x4 v) {
#if WT_STORES
    asm volatile("global_store_dwordx4 %0, %1, off sc1\n\ts_nop 1" :: "v"(p), "v"(v) : "memory");
#else
    *(u32x4*)p = v;
#endif
}
#ifndef NT_STREAMS
#define NT_STREAMS 1
#endif
#if NT_STREAMS
#define NT_LOAD(p) __builtin_nontemporal_load(p)
#define NT_STORE(v, p) __builtin_nontemporal_store((v), (p))
#else
#define NT_LOAD(p) (*(p))
#define NT_STORE(v, p) (*(p) = (v))
#endif
__device__ __forceinline__ int opaque_tid() { int t = threadIdx.x; asm volatile("" : "+v"(t)); return t; }

struct Params {
    const float* in[30];
    float* out;
    unsigned char* ws;
};
enum { I_X = 0, I_G1, I_WIN, I_LRE, I_LIM, I_LOGDT, I_BRE, I_BIM, I_CRE, I_CIM, I_DSK, I_WGLU, I_BGLU, I_QG, I_KG, I_LQ1, I_LK1, I_LQ2, I_LK2, I_SG, I_WPS, I_WPA, I_WOUT, I_G2, I_WR, I_BR, I_W1, I_B1, I_W2, I_B2 };

constexpr int NWAVES = 8, NTHREADS = 512;
constexpr int LDS_BYTES = 147456;
constexpr int RING_BYTES = 131072;
constexpr int MISC_OFF = RING_BYTES + 320;
__device__ __forceinline__ void p0_transpose_item(const float* __restrict__ W, int N, bf16_t* __restrict__ WT, int ldo, int k_off, LAS float* scr, int kb, int nb, int lane) {
    const int k0 = 64 * kb, n0 = 32 * nb;
    { f32x4 v[8];
#pragma unroll
        for (int i = 0; i < 8; ++i) v[i] = NT_LOAD((const f32x4*)(W + (size_t)(k0 + 8 * i + (lane >> 3)) * N + n0 + (lane & 7) * 4));
#pragma unroll
        for (int i = 0; i < 8; ++i) { LAS float* d = scr + (8 * i + (lane >> 3)) * 33 + (lane & 7) * 4; d[0] = v[i].x; d[1] = v[i].y; d[2] = v[i].z; d[3] = v[i].w; } }
    asm volatile("s_waitcnt lgkmcnt(0)" ::: "memory");
    const int c = lane & 7;
#pragma unroll
    for (int j = 0; j < 4; ++j) { const int n = (lane >> 3) + 8 * j; const LAS float* s = scr + (8 * c) * 33 + n;
        u32x4 o; o.x = pk2(s[0 * 33], s[1 * 33]); o.y = pk2(s[2 * 33], s[3 * 33]); o.z = pk2(s[4 * 33], s[5 * 33]); o.w = pk2(s[6 * 33], s[7 * 33]);
        *(u32x4*)(WT + (size_t)(n0 + n) * ldo + k_off + k0 + 8 * c) = o; }
    asm volatile("s_waitcnt lgkmcnt(0)" ::: "memory");
}
__device__ __forceinline__ void p0_transpose_item_fp8(const float* __restrict__ W, int N, unsigned char* __restrict__ WT, int ldo, LAS float* scr, int kb, int nb, int lane) {
    const int k0 = 64 * kb, n0 = 32 * nb;
    { f32x4 v[8];
#pragma unroll
        for (int i = 0; i < 8; ++i) v[i] = NT_LOAD((const f32x4*)(W + (size_t)(k0 + 8 * i + (lane >> 3)) * N + n0 + (lane & 7) * 4));
#pragma unroll
        for (int i = 0; i < 8; ++i) { LAS float* d = scr + (8 * i + (lane >> 3)) * 33 + (lane & 7) * 4; d[0] = v[i].x; d[1] = v[i].y; d[2] = v[i].z; d[3] = v[i].w; } }
    asm volatile("s_waitcnt lgkmcnt(0)" ::: "memory");
    const int n = lane >> 1, half = lane & 1; const LAS float* s = scr + (32 * half) * 33 + n;
    unsigned o[8];
#pragma unroll
    for (int q = 0; q < 8; ++q) o[q] = pk4_fp8(s[(4 * q) * 33] * W8_SCALE, s[(4 * q + 1) * 33] * W8_SCALE, s[(4 * q + 2) * 33] * W8_SCALE, s[(4 * q + 3) * 33] * W8_SCALE);
    u32x4* dst = (u32x4*)(WT + (size_t)(n0 + n) * ldo + k0 + 32 * half);
    dst[0] = (u32x4){o[0], o[1], o[2], o[3]}; dst[1] = (u32x4){o[4], o[5], o[6], o[7]};
    asm volatile("s_waitcnt lgkmcnt(0)" ::: "memory");
}
__device__ __forceinline__ void p0_transpose_f32_item(const float* __restrict__ W, float* __restrict__ WT, int K, LAS float* scr, int kb, int lane) {
    const int k0 = 64 * kb;
#pragma unroll 8
    for (int i = 0; i < 32; ++i) { const int kk = 2 * i + (lane >> 5); scr[kk * 33 + (lane & 31)] = W[(size_t)(k0 + kk) * 32 + (lane & 31)]; }
    asm volatile("s_waitcnt lgkmcnt(0)" ::: "memory");
#pragma unroll 8
    for (int n = 0; n < 32; ++n) WT[(size_t)n * K + k0 + lane] = scr[lane * 33 + n];
    asm volatile("s_waitcnt lgkmcnt(0)" ::: "memory");
}
__device__ __forceinline__ void rms_row_to_bf16(const float* __restrict__ xrow, const float* __restrict__ g, bf16_t* __restrict__ orow, int lane) {
    const f32x4* xr = (const f32x4*)xrow + lane; const f32x4* gr = (const f32x4*)g + lane;
    f32x4 v[4]; float s = 0.f;
#pragma unroll
    for (int j = 0; j < 4; ++j) { v[j] = NT_LOAD(xr + 64 * j); s += (v[j].x * v[j].x + v[j].y * v[j].y) + (v[j].z * v[j].z + v[j].w * v[j].w); }
    const float r = rsqrtf(wave_sum(s) * (1.f / D) + EPS);
    u32x2* o8 = (u32x2*)orow + lane;
#pragma unroll
    for (int j = 0; j < 4; ++j) { const f32x4 gg = gr[64 * j]; u32x2 w; w.x = pk2(v[j].x * r * gg.x, v[j].y * r * gg.y); w.y = pk2(v[j].z * r * gg.z, v[j].w * r * gg.w); o8[64 * j] = w; }
}
struct SsmGP { float lrdt, lidt, cr, ci; };
__device__ __forceinline__ SsmGP ssm_gp(const Params& P, int g, int p) {
    const float dt = expf(P.in[I_LOGDT][g]);
    const float lr = fminf(P.in[I_LRE][g * SSM_P + p], -1e-4f), li = P.in[I_LIM][g * SSM_P + p];
    const float mag = expf(lr * dt);
    float sn, cs; sincosf(li * dt, &sn, &cs);
    const float ar = mag * cs, ai = mag * sn;
    const float den = lr * lr + li * li, nr = ar - 1.f;
    SsmGP r; r.lrdt = lr * dt; r.lidt = li * dt; r.cr = (nr * lr + ai * li) / den; r.ci = (ai * lr - nr * li) / den;
    return r;
}
__device__ __forceinline__ void ssm_pow(const SsmGP& q, int j, float& pr, float& pi) {
    const float m = expf((float)j * q.lrdt); float sn, cs; sincosf((float)j * q.lidt, &sn, &cs); pr = m * cs; pi = m * sn;
}

#ifndef EXP_DMA_AUX
#define EXP_DMA_AUX 2
#endif
struct ExpItem { const float* W; unsigned char* WT; int N, ldo, kb, nb, sw; };
__device__ __forceinline__ ExpItem exp_item(const Params& P, int it) {
    constexpr int I_E1 = (1024 / 128) * (2048 / 32), I_E2 = (1024 / 128) * (1024 / 32);
    ExpItem x;
    if (it < NE * I_E1) { const int e = it / I_E1, q = it % I_E1; x.W = P.in[I_W1] + (size_t)e * D * 2 * DFF; x.WT = P.ws + WS_W1_T + (size_t)e * 2 * DFF * D; x.N = 2 * DFF; x.ldo = D; x.kb = q / 64; x.nb = q % 64; x.sw = 3; }
    else { const int r = it - NE * I_E1, e = r / I_E2, q = r % I_E2; x.W = P.in[I_W2] + (size_t)e * DFF * D; x.WT = P.ws + WS_W2_T + (size_t)e * D * DFF; x.N = D; x.ldo = DFF; x.kb = q / 32; x.nb = q % 32; x.sw = 0; }
    return x;
}
__device__ __forceinline__ void exp_dma(const ExpItem& x, int lane, LAS unsigned char* buf) {
    const float* src = x.W + (size_t)(128 * x.kb + (lane >> 3)) * x.N + 32 * x.nb;
#pragma unroll
    for (int i = 0; i < 16; ++i) __builtin_amdgcn_global_load_lds((const unsigned*)(src + (size_t)(8 * i) * x.N + ((((lane & 7) ^ (lane >> 3) ^ (i >> 1)) & 7) << 2)), (LAS unsigned*)(buf + i * 1024), 16, 0, EXP_DMA_AUX);
}
#if defined(PROBE_CONV_NOSTORE)
#define g_conv_nostore nostore_
__device__ __forceinline__ void exp_finish_lds(const ExpItem& x, int lane, const LAS unsigned char* buf, bool nostore_ = false) {
#else
__device__ __forceinline__ void exp_finish_lds(const ExpItem& x, int lane, const LAS unsigned char* buf) {
#endif
    const int c = lane & 7;
#pragma unroll
    for (int pass = 0; pass < 4; ++pass) {
        const int n = 8 * pass + (lane >> 3), q0 = (n >> 2) ^ c;
        const int no = n ^ ((((n >> 1) ^ n) & 1) ? x.sw : 0);
        const LAS unsigned char* rb = buf + c * 2048 + ((n & 3) << 2);
        float f[16];
#pragma unroll
        for (int j = 0; j < 16; ++j) f[j] = *(const LAS float*)(rb + j * 128 + (((q0 ^ j) & 7) << 4)) * W8_SCALE;
        const u32x4 o = (u32x4){pk4_fp8(f[0], f[1], f[2], f[3]), pk4_fp8(f[4], f[5], f[6], f[7]), pk4_fp8(f[8], f[9], f[10], f[11]), pk4_fp8(f[12], f[13], f[14], f[15])};
#if defined(PROBE_CONV_NOSTORE)
        if (g_conv_nostore) { asm volatile("" :: "v"(o)); } else
#endif
#if NT_STREAMS && !defined(CONV_ST_DEFAULT)
        __builtin_nontemporal_store(o, (u32x4*)(x.WT + (size_t)(32 * x.nb + no) * x.ldo + 128 * x.kb + 16 * c));
#else
        *(u32x4*)(x.WT + (size_t)(32 * x.nb + no) * x.ldo + 128 * x.kb + 16 * c) = o;
#endif
    }
    asm volatile("s_waitcnt lgkmcnt(0)" ::: "memory");
}
constexpr int EXP_ITEMS = NE * ((1024 / 128) * (2048 / 32) + (1024 / 128) * (1024 / 32));
constexpr int EXP_N_IN = 32, EXP_N_S2 = 20, EXP_N_GLU = 20, EXP_N_M1 = 0;
constexpr int EXP_IN0 = 0, EXP_S20 = 128 * EXP_N_IN, EXP_GLU0 = EXP_S20 + 128 * EXP_N_S2, EXP_ATT0 = EXP_GLU0 + 128 * EXP_N_GLU, EXP_M10 = EXP_ITEMS - 128 * EXP_N_M1;
static_assert((EXP_M10 - EXP_ATT0) % 256 == 0 && EXP_M10 >= NE * (1024 / 128) * (2048 / 32), "item split (the expert-GEMM-1 tail share must be W2 items only)");
__device__ __forceinline__ void expert_convert_slice(const Params& P, LAS unsigned char* lds, int i0, int i1, bool probe_nostore = false) {
    const int tid = opaque_tid(), lane = tid & 63, wave = __builtin_amdgcn_readfirstlane(tid >> 6);
    LAS unsigned char* b0 = lds + wave * 16384;
    for (int it = i0 + wave; it < i1; it += NWAVES) {
        const ExpItem c0 = exp_item(P, it);
        exp_dma(c0, lane, b0);
        asm volatile("s_waitcnt vmcnt(0)" ::: "memory");
#if defined(PROBE_CONV_NOSTORE)
        exp_finish_lds(c0, lane, b0, probe_nostore);
#else
        exp_finish_lds(c0, lane, b0);
#endif
    }
}
__device__ __forceinline__ void p0_prologue(const Params& P, LAS unsigned char* lds, int vcu, int G) {
    const int tid = opaque_tid(), lane = tid & 63, wave = __builtin_amdgcn_readfirstlane(tid >> 6);
    LAS float* scr = (LAS float*)(lds + wave * 16384);
    unsigned char* ws = P.ws;
    const int gw = vcu * NWAVES + wave, NGW = G * NWAVES;
    constexpr int I_IN = (D / 64) * (IN_W / 32);
    constexpr int I_GLU = (512 / 64) * (512 / 32);
    constexpr int I_PS = (512 / 64) * (1024 / 32);
    constexpr int I_PA = (1024 / 64) * (1024 / 32);
    constexpr int I_OUT = I_PA;
    constexpr int I_R = 1024 / 64;
    constexpr int I_E1 = (1024 / 64) * (2048 / 32);
    constexpr int I_E2 = (1024 / 64) * (1024 / 32);
#ifndef EXPERTS_IN_ATTN
#define EXPERTS_IN_ATTN 1
#endif
    constexpr int NITEMS = I_IN + I_GLU + I_PS + I_PA + I_OUT + I_R + (EXPERTS_IN_ATTN ? 0 : NE * I_E1 + NE * I_E2);
    for (int it = gw; it < NITEMS; it += NGW) {
        int r = it;
        if (r < I_IN) { const int nblk = IN_W / 32; p0_transpose_item(P.in[I_WIN], IN_W, (bf16_t*)(ws + WS_WIN_T), D, 0, scr, r / nblk, r % nblk, lane); continue; } r -= I_IN;
        if (r < I_GLU) { const int nblk = 512 / 32; p0_transpose_item(P.in[I_WGLU], 512, (bf16_t*)(ws + WS_WGLU_T), 512, 0, scr, r / nblk, r % nblk, lane); continue; } r -= I_GLU;
        if (r < I_PS) { const int nblk = 1024 / 32; p0_transpose_item(P.in[I_WPS], 1024, (bf16_t*)(ws + WS_WP_T), MA_LD, 1024, scr, r / nblk, r % nblk, lane); continue; } r -= I_PS;
        if (r < I_PA) { const int nblk = 1024 / 32; p0_transpose_item(P.in[I_WPA], 1024, (bf16_t*)(ws + WS_WP_T), MA_LD, 0, scr, r / nblk, r % nblk, lane); continue; } r -= I_PA;
        if (r < I_OUT) { const int nblk = 1024 / 32; p0_transpose_item(P.in[I_WOUT], 1024, (bf16_t*)(ws + WS_WOUT_T), D, 0, scr, r / nblk, r % nblk, lane); continue; } r -= I_OUT;
        if (r < I_R) { p0_transpose_f32_item(P.in[I_WR], (float*)(ws + WS_WR_T), D, scr, r, lane); continue; } r -= I_R;
        if (EXPERTS_IN_ATTN) continue;
        if (r < NE * I_E1) { const int e = r / I_E1, q = r % I_E1, nblk = 2048 / 32;
            p0_transpose_item_fp8(P.in[I_W1] + (size_t)e * D * 2 * DFF, 2 * DFF, ws + WS_W1_T + (size_t)e * 2 * DFF * D, D, scr, q / nblk, q % nblk, lane); continue; } r -= NE * I_E1;
        { const int e = r / I_E2, q = r % I_E2, nblk = 1024 / 32;
            p0_transpose_item_fp8(P.in[I_W2] + (size_t)e * DFF * D, D, ws + WS_W2_T + (size_t)e * D * DFF, DFF, scr, q / nblk, q % nblk, lane); }
    }
#if EXPERTS_IN_ATTN
    if (G != 256) { __syncthreads(); for (int c0 = vcu * 64; c0 < EXP_ATT0; c0 += G * 64) expert_convert_slice(P, lds, c0, min(EXP_ATT0, c0 + 64));
        for (int c0 = EXP_M10 + vcu * 64; c0 < EXP_ITEMS; c0 += G * 64) expert_convert_slice(P, lds, c0, min(EXP_ITEMS, c0 + 64)); __syncthreads(); }
#endif
    for (int m = gw; m < T; m += NGW) rms_row_to_bf16(P.in[I_X] + (size_t)m * D, P.in[I_G1], (bf16_t*)(ws + WS_XN) + (size_t)m * D, lane);
    if (gw == 0) { u32x4* z = (u32x4*)(ws + WS_H2 + (size_t)T * D); z[lane] = (u32x4){0u, 0u, 0u, 0u}; }
    const int gt = vcu * NTHREADS + tid, NGT = G * NTHREADS;
    for (int it = gw; it < SSM_G * CH_L; it += NGW) {
        const int g = it / CH_L, j = it % CH_L, h = lane >> 2, hq = (lane & 3) * 4;
        { const SsmGP q = ssm_gp(P, g, lane); float pr, pi; ssm_pow(q, j, pr, pi); scr[2 * lane] = pr * q.cr - pi * q.ci; scr[2 * lane + 1] = pr * q.ci + pi * q.cr; }
        asm volatile("s_waitcnt lgkmcnt(0)" ::: "memory");
        float a0 = 0.f, a1 = 0.f, a2 = 0.f, a3 = 0.f;
#pragma unroll 4
        for (int p = 0; p < SSM_P; ++p) {
            const float wr = scr[2 * p], wi = scr[2 * p + 1];
            const float cre = P.in[I_CRE][(g * SSM_H + h) * SSM_P + p], cim = P.in[I_CIM][(g * SSM_H + h) * SSM_P + p];
            const float mr = cre * wr - cim * wi, mi = cre * wi + cim * wr;
            const f32x4 br = *(const f32x4*)(P.in[I_BRE] + (g * SSM_P + p) * SSM_H + hq), bi = *(const f32x4*)(P.in[I_BIM] + (g * SSM_P + p) * SSM_H + hq);
            a0 += mr * br.x - mi * bi.x; a1 += mr * br.y - mi * bi.y; a2 += mr * br.z - mi * bi.z; a3 += mr * br.w - mi * bi.w;
        }
        if (j == 0) { const float dsk = P.in[I_DSK][g * SSM_H + h]; if (hq == (h & 12)) { const int w = h & 3; if (w == 0) a0 += dsk; else if (w == 1) a1 += dsk; else if (w == 2) a2 += dsk; else a3 += dsk; } }
        *(f32x4*)((float*)(ws + WS_KJ) + ((size_t)(g * CH_L + j) * SSM_H + h) * SSM_H + hq) = (f32x4){a0, a1, a2, a3};
        asm volatile("s_waitcnt lgkmcnt(0)" ::: "memory");
    }
    for (int it = gt; it < SSM_G * 128 * CH_L; it += NGT) {
        const int s = it % CH_L, n = (it / CH_L) % 128, g = it / (CH_L * 128), p = n & 63, part = n >> 6;
        const SsmGP q = ssm_gp(P, g, p); float pr, pi; ssm_pow(q, CH_L - 1 - s, pr, pi);
        const float wr = pr * q.cr - pi * q.ci, wi = pr * q.ci + pi * q.cr;
        const float* br = P.in[I_BRE] + (g * SSM_P + p) * SSM_H; const float* bi = P.in[I_BIM] + (g * SSM_P + p) * SSM_H;
        unsigned o[8];
#pragma unroll
        for (int h2 = 0; h2 < 8; ++h2) {
            float v0, v1;
            if (part == 0) { v0 = wr * br[2 * h2] - wi * bi[2 * h2]; v1 = wr * br[2 * h2 + 1] - wi * bi[2 * h2 + 1]; }
            else { v0 = wr * bi[2 * h2] + wi * br[2 * h2]; v1 = wr * bi[2 * h2 + 1] + wi * br[2 * h2 + 1]; }
            o[h2] = pk2(v0, v1);
        }
        u32x4* dst = (u32x4*)((bf16_t*)(ws + WS_WS_T) + ((size_t)(g * 128 + n) * 512 + s * 16));
        dst[0] = (u32x4){o[0], o[1], o[2], o[3]}; dst[1] = (u32x4){o[4], o[5], o[6], o[7]};
    }
    for (int it = gt; it < SSM_G * CH_L * SSM_P; it += NGT) {
        const int p = it % SSM_P, t = (it / SSM_P) % CH_L, g = it / (SSM_P * CH_L);
        const SsmGP q = ssm_gp(P, g, p); float pr, pi; ssm_pow(q, t + 1, pr, pi);
        bf16_t* base = (bf16_t*)(ws + WS_BT_SSM) + ((size_t)(g * 512 + t * 16)) * ACAT_LD + 512 + p;
#pragma unroll 4
        for (int h = 0; h < SSM_H; ++h) {
            const float cre = P.in[I_CRE][(g * SSM_H + h) * SSM_P + p], cim = P.in[I_CIM][(g * SSM_H + h) * SSM_P + p];
            base[(size_t)h * ACAT_LD] = (bf16_t)f2bf(cre * pr - cim * pi);
            base[(size_t)h * ACAT_LD + 64] = (bf16_t)f2bf(-(cre * pi + cim * pr));
        }
    }
}
__device__ __forceinline__ void ssm_toeplitz_expand(const Params& P, int vcu, int G) {
    const int gt = vcu * NTHREADS + opaque_tid(), NGT = G * NTHREADS;
    unsigned char* ws = P.ws;
    for (int it = gt; it < SSM_G * 512 * 64; it += NGT) {
        const int kc = it & 63, n = (it >> 6) & 511, g = it >> 15;
        const int s = kc >> 1, hq = (kc & 1) * 8, t = n >> 4, h = n & 15;
        u32x4 o = (u32x4){0u, 0u, 0u, 0u};
        if (s <= t) { const float* kj = (const float*)(ws + WS_KJ) + ((size_t)(g * CH_L + (t - s)) * SSM_H + h) * SSM_H + hq;
            const f32x4 a = *(const f32x4*)kj, b = *(const f32x4*)(kj + 4);
            o.x = pk2(a.x, a.y); o.y = pk2(a.z, a.w); o.z = pk2(b.x, b.y); o.w = pk2(b.z, b.w); }
        *(u32x4*)((bf16_t*)(ws + WS_BT_SSM) + ((size_t)(g * 512 + n)) * ACAT_LD + kc * 8) = o;
    }
}
#ifndef PG_WGM
#define PG_WGM 8
#endif
namespace pg {
constexpr int BM = 256, BK = 64, HALF = 128, HTB = HALF * BK * 2, STAGE_BYTES = 8 * HTB;
__host__ __device__ __forceinline__ int lds_byte(int r, int c) { const int st = (r >> 4) * 2 + (c >> 5), rr = r & 15, cc = c & 31, ob = rr * 64 + cc * 2; return st * 1024 + (ob ^ (((ob >> 9) & 1) << 5)); }
__host__ __device__ __forceinline__ void stage_rc(int b, int& R, int& C) { const int st = b / 1024, sb = b % 1024, swz = sb ^ (((sb >> 9) & 1) << 5); R = (st >> 1) * 16 + swz / 64; C = (st & 1) * 32 + (swz % 64) / 2; }
__host__ __device__ __forceinline__ int perm32(int rho) { const int n = rho >> 4, i = rho & 15; return 8 * (i >> 2) + 4 * n + (i & 3); }

struct Unit {
    const char* A;
    const char* B;
    unsigned aoff[2][2];
    int pm, pn, aux, aux2;
    int ord;
};
struct EpiInfo { int pm, pn, aux, aux2, ord; };
typedef f32x4 Acc[2][2][4][2];

typedef int v8i_t __attribute__((ext_vector_type(8)));
typedef int v4i_t __attribute__((ext_vector_type(4)));
template <bool FP8 = false, int BAUX = 0  , class Sched, class Epi>
__device__ __forceinline__ void gemm_phase(LAS unsigned char* lds, const Sched& S, const Epi& E, const int nt, const int ldb, const int ktm = -1  ) {
    const int tid = opaque_tid(), wid = __builtin_amdgcn_readfirstlane(tid >> 6), lane = tid & 63, wr = wid >> 2, wc = wid & 3, fr = lane & 15, fq = lane >> 4;
    unsigned voffB[2];
#pragma unroll
    for (int i = 0; i < 2; ++i) { int R, C; stage_rc(tid * 16 + i * 8192, R, C); voffB[i] = (unsigned)((64 * (R >> 5) + perm32(R & 31)) * ldb + C) * 2u; }
    const unsigned hB = (unsigned)(32 * ldb * 2);
    const unsigned ldsw = (unsigned)wid * 1024u;
    const int aoffl = lds_byte(wr * 64 + fr, fq * 8), boffl = lds_byte(wc * 32 + fr, fq * 8);
#define PG_SA(b, h) (((b) * 2 + (h)) * pg::HTB)
#define PG_SB(b, h) ((4 + (b) * 2 + (h)) * pg::HTB)
#define PG_GLDS(gp, bufoff, i) __builtin_amdgcn_global_load_lds((const unsigned*)(gp), (LAS unsigned*)(lds + (bufoff) + ldsw + (i) * 8192), 16, 0, 0)
#define PG_STAGE_A(bufoff, Ab, o0, o1, kt) do { const char* _b = (Ab) + (size_t)((kt) & ktm) * 128; PG_GLDS(_b + (o0), bufoff, 0); PG_GLDS(_b + (o1), bufoff, 1); } while (0)
#define PG_GLDSB(gp, bufoff, i) __builtin_amdgcn_global_load_lds((const unsigned*)(gp), (LAS unsigned*)(lds + (bufoff) + ldsw + (i) * 8192), 16, 0, BAUX)
#define PG_STAGE_B(bufoff, Bb, h, kt) do { const char* _b = (Bb) + (size_t)((kt) & ktm) * 128 + (h) * hB; PG_GLDSB(_b + voffB[0], bufoff, 0); PG_GLDSB(_b + voffB[1], bufoff, 1); } while (0)
#define PG_LDA(dst, b, h) do { _Pragma("unroll") for (int m = 0; m < 4; ++m) _Pragma("unroll") for (int k = 0; k < 2; ++k) dst[m][k] = *(const LAS bf16x8*)(lds + PG_SA(b, h) + aoffl + m * 2048 + k * 1024); } while (0)
#define PG_LDB(dst, b, h) do { _Pragma("unroll") for (int n = 0; n < 2; ++n) _Pragma("unroll") for (int k = 0; k < 2; ++k) dst[n][k] = *(const LAS bf16x8*)(lds + PG_SB(b, h) + boffl + n * 2048 + k * 1024); } while (0)
#define PG_CAT8(lo, hi) __builtin_shufflevector(__builtin_bit_cast(v4i_t, lo), __builtin_bit_cast(v4i_t, hi), 0, 1, 2, 3, 4, 5, 6, 7)
#define PG_MMA(ai, bj, At, Bt) do { __builtin_amdgcn_s_setprio(1); if constexpr (FP8) { _Pragma("unroll") for (int m = 0; m < 4; ++m) _Pragma("unroll") for (int n = 0; n < 2; ++n) \
            acc[ai][bj][m][n] = __builtin_amdgcn_mfma_scale_f32_16x16x128_f8f6f4(PG_CAT8(Bt[n][0], Bt[n][1]), PG_CAT8(At[m][0], At[m][1]), acc[ai][bj][m][n], 0, 0, 0, 0x79797979, 0, 0x7f7f7f7f); } \
        else { _Pragma("unroll") for (int m = 0; m < 4; ++m) _Pragma("unroll") for (int n = 0; n < 2; ++n) _Pragma("unroll") for (int k = 0; k < 2; ++k) \
        acc[ai][bj][m][n] = __builtin_amdgcn_mfma_f32_16x16x32_bf16(Bt[n][k], At[m][k], acc[ai][bj][m][n], 0, 0, 0); } __builtin_amdgcn_s_setprio(0); } while (0)
#define PG_WAIT_V(n) asm volatile("s_waitcnt vmcnt(" #n ")" ::: "memory")
#define PG_WAIT_L(n) asm volatile("s_waitcnt lgkmcnt(" #n ")" ::: "memory")
#define PG_BAR __builtin_amdgcn_s_barrier()
#define PG_SCHED __builtin_amdgcn_sched_barrier(0)
#define PG_KLOOP(T0, T1) _Pragma("clang loop unroll(disable)") for (int t = (T0); t < (T1); t += 2) { \
            const bool last = (t == nt - 2); \
            PG_LDB(B0, 0, 0); PG_LDB(B1, 0, 1); PG_SCHED; PG_LDA(At, 0, 0); PG_STAGE_A(PG_SA(1, 1), st.A, st.aoff[1][0], st.aoff[1][1], t + 1); \
            if (last) { Unit nu_; has_next = S.next(ui + 1, nu_); if (has_next) { st = nu_; } } \
            const int k2 = last ? 0 : t + 2, k3 = k2 + 1; \
            PG_WAIT_V(8); PG_WAIT_L(0); PG_BAR; PG_MMA(0, 0, At, B0); PG_MMA(0, 1, At, B1); PG_BAR; PG_SCHED; \
            PG_LDA(At, 0, 1); PG_STAGE_B(PG_SB(0, 0), st.B, 0, k2); PG_STAGE_B(PG_SB(0, 1), st.B, 1, k2); PG_STAGE_A(PG_SA(0, 0), st.A, st.aoff[0][0], st.aoff[0][1], k2); \
            PG_WAIT_V(8); PG_WAIT_L(0); PG_BAR; PG_MMA(1, 0, At, B0); PG_MMA(1, 1, At, B1); PG_BAR; PG_SCHED; \
            PG_LDB(B0, 1, 0); PG_LDB(B1, 1, 1); PG_SCHED; PG_LDA(At, 1, 0); PG_STAGE_A(PG_SA(0, 1), st.A, st.aoff[1][0], st.aoff[1][1], k2); \
            PG_WAIT_V(8); PG_WAIT_L(0); PG_BAR; PG_MMA(0, 0, At, B0); PG_MMA(0, 1, At, B1); PG_BAR; PG_SCHED; \
            PG_LDA(At, 1, 1); PG_STAGE_B(PG_SB(1, 0), st.B, 0, k3); PG_STAGE_B(PG_SB(1, 1), st.B, 1, k3); PG_STAGE_A(PG_SA(1, 0), st.A, st.aoff[0][0], st.aoff[0][1], k3); \
            PG_WAIT_V(8); PG_WAIT_L(0); PG_BAR; PG_MMA(1, 0, At, B0); PG_MMA(1, 1, At, B1); PG_BAR; PG_SCHED; \
        }
    Unit st; int ui = 0;
    if (!S.next(0, st)) return;
    EpiInfo cur; cur.pm = st.pm; cur.pn = st.pn; cur.aux = st.aux; cur.aux2 = st.aux2; cur.ord = st.ord;
    Acc acc;
#pragma unroll
    for (int a = 0; a < 2; ++a)
#pragma unroll
        for (int b = 0; b < 2; ++b)
#pragma unroll
            for (int m = 0; m < 4; ++m)
#pragma unroll
                for (int n = 0; n < 2; ++n) acc[a][b][m][n] = (f32x4){0.f, 0.f, 0.f, 0.f};
    bf16x8 At[4][2], B0[2][2], B1[2][2];
    PG_STAGE_B(PG_SB(0, 0), st.B, 0, 0); PG_STAGE_B(PG_SB(0, 1), st.B, 1, 0); PG_STAGE_A(PG_SA(0, 0), st.A, st.aoff[0][0], st.aoff[0][1], 0); PG_STAGE_A(PG_SA(0, 1), st.A, st.aoff[1][0], st.aoff[1][1], 0);
    if (wr == 1) PG_BAR;
    PG_WAIT_V(2); PG_BAR;
    PG_STAGE_B(PG_SB(1, 0), st.B, 0, 1); PG_STAGE_A(PG_SA(1, 0), st.A, st.aoff[0][0], st.aoff[0][1], 1); PG_STAGE_B(PG_SB(1, 1), st.B, 1, 1);
    PG_WAIT_V(6); PG_BAR;
    for (;;) {
        bool has_next = false;
        if constexpr (Epi::HAS_MID) { PG_KLOOP(0, Epi::MID_T) E.mid(acc, cur, wr, wc, fr, fq); PG_KLOOP(Epi::MID_T, nt) } else { PG_KLOOP(0, nt) }
        if (wr == 0) PG_BAR;
        E(acc, cur, wr, wc, fr, fq);
        if (!has_next) break;
#pragma unroll
        for (int a = 0; a < 2; ++a)
#pragma unroll
            for (int b = 0; b < 2; ++b)
#pragma unroll
                for (int m = 0; m < 4; ++m)
#pragma unroll
                    for (int n = 0; n < 2; ++n) acc[a][b][m][n] = (f32x4){0.f, 0.f, 0.f, 0.f};
        cur.pm = st.pm; cur.pn = st.pn; cur.aux = st.aux; cur.aux2 = st.aux2; cur.ord = st.ord; ++ui;
        if (wr == 1) PG_BAR;
    }
    PG_WAIT_V(0);
    PG_BAR;
#undef PG_SA
#undef PG_SB
#undef PG_GLDS
#undef PG_GLDSB
#undef PG_STAGE_A
#undef PG_STAGE_B
#undef PG_LDA
#undef PG_LDB
#undef PG_MMA
#undef PG_WAIT_V
#undef PG_WAIT_L
#undef PG_BAR
#undef PG_SCHED
#undef PG_KLOOP
}

struct LaneRC { int R[2], C[2]; __device__ __forceinline__ LaneRC() { const int t = opaque_tid(); stage_rc(t * 16, R[0], C[0]); stage_rc(t * 16 + 8192, R[1], C[1]); } };

struct DenseSched {
    const bf16_t* A; const bf16_t* Bt; int lda, ldb, nM, nN, nwg, G, c;
    __device__ __forceinline__ void init(const bf16_t* A_, int lda_, const bf16_t* Bt_, int ldb_, int M, int N, int G_, int c_) { A = A_; Bt = Bt_; lda = lda_; ldb = ldb_; nM = M / BM; nN = N / BM; nwg = nM * nN; G = G_; c = c_; }
    __device__ __forceinline__ bool next(int i, Unit& u) const {
        const long L = (long)i * G + c; if (L >= nwg) return false;
        int wgid = (int)L; { const int q = nwg / 8, r = nwg % 8, xcd = wgid % 8, off = wgid / 8; wgid = (xcd < r ? xcd * (q + 1) : r * (q + 1) + (xcd - r) * q) + off; }
        const int WGM = PG_WGM, nig = WGM * nN, gid = wgid / nig, fm = gid * WGM, gsz = (nM - fm) < WGM ? (nM - fm) : WGM;
        u.pm = fm + ((wgid % nig) % gsz); u.pn = (wgid % nig) / gsz; u.aux = 0; u.aux2 = 0; u.ord = i;
        u.A = (const char*)A; u.B = (const char*)(Bt + (size_t)u.pn * BM * ldb); const LaneRC rc;
#pragma unroll
        for (int h = 0; h < 2; ++h)
#pragma unroll
            for (int j = 0; j < 2; ++j) u.aoff[h][j] = (unsigned)(((u.pm * BM + 128 * h + rc.R[j]) * lda + rc.C[j]) * 2);
        return true;
    }
};
}
namespace pg {
constexpr int TAB_OFF = RING_BYTES + 1024;
__device__ __forceinline__ void moe_build_tab(LAS unsigned char* lds, const unsigned* cnt) {
    LAS int* tab = (LAS int*)(lds + TAB_OFF);
    if (threadIdx.x == 0) { int acc = 0; for (int e = 0; e < NE; ++e) { const int n = (int)__hip_atomic_load(cnt + e, __ATOMIC_RELAXED, __HIP_MEMORY_SCOPE_AGENT); tab[e] = acc; tab[40 + e] = n; acc += (n + 255) >> 8; } tab[NE] = acc; }
    __syncthreads();
}
#ifndef MOE_MAXU_OVERRIDE
#define MOE_MAXU_OVERRIDE 9
#endif
constexpr int MOE_MAXU = MOE_MAXU_OVERRIDE;
constexpr int UT_OFF = RING_BYTES + 1536;
constexpr int UB_OFF = UT_OFF + MOE_MAXU * 512;
static_assert(UB_OFF + MOE_MAXU * 1024 <= LDS_BYTES, "LDS map");
template <int KIND>
struct MoeSched {
    static constexpr int NPN = KIND == 1 ? 8 : 4;
    unsigned char* ws; const LAS int* tab; LAS unsigned char* lds; int G, c; bool freeze = false;
    __device__ __forceinline__ bool unit(int i, int& e, int& rb, int& pn) const {
        const int x = c & 7, j = c >> 3, NJ = G >> 3;
        int L = i * NJ + j; e = -1; rb = 0; pn = 0;
#pragma unroll
        for (int q = 0; q < NE / 8; ++q) { const int eq = x + 8 * q, uq = (tab[eq + 1] - tab[eq]) * NPN;
            if (e < 0) { if (L < uq) { e = eq; rb = L / NPN; pn = L % NPN; } else L -= uq; } }
        if (e < 0) return false;
        e = __builtin_amdgcn_readfirstlane(e); rb = __builtin_amdgcn_readfirstlane(rb); pn = __builtin_amdgcn_readfirstlane(pn);
        return true;
    }
    __device__ __forceinline__ void init(unsigned char* ws_, LAS unsigned char* lds_, int G_, int c_, const float* bias) {
        ws = ws_; lds = lds_; tab = (const LAS int*)(lds_ + TAB_OFF); G = G_; c = c_;
        const int tid = opaque_tid();
        for (int i = 0; i < MOE_MAXU; ++i) { int e, rb, pn; if (!unit(i, e, rb, pn)) break;
            if (tid < 256) { if (KIND == 1) { const int nvalid = min(256, tab[40 + e] - rb * 256); const int tok = tid < nvalid ? ((const int*)(ws + WS_SLOT_TOK))[(size_t)e * CAP + rb * 256 + tid] : T;
                    ((LAS unsigned short*)(lds + UT_OFF))[i * 256 + tid] = (unsigned short)tok; } }
            else ((LAS float*)(lds + UB_OFF))[i * 256 + tid - 256] = bias[(size_t)e * (NPN * 256) + pn * 256 + tid - 256]; }
        __syncthreads();
    }
    __device__ __forceinline__ bool next(int i, Unit& u) const {
        int e, rb, pn; if (!unit(i, e, rb, pn)) return false;
#if defined(PROBE_FREEZE)
        if (freeze) { int e0, r0, p0; unit(0, e0, r0, p0); e = e0; rb = r0; pn = p0; }
#endif
        const int blk = tab[e] + rb, nvalid = min(256, tab[40 + e] - rb * 256);
        u.pm = rb; u.pn = pn; u.aux = e; u.ord = i; const LaneRC rc;
        if (KIND == 1) {
            u.aux2 = blk; u.A = (const char*)(ws + WS_H2); u.B = (const char*)(ws + WS_W1_T + ((size_t)e * 2 * DFF + (size_t)pn * BM) * D);
#pragma unroll
            for (int h = 0; h < 2; ++h)
#pragma unroll
                for (int jj = 0; jj < 2; ++jj) { const int r = 128 * h + rc.R[jj]; int tok;
                    if (i < MOE_MAXU) tok = ((const LAS unsigned short*)(lds + UT_OFF))[i * 256 + r];
                    else { tok = r < nvalid ? ((const int*)(ws + WS_SLOT_TOK))[(size_t)e * CAP + rb * 256 + r] : T; __builtin_amdgcn_s_waitcnt(0x0F70); }
                    u.aoff[h][jj] = (unsigned)(tok * D + rc.C[jj] * 2); }
        } else {
            u.aux2 = blk | (nvalid << 16); u.A = (const char*)(ws + WS_ACT); u.B = (const char*)(ws + WS_W2_T + ((size_t)e * D + (size_t)pn * BM) * DFF);
#pragma unroll
            for (int h = 0; h < 2; ++h)
#pragma unroll
                for (int jj = 0; jj < 2; ++jj) u.aoff[h][jj] = (unsigned)((blk * 256 + 128 * h + rc.R[jj]) * DFF + rc.C[jj] * 2);
        }
        return true;
    }
};
}
namespace pg {
struct EpiBase { static constexpr bool HAS_MID = false; static constexpr int MID_T = -1; __device__ __forceinline__ void mid(Acc&, const EpiInfo&, int, int, int, int) const {} };
__device__ __forceinline__ u32x4 pack8(const f32x4 a, const f32x4 b) { u32x4 w; w.x = pk2(a[0], a[1]); w.y = pk2(a[2], a[3]); w.z = pk2(b[0], b[1]); w.w = pk2(b[2], b[3]); return w; }
__device__ __forceinline__ void unpack8(const u32x4 w, f32x4& a, f32x4& b) { a = (f32x4){bflo(w.x), bfhi(w.x), bflo(w.y), bfhi(w.y)}; b = (f32x4){bflo(w.z), bfhi(w.z), bflo(w.w), bfhi(w.w)}; }

struct EpiNull : EpiBase {
    __device__ __forceinline__ void operator()(Acc& acc, const EpiInfo&, int, int, int, int) const {
#pragma unroll
        for (int a = 0; a < 2; ++a)
#pragma unroll
            for (int b = 0; b < 2; ++b)
#pragma unroll
                for (int m = 0; m < 4; ++m)
#pragma unroll
                    for (int n = 0; n < 2; ++n) asm volatile("" :: "v"(acc[a][b][m][n]));
    }
};
struct EpiInProj : EpiBase {
    unsigned char* ws; const float* qg; const float* kg;
    __device__ __forceinline__ void operator()(Acc& acc, const EpiInfo& u, int wr, int wc, int fr, int fq) const {
        const int pn = u.pn, row0 = u.pm * BM + wr * 64 + fr, colw = 64 * wc + 8 * fq;
        if (pn < 2) {
            bf16_t* acat = (bf16_t*)(ws + WS_ACAT);
#pragma unroll
            for (int ai = 0; ai < 2; ++ai)
#pragma unroll
                for (int m = 0; m < 4; ++m) { const int tok = row0 + ai * 128 + m * 16;
#pragma unroll
                    for (int bj = 0; bj < 2; ++bj) { const int cu = pn * 256 + colw + 32 * bj, g = cu >> 4, h0 = cu & 15;
                        *(u32x4*)(acat + ((size_t)(g * ACAT_ROWS + (tok >> 5))) * ACAT_LD + (tok & 31) * 16 + h0) = pack8(acc[ai][bj][m][0], acc[ai][bj][m][1]); } }
        } else if (pn < 10) {
            const bool isq = pn < 6; const float* gain = isq ? qg : kg; const float sc = isq ? QC2 : 1.f;
            bf16_t* dst = (bf16_t*)(ws + (isq ? WS_Q : WS_K)) + (size_t)(pn - (isq ? 2 : 6)) * 256 + colw;
            f32x4 gv[2][2];
#pragma unroll
            for (int bj = 0; bj < 2; ++bj)
#pragma unroll
                for (int n = 0; n < 2; ++n) gv[bj][n] = *(const f32x4*)(gain + 32 * bj + 8 * fq + 4 * n);
#pragma unroll
            for (int ai = 0; ai < 2; ++ai)
#pragma unroll
                for (int m = 0; m < 4; ++m) { const int tok = row0 + ai * 128 + m * 16; float ss = 0.f;
#pragma unroll
                    for (int bj = 0; bj < 2; ++bj)
#pragma unroll
                        for (int n = 0; n < 2; ++n) { const f32x4 v = acc[ai][bj][m][n]; ss += (v[0] * v[0] + v[1] * v[1]) + (v[2] * v[2] + v[3] * v[3]); }
                    ss += __shfl_xor(ss, 16); ss += __shfl_xor(ss, 32);
                    const float r = rsqrtf(ss * (1.f / 64.f) + EPS) * sc;
#pragma unroll
                    for (int bj = 0; bj < 2; ++bj) store16(dst + (size_t)tok * D + 32 * bj, pack8(acc[ai][bj][m][0] * r * gv[bj][0], acc[ai][bj][m][1] * r * gv[bj][1])); }
        } else {
            const size_t base = pn < 14 ? WS_V : (pn < 18 ? WS_GS : WS_GA); const int t0 = pn < 14 ? 10 : (pn < 18 ? 14 : 18); const bool ntst = pn >= 14;
            bf16_t* dst = (bf16_t*)(ws + base) + (size_t)(pn - t0) * 256 + colw;
#pragma unroll
            for (int ai = 0; ai < 2; ++ai)
#pragma unroll
                for (int m = 0; m < 4; ++m) { const int tok = row0 + ai * 128 + m * 16;
#pragma unroll
                    for (int bj = 0; bj < 2; ++bj) { const u32x4 w = pack8(acc[ai][bj][m][0], acc[ai][bj][m][1]); if (ntst) NT_STORE(w, (u32x4*)(dst + (size_t)tok * D + 32 * bj)); else store16(dst + (size_t)tok * D + 32 * bj, w); } }
        }
    }
};
struct EpiSsm2 : EpiBase {
    unsigned char* ws;
    __device__ __forceinline__ void operator()(Acc& acc, const EpiInfo& u, int wr, int wc, int fr, int fq) const {
        bf16_t* Z = (bf16_t*)(ws + WS_Z); const int g = u.aux;
#pragma unroll
        for (int ai = 0; ai < 2; ++ai)
#pragma unroll
            for (int m = 0; m < 4; ++m) { const int r = u.pm * BM + ai * 128 + wr * 64 + m * 16 + fr, b = r >> 6, c = r & 63;
#pragma unroll
                for (int bj = 0; bj < 2; ++bj) { const int n_ = u.pn * 256 + 64 * wc + 32 * bj + 8 * fq, t = n_ >> 4, h0 = n_ & 15; const int tok = b * SEQ + c * CH_L + t;
                    f32x4 a = acc[ai][bj][m][0], bb = acc[ai][bj][m][1];
#pragma unroll
                    for (int q = 0; q < 4; ++q) { a[q] = gelu_tanh(a[q]); bb[q] = gelu_tanh(bb[q]); }
                    *(u32x4*)(Z + (size_t)tok * SSM_W + 16 * g + h0) = pack8(a, bb); } }
    }
};
struct EpiGlu : EpiBase {
    unsigned char* ws; const float* bglu;
    __device__ __forceinline__ void operator()(Acc& acc, const EpiInfo& u, int wr, int wc, int fr, int fq) const {
        asm volatile("" : "+v"(fr), "+v"(fq));
        const bf16_t* Z = (const bf16_t*)(ws + WS_Z); bf16_t* MA = (bf16_t*)(ws + WS_MA);
        const int col0 = u.pn * 256 + 64 * wc + 8 * fq;
        f32x4 cb[2][2];
#pragma unroll
        for (int bj = 0; bj < 2; ++bj) { cb[bj][0] = *(const f32x4*)(bglu + col0 + 32 * bj); cb[bj][1] = *(const f32x4*)(bglu + col0 + 32 * bj + 4); }
#pragma unroll
        for (int ai = 0; ai < 2; ++ai) { u32x4 zz[4][2];
#pragma unroll
            for (int m = 0; m < 4; ++m) { const int tok = u.pm * BM + ai * 128 + wr * 64 + m * 16 + fr;
#pragma unroll
                for (int bj = 0; bj < 2; ++bj) zz[m][bj] = *(const u32x4*)(Z + (size_t)tok * SSM_W + col0 + 32 * bj); }
            asm volatile("" ::: "memory");
#pragma unroll
            for (int m = 0; m < 4; ++m) { const int tok = u.pm * BM + ai * 128 + wr * 64 + m * 16 + fr;
#pragma unroll
                for (int bj = 0; bj < 2; ++bj) { f32x4 z0, z1; unpack8(zz[m][bj], z0, z1);
                    f32x4 a = acc[ai][bj][m][0] + cb[bj][0], bb = acc[ai][bj][m][1] + cb[bj][1];
#pragma unroll
                    for (int q = 0; q < 4; ++q) { a[q] = z0[q] * sigmoid_f(a[q]); bb[q] = z1[q] * sigmoid_f(bb[q]); }
                    *(u32x4*)(MA + (size_t)tok * MA_LD + 1024 + col0 + 32 * bj) = pack8(a, bb); } }
            asm volatile("" ::: "memory"); }
    }
};
struct EpiMerged : EpiBase {
    static constexpr bool HAS_MID = true; static constexpr int MID_T = 16;
    unsigned char* ws;
    __device__ __forceinline__ float ratio(float a, float s) const { a = fminf(fmaxf(a, -30.f), 30.f); s = fminf(fmaxf(s, -30.f), 30.f); return (1.f + __expf(-s)) * __builtin_amdgcn_rcpf(1.f + __expf(-a)); }
    __device__ __forceinline__ void mid(Acc& acc, const EpiInfo& u, int wr, int wc, int fr, int fq) const {
        asm volatile("" : "+v"(fr), "+v"(fq));
        const bf16_t* GS = (const bf16_t*)(ws + WS_GS); const bf16_t* GA = (const bf16_t*)(ws + WS_GA);
        const int col0 = u.pn * 256 + 64 * wc + 8 * fq;
#pragma unroll
        for (int ai = 0; ai < 2; ++ai)
#pragma unroll
            for (int mp = 0; mp < 2; ++mp) { u32x4 gs_[2][2], ga_[2][2];
#pragma unroll
                for (int mm = 0; mm < 2; ++mm) { const int tok = u.pm * BM + ai * 128 + wr * 64 + (2 * mp + mm) * 16 + fr;
#pragma unroll
                    for (int bj = 0; bj < 2; ++bj) { gs_[mm][bj] = *(const u32x4*)(GS + (size_t)tok * D + col0 + 32 * bj); ga_[mm][bj] = *(const u32x4*)(GA + (size_t)tok * D + col0 + 32 * bj); } }
#pragma unroll
                for (int mm = 0; mm < 2; ++mm)
#pragma unroll
                    for (int bj = 0; bj < 2; ++bj) { const int m = 2 * mp + mm; const u32x4 ws_ = gs_[mm][bj], wa_ = ga_[mm][bj];
                        acc[ai][bj][m][0][0] *= ratio(bflo(wa_.x), bflo(ws_.x)); acc[ai][bj][m][0][1] *= ratio(bfhi(wa_.x), bfhi(ws_.x));
                        acc[ai][bj][m][0][2] *= ratio(bflo(wa_.y), bflo(ws_.y)); acc[ai][bj][m][0][3] *= ratio(bfhi(wa_.y), bfhi(ws_.y));
                        acc[ai][bj][m][1][0] *= ratio(bflo(wa_.z), bflo(ws_.z)); acc[ai][bj][m][1][1] *= ratio(bfhi(wa_.z), bfhi(ws_.z));
                        acc[ai][bj][m][1][2] *= ratio(bflo(wa_.w), bflo(ws_.w)); acc[ai][bj][m][1][3] *= ratio(bfhi(wa_.w), bfhi(ws_.w)); }
                asm volatile("" ::: "memory"); }
    }
    __device__ __forceinline__ void operator()(Acc& acc, const EpiInfo& u, int wr, int wc, int fr, int fq) const {
        asm volatile("" : "+v"(fr), "+v"(fq));
        const bf16_t* GS = (const bf16_t*)(ws + WS_GS); bf16_t* O = (bf16_t*)(ws + WS_MERGED);
        const int col0 = u.pn * 256 + 64 * wc + 8 * fq;
#pragma unroll
        for (int ai = 0; ai < 2; ++ai) { u32x4 gs_[4][2];
#pragma unroll
            for (int m = 0; m < 4; ++m) { const int tok = u.pm * BM + ai * 128 + wr * 64 + m * 16 + fr;
#pragma unroll
                for (int bj = 0; bj < 2; ++bj) gs_[m][bj] = *(const u32x4*)(GS + (size_t)tok * D + col0 + 32 * bj); }
#pragma unroll
            for (int m = 0; m < 4; ++m) { const int tok = u.pm * BM + ai * 128 + wr * 64 + m * 16 + fr;
#pragma unroll
                for (int bj = 0; bj < 2; ++bj) { f32x4 s0, s1; unpack8(gs_[m][bj], s0, s1);
                    f32x4 a = acc[ai][bj][m][0], bb = acc[ai][bj][m][1];
#pragma unroll
                    for (int q = 0; q < 4; ++q) { a[q] *= sigmoid_c(s0[q]); bb[q] *= sigmoid_c(s1[q]); }
                    *(u32x4*)(O + (size_t)tok * D + col0 + 32 * bj) = pack8(a, bb); } }
            asm volatile("" ::: "memory"); }
    }
};
struct EpiWout : EpiBase {
    const float* x; bf16_t* out;
    __device__ __forceinline__ void operator()(Acc& acc, const EpiInfo& u, int wr, int wc, int fr, int fq) const {
        asm volatile("" : "+v"(fr), "+v"(fq));
        const int col0 = u.pn * 256 + 64 * wc + 8 * fq;
#pragma unroll
        for (int ai = 0; ai < 2; ++ai)
#pragma unroll
            for (int mp = 0; mp < 2; ++mp) { f32x4 xv[2][2][2];
#pragma unroll
                for (int mm = 0; mm < 2; ++mm) { const int tok = u.pm * BM + ai * 128 + wr * 64 + (2 * mp + mm) * 16 + fr;
#pragma unroll
                    for (int bj = 0; bj < 2; ++bj) { const size_t o = (size_t)tok * D + col0 + 32 * bj; xv[mm][bj][0] = NT_LOAD((const f32x4*)(x + o)); xv[mm][bj][1] = NT_LOAD((const f32x4*)(x + o + 4)); } }
                asm volatile("" ::: "memory");
#pragma unroll
                for (int mm = 0; mm < 2; ++mm) { const int m = 2 * mp + mm, tok = u.pm * BM + ai * 128 + wr * 64 + m * 16 + fr;
#pragma unroll
                    for (int bj = 0; bj < 2; ++bj) *(u32x4*)(out + (size_t)tok * D + col0 + 32 * bj) = pack8(xv[mm][bj][0] + acc[ai][bj][m][0], xv[mm][bj][1] + acc[ai][bj][m][1]); }
                asm volatile("" ::: "memory"); }
    }
};
struct EpiMoe1 : EpiBase {
    unsigned char* ws; const float* b1; LAS unsigned char* lds; bool nostore = false;
    __device__ __forceinline__ void operator()(Acc& acc, const EpiInfo& u, int wr, int wc, int fr, int fq) const {
        asm volatile("" : "+v"(fr), "+v"(fq));
        unsigned char* ACT = ws + WS_ACT; const int e = u.aux, blk = u.aux2;
        f32x4 cb[2][2];
#pragma unroll
        for (int bj = 0; bj < 2; ++bj) { const int cl = 64 * wc + 32 * bj + 8 * fq; f32x4 r0, r1;
            if (u.ord < MOE_MAXU) { const LAS float* bl = (const LAS float*)(lds + UB_OFF) + u.ord * 256 + cl; r0 = *(const LAS f32x4*)bl; r1 = *(const LAS f32x4*)(bl + 4); }
            else { const float* bg = b1 + (size_t)e * 2 * DFF + u.pn * 256 + cl; r0 = *(const f32x4*)bg; r1 = *(const f32x4*)(bg + 4); __builtin_amdgcn_s_waitcnt(0x0F70); }
            cb[bj][0] = __builtin_shufflevector(r0, r0, 0, 2, 1, 3); cb[bj][1] = __builtin_shufflevector(r1, r1, 0, 2, 1, 3); }
        const f32x2 c7 = {7.f, 7.f}, one = {1.f, 1.f}, cexp = {-1.702f * 1.4426950408889634f, -1.702f * 1.4426950408889634f};
#pragma unroll
        for (int ai = 0; ai < 2; ++ai)
#pragma unroll
            for (int m = 0; m < 4; ++m) { const int row = ai * 128 + wr * 64 + m * 16 + fr; unsigned w[2];
#pragma unroll
                for (int bj = 0; bj < 2; ++bj) { f32x2 r[2];
#pragma unroll
                    for (int n = 0; n < 2; ++n) { const f32x4 h = acc[ai][bj][m][n] + cb[bj][n];
                        f32x2 g = {fminf(h[0], 7.f), fminf(h[1], 7.f)}; const f32x2 up = {fminf(fmaxf(h[2], -7.f), 7.f), fminf(fmaxf(h[3], -7.f), 7.f)};
                        const f32x2 x = g * cexp; f32x2 ex = {__builtin_amdgcn_exp2f(x[0]), __builtin_amdgcn_exp2f(x[1])};
                        ex = ex + one; const f32x2 s = {__builtin_amdgcn_rcpf(ex[0]), __builtin_amdgcn_rcpf(ex[1])};
                        r[n] = (up * g + g) * s; }
                    w[bj] = pk4_fp8(r[0][0], r[0][1], r[1][0], r[1][1]); }
                unsigned char* rowp = ACT + ((size_t)blk * 256 + row) * DFF + ((u.pn * 256 + 64 * wc + 8 * fq) >> 1);
#if defined(PROBE_NOSTORE)
                if (nostore) { asm volatile("" :: "v"(w[0]), "v"(w[1])); } else
#endif
                { *(unsigned*)rowp = w[0]; *(unsigned*)(rowp + 16) = w[1]; } }
        (void)c7;
    }
};
struct EpiMoe2 : EpiBase {
    unsigned char* ws; const float* b2; LAS unsigned char* lds; bool nostore = false;
    __device__ __forceinline__ void operator()(Acc& acc, const EpiInfo& u, int wr, int wc, int fr, int fq) const {
        asm volatile("" : "+v"(fr), "+v"(fq));
        bf16_t* Y = (bf16_t*)(ws + WS_Y); const int e = u.aux, blk = u.aux2 & 0xffff;
        f32x4 cb[2][2];
#pragma unroll
        for (int bj = 0; bj < 2; ++bj) { const int cl = 64 * wc + 32 * bj + 8 * fq;
            if (u.ord < MOE_MAXU) { const LAS float* bl = (const LAS float*)(lds + UB_OFF) + u.ord * 256 + cl; cb[bj][0] = *(const LAS f32x4*)bl; cb[bj][1] = *(const LAS f32x4*)(bl + 4); }
            else { const float* bg = b2 + (size_t)e * D + u.pn * 256 + cl; cb[bj][0] = *(const f32x4*)bg; cb[bj][1] = *(const f32x4*)(bg + 4); __builtin_amdgcn_s_waitcnt(0x0F70); } }
#pragma unroll
        for (int ai = 0; ai < 2; ++ai)
#pragma unroll
            for (int m = 0; m < 4; ++m) { const int row = ai * 128 + wr * 64 + m * 16 + fr;
#pragma unroll
                for (int bj = 0; bj < 2; ++bj) { const int col = u.pn * 256 + 64 * wc + 32 * bj + 8 * fq;
                    const u32x4 w = pack8(acc[ai][bj][m][0] + cb[bj][0], acc[ai][bj][m][1] + cb[bj][1]);
#if defined(PROBE_NOSTORE)
                    if (nostore) { asm volatile("" :: "v"(w)); } else
#endif
                    store16(Y + ((size_t)blk * 256 + row) * D + col, w); } }
    }
};
}
namespace attn_body {
using bf16=__hip_bfloat16;
using bf16x8=__attribute__((ext_vector_type(8)))short;
using s16x4=__attribute__((ext_vector_type(4)))short;
using f32x16=__attribute__((ext_vector_type(16)))float;
using u32x4=__attribute__((ext_vector_type(4)))unsigned;
constexpr int SEQ=2048,D=64,DM=1024;
constexpr int NW=8,QBLK=32,QB=QBLK*NW,KVBLK=64,NQB=SEQ/QB;
constexpr int ATTN_PITCH=DM, ATTN_UNIT_ROWS=QB;
__device__ __forceinline__ int crow(int r,int hi){return (r&3)+8*(r>>2)+4*hi;}
#define SBAR() __builtin_amdgcn_sched_barrier(0)
__device__ __forceinline__ void cmask(f32x16&p0,f32x16&p1,int jb,int qrel,int hi){
  const float NEG=-INFINITY; int kb=64*jb+4*hi;
  #pragma unroll
  for(int r=0;r<16;++r){int kv=kb+(r&3)+8*(r>>2); if(kv>qrel)p0[r]=NEG; if(kv+32>qrel)p1[r]=NEG;}
}

constexpr int NSLOT=3, SLOTB=8192;
constexpr int LDS_K=0, LDS_V=NSLOT*SLOTB, LDS_WS=2*NSLOT*SLOTB, LDS_OST=LDS_WS+NW*64*4, ALDS_BYTES=LDS_OST+NW*4096;
constexpr float C2=0.125f*1.4426950408889634f;
__device__ __forceinline__ void glds16(const void*gsrc,unsigned lds_dst){unsigned keep;
  asm volatile("s_mov_b32 %0, m0\n\ts_mov_b32 m0, %2\n\ts_nop 0\n\tglobal_load_lds_dwordx4 %1, off\n\ts_mov_b32 m0, %0":"=&s"(keep):"v"(gsrc),"s"(lds_dst):"memory");}
__device__ __forceinline__ float max3f(float a,float b,float c){float r;asm("v_max3_f32 %0, %1, %2, %3":"=v"(r):"v"(a),"v"(b),"v"(c));return r;}
__device__ __forceinline__ float max2f(float a,float b){float r;asm("v_max_f32_e32 %0, %1, %2":"=v"(r):"v"(a),"v"(b));return r;}
__device__ __forceinline__ float fadd_s(float a,float b){float r;asm("v_add_f32_e32 %0, %1, %2":"=v"(r):"v"(a),"v"(b));return r;}
__device__ __forceinline__ float fsub_s(float a,float b){float r;asm("v_sub_f32_e32 %0, %1, %2":"=v"(r):"v"(a),"v"(b));return r;}
typedef float f32x2_t __attribute__((ext_vector_type(2))); typedef __bf16 bf16x2_t __attribute__((ext_vector_type(2)));
__device__ __forceinline__ unsigned cvtpk_s(float lo,float hi){f32x2_t v={lo,hi};bf16x2_t b=__builtin_convertvector(v,bf16x2_t);return __builtin_bit_cast(unsigned,b);}
#define WAIT_BAR(N) asm volatile("s_waitcnt vmcnt(" #N ") lgkmcnt(0)\n\ts_barrier":::"memory")

__device__ __forceinline__ void qkt(f32x16&p0,f32x16&p1,const char*Kslot,const bf16x8*qr,const f32x16&negm,int r32,int hi){
  const char*kb=Kslot+hi*1024+r32*16;
  #pragma unroll
  for(int d0=0;d0<4;++d0){
    const bf16x8 b0=*reinterpret_cast<const bf16x8*>(kb+d0*2048);
    const bf16x8 b1=*reinterpret_cast<const bf16x8*>(kb+d0*2048+512);
    if(d0==0){p0=__builtin_amdgcn_mfma_f32_32x32x16_bf16(b0,qr[0],negm,0,0,0);p1=__builtin_amdgcn_mfma_f32_32x32x16_bf16(b1,qr[0],negm,0,0,0);}
    else{p0=__builtin_amdgcn_mfma_f32_32x32x16_bf16(b0,qr[d0],p0,0,0,0);p1=__builtin_amdgcn_mfma_f32_32x32x16_bf16(b1,qr[d0],p1,0,0,0);}}
}
typedef __attribute__((address_space(3))) const char* lds_cptr;
typedef short v4i16_t __attribute__((ext_vector_type(4)));
__device__ __forceinline__ void kload8(bf16x8*kf,lds_cptr kp){
  kf[0]=*(const __attribute__((address_space(3))) bf16x8*)(kp);      kf[1]=*(const __attribute__((address_space(3))) bf16x8*)(kp+512);
  kf[2]=*(const __attribute__((address_space(3))) bf16x8*)(kp+2048); kf[3]=*(const __attribute__((address_space(3))) bf16x8*)(kp+2560);
  kf[4]=*(const __attribute__((address_space(3))) bf16x8*)(kp+4096); kf[5]=*(const __attribute__((address_space(3))) bf16x8*)(kp+4608);
  kf[6]=*(const __attribute__((address_space(3))) bf16x8*)(kp+6144); kf[7]=*(const __attribute__((address_space(3))) bf16x8*)(kp+6656);
}
__device__ __forceinline__ void kload2(bf16x8*kf,lds_cptr kp,int j){ kf[2*j]=*(const __attribute__((address_space(3))) bf16x8*)(kp+j*2048); kf[2*j+1]=*(const __attribute__((address_space(3))) bf16x8*)(kp+j*2048+512); }
__device__ __forceinline__ s16x4 vtr(lds_cptr p){ return __builtin_bit_cast(s16x4,__builtin_amdgcn_ds_read_tr16_b64_v4i16((__attribute__((address_space(3))) v4i16_t*)p)); }
__device__ __forceinline__ float rowmax(const f32x16&p0,const f32x16&p1){
  float a=max3f(p0[0],p0[1],p1[0]),b=max3f(p0[2],p0[3],p1[1]);a=max3f(a,p1[2],p1[3]);
  #pragma unroll
  for(int r=4;r<16;r+=4){a=max3f(a,p0[r],p0[r+1]);b=max3f(b,p0[r+2],p0[r+3]);a=max3f(a,p1[r],p1[r+1]);b=max3f(b,p1[r+2],p1[r+3]);}
  const float m=max2f(a,b);
  auto rr=__builtin_amdgcn_permlane32_swap(__float_as_uint(m),__float_as_uint(m),false,false);
  return max2f(__uint_as_float(rr[0]),__uint_as_float(rr[1]));
}
__device__ __forceinline__ void pv(f32x16*o,int vb,bf16x8 pa0,bf16x8 pa1,bf16x8 pa2,bf16x8 pa3){
  #pragma unroll
  for(int d0=0;d0<2;++d0){s16x4 lo[4],hi[4];
    #pragma unroll
    for(int ks=0;ks<4;++ks){
      asm volatile("ds_read_b64_tr_b16 %0,%1 offset:%c2":"=&v"(lo[ks]):"v"(vb),"i"(d0*4096+ks*1024):"memory");
      asm volatile("ds_read_b64_tr_b16 %0,%1 offset:%c2":"=&v"(hi[ks]):"v"(vb),"i"(d0*4096+ks*1024+512):"memory");}
    asm volatile("s_waitcnt lgkmcnt(0)":::"memory");SBAR();
    #define PK(k) (bf16x8){lo[k][0],lo[k][1],lo[k][2],lo[k][3],hi[k][0],hi[k][1],hi[k][2],hi[k][3]}
    o[d0]=__builtin_amdgcn_mfma_f32_32x32x16_bf16(pa0,PK(0),o[d0],0,0,0);
    o[d0]=__builtin_amdgcn_mfma_f32_32x32x16_bf16(pa1,PK(1),o[d0],0,0,0);
    o[d0]=__builtin_amdgcn_mfma_f32_32x32x16_bf16(pa2,PK(2),o[d0],0,0,0);
    o[d0]=__builtin_amdgcn_mfma_f32_32x32x16_bf16(pa3,PK(3),o[d0],0,0,0);
    #undef PK
  }
}

#ifndef ATTN_STORE16
#define ATTN_STORE16(p,v) (*(u32x4*)(p)=(v))
#endif
template<int THRL> __device__ __forceinline__ void attn_unit(int b,int qcol,int kcol,int vcol,int ocol,int qb,const bf16*Q,const bf16*__restrict__ K,const bf16*__restrict__ V,bf16*O,char*shm){
  int tid_=threadIdx.x; asm volatile("":"+v"(tid_));
  const int tid=tid_,lane=tid&63,r32=lane&31,hi=lane>>5; const int wid=__builtin_amdgcn_readfirstlane(tid>>6);
  const long rowbase=(long)b*SEQ; const int q0=qb*QB;
  const bf16*Qw=Q+(rowbase+q0+wid*QBLK)*DM+qcol;
  const bf16*Kh=K+rowbase*DM+kcol,*Vh=V+rowbase*DM+vcol;
  const unsigned lds0=(unsigned)(uintptr_t)shm;
  float*wsf=(float*)(shm+LDS_WS)+wid*64;
  const bf16*ksrc=Kh+(long)lane*DM+wid*8;
  const bf16*vsrc=Vh+(long)(16*(wid&3)+(lane>>2))*DM+(wid>>2)*32+(lane&3)*8;
  const unsigned kdst=lds0+LDS_K+wid*1024, vdst=lds0+LDS_V+wid*1024;
  #define DMA_K(t,slot) glds16(ksrc+(long)(t)*KVBLK*DM,(unsigned)__builtin_amdgcn_readfirstlane(kdst+(slot)))
  #define DMA_V(t,slot) glds16(vsrc+(long)(t)*KVBLK*DM,(unsigned)__builtin_amdgcn_readfirstlane(vdst+(slot)))
  const int vb0=(int)(lds0+LDS_V)+((lane>>4)&1)*32+(lane&3)*8+(4*hi+((lane&15)>>2))*64;
  const char*Kbase=shm+LDS_K; bf16x8 kf[8];
  const lds_cptr shm3=(lds_cptr)shm; const lds_cptr kp0=shm3+LDS_K+hi*1024+r32*16; const lds_cptr vp0=shm3+LDS_V+((lane>>4)&1)*32+(lane&3)*8+(4*hi+((lane&15)>>2))*64;
  const int NT=(q0+QB)/KVBLK;
  DMA_K(0,0);DMA_V(0,0);DMA_K(1,SLOTB);
  bf16x8 qr[4];
  #pragma unroll
  for(int d0=0;d0<4;++d0)qr[d0]=*reinterpret_cast<const bf16x8*>(&Qw[(long)r32*DM+d0*16+hi*8]);
  float l_reg=0.f;f32x16 o[2];o[0]=f32x16{};o[1]=f32x16{};const f32x16 negm=f32x16{};
  const int qrel=wid*QBLK+r32;
  #define CMASK(P0,P1,t) do{int jb_=(t)-(NT-4); if(jb_>=0)cmask(P0,P1,jb_,qrel,hi);}while(0)
  #define START(P0,P1) do{ _Pragma("unroll") for(int r=0;r<16;++r)P0[r]=__builtin_amdgcn_exp2f(P0[r]); }while(0)
  #define RESC() do{}while(0)
  f32x16 pA0,pA1,pB0,pB1;
  int sl_prev=0,sl_cur=0,sl_next=SLOTB;
  #define ROT() do{sl_prev=sl_cur;sl_cur=sl_next;sl_next=(sl_next==(NSLOT-1)*SLOTB)?0:sl_next+SLOTB;}while(0)
  DMA_K(2,2*SLOTB);
  WAIT_BAR(3);
  qkt(pA0,pA1,Kbase,qr,negm,r32,hi);asm volatile("s_nop 15\n\ts_nop 7":"+v"(pA0),"+v"(pA1));CMASK(pA0,pA1,0);
  START(pA0,pA1);
  _Pragma("unroll") for(int r=0;r<16;++r)pA1[r]=__builtin_amdgcn_exp2f(pA1[r]);
  WAIT_BAR(0);
  DMA_K(3,0);DMA_V(1,SLOTB);
  ROT();
  kload8(kf,kp0+sl_cur);
  WAIT_BAR(2);
  s16x4 vlo[8],vhi[8]; u32x4 pw0,pw1,pw2,pw3;
  #define PKW(P,B) cvtpk_s(P[B],P[B+1])
  #define PAF(k) __builtin_bit_cast(bf16x8,pw##k)
  #define VFR(i) (bf16x8){vlo[i][0],vlo[i][1],vlo[i][2],vlo[i][3],vhi[i][0],vhi[i][1],vhi[i][2],vhi[i][3]}
  #define PIN(x) asm volatile("":"+v"(x))
  #define MX3(a,b,c) __builtin_fmaxf(__builtin_fmaxf((a),(b)),(c))
  #define GAPA(MF,A0,A1,A2,A3,W0,W1,PW) do{ MF; sacc+=A0; sacc+=A1; sacc+=A2; sacc+=A3; PIN(sacc); W0; W1; PIN(PW); SBAR(); }while(0)
  #define EX(v) __builtin_amdgcn_exp2f(v)
  #define GAPB(MF,X,B) do{ MF; X[B]=EX(X[B]); X[B+1]=EX(X[B+1]); X[B+2]=EX(X[B+2]); X[B+3]=EX(X[B+3]); PIN(X); SBAR(); }while(0)
  #define VRD(i) do{ vlo[i]=vtr(vp_+(((i)>>2)*4096+((i)&3)*1024)); vhi[i]=vtr(vp_+(((i)>>2)*4096+((i)&3)*1024+512)); }while(0)
  #define KRD(G,j) do{ if(G){ kload2(kf,kp0+sl_next,j); SBAR(); } }while(0)
  #define STEP(C0,C1,P0,P1,t,GK,GV,GL) do{ SBAR(); \
    const lds_cptr vp_=vp0+sl_prev; \
    VRD(0); SBAR(); float sacc=(P0[0]+P0[1]); \
    GAPA(C0=__builtin_amdgcn_mfma_f32_32x32x16_bf16(kf[0],qr[0],negm,0,0,0), P0[2],P0[3],P0[4],P0[5],     pw0[0]=PKW(P0,0), pw0[1]=PKW(P0,2), pw0); \
    VRD(4); SBAR(); GAPA(C1=__builtin_amdgcn_mfma_f32_32x32x16_bf16(kf[1],qr[0],negm,0,0,0), P0[6],P0[7],P0[8],P0[9],     pw0[2]=PKW(P0,4), pw0[3]=PKW(P0,6), pw0); \
    VRD(1); SBAR(); GAPA(C0=__builtin_amdgcn_mfma_f32_32x32x16_bf16(kf[2],qr[1],C0,0,0,0),   P0[10],P0[11],P0[12],P0[13], pw1[0]=PKW(P0,8), pw1[1]=PKW(P0,10), pw1); \
    VRD(5); SBAR(); GAPA(C1=__builtin_amdgcn_mfma_f32_32x32x16_bf16(kf[3],qr[1],C1,0,0,0),   P0[14],P0[15],P1[0],P1[1],   pw1[2]=PKW(P0,12),pw1[3]=PKW(P0,14), pw1); \
    VRD(2); SBAR(); GAPA(C0=__builtin_amdgcn_mfma_f32_32x32x16_bf16(kf[4],qr[2],C0,0,0,0),   P1[2],P1[3],P1[4],P1[5],     pw2[0]=PKW(P1,0), pw2[1]=PKW(P1,2), pw2); \
    VRD(6); SBAR(); GAPA(C1=__builtin_amdgcn_mfma_f32_32x32x16_bf16(kf[5],qr[2],C1,0,0,0),   P1[6],P1[7],P1[8],P1[9],     pw2[2]=PKW(P1,4), pw2[3]=PKW(P1,6), pw2); \
    VRD(3); SBAR(); GAPA(C0=__builtin_amdgcn_mfma_f32_32x32x16_bf16(kf[6],qr[3],C0,0,0,0),   P1[10],P1[11],P1[12],P1[13], pw3[0]=PKW(P1,8), pw3[1]=PKW(P1,10), pw3); \
    VRD(7); SBAR(); GAPA(C1=__builtin_amdgcn_mfma_f32_32x32x16_bf16(kf[7],qr[3],C1,0,0,0),   P1[14],P1[15],0.f,0.f,       pw3[2]=PKW(P1,12),pw3[3]=PKW(P1,14), pw3); \
    l_reg+=sacc; \
    if(GK){DMA_K((t)+3,sl_cur);} if(GV){DMA_V((t)+1,sl_next);} \
    CMASK(C0,C1,t); \
    SBAR(); \
    GAPB(o[0]=__builtin_amdgcn_mfma_f32_32x32x16_bf16(PAF(0),VFR(0),o[0],0,0,0), C0,0); \
    GAPB(o[1]=__builtin_amdgcn_mfma_f32_32x32x16_bf16(PAF(0),VFR(4),o[1],0,0,0), C0,4); \
    KRD(GL,0); GAPB(o[0]=__builtin_amdgcn_mfma_f32_32x32x16_bf16(PAF(1),VFR(1),o[0],0,0,0), C0,8); \
    KRD(GL,1); GAPB(o[1]=__builtin_amdgcn_mfma_f32_32x32x16_bf16(PAF(1),VFR(5),o[1],0,0,0), C0,12); \
    KRD(GL,2); GAPB(o[0]=__builtin_amdgcn_mfma_f32_32x32x16_bf16(PAF(2),VFR(2),o[0],0,0,0), C1,0); \
    KRD(GL,3); GAPB(o[1]=__builtin_amdgcn_mfma_f32_32x32x16_bf16(PAF(2),VFR(6),o[1],0,0,0), C1,4); \
    GAPB(o[0]=__builtin_amdgcn_mfma_f32_32x32x16_bf16(PAF(3),VFR(3),o[0],0,0,0), C1,8); \
    GAPB(o[1]=__builtin_amdgcn_mfma_f32_32x32x16_bf16(PAF(3),VFR(7),o[1],0,0,0), C1,12); \
    }while(0)
  int t=1;
  #undef CMASK
  #define CMASK(P0,P1,t) do{}while(0)
  for(;t+5<NT;t+=2){
    STEP(pB0,pB1,pA0,pA1,t,true,true,true);     WAIT_BAR(2); RESC(); ROT();
    STEP(pA0,pA1,pB0,pB1,t+1,true,true,true);   WAIT_BAR(2); RESC(); ROT();
  }
  #undef CMASK
  #define CMASK(P0,P1,t) do{int jb_=(t)-(NT-4); if(jb_>=0)cmask(P0,P1,jb_,qrel,hi);}while(0)
  #define ENDW(tt) do{ if((tt)+3<NT){WAIT_BAR(2);} else if((tt)+2<NT){WAIT_BAR(1);} else {WAIT_BAR(0);} }while(0)
  for(;t+1<NT;t+=2){
    STEP(pB0,pB1,pA0,pA1,t,(t+3<NT),(t+1<NT),(t+1<NT));       ENDW(t);   RESC(); ROT();
    STEP(pA0,pA1,pB0,pB1,t+1,(t+4<NT),(t+2<NT),(t+2<NT));     ENDW(t+1); RESC(); ROT();
  }
  STEP(pB0,pB1,pA0,pA1,NT-1,false,false,false); RESC();
  { float sacc=pB0[0]+pB0[1]; _Pragma("unroll") for(int r=2;r<16;++r)sacc+=pB0[r]; _Pragma("unroll") for(int r=0;r<16;++r)sacc+=pB1[r]; l_reg+=sacc;
    pw0=(u32x4){PKW(pB0,0),PKW(pB0,2),PKW(pB0,4),PKW(pB0,6)};pw1=(u32x4){PKW(pB0,8),PKW(pB0,10),PKW(pB0,12),PKW(pB0,14)};pw2=(u32x4){PKW(pB1,0),PKW(pB1,2),PKW(pB1,4),PKW(pB1,6)};pw3=(u32x4){PKW(pB1,8),PKW(pB1,10),PKW(pB1,12),PKW(pB1,14)};
    SBAR(); pv(o,vb0+sl_cur,PAF(0),PAF(1),PAF(2),PAF(3)); }
  #undef PKW
  #undef PAF
  #undef VFR
  #undef PIN
  #undef MX3
  #undef GAPA
  #undef GAPB
  #undef EX
  #undef VRD
  #undef KRD
  #undef STEP
  #undef ENDW
  {auto rr=__builtin_amdgcn_permlane32_swap(__float_as_uint(l_reg),__float_as_uint(l_reg),false,false);l_reg=__uint_as_float(rr[0])+__uint_as_float(rr[1]);}
  if(hi==0)wsf[32+r32]=l_reg;asm volatile("s_waitcnt lgkmcnt(0)":::"memory");
  float rli[16];
  #pragma unroll
  for(int r=0;r<16;++r)rli[r]=__builtin_amdgcn_rcpf(wsf[32+crow(r,hi)]);
  bf16*Ow=O+(rowbase+q0+wid*QBLK)*DM+ocol;
  { bf16*stg=(bf16*)(shm+LDS_OST)+wid*2048;
    #pragma unroll
    for(int r=0;r<16;++r){const int orow=crow(r,hi);
      #pragma unroll
      for(int d0=0;d0<2;++d0)stg[orow*64+d0*32+r32]=__float2bfloat16(o[d0][r]*rli[r]);}
    asm volatile("s_waitcnt lgkmcnt(0)":::"memory");
    #pragma unroll
    for(int i=0;i<4;++i){const int row=i*8+(lane>>3),ch=lane&7; const u32x4 v=*(const u32x4*)(stg+row*64+ch*8); ATTN_STORE16(Ow+(long)row*DM+ch*8,v);} }
  asm volatile("s_waitcnt lgkmcnt(0)\n\ts_barrier":::"memory");
  #undef DMA_K
  #undef DMA_V
  #undef CMASK
  #undef START
  #undef RESC
  #undef ROT
}
constexpr int ATTN_LDS_BYTES=ALDS_BYTES;

#undef SBAR
#undef WAIT_BAR
#undef ATTN_STORE16
}
namespace attn128 {
using bf16=__hip_bfloat16;
using bf16x8=__attribute__((ext_vector_type(8)))short;
using s16x4=__attribute__((ext_vector_type(4)))short;
using f32x16=__attribute__((ext_vector_type(16)))float;
using u32x4=__attribute__((ext_vector_type(4)))unsigned;
constexpr int SEQ=2048,D=64,DM=1024;
constexpr int NW=8,QBLK=32,QB=QBLK*NW,KVBLK=64,NQB=SEQ/QB;
constexpr int ATTN_PITCH=DM, ATTN_UNIT_ROWS=QB;
__device__ __forceinline__ int crow(int r,int hi){return (r&3)+8*(r>>2)+4*hi;}
#define SBAR() __builtin_amdgcn_sched_barrier(0)
__device__ __forceinline__ void cmask(f32x16&p0,f32x16&p1,int jb,int qrel,int hi){
  const float NEG=-INFINITY; int kb=64*jb+4*hi;
  #pragma unroll
  for(int r=0;r<16;++r){int kv=kb+(r&3)+8*(r>>2); if(kv>qrel)p0[r]=NEG; if(kv+32>qrel)p1[r]=NEG;}
}

constexpr int NSLOT=3, SLOTB=8192;
constexpr int VSLOTB=2*SLOTB;
constexpr int LDS_K=0, LDS_V=NSLOT*SLOTB, LDS_WS=LDS_V+NSLOT*VSLOTB, LDS_OST=LDS_WS+NW*64*4, ALDS_BYTES=LDS_OST+NW*4096;
constexpr float C2=0.125f*1.4426950408889634f;
__device__ __forceinline__ void glds16(const void*gsrc,unsigned lds_dst){unsigned keep;
  asm volatile("s_mov_b32 %0, m0\n\ts_mov_b32 m0, %2\n\ts_nop 0\n\tglobal_load_lds_dwordx4 %1, off\n\ts_mov_b32 m0, %0":"=&s"(keep):"v"(gsrc),"s"(lds_dst):"memory");}
__device__ __forceinline__ float max3f(float a,float b,float c){float r;asm("v_max3_f32 %0, %1, %2, %3":"=v"(r):"v"(a),"v"(b),"v"(c));return r;}
__device__ __forceinline__ float max2f(float a,float b){float r;asm("v_max_f32_e32 %0, %1, %2":"=v"(r):"v"(a),"v"(b));return r;}
__device__ __forceinline__ float fadd_s(float a,float b){float r;asm("v_add_f32_e32 %0, %1, %2":"=v"(r):"v"(a),"v"(b));return r;}
__device__ __forceinline__ float fsub_s(float a,float b){float r;asm("v_sub_f32_e32 %0, %1, %2":"=v"(r):"v"(a),"v"(b));return r;}
typedef float f32x2_t __attribute__((ext_vector_type(2))); typedef __bf16 bf16x2_t __attribute__((ext_vector_type(2)));
__device__ __forceinline__ unsigned cvtpk_s(float lo,float hi){f32x2_t v={lo,hi};bf16x2_t b=__builtin_convertvector(v,bf16x2_t);return __builtin_bit_cast(unsigned,b);}
#define WAIT_BAR(N) asm volatile("s_waitcnt vmcnt(" #N ") lgkmcnt(0)\n\ts_barrier":::"memory")

__device__ __forceinline__ void qkt(f32x16&p0,f32x16&p1,const char*Kslot,const bf16x8*qr,const f32x16&negm,int r32,int hi){
  const char*kb=Kslot+hi*1024+r32*16;
  #pragma unroll
  for(int d0=0;d0<4;++d0){
    const bf16x8 b0=*reinterpret_cast<const bf16x8*>(kb+d0*2048);
    const bf16x8 b1=*reinterpret_cast<const bf16x8*>(kb+d0*2048+512);
    if(d0==0){p0=__builtin_amdgcn_mfma_f32_32x32x16_bf16(b0,qr[0],negm,0,0,0);p1=__builtin_amdgcn_mfma_f32_32x32x16_bf16(b1,qr[0],negm,0,0,0);}
    else{p0=__builtin_amdgcn_mfma_f32_32x32x16_bf16(b0,qr[d0],p0,0,0,0);p1=__builtin_amdgcn_mfma_f32_32x32x16_bf16(b1,qr[d0],p1,0,0,0);}}
}
typedef __attribute__((address_space(3))) const char* lds_cptr;
typedef short v4i16_t __attribute__((ext_vector_type(4)));
__device__ __forceinline__ void kload8(bf16x8*kf,lds_cptr kp){
  kf[0]=*(const __attribute__((address_space(3))) bf16x8*)(kp);      kf[1]=*(const __attribute__((address_space(3))) bf16x8*)(kp+512);
  kf[2]=*(const __attribute__((address_space(3))) bf16x8*)(kp+2048); kf[3]=*(const __attribute__((address_space(3))) bf16x8*)(kp+2560);
  kf[4]=*(const __attribute__((address_space(3))) bf16x8*)(kp+4096); kf[5]=*(const __attribute__((address_space(3))) bf16x8*)(kp+4608);
  kf[6]=*(const __attribute__((address_space(3))) bf16x8*)(kp+6144); kf[7]=*(const __attribute__((address_space(3))) bf16x8*)(kp+6656);
}
__device__ __forceinline__ void kload2(bf16x8*kf,lds_cptr kp,int j){ kf[2*j]=*(const __attribute__((address_space(3))) bf16x8*)(kp+j*2048); kf[2*j+1]=*(const __attribute__((address_space(3))) bf16x8*)(kp+j*2048+512); }
__device__ __forceinline__ s16x4 vtr(lds_cptr p){ return __builtin_bit_cast(s16x4,__builtin_amdgcn_ds_read_tr16_b64_v4i16((__attribute__((address_space(3))) v4i16_t*)p)); }
__device__ __forceinline__ float rowmax(const f32x16&p0,const f32x16&p1){
  float a=max3f(p0[0],p0[1],p1[0]),b=max3f(p0[2],p0[3],p1[1]);a=max3f(a,p1[2],p1[3]);
  #pragma unroll
  for(int r=4;r<16;r+=4){a=max3f(a,p0[r],p0[r+1]);b=max3f(b,p0[r+2],p0[r+3]);a=max3f(a,p1[r],p1[r+1]);b=max3f(b,p1[r+2],p1[r+3]);}
  const float m=max2f(a,b);
  auto rr=__builtin_amdgcn_permlane32_swap(__float_as_uint(m),__float_as_uint(m),false,false);
  return max2f(__uint_as_float(rr[0]),__uint_as_float(rr[1]));
}
__device__ __forceinline__ void pv(f32x16*o,int vb,bf16x8 pa0,bf16x8 pa1,bf16x8 pa2,bf16x8 pa3){
  #pragma unroll
  for(int d0=0;d0<4;++d0){s16x4 lo[4],hi[4];
    #pragma unroll
    for(int ks=0;ks<4;++ks){
      asm volatile("ds_read_b64_tr_b16 %0,%1 offset:%c2":"=&v"(lo[ks]):"v"(vb),"i"(d0*4096+ks*1024):"memory");
      asm volatile("ds_read_b64_tr_b16 %0,%1 offset:%c2":"=&v"(hi[ks]):"v"(vb),"i"(d0*4096+ks*1024+512):"memory");}
    asm volatile("s_waitcnt lgkmcnt(0)":::"memory");SBAR();
    #define PK(k) (bf16x8){lo[k][0],lo[k][1],lo[k][2],lo[k][3],hi[k][0],hi[k][1],hi[k][2],hi[k][3]}
    o[d0]=__builtin_amdgcn_mfma_f32_32x32x16_bf16(pa0,PK(0),o[d0],0,0,0);
    o[d0]=__builtin_amdgcn_mfma_f32_32x32x16_bf16(pa1,PK(1),o[d0],0,0,0);
    o[d0]=__builtin_amdgcn_mfma_f32_32x32x16_bf16(pa2,PK(2),o[d0],0,0,0);
    o[d0]=__builtin_amdgcn_mfma_f32_32x32x16_bf16(pa3,PK(3),o[d0],0,0,0);
    #undef PK
  }
}

#ifndef ATTN_STORE16
#define ATTN_STORE16(p,v) (*(u32x4*)(p)=(v))
#endif
template<int THRL> __device__ __forceinline__ void attn_unit(int b,int qcol,int kcol,int vcol,int ocol,int qb,const bf16*Q,const bf16*__restrict__ K,const bf16*__restrict__ V,bf16*O,char*shm){
  int tid_=threadIdx.x; asm volatile("":"+v"(tid_));
  const int tid=tid_,lane=tid&63,r32=lane&31,hi=lane>>5; const int wid=__builtin_amdgcn_readfirstlane(tid>>6);
  const long rowbase=(long)b*SEQ; const int q0=qb*QB;
  const bf16*Qw=Q+(rowbase+q0+wid*QBLK)*DM+qcol;
  const bf16*Kh=K+rowbase*DM+kcol,*Vh=V+rowbase*DM+vcol;
  const unsigned lds0=(unsigned)(uintptr_t)shm;
  float*wsf=(float*)(shm+LDS_WS)+wid*64;
  const bf16*ksrc=Kh+(long)lane*DM+wid*8;
  const bf16*vsrc=Vh+(long)(16*(wid&3)+(lane>>2))*DM+(wid>>2)*32+(lane&3)*8;
  const unsigned kdst=lds0+LDS_K+wid*1024, vdst=lds0+LDS_V+wid*1024;
  #define DMA_K(t,slot) glds16(ksrc+(long)(t)*KVBLK*DM,(unsigned)__builtin_amdgcn_readfirstlane(kdst+(slot)))
  #define DMA_V(t,slot) do{ glds16(vsrc+(long)(t)*KVBLK*DM,(unsigned)__builtin_amdgcn_readfirstlane(vdst+2*(slot))); glds16(vsrc+64+(long)(t)*KVBLK*DM,(unsigned)__builtin_amdgcn_readfirstlane(vdst+8192+2*(slot))); }while(0)
  const int vb0=(int)(lds0+LDS_V)+((lane>>4)&1)*32+(lane&3)*8+(4*hi+((lane&15)>>2))*64;
  const char*Kbase=shm+LDS_K; bf16x8 kf[8];
  const lds_cptr shm3=(lds_cptr)shm; const lds_cptr kp0=shm3+LDS_K+hi*1024+r32*16; const lds_cptr vp0=shm3+LDS_V+((lane>>4)&1)*32+(lane&3)*8+(4*hi+((lane&15)>>2))*64;
  const int NT=(q0+QB)/KVBLK;
  DMA_K(0,0);DMA_V(0,0);DMA_K(1,SLOTB);
  bf16x8 qr[4];
  #pragma unroll
  for(int d0=0;d0<4;++d0)qr[d0]=*reinterpret_cast<const bf16x8*>(&Qw[(long)r32*DM+d0*16+hi*8]);
  float l_reg=0.f;f32x16 o[4];o[0]=f32x16{};o[1]=f32x16{};o[2]=f32x16{};o[3]=f32x16{};const f32x16 negm=f32x16{};
  const int qrel=wid*QBLK+r32;
  #define CMASK(P0,P1,t) do{int jb_=(t)-(NT-4); if(jb_>=0)cmask(P0,P1,jb_,qrel,hi);}while(0)
  #define START(P0,P1) do{ _Pragma("unroll") for(int r=0;r<16;++r)P0[r]=__builtin_amdgcn_exp2f(P0[r]); }while(0)
  #define RESC() do{}while(0)
  f32x16 pA0,pA1,pB0,pB1;
  int sl_prev=0,sl_cur=0,sl_next=SLOTB;
  #define ROT() do{sl_prev=sl_cur;sl_cur=sl_next;sl_next=(sl_next==(NSLOT-1)*SLOTB)?0:sl_next+SLOTB;}while(0)
  DMA_K(2,2*SLOTB);
  WAIT_BAR(4);
  qkt(pA0,pA1,Kbase,qr,negm,r32,hi);asm volatile("s_nop 15\n\ts_nop 7":"+v"(pA0),"+v"(pA1));CMASK(pA0,pA1,0);
  START(pA0,pA1);
  _Pragma("unroll") for(int r=0;r<16;++r)pA1[r]=__builtin_amdgcn_exp2f(pA1[r]);
  WAIT_BAR(0);
  DMA_K(3,0);DMA_V(1,SLOTB);
  ROT();
  kload8(kf,kp0+sl_cur);
  WAIT_BAR(3);
  s16x4 vlo[8],vhi[8]; u32x4 pw0,pw1,pw2,pw3;
  #define PKW(P,B) cvtpk_s(P[B],P[B+1])
  #define PAF(k) __builtin_bit_cast(bf16x8,pw##k)
  #define VFR(i) (bf16x8){vlo[i][0],vlo[i][1],vlo[i][2],vlo[i][3],vhi[i][0],vhi[i][1],vhi[i][2],vhi[i][3]}
  #define PIN(x) asm volatile("":"+v"(x))
  #define MX3(a,b,c) __builtin_fmaxf(__builtin_fmaxf((a),(b)),(c))
  #define GAPA(MF,A0,A1,A2,A3,W0,W1,PW) do{ MF; sacc+=A0; sacc+=A1; sacc+=A2; sacc+=A3; PIN(sacc); W0; W1; PIN(PW); SBAR(); }while(0)
  #define EX(v) __builtin_amdgcn_exp2f(v)
  #define GAPB(MF,X,B) do{ MF; X[B]=EX(X[B]); X[B+1]=EX(X[B+1]); PIN(X); SBAR(); }while(0)
  #define VRD2(i) do{ vlo[i]=vtr(vp_+((((i)>>2)+2)*4096+((i)&3)*1024)); vhi[i]=vtr(vp_+((((i)>>2)+2)*4096+((i)&3)*1024+512)); }while(0)
  #define VRD(i) do{ vlo[i]=vtr(vp_+(((i)>>2)*4096+((i)&3)*1024)); vhi[i]=vtr(vp_+(((i)>>2)*4096+((i)&3)*1024+512)); }while(0)
  #define KRD(G,j) do{ if(G){ kload2(kf,kp0+sl_next,j); SBAR(); } }while(0)
  #define STEP(C0,C1,P0,P1,t,GK,GV,GL) do{ SBAR(); \
    const lds_cptr vp_=vp0+2*sl_prev; \
    VRD(0); SBAR(); float sacc=(P0[0]+P0[1]); \
    GAPA(C0=__builtin_amdgcn_mfma_f32_32x32x16_bf16(kf[0],qr[0],negm,0,0,0), P0[2],P0[3],P0[4],P0[5],     pw0[0]=PKW(P0,0), pw0[1]=PKW(P0,2), pw0); \
    VRD(4); SBAR(); GAPA(C1=__builtin_amdgcn_mfma_f32_32x32x16_bf16(kf[1],qr[0],negm,0,0,0), P0[6],P0[7],P0[8],P0[9],     pw0[2]=PKW(P0,4), pw0[3]=PKW(P0,6), pw0); \
    VRD(1); SBAR(); GAPA(C0=__builtin_amdgcn_mfma_f32_32x32x16_bf16(kf[2],qr[1],C0,0,0,0),   P0[10],P0[11],P0[12],P0[13], pw1[0]=PKW(P0,8), pw1[1]=PKW(P0,10), pw1); \
    VRD(5); SBAR(); GAPA(C1=__builtin_amdgcn_mfma_f32_32x32x16_bf16(kf[3],qr[1],C1,0,0,0),   P0[14],P0[15],P1[0],P1[1],   pw1[2]=PKW(P0,12),pw1[3]=PKW(P0,14), pw1); \
    VRD(2); SBAR(); GAPA(C0=__builtin_amdgcn_mfma_f32_32x32x16_bf16(kf[4],qr[2],C0,0,0,0),   P1[2],P1[3],P1[4],P1[5],     pw2[0]=PKW(P1,0), pw2[1]=PKW(P1,2), pw2); \
    VRD(6); SBAR(); GAPA(C1=__builtin_amdgcn_mfma_f32_32x32x16_bf16(kf[5],qr[2],C1,0,0,0),   P1[6],P1[7],P1[8],P1[9],     pw2[2]=PKW(P1,4), pw2[3]=PKW(P1,6), pw2); \
    VRD(3); SBAR(); GAPA(C0=__builtin_amdgcn_mfma_f32_32x32x16_bf16(kf[6],qr[3],C0,0,0,0),   P1[10],P1[11],P1[12],P1[13], pw3[0]=PKW(P1,8), pw3[1]=PKW(P1,10), pw3); \
    VRD(7); SBAR(); GAPA(C1=__builtin_amdgcn_mfma_f32_32x32x16_bf16(kf[7],qr[3],C1,0,0,0),   P1[14],P1[15],0.f,0.f,       pw3[2]=PKW(P1,12),pw3[3]=PKW(P1,14), pw3); \
    l_reg+=sacc; \
    if(GK){DMA_K((t)+3,sl_cur);} if(GV){DMA_V((t)+1,sl_next);} \
    CMASK(C0,C1,t); \
    SBAR(); \
    GAPB(o[0]=__builtin_amdgcn_mfma_f32_32x32x16_bf16(PAF(0),VFR(0),o[0],0,0,0), C0,0);  VRD2(0); SBAR(); \
    GAPB(o[1]=__builtin_amdgcn_mfma_f32_32x32x16_bf16(PAF(0),VFR(4),o[1],0,0,0), C0,2);  VRD2(4); SBAR(); \
    KRD(GL,0); GAPB(o[0]=__builtin_amdgcn_mfma_f32_32x32x16_bf16(PAF(1),VFR(1),o[0],0,0,0), C0,4);  VRD2(1); SBAR(); \
    KRD(GL,1); GAPB(o[1]=__builtin_amdgcn_mfma_f32_32x32x16_bf16(PAF(1),VFR(5),o[1],0,0,0), C0,6);  VRD2(5); SBAR(); \
    KRD(GL,2); GAPB(o[0]=__builtin_amdgcn_mfma_f32_32x32x16_bf16(PAF(2),VFR(2),o[0],0,0,0), C0,8);  VRD2(2); SBAR(); \
    KRD(GL,3); GAPB(o[1]=__builtin_amdgcn_mfma_f32_32x32x16_bf16(PAF(2),VFR(6),o[1],0,0,0), C0,10); VRD2(6); SBAR(); \
    GAPB(o[0]=__builtin_amdgcn_mfma_f32_32x32x16_bf16(PAF(3),VFR(3),o[0],0,0,0), C0,12); VRD2(3); SBAR(); \
    GAPB(o[1]=__builtin_amdgcn_mfma_f32_32x32x16_bf16(PAF(3),VFR(7),o[1],0,0,0), C0,14); VRD2(7); SBAR(); \
    GAPB(o[2]=__builtin_amdgcn_mfma_f32_32x32x16_bf16(PAF(0),VFR(0),o[2],0,0,0), C1,0); \
    GAPB(o[3]=__builtin_amdgcn_mfma_f32_32x32x16_bf16(PAF(0),VFR(4),o[3],0,0,0), C1,2); \
    GAPB(o[2]=__builtin_amdgcn_mfma_f32_32x32x16_bf16(PAF(1),VFR(1),o[2],0,0,0), C1,4); \
    GAPB(o[3]=__builtin_amdgcn_mfma_f32_32x32x16_bf16(PAF(1),VFR(5),o[3],0,0,0), C1,6); \
    GAPB(o[2]=__builtin_amdgcn_mfma_f32_32x32x16_bf16(PAF(2),VFR(2),o[2],0,0,0), C1,8); \
    GAPB(o[3]=__builtin_amdgcn_mfma_f32_32x32x16_bf16(PAF(2),VFR(6),o[3],0,0,0), C1,10); \
    GAPB(o[2]=__builtin_amdgcn_mfma_f32_32x32x16_bf16(PAF(3),VFR(3),o[2],0,0,0), C1,12); \
    GAPB(o[3]=__builtin_amdgcn_mfma_f32_32x32x16_bf16(PAF(3),VFR(7),o[3],0,0,0), C1,14); \
    }while(0)
  int t=1;
  #undef CMASK
  #define CMASK(P0,P1,t) do{}while(0)
  for(;t+5<NT;t+=2){
    STEP(pB0,pB1,pA0,pA1,t,true,true,true);     WAIT_BAR(3); RESC(); ROT();
    STEP(pA0,pA1,pB0,pB1,t+1,true,true,true);   WAIT_BAR(3); RESC(); ROT();
  }
  #undef CMASK
  #define CMASK(P0,P1,t) do{int jb_=(t)-(NT-4); if(jb_>=0)cmask(P0,P1,jb_,qrel,hi);}while(0)
  #define ENDW(tt) do{ if((tt)+3<NT){WAIT_BAR(3);} else if((tt)+2<NT){WAIT_BAR(2);} else {WAIT_BAR(0);} }while(0)
  for(;t+1<NT;t+=2){
    STEP(pB0,pB1,pA0,pA1,t,(t+3<NT),(t+1<NT),(t+1<NT));       ENDW(t);   RESC(); ROT();
    STEP(pA0,pA1,pB0,pB1,t+1,(t+4<NT),(t+2<NT),(t+2<NT));     ENDW(t+1); RESC(); ROT();
  }
  STEP(pB0,pB1,pA0,pA1,NT-1,false,false,false); RESC();
  { float sacc=pB0[0]+pB0[1]; _Pragma("unroll") for(int r=2;r<16;++r)sacc+=pB0[r]; _Pragma("unroll") for(int r=0;r<16;++r)sacc+=pB1[r]; l_reg+=sacc;
    pw0=(u32x4){PKW(pB0,0),PKW(pB0,2),PKW(pB0,4),PKW(pB0,6)};pw1=(u32x4){PKW(pB0,8),PKW(pB0,10),PKW(pB0,12),PKW(pB0,14)};pw2=(u32x4){PKW(pB1,0),PKW(pB1,2),PKW(pB1,4),PKW(pB1,6)};pw3=(u32x4){PKW(pB1,8),PKW(pB1,10),PKW(pB1,12),PKW(pB1,14)};
    SBAR(); pv(o,vb0+2*sl_cur,PAF(0),PAF(1),PAF(2),PAF(3)); }
  #undef PKW
  #undef PAF
  #undef VFR
  #undef PIN
  #undef MX3
  #undef GAPA
  #undef GAPB
  #undef EX
  #undef VRD
  #undef VRD2
  #undef KRD
  #undef STEP
  #undef ENDW
  {auto rr=__builtin_amdgcn_permlane32_swap(__float_as_uint(l_reg),__float_as_uint(l_reg),false,false);l_reg=__uint_as_float(rr[0])+__uint_as_float(rr[1]);}
  if(hi==0)wsf[32+r32]=l_reg;asm volatile("s_waitcnt lgkmcnt(0)":::"memory");
  float rli[16];
  #pragma unroll
  for(int r=0;r<16;++r)rli[r]=__builtin_amdgcn_rcpf(wsf[32+crow(r,hi)]);
  bf16*Ow=O+(rowbase+q0+wid*QBLK)*DM+ocol;
  { bf16*stg=(bf16*)(shm+LDS_OST)+wid*2048;
    #pragma unroll
    for(int hv=0;hv<2;++hv){
      #pragma unroll
      for(int r=0;r<16;++r){const int orow=crow(r,hi);
        #pragma unroll
        for(int d0=0;d0<2;++d0)stg[orow*64+d0*32+r32]=__float2bfloat16(o[2*hv+d0][r]*rli[r]);}
      asm volatile("s_waitcnt lgkmcnt(0)":::"memory");
      #pragma unroll
      for(int i=0;i<4;++i){const int row=i*8+(lane>>3),ch=lane&7; const u32x4 v=*(const u32x4*)(stg+row*64+ch*8); ATTN_STORE16(Ow+(long)row*DM+hv*64+ch*8,v);}
      asm volatile("s_waitcnt lgkmcnt(0)":::"memory"); } }
  asm volatile("s_waitcnt lgkmcnt(0)\n\ts_barrier":::"memory");
  #undef DMA_K
  #undef DMA_V
  #undef CMASK
  #undef START
  #undef RESC
  #undef ROT
}
constexpr int ATTN_LDS_BYTES=ALDS_BYTES;

#undef SBAR
#undef WAIT_BAR
#undef ATTN_STORE16
}
constexpr size_t WS_ATT0 = WS_ACT, WS_ATT1 = WS_ACT + 32 * MiB;

__device__ __forceinline__ void diff_combine(const Params& P, int b, int h, int qb) {
    int tid_ = threadIdx.x; asm volatile("" : "+v"(tid_));
    const int tid = tid_, lane = tid & 63, wid = tid >> 6;
    const float lam = __expf(wave_sum(P.in[I_LQ1][lane] * P.in[I_LK1][lane])) - __expf(wave_sum(P.in[I_LQ2][lane] * P.in[I_LK2][lane])) + 0.2f;
    const int ch = lane & 15;
    const f32x4 g0 = *(const f32x4*)(P.in[I_SG] + 8 * ch), g1 = *(const f32x4*)(P.in[I_SG] + 8 * ch + 4);
    const size_t row0 = (size_t)b * SEQ + qb * 256 + wid * 32 + (lane >> 4);
    const bf16_t* s0 = (const bf16_t*)(P.ws + WS_ATT0) + row0 * D + h * 128 + 8 * ch; const bf16_t* s1 = (const bf16_t*)(P.ws + WS_ATT1) + row0 * D + h * 128 + 8 * ch;
    bf16_t* dst = (bf16_t*)(P.ws + WS_MA) + row0 * MA_LD + h * 128 + 8 * ch;
#pragma unroll
    for (int hb = 0; hb < 2; ++hb) { u32x4 ra[4], rb[4];
#pragma unroll
        for (int q = 0; q < 4; ++q) { const int it = 4 * hb + q; ra[q] = *(const u32x4*)(s0 + (size_t)(4 * it) * D); rb[q] = *(const u32x4*)(s1 + (size_t)(4 * it) * D); }
        asm volatile("" ::: "memory");
#pragma unroll
        for (int q = 0; q < 4; ++q) { const int it = 4 * hb + q;
            f32x4 a0, a1, b0, b1; pg::unpack8(ra[q], a0, a1); pg::unpack8(rb[q], b0, b1);
            const f32x4 o0 = a0 - lam * b0, o1 = a1 - lam * b1;
            float ss = (o0[0] * o0[0] + o0[1] * o0[1]) + (o0[2] * o0[2] + o0[3] * o0[3]) + (o1[0] * o1[0] + o1[1] * o1[1]) + (o1[2] * o1[2] + o1[3] * o1[3]);
            ss += __shfl_xor(ss, 1); ss += __shfl_xor(ss, 2); ss += __shfl_xor(ss, 4); ss += __shfl_xor(ss, 8);
            const float r = rsqrtf(ss * (1.f / 128.f) + EPS) * 0.8f;
            *(u32x4*)(dst + (size_t)(4 * it) * MA_LD) = pg::pack8(o0 * r * g0, o1 * r * g1); }
        asm volatile("" ::: "memory"); }
}
__device__ __forceinline__ void attn_phase(const Params& P, char* lds, int vcu, int G) {
    using attn_body::bf16;
    const bf16* Q = (const bf16*)(P.ws + WS_Q); const bf16* K = (const bf16*)(P.ws + WS_K); const bf16* V = (const bf16*)(P.ws + WS_V);
    for (int v = vcu; v < 256; v += G) {
        const int bh = v >> 2, b = bh >> 3, h = bh & 7, s = v & 3;
        for (int i = 0; i < 2; ++i) { const int qb = i == 0 ? 7 - s : s;
#ifndef ATTN_V128
#define ATTN_V128 1
#endif
#if ATTN_V128
            for (int m = 0; m < 2; ++m) {
#if EXPERTS_IN_ATTN
#ifndef CONV_SLOTS
#define CONV_SLOTS 4
#endif
#ifndef CONV_SPLIT
#define CONV_SPLIT 1
#endif
                if (CONV_SLOTS == 2 ? (i == 0 && m == ((v >> 2) & 1)) : ((i * 2 + m - (((v >> 2) + v) & 3)) & (CONV_SPLIT == 2 ? 1 : 3)) == 0) {
                    constexpr int per = (EXP_M10 - EXP_ATT0) / 256; const int hsel = CONV_SPLIT == 2 ? (((i * 2 + m - (((v >> 2) + v) & 3)) >> 1) & 1) : 0;
                    expert_convert_slice(P, (LAS unsigned char*)lds, EXP_ATT0 + v * per + hsel * (per / 2), CONV_SPLIT == 2 ? EXP_ATT0 + v * per + (hsel + 1) * (per / 2) : EXP_ATT0 + (v + 1) * per);
#if defined(PROBE_CONV2)
                    asm volatile("s_waitcnt vmcnt(0) lgkmcnt(0)" ::: "memory"); __syncthreads(); expert_convert_slice(P, (LAS unsigned char*)lds, EXP_ATT0 + v * per, EXP_ATT0 + (v + 1) * per, true);
#endif
                    asm volatile("s_waitcnt vmcnt(0) lgkmcnt(0)" ::: "memory"); __syncthreads(); }
#endif
                attn128::attn_unit<8>(b, h * 128 + m * 64, h * 128 + m * 64, h * 128, h * 128, qb, (const attn128::bf16*)Q, (const attn128::bf16*)K, (const attn128::bf16*)V, (attn128::bf16*)(P.ws + (m == 0 ? WS_ATT0 : WS_ATT1)), lds); }
#else
            for (int pass = 0; pass < 4; ++pass) { const int m = pass >> 1, vh = pass & 1;
#if EXPERTS_IN_ATTN
                if (i * 4 + pass == (((v >> 2) + v) & 3)) {
                    constexpr int per = (EXP_M10 - EXP_ATT0) / 256; expert_convert_slice(P, (LAS unsigned char*)lds, EXP_ATT0 + v * per, EXP_ATT0 + (v + 1) * per);
                    asm volatile("s_waitcnt vmcnt(0) lgkmcnt(0)" ::: "memory"); __syncthreads(); }
#endif
                attn_body::attn_unit<8>(b, h * 128 + m * 64, h * 128 + m * 64, h * 128 + vh * 64, h * 128 + vh * 64, qb, Q, K, V, (bf16*)(P.ws + (m == 0 ? WS_ATT0 : WS_ATT1)), lds); }
#endif
            asm volatile("s_waitcnt vmcnt(0)" ::: "memory");
            diff_combine(P, b, h, qb);
        }
    }
}

__device__ __forceinline__ void ssm1_phase(const Params& P, LAS unsigned char* lds, int vcu, int G) {
    const int tid = opaque_tid(), lane = tid & 63, wid = __builtin_amdgcn_readfirstlane(tid >> 6), fr = lane & 15, fq = lane >> 4;
    LAS float* Sl = (LAS float*)lds;
    for (int u = vcu; u < SSM_G * BATCH; u += G) {
        const int g = u >> 3, b = u & 7;
        bf16_t* A = (bf16_t*)(P.ws + WS_ACAT) + (size_t)(g * ACAT_ROWS + b * NCH) * ACAT_LD;
        const bf16_t* Bw = (const bf16_t*)(P.ws + WS_WS_T) + (size_t)(g * 128 + 16 * wid + fr) * 512 + fq * 8;
        f32x4 acc[4];
#pragma unroll
        for (int m = 0; m < 4; ++m) acc[m] = (f32x4){0.f, 0.f, 0.f, 0.f};
#pragma unroll 4
        for (int ks = 0; ks < 16; ++ks) {
            const bf16x8 bf = *(const bf16x8*)(Bw + ks * 32);
#pragma unroll
            for (int m = 0; m < 4; ++m) { const bf16x8 af = *(const bf16x8*)(A + (size_t)(16 * m + fr) * ACAT_LD + ks * 32 + fq * 8);
                acc[m] = __builtin_amdgcn_mfma_f32_16x16x32_bf16(af, bf, acc[m], 0, 0, 0); }
        }
#pragma unroll
        for (int m = 0; m < 4; ++m)
#pragma unroll
            for (int q = 0; q < 4; ++q) Sl[(16 * m + 4 * fq + q) * 129 + 16 * wid + fr] = acc[m][q];
        __syncthreads();
        if (tid < SSM_P) {
            const int p = tid; const SsmGP gp = ssm_gp(P, g, p); float aLr, aLi; ssm_pow(gp, CH_L, aLr, aLi);
            float xr = 0.f, xi = 0.f;
            bf16_t* xp = A + 512 + p;
            for (int c = 0; c < NCH; ++c) {
                xp[(size_t)c * ACAT_LD] = (bf16_t)f2bf(xr); xp[(size_t)c * ACAT_LD + 64] = (bf16_t)f2bf(xi);
                const float sr = Sl[c * 129 + p], si = Sl[c * 129 + 64 + p];
                const float nr = aLr * xr - aLi * xi + sr, ni = aLr * xi + aLi * xr + si; xr = nr; xi = ni;
            }
        }
        __syncthreads();
    }
}
namespace pg {
struct Ssm2Sched {
    unsigned char* ws; int G, c;
    __device__ __forceinline__ void init(unsigned char* ws_, int G_, int c_) { ws = ws_; G = G_; c = c_; }
    __device__ __forceinline__ bool next(int i, Unit& u) const {
        const int L = i * G + c; if (L >= SSM_G * 4) return false;
        const int g = L >> 2; u.pm = (L >> 1) & 1; u.pn = L & 1; u.aux = g; u.aux2 = 0; u.ord = i; const LaneRC rc;
        u.A = (const char*)((const bf16_t*)(ws + WS_ACAT) + (size_t)g * ACAT_ROWS * ACAT_LD); u.B = (const char*)((const bf16_t*)(ws + WS_BT_SSM) + ((size_t)g * 512 + u.pn * BM) * ACAT_LD);
#pragma unroll
        for (int h = 0; h < 2; ++h)
#pragma unroll
            for (int j = 0; j < 2; ++j) u.aoff[h][j] = (unsigned)(((u.pm * BM + 128 * h + rc.R[j]) * ACAT_LD + rc.C[j]) * 2);
        return true;
    }
};
}

constexpr int RT_LG_OFF = RING_BYTES + 2048;
constexpr int RT_HIST_OFF = RT_LG_OFF + 64 * 33 * 4;
__device__ __forceinline__ void router_phase(const Params& P, LAS unsigned char* lds, int vcu, int G) {
    const int tid = opaque_tid(), lane = tid & 63, wid = __builtin_amdgcn_readfirstlane(tid >> 6);
    const float* wrt = (const float*)(P.ws + WS_WR_T);
#pragma unroll
    for (int i = 0; i < 16; ++i) __builtin_amdgcn_global_load_lds((const unsigned*)(wrt + (size_t)(tid + NTHREADS * i) * 4), (LAS unsigned*)(lds + wid * 1024 + i * 8192), 16, 0, 0);
    LAS float* lg = (LAS float*)(lds + RT_LG_OFF); LAS int* hist = (LAS int*)(lds + RT_HIST_OFF);
    int* slot_tok = (int*)(P.ws + WS_SLOT_TOK); float* slot_gate = (float*)(P.ws + WS_SLOT_GATE); int* tok_ep = (int*)(P.ws + WS_TOK_EP);
    unsigned char* H2 = P.ws + WS_H2;
    for (int tb = vcu; tb < T / 64; tb += G) {
        if (tid < 64) hist[tid] = 0;
        _Pragma("clang loop unroll(disable)") for (int pass = 0; pass < 2; ++pass) {
            const int t0 = tb * 64 + wid * 8 + pass * 4;
            f32x4 h[4][4];
            { u32x2 hr[4][4];
#pragma unroll
              for (int t = 0; t < 4; ++t)
#pragma unroll
                  for (int j = 0; j < 4; ++j) hr[t][j] = NT_LOAD((const u32x2*)((const bf16_t*)(P.ws + WS_X1) + (size_t)(t0 + t) * D) + lane + 64 * j);
#pragma unroll
              for (int t = 0; t < 4; ++t)
#pragma unroll
                  for (int j = 0; j < 4; ++j) h[t][j] = (f32x4){bflo(hr[t][j].x), bfhi(hr[t][j].x), bflo(hr[t][j].y), bfhi(hr[t][j].y)}; }
            if (pass == 0) { asm volatile("s_waitcnt vmcnt(0)" ::: "memory"); __syncthreads(); }
            f32x2 ha[4][4], hb[4][4];
#pragma unroll
            for (int tp = 0; tp < 2; ++tp) {
                float s0 = 0.f, s1 = 0.f;
#pragma unroll
                for (int j = 0; j < 4; ++j) { const f32x4 a = h[2 * tp][j], b = h[2 * tp + 1][j]; s0 += (a.x * a.x + a.y * a.y) + (a.z * a.z + a.w * a.w); s1 += (b.x * b.x + b.y * b.y) + (b.z * b.z + b.w * b.w); }
                const float r0 = rsqrtf(wave_sum(s0) * (1.f / D) + EPS), r1 = rsqrtf(wave_sum(s1) * (1.f / D) + EPS);
#pragma unroll
                for (int j = 0; j < 4; ++j) { const f32x4 g2 = ((const f32x4*)P.in[I_G2])[lane + 64 * j]; const f32x4 a = h[2 * tp][j] * r0 * g2, b = h[2 * tp + 1][j] * r1 * g2;
                    ((unsigned*)(H2 + (size_t)(t0 + 2 * tp) * D))[lane + 64 * j] = pk4_fp8(a.x, a.y, a.z, a.w);
                    ((unsigned*)(H2 + (size_t)(t0 + 2 * tp + 1) * D))[lane + 64 * j] = pk4_fp8(b.x, b.y, b.z, b.w);
#pragma unroll
                    for (int c = 0; c < 4; ++c) { const f32x2 pr = {a[c], b[c]}; if (tp == 0) ha[j][c] = pr; else hb[j][c] = pr; } }
            }
            f32x2 v[64];
#pragma unroll
            for (int e = 0; e < NE; ++e) { f32x2 a0 = {0.f, 0.f}, a1 = {0.f, 0.f};
                f32x4 w[4];
#pragma unroll
                for (int j = 0; j < 4; ++j) w[j] = ((const LAS f32x4*)(lds + e * 4096))[lane + 64 * j];
#pragma unroll
                for (int j = 0; j < 4; ++j)
#pragma unroll
                    for (int c = 0; c < 4; ++c) { const f32x2 ww = {w[j][c], w[j][c]}; a0 += ha[j][c] * ww; a1 += hb[j][c] * ww; }
                v[e] = a0; v[32 + e] = a1; }
#pragma unroll
            for (int half = 32; half >= 1; half >>= 1) { const bool upper = (lane & half) != 0;
#pragma unroll
                for (int i = 0; i < half; ++i) { const f32x2 send = upper ? v[i] : v[i + half], keep = upper ? v[i + half] : v[i]; const f32x2 got = {__shfl_xor(send.x, half), __shfl_xor(send.y, half)}; v[i] = keep + got; } }
            const float br = P.in[I_BR][lane & 31]; const int tl = wid * 8 + pass * 4 + 2 * (lane >> 5);
            lg[tl * 33 + (lane & 31)] = v[0].x + br; lg[(tl + 1) * 33 + (lane & 31)] = v[0].y + br;
        }
        __syncthreads();
        if (wid == 0) {
            const int tok = tb * 64 + lane;
            float tv[4]; int ti[4];
#pragma unroll
            for (int k = 0; k < 4; ++k) { tv[k] = -INFINITY; ti[k] = 0; }
            for (int e = 0; e < NE; ++e) { const float x = lg[lane * 33 + e];
                if (x > tv[3]) { if (x > tv[2]) { tv[3] = tv[2]; ti[3] = ti[2]; if (x > tv[1]) { tv[2] = tv[1]; ti[2] = ti[1]; if (x > tv[0]) { tv[1] = tv[0]; ti[1] = ti[0]; tv[0] = x; ti[0] = e; } else { tv[1] = x; ti[1] = e; } } else { tv[2] = x; ti[2] = e; } } else { tv[3] = x; ti[3] = e; } } }
            const float e1 = __expf(tv[1] - tv[0]), e2 = __expf(tv[2] - tv[0]), e3 = __expf(tv[3] - tv[0]); const float inv = 1.f / (1.f + e1 + e2 + e3);
            const float gk[4] = {inv, e1 * inv, e2 * inv, e3 * inv};
            int lp[4];
#pragma unroll
            for (int k = 0; k < 4; ++k) lp[k] = atomicAdd((int*)&hist[ti[k]], 1);
            asm volatile("s_waitcnt lgkmcnt(0)" ::: "memory");
            { const int l2 = opaque_tid() & 63;
              if (l2 < NE) { const int n = hist[l2]; hist[32 + l2] = n ? (int)atomicAdd((unsigned*)(P.ws + WS_CTL) + CW_CNT + l2, (unsigned)n) : 0; } }
            asm volatile("s_waitcnt vmcnt(0) lgkmcnt(0)" ::: "memory");
#pragma unroll
            for (int k = 0; k < 4; ++k) { const int e = ti[k], pos = hist[32 + e] + lp[k];
                slot_tok[(size_t)e * CAP + pos] = tok; slot_gate[(size_t)e * CAP + pos] = gk[k]; tok_ep[tok * 4 + k] = (e << 16) | pos; }
        }
        __syncthreads();
    }
}

#ifndef COMB_Y_DEFAULT
#define COMB_Y_LOAD(p) NT_LOAD(p)
#else
#define COMB_Y_LOAD(p) (*(p))
#endif
__device__ __forceinline__ void combine_phase(const Params& P, LAS unsigned char* lds, int vcu, int G) {
    const int tid = opaque_tid(), lane = tid & 63, wid = __builtin_amdgcn_readfirstlane(tid >> 6);
    const LAS int* tab = (const LAS int*)(lds + pg::TAB_OFF);
    const int* tok_ep = (const int*)(P.ws + WS_TOK_EP); const bf16_t* Y = (const bf16_t*)(P.ws + WS_Y); const float* sgate = (const float*)(P.ws + WS_SLOT_GATE);
    for (int tok = (vcu * NWAVES + wid) * 2; tok < T; tok += G * NWAVES * 2) {
        f32x4 a[2][4]; u32x2 xr[2][4]; u32x2 yv[2][4][4]; float gk[2][4];
#pragma unroll
        for (int tt = 0; tt < 2; ++tt) {
#pragma unroll
            for (int j = 0; j < 4; ++j) xr[tt][j] = NT_LOAD((const u32x2*)((const bf16_t*)(P.ws + WS_X1) + (size_t)(tok + tt) * D) + lane + 64 * j);
#pragma unroll
            for (int k = 0; k < 4; ++k) { const int ep = tok_ep[(tok + tt) * 4 + k]; const int slot = tab[ep >> 16] * 256 + (ep & 0xffff); gk[tt][k] = sgate[(size_t)(ep >> 16) * CAP + (ep & 0xffff)];
#pragma unroll
                for (int j = 0; j < 4; ++j) yv[tt][k][j] = COMB_Y_LOAD((const u32x2*)(Y + (size_t)slot * D) + lane + 64 * j); } }
        asm volatile("" ::: "memory");
#pragma unroll
        for (int tt = 0; tt < 2; ++tt) {
#pragma unroll
            for (int j = 0; j < 4; ++j) a[tt][j] = (f32x4){bflo(xr[tt][j].x), bfhi(xr[tt][j].x), bflo(xr[tt][j].y), bfhi(xr[tt][j].y)};
#pragma unroll
            for (int k = 0; k < 4; ++k)
#pragma unroll
                for (int j = 0; j < 4; ++j) { const u32x2 w = yv[tt][k][j]; a[tt][j] += gk[tt][k] * (f32x4){bflo(w.x), bfhi(w.x), bflo(w.y), bfhi(w.y)}; }
#pragma unroll
            for (int j = 0; j < 4; ++j) NT_STORE(a[tt][j], (f32x4*)(P.out + (size_t)(tok + tt) * D) + lane + 64 * j); }
    }
}
#define XB_TMO      128
#define XB_XCNT(j)  (256  + 64 * (j))
#define XB_XSUB(j)  (1280 + 64 * (j))
#define XB_XGEN(j)  (2304 + 64 * (j))
#define XB_TOP      3328
#define XB_TOPGEN   3392
#define XCD_BAR_WORDS 3456
#define XB_SPIN_CAP (1u << 18)
__device__ __forceinline__ unsigned xb_ld(unsigned* p)              { return __hip_atomic_load(p, __ATOMIC_RELAXED, __HIP_MEMORY_SCOPE_AGENT); }
__device__ __forceinline__ unsigned xb_add(unsigned* p, unsigned v) { return __hip_atomic_fetch_add(p, v, __ATOMIC_RELAXED, __HIP_MEMORY_SCOPE_AGENT); }
__device__ __forceinline__ unsigned xb_xcc_id() { return (unsigned)__builtin_amdgcn_s_getreg((3 << 11) | 20) & 0xFu; }
#define XB_SPIN(cond, bar) do { unsigned _sp = 0; while (cond) { __builtin_amdgcn_s_sleep(1); \
    if ((++_sp & 255u) == 0u) { if (xb_ld(&(bar)[XB_TMO])) break; if (_sp > XB_SPIN_CAP) { atomicAdd(&(bar)[XB_TMO], 1u); break; } } } } while (0)
struct XcdBarrier { unsigned* bar; unsigned x; volatile LAS unsigned* st; };
__device__ __forceinline__ XcdBarrier xcd_barrier_post(unsigned* bar, volatile LAS unsigned* st) {
    XcdBarrier b; b.bar = bar; b.x = xb_xcc_id(); b.st = st;
    if (threadIdx.x == 0) (void)xb_add(&bar[XB_XCNT(b.x)], 1u);
    return b;
}
__device__ __forceinline__ void xcd_barrier_complete(unsigned* bar, unsigned x, unsigned& nloc, unsigned& nx) {
    const unsigned G = gridDim.x * gridDim.y * gridDim.z;
    unsigned sum, cnt, mine, sp = 0u;
    for (;;) {
        sum = 0u; cnt = 0u; mine = 0u;
#pragma unroll
        for (unsigned j = 0; j < 16; ++j) { const unsigned c = xb_ld(&bar[XB_XCNT(j)]); sum += c; cnt += (c > 0u) ? 1u : 0u; mine = (j == x) ? c : mine; }
        if (sum == G) break;
        __builtin_amdgcn_s_sleep(1);
        if ((++sp & 255u) == 0u) { if (xb_ld(&bar[XB_TMO])) break; if (sp > XB_SPIN_CAP) { atomicAdd(&bar[XB_TMO], 1u); break; } }
    }
    nloc = mine > 0u ? mine : 1u; nx = cnt > 0u ? cnt : 1u;
}
__device__ __forceinline__ void xcd_barrier(const XcdBarrier& b) {
    asm volatile("s_waitcnt vmcnt(0)" ::: "memory");
    __syncthreads();
    if (threadIdx.x == 0) {
        unsigned* bar = b.bar;
        __builtin_amdgcn_s_waitcnt(0);
        unsigned nloc = b.st[0], nx = b.st[1];
        if (nloc == 0u) { xcd_barrier_complete(bar, b.x, nloc, nx); b.st[0] = nloc; b.st[1] = nx; }
        const unsigned old = xb_add(&bar[XB_XSUB(b.x)], 1u);
        const unsigned gen = old / nloc;
        if (old + 1u == (gen + 1u) * nloc) {
            __builtin_amdgcn_fence(__ATOMIC_RELEASE, "agent");
            asm volatile("s_waitcnt vmcnt(0)" ::: "memory");
            const unsigned og = xb_add(&bar[XB_TOP], 1u);
            const unsigned tg = og / nx;
            if (og + 1u == (tg + 1u) * nx) xb_add(&bar[XB_TOPGEN], 1u);
            else XB_SPIN(xb_ld(&bar[XB_TOPGEN]) == tg, bar);
            __builtin_amdgcn_fence(__ATOMIC_ACQUIRE, "agent");
            xb_add(&bar[XB_XGEN(b.x)], 1u);
            asm volatile("s_waitcnt vmcnt(0)" ::: "memory");
        } else {
            XB_SPIN(xb_ld(&bar[XB_XGEN(b.x)]) == gen, bar);
            __builtin_amdgcn_fence(__ATOMIC_ACQUIRE, "agent");
            asm volatile("s_waitcnt vmcnt(0)" ::: "memory");
        }
    }
    __syncthreads();
}
#ifndef PH_MASK
#define PH_MASK 0xffffffffu
#endif
__global__ void __launch_bounds__(NTHREADS, 2) mega_fwd(Params P) {
    extern __shared__ __attribute__((aligned(16))) unsigned char lds_[];
    LAS unsigned char* lds = (LAS unsigned char*)lds_;
    const int tid = threadIdx.x;
    const int G = gridDim.x, bx = blockIdx.x, vcu = (G % 8 == 0) ? (bx % 8) * (G / 8) + bx / 8 : bx;
    for (int u = tid; u < (LDS_BYTES - RING_BYTES) / 4; u += NTHREADS) ((LAS unsigned*)(lds + RING_BYTES))[u] = 0u;
    __syncthreads();
    unsigned* ctl = (unsigned*)(P.ws + WS_CTL);
    const XcdBarrier bar = xcd_barrier_post(ctl + CW_BAR, (volatile LAS unsigned*)(lds + MISC_OFF) + 8);
#ifndef PH_REP
#define PH_REP 0u
#endif
#ifndef BAR_REP
#define BAR_REP 1
#endif
#define GRID_BAR() do { for (int b_ = 0; b_ < BAR_REP; ++b_) xcd_barrier(bar); } while (0)
#define ON(k) for (int r_ = 0; r_ < 1 + (int)((PH_REP >> (k)) & 1u); ++r_) if ((PH_MASK >> (k)) & 1u)
#ifndef FWD_REP
#define FWD_REP 1
#endif
    for (int fwd_ = 0; fwd_ < FWD_REP; ++fwd_) {
    if (fwd_ > 0) { GRID_BAR(); if (bx == 0 && tid < 64) ctl[CW_CNT + tid] = 0u; }
    ON(0) p0_prologue(P, lds, vcu, G);
    GRID_BAR();
    ON(1) { pg::DenseSched S; S.init((const bf16_t*)(P.ws + WS_XN), D, (const bf16_t*)(P.ws + WS_WIN_T), D, T, IN_W, G, bx);
        pg::EpiInProj E; E.ws = P.ws; E.qg = P.in[I_QG]; E.kg = P.in[I_KG];
#if defined(PROBE_NULL_EPI)
        if (r_ == 1) { pg::EpiNull EN; pg::gemm_phase(lds, S, EN, D / 64, D); } else
#endif
#ifndef INPROJ_BAUX
#define INPROJ_BAUX 0
#endif
        pg::gemm_phase<false, INPROJ_BAUX>(lds, S, E, D / 64, D);
#if EXPERTS_IN_ATTN
        if (r_ == 0 && G == 256 && bx >= 128) expert_convert_slice(P, lds, EXP_IN0 + (bx - 128) * EXP_N_IN, EXP_IN0 + (bx - 127) * EXP_N_IN);
        __syncthreads();
#endif
    }
    GRID_BAR();
    ON(2) { ssm_toeplitz_expand(P, vcu, G); ssm1_phase(P, lds, vcu, G); }
    ON(3) attn_phase(P, (char*)lds_, vcu, G);
    GRID_BAR();
    ON(4) { pg::Ssm2Sched S; S.init(P.ws, G, bx); pg::EpiSsm2 E; E.ws = P.ws; pg::gemm_phase(lds, S, E, ACAT_LD / 64, ACAT_LD);
#if EXPERTS_IN_ATTN
        if (r_ == 0 && G == 256 && bx >= 128) expert_convert_slice(P, lds, EXP_S20 + (bx - 128) * EXP_N_S2, EXP_S20 + (bx - 127) * EXP_N_S2);
        __syncthreads();
#endif
    }
    GRID_BAR();
    ON(5) { pg::DenseSched S; S.init((const bf16_t*)(P.ws + WS_Z), SSM_W, (const bf16_t*)(P.ws + WS_WGLU_T), SSM_W, T, SSM_W, G, bx);
        pg::EpiGlu E; E.ws = P.ws; E.bglu = P.in[I_BGLU]; pg::gemm_phase(lds, S, E, SSM_W / 64, SSM_W);
#if EXPERTS_IN_ATTN
        if (r_ == 0 && G == 256 && bx >= 128) expert_convert_slice(P, lds, EXP_GLU0 + (bx - 128) * EXP_N_GLU, EXP_GLU0 + (bx - 127) * EXP_N_GLU);
        __syncthreads();
#endif
    }
    GRID_BAR();
    ON(6) { pg::DenseSched S; S.init((const bf16_t*)(P.ws + WS_MA), MA_LD, (const bf16_t*)(P.ws + WS_WP_T), MA_LD, T, D, G, bx);
        pg::EpiMerged E; E.ws = P.ws; pg::gemm_phase(lds, S, E, MA_LD / 64, MA_LD); }
    GRID_BAR();
    ON(7) { pg::DenseSched S; S.init((const bf16_t*)(P.ws + WS_MERGED), D, (const bf16_t*)(P.ws + WS_WOUT_T), D, T, D, G, bx);
        pg::EpiWout E; E.x = P.in[I_X]; E.out = (bf16_t*)(P.ws + WS_X1); pg::gemm_phase(lds, S, E, D / 64, D); }
    GRID_BAR();
    ON(8) router_phase(P, lds, vcu, G);
    GRID_BAR();
    pg::moe_build_tab(lds, (const unsigned*)(P.ws + WS_CTL) + CW_CNT);
    ON(9) { pg::MoeSched<1> S; S.init(P.ws, lds, G, bx, P.in[I_B1]); pg::EpiMoe1 E; E.ws = P.ws; E.b1 = P.in[I_B1]; E.lds = lds; E.nostore = (r_ == 1);
#if defined(PROBE_MOE_NT)
        if (r_ == 1) { pg::EpiNull EN; pg::gemm_phase<true>(lds, S, EN, PROBE_MOE_NT, D / 2, 7); } else
#endif
        pg::gemm_phase<true>(lds, S, E, D / 128, D / 2);
#if EXPERTS_IN_ATTN
        if (r_ == 0 && G == 256 && (bx >> 3) >= 16) { const int k_ = (bx & 7) * 16 + (bx >> 3) - 16; expert_convert_slice(P, lds, EXP_M10 + k_ * EXP_N_M1, EXP_M10 + (k_ + 1) * EXP_N_M1); }
        __syncthreads();
#endif
    }
    GRID_BAR();
    ON(10) { pg::MoeSched<2> S; S.init(P.ws, lds, G, bx, P.in[I_B2]);
#if defined(PROBE_FREEZE)
        S.freeze = (r_ == 1);
#endif
 pg::EpiMoe2 E; E.ws = P.ws; E.b2 = P.in[I_B2]; E.lds = lds; E.nostore = (r_ == 1);
#if defined(PROBE_MOE_NT)
        if (r_ == 1) { pg::EpiNull EN; pg::gemm_phase<true>(lds, S, EN, PROBE_MOE_NT, DFF / 2, 7); } else
#endif
        pg::gemm_phase<true>(lds, S, E, DFF / 128, DFF / 2); }
    GRID_BAR();
    ON(11) combine_phase(P, lds, vcu, G);
    }
#undef ON
}

extern "C" void kernel_launch(void* const* d_in, const int* in_sizes, int n_in, void* d_out, int out_size, void* d_ws, size_t ws_size, hipStream_t stream) {
    static int grid = 0;
    if (grid == 0) {
        int dev = 0, cus = 0, per_cu = 0;
        if (hipGetDevice(&dev) != hipSuccess || hipDeviceGetAttribute(&cus, hipDeviceAttributeMultiprocessorCount, dev) != hipSuccess) { fprintf(stderr, "kernel_launch: device query failed\n"); grid = -1; return; }
        if (hipFuncSetAttribute((const void*)mega_fwd, hipFuncAttributeMaxDynamicSharedMemorySize, LDS_BYTES) != hipSuccess) { fprintf(stderr, "kernel_launch: hipFuncSetAttribute failed\n"); grid = -1; return; }
        if (hipOccupancyMaxActiveBlocksPerMultiprocessor(&per_cu, (const void*)mega_fwd, NTHREADS, LDS_BYTES) != hipSuccess || per_cu < 1) { fprintf(stderr, "kernel_launch: occupancy query reports %d workgroups per CU\n", per_cu); per_cu = 1; }
        (void)hipGetLastError();
        grid = cus;
        if (ws_size < WS_END) { fprintf(stderr, "kernel_launch: workspace too small\n"); grid = -1; return; }
    }
    if (grid < 0) return;
    hipMemsetAsync((char*)d_ws + WS_CTL, 0, CTL_ZERO_BYTES, stream);
    Params P{};
    for (int i = 0; i < 30; ++i) P.in[i] = (const float*)d_in[i];
    P.out = (float*)d_out; P.ws = (unsigned char*)d_ws;
    hipLaunchKernelGGL(mega_fwd, dim3(grid), dim3(NTHREADS), LDS_BYTES, stream, P);
#if defined(PROBE_TWO_LAUNCHES)
    hipMemsetAsync((char*)d_ws + WS_CTL, 0, CTL_ZERO_BYTES, stream);
    hipLaunchKernelGGL(mega_fwd, dim3(grid), dim3(NTHREADS), LDS_BYTES, stream, P);
#endif
}
```

```cpp
#include <hip/hip_runtime.h>
#include <hip/hip_bf16.h>
#include <stdint.h>
#include <math.h>
#include <cstdio>

constexpr int D = 1024, BATCH = 8, SEQ = 2048, T = BATCH * SEQ;
constexpr int SSM_W = 512, SSM_H = 16, SSM_G = 32, SSM_P = 64;
constexpr int CH_L = 32, NCH = SEQ / CH_L;
constexpr int ACAT_ROWS = BATCH * NCH;
constexpr int ACAT_LD = CH_L * SSM_H + 2 * SSM_P;
constexpr int AH = 8, AW = 1024;
constexpr int IN_W = 5632;
constexpr int NE = 32, DFF = 1024;
constexpr float EPS = 1e-5f;
constexpr int OFF_U = 0, OFF_Q = 512, OFF_K = 1536, OFF_V = 2560, OFF_GS = 3584, OFF_GA = 4608;
constexpr int CAP = T;
constexpr int MAXBLK = 288;
constexpr float QC2 = 0.125f * 1.4426950408889634f;
constexpr int MA_LD = 1536;

constexpr size_t MiB = 1u << 20;
constexpr size_t WS_CTL = 0, CTL_ZERO_BYTES = 64 * 1024;
constexpr size_t WS_WIN_T = 2 * MiB;
constexpr size_t WS_WGLU_T = 13 * MiB;
constexpr size_t WS_WP_T = 14 * MiB;
constexpr size_t WS_WOUT_T = 17 * MiB;
constexpr size_t WS_WR_T = 19 * MiB;
constexpr size_t WS_KJ = 21 * MiB;
constexpr size_t WS_WS_T = 22 * MiB;
constexpr size_t WS_BT_SSM = 26 * MiB;
constexpr size_t WS_W1_T = 48 * MiB;
constexpr size_t WS_W2_T = 176 * MiB;
constexpr size_t WS_XN = 240 * MiB;
constexpr size_t WS_ACAT = 272 * MiB;
constexpr size_t WS_Q = 292 * MiB, WS_K = 324 * MiB, WS_V = 356 * MiB;
constexpr size_t WS_GS = 388 * MiB, WS_GA = 420 * MiB;
constexpr size_t WS_X1 = 292 * MiB;
constexpr size_t WS_Z = 452 * MiB;
constexpr size_t WS_MA = 468 * MiB;
constexpr size_t WS_MERGED = 516 * MiB;
constexpr size_t WS_H2 = 548 * MiB;
constexpr size_t WS_SLOT_TOK = 582 * MiB;
constexpr size_t WS_SLOT_GATE = 584 * MiB;
constexpr size_t WS_TOK_EP = 586 * MiB;
constexpr size_t WS_ACT = 588 * MiB;
constexpr size_t WS_Y = 732 * MiB;
constexpr size_t WS_END = 876 * MiB;
constexpr int CW_CNT = 64;
constexpr int CW_BAR = 4096;

typedef unsigned short bf16_t;
typedef short bf16x8 __attribute__((ext_vector_type(8)));
typedef float f32x4 __attribute__((ext_vector_type(4)));
typedef float f32x2 __attribute__((ext_vector_type(2)));
typedef unsigned u32x4 __attribute__((ext_vector_type(4)));
typedef unsigned u32x2 __attribute__((ext_vector_type(2)));
#define LAS __attribute__((address_space(3)))
#define GAS __attribute__((address_space(1)))

__device__ __forceinline__ float wave_sum(float v) {
#pragma unroll
    for (int o = 1; o < 64; o <<= 1) v += __shfl_xor(v, o);
    return v;
}
typedef __bf16 bf16x2_hw __attribute__((ext_vector_type(2)));
__device__ __forceinline__ unsigned pk2(float lo, float hi) { const f32x2 v = {lo, hi}; return __builtin_bit_cast(unsigned, __builtin_convertvector(v, bf16x2_hw)); }
__device__ __forceinline__ unsigned f2bf(float f) { return pk2(f, 0.f) & 0xffffu; }
__device__ __forceinline__ float bf2f(unsigned short b) { return __builtin_bit_cast(float, (unsigned)b << 16); }
__device__ __forceinline__ float bflo(unsigned w) { return __builtin_bit_cast(float, w << 16); }
__device__ __forceinline__ float bfhi(unsigned w) { return __builtin_bit_cast(float, w & 0xffff0000u); }
__device__ __forceinline__ float sigmoid_f(float x) { return __builtin_amdgcn_rcpf(1.f + __expf(-x)); }
__device__ __forceinline__ float sigmoid_c(float x) { x = fminf(fmaxf(x, -30.f), 30.f); return __builtin_amdgcn_rcpf(1.f + __expf(-x)); }
__device__ __forceinline__ float gelu_tanh(float x) { const float u = 0.7978845608028654f * (x + 0.044715f * x * x * x); return x * sigmoid_f(2.f * u); }

__device__ __forceinline__ unsigned pk4_fp8(float a, float b, float cc, float d) { int w = 0; w = __builtin_amdgcn_cvt_pk_fp8_f32(a, b, w, false); w = __builtin_amdgcn_cvt_pk_fp8_f32(cc, d, w, true); return (unsigned)w; }
__device__ __forceinline__ void unpk4_fp8(unsigned w, float& a, float& b, float& cc, float& d) { const f32x2 lo = __builtin_amdgcn_cvt_pk_f32_fp8((int)w, false), hi = __builtin_amdgcn_cvt_pk_f32_fp8((int)w, true); a = lo.x; b = lo.y; cc = hi.x; d = hi.y; }
constexpr float W8_SCALE = 64.f;
#ifndef WT_STORES
#define WT_STORES 0
#endif
__device__ __forceinline__ void store16(void* p, const u32x4 v) {
#if WT_STORES
    asm volatile("global_store_dwordx4 %0, %1, off sc1\n\ts_nop 1" :: "v"(p), "v"(v) : "memory");
#else
    *(u32x4*)p = v;
#endif
}
#ifndef NT_STREAMS
#define NT_STREAMS 1
#endif
#if NT_STREAMS
#define NT_LOAD(p) __builtin_nontemporal_load(p)
#define NT_STORE(v, p) __builtin_nontemporal_store((v), (p))
#else
#define NT_LOAD(p) (*(p))
#define NT_STORE(v, p) (*(p) = (v))
#endif
__device__ __forceinline__ int opaque_tid() { int t = threadIdx.x; asm volatile("" : "+v"(t)); return t; }

struct Params {
    const float* in[30];
    float* out;
    unsigned char* ws;
};
enum { I_X = 0, I_G1, I_WIN, I_LRE, I_LIM, I_LOGDT, I_BRE, I_BIM, I_CRE, I_CIM, I_DSK, I_WGLU, I_BGLU, I_QG, I_KG, I_LQ1, I_LK1, I_LQ2, I_LK2, I_SG, I_WPS, I_WPA, I_WOUT, I_G2, I_WR, I_BR, I_W1, I_B1, I_W2, I_B2 };

constexpr int NWAVES = 8, NTHREADS = 512;
constexpr int LDS_BYTES = 147456;
constexpr int RING_BYTES = 131072;
constexpr int MISC_OFF = RING_BYTES + 320;
__device__ __forceinline__ void p0_transpose_item(const float* __restrict__ W, int N, bf16_t* __restrict__ WT, int ldo, int k_off, LAS float* scr, int kb, int nb, int lane) {
    const int k0 = 64 * kb, n0 = 32 * nb;
    { f32x4 v[8];
#pragma unroll
        for (int i = 0; i < 8; ++i) v[i] = NT_LOAD((const f32x4*)(W + (size_t)(k0 + 8 * i + (lane >> 3)) * N + n0 + (lane & 7) * 4));
#pragma unroll
        for (int i = 0; i < 8; ++i) { LAS float* d = scr + (8 * i + (lane >> 3)) * 33 + (lane & 7) * 4; d[0] = v[i].x; d[1] = v[i].y; d[2] = v[i].z; d[3] = v[i].w; } }
    asm volatile("s_waitcnt lgkmcnt(0)" ::: "memory");
    const int c = lane & 7;
#pragma unroll
    for (int j = 0; j < 4; ++j) { const int n = (lane >> 3) + 8 * j; const LAS float* s = scr + (8 * c) * 33 + n;
        u32x4 o; o.x = pk2(s[0 * 33], s[1 * 33]); o.y = pk2(s[2 * 33], s[3 * 33]); o.z = pk2(s[4 * 33], s[5 * 33]); o.w = pk2(s[6 * 33], s[7 * 33]);
        *(u32x4*)(WT + (size_t)(n0 + n) * ldo + k_off + k0 + 8 * c) = o; }
    asm volatile("s_waitcnt lgkmcnt(0)" ::: "memory");
}
__device__ __forceinline__ void p0_transpose_item_fp8(const float* __restrict__ W, int N, unsigned char* __restrict__ WT, int ldo, LAS float* scr, int kb, int nb, int lane) {
    const int k0 = 64 * kb, n0 = 32 * nb;
    { f32x4 v[8];
#pragma unroll
        for (int i = 0; i < 8; ++i) v[i] = NT_LOAD((const f32x4*)(W + (size_t)(k0 + 8 * i + (lane >> 3)) * N + n0 + (lane & 7) * 4));
#pragma unroll
        for (int i = 0; i < 8; ++i) { LAS float* d = scr + (8 * i + (lane >> 3)) * 33 + (lane & 7) * 4; d[0] = v[i].x; d[1] = v[i].y; d[2] = v[i].z; d[3] = v[i].w; } }
    asm volatile("s_waitcnt lgkmcnt(0)" ::: "memory");
    const int n = lane >> 1, half = lane & 1; const LAS float* s = scr + (32 * half) * 33 + n;
    unsigned o[8];
#pragma unroll
    for (int q = 0; q < 8; ++q) o[q] = pk4_fp8(s[(4 * q) * 33] * W8_SCALE, s[(4 * q + 1) * 33] * W8_SCALE, s[(4 * q + 2) * 33] * W8_SCALE, s[(4 * q + 3) * 33] * W8_SCALE);
    u32x4* dst = (u32x4*)(WT + (size_t)(n0 + n) * ldo + k0 + 32 * half);
    dst[0] = (u32x4){o[0], o[1], o[2], o[3]}; dst[1] = (u32x4){o[4], o[5], o[6], o[7]};
    asm volatile("s_waitcnt lgkmcnt(0)" ::: "memory");
}
__device__ __forceinline__ void p0_transpose_f32_item(const float* __restrict__ W, float* __restrict__ WT, int K, LAS float* scr, int kb, int lane) {
    const int k0 = 64 * kb;
#pragma unroll 8
    for (int i = 0; i < 32; ++i) { const int kk = 2 * i + (lane >> 5); scr[kk * 33 + (lane & 31)] = W[(size_t)(k0 + kk) * 32 + (lane & 31)]; }
    asm volatile("s_waitcnt lgkmcnt(0)" ::: "memory");
#pragma unroll 8
    for (int n = 0; n < 32; ++n) WT[(size_t)n * K + k0 + lane] = scr[lane * 33 + n];
    asm volatile("s_waitcnt lgkmcnt(0)" ::: "memory");
}
__device__ __forceinline__ void rms_row_to_bf16(const float* __restrict__ xrow, const float* __restrict__ g, bf16_t* __restrict__ orow, int lane) {
    const f32x4* xr = (const f32x4*)xrow + lane; const f32x4* gr = (const f32x4*)g + lane;
    f32x4 v[4]; float s = 0.f;
#pragma unroll
    for (int j = 0; j < 4; ++j) { v[j] = NT_LOAD(xr + 64 * j); s += (v[j].x * v[j].x + v[j].y * v[j].y) + (v[j].z * v[j].z + v[j].w * v[j].w); }
    const float r = rsqrtf(wave_sum(s) * (1.f / D) + EPS);
    u32x2* o8 = (u32x2*)orow + lane;
#pragma unroll
    for (int j = 0; j < 4; ++j) { const f32x4 gg = gr[64 * j]; u32x2 w; w.x = pk2(v[j].x * r * gg.x, v[j].y * r * gg.y); w.y = pk2(v[j].z * r * gg.z, v[j].w * r * gg.w); o8[64 * j] = w; }
}
struct SsmGP { float lrdt, lidt, cr, ci; };
__device__ __forceinline__ SsmGP ssm_gp(const Params& P, int g, int p) {
    const float dt = expf(P.in[I_LOGDT][g]);
    const float lr = fminf(P.in[I_LRE][g * SSM_P + p], -1e-4f), li = P.in[I_LIM][g * SSM_P + p];
    const float mag = expf(lr * dt);
    float sn, cs; sincosf(li * dt, &sn, &cs);
    const float ar = mag * cs, ai = mag * sn;
    const float den = lr * lr + li * li, nr = ar - 1.f;
    SsmGP r; r.lrdt = lr * dt; r.lidt = li * dt; r.cr = (nr * lr + ai * li) / den; r.ci = (ai * lr - nr * li) / den;
    return r;
}
__device__ __forceinline__ void ssm_pow(const SsmGP& q, int j, float& pr, float& pi) {
    const float m = expf((float)j * q.lrdt); float sn, cs; sincosf((float)j * q.lidt, &sn, &cs); pr = m * cs; pi = m * sn;
}

#ifndef EXP_DMA_AUX
#define EXP_DMA_AUX 2
#endif
struct ExpItem { const float* W; unsigned char* WT; int N, ldo, kb, nb, sw; };
__device__ __forceinline__ ExpItem exp_item(const Params& P, int it) {
    constexpr int I_E1 = (1024 / 128) * (2048 / 32), I_E2 = (1024 / 128) * (1024 / 32);
    ExpItem x;
    if (it < NE * I_E1) { const int e = it / I_E1, q = it % I_E1; x.W = P.in[I_W1] + (size_t)e * D * 2 * DFF; x.WT = P.ws + WS_W1_T + (size_t)e * 2 * DFF * D; x.N = 2 * DFF; x.ldo = D; x.kb = q / 64; x.nb = q % 64; x.sw = 3; }
    else { const int r = it - NE * I_E1, e = r / I_E2, q = r % I_E2; x.W = P.in[I_W2] + (size_t)e * DFF * D; x.WT = P.ws + WS_W2_T + (size_t)e * D * DFF; x.N = D; x.ldo = DFF; x.kb = q / 32; x.nb = q % 32; x.sw = 0; }
    return x;
}
__device__ __forceinline__ void exp_dma(const ExpItem& x, int lane, LAS unsigned char* buf) {
    const float* src = x.W + (size_t)(128 * x.kb + (lane >> 3)) * x.N + 32 * x.nb;
#pragma unroll
    for (int i = 0; i < 16; ++i) __builtin_amdgcn_global_load_lds((const unsigned*)(src + (size_t)(8 * i) * x.N + ((((lane & 7) ^ (lane >> 3) ^ (i >> 1)) & 7) << 2)), (LAS unsigned*)(buf + i * 1024), 16, 0, EXP_DMA_AUX);
}
#if defined(PROBE_CONV_NOSTORE)
#define g_conv_nostore nostore_
__device__ __forceinline__ void exp_finish_lds(const ExpItem& x, int lane, const LAS unsigned char* buf, bool nostore_ = false) {
#else
__device__ __forceinline__ void exp_finish_lds(const ExpItem& x, int lane, const LAS unsigned char* buf) {
#endif
    const int c = lane & 7;
#pragma unroll
    for (int pass = 0; pass < 4; ++pass) {
        const int n = 8 * pass + (lane >> 3), q0 = (n >> 2) ^ c;
        const int no = n ^ ((((n >> 1) ^ n) & 1) ? x.sw : 0);
        const LAS unsigned char* rb = buf + c * 2048 + ((n & 3) << 2);
        float f[16];
#pragma unroll
        for (int j = 0; j < 16; ++j) f[j] = *(const LAS float*)(rb + j * 128 + (((q0 ^ j) & 7) << 4)) * W8_SCALE;
        const u32x4 o = (u32x4){pk4_fp8(f[0], f[1], f[2], f[3]), pk4_fp8(f[4], f[5], f[6], f[7]), pk4_fp8(f[8], f[9], f[10], f[11]), pk4_fp8(f[12], f[13], f[14], f[15])};
#if defined(PROBE_CONV_NOSTORE)
        if (g_conv_nostore) { asm volatile("" :: "v"(o)); } else
#endif
#if NT_STREAMS && !defined(CONV_ST_DEFAULT)
        __builtin_nontemporal_store(o, (u32x4*)(x.WT + (size_t)(32 * x.nb + no) * x.ldo + 128 * x.kb + 16 * c));
#else
        *(u32x4*)(x.WT + (size_t)(32 * x.nb + no) * x.ldo + 128 * x.kb + 16 * c) = o;
#endif
    }
    asm volatile("s_waitcnt lgkmcnt(0)" ::: "memory");
}
constexpr int EXP_ITEMS = NE * ((1024 / 128) * (2048 / 32) + (1024 / 128) * (1024 / 32));
constexpr int EXP_N_IN = 32, EXP_N_S2 = 20, EXP_N_GLU = 20, EXP_N_M1 = 0;
constexpr int EXP_IN0 = 0, EXP_S20 = 128 * EXP_N_IN, EXP_GLU0 = EXP_S20 + 128 * EXP_N_S2, EXP_ATT0 = EXP_GLU0 + 128 * EXP_N_GLU, EXP_M10 = EXP_ITEMS - 128 * EXP_N_M1;
static_assert((EXP_M10 - EXP_ATT0) % 256 == 0 && EXP_M10 >= NE * (1024 / 128) * (2048 / 32), "item split (the expert-GEMM-1 tail share must be W2 items only)");
__device__ __forceinline__ void expert_convert_slice(const Params& P, LAS unsigned char* lds, int i0, int i1, bool probe_nostore = false) {
    const int tid = opaque_tid(), lane = tid & 63, wave = __builtin_amdgcn_readfirstlane(tid >> 6);
    LAS unsigned char* b0 = lds + wave * 16384;
    for (int it = i0 + wave; it < i1; it += NWAVES) {
        const ExpItem c0 = exp_item(P, it);
        exp_dma(c0, lane, b0);
        asm volatile("s_waitcnt vmcnt(0)" ::: "memory");
#if defined(PROBE_CONV_NOSTORE)
        exp_finish_lds(c0, lane, b0, probe_nostore);
#else
        exp_finish_lds(c0, lane, b0);
#endif
    }
}
__device__ __forceinline__ void p0_prologue(const Params& P, LAS unsigned char* lds, int vcu, int G) {
    const int tid = opaque_tid(), lane = tid & 63, wave = __builtin_amdgcn_readfirstlane(tid >> 6);
    LAS float* scr = (LAS float*)(lds + wave * 16384);
    unsigned char* ws = P.ws;
    const int gw = vcu * NWAVES + wave, NGW = G * NWAVES;
    constexpr int I_IN = (D / 64) * (IN_W / 32);
    constexpr int I_GLU = (512 / 64) * (512 / 32);
    constexpr int I_PS = (512 / 64) * (1024 / 32);
    constexpr int I_PA = (1024 / 64) * (1024 / 32);
    constexpr int I_OUT = I_PA;
    constexpr int I_R = 1024 / 64;
    constexpr int I_E1 = (1024 / 64) * (2048 / 32);
    constexpr int I_E2 = (1024 / 64) * (1024 / 32);
#ifndef EXPERTS_IN_ATTN
#define EXPERTS_IN_ATTN 1
#endif
    constexpr int NITEMS = I_IN + I_GLU + I_PS + I_PA + I_OUT + I_R + (EXPERTS_IN_ATTN ? 0 : NE * I_E1 + NE * I_E2);
    for (int it = gw; it < NITEMS; it += NGW) {
        int r = it;
        if (r < I_IN) { const int nblk = IN_W / 32; p0_transpose_item(P.in[I_WIN], IN_W, (bf16_t*)(ws + WS_WIN_T), D, 0, scr, r / nblk, r % nblk, lane); continue; } r -= I_IN;
        if (r < I_GLU) { const int nblk = 512 / 32; p0_transpose_item(P.in[I_WGLU], 512, (bf16_t*)(ws + WS_WGLU_T), 512, 0, scr, r / nblk, r % nblk, lane); continue; } r -= I_GLU;
        if (r < I_PS) { const int nblk = 1024 / 32; p0_transpose_item(P.in[I_WPS], 1024, (bf16_t*)(ws + WS_WP_T), MA_LD, 1024, scr, r / nblk, r % nblk, lane); continue; } r -= I_PS;
        if (r < I_PA) { const int nblk = 1024 / 32; p0_transpose_item(P.in[I_WPA], 1024, (bf16_t*)(ws + WS_WP_T), MA_LD, 0, scr, r / nblk, r % nblk, lane); continue; } r -= I_PA;
        if (r < I_OUT) { const int nblk = 1024 / 32; p0_transpose_item(P.in[I_WOUT], 1024, (bf16_t*)(ws + WS_WOUT_T), D, 0, scr, r / nblk, r % nblk, lane); continue; } r -= I_OUT;
        if (r < I_R) { p0_transpose_f32_item(P.in[I_WR], (float*)(ws + WS_WR_T), D, scr, r, lane); continue; } r -= I_R;
        if (EXPERTS_IN_ATTN) continue;
        if (r < NE * I_E1) { const int e = r / I_E1, q = r % I_E1, nblk = 2048 / 32;
            p0_transpose_item_fp8(P.in[I_W1] + (size_t)e * D * 2 * DFF, 2 * DFF, ws + WS_W1_T + (size_t)e * 2 * DFF * D, D, scr, q / nblk, q % nblk, lane); continue; } r -= NE * I_E1;
        { const int e = r / I_E2, q = r % I_E2, nblk = 1024 / 32;
            p0_transpose_item_fp8(P.in[I_W2] + (size_t)e * DFF * D, D, ws + WS_W2_T + (size_t)e * D * DFF, DFF, scr, q / nblk, q % nblk, lane); }
    }
#if EXPERTS_IN_ATTN
    if (G != 256) { __syncthreads(); for (int c0 = vcu * 64; c0 < EXP_ATT0; c0 += G * 64) expert_convert_slice(P, lds, c0, min(EXP_ATT0, c0 + 64));
        for (int c0 = EXP_M10 + vcu * 64; c0 < EXP_ITEMS; c0 += G * 64) expert_convert_slice(P, lds, c0, min(EXP_ITEMS, c0 + 64)); __syncthreads(); }
#endif
    for (int m = gw; m < T; m += NGW) rms_row_to_bf16(P.in[I_X] + (size_t)m * D, P.in[I_G1], (bf16_t*)(ws + WS_XN) + (size_t)m * D, lane);
    if (gw == 0) { u32x4* z = (u32x4*)(ws + WS_H2 + (size_t)T * D); z[lane] = (u32x4){0u, 0u, 0u, 0u}; }
    const int gt = vcu * NTHREADS + tid, NGT = G * NTHREADS;
#ifndef TABLES_REP
#define TABLES_REP 1
#endif
    _Pragma("clang loop unroll(disable)") for (int trep = 0; trep < TABLES_REP; ++trep) {
#ifndef REP_II
#define REP_II 1
#define REP_III 1
#define REP_IV 1
#endif
    _Pragma("clang loop unroll(disable)") for (int r2 = 0; r2 < REP_II; ++r2)
    for (int it = vcu + G * wave; it < SSM_G * CH_L; it += NGW) {
        const int g = it / CH_L, j = it % CH_L, i16 = lane & 15, q = lane >> 4;
        { const SsmGP gp = ssm_gp(P, g, lane); float pr, pi; ssm_pow(gp, j, pr, pi); scr[2 * lane] = pr * gp.cr - pi * gp.ci; scr[2 * lane + 1] = pr * gp.ci + pi * gp.cr; }
        float cre[16], cim[16], brv[16], biv[16];
#pragma unroll
        for (int s4 = 0; s4 < 4; ++s4) { const f32x4 vr = *(const f32x4*)(P.in[I_CRE] + (g * SSM_H + i16) * SSM_P + 16 * s4 + 4 * q), vi = *(const f32x4*)(P.in[I_CIM] + (g * SSM_H + i16) * SSM_P + 16 * s4 + 4 * q);
#pragma unroll
            for (int c = 0; c < 4; ++c) { const int pp = 16 * s4 + 4 * q + c; cre[4 * s4 + c] = vr[c]; cim[4 * s4 + c] = vi[c];
                brv[4 * s4 + c] = P.in[I_BRE][(g * SSM_P + pp) * SSM_H + i16]; biv[4 * s4 + c] = P.in[I_BIM][(g * SSM_P + pp) * SSM_H + i16]; } }
        asm volatile("s_waitcnt lgkmcnt(0)" ::: "memory");
        f32x4 kacc = {0.f, 0.f, 0.f, 0.f};
#pragma unroll
        for (int s = 0; s < 16; ++s) { const int pp = 16 * (s >> 2) + 4 * q + (s & 3); const float wr = scr[2 * pp], wi = scr[2 * pp + 1];
            const float mr = cre[s] * wr - cim[s] * wi, mi = cre[s] * wi + cim[s] * wr;
            kacc = __builtin_amdgcn_mfma_f32_16x16x4f32(mr, brv[s], kacc, 0, 0, 0);
            kacc = __builtin_amdgcn_mfma_f32_16x16x4f32(-mi, biv[s], kacc, 0, 0, 0); }
#pragma unroll
        for (int r = 0; r < 4; ++r) { const int h = 4 * q + r; float v = kacc[r];
            if (j == 0 && h == i16) v += P.in[I_DSK][g * SSM_H + h];
            ((float*)(ws + WS_KJ))[((size_t)(g * CH_L + j) * SSM_H + h) * SSM_H + i16] = v; }
        asm volatile("s_waitcnt lgkmcnt(0)" ::: "memory");
    }
    _Pragma("clang loop unroll(disable)") for (int r3 = 0; r3 < REP_III; ++r3)
    for (int it = gt; it < SSM_G * 128 * CH_L; it += NGT) {
        const int s = it % CH_L, n = (it / CH_L) % 128, g = it / (CH_L * 128), p = n & 63, part = n >> 6;
        const SsmGP q = ssm_gp(P, g, p); float pr, pi; ssm_pow(q, CH_L - 1 - s, pr, pi);
        const float wr = pr * q.cr - pi * q.ci, wi = pr * q.ci + pi * q.cr;
        float br[16], bi[16];
#pragma unroll
        for (int q4 = 0; q4 < 4; ++q4) { const f32x4 vb = *(const f32x4*)(P.in[I_BRE] + (g * SSM_P + p) * SSM_H + 4 * q4), vi = *(const f32x4*)(P.in[I_BIM] + (g * SSM_P + p) * SSM_H + 4 * q4);
#pragma unroll
            for (int c = 0; c < 4; ++c) { br[4 * q4 + c] = vb[c]; bi[4 * q4 + c] = vi[c]; } }
        unsigned o[8];
#pragma unroll
        for (int h2 = 0; h2 < 8; ++h2) {
            float v0, v1;
            if (part == 0) { v0 = wr * br[2 * h2] - wi * bi[2 * h2]; v1 = wr * br[2 * h2 + 1] - wi * bi[2 * h2 + 1]; }
            else { v0 = wr * bi[2 * h2] + wi * br[2 * h2]; v1 = wr * bi[2 * h2 + 1] + wi * br[2 * h2 + 1]; }
            o[h2] = pk2(v0, v1);
        }
        u32x4* dst = (u32x4*)((bf16_t*)(ws + WS_WS_T) + ((size_t)(g * 128 + n) * 512 + s * 16));
        dst[0] = (u32x4){o[0], o[1], o[2], o[3]}; dst[1] = (u32x4){o[4], o[5], o[6], o[7]};
    }
    _Pragma("clang loop unroll(disable)") for (int r4 = 0; r4 < REP_IV; ++r4)
    for (int it = gt; it < SSM_G * CH_L * SSM_P; it += NGT) {
        const int p = it % SSM_P, t = (it / SSM_P) % CH_L, g = it / (SSM_P * CH_L);
        const SsmGP q = ssm_gp(P, g, p); float pr, pi; ssm_pow(q, t + 1, pr, pi);
        bf16_t* base = (bf16_t*)(ws + WS_BT_SSM) + ((size_t)(g * 512 + t * 16)) * ACAT_LD + 512 + p;
#pragma unroll
        for (int h = 0; h < SSM_H; ++h) {
            const float cre = P.in[I_CRE][(g * SSM_H + h) * SSM_P + p], cim = P.in[I_CIM][(g * SSM_H + h) * SSM_P + p];
            base[(size_t)h * ACAT_LD] = (bf16_t)f2bf(cre * pr - cim * pi);
            base[(size_t)h * ACAT_LD + 64] = (bf16_t)f2bf(-(cre * pi + cim * pr));
        }
    }
    }
}
__device__ __forceinline__ void ssm_toeplitz_expand(const Params& P, int vcu, int G) {
    const int gt = vcu * NTHREADS + opaque_tid(), NGT = G * NTHREADS;
    unsigned char* ws = P.ws;
    for (int it = gt; it < SSM_G * 512 * 64; it += NGT) {
        const int kc = it & 63, n = (it >> 6) & 511, g = it >> 15;
        const int s = kc >> 1, hq = (kc & 1) * 8, t = n >> 4, h = n & 15;
        u32x4 o = (u32x4){0u, 0u, 0u, 0u};
        if (s <= t) { const float* kj = (const float*)(ws + WS_KJ) + ((size_t)(g * CH_L + (t - s)) * SSM_H + h) * SSM_H + hq;
            const f32x4 a = *(const f32x4*)kj, b = *(const f32x4*)(kj + 4);
            o.x = pk2(a.x, a.y); o.y = pk2(a.z, a.w); o.z = pk2(b.x, b.y); o.w = pk2(b.z, b.w); }
        *(u32x4*)((bf16_t*)(ws + WS_BT_SSM) + ((size_t)(g * 512 + n)) * ACAT_LD + kc * 8) = o;
    }
}
#ifndef PG_WGM
#define PG_WGM 8
#endif
namespace pg {
constexpr int BM = 256, BK = 64, HALF = 128, HTB = HALF * BK * 2, STAGE_BYTES = 8 * HTB;
__host__ __device__ __forceinline__ int lds_byte(int r, int c) { const int st = (r >> 4) * 2 + (c >> 5), rr = r & 15, cc = c & 31, ob = rr * 64 + cc * 2; return st * 1024 + (ob ^ (((ob >> 9) & 1) << 5)); }
__host__ __device__ __forceinline__ void stage_rc(int b, int& R, int& C) { const int st = b / 1024, sb = b % 1024, swz = sb ^ (((sb >> 9) & 1) << 5); R = (st >> 1) * 16 + swz / 64; C = (st & 1) * 32 + (swz % 64) / 2; }
__host__ __device__ __forceinline__ int perm32(int rho) { const int n = rho >> 4, i = rho & 15; return 8 * (i >> 2) + 4 * n + (i & 3); }

struct Unit {
    const char* A;
    const char* B;
    unsigned aoff[2][2];
    int pm, pn, aux, aux2;
    int ord;
};
struct EpiInfo { int pm, pn, aux, aux2, ord; };
typedef f32x4 Acc[2][2][4][2];

typedef int v8i_t __attribute__((ext_vector_type(8)));
typedef int v4i_t __attribute__((ext_vector_type(4)));
template <bool FP8 = false, int BAUX = 0  , class Sched, class Epi>
__device__ __forceinline__ void gemm_phase(LAS unsigned char* lds, const Sched& S, const Epi& E, const int nt, const int ldb, const int ktm = -1  ) {
    const int tid = opaque_tid(), wid = __builtin_amdgcn_readfirstlane(tid >> 6), lane = tid & 63, wr = wid >> 2, wc = wid & 3, fr = lane & 15, fq = lane >> 4;
    unsigned voffB[2];
#pragma unroll
    for (int i = 0; i < 2; ++i) { int R, C; stage_rc(tid * 16 + i * 8192, R, C); voffB[i] = (unsigned)((64 * (R >> 5) + perm32(R & 31)) * ldb + C) * 2u; }
    const unsigned hB = (unsigned)(32 * ldb * 2);
    const unsigned ldsw = (unsigned)wid * 1024u;
    const int aoffl = lds_byte(wr * 64 + fr, fq * 8), boffl = lds_byte(wc * 32 + fr, fq * 8);
#define PG_SA(b, h) (((b) * 2 + (h)) * pg::HTB)
#define PG_SB(b, h) ((4 + (b) * 2 + (h)) * pg::HTB)
#define PG_GLDS(gp, bufoff, i) __builtin_amdgcn_global_load_lds((const unsigned*)(gp), (LAS unsigned*)(lds + (bufoff) + ldsw + (i) * 8192), 16, 0, 0)
#define PG_STAGE_A(bufoff, Ab, o0, o1, kt) do { const char* _b = (Ab) + (size_t)((kt) & ktm) * 128; PG_GLDS(_b + (o0), bufoff, 0); PG_GLDS(_b + (o1), bufoff, 1); } while (0)
#define PG_GLDSB(gp, bufoff, i) __builtin_amdgcn_global_load_lds((const unsigned*)(gp), (LAS unsigned*)(lds + (bufoff) + ldsw + (i) * 8192), 16, 0, BAUX)
#define PG_STAGE_B(bufoff, Bb, h, kt) do { const char* _b = (Bb) + (size_t)((kt) & ktm) * 128 + (h) * hB; PG_GLDSB(_b + voffB[0], bufoff, 0); PG_GLDSB(_b + voffB[1], bufoff, 1); } while (0)
#define PG_LDA(dst, b, h) do { _Pragma("unroll") for (int m = 0; m < 4; ++m) _Pragma("unroll") for (int k = 0; k < 2; ++k) dst[m][k] = *(const LAS bf16x8*)(lds + PG_SA(b, h) + aoffl + m * 2048 + k * 1024); } while (0)
#define PG_LDB(dst, b, h) do { _Pragma("unroll") for (int n = 0; n < 2; ++n) _Pragma("unroll") for (int k = 0; k < 2; ++k) dst[n][k] = *(const LAS bf16x8*)(lds + PG_SB(b, h) + boffl + n * 2048 + k * 1024); } while (0)
#define PG_CAT8(lo, hi) __builtin_shufflevector(__builtin_bit_cast(v4i_t, lo), __builtin_bit_cast(v4i_t, hi), 0, 1, 2, 3, 4, 5, 6, 7)
#define PG_MMA(ai, bj, At, Bt) do { __builtin_amdgcn_s_setprio(1); if constexpr (FP8) { _Pragma("unroll") for (int m = 0; m < 4; ++m) _Pragma("unroll") for (int n = 0; n < 2; ++n) \
            acc[ai][bj][m][n] = __builtin_amdgcn_mfma_scale_f32_16x16x128_f8f6f4(PG_CAT8(Bt[n][0], Bt[n][1]), PG_CAT8(At[m][0], At[m][1]), acc[ai][bj][m][n], 0, 0, 0, 0x79797979, 0, 0x7f7f7f7f); } \
        else { _Pragma("unroll") for (int m = 0; m < 4; ++m) _Pragma("unroll") for (int n = 0; n < 2; ++n) _Pragma("unroll") for (int k = 0; k < 2; ++k) \
        acc[ai][bj][m][n] = __builtin_amdgcn_mfma_f32_16x16x32_bf16(Bt[n][k], At[m][k], acc[ai][bj][m][n], 0, 0, 0); } __builtin_amdgcn_s_setprio(0); } while (0)
#define PG_WAIT_V(n) asm volatile("s_waitcnt vmcnt(" #n ")" ::: "memory")
#define PG_WAIT_L(n) asm volatile("s_waitcnt lgkmcnt(" #n ")" ::: "memory")
#define PG_BAR __builtin_amdgcn_s_barrier()
#define PG_SCHED __builtin_amdgcn_sched_barrier(0)
#define PG_KLOOP(T0, T1) _Pragma("clang loop unroll(disable)") for (int t = (T0); t < (T1); t += 2) { \
            const bool last = (t == nt - 2); \
            PG_LDB(B0, 0, 0); PG_LDB(B1, 0, 1); PG_SCHED; PG_LDA(At, 0, 0); PG_STAGE_A(PG_SA(1, 1), st.A, st.aoff[1][0], st.aoff[1][1], t + 1); \
            if (last) { Unit nu_; has_next = S.next(ui + 1, nu_); if (has_next) { st = nu_; } } \
            const int k2 = last ? 0 : t + 2, k3 = k2 + 1; \
            PG_WAIT_V(8); PG_WAIT_L(0); PG_BAR; PG_MMA(0, 0, At, B0); PG_MMA(0, 1, At, B1); PG_BAR; PG_SCHED; \
            PG_LDA(At, 0, 1); PG_STAGE_B(PG_SB(0, 0), st.B, 0, k2); PG_STAGE_B(PG_SB(0, 1), st.B, 1, k2); PG_STAGE_A(PG_SA(0, 0), st.A, st.aoff[0][0], st.aoff[0][1], k2); \
            PG_WAIT_V(8); PG_WAIT_L(0); PG_BAR; PG_MMA(1, 0, At, B0); PG_MMA(1, 1, At, B1); PG_BAR; PG_SCHED; \
            PG_LDB(B0, 1, 0); PG_LDB(B1, 1, 1); PG_SCHED; PG_LDA(At, 1, 0); PG_STAGE_A(PG_SA(0, 1), st.A, st.aoff[1][0], st.aoff[1][1], k2); \
            PG_WAIT_V(8); PG_WAIT_L(0); PG_BAR; PG_MMA(0, 0, At, B0); PG_MMA(0, 1, At, B1); PG_BAR; PG_SCHED; \
            PG_LDA(At, 1, 1); PG_STAGE_B(PG_SB(1, 0), st.B, 0, k3); PG_STAGE_B(PG_SB(1, 1), st.B, 1, k3); PG_STAGE_A(PG_SA(1, 0), st.A, st.aoff[0][0], st.aoff[0][1], k3); \
            PG_WAIT_V(8); PG_WAIT_L(0); PG_BAR; PG_MMA(1, 0, At, B0); PG_MMA(1, 1, At, B1); PG_BAR; PG_SCHED; \
        }
    Unit st; int ui = 0;
    if (!S.next(0, st)) return;
    EpiInfo cur; cur.pm = st.pm; cur.pn = st.pn; cur.aux = st.aux; cur.aux2 = st.aux2; cur.ord = st.ord;
    Acc acc;
#pragma unroll
    for (int a = 0; a < 2; ++a)
#pragma unroll
        for (int b = 0; b < 2; ++b)
#pragma unroll
            for (int m = 0; m < 4; ++m)
#pragma unroll
                for (int n = 0; n < 2; ++n) acc[a][b][m][n] = (f32x4){0.f, 0.f, 0.f, 0.f};
    bf16x8 At[4][2], B0[2][2], B1[2][2];
    PG_STAGE_B(PG_SB(0, 0), st.B, 0, 0); PG_STAGE_B(PG_SB(0, 1), st.B, 1, 0); PG_STAGE_A(PG_SA(0, 0), st.A, st.aoff[0][0], st.aoff[0][1], 0); PG_STAGE_A(PG_SA(0, 1), st.A, st.aoff[1][0], st.aoff[1][1], 0);
    if (wr == 1) PG_BAR;
    PG_WAIT_V(2); PG_BAR;
    PG_STAGE_B(PG_SB(1, 0), st.B, 0, 1); PG_STAGE_A(PG_SA(1, 0), st.A, st.aoff[0][0], st.aoff[0][1], 1); PG_STAGE_B(PG_SB(1, 1), st.B, 1, 1);
    PG_WAIT_V(6); PG_BAR;
    for (;;) {
        bool has_next = false;
        if constexpr (Epi::HAS_MID) { PG_KLOOP(0, Epi::MID_T) E.mid(acc, cur, wr, wc, fr, fq); PG_KLOOP(Epi::MID_T, nt) } else { PG_KLOOP(0, nt) }
        if (wr == 0) PG_BAR;
        E(acc, cur, wr, wc, fr, fq);
        if (!has_next) break;
#pragma unroll
        for (int a = 0; a < 2; ++a)
#pragma unroll
            for (int b = 0; b < 2; ++b)
#pragma unroll
                for (int m = 0; m < 4; ++m)
#pragma unroll
                    for (int n = 0; n < 2; ++n) acc[a][b][m][n] = (f32x4){0.f, 0.f, 0.f, 0.f};
        cur.pm = st.pm; cur.pn = st.pn; cur.aux = st.aux; cur.aux2 = st.aux2; cur.ord = st.ord; ++ui;
        if (wr == 1) PG_BAR;
    }
    PG_WAIT_V(0);
    PG_BAR;
#undef PG_SA
#undef PG_SB
#undef PG_GLDS
#undef PG_GLDSB
#undef PG_STAGE_A
#undef PG_STAGE_B
#undef PG_LDA
#undef PG_LDB
#undef PG_MMA
#undef PG_WAIT_V
#undef PG_WAIT_L
#undef PG_BAR
#undef PG_SCHED
#undef PG_KLOOP
}

struct LaneRC { int R[2], C[2]; __device__ __forceinline__ LaneRC() { const int t = opaque_tid(); stage_rc(t * 16, R[0], C[0]); stage_rc(t * 16 + 8192, R[1], C[1]); } };

struct DenseSched {
    const bf16_t* A; const bf16_t* Bt; int lda, ldb, nM, nN, nwg, G, c;
    __device__ __forceinline__ void init(const bf16_t* A_, int lda_, const bf16_t* Bt_, int ldb_, int M, int N, int G_, int c_) { A = A_; Bt = Bt_; lda = lda_; ldb = ldb_; nM = M / BM; nN = N / BM; nwg = nM * nN; G = G_; c = c_; }
    __device__ __forceinline__ bool next(int i, Unit& u) const {
        const long L = (long)i * G + c; if (L >= nwg) return false;
        int wgid = (int)L; { const int q = nwg / 8, r = nwg % 8, xcd = wgid % 8, off = wgid / 8; wgid = (xcd < r ? xcd * (q + 1) : r * (q + 1) + (xcd - r) * q) + off; }
        const int WGM = PG_WGM, nig = WGM * nN, gid = wgid / nig, fm = gid * WGM, gsz = (nM - fm) < WGM ? (nM - fm) : WGM;
        u.pm = fm + ((wgid % nig) % gsz); u.pn = (wgid % nig) / gsz; u.aux = 0; u.aux2 = 0; u.ord = i;
        u.A = (const char*)A; u.B = (const char*)(Bt + (size_t)u.pn * BM * ldb); const LaneRC rc;
#pragma unroll
        for (int h = 0; h < 2; ++h)
#pragma unroll
            for (int j = 0; j < 2; ++j) u.aoff[h][j] = (unsigned)(((u.pm * BM + 128 * h + rc.R[j]) * lda + rc.C[j]) * 2);
        return true;
    }
};
}
namespace pg {
constexpr int TAB_OFF = RING_BYTES + 1024;
__device__ __forceinline__ void moe_build_tab(LAS unsigned char* lds, const unsigned* cnt) {
    LAS int* tab = (LAS int*)(lds + TAB_OFF);
    if (threadIdx.x == 0) { int acc = 0; for (int e = 0; e < NE; ++e) { const int n = (int)__hip_atomic_load(cnt + e, __ATOMIC_RELAXED, __HIP_MEMORY_SCOPE_AGENT); tab[e] = acc; tab[40 + e] = n; acc += (n + 255) >> 8; } tab[NE] = acc; }
    __syncthreads();
}
#ifndef MOE_MAXU_OVERRIDE
#define MOE_MAXU_OVERRIDE 9
#endif
constexpr int MOE_MAXU = MOE_MAXU_OVERRIDE;
constexpr int UT_OFF = RING_BYTES + 1536;
constexpr int UB_OFF = UT_OFF + MOE_MAXU * 512;
static_assert(UB_OFF + MOE_MAXU * 1024 <= LDS_BYTES, "LDS map");
template <int KIND>
struct MoeSched {
    static constexpr int NPN = KIND == 1 ? 8 : 4;
    unsigned char* ws; const LAS int* tab; LAS unsigned char* lds; int G, c; bool freeze = false;
    __device__ __forceinline__ bool unit(int i, int& e, int& rb, int& pn) const {
        const int x = c & 7, j = c >> 3, NJ = G >> 3;
        int L = i * NJ + j; e = -1; rb = 0; pn = 0;
#pragma unroll
        for (int q = 0; q < NE / 8; ++q) { const int eq = x + 8 * q, uq = (tab[eq + 1] - tab[eq]) * NPN;
            if (e < 0) { if (L < uq) { e = eq; rb = L / NPN; pn = L % NPN; } else L -= uq; } }
        if (e < 0) return false;
        e = __builtin_amdgcn_readfirstlane(e); rb = __builtin_amdgcn_readfirstlane(rb); pn = __builtin_amdgcn_readfirstlane(pn);
        return true;
    }
    __device__ __forceinline__ void init(unsigned char* ws_, LAS unsigned char* lds_, int G_, int c_, const float* bias) {
        ws = ws_; lds = lds_; tab = (const LAS int*)(lds_ + TAB_OFF); G = G_; c = c_;
        const int tid = opaque_tid();
        for (int i = 0; i < MOE_MAXU; ++i) { int e, rb, pn; if (!unit(i, e, rb, pn)) break;
            if (tid < 256) { if (KIND == 1) { const int nvalid = min(256, tab[40 + e] - rb * 256); const int tok = tid < nvalid ? ((const int*)(ws + WS_SLOT_TOK))[(size_t)e * CAP + rb * 256 + tid] : T;
                    ((LAS unsigned short*)(lds + UT_OFF))[i * 256 + tid] = (unsigned short)tok; } }
            else ((LAS float*)(lds + UB_OFF))[i * 256 + tid - 256] = bias[(size_t)e * (NPN * 256) + pn * 256 + tid - 256]; }
        __syncthreads();
    }
    __device__ __forceinline__ bool next(int i, Unit& u) const {
        int e, rb, pn; if (!unit(i, e, rb, pn)) return false;
#if defined(PROBE_FREEZE)
        if (freeze) { int e0, r0, p0; unit(0, e0, r0, p0); e = e0; rb = r0; pn = p0; }
#endif
        const int blk = tab[e] + rb, nvalid = min(256, tab[40 + e] - rb * 256);
        u.pm = rb; u.pn = pn; u.aux = e; u.ord = i; const LaneRC rc;
        if (KIND == 1) {
            u.aux2 = blk; u.A = (const char*)(ws + WS_H2); u.B = (const char*)(ws + WS_W1_T + ((size_t)e * 2 * DFF + (size_t)pn * BM) * D);
#pragma unroll
            for (int h = 0; h < 2; ++h)
#pragma unroll
                for (int jj = 0; jj < 2; ++jj) { const int r = 128 * h + rc.R[jj]; int tok;
                    if (i < MOE_MAXU) tok = ((const LAS unsigned short*)(lds + UT_OFF))[i * 256 + r];
                    else { tok = r < nvalid ? ((const int*)(ws + WS_SLOT_TOK))[(size_t)e * CAP + rb * 256 + r] : T; __builtin_amdgcn_s_waitcnt(0x0F70); }
                    u.aoff[h][jj] = (unsigned)(tok * D + rc.C[jj] * 2); }
        } else {
            u.aux2 = blk | (nvalid << 16); u.A = (const char*)(ws + WS_ACT); u.B = (const char*)(ws + WS_W2_T + ((size_t)e * D + (size_t)pn * BM) * DFF);
#pragma unroll
            for (int h = 0; h < 2; ++h)
#pragma unroll
                for (int jj = 0; jj < 2; ++jj) u.aoff[h][jj] = (unsigned)((blk * 256 + 128 * h + rc.R[jj]) * DFF + rc.C[jj] * 2);
        }
        return true;
    }
};
}
namespace pg {
struct EpiBase { static constexpr bool HAS_MID = false; static constexpr int MID_T = -1; __device__ __forceinline__ void mid(Acc&, const EpiInfo&, int, int, int, int) const {} };
__device__ __forceinline__ u32x4 pack8(const f32x4 a, const f32x4 b) { u32x4 w; w.x = pk2(a[0], a[1]); w.y = pk2(a[2], a[3]); w.z = pk2(b[0], b[1]); w.w = pk2(b[2], b[3]); return w; }
__device__ __forceinline__ void unpack8(const u32x4 w, f32x4& a, f32x4& b) { a = (f32x4){bflo(w.x), bfhi(w.x), bflo(w.y), bfhi(w.y)}; b = (f32x4){bflo(w.z), bfhi(w.z), bflo(w.w), bfhi(w.w)}; }

struct EpiNull : EpiBase {
    __device__ __forceinline__ void operator()(Acc& acc, const EpiInfo&, int, int, int, int) const {
#pragma unroll
        for (int a = 0; a < 2; ++a)
#pragma unroll
            for (int b = 0; b < 2; ++b)
#pragma unroll
                for (int m = 0; m < 4; ++m)
#pragma unroll
                    for (int n = 0; n < 2; ++n) asm volatile("" :: "v"(acc[a][b][m][n]));
    }
};
struct EpiInProj : EpiBase {
    unsigned char* ws; const float* qg; const float* kg;
    __device__ __forceinline__ void operator()(Acc& acc, const EpiInfo& u, int wr, int wc, int fr, int fq) const {
        const int pn = u.pn, row0 = u.pm * BM + wr * 64 + fr, colw = 64 * wc + 8 * fq;
        if (pn < 2) {
            bf16_t* acat = (bf16_t*)(ws + WS_ACAT);
#pragma unroll
            for (int ai = 0; ai < 2; ++ai)
#pragma unroll
                for (int m = 0; m < 4; ++m) { const int tok = row0 + ai * 128 + m * 16;
#pragma unroll
                    for (int bj = 0; bj < 2; ++bj) { const int cu = pn * 256 + colw + 32 * bj, g = cu >> 4, h0 = cu & 15;
                        *(u32x4*)(acat + ((size_t)(g * ACAT_ROWS + (tok >> 5))) * ACAT_LD + (tok & 31) * 16 + h0) = pack8(acc[ai][bj][m][0], acc[ai][bj][m][1]); } }
        } else if (pn < 10) {
            const bool isq = pn < 6; const float* gain = isq ? qg : kg; const float sc = isq ? QC2 : 1.f;
            bf16_t* dst = (bf16_t*)(ws + (isq ? WS_Q : WS_K)) + (size_t)(pn - (isq ? 2 : 6)) * 256 + colw;
            f32x4 gv[2][2];
#pragma unroll
            for (int bj = 0; bj < 2; ++bj)
#pragma unroll
                for (int n = 0; n < 2; ++n) gv[bj][n] = *(const f32x4*)(gain + 32 * bj + 8 * fq + 4 * n);
#pragma unroll
            for (int ai = 0; ai < 2; ++ai)
#pragma unroll
                for (int m = 0; m < 4; ++m) { const int tok = row0 + ai * 128 + m * 16; float ss = 0.f;
#pragma unroll
                    for (int bj = 0; bj < 2; ++bj)
#pragma unroll
                        for (int n = 0; n < 2; ++n) { const f32x4 v = acc[ai][bj][m][n]; ss += (v[0] * v[0] + v[1] * v[1]) + (v[2] * v[2] + v[3] * v[3]); }
                    ss += __shfl_xor(ss, 16); ss += __shfl_xor(ss, 32);
                    const float r = rsqrtf(ss * (1.f / 64.f) + EPS) * sc;
#pragma unroll
                    for (int bj = 0; bj < 2; ++bj) store16(dst + (size_t)tok * D + 32 * bj, pack8(acc[ai][bj][m][0] * r * gv[bj][0], acc[ai][bj][m][1] * r * gv[bj][1])); }
        } else {
            const size_t base = pn < 14 ? WS_V : (pn < 18 ? WS_GS : WS_GA); const int t0 = pn < 14 ? 10 : (pn < 18 ? 14 : 18); const bool ntst = pn >= 14;
            bf16_t* dst = (bf16_t*)(ws + base) + (size_t)(pn - t0) * 256 + colw;
#pragma unroll
            for (int ai = 0; ai < 2; ++ai)
#pragma unroll
                for (int m = 0; m < 4; ++m) { const int tok = row0 + ai * 128 + m * 16;
#pragma unroll
                    for (int bj = 0; bj < 2; ++bj) { const u32x4 w = pack8(acc[ai][bj][m][0], acc[ai][bj][m][1]); if (ntst) NT_STORE(w, (u32x4*)(dst + (size_t)tok * D + 32 * bj)); else store16(dst + (size_t)tok * D + 32 * bj, w); } }
        }
    }
};
struct EpiSsm2 : EpiBase {
    unsigned char* ws;
    __device__ __forceinline__ void operator()(Acc& acc, const EpiInfo& u, int wr, int wc, int fr, int fq) const {
        bf16_t* Z = (bf16_t*)(ws + WS_Z); const int g = u.aux;
#pragma unroll
        for (int ai = 0; ai < 2; ++ai)
#pragma unroll
            for (int m = 0; m < 4; ++m) { const int r = u.pm * BM + ai * 128 + wr * 64 + m * 16 + fr, b = r >> 6, c = r & 63;
#pragma unroll
                for (int bj = 0; bj < 2; ++bj) { const int n_ = u.pn * 256 + 64 * wc + 32 * bj + 8 * fq, t = n_ >> 4, h0 = n_ & 15; const int tok = b * SEQ + c * CH_L + t;
                    f32x4 a = acc[ai][bj][m][0], bb = acc[ai][bj][m][1];
#pragma unroll
                    for (int q = 0; q < 4; ++q) { a[q] = gelu_tanh(a[q]); bb[q] = gelu_tanh(bb[q]); }
                    *(u32x4*)(Z + (size_t)tok * SSM_W + 16 * g + h0) = pack8(a, bb); } }
    }
};
struct EpiGlu : EpiBase {
    unsigned char* ws; const float* bglu;
    __device__ __forceinline__ void operator()(Acc& acc, const EpiInfo& u, int wr, int wc, int fr, int fq) const {
        asm volatile("" : "+v"(fr), "+v"(fq));
        const bf16_t* Z = (const bf16_t*)(ws + WS_Z); bf16_t* MA = (bf16_t*)(ws + WS_MA);
        const int col0 = u.pn * 256 + 64 * wc + 8 * fq;
        f32x4 cb[2][2];
#pragma unroll
        for (int bj = 0; bj < 2; ++bj) { cb[bj][0] = *(const f32x4*)(bglu + col0 + 32 * bj); cb[bj][1] = *(const f32x4*)(bglu + col0 + 32 * bj + 4); }
#pragma unroll
        for (int ai = 0; ai < 2; ++ai) { u32x4 zz[4][2];
#pragma unroll
            for (int m = 0; m < 4; ++m) { const int tok = u.pm * BM + ai * 128 + wr * 64 + m * 16 + fr;
#pragma unroll
                for (int bj = 0; bj < 2; ++bj) zz[m][bj] = *(const u32x4*)(Z + (size_t)tok * SSM_W + col0 + 32 * bj); }
            asm volatile("" ::: "memory");
#pragma unroll
            for (int m = 0; m < 4; ++m) { const int tok = u.pm * BM + ai * 128 + wr * 64 + m * 16 + fr;
#pragma unroll
                for (int bj = 0; bj < 2; ++bj) { f32x4 z0, z1; unpack8(zz[m][bj], z0, z1);
                    f32x4 a = acc[ai][bj][m][0] + cb[bj][0], bb = acc[ai][bj][m][1] + cb[bj][1];
#pragma unroll
                    for (int q = 0; q < 4; ++q) { a[q] = z0[q] * sigmoid_f(a[q]); bb[q] = z1[q] * sigmoid_f(bb[q]); }
                    *(u32x4*)(MA + (size_t)tok * MA_LD + 1024 + col0 + 32 * bj) = pack8(a, bb); } }
            asm volatile("" ::: "memory"); }
    }
};
struct EpiMerged : EpiBase {
    static constexpr bool HAS_MID = true; static constexpr int MID_T = 16;
    unsigned char* ws;
    __device__ __forceinline__ float ratio(float a, float s) const { a = fminf(fmaxf(a, -30.f), 30.f); s = fminf(fmaxf(s, -30.f), 30.f); return (1.f + __expf(-s)) * __builtin_amdgcn_rcpf(1.f + __expf(-a)); }
    __device__ __forceinline__ void mid(Acc& acc, const EpiInfo& u, int wr, int wc, int fr, int fq) const {
        asm volatile("" : "+v"(fr), "+v"(fq));
        const bf16_t* GS = (const bf16_t*)(ws + WS_GS); const bf16_t* GA = (const bf16_t*)(ws + WS_GA);
        const int col0 = u.pn * 256 + 64 * wc + 8 * fq;
#pragma unroll
        for (int ai = 0; ai < 2; ++ai)
#pragma unroll
            for (int mp = 0; mp < 2; ++mp) { u32x4 gs_[2][2], ga_[2][2];
#pragma unroll
                for (int mm = 0; mm < 2; ++mm) { const int tok = u.pm * BM + ai * 128 + wr * 64 + (2 * mp + mm) * 16 + fr;
#pragma unroll
                    for (int bj = 0; bj < 2; ++bj) { gs_[mm][bj] = *(const u32x4*)(GS + (size_t)tok * D + col0 + 32 * bj); ga_[mm][bj] = *(const u32x4*)(GA + (size_t)tok * D + col0 + 32 * bj); } }
#pragma unroll
                for (int mm = 0; mm < 2; ++mm)
#pragma unroll
                    for (int bj = 0; bj < 2; ++bj) { const int m = 2 * mp + mm; const u32x4 ws_ = gs_[mm][bj], wa_ = ga_[mm][bj];
                        acc[ai][bj][m][0][0] *= ratio(bflo(wa_.x), bflo(ws_.x)); acc[ai][bj][m][0][1] *= ratio(bfhi(wa_.x), bfhi(ws_.x));
                        acc[ai][bj][m][0][2] *= ratio(bflo(wa_.y), bflo(ws_.y)); acc[ai][bj][m][0][3] *= ratio(bfhi(wa_.y), bfhi(ws_.y));
                        acc[ai][bj][m][1][0] *= ratio(bflo(wa_.z), bflo(ws_.z)); acc[ai][bj][m][1][1] *= ratio(bfhi(wa_.z), bfhi(ws_.z));
                        acc[ai][bj][m][1][2] *= ratio(bflo(wa_.w), bflo(ws_.w)); acc[ai][bj][m][1][3] *= ratio(bfhi(wa_.w), bfhi(ws_.w)); }
                asm volatile("" ::: "memory"); }
    }
    __device__ __forceinline__ void operator()(Acc& acc, const EpiInfo& u, int wr, int wc, int fr, int fq) const {
        asm volatile("" : "+v"(fr), "+v"(fq));
        const bf16_t* GS = (const bf16_t*)(ws + WS_GS); bf16_t* O = (bf16_t*)(ws + WS_MERGED);
        const int col0 = u.pn * 256 + 64 * wc + 8 * fq;
#pragma unroll
        for (int ai = 0; ai < 2; ++ai) { u32x4 gs_[4][2];
#pragma unroll
            for (int m = 0; m < 4; ++m) { const int tok = u.pm * BM + ai * 128 + wr * 64 + m * 16 + fr;
#pragma unroll
                for (int bj = 0; bj < 2; ++bj) gs_[m][bj] = *(const u32x4*)(GS + (size_t)tok * D + col0 + 32 * bj); }
#pragma unroll
            for (int m = 0; m < 4; ++m) { const int tok = u.pm * BM + ai * 128 + wr * 64 + m * 16 + fr;
#pragma unroll
                for (int bj = 0; bj < 2; ++bj) { f32x4 s0, s1; unpack8(gs_[m][bj], s0, s1);
                    f32x4 a = acc[ai][bj][m][0], bb = acc[ai][bj][m][1];
#pragma unroll
                    for (int q = 0; q < 4; ++q) { a[q] *= sigmoid_c(s0[q]); bb[q] *= sigmoid_c(s1[q]); }
                    *(u32x4*)(O + (size_t)tok * D + col0 + 32 * bj) = pack8(a, bb); } }
            asm volatile("" ::: "memory"); }
    }
};
struct EpiWout : EpiBase {
    const float* x; bf16_t* out;
    __device__ __forceinline__ void operator()(Acc& acc, const EpiInfo& u, int wr, int wc, int fr, int fq) const {
        asm volatile("" : "+v"(fr), "+v"(fq));
        const int col0 = u.pn * 256 + 64 * wc + 8 * fq;
#pragma unroll
        for (int ai = 0; ai < 2; ++ai)
#pragma unroll
            for (int mp = 0; mp < 2; ++mp) { f32x4 xv[2][2][2];
#pragma unroll
                for (int mm = 0; mm < 2; ++mm) { const int tok = u.pm * BM + ai * 128 + wr * 64 + (2 * mp + mm) * 16 + fr;
#pragma unroll
                    for (int bj = 0; bj < 2; ++bj) { const size_t o = (size_t)tok * D + col0 + 32 * bj; xv[mm][bj][0] = NT_LOAD((const f32x4*)(x + o)); xv[mm][bj][1] = NT_LOAD((const f32x4*)(x + o + 4)); } }
                asm volatile("" ::: "memory");
#pragma unroll
                for (int mm = 0; mm < 2; ++mm) { const int m = 2 * mp + mm, tok = u.pm * BM + ai * 128 + wr * 64 + m * 16 + fr;
#pragma unroll
                    for (int bj = 0; bj < 2; ++bj) *(u32x4*)(out + (size_t)tok * D + col0 + 32 * bj) = pack8(xv[mm][bj][0] + acc[ai][bj][m][0], xv[mm][bj][1] + acc[ai][bj][m][1]); }
                asm volatile("" ::: "memory"); }
    }
};
struct EpiMoe1 : EpiBase {
    unsigned char* ws; const float* b1; LAS unsigned char* lds; bool nostore = false;
    __device__ __forceinline__ void operator()(Acc& acc, const EpiInfo& u, int wr, int wc, int fr, int fq) const {
        asm volatile("" : "+v"(fr), "+v"(fq));
        unsigned char* ACT = ws + WS_ACT; const int e = u.aux, blk = u.aux2;
        f32x4 cb[2][2];
#pragma unroll
        for (int bj = 0; bj < 2; ++bj) { const int cl = 64 * wc + 32 * bj + 8 * fq; f32x4 r0, r1;
            if (u.ord < MOE_MAXU) { const LAS float* bl = (const LAS float*)(lds + UB_OFF) + u.ord * 256 + cl; r0 = *(const LAS f32x4*)bl; r1 = *(const LAS f32x4*)(bl + 4); }
            else { const float* bg = b1 + (size_t)e * 2 * DFF + u.pn * 256 + cl; r0 = *(const f32x4*)bg; r1 = *(const f32x4*)(bg + 4); __builtin_amdgcn_s_waitcnt(0x0F70); }
            cb[bj][0] = __builtin_shufflevector(r0, r0, 0, 2, 1, 3); cb[bj][1] = __builtin_shufflevector(r1, r1, 0, 2, 1, 3); }
        const f32x2 c7 = {7.f, 7.f}, one = {1.f, 1.f}, cexp = {-1.702f * 1.4426950408889634f, -1.702f * 1.4426950408889634f};
#pragma unroll
        for (int ai = 0; ai < 2; ++ai)
#pragma unroll
            for (int m = 0; m < 4; ++m) { const int row = ai * 128 + wr * 64 + m * 16 + fr; unsigned w[2];
#pragma unroll
                for (int bj = 0; bj < 2; ++bj) { f32x2 r[2];
#pragma unroll
                    for (int n = 0; n < 2; ++n) { const f32x4 h = acc[ai][bj][m][n] + cb[bj][n];
                        f32x2 g = {fminf(h[0], 7.f), fminf(h[1], 7.f)}; const f32x2 up = {fminf(fmaxf(h[2], -7.f), 7.f), fminf(fmaxf(h[3], -7.f), 7.f)};
                        const f32x2 x = g * cexp; f32x2 ex = {__builtin_amdgcn_exp2f(x[0]), __builtin_amdgcn_exp2f(x[1])};
                        ex = ex + one; const f32x2 s = {__builtin_amdgcn_rcpf(ex[0]), __builtin_amdgcn_rcpf(ex[1])};
                        r[n] = (up * g + g) * s; }
                    w[bj] = pk4_fp8(r[0][0], r[0][1], r[1][0], r[1][1]); }
                unsigned char* rowp = ACT + ((size_t)blk * 256 + row) * DFF + ((u.pn * 256 + 64 * wc + 8 * fq) >> 1);
#if defined(PROBE_NOSTORE)
                if (nostore) { asm volatile("" :: "v"(w[0]), "v"(w[1])); } else
#endif
                { *(unsigned*)rowp = w[0]; *(unsigned*)(rowp + 16) = w[1]; } }
        (void)c7;
    }
};
struct EpiMoe2 : EpiBase {
    unsigned char* ws; const float* b2; LAS unsigned char* lds; bool nostore = false;
    __device__ __forceinline__ void operator()(Acc& acc, const EpiInfo& u, int wr, int wc, int fr, int fq) const {
        asm volatile("" : "+v"(fr), "+v"(fq));
        bf16_t* Y = (bf16_t*)(ws + WS_Y); const int e = u.aux, blk = u.aux2 & 0xffff;
        f32x4 cb[2][2];
#pragma unroll
        for (int bj = 0; bj < 2; ++bj) { const int cl = 64 * wc + 32 * bj + 8 * fq;
            if (u.ord < MOE_MAXU) { const LAS float* bl = (const LAS float*)(lds + UB_OFF) + u.ord * 256 + cl; cb[bj][0] = *(const LAS f32x4*)bl; cb[bj][1] = *(const LAS f32x4*)(bl + 4); }
            else { const float* bg = b2 + (size_t)e * D + u.pn * 256 + cl; cb[bj][0] = *(const f32x4*)bg; cb[bj][1] = *(const f32x4*)(bg + 4); __builtin_amdgcn_s_waitcnt(0x0F70); } }
#pragma unroll
        for (int ai = 0; ai < 2; ++ai)
#pragma unroll
            for (int m = 0; m < 4; ++m) { const int row = ai * 128 + wr * 64 + m * 16 + fr;
#pragma unroll
                for (int bj = 0; bj < 2; ++bj) { const int col = u.pn * 256 + 64 * wc + 32 * bj + 8 * fq;
                    const u32x4 w = pack8(acc[ai][bj][m][0] + cb[bj][0], acc[ai][bj][m][1] + cb[bj][1]);
#if defined(PROBE_NOSTORE)
                    if (nostore) { asm volatile("" :: "v"(w)); } else
#endif
                    store16(Y + ((size_t)blk * 256 + row) * D + col, w); } }
    }
};
}
namespace attn_body {
using bf16=__hip_bfloat16;
using bf16x8=__attribute__((ext_vector_type(8)))short;
using s16x4=__attribute__((ext_vector_type(4)))short;
using f32x16=__attribute__((ext_vector_type(16)))float;
using u32x4=__attribute__((ext_vector_type(4)))unsigned;
constexpr int SEQ=2048,D=64,DM=1024;
constexpr int NW=8,QBLK=32,QB=QBLK*NW,KVBLK=64,NQB=SEQ/QB;
constexpr int ATTN_PITCH=DM, ATTN_UNIT_ROWS=QB;
__device__ __forceinline__ int crow(int r,int hi){return (r&3)+8*(r>>2)+4*hi;}
#define SBAR() __builtin_amdgcn_sched_barrier(0)
__device__ __forceinline__ void cmask(f32x16&p0,f32x16&p1,int jb,int qrel,int hi){
  const float NEG=-INFINITY; int kb=64*jb+4*hi;
  #pragma unroll
  for(int r=0;r<16;++r){int kv=kb+(r&3)+8*(r>>2); if(kv>qrel)p0[r]=NEG; if(kv+32>qrel)p1[r]=NEG;}
}

constexpr int NSLOT=3, SLOTB=8192;
constexpr int LDS_K=0, LDS_V=NSLOT*SLOTB, LDS_WS=2*NSLOT*SLOTB, LDS_OST=LDS_WS+NW*64*4, ALDS_BYTES=LDS_OST+NW*4096;
constexpr float C2=0.125f*1.4426950408889634f;
__device__ __forceinline__ void glds16(const void*gsrc,unsigned lds_dst){unsigned keep;
  asm volatile("s_mov_b32 %0, m0\n\ts_mov_b32 m0, %2\n\ts_nop 0\n\tglobal_load_lds_dwordx4 %1, off\n\ts_mov_b32 m0, %0":"=&s"(keep):"v"(gsrc),"s"(lds_dst):"memory");}
__device__ __forceinline__ float max3f(float a,float b,float c){float r;asm("v_max3_f32 %0, %1, %2, %3":"=v"(r):"v"(a),"v"(b),"v"(c));return r;}
__device__ __forceinline__ float max2f(float a,float b){float r;asm("v_max_f32_e32 %0, %1, %2":"=v"(r):"v"(a),"v"(b));return r;}
__device__ __forceinline__ float fadd_s(float a,float b){float r;asm("v_add_f32_e32 %0, %1, %2":"=v"(r):"v"(a),"v"(b));return r;}
__device__ __forceinline__ float fsub_s(float a,float b){float r;asm("v_sub_f32_e32 %0, %1, %2":"=v"(r):"v"(a),"v"(b));return r;}
typedef float f32x2_t __attribute__((ext_vector_type(2))); typedef __bf16 bf16x2_t __attribute__((ext_vector_type(2)));
__device__ __forceinline__ unsigned cvtpk_s(float lo,float hi){f32x2_t v={lo,hi};bf16x2_t b=__builtin_convertvector(v,bf16x2_t);return __builtin_bit_cast(unsigned,b);}
#define WAIT_BAR(N) asm volatile("s_waitcnt vmcnt(" #N ") lgkmcnt(0)\n\ts_barrier":::"memory")

__device__ __forceinline__ void qkt(f32x16&p0,f32x16&p1,const char*Kslot,const bf16x8*qr,const f32x16&negm,int r32,int hi){
  const char*kb=Kslot+hi*1024+r32*16;
  #pragma unroll
  for(int d0=0;d0<4;++d0){
    const bf16x8 b0=*reinterpret_cast<const bf16x8*>(kb+d0*2048);
    const bf16x8 b1=*reinterpret_cast<const bf16x8*>(kb+d0*2048+512);
    if(d0==0){p0=__builtin_amdgcn_mfma_f32_32x32x16_bf16(b0,qr[0],negm,0,0,0);p1=__builtin_amdgcn_mfma_f32_32x32x16_bf16(b1,qr[0],negm,0,0,0);}
    else{p0=__builtin_amdgcn_mfma_f32_32x32x16_bf16(b0,qr[d0],p0,0,0,0);p1=__builtin_amdgcn_mfma_f32_32x32x16_bf16(b1,qr[d0],p1,0,0,0);}}
}
typedef __attribute__((address_space(3))) const char* lds_cptr;
typedef short v4i16_t __attribute__((ext_vector_type(4)));
__device__ __forceinline__ void kload8(bf16x8*kf,lds_cptr kp){
  kf[0]=*(const __attribute__((address_space(3))) bf16x8*)(kp);      kf[1]=*(const __attribute__((address_space(3))) bf16x8*)(kp+512);
  kf[2]=*(const __attribute__((address_space(3))) bf16x8*)(kp+2048); kf[3]=*(const __attribute__((address_space(3))) bf16x8*)(kp+2560);
  kf[4]=*(const __attribute__((address_space(3))) bf16x8*)(kp+4096); kf[5]=*(const __attribute__((address_space(3))) bf16x8*)(kp+4608);
  kf[6]=*(const __attribute__((address_space(3))) bf16x8*)(kp+6144); kf[7]=*(const __attribute__((address_space(3))) bf16x8*)(kp+6656);
}
__device__ __forceinline__ void kload2(bf16x8*kf,lds_cptr kp,int j){ kf[2*j]=*(const __attribute__((address_space(3))) bf16x8*)(kp+j*2048); kf[2*j+1]=*(const __attribute__((address_space(3))) bf16x8*)(kp+j*2048+512); }
__device__ __forceinline__ s16x4 vtr(lds_cptr p){ return __builtin_bit_cast(s16x4,__builtin_amdgcn_ds_read_tr16_b64_v4i16((__attribute__((address_space(3))) v4i16_t*)p)); }
__device__ __forceinline__ float rowmax(const f32x16&p0,const f32x16&p1){
  float a=max3f(p0[0],p0[1],p1[0]),b=max3f(p0[2],p0[3],p1[1]);a=max3f(a,p1[2],p1[3]);
  #pragma unroll
  for(int r=4;r<16;r+=4){a=max3f(a,p0[r],p0[r+1]);b=max3f(b,p0[r+2],p0[r+3]);a=max3f(a,p1[r],p1[r+1]);b=max3f(b,p1[r+2],p1[r+3]);}
  const float m=max2f(a,b);
  auto rr=__builtin_amdgcn_permlane32_swap(__float_as_uint(m),__float_as_uint(m),false,false);
  return max2f(__uint_as_float(rr[0]),__uint_as_float(rr[1]));
}
__device__ __forceinline__ void pv(f32x16*o,int vb,bf16x8 pa0,bf16x8 pa1,bf16x8 pa2,bf16x8 pa3){
  #pragma unroll
  for(int d0=0;d0<2;++d0){s16x4 lo[4],hi[4];
    #pragma unroll
    for(int ks=0;ks<4;++ks){
      asm volatile("ds_read_b64_tr_b16 %0,%1 offset:%c2":"=&v"(lo[ks]):"v"(vb),"i"(d0*4096+ks*1024):"memory");
      asm volatile("ds_read_b64_tr_b16 %0,%1 offset:%c2":"=&v"(hi[ks]):"v"(vb),"i"(d0*4096+ks*1024+512):"memory");}
    asm volatile("s_waitcnt lgkmcnt(0)":::"memory");SBAR();
    #define PK(k) (bf16x8){lo[k][0],lo[k][1],lo[k][2],lo[k][3],hi[k][0],hi[k][1],hi[k][2],hi[k][3]}
    o[d0]=__builtin_amdgcn_mfma_f32_32x32x16_bf16(pa0,PK(0),o[d0],0,0,0);
    o[d0]=__builtin_amdgcn_mfma_f32_32x32x16_bf16(pa1,PK(1),o[d0],0,0,0);
    o[d0]=__builtin_amdgcn_mfma_f32_32x32x16_bf16(pa2,PK(2),o[d0],0,0,0);
    o[d0]=__builtin_amdgcn_mfma_f32_32x32x16_bf16(pa3,PK(3),o[d0],0,0,0);
    #undef PK
  }
}

#ifndef ATTN_STORE16
#define ATTN_STORE16(p,v) (*(u32x4*)(p)=(v))
#endif
template<int THRL> __device__ __forceinline__ void attn_unit(int b,int qcol,int kcol,int vcol,int ocol,int qb,const bf16*Q,const bf16*__restrict__ K,const bf16*__restrict__ V,bf16*O,char*shm){
  int tid_=threadIdx.x; asm volatile("":"+v"(tid_));
  const int tid=tid_,lane=tid&63,r32=lane&31,hi=lane>>5; const int wid=__builtin_amdgcn_readfirstlane(tid>>6);
  const long rowbase=(long)b*SEQ; const int q0=qb*QB;
  const bf16*Qw=Q+(rowbase+q0+wid*QBLK)*DM+qcol;
  const bf16*Kh=K+rowbase*DM+kcol,*Vh=V+rowbase*DM+vcol;
  const unsigned lds0=(unsigned)(uintptr_t)shm;
  float*wsf=(float*)(shm+LDS_WS)+wid*64;
  const bf16*ksrc=Kh+(long)lane*DM+wid*8;
  const bf16*vsrc=Vh+(long)(16*(wid&3)+(lane>>2))*DM+(wid>>2)*32+(lane&3)*8;
  const unsigned kdst=lds0+LDS_K+wid*1024, vdst=lds0+LDS_V+wid*1024;
  #define DMA_K(t,slot) glds16(ksrc+(long)(t)*KVBLK*DM,(unsigned)__builtin_amdgcn_readfirstlane(kdst+(slot)))
  #define DMA_V(t,slot) glds16(vsrc+(long)(t)*KVBLK*DM,(unsigned)__builtin_amdgcn_readfirstlane(vdst+(slot)))
  const int vb0=(int)(lds0+LDS_V)+((lane>>4)&1)*32+(lane&3)*8+(4*hi+((lane&15)>>2))*64;
  const char*Kbase=shm+LDS_K; bf16x8 kf[8];
  const lds_cptr shm3=(lds_cptr)shm; const lds_cptr kp0=shm3+LDS_K+hi*1024+r32*16; const lds_cptr vp0=shm3+LDS_V+((lane>>4)&1)*32+(lane&3)*8+(4*hi+((lane&15)>>2))*64;
  const int NT=(q0+QB)/KVBLK;
  DMA_K(0,0);DMA_V(0,0);DMA_K(1,SLOTB);
  bf16x8 qr[4];
  #pragma unroll
  for(int d0=0;d0<4;++d0)qr[d0]=*reinterpret_cast<const bf16x8*>(&Qw[(long)r32*DM+d0*16+hi*8]);
  float l_reg=0.f;f32x16 o[2];o[0]=f32x16{};o[1]=f32x16{};const f32x16 negm=f32x16{};
  const int qrel=wid*QBLK+r32;
  #define CMASK(P0,P1,t) do{int jb_=(t)-(NT-4); if(jb_>=0)cmask(P0,P1,jb_,qrel,hi);}while(0)
  #define START(P0,P1) do{ _Pragma("unroll") for(int r=0;r<16;++r)P0[r]=__builtin_amdgcn_exp2f(P0[r]); }while(0)
  #define RESC() do{}while(0)
  f32x16 pA0,pA1,pB0,pB1;
  int sl_prev=0,sl_cur=0,sl_next=SLOTB;
  #define ROT() do{sl_prev=sl_cur;sl_cur=sl_next;sl_next=(sl_next==(NSLOT-1)*SLOTB)?0:sl_next+SLOTB;}while(0)
  DMA_K(2,2*SLOTB);
  WAIT_BAR(3);
  qkt(pA0,pA1,Kbase,qr,negm,r32,hi);asm volatile("s_nop 15\n\ts_nop 7":"+v"(pA0),"+v"(pA1));CMASK(pA0,pA1,0);
  START(pA0,pA1);
  _Pragma("unroll") for(int r=0;r<16;++r)pA1[r]=__builtin_amdgcn_exp2f(pA1[r]);
  WAIT_BAR(0);
  DMA_K(3,0);DMA_V(1,SLOTB);
  ROT();
  kload8(kf,kp0+sl_cur);
  WAIT_BAR(2);
  s16x4 vlo[8],vhi[8]; u32x4 pw0,pw1,pw2,pw3;
  #define PKW(P,B) cvtpk_s(P[B],P[B+1])
  #define PAF(k) __builtin_bit_cast(bf16x8,pw##k)
  #define VFR(i) (bf16x8){vlo[i][0],vlo[i][1],vlo[i][2],vlo[i][3],vhi[i][0],vhi[i][1],vhi[i][2],vhi[i][3]}
  #define PIN(x) asm volatile("":"+v"(x))
  #define MX3(a,b,c) __builtin_fmaxf(__builtin_fmaxf((a),(b)),(c))
  #define GAPA(MF,A0,A1,A2,A3,W0,W1,PW) do{ MF; sacc+=A0; sacc+=A1; sacc+=A2; sacc+=A3; PIN(sacc); W0; W1; PIN(PW); SBAR(); }while(0)
  #define EX(v) __builtin_amdgcn_exp2f(v)
  #define GAPB(MF,X,B) do{ MF; X[B]=EX(X[B]); X[B+1]=EX(X[B+1]); X[B+2]=EX(X[B+2]); X[B+3]=EX(X[B+3]); PIN(X); SBAR(); }while(0)
  #define VRD(i) do{ vlo[i]=vtr(vp_+(((i)>>2)*4096+((i)&3)*1024)); vhi[i]=vtr(vp_+(((i)>>2)*4096+((i)&3)*1024+512)); }while(0)
  #define KRD(G,j) do{ if(G){ kload2(kf,kp0+sl_next,j); SBAR(); } }while(0)
  #define STEP(C0,C1,P0,P1,t,GK,GV,GL) do{ SBAR(); \
    const lds_cptr vp_=vp0+sl_prev; \
    VRD(0); SBAR(); float sacc=(P0[0]+P0[1]); \
    GAPA(C0=__builtin_amdgcn_mfma_f32_32x32x16_bf16(kf[0],qr[0],negm,0,0,0), P0[2],P0[3],P0[4],P0[5],     pw0[0]=PKW(P0,0), pw0[1]=PKW(P0,2), pw0); \
    VRD(4); SBAR(); GAPA(C1=__builtin_amdgcn_mfma_f32_32x32x16_bf16(kf[1],qr[0],negm,0,0,0), P0[6],P0[7],P0[8],P0[9],     pw0[2]=PKW(P0,4), pw0[3]=PKW(P0,6), pw0); \
    VRD(1); SBAR(); GAPA(C0=__builtin_amdgcn_mfma_f32_32x32x16_bf16(kf[2],qr[1],C0,0,0,0),   P0[10],P0[11],P0[12],P0[13], pw1[0]=PKW(P0,8), pw1[1]=PKW(P0,10), pw1); \
    VRD(5); SBAR(); GAPA(C1=__builtin_amdgcn_mfma_f32_32x32x16_bf16(kf[3],qr[1],C1,0,0,0),   P0[14],P0[15],P1[0],P1[1],   pw1[2]=PKW(P0,12),pw1[3]=PKW(P0,14), pw1); \
    VRD(2); SBAR(); GAPA(C0=__builtin_amdgcn_mfma_f32_32x32x16_bf16(kf[4],qr[2],C0,0,0,0),   P1[2],P1[3],P1[4],P1[5],     pw2[0]=PKW(P1,0), pw2[1]=PKW(P1,2), pw2); \
    VRD(6); SBAR(); GAPA(C1=__builtin_amdgcn_mfma_f32_32x32x16_bf16(kf[5],qr[2],C1,0,0,0),   P1[6],P1[7],P1[8],P1[9],     pw2[2]=PKW(P1,4), pw2[3]=PKW(P1,6), pw2); \
    VRD(3); SBAR(); GAPA(C0=__builtin_amdgcn_mfma_f32_32x32x16_bf16(kf[6],qr[3],C0,0,0,0),   P1[10],P1[11],P1[12],P1[13], pw3[0]=PKW(P1,8), pw3[1]=PKW(P1,10), pw3); \
    VRD(7); SBAR(); GAPA(C1=__builtin_amdgcn_mfma_f32_32x32x16_bf16(kf[7],qr[3],C1,0,0,0),   P1[14],P1[15],0.f,0.f,       pw3[2]=PKW(P1,12),pw3[3]=PKW(P1,14), pw3); \
    l_reg+=sacc; \
    if(GK){DMA_K((t)+3,sl_cur);} if(GV){DMA_V((t)+1,sl_next);} \
    CMASK(C0,C1,t); \
    SBAR(); \
    GAPB(o[0]=__builtin_amdgcn_mfma_f32_32x32x16_bf16(PAF(0),VFR(0),o[0],0,0,0), C0,0); \
    GAPB(o[1]=__builtin_amdgcn_mfma_f32_32x32x16_bf16(PAF(0),VFR(4),o[1],0,0,0), C0,4); \
    KRD(GL,0); GAPB(o[0]=__builtin_amdgcn_mfma_f32_32x32x16_bf16(PAF(1),VFR(1),o[0],0,0,0), C0,8); \
    KRD(GL,1); GAPB(o[1]=__builtin_amdgcn_mfma_f32_32x32x16_bf16(PAF(1),VFR(5),o[1],0,0,0), C0,12); \
    KRD(GL,2); GAPB(o[0]=__builtin_amdgcn_mfma_f32_32x32x16_bf16(PAF(2),VFR(2),o[0],0,0,0), C1,0); \
    KRD(GL,3); GAPB(o[1]=__builtin_amdgcn_mfma_f32_32x32x16_bf16(PAF(2),VFR(6),o[1],0,0,0), C1,4); \
    GAPB(o[0]=__builtin_amdgcn_mfma_f32_32x32x16_bf16(PAF(3),VFR(3),o[0],0,0,0), C1,8); \
    GAPB(o[1]=__builtin_amdgcn_mfma_f32_32x32x16_bf16(PAF(3),VFR(7),o[1],0,0,0), C1,12); \
    }while(0)
  int t=1;
  #undef CMASK
  #define CMASK(P0,P1,t) do{}while(0)
  for(;t+5<NT;t+=2){
    STEP(pB0,pB1,pA0,pA1,t,true,true,true);     WAIT_BAR(2); RESC(); ROT();
    STEP(pA0,pA1,pB0,pB1,t+1,true,true,true);   WAIT_BAR(2); RESC(); ROT();
  }
  #undef CMASK
  #define CMASK(P0,P1,t) do{int jb_=(t)-(NT-4); if(jb_>=0)cmask(P0,P1,jb_,qrel,hi);}while(0)
  #define ENDW(tt) do{ if((tt)+3<NT){WAIT_BAR(2);} else if((tt)+2<NT){WAIT_BAR(1);} else {WAIT_BAR(0);} }while(0)
  for(;t+1<NT;t+=2){
    STEP(pB0,pB1,pA0,pA1,t,(t+3<NT),(t+1<NT),(t+1<NT));       ENDW(t);   RESC(); ROT();
    STEP(pA0,pA1,pB0,pB1,t+1,(t+4<NT),(t+2<NT),(t+2<NT));     ENDW(t+1); RESC(); ROT();
  }
  STEP(pB0,pB1,pA0,pA1,NT-1,false,false,false); RESC();
  { float sacc=pB0[0]+pB0[1]; _Pragma("unroll") for(int r=2;r<16;++r)sacc+=pB0[r]; _Pragma("unroll") for(int r=0;r<16;++r)sacc+=pB1[r]; l_reg+=sacc;
    pw0=(u32x4){PKW(pB0,0),PKW(pB0,2),PKW(pB0,4),PKW(pB0,6)};pw1=(u32x4){PKW(pB0,8),PKW(pB0,10),PKW(pB0,12),PKW(pB0,14)};pw2=(u32x4){PKW(pB1,0),PKW(pB1,2),PKW(pB1,4),PKW(pB1,6)};pw3=(u32x4){PKW(pB1,8),PKW(pB1,10),PKW(pB1,12),PKW(pB1,14)};
    SBAR(); pv(o,vb0+sl_cur,PAF(0),PAF(1),PAF(2),PAF(3)); }
  #undef PKW
  #undef PAF
  #undef VFR
  #undef PIN
  #undef MX3
  #undef GAPA
  #undef GAPB
  #undef EX
  #undef VRD
  #undef KRD
  #undef STEP
  #undef ENDW
  {auto rr=__builtin_amdgcn_permlane32_swap(__float_as_uint(l_reg),__float_as_uint(l_reg),false,false);l_reg=__uint_as_float(rr[0])+__uint_as_float(rr[1]);}
  if(hi==0)wsf[32+r32]=l_reg;asm volatile("s_waitcnt lgkmcnt(0)":::"memory");
  float rli[16];
  #pragma unroll
  for(int r=0;r<16;++r)rli[r]=__builtin_amdgcn_rcpf(wsf[32+crow(r,hi)]);
  bf16*Ow=O+(rowbase+q0+wid*QBLK)*DM+ocol;
  { bf16*stg=(bf16*)(shm+LDS_OST)+wid*2048;
    #pragma unroll
    for(int r=0;r<16;++r){const int orow=crow(r,hi);
      #pragma unroll
      for(int d0=0;d0<2;++d0)stg[orow*64+d0*32+r32]=__float2bfloat16(o[d0][r]*rli[r]);}
    asm volatile("s_waitcnt lgkmcnt(0)":::"memory");
    #pragma unroll
    for(int i=0;i<4;++i){const int row=i*8+(lane>>3),ch=lane&7; const u32x4 v=*(const u32x4*)(stg+row*64+ch*8); ATTN_STORE16(Ow+(long)row*DM+ch*8,v);} }
  asm volatile("s_waitcnt lgkmcnt(0)\n\ts_barrier":::"memory");
  #undef DMA_K
  #undef DMA_V
  #undef CMASK
  #undef START
  #undef RESC
  #undef ROT
}
constexpr int ATTN_LDS_BYTES=ALDS_BYTES;

#undef SBAR
#undef WAIT_BAR
#undef ATTN_STORE16
}
namespace attn128 {
using bf16=__hip_bfloat16;
using bf16x8=__attribute__((ext_vector_type(8)))short;
using s16x4=__attribute__((ext_vector_type(4)))short;
using f32x16=__attribute__((ext_vector_type(16)))float;
using u32x4=__attribute__((ext_vector_type(4)))unsigned;
constexpr int SEQ=2048,D=64,DM=1024;
constexpr int NW=8,QBLK=32,QB=QBLK*NW,KVBLK=64,NQB=SEQ/QB;
constexpr int ATTN_PITCH=DM, ATTN_UNIT_ROWS=QB;
__device__ __forceinline__ int crow(int r,int hi){return (r&3)+8*(r>>2)+4*hi;}
#define SBAR() __builtin_amdgcn_sched_barrier(0)
__device__ __forceinline__ void cmask(f32x16&p0,f32x16&p1,int jb,int qrel,int hi){
  const float NEG=-INFINITY; int kb=64*jb+4*hi;
  #pragma unroll
  for(int r=0;r<16;++r){int kv=kb+(r&3)+8*(r>>2); if(kv>qrel)p0[r]=NEG; if(kv+32>qrel)p1[r]=NEG;}
}

constexpr int NSLOT=3, SLOTB=8192;
constexpr int VSLOTB=2*SLOTB;
constexpr int LDS_K=0, LDS_V=NSLOT*SLOTB, LDS_WS=LDS_V+NSLOT*VSLOTB, LDS_OST=LDS_WS+NW*64*4, ALDS_BYTES=LDS_OST+NW*4096;
constexpr float C2=0.125f*1.4426950408889634f;
__device__ __forceinline__ void glds16(const void*gsrc,unsigned lds_dst){unsigned keep;
  asm volatile("s_mov_b32 %0, m0\n\ts_mov_b32 m0, %2\n\ts_nop 0\n\tglobal_load_lds_dwordx4 %1, off\n\ts_mov_b32 m0, %0":"=&s"(keep):"v"(gsrc),"s"(lds_dst):"memory");}
__device__ __forceinline__ float max3f(float a,float b,float c){float r;asm("v_max3_f32 %0, %1, %2, %3":"=v"(r):"v"(a),"v"(b),"v"(c));return r;}
__device__ __forceinline__ float max2f(float a,float b){float r;asm("v_max_f32_e32 %0, %1, %2":"=v"(r):"v"(a),"v"(b));return r;}
__device__ __forceinline__ float fadd_s(float a,float b){float r;asm("v_add_f32_e32 %0, %1, %2":"=v"(r):"v"(a),"v"(b));return r;}
__device__ __forceinline__ float fsub_s(float a,float b){float r;asm("v_sub_f32_e32 %0, %1, %2":"=v"(r):"v"(a),"v"(b));return r;}
typedef float f32x2_t __attribute__((ext_vector_type(2))); typedef __bf16 bf16x2_t __attribute__((ext_vector_type(2)));
__device__ __forceinline__ unsigned cvtpk_s(float lo,float hi){f32x2_t v={lo,hi};bf16x2_t b=__builtin_convertvector(v,bf16x2_t);return __builtin_bit_cast(unsigned,b);}
#define WAIT_BAR(N) asm volatile("s_waitcnt vmcnt(" #N ") lgkmcnt(0)\n\ts_barrier":::"memory")

__device__ __forceinline__ void qkt(f32x16&p0,f32x16&p1,const char*Kslot,const bf16x8*qr,const f32x16&negm,int r32,int hi){
  const char*kb=Kslot+hi*1024+r32*16;
  #pragma unroll
  for(int d0=0;d0<4;++d0){
    const bf16x8 b0=*reinterpret_cast<const bf16x8*>(kb+d0*2048);
    const bf16x8 b1=*reinterpret_cast<const bf16x8*>(kb+d0*2048+512);
    if(d0==0){p0=__builtin_amdgcn_mfma_f32_32x32x16_bf16(b0,qr[0],negm,0,0,0);p1=__builtin_amdgcn_mfma_f32_32x32x16_bf16(b1,qr[0],negm,0,0,0);}
    else{p0=__builtin_amdgcn_mfma_f32_32x32x16_bf16(b0,qr[d0],p0,0,0,0);p1=__builtin_amdgcn_mfma_f32_32x32x16_bf16(b1,qr[d0],p1,0,0,0);}}
}
typedef __attribute__((address_space(3))) const char* lds_cptr;
typedef short v4i16_t __attribute__((ext_vector_type(4)));
__device__ __forceinline__ void kload8(bf16x8*kf,lds_cptr kp){
  kf[0]=*(const __attribute__((address_space(3))) bf16x8*)(kp);      kf[1]=*(const __attribute__((address_space(3))) bf16x8*)(kp+512);
  kf[2]=*(const __attribute__((address_space(3))) bf16x8*)(kp+2048); kf[3]=*(const __attribute__((address_space(3))) bf16x8*)(kp+2560);
  kf[4]=*(const __attribute__((address_space(3))) bf16x8*)(kp+4096); kf[5]=*(const __attribute__((address_space(3))) bf16x8*)(kp+4608);
  kf[6]=*(const __attribute__((address_space(3))) bf16x8*)(kp+6144); kf[7]=*(const __attribute__((address_space(3))) bf16x8*)(kp+6656);
}
__device__ __forceinline__ void kload2(bf16x8*kf,lds_cptr kp,int j){ kf[2*j]=*(const __attribute__((address_space(3))) bf16x8*)(kp+j*2048); kf[2*j+1]=*(const __attribute__((address_space(3))) bf16x8*)(kp+j*2048+512); }
__device__ __forceinline__ s16x4 vtr(lds_cptr p){ return __builtin_bit_cast(s16x4,__builtin_amdgcn_ds_read_tr16_b64_v4i16((__attribute__((address_space(3))) v4i16_t*)p)); }
__device__ __forceinline__ float rowmax(const f32x16&p0,const f32x16&p1){
  float a=max3f(p0[0],p0[1],p1[0]),b=max3f(p0[2],p0[3],p1[1]);a=max3f(a,p1[2],p1[3]);
  #pragma unroll
  for(int r=4;r<16;r+=4){a=max3f(a,p0[r],p0[r+1]);b=max3f(b,p0[r+2],p0[r+3]);a=max3f(a,p1[r],p1[r+1]);b=max3f(b,p1[r+2],p1[r+3]);}
  const float m=max2f(a,b);
  auto rr=__builtin_amdgcn_permlane32_swap(__float_as_uint(m),__float_as_uint(m),false,false);
  return max2f(__uint_as_float(rr[0]),__uint_as_float(rr[1]));
}
__device__ __forceinline__ void pv(f32x16*o,int vb,bf16x8 pa0,bf16x8 pa1,bf16x8 pa2,bf16x8 pa3){
  #pragma unroll
  for(int d0=0;d0<4;++d0){s16x4 lo[4],hi[4];
    #pragma unroll
    for(int ks=0;ks<4;++ks){
      asm volatile("ds_read_b64_tr_b16 %0,%1 offset:%c2":"=&v"(lo[ks]):"v"(vb),"i"(d0*4096+ks*1024):"memory");
      asm volatile("ds_read_b64_tr_b16 %0,%1 offset:%c2":"=&v"(hi[ks]):"v"(vb),"i"(d0*4096+ks*1024+512):"memory");}
    asm volatile("s_waitcnt lgkmcnt(0)":::"memory");SBAR();
    #define PK(k) (bf16x8){lo[k][0],lo[k][1],lo[k][2],lo[k][3],hi[k][0],hi[k][1],hi[k][2],hi[k][3]}
    o[d0]=__builtin_amdgcn_mfma_f32_32x32x16_bf16(pa0,PK(0),o[d0],0,0,0);
    o[d0]=__builtin_amdgcn_mfma_f32_32x32x16_bf16(pa1,PK(1),o[d0],0,0,0);
    o[d0]=__builtin_amdgcn_mfma_f32_32x32x16_bf16(pa2,PK(2),o[d0],0,0,0);
    o[d0]=__builtin_amdgcn_mfma_f32_32x32x16_bf16(pa3,PK(3),o[d0],0,0,0);
    #undef PK
  }
}

#ifndef ATTN_STORE16
#define ATTN_STORE16(p,v) (*(u32x4*)(p)=(v))
#endif
template<int THRL> __device__ __forceinline__ void attn_unit(int b,int qcol,int kcol,int vcol,int ocol,int qb,const bf16*Q,const bf16*__restrict__ K,const bf16*__restrict__ V,bf16*O,char*shm){
  int tid_=threadIdx.x; asm volatile("":"+v"(tid_));
  const int tid=tid_,lane=tid&63,r32=lane&31,hi=lane>>5; const int wid=__builtin_amdgcn_readfirstlane(tid>>6);
  const long rowbase=(long)b*SEQ; const int q0=qb*QB;
  const bf16*Qw=Q+(rowbase+q0+wid*QBLK)*DM+qcol;
  const bf16*Kh=K+rowbase*DM+kcol,*Vh=V+rowbase*DM+vcol;
  const unsigned lds0=(unsigned)(uintptr_t)shm;
  float*wsf=(float*)(shm+LDS_WS)+wid*64;
  const bf16*ksrc=Kh+(long)lane*DM+wid*8;
  const bf16*vsrc=Vh+(long)(16*(wid&3)+(lane>>2))*DM+(wid>>2)*32+(lane&3)*8;
  const unsigned kdst=lds0+LDS_K+wid*1024, vdst=lds0+LDS_V+wid*1024;
  #define DMA_K(t,slot) glds16(ksrc+(long)(t)*KVBLK*DM,(unsigned)__builtin_amdgcn_readfirstlane(kdst+(slot)))
  #define DMA_V(t,slot) do{ glds16(vsrc+(long)(t)*KVBLK*DM,(unsigned)__builtin_amdgcn_readfirstlane(vdst+2*(slot))); glds16(vsrc+64+(long)(t)*KVBLK*DM,(unsigned)__builtin_amdgcn_readfirstlane(vdst+8192+2*(slot))); }while(0)
  const int vb0=(int)(lds0+LDS_V)+((lane>>4)&1)*32+(lane&3)*8+(4*hi+((lane&15)>>2))*64;
  const char*Kbase=shm+LDS_K; bf16x8 kf[8];
  const lds_cptr shm3=(lds_cptr)shm; const lds_cptr kp0=shm3+LDS_K+hi*1024+r32*16; const lds_cptr vp0=shm3+LDS_V+((lane>>4)&1)*32+(lane&3)*8+(4*hi+((lane&15)>>2))*64;
  const int NT=(q0+QB)/KVBLK;
  DMA_K(0,0);DMA_V(0,0);DMA_K(1,SLOTB);
  bf16x8 qr[4];
  #pragma unroll
  for(int d0=0;d0<4;++d0)qr[d0]=*reinterpret_cast<const bf16x8*>(&Qw[(long)r32*DM+d0*16+hi*8]);
  float l_reg=0.f;f32x16 o[4];o[0]=f32x16{};o[1]=f32x16{};o[2]=f32x16{};o[3]=f32x16{};const f32x16 negm=f32x16{};
  const int qrel=wid*QBLK+r32;
  #define CMASK(P0,P1,t) do{int jb_=(t)-(NT-4); if(jb_>=0)cmask(P0,P1,jb_,qrel,hi);}while(0)
  #define START(P0,P1) do{ _Pragma("unroll") for(int r=0;r<16;++r)P0[r]=__builtin_amdgcn_exp2f(P0[r]); }while(0)
  #define RESC() do{}while(0)
  f32x16 pA0,pA1,pB0,pB1;
  int sl_prev=0,sl_cur=0,sl_next=SLOTB;
  #define ROT() do{sl_prev=sl_cur;sl_cur=sl_next;sl_next=(sl_next==(NSLOT-1)*SLOTB)?0:sl_next+SLOTB;}while(0)
  DMA_K(2,2*SLOTB);
  WAIT_BAR(4);
  qkt(pA0,pA1,Kbase,qr,negm,r32,hi);asm volatile("s_nop 15\n\ts_nop 7":"+v"(pA0),"+v"(pA1));CMASK(pA0,pA1,0);
  START(pA0,pA1);
  _Pragma("unroll") for(int r=0;r<16;++r)pA1[r]=__builtin_amdgcn_exp2f(pA1[r]);
  WAIT_BAR(0);
  DMA_K(3,0);DMA_V(1,SLOTB);
  ROT();
  kload8(kf,kp0+sl_cur);
  WAIT_BAR(3);
  s16x4 vlo[8],vhi[8]; u32x4 pw0,pw1,pw2,pw3;
  #define PKW(P,B) cvtpk_s(P[B],P[B+1])
  #define PAF(k) __builtin_bit_cast(bf16x8,pw##k)
  #define VFR(i) (bf16x8){vlo[i][0],vlo[i][1],vlo[i][2],vlo[i][3],vhi[i][0],vhi[i][1],vhi[i][2],vhi[i][3]}
  #define PIN(x) asm volatile("":"+v"(x))
  #define MX3(a,b,c) __builtin_fmaxf(__builtin_fmaxf((a),(b)),(c))
  #define GAPA(MF,A0,A1,A2,A3,W0,W1,PW) do{ MF; sacc+=A0; sacc+=A1; sacc+=A2; sacc+=A3; PIN(sacc); W0; W1; PIN(PW); SBAR(); }while(0)
  #define EX(v) __builtin_amdgcn_exp2f(v)
  #define GAPB(MF,X,B) do{ MF; X[B]=EX(X[B]); X[B+1]=EX(X[B+1]); PIN(X); SBAR(); }while(0)
  #define VRD2(i) do{ vlo[i]=vtr(vp_+((((i)>>2)+2)*4096+((i)&3)*1024)); vhi[i]=vtr(vp_+((((i)>>2)+2)*4096+((i)&3)*1024+512)); }while(0)
  #define VRD(i) do{ vlo[i]=vtr(vp_+(((i)>>2)*4096+((i)&3)*1024)); vhi[i]=vtr(vp_+(((i)>>2)*4096+((i)&3)*1024+512)); }while(0)
  #define KRD(G,j) do{ if(G){ kload2(kf,kp0+sl_next,j); SBAR(); } }while(0)
  #define STEP(C0,C1,P0,P1,t,GK,GV,GL) do{ SBAR(); \
    const lds_cptr vp_=vp0+2*sl_prev; \
    VRD(0); SBAR(); float sacc=(P0[0]+P0[1]); \
    GAPA(C0=__builtin_amdgcn_mfma_f32_32x32x16_bf16(kf[0],qr[0],negm,0,0,0), P0[2],P0[3],P0[4],P0[5],     pw0[0]=PKW(P0,0), pw0[1]=PKW(P0,2), pw0); \
    VRD(4); SBAR(); GAPA(C1=__builtin_amdgcn_mfma_f32_32x32x16_bf16(kf[1],qr[0],negm,0,0,0), P0[6],P0[7],P0[8],P0[9],     pw0[2]=PKW(P0,4), pw0[3]=PKW(P0,6), pw0); \
    VRD(1); SBAR(); GAPA(C0=__builtin_amdgcn_mfma_f32_32x32x16_bf16(kf[2],qr[1],C0,0,0,0),   P0[10],P0[11],P0[12],P0[13], pw1[0]=PKW(P0,8), pw1[1]=PKW(P0,10), pw1); \
    VRD(5); SBAR(); GAPA(C1=__builtin_amdgcn_mfma_f32_32x32x16_bf16(kf[3],qr[1],C1,0,0,0),   P0[14],P0[15],P1[0],P1[1],   pw1[2]=PKW(P0,12),pw1[3]=PKW(P0,14), pw1); \
    VRD(2); SBAR(); GAPA(C0=__builtin_amdgcn_mfma_f32_32x32x16_bf16(kf[4],qr[2],C0,0,0,0),   P1[2],P1[3],P1[4],P1[5],     pw2[0]=PKW(P1,0), pw2[1]=PKW(P1,2), pw2); \
    VRD(6); SBAR(); GAPA(C1=__builtin_amdgcn_mfma_f32_32x32x16_bf16(kf[5],qr[2],C1,0,0,0),   P1[6],P1[7],P1[8],P1[9],     pw2[2]=PKW(P1,4), pw2[3]=PKW(P1,6), pw2); \
    VRD(3); SBAR(); GAPA(C0=__builtin_amdgcn_mfma_f32_32x32x16_bf16(kf[6],qr[3],C0,0,0,0),   P1[10],P1[11],P1[12],P1[13], pw3[0]=PKW(P1,8), pw3[1]=PKW(P1,10), pw3); \
    VRD(7); SBAR(); GAPA(C1=__builtin_amdgcn_mfma_f32_32x32x16_bf16(kf[7],qr[3],C1,0,0,0),   P1[14],P1[15],0.f,0.f,       pw3[2]=PKW(P1,12),pw3[3]=PKW(P1,14), pw3); \
    l_reg+=sacc; \
    if(GK){DMA_K((t)+3,sl_cur);} if(GV){DMA_V((t)+1,sl_next);} \
    CMASK(C0,C1,t); \
    SBAR(); \
    GAPB(o[0]=__builtin_amdgcn_mfma_f32_32x32x16_bf16(PAF(0),VFR(0),o[0],0,0,0), C0,0);  VRD2(0); SBAR(); \
    GAPB(o[1]=__builtin_amdgcn_mfma_f32_32x32x16_bf16(PAF(0),VFR(4),o[1],0,0,0), C0,2);  VRD2(4); SBAR(); \
    KRD(GL,0); GAPB(o[0]=__builtin_amdgcn_mfma_f32_32x32x16_bf16(PAF(1),VFR(1),o[0],0,0,0), C0,4);  VRD2(1); SBAR(); \
    KRD(GL,1); GAPB(o[1]=__builtin_amdgcn_mfma_f32_32x32x16_bf16(PAF(1),VFR(5),o[1],0,0,0), C0,6);  VRD2(5); SBAR(); \
    KRD(GL,2); GAPB(o[0]=__builtin_amdgcn_mfma_f32_32x32x16_bf16(PAF(2),VFR(2),o[0],0,0,0), C0,8);  VRD2(2); SBAR(); \
    KRD(GL,3); GAPB(o[1]=__builtin_amdgcn_mfma_f32_32x32x16_bf16(PAF(2),VFR(6),o[1],0,0,0), C0,10); VRD2(6); SBAR(); \
    GAPB(o[0]=__builtin_amdgcn_mfma_f32_32x32x16_bf16(PAF(3),VFR(3),o[0],0,0,0), C0,12); VRD2(3); SBAR(); \
    GAPB(o[1]=__builtin_amdgcn_mfma_f32_32x32x16_bf16(PAF(3),VFR(7),o[1],0,0,0), C0,14); VRD2(7); SBAR(); \
    GAPB(o[2]=__builtin_amdgcn_mfma_f32_32x32x16_bf16(PAF(0),VFR(0),o[2],0,0,0), C1,0); \
    GAPB(o[3]=__builtin_amdgcn_mfma_f32_32x32x16_bf16(PAF(0),VFR(4),o[3],0,0,0), C1,2); \
    GAPB(o[2]=__builtin_amdgcn_mfma_f32_32x32x16_bf16(PAF(1),VFR(1),o[2],0,0,0), C1,4); \
    GAPB(o[3]=__builtin_amdgcn_mfma_f32_32x32x16_bf16(PAF(1),VFR(5),o[3],0,0,0), C1,6); \
    GAPB(o[2]=__builtin_amdgcn_mfma_f32_32x32x16_bf16(PAF(2),VFR(2),o[2],0,0,0), C1,8); \
    GAPB(o[3]=__builtin_amdgcn_mfma_f32_32x32x16_bf16(PAF(2),VFR(6),o[3],0,0,0), C1,10); \
    GAPB(o[2]=__builtin_amdgcn_mfma_f32_32x32x16_bf16(PAF(3),VFR(3),o[2],0,0,0), C1,12); \
    GAPB(o[3]=__builtin_amdgcn_mfma_f32_32x32x16_bf16(PAF(3),VFR(7),o[3],0,0,0), C1,14); \
    }while(0)
  int t=1;
  #undef CMASK
  #define CMASK(P0,P1,t) do{}while(0)
  for(;t+5<NT;t+=2){
    STEP(pB0,pB1,pA0,pA1,t,true,true,true);     WAIT_BAR(3); RESC(); ROT();
    STEP(pA0,pA1,pB0,pB1,t+1,true,true,true);   WAIT_BAR(3); RESC(); ROT();
  }
  #undef CMASK
  #define CMASK(P0,P1,t) do{int jb_=(t)-(NT-4); if(jb_>=0)cmask(P0,P1,jb_,qrel,hi);}while(0)
  #define ENDW(tt) do{ if((tt)+3<NT){WAIT_BAR(3);} else if((tt)+2<NT){WAIT_BAR(2);} else {WAIT_BAR(0);} }while(0)
  for(;t+1<NT;t+=2){
    STEP(pB0,pB1,pA0,pA1,t,(t+3<NT),(t+1<NT),(t+1<NT));       ENDW(t);   RESC(); ROT();
    STEP(pA0,pA1,pB0,pB1,t+1,(t+4<NT),(t+2<NT),(t+2<NT));     ENDW(t+1); RESC(); ROT();
  }
  STEP(pB0,pB1,pA0,pA1,NT-1,false,false,false); RESC();
  { float sacc=pB0[0]+pB0[1]; _Pragma("unroll") for(int r=2;r<16;++r)sacc+=pB0[r]; _Pragma("unroll") for(int r=0;r<16;++r)sacc+=pB1[r]; l_reg+=sacc;
    pw0=(u32x4){PKW(pB0,0),PKW(pB0,2),PKW(pB0,4),PKW(pB0,6)};pw1=(u32x4){PKW(pB0,8),PKW(pB0,10),PKW(pB0,12),PKW(pB0,14)};pw2=(u32x4){PKW(pB1,0),PKW(pB1,2),PKW(pB1,4),PKW(pB1,6)};pw3=(u32x4){PKW(pB1,8),PKW(pB1,10),PKW(pB1,12),PKW(pB1,14)};
    SBAR(); pv(o,vb0+2*sl_cur,PAF(0),PAF(1),PAF(2),PAF(3)); }
  #undef PKW
  #undef PAF
  #undef VFR
  #undef PIN
  #undef MX3
  #undef GAPA
  #undef GAPB
  #undef EX
  #undef VRD
  #undef VRD2
  #undef KRD
  #undef STEP
  #undef ENDW
  {auto rr=__builtin_amdgcn_permlane32_swap(__float_as_uint(l_reg),__float_as_uint(l_reg),false,false);l_reg=__uint_as_float(rr[0])+__uint_as_float(rr[1]);}
  if(hi==0)wsf[32+r32]=l_reg;asm volatile("s_waitcnt lgkmcnt(0)":::"memory");
  float rli[16];
  #pragma unroll
  for(int r=0;r<16;++r)rli[r]=__builtin_amdgcn_rcpf(wsf[32+crow(r,hi)]);
  bf16*Ow=O+(rowbase+q0+wid*QBLK)*DM+ocol;
  { bf16*stg=(bf16*)(shm+LDS_OST)+wid*2048;
    #pragma unroll
    for(int hv=0;hv<2;++hv){
      #pragma unroll
      for(int r=0;r<16;++r){const int orow=crow(r,hi);
        #pragma unroll
        for(int d0=0;d0<2;++d0)stg[orow*64+d0*32+r32]=__float2bfloat16(o[2*hv+d0][r]*rli[r]);}
      asm volatile("s_waitcnt lgkmcnt(0)":::"memory");
      #pragma unroll
      for(int i=0;i<4;++i){const int row=i*8+(lane>>3),ch=lane&7; const u32x4 v=*(const u32x4*)(stg+row*64+ch*8); ATTN_STORE16(Ow+(long)row*DM+hv*64+ch*8,v);}
      asm volatile("s_waitcnt lgkmcnt(0)":::"memory"); } }
  asm volatile("s_waitcnt lgkmcnt(0)\n\ts_barrier":::"memory");
  #undef DMA_K
  #undef DMA_V
  #undef CMASK
  #undef START
  #undef RESC
  #undef ROT
}
constexpr int ATTN_LDS_BYTES=ALDS_BYTES;

#undef SBAR
#undef WAIT_BAR
#undef ATTN_STORE16
}
constexpr size_t WS_ATT0 = WS_ACT, WS_ATT1 = WS_ACT + 32 * MiB;

__device__ __forceinline__ void diff_combine(const Params& P, int b, int h, int qb) {
    int tid_ = threadIdx.x; asm volatile("" : "+v"(tid_));
    const int tid = tid_, lane = tid & 63, wid = tid >> 6;
    const float lam = __expf(wave_sum(P.in[I_LQ1][lane] * P.in[I_LK1][lane])) - __expf(wave_sum(P.in[I_LQ2][lane] * P.in[I_LK2][lane])) + 0.2f;
    const int ch = lane & 15;
    const f32x4 g0 = *(const f32x4*)(P.in[I_SG] + 8 * ch), g1 = *(const f32x4*)(P.in[I_SG] + 8 * ch + 4);
    const size_t row0 = (size_t)b * SEQ + qb * 256 + wid * 32 + (lane >> 4);
    const bf16_t* s0 = (const bf16_t*)(P.ws + WS_ATT0) + row0 * D + h * 128 + 8 * ch; const bf16_t* s1 = (const bf16_t*)(P.ws + WS_ATT1) + row0 * D + h * 128 + 8 * ch;
    bf16_t* dst = (bf16_t*)(P.ws + WS_MA) + row0 * MA_LD + h * 128 + 8 * ch;
#pragma unroll
    for (int hb = 0; hb < 2; ++hb) { u32x4 ra[4], rb[4];
#pragma unroll
        for (int q = 0; q < 4; ++q) { const int it = 4 * hb + q; ra[q] = *(const u32x4*)(s0 + (size_t)(4 * it) * D); rb[q] = *(const u32x4*)(s1 + (size_t)(4 * it) * D); }
        asm volatile("" ::: "memory");
#pragma unroll
        for (int q = 0; q < 4; ++q) { const int it = 4 * hb + q;
            f32x4 a0, a1, b0, b1; pg::unpack8(ra[q], a0, a1); pg::unpack8(rb[q], b0, b1);
            const f32x4 o0 = a0 - lam * b0, o1 = a1 - lam * b1;
            float ss = (o0[0] * o0[0] + o0[1] * o0[1]) + (o0[2] * o0[2] + o0[3] * o0[3]) + (o1[0] * o1[0] + o1[1] * o1[1]) + (o1[2] * o1[2] + o1[3] * o1[3]);
            ss += __shfl_xor(ss, 1); ss += __shfl_xor(ss, 2); ss += __shfl_xor(ss, 4); ss += __shfl_xor(ss, 8);
            const float r = rsqrtf(ss * (1.f / 128.f) + EPS) * 0.8f;
            *(u32x4*)(dst + (size_t)(4 * it) * MA_LD) = pg::pack8(o0 * r * g0, o1 * r * g1); }
        asm volatile("" ::: "memory"); }
}
__device__ __forceinline__ void attn_phase(const Params& P, char* lds, int vcu, int G) {
    using attn_body::bf16;
    const bf16* Q = (const bf16*)(P.ws + WS_Q); const bf16* K = (const bf16*)(P.ws + WS_K); const bf16* V = (const bf16*)(P.ws + WS_V);
    for (int v = vcu; v < 256; v += G) {
        const int bh = v >> 2, b = bh >> 3, h = bh & 7, s = v & 3;
        for (int i = 0; i < 2; ++i) { const int qb = i == 0 ? 7 - s : s;
#ifndef ATTN_V128
#define ATTN_V128 1
#endif
#if ATTN_V128
            for (int m = 0; m < 2; ++m) {
#if EXPERTS_IN_ATTN
#ifndef CONV_SLOTS
#define CONV_SLOTS 4
#endif
#ifndef CONV_SPLIT
#define CONV_SPLIT 1
#endif
                if (CONV_SLOTS == 2 ? (i == 0 && m == ((v >> 2) & 1)) : ((i * 2 + m - (((v >> 2) + v) & 3)) & (CONV_SPLIT == 2 ? 1 : 3)) == 0) {
                    constexpr int per = (EXP_M10 - EXP_ATT0) / 256; const int hsel = CONV_SPLIT == 2 ? (((i * 2 + m - (((v >> 2) + v) & 3)) >> 1) & 1) : 0;
                    expert_convert_slice(P, (LAS unsigned char*)lds, EXP_ATT0 + v * per + hsel * (per / 2), CONV_SPLIT == 2 ? EXP_ATT0 + v * per + (hsel + 1) * (per / 2) : EXP_ATT0 + (v + 1) * per);
#if defined(PROBE_CONV2)
                    asm volatile("s_waitcnt vmcnt(0) lgkmcnt(0)" ::: "memory"); __syncthreads(); expert_convert_slice(P, (LAS unsigned char*)lds, EXP_ATT0 + v * per, EXP_ATT0 + (v + 1) * per, true);
#endif
                    asm volatile("s_waitcnt vmcnt(0) lgkmcnt(0)" ::: "memory"); __syncthreads(); }
#endif
                attn128::attn_unit<8>(b, h * 128 + m * 64, h * 128 + m * 64, h * 128, h * 128, qb, (const attn128::bf16*)Q, (const attn128::bf16*)K, (const attn128::bf16*)V, (attn128::bf16*)(P.ws + (m == 0 ? WS_ATT0 : WS_ATT1)), lds); }
#else
            for (int pass = 0; pass < 4; ++pass) { const int m = pass >> 1, vh = pass & 1;
#if EXPERTS_IN_ATTN
                if (i * 4 + pass == (((v >> 2) + v) & 3)) {
                    constexpr int per = (EXP_M10 - EXP_ATT0) / 256; expert_convert_slice(P, (LAS unsigned char*)lds, EXP_ATT0 + v * per, EXP_ATT0 + (v + 1) * per);
                    asm volatile("s_waitcnt vmcnt(0) lgkmcnt(0)" ::: "memory"); __syncthreads(); }
#endif
                attn_body::attn_unit<8>(b, h * 128 + m * 64, h * 128 + m * 64, h * 128 + vh * 64, h * 128 + vh * 64, qb, Q, K, V, (bf16*)(P.ws + (m == 0 ? WS_ATT0 : WS_ATT1)), lds); }
#endif
            asm volatile("s_waitcnt vmcnt(0)" ::: "memory");
            diff_combine(P, b, h, qb);
        }
    }
}

__device__ __forceinline__ void ssm1_phase(const Params& P, LAS unsigned char* lds, int vcu, int G) {
    const int tid = opaque_tid(), lane = tid & 63, wid = __builtin_amdgcn_readfirstlane(tid >> 6), fr = lane & 15, fq = lane >> 4;
    LAS float* Sl = (LAS float*)lds;
    for (int u = vcu; u < SSM_G * BATCH; u += G) {
        const int g = u >> 3, b = u & 7;
        bf16_t* A = (bf16_t*)(P.ws + WS_ACAT) + (size_t)(g * ACAT_ROWS + b * NCH) * ACAT_LD;
        const bf16_t* Bw = (const bf16_t*)(P.ws + WS_WS_T) + (size_t)(g * 128 + 16 * wid + fr) * 512 + fq * 8;
        f32x4 acc[4];
#pragma unroll
        for (int m = 0; m < 4; ++m) acc[m] = (f32x4){0.f, 0.f, 0.f, 0.f};
#pragma unroll 4
        for (int ks = 0; ks < 16; ++ks) {
            const bf16x8 bf = *(const bf16x8*)(Bw + ks * 32);
#pragma unroll
            for (int m = 0; m < 4; ++m) { const bf16x8 af = *(const bf16x8*)(A + (size_t)(16 * m + fr) * ACAT_LD + ks * 32 + fq * 8);
                acc[m] = __builtin_amdgcn_mfma_f32_16x16x32_bf16(af, bf, acc[m], 0, 0, 0); }
        }
#pragma unroll
        for (int m = 0; m < 4; ++m)
#pragma unroll
            for (int q = 0; q < 4; ++q) Sl[(16 * m + 4 * fq + q) * 129 + 16 * wid + fr] = acc[m][q];
        __syncthreads();
        if (tid < SSM_P) {
            const int p = tid; const SsmGP gp = ssm_gp(P, g, p); float aLr, aLi; ssm_pow(gp, CH_L, aLr, aLi);
            float xr = 0.f, xi = 0.f;
            bf16_t* xp = A + 512 + p;
            for (int c = 0; c < NCH; ++c) {
                xp[(size_t)c * ACAT_LD] = (bf16_t)f2bf(xr); xp[(size_t)c * ACAT_LD + 64] = (bf16_t)f2bf(xi);
                const float sr = Sl[c * 129 + p], si = Sl[c * 129 + 64 + p];
                const float nr = aLr * xr - aLi * xi + sr, ni = aLr * xi + aLi * xr + si; xr = nr; xi = ni;
            }
        }
        __syncthreads();
    }
}
namespace pg {
struct Ssm2Sched {
    unsigned char* ws; int G, c;
    __device__ __forceinline__ void init(unsigned char* ws_, int G_, int c_) { ws = ws_; G = G_; c = c_; }
    __device__ __forceinline__ bool next(int i, Unit& u) const {
        const int L = i * G + c; if (L >= SSM_G * 4) return false;
        const int g = L >> 2; u.pm = (L >> 1) & 1; u.pn = L & 1; u.aux = g; u.aux2 = 0; u.ord = i; const LaneRC rc;
        u.A = (const char*)((const bf16_t*)(ws + WS_ACAT) + (size_t)g * ACAT_ROWS * ACAT_LD); u.B = (const char*)((const bf16_t*)(ws + WS_BT_SSM) + ((size_t)g * 512 + u.pn * BM) * ACAT_LD);
#pragma unroll
        for (int h = 0; h < 2; ++h)
#pragma unroll
            for (int j = 0; j < 2; ++j) u.aoff[h][j] = (unsigned)(((u.pm * BM + 128 * h + rc.R[j]) * ACAT_LD + rc.C[j]) * 2);
        return true;
    }
};
}

constexpr int RT_LG_OFF = RING_BYTES + 2048;
constexpr int RT_HIST_OFF = RT_LG_OFF + 64 * 33 * 4;
__device__ __forceinline__ void router_phase(const Params& P, LAS unsigned char* lds, int vcu, int G) {
    const int tid = opaque_tid(), lane = tid & 63, wid = __builtin_amdgcn_readfirstlane(tid >> 6);
    const float* wrt = (const float*)(P.ws + WS_WR_T);
#pragma unroll
    for (int i = 0; i < 16; ++i) __builtin_amdgcn_global_load_lds((const unsigned*)(wrt + (size_t)(tid + NTHREADS * i) * 4), (LAS unsigned*)(lds + wid * 1024 + i * 8192), 16, 0, 0);
    LAS float* lg = (LAS float*)(lds + RT_LG_OFF); LAS int* hist = (LAS int*)(lds + RT_HIST_OFF);
    int* slot_tok = (int*)(P.ws + WS_SLOT_TOK); float* slot_gate = (float*)(P.ws + WS_SLOT_GATE); int* tok_ep = (int*)(P.ws + WS_TOK_EP);
    unsigned char* H2 = P.ws + WS_H2;
    for (int tb = vcu; tb < T / 64; tb += G) {
        if (tid < 64) hist[tid] = 0;
        _Pragma("clang loop unroll(disable)") for (int pass = 0; pass < 2; ++pass) {
            const int t0 = tb * 64 + wid * 8 + pass * 4;
            f32x4 h[4][4];
            { u32x2 hr[4][4];
#pragma unroll
              for (int t = 0; t < 4; ++t)
#pragma unroll
                  for (int j = 0; j < 4; ++j) hr[t][j] = NT_LOAD((const u32x2*)((const bf16_t*)(P.ws + WS_X1) + (size_t)(t0 + t) * D) + lane + 64 * j);
#pragma unroll
              for (int t = 0; t < 4; ++t)
#pragma unroll
                  for (int j = 0; j < 4; ++j) h[t][j] = (f32x4){bflo(hr[t][j].x), bfhi(hr[t][j].x), bflo(hr[t][j].y), bfhi(hr[t][j].y)}; }
            if (pass == 0) { asm volatile("s_waitcnt vmcnt(0)" ::: "memory"); __syncthreads(); }
            f32x2 ha[4][4], hb[4][4];
#pragma unroll
            for (int tp = 0; tp < 2; ++tp) {
                float s0 = 0.f, s1 = 0.f;
#pragma unroll
                for (int j = 0; j < 4; ++j) { const f32x4 a = h[2 * tp][j], b = h[2 * tp + 1][j]; s0 += (a.x * a.x + a.y * a.y) + (a.z * a.z + a.w * a.w); s1 += (b.x * b.x + b.y * b.y) + (b.z * b.z + b.w * b.w); }
                const float r0 = rsqrtf(wave_sum(s0) * (1.f / D) + EPS), r1 = rsqrtf(wave_sum(s1) * (1.f / D) + EPS);
#pragma unroll
                for (int j = 0; j < 4; ++j) { const f32x4 g2 = ((const f32x4*)P.in[I_G2])[lane + 64 * j]; const f32x4 a = h[2 * tp][j] * r0 * g2, b = h[2 * tp + 1][j] * r1 * g2;
                    ((unsigned*)(H2 + (size_t)(t0 + 2 * tp) * D))[lane + 64 * j] = pk4_fp8(a.x, a.y, a.z, a.w);
                    ((unsigned*)(H2 + (size_t)(t0 + 2 * tp + 1) * D))[lane + 64 * j] = pk4_fp8(b.x, b.y, b.z, b.w);
#pragma unroll
                    for (int c = 0; c < 4; ++c) { const f32x2 pr = {a[c], b[c]}; if (tp == 0) ha[j][c] = pr; else hb[j][c] = pr; } }
            }
            f32x2 v[64];
#pragma unroll
            for (int e = 0; e < NE; ++e) { f32x2 a0 = {0.f, 0.f}, a1 = {0.f, 0.f};
                f32x4 w[4];
#pragma unroll
                for (int j = 0; j < 4; ++j) w[j] = ((const LAS f32x4*)(lds + e * 4096))[lane + 64 * j];
#pragma unroll
                for (int j = 0; j < 4; ++j)
#pragma unroll
                    for (int c = 0; c < 4; ++c) { const f32x2 ww = {w[j][c], w[j][c]}; a0 += ha[j][c] * ww; a1 += hb[j][c] * ww; }
                v[e] = a0; v[32 + e] = a1; }
#pragma unroll
            for (int half = 32; half >= 1; half >>= 1) { const bool upper = (lane & half) != 0;
#pragma unroll
                for (int i = 0; i < half; ++i) { const f32x2 send = upper ? v[i] : v[i + half], keep = upper ? v[i + half] : v[i]; const f32x2 got = {__shfl_xor(send.x, half), __shfl_xor(send.y, half)}; v[i] = keep + got; } }
            const float br = P.in[I_BR][lane & 31]; const int tl = wid * 8 + pass * 4 + 2 * (lane >> 5);
            lg[tl * 33 + (lane & 31)] = v[0].x + br; lg[(tl + 1) * 33 + (lane & 31)] = v[0].y + br;
        }
        __syncthreads();
        if (wid == 0) {
            const int tok = tb * 64 + lane;
            float tv[4]; int ti[4];
#pragma unroll
            for (int k = 0; k < 4; ++k) { tv[k] = -INFINITY; ti[k] = 0; }
            for (int e = 0; e < NE; ++e) { const float x = lg[lane * 33 + e];
                if (x > tv[3]) { if (x > tv[2]) { tv[3] = tv[2]; ti[3] = ti[2]; if (x > tv[1]) { tv[2] = tv[1]; ti[2] = ti[1]; if (x > tv[0]) { tv[1] = tv[0]; ti[1] = ti[0]; tv[0] = x; ti[0] = e; } else { tv[1] = x; ti[1] = e; } } else { tv[2] = x; ti[2] = e; } } else { tv[3] = x; ti[3] = e; } } }
            const float e1 = __expf(tv[1] - tv[0]), e2 = __expf(tv[2] - tv[0]), e3 = __expf(tv[3] - tv[0]); const float inv = 1.f / (1.f + e1 + e2 + e3);
            const float gk[4] = {inv, e1 * inv, e2 * inv, e3 * inv};
            int lp[4];
#pragma unroll
            for (int k = 0; k < 4; ++k) lp[k] = atomicAdd((int*)&hist[ti[k]], 1);
            asm volatile("s_waitcnt lgkmcnt(0)" ::: "memory");
            { const int l2 = opaque_tid() & 63;
              if (l2 < NE) { const int n = hist[l2]; hist[32 + l2] = n ? (int)atomicAdd((unsigned*)(P.ws + WS_CTL) + CW_CNT + l2, (unsigned)n) : 0; } }
            asm volatile("s_waitcnt vmcnt(0) lgkmcnt(0)" ::: "memory");
#pragma unroll
            for (int k = 0; k < 4; ++k) { const int e = ti[k], pos = hist[32 + e] + lp[k];
                slot_tok[(size_t)e * CAP + pos] = tok; slot_gate[(size_t)e * CAP + pos] = gk[k]; tok_ep[tok * 4 + k] = (e << 16) | pos; }
        }
        __syncthreads();
    }
}

#ifndef COMB_Y_DEFAULT
#define COMB_Y_LOAD(p) NT_LOAD(p)
#else
#define COMB_Y_LOAD(p) (*(p))
#endif
__device__ __forceinline__ void combine_phase(const Params& P, LAS unsigned char* lds, int vcu, int G) {
    const int tid = opaque_tid(), lane = tid & 63, wid = __builtin_amdgcn_readfirstlane(tid >> 6);
    const LAS int* tab = (const LAS int*)(lds + pg::TAB_OFF);
    const int* tok_ep = (const int*)(P.ws + WS_TOK_EP); const bf16_t* Y = (const bf16_t*)(P.ws + WS_Y); const float* sgate = (const float*)(P.ws + WS_SLOT_GATE);
    for (int tok = (vcu * NWAVES + wid) * 2; tok < T; tok += G * NWAVES * 2) {
        f32x4 a[2][4]; u32x2 xr[2][4]; u32x2 yv[2][4][4]; float gk[2][4];
#pragma unroll
        for (int tt = 0; tt < 2; ++tt) {
#pragma unroll
            for (int j = 0; j < 4; ++j) xr[tt][j] = NT_LOAD((const u32x2*)((const bf16_t*)(P.ws + WS_X1) + (size_t)(tok + tt) * D) + lane + 64 * j);
#pragma unroll
            for (int k = 0; k < 4; ++k) { const int ep = tok_ep[(tok + tt) * 4 + k]; const int slot = tab[ep >> 16] * 256 + (ep & 0xffff); gk[tt][k] = sgate[(size_t)(ep >> 16) * CAP + (ep & 0xffff)];
#pragma unroll
                for (int j = 0; j < 4; ++j) yv[tt][k][j] = COMB_Y_LOAD((const u32x2*)(Y + (size_t)slot * D) + lane + 64 * j); } }
        asm volatile("" ::: "memory");
#pragma unroll
        for (int tt = 0; tt < 2; ++tt) {
#pragma unroll
            for (int j = 0; j < 4; ++j) a[tt][j] = (f32x4){bflo(xr[tt][j].x), bfhi(xr[tt][j].x), bflo(xr[tt][j].y), bfhi(xr[tt][j].y)};
#pragma unroll
            for (int k = 0; k < 4; ++k)
#pragma unroll
                for (int j = 0; j < 4; ++j) { const u32x2 w = yv[tt][k][j]; a[tt][j] += gk[tt][k] * (f32x4){bflo(w.x), bfhi(w.x), bflo(w.y), bfhi(w.y)}; }
#pragma unroll
            for (int j = 0; j < 4; ++j) NT_STORE(a[tt][j], (f32x4*)(P.out + (size_t)(tok + tt) * D) + lane + 64 * j); }
    }
}
#define XB_TMO      128
#define XB_XCNT(j)  (256  + 64 * (j))
#define XB_XSUB(j)  (1280 + 64 * (j))
#define XB_XGEN(j)  (2304 + 64 * (j))
#define XB_TOP      3328
#define XB_TOPGEN   3392
#define XCD_BAR_WORDS 3456
#define XB_SPIN_CAP (1u << 18)
__device__ __forceinline__ unsigned xb_ld(unsigned* p)              { return __hip_atomic_load(p, __ATOMIC_RELAXED, __HIP_MEMORY_SCOPE_AGENT); }
__device__ __forceinline__ unsigned xb_add(unsigned* p, unsigned v) { return __hip_atomic_fetch_add(p, v, __ATOMIC_RELAXED, __HIP_MEMORY_SCOPE_AGENT); }
__device__ __forceinline__ unsigned xb_xcc_id() { return (unsigned)__builtin_amdgcn_s_getreg((3 << 11) | 20) & 0xFu; }
#define XB_SPIN(cond, bar) do { unsigned _sp = 0; while (cond) { __builtin_amdgcn_s_sleep(1); \
    if ((++_sp & 255u) == 0u) { if (xb_ld(&(bar)[XB_TMO])) break; if (_sp > XB_SPIN_CAP) { atomicAdd(&(bar)[XB_TMO], 1u); break; } } } } while (0)
struct XcdBarrier { unsigned* bar; unsigned x; volatile LAS unsigned* st; };
__device__ __forceinline__ XcdBarrier xcd_barrier_post(unsigned* bar, volatile LAS unsigned* st) {
    XcdBarrier b; b.bar = bar; b.x = xb_xcc_id(); b.st = st;
    if (threadIdx.x == 0) (void)xb_add(&bar[XB_XCNT(b.x)], 1u);
    return b;
}
__device__ __forceinline__ void xcd_barrier_complete(unsigned* bar, unsigned x, unsigned& nloc, unsigned& nx) {
    const unsigned G = gridDim.x * gridDim.y * gridDim.z;
    unsigned sum, cnt, mine, sp = 0u;
    for (;;) {
        sum = 0u; cnt = 0u; mine = 0u;
#pragma unroll
        for (unsigned j = 0; j < 16; ++j) { const unsigned c = xb_ld(&bar[XB_XCNT(j)]); sum += c; cnt += (c > 0u) ? 1u : 0u; mine = (j == x) ? c : mine; }
        if (sum == G) break;
        __builtin_amdgcn_s_sleep(1);
        if ((++sp & 255u) == 0u) { if (xb_ld(&bar[XB_TMO])) break; if (sp > XB_SPIN_CAP) { atomicAdd(&bar[XB_TMO], 1u); break; } }
    }
    nloc = mine > 0u ? mine : 1u; nx = cnt > 0u ? cnt : 1u;
}
__device__ __forceinline__ void xcd_barrier(const XcdBarrier& b) {
    asm volatile("s_waitcnt vmcnt(0)" ::: "memory");
    __syncthreads();
    if (threadIdx.x == 0) {
        unsigned* bar = b.bar;
        __builtin_amdgcn_s_waitcnt(0);
        unsigned nloc = b.st[0], nx = b.st[1];
        if (nloc == 0u) { xcd_barrier_complete(bar, b.x, nloc, nx); b.st[0] = nloc; b.st[1] = nx; }
        const unsigned old = xb_add(&bar[XB_XSUB(b.x)], 1u);
        const unsigned gen = old / nloc;
        if (old + 1u == (gen + 1u) * nloc) {
            __builtin_amdgcn_fence(__ATOMIC_RELEASE, "agent");
            asm volatile("s_waitcnt vmcnt(0)" ::: "memory");
            const unsigned og = xb_add(&bar[XB_TOP], 1u);
            const unsigned tg = og / nx;
            if (og + 1u == (tg + 1u) * nx) xb_add(&bar[XB_TOPGEN], 1u);
            else XB_SPIN(xb_ld(&bar[XB_TOPGEN]) == tg, bar);
            __builtin_amdgcn_fence(__ATOMIC_ACQUIRE, "agent");
            xb_add(&bar[XB_XGEN(b.x)], 1u);
            asm volatile("s_waitcnt vmcnt(0)" ::: "memory");
        } else {
            XB_SPIN(xb_ld(&bar[XB_XGEN(b.x)]) == gen, bar);
            __builtin_amdgcn_fence(__ATOMIC_ACQUIRE, "agent");
            asm volatile("s_waitcnt vmcnt(0)" ::: "memory");
        }
    }
    __syncthreads();
}
#ifndef PH_MASK
#define PH_MASK 0xffffffffu
#endif
__global__ void __launch_bounds__(NTHREADS, 2) mega_fwd(Params P) {
    extern __shared__ __attribute__((aligned(16))) unsigned char lds_[];
    LAS unsigned char* lds = (LAS unsigned char*)lds_;
    const int tid = threadIdx.x;
    const int G = gridDim.x, bx = blockIdx.x, vcu = (G % 8 == 0) ? (bx % 8) * (G / 8) + bx / 8 : bx;
    for (int u = tid; u < (LDS_BYTES - RING_BYTES) / 4; u += NTHREADS) ((LAS unsigned*)(lds + RING_BYTES))[u] = 0u;
    __syncthreads();
    unsigned* ctl = (unsigned*)(P.ws + WS_CTL);
    const XcdBarrier bar = xcd_barrier_post(ctl + CW_BAR, (volatile LAS unsigned*)(lds + MISC_OFF) + 8);
#ifndef PH_REP
#define PH_REP 0u
#endif
#ifndef BAR_REP
#define BAR_REP 1
#endif
#define GRID_BAR() do { for (int b_ = 0; b_ < BAR_REP; ++b_) xcd_barrier(bar); } while (0)
#define ON(k) for (int r_ = 0; r_ < 1 + (int)((PH_REP >> (k)) & 1u); ++r_) if ((PH_MASK >> (k)) & 1u)
#ifndef FWD_REP
#define FWD_REP 1
#endif
    for (int fwd_ = 0; fwd_ < FWD_REP; ++fwd_) {
    if (fwd_ > 0) { GRID_BAR(); if (bx == 0 && tid < 64) ctl[CW_CNT + tid] = 0u; }
    ON(0) p0_prologue(P, lds, vcu, G);
    GRID_BAR();
    ON(1) { pg::DenseSched S; S.init((const bf16_t*)(P.ws + WS_XN), D, (const bf16_t*)(P.ws + WS_WIN_T), D, T, IN_W, G, bx);
        pg::EpiInProj E; E.ws = P.ws; E.qg = P.in[I_QG]; E.kg = P.in[I_KG];
#if defined(PROBE_NULL_EPI)
        if (r_ == 1) { pg::EpiNull EN; pg::gemm_phase(lds, S, EN, D / 64, D); } else
#endif
#ifndef INPROJ_BAUX
#define INPROJ_BAUX 0
#endif
        pg::gemm_phase<false, INPROJ_BAUX>(lds, S, E, D / 64, D);
#if EXPERTS_IN_ATTN
        if (r_ == 0 && G == 256 && bx >= 128) expert_convert_slice(P, lds, EXP_IN0 + (bx - 128) * EXP_N_IN, EXP_IN0 + (bx - 127) * EXP_N_IN);
        __syncthreads();
#endif
    }
    GRID_BAR();
    ON(2) { ssm_toeplitz_expand(P, vcu, G); ssm1_phase(P, lds, vcu, G); }
    ON(3) attn_phase(P, (char*)lds_, vcu, G);
    GRID_BAR();
    ON(4) { pg::Ssm2Sched S; S.init(P.ws, G, bx); pg::EpiSsm2 E; E.ws = P.ws; pg::gemm_phase(lds, S, E, ACAT_LD / 64, ACAT_LD);
#if EXPERTS_IN_ATTN
        if (r_ == 0 && G == 256 && bx >= 128) expert_convert_slice(P, lds, EXP_S20 + (bx - 128) * EXP_N_S2, EXP_S20 + (bx - 127) * EXP_N_S2);
        __syncthreads();
#endif
    }
    GRID_BAR();
    ON(5) { pg::DenseSched S; S.init((const bf16_t*)(P.ws + WS_Z), SSM_W, (const bf16_t*)(P.ws + WS_WGLU_T), SSM_W, T, SSM_W, G, bx);
        pg::EpiGlu E; E.ws = P.ws; E.bglu = P.in[I_BGLU]; pg::gemm_phase(lds, S, E, SSM_W / 64, SSM_W);
#if EXPERTS_IN_ATTN
        if (r_ == 0 && G == 256 && bx >= 128) expert_convert_slice(P, lds, EXP_GLU0 + (bx - 128) * EXP_N_GLU, EXP_GLU0 + (bx - 127) * EXP_N_GLU);
        __syncthreads();
#endif
    }
    GRID_BAR();
    ON(6) { pg::DenseSched S; S.init((const bf16_t*)(P.ws + WS_MA), MA_LD, (const bf16_t*)(P.ws + WS_WP_T), MA_LD, T, D, G, bx);
        pg::EpiMerged E; E.ws = P.ws; pg::gemm_phase(lds, S, E, MA_LD / 64, MA_LD); }
    GRID_BAR();
    ON(7) { pg::DenseSched S; S.init((const bf16_t*)(P.ws + WS_MERGED), D, (const bf16_t*)(P.ws + WS_WOUT_T), D, T, D, G, bx);
        pg::EpiWout E; E.x = P.in[I_X]; E.out = (bf16_t*)(P.ws + WS_X1); pg::gemm_phase(lds, S, E, D / 64, D); }
    GRID_BAR();
    ON(8) router_phase(P, lds, vcu, G);
    GRID_BAR();
    pg::moe_build_tab(lds, (const unsigned*)(P.ws + WS_CTL) + CW_CNT);
    ON(9) { pg::MoeSched<1> S; S.init(P.ws, lds, G, bx, P.in[I_B1]); pg::EpiMoe1 E; E.ws = P.ws; E.b1 = P.in[I_B1]; E.lds = lds; E.nostore = (r_ == 1);
#if defined(PROBE_MOE_NT)
        if (r_ == 1) { pg::EpiNull EN; pg::gemm_phase<true>(lds, S, EN, PROBE_MOE_NT, D / 2, 7); } else
#endif
        pg::gemm_phase<true>(lds, S, E, D / 128, D / 2);
#if EXPERTS_IN_ATTN
        if (r_ == 0 && G == 256 && (bx >> 3) >= 16) { const int k_ = (bx & 7) * 16 + (bx >> 3) - 16; expert_convert_slice(P, lds, EXP_M10 + k_ * EXP_N_M1, EXP_M10 + (k_ + 1) * EXP_N_M1); }
        __syncthreads();
#endif
    }
    GRID_BAR();
    ON(10) { pg::MoeSched<2> S; S.init(P.ws, lds, G, bx, P.in[I_B2]);
#if defined(PROBE_FREEZE)
        S.freeze = (r_ == 1);
#endif
 pg::EpiMoe2 E; E.ws = P.ws; E.b2 = P.in[I_B2]; E.lds = lds; E.nostore = (r_ == 1);
#if defined(PROBE_MOE_NT)
        if (r_ == 1) { pg::EpiNull EN; pg::gemm_phase<true>(lds, S, EN, PROBE_MOE_NT, DFF / 2, 7); } else
#endif
        pg::gemm_phase<true>(lds, S, E, DFF / 128, DFF / 2); }
    GRID_BAR();
    ON(11) combine_phase(P, lds, vcu, G);
    }
#undef ON
}

extern "C" void kernel_launch(void* const* d_in, const int* in_sizes, int n_in, void* d_out, int out_size, void* d_ws, size_t ws_size, hipStream_t stream) {
    static int grid = 0;
    if (grid == 0) {
        int dev = 0, cus = 0, per_cu = 0;
        if (hipGetDevice(&dev) != hipSuccess || hipDeviceGetAttribute(&cus, hipDeviceAttributeMultiprocessorCount, dev) != hipSuccess) { fprintf(stderr, "kernel_launch: device query failed\n"); grid = -1; return; }
        if (hipFuncSetAttribute((const void*)mega_fwd, hipFuncAttributeMaxDynamicSharedMemorySize, LDS_BYTES) != hipSuccess) { fprintf(stderr, "kernel_launch: hipFuncSetAttribute failed\n"); grid = -1; return; }
        if (hipOccupancyMaxActiveBlocksPerMultiprocessor(&per_cu, (const void*)mega_fwd, NTHREADS, LDS_BYTES) != hipSuccess || per_cu < 1) { fprintf(stderr, "kernel_launch: occupancy query reports %d workgroups per CU\n", per_cu); per_cu = 1; }
        (void)hipGetLastError();
        grid = cus;
        if (ws_size < WS_END) { fprintf(stderr, "kernel_launch: workspace too small\n"); grid = -1; return; }
    }
    if (grid < 0) return;
    hipMemsetAsync((char*)d_ws + WS_CTL, 0, CTL_ZERO_BYTES, stream);
    Params P{};
    for (int i = 0; i < 30; ++i) P.in[i] = (const float*)d_in[i];
    P.out = (float*)d_out; P.ws = (unsigned char*)d_ws;
    hipLaunchKernelGGL(mega_fwd, dim3(grid), dim3(NTHREADS), LDS_BYTES, stream, P);
#if defined(PROBE_TWO_LAUNCHES)
    hipMemsetAsync((char*)d_ws + WS_CTL, 0, CTL_ZERO_BYTES, stream);
    hipLaunchKernelGGL(mega_fwd, dim3(grid), dim3(NTHREADS), LDS_BYTES, stream, P);
#endif
}
```

```cpp
#include <hip/hip_runtime.h>
#include <hip/hip_bf16.h>
#include <stdint.h>
#include <math.h>
#include <cstdio>

constexpr int D = 1024, BATCH = 8, SEQ = 2048, T = BATCH * SEQ;
constexpr int SSM_W = 512, SSM_H = 16, SSM_G = 32, SSM_P = 64;
constexpr int CH_L = 32, NCH = SEQ / CH_L;
constexpr int ACAT_ROWS = BATCH * NCH;
constexpr int ACAT_LD = CH_L * SSM_H + 2 * SSM_P;
constexpr int AH = 8, AW = 1024;
constexpr int IN_W = 5632;
constexpr int NE = 32, DFF = 1024;
constexpr float EPS = 1e-5f;
constexpr int OFF_U = 0, OFF_Q = 512, OFF_K = 1536, OFF_V = 2560, OFF_GS = 3584, OFF_GA = 4608;
constexpr int CAP = T;
constexpr int MAXBLK = 288;
constexpr float QC2 = 0.125f * 1.4426950408889634f;
constexpr int MA_LD = 1536;

constexpr size_t MiB = 1u << 20;
constexpr size_t WS_CTL = 0, CTL_ZERO_BYTES = 64 * 1024;
constexpr size_t WS_WIN_T = 2 * MiB;
constexpr size_t WS_WGLU_T = 13 * MiB;
constexpr size_t WS_WP_T = 14 * MiB;
constexpr size_t WS_WOUT_T = 17 * MiB;
constexpr size_t WS_WR_T = 19 * MiB;
constexpr size_t WS_KJ = 21 * MiB;
constexpr size_t WS_WS_T = 22 * MiB;
constexpr size_t WS_BT_SSM = 26 * MiB;
constexpr size_t WS_W1_T = 48 * MiB;
constexpr size_t WS_W2_T = 176 * MiB;
constexpr size_t WS_XN = 240 * MiB;
constexpr size_t WS_ACAT = 272 * MiB;
constexpr size_t WS_Q = 292 * MiB, WS_K = 324 * MiB, WS_V = 356 * MiB;
constexpr size_t WS_GS = 388 * MiB, WS_GA = 420 * MiB;
constexpr size_t WS_X1 = 292 * MiB;
constexpr size_t WS_Z = 452 * MiB;
constexpr size_t WS_MA = 468 * MiB;
constexpr size_t WS_MERGED = 516 * MiB;
constexpr size_t WS_H2 = 548 * MiB;
constexpr size_t WS_SLOT_TOK = 582 * MiB;
constexpr size_t WS_SLOT_GATE = 584 * MiB;
constexpr size_t WS_TOK_EP = 586 * MiB;
constexpr size_t WS_ACT = 588 * MiB;
constexpr size_t WS_Y = 732 * MiB;
constexpr size_t WS_END = 876 * MiB;
constexpr int CW_CNT = 64;
constexpr int CW_BAR = 4096;

typedef unsigned short bf16_t;
typedef short bf16x8 __attribute__((ext_vector_type(8)));
typedef float f32x4 __attribute__((ext_vector_type(4)));
typedef float f32x2 __attribute__((ext_vector_type(2)));
typedef unsigned u32x4 __attribute__((ext_vector_type(4)));
typedef unsigned u32x2 __attribute__((ext_vector_type(2)));
#define LAS __attribute__((address_space(3)))
#define GAS __attribute__((address_space(1)))

__device__ __forceinline__ float wave_sum(float v) {
#pragma unroll
    for (int o = 1; o < 64; o <<= 1) v += __shfl_xor(v, o);
    return v;
}
typedef __bf16 bf16x2_hw __attribute__((ext_vector_type(2)));
__device__ __forceinline__ unsigned pk2(float lo, float hi) { const f32x2 v = {lo, hi}; return __builtin_bit_cast(unsigned, __builtin_convertvector(v, bf16x2_hw)); }
__device__ __forceinline__ unsigned f2bf(float f) { return pk2(f, 0.f) & 0xffffu; }
__device__ __forceinline__ float bf2f(unsigned short b) { return __builtin_bit_cast(float, (unsigned)b << 16); }
__device__ __forceinline__ float bflo(unsigned w) { return __builtin_bit_cast(float, w << 16); }
__device__ __forceinline__ float bfhi(unsigned w) { return __builtin_bit_cast(float, w & 0xffff0000u); }
__device__ __forceinline__ float sigmoid_f(float x) { return __builtin_amdgcn_rcpf(1.f + __expf(-x)); }
__device__ __forceinline__ float sigmoid_c(float x) { x = fminf(fmaxf(x, -30.f), 30.f); return __builtin_amdgcn_rcpf(1.f + __expf(-x)); }
__device__ __forceinline__ float gelu_tanh(float x) { const float u = 0.7978845608028654f * (x + 0.044715f * x * x * x); return x * sigmoid_f(2.f * u); }

__device__ __forceinline__ unsigned pk4_fp8(float a, float b, float cc, float d) { int w = 0; w = __builtin_amdgcn_cvt_pk_fp8_f32(a, b, w, false); w = __builtin_amdgcn_cvt_pk_fp8_f32(cc, d, w, true); return (unsigned)w; }
__device__ __forceinline__ void unpk4_fp8(unsigned w, float& a, float& b, float& cc, float& d) { const f32x2 lo = __builtin_amdgcn_cvt_pk_f32_fp8((int)w, false), hi = __builtin_amdgcn_cvt_pk_f32_fp8((int)w, true); a = lo.x; b = lo.y; cc = hi.x; d = hi.y; }
constexpr float W8_SCALE = 64.f;
#ifndef WT_STORES
#define WT_STORES 0
#endif
__device__ __forceinline__ void store16(void* p, const u32x4 v) {
#if WT_STORES
    asm volatile("global_store_dwordx4 %0, %1, off sc1\n\ts_nop 1" :: "v"(p), "v"(v) : "memory");
#else
    *(u32x4*)p = v;
#endif
}
#ifndef NT_STREAMS
#define NT_STREAMS 1
#endif
#if NT_STREAMS
#define NT_LOAD(p) __builtin_nontemporal_load(p)
#define NT_STORE(v, p) __builtin_nontemporal_store((v), (p))
#else
#define NT_LOAD(p) (*(p))
#define NT_STORE(v, p) (*(p) = (v))
#endif
__device__ __forceinline__ int opaque_tid() { int t = threadIdx.x; asm volatile("" : "+v"(t)); return t; }

struct Params {
    const float* in[30];
    float* out;
    unsigned char* ws;
};
enum { I_X = 0, I_G1, I_WIN, I_LRE, I_LIM, I_LOGDT, I_BRE, I_BIM, I_CRE, I_CIM, I_DSK, I_WGLU, I_BGLU, I_QG, I_KG, I_LQ1, I_LK1, I_LQ2, I_LK2, I_SG, I_WPS, I_WPA, I_WOUT, I_G2, I_WR, I_BR, I_W1, I_B1, I_W2, I_B2 };

constexpr int NWAVES = 8, NTHREADS = 512;
constexpr int LDS_BYTES = 147456;
constexpr int RING_BYTES = 131072;
constexpr int MISC_OFF = RING_BYTES + 320;
__device__ __forceinline__ void p0_transpose_item(const float* __restrict__ W, int N, bf16_t* __restrict__ WT, int ldo, int k_off, LAS float* scr, int kb, int nb, int lane) {
    const int k0 = 64 * kb, n0 = 32 * nb;
    { f32x4 v[8];
#pragma unroll
        for (int i = 0; i < 8; ++i) v[i] = NT_LOAD((const f32x4*)(W + (size_t)(k0 + 8 * i + (lane >> 3)) * N + n0 + (lane & 7) * 4));
#pragma unroll
        for (int i = 0; i < 8; ++i) { LAS float* d = scr + (8 * i + (lane >> 3)) * 33 + (lane & 7) * 4; d[0] = v[i].x; d[1] = v[i].y; d[2] = v[i].z; d[3] = v[i].w; } }
    asm volatile("s_waitcnt lgkmcnt(0)" ::: "memory");
    const int c = lane & 7;
#pragma unroll
    for (int j = 0; j < 4; ++j) { const int n = (lane >> 3) + 8 * j; const LAS float* s = scr + (8 * c) * 33 + n;
        u32x4 o; o.x = pk2(s[0 * 33], s[1 * 33]); o.y = pk2(s[2 * 33], s[3 * 33]); o.z = pk2(s[4 * 33], s[5 * 33]); o.w = pk2(s[6 * 33], s[7 * 33]);
        *(u32x4*)(WT + (size_t)(n0 + n) * ldo + k_off + k0 + 8 * c) = o; }
    asm volatile("s_waitcnt lgkmcnt(0)" ::: "memory");
}
__device__ __forceinline__ void p0_transpose_item_fp8(const float* __restrict__ W, int N, unsigned char* __restrict__ WT, int ldo, LAS float* scr, int kb, int nb, int lane) {
    const int k0 = 64 * kb, n0 = 32 * nb;
    { f32x4 v[8];
#pragma unroll
        for (int i = 0; i < 8; ++i) v[i] = NT_LOAD((const f32x4*)(W + (size_t)(k0 + 8 * i + (lane >> 3)) * N + n0 + (lane & 7) * 4));
#pragma unroll
        for (int i = 0; i < 8; ++i) { LAS float* d = scr + (8 * i + (lane >> 3)) * 33 + (lane & 7) * 4; d[0] = v[i].x; d[1] = v[i].y; d[2] = v[i].z; d[3] = v[i].w; } }
    asm volatile("s_waitcnt lgkmcnt(0)" ::: "memory");
    const int n = lane >> 1, half = lane & 1; const LAS float* s = scr + (32 * half) * 33 + n;
    unsigned o[8];
#pragma unroll
    for (int q = 0; q < 8; ++q) o[q] = pk4_fp8(s[(4 * q) * 33] * W8_SCALE, s[(4 * q + 1) * 33] * W8_SCALE, s[(4 * q + 2) * 33] * W8_SCALE, s[(4 * q + 3) * 33] * W8_SCALE);
    u32x4* dst = (u32x4*)(WT + (size_t)(n0 + n) * ldo + k0 + 32 * half);
    dst[0] = (u32x4){o[0], o[1], o[2], o[3]}; dst[1] = (u32x4){o[4], o[5], o[6], o[7]};
    asm volatile("s_waitcnt lgkmcnt(0)" ::: "memory");
}
__device__ __forceinline__ void p0_transpose_f32_item(const float* __restrict__ W, float* __restrict__ WT, int K, LAS float* scr, int kb, int lane) {
    const int k0 = 64 * kb;
#pragma unroll 8
    for (int i = 0; i < 32; ++i) { const int kk = 2 * i + (lane >> 5); scr[kk * 33 + (lane & 31)] = W[(size_t)(k0 + kk) * 32 + (lane & 31)]; }
    asm volatile("s_waitcnt lgkmcnt(0)" ::: "memory");
#pragma unroll 8
    for (int n = 0; n < 32; ++n) WT[(size_t)n * K + k0 + lane] = scr[lane * 33 + n];
    asm volatile("s_waitcnt lgkmcnt(0)" ::: "memory");
}
__device__ __forceinline__ void rms_row_to_bf16(const float* __restrict__ xrow, const float* __restrict__ g, bf16_t* __restrict__ orow, int lane) {
    const f32x4* xr = (const f32x4*)xrow + lane; const f32x4* gr = (const f32x4*)g + lane;
    f32x4 v[4]; float s = 0.f;
#pragma unroll
    for (int j = 0; j < 4; ++j) { v[j] = NT_LOAD(xr + 64 * j); s += (v[j].x * v[j].x + v[j].y * v[j].y) + (v[j].z * v[j].z + v[j].w * v[j].w); }
    const float r = rsqrtf(wave_sum(s) * (1.f / D) + EPS);
    u32x2* o8 = (u32x2*)orow + lane;
#pragma unroll
    for (int j = 0; j < 4; ++j) { const f32x4 gg = gr[64 * j]; u32x2 w; w.x = pk2(v[j].x * r * gg.x, v[j].y * r * gg.y); w.y = pk2(v[j].z * r * gg.z, v[j].w * r * gg.w); o8[64 * j] = w; }
}
struct SsmGP { float lrdt, lidt, cr, ci; };
__device__ __forceinline__ SsmGP ssm_gp(const Params& P, int g, int p) {
    const float dt = expf(P.in[I_LOGDT][g]);
    const float lr = fminf(P.in[I_LRE][g * SSM_P + p], -1e-4f), li = P.in[I_LIM][g * SSM_P + p];
    const float mag = expf(lr * dt);
    float sn, cs; sincosf(li * dt, &sn, &cs);
    const float ar = mag * cs, ai = mag * sn;
    const float den = lr * lr + li * li, nr = ar - 1.f;
    SsmGP r; r.lrdt = lr * dt; r.lidt = li * dt; r.cr = (nr * lr + ai * li) / den; r.ci = (ai * lr - nr * li) / den;
    return r;
}
__device__ __forceinline__ void ssm_pow(const SsmGP& q, int j, float& pr, float& pi) {
    const float m = expf((float)j * q.lrdt); float sn, cs; sincosf((float)j * q.lidt, &sn, &cs); pr = m * cs; pi = m * sn;
}

#ifndef EXP_DMA_AUX
#define EXP_DMA_AUX 2
#endif
struct ExpItem { const float* W; unsigned char* WT; int N, ldo, kb, nb, sw; };
__device__ __forceinline__ ExpItem exp_item(const Params& P, int it) {
    constexpr int I_E1 = (1024 / 128) * (2048 / 32), I_E2 = (1024 / 128) * (1024 / 32);
    ExpItem x;
    if (it < NE * I_E1) { const int e = it / I_E1, q = it % I_E1; x.W = P.in[I_W1] + (size_t)e * D * 2 * DFF; x.WT = P.ws + WS_W1_T + (size_t)e * 2 * DFF * D; x.N = 2 * DFF; x.ldo = D; x.kb = q / 64; x.nb = q % 64; x.sw = 3; }
    else { const int r = it - NE * I_E1, e = r / I_E2, q = r % I_E2; x.W = P.in[I_W2] + (size_t)e * DFF * D; x.WT = P.ws + WS_W2_T + (size_t)e * D * DFF; x.N = D; x.ldo = DFF; x.kb = q / 32; x.nb = q % 32; x.sw = 0; }
    return x;
}
__device__ __forceinline__ void exp_dma(const ExpItem& x, int lane, LAS unsigned char* buf) {
    const float* src = x.W + (size_t)(128 * x.kb + (lane >> 3)) * x.N + 32 * x.nb;
#pragma unroll
    for (int i = 0; i < 16; ++i) __builtin_amdgcn_global_load_lds((const unsigned*)(src + (size_t)(8 * i) * x.N + ((((lane & 7) ^ (lane >> 3) ^ (i >> 1)) & 7) << 2)), (LAS unsigned*)(buf + i * 1024), 16, 0, EXP_DMA_AUX);
}
#if defined(PROBE_CONV_NOSTORE)
#define g_conv_nostore nostore_
__device__ __forceinline__ void exp_finish_lds(const ExpItem& x, int lane, const LAS unsigned char* buf, bool nostore_ = false) {
#else
__device__ __forceinline__ void exp_finish_lds(const ExpItem& x, int lane, const LAS unsigned char* buf) {
#endif
    const int c = lane & 7;
#pragma unroll
    for (int pass = 0; pass < 4; ++pass) {
        const int n = 8 * pass + (lane >> 3), q0 = (n >> 2) ^ c;
        const int no = n ^ ((((n >> 1) ^ n) & 1) ? x.sw : 0);
        const LAS unsigned char* rb = buf + c * 2048 + ((n & 3) << 2);
        float f[16];
#pragma unroll
        for (int j = 0; j < 16; ++j) f[j] = *(const LAS float*)(rb + j * 128 + (((q0 ^ j) & 7) << 4)) * W8_SCALE;
        const u32x4 o = (u32x4){pk4_fp8(f[0], f[1], f[2], f[3]), pk4_fp8(f[4], f[5], f[6], f[7]), pk4_fp8(f[8], f[9], f[10], f[11]), pk4_fp8(f[12], f[13], f[14], f[15])};
#if defined(PROBE_CONV_NOSTORE)
        if (g_conv_nostore) { asm volatile("" :: "v"(o)); } else
#endif
#if NT_STREAMS && !defined(CONV_ST_DEFAULT)
        __builtin_nontemporal_store(o, (u32x4*)(x.WT + (size_t)(32 * x.nb + no) * x.ldo + 128 * x.kb + 16 * c));
#else
        *(u32x4*)(x.WT + (size_t)(32 * x.nb + no) * x.ldo + 128 * x.kb + 16 * c) = o;
#endif
    }
    asm volatile("s_waitcnt lgkmcnt(0)" ::: "memory");
}
constexpr int EXP_ITEMS = NE * ((1024 / 128) * (2048 / 32) + (1024 / 128) * (1024 / 32));
constexpr int EXP_N_IN = 32, EXP_N_S2 = 20, EXP_N_GLU = 20, EXP_N_M1 = 0;
constexpr int EXP_IN0 = 0, EXP_S20 = 128 * EXP_N_IN, EXP_GLU0 = EXP_S20 + 128 * EXP_N_S2, EXP_ATT0 = EXP_GLU0 + 128 * EXP_N_GLU, EXP_M10 = EXP_ITEMS - 128 * EXP_N_M1;
static_assert((EXP_M10 - EXP_ATT0) % 256 == 0 && EXP_M10 >= NE * (1024 / 128) * (2048 / 32), "item split (the expert-GEMM-1 tail share must be W2 items only)");
__device__ __forceinline__ void expert_convert_slice(const Params& P, LAS unsigned char* lds, int i0, int i1, bool probe_nostore = false) {
    const int tid = opaque_tid(), lane = tid & 63, wave = __builtin_amdgcn_readfirstlane(tid >> 6);
    LAS unsigned char* b0 = lds + wave * 16384;
    for (int it = i0 + wave; it < i1; it += NWAVES) {
        const ExpItem c0 = exp_item(P, it);
        exp_dma(c0, lane, b0);
        asm volatile("s_waitcnt vmcnt(0)" ::: "memory");
#if defined(PROBE_CONV_NOSTORE)
        exp_finish_lds(c0, lane, b0, probe_nostore);
#else
        exp_finish_lds(c0, lane, b0);
#endif
    }
}
__device__ __forceinline__ void p0_prologue(const Params& P, LAS unsigned char* lds, int vcu, int G) {
    const int tid = opaque_tid(), lane = tid & 63, wave = __builtin_amdgcn_readfirstlane(tid >> 6);
    LAS float* scr = (LAS float*)(lds + wave * 16384);
    unsigned char* ws = P.ws;
    const int gw = vcu * NWAVES + wave, NGW = G * NWAVES;
    constexpr int I_IN = (D / 64) * (IN_W / 32);
    constexpr int I_GLU = (512 / 64) * (512 / 32);
    constexpr int I_PS = (512 / 64) * (1024 / 32);
    constexpr int I_PA = (1024 / 64) * (1024 / 32);
    constexpr int I_OUT = I_PA;
    constexpr int I_R = 1024 / 64;
    constexpr int I_E1 = (1024 / 64) * (2048 / 32);
    constexpr int I_E2 = (1024 / 64) * (1024 / 32);
#ifndef EXPERTS_IN_ATTN
#define EXPERTS_IN_ATTN 1
#endif
    constexpr int NITEMS = I_IN + I_GLU + I_PS + I_PA + I_OUT + I_R + (EXPERTS_IN_ATTN ? 0 : NE * I_E1 + NE * I_E2);
    for (int it = gw; it < NITEMS; it += NGW) {
        int r = it;
        if (r < I_IN) { const int nblk = IN_W / 32; p0_transpose_item(P.in[I_WIN], IN_W, (bf16_t*)(ws + WS_WIN_T), D, 0, scr, r / nblk, r % nblk, lane); continue; } r -= I_IN;
        if (r < I_GLU) { const int nblk = 512 / 32; p0_transpose_item(P.in[I_WGLU], 512, (bf16_t*)(ws + WS_WGLU_T), 512, 0, scr, r / nblk, r % nblk, lane); continue; } r -= I_GLU;
        if (r < I_PS) { const int nblk = 1024 / 32; p0_transpose_item(P.in[I_WPS], 1024, (bf16_t*)(ws + WS_WP_T), MA_LD, 1024, scr, r / nblk, r % nblk, lane); continue; } r -= I_PS;
        if (r < I_PA) { const int nblk = 1024 / 32; p0_transpose_item(P.in[I_WPA], 1024, (bf16_t*)(ws + WS_WP_T), MA_LD, 0, scr, r / nblk, r % nblk, lane); continue; } r -= I_PA;
        if (r < I_OUT) { const int nblk = 1024 / 32; p0_transpose_item(P.in[I_WOUT], 1024, (bf16_t*)(ws + WS_WOUT_T), D, 0, scr, r / nblk, r % nblk, lane); continue; } r -= I_OUT;
        if (r < I_R) { p0_transpose_f32_item(P.in[I_WR], (float*)(ws + WS_WR_T), D, scr, r, lane); continue; } r -= I_R;
        if (EXPERTS_IN_ATTN) continue;
        if (r < NE * I_E1) { const int e = r / I_E1, q = r % I_E1, nblk = 2048 / 32;
            p0_transpose_item_fp8(P.in[I_W1] + (size_t)e * D * 2 * DFF, 2 * DFF, ws + WS_W1_T + (size_t)e * 2 * DFF * D, D, scr, q / nblk, q % nblk, lane); continue; } r -= NE * I_E1;
        { const int e = r / I_E2, q = r % I_E2, nblk = 1024 / 32;
            p0_transpose_item_fp8(P.in[I_W2] + (size_t)e * DFF * D, D, ws + WS_W2_T + (size_t)e * D * DFF, DFF, scr, q / nblk, q % nblk, lane); }
    }
#if EXPERTS_IN_ATTN
    if (G != 256) { __syncthreads(); for (int c0 = vcu * 64; c0 < EXP_ATT0; c0 += G * 64) expert_convert_slice(P, lds, c0, min(EXP_ATT0, c0 + 64));
        for (int c0 = EXP_M10 + vcu * 64; c0 < EXP_ITEMS; c0 += G * 64) expert_convert_slice(P, lds, c0, min(EXP_ITEMS, c0 + 64)); __syncthreads(); }
#endif
    for (int m = gw; m < T; m += NGW) rms_row_to_bf16(P.in[I_X] + (size_t)m * D, P.in[I_G1], (bf16_t*)(ws + WS_XN) + (size_t)m * D, lane);
    if (gw == 0) { u32x4* z = (u32x4*)(ws + WS_H2 + (size_t)T * D); z[lane] = (u32x4){0u, 0u, 0u, 0u}; }
    const int gt = vcu * NTHREADS + tid, NGT = G * NTHREADS;
#ifndef TABLES_REP
#define TABLES_REP 1
#endif
    _Pragma("clang loop unroll(disable)") for (int trep = 0; trep < TABLES_REP; ++trep) {
#ifndef REP_II
#define REP_II 1
#define REP_III 1
#define REP_IV 1
#endif
    _Pragma("clang loop unroll(disable)") for (int r2 = 0; r2 < REP_II; ++r2)
    for (int it = vcu + G * wave; it < SSM_G * CH_L; it += NGW) {
        const int g = it / CH_L, j = it % CH_L, i16 = lane & 15, q = lane >> 4;
        { const SsmGP gp = ssm_gp(P, g, lane); float pr, pi; ssm_pow(gp, j, pr, pi); scr[2 * lane] = pr * gp.cr - pi * gp.ci; scr[2 * lane + 1] = pr * gp.ci + pi * gp.cr; }
        float cre[16], cim[16], brv[16], biv[16];
#pragma unroll
        for (int s4 = 0; s4 < 4; ++s4) { const f32x4 vr = *(const f32x4*)(P.in[I_CRE] + (g * SSM_H + i16) * SSM_P + 16 * s4 + 4 * q), vi = *(const f32x4*)(P.in[I_CIM] + (g * SSM_H + i16) * SSM_P + 16 * s4 + 4 * q);
#pragma unroll
            for (int c = 0; c < 4; ++c) { const int pp = 16 * s4 + 4 * q + c; cre[4 * s4 + c] = vr[c]; cim[4 * s4 + c] = vi[c];
                brv[4 * s4 + c] = P.in[I_BRE][(g * SSM_P + pp) * SSM_H + i16]; biv[4 * s4 + c] = P.in[I_BIM][(g * SSM_P + pp) * SSM_H + i16]; } }
        asm volatile("s_waitcnt lgkmcnt(0)" ::: "memory");
        f32x4 kacc = {0.f, 0.f, 0.f, 0.f};
#pragma unroll
        for (int s = 0; s < 16; ++s) { const int pp = 16 * (s >> 2) + 4 * q + (s & 3); const float wr = scr[2 * pp], wi = scr[2 * pp + 1];
            const float mr = cre[s] * wr - cim[s] * wi, mi = cre[s] * wi + cim[s] * wr;
            kacc = __builtin_amdgcn_mfma_f32_16x16x4f32(mr, brv[s], kacc, 0, 0, 0);
            kacc = __builtin_amdgcn_mfma_f32_16x16x4f32(-mi, biv[s], kacc, 0, 0, 0); }
#pragma unroll
        for (int r = 0; r < 4; ++r) { const int h = 4 * q + r; float v = kacc[r];
            if (j == 0 && h == i16) v += P.in[I_DSK][g * SSM_H + h];
            ((float*)(ws + WS_KJ))[((size_t)(g * CH_L + j) * SSM_H + h) * SSM_H + i16] = v; }
        asm volatile("s_waitcnt lgkmcnt(0)" ::: "memory");
    }
    _Pragma("clang loop unroll(disable)") for (int r3 = 0; r3 < REP_III; ++r3)
    for (int it = gt; it < SSM_G * 128 * CH_L; it += NGT) {
        const int s = it % CH_L, n = (it / CH_L) % 128, g = it / (CH_L * 128), p = n & 63, part = n >> 6;
        const SsmGP q = ssm_gp(P, g, p); float pr, pi; ssm_pow(q, CH_L - 1 - s, pr, pi);
        const float wr = pr * q.cr - pi * q.ci, wi = pr * q.ci + pi * q.cr;
        float br[16], bi[16];
#pragma unroll
        for (int q4 = 0; q4 < 4; ++q4) { const f32x4 vb = *(const f32x4*)(P.in[I_BRE] + (g * SSM_P + p) * SSM_H + 4 * q4), vi = *(const f32x4*)(P.in[I_BIM] + (g * SSM_P + p) * SSM_H + 4 * q4);
#pragma unroll
            for (int c = 0; c < 4; ++c) { br[4 * q4 + c] = vb[c]; bi[4 * q4 + c] = vi[c]; } }
        unsigned o[8];
#pragma unroll
        for (int h2 = 0; h2 < 8; ++h2) {
            float v0, v1;
            if (part == 0) { v0 = wr * br[2 * h2] - wi * bi[2 * h2]; v1 = wr * br[2 * h2 + 1] - wi * bi[2 * h2 + 1]; }
            else { v0 = wr * bi[2 * h2] + wi * br[2 * h2]; v1 = wr * bi[2 * h2 + 1] + wi * br[2 * h2 + 1]; }
            o[h2] = pk2(v0, v1);
        }
        u32x4* dst = (u32x4*)((bf16_t*)(ws + WS_WS_T) + ((size_t)(g * 128 + n) * 512 + s * 16));
        dst[0] = (u32x4){o[0], o[1], o[2], o[3]}; dst[1] = (u32x4){o[4], o[5], o[6], o[7]};
    }
    _Pragma("clang loop unroll(disable)") for (int r4 = 0; r4 < REP_IV; ++r4)
    for (int it = gt; it < SSM_G * CH_L * SSM_P; it += NGT) {
        const int p = it % SSM_P, t = (it / SSM_P) % CH_L, g = it / (SSM_P * CH_L);
        const SsmGP q = ssm_gp(P, g, p); float pr, pi; ssm_pow(q, t + 1, pr, pi);
        bf16_t* base = (bf16_t*)(ws + WS_BT_SSM) + ((size_t)(g * 512 + t * 16)) * ACAT_LD + 512 + p;
#pragma unroll
        for (int h = 0; h < SSM_H; ++h) {
            const float cre = P.in[I_CRE][(g * SSM_H + h) * SSM_P + p], cim = P.in[I_CIM][(g * SSM_H + h) * SSM_P + p];
            base[(size_t)h * ACAT_LD] = (bf16_t)f2bf(cre * pr - cim * pi);
            base[(size_t)h * ACAT_LD + 64] = (bf16_t)f2bf(-(cre * pi + cim * pr));
        }
    }
    }
}
__device__ __forceinline__ void ssm_toeplitz_expand(const Params& P, int vcu, int G) {
    const int gt = vcu * NTHREADS + opaque_tid(), NGT = G * NTHREADS;
    unsigned char* ws = P.ws;
    for (int it = gt; it < SSM_G * 512 * 64; it += NGT) {
        const int kc = it & 63, n = (it >> 6) & 511, g = it >> 15;
        const int s = kc >> 1, hq = (kc & 1) * 8, t = n >> 4, h = n & 15;
        u32x4 o = (u32x4){0u, 0u, 0u, 0u};
        if (s <= t) { const float* kj = (const float*)(ws + WS_KJ) + ((size_t)(g * CH_L + (t - s)) * SSM_H + h) * SSM_H + hq;
            const f32x4 a = *(const f32x4*)kj, b = *(const f32x4*)(kj + 4);
            o.x = pk2(a.x, a.y); o.y = pk2(a.z, a.w); o.z = pk2(b.x, b.y); o.w = pk2(b.z, b.w); }
        *(u32x4*)((bf16_t*)(ws + WS_BT_SSM) + ((size_t)(g * 512 + n)) * ACAT_LD + kc * 8) = o;
    }
}
#ifndef PG_WGM
#define PG_WGM 8
#endif
namespace pg {
constexpr int BM = 256, BK = 64, HALF = 128, HTB = HALF * BK * 2, STAGE_BYTES = 8 * HTB;
__host__ __device__ __forceinline__ int lds_byte(int r, int c) { const int st = (r >> 4) * 2 + (c >> 5), rr = r & 15, cc = c & 31, ob = rr * 64 + cc * 2; return st * 1024 + (ob ^ (((ob >> 9) & 1) << 5)); }
__host__ __device__ __forceinline__ void stage_rc(int b, int& R, int& C) { const int st = b / 1024, sb = b % 1024, swz = sb ^ (((sb >> 9) & 1) << 5); R = (st >> 1) * 16 + swz / 64; C = (st & 1) * 32 + (swz % 64) / 2; }
__host__ __device__ __forceinline__ int perm32(int rho) { const int n = rho >> 4, i = rho & 15; return 8 * (i >> 2) + 4 * n + (i & 3); }

struct Unit {
    const char* A;
    const char* B;
    unsigned aoff[2][2];
    int pm, pn, aux, aux2;
    int ord;
};
struct EpiInfo { int pm, pn, aux, aux2, ord; };
typedef f32x4 Acc[2][2][4][2];

typedef int v8i_t __attribute__((ext_vector_type(8)));
typedef int v4i_t __attribute__((ext_vector_type(4)));
template <bool FP8 = false, int BAUX = 0  , class Sched, class Epi>
__device__ __forceinline__ void gemm_phase(LAS unsigned char* lds, const Sched& S, const Epi& E, const int nt, const int ldb, const int ktm = -1  ) {
    const int tid = opaque_tid(), wid = __builtin_amdgcn_readfirstlane(tid >> 6), lane = tid & 63, wr = wid >> 2, wc = wid & 3, fr = lane & 15, fq = lane >> 4;
    unsigned voffB[2];
#pragma unroll
    for (int i = 0; i < 2; ++i) { int R, C; stage_rc(tid * 16 + i * 8192, R, C); voffB[i] = (unsigned)((64 * (R >> 5) + perm32(R & 31)) * ldb + C) * 2u; }
    const unsigned hB = (unsigned)(32 * ldb * 2);
    const unsigned ldsw = (unsigned)wid * 1024u;
    const int aoffl = lds_byte(wr * 64 + fr, fq * 8), boffl = lds_byte(wc * 32 + fr, fq * 8);
#define PG_SA(b, h) (((b) * 2 + (h)) * pg::HTB)
#define PG_SB(b, h) ((4 + (b) * 2 + (h)) * pg::HTB)
#define PG_GLDS(gp, bufoff, i) __builtin_amdgcn_global_load_lds((const unsigned*)(gp), (LAS unsigned*)(lds + (bufoff) + ldsw + (i) * 8192), 16, 0, 0)
#define PG_STAGE_A(bufoff, Ab, o0, o1, kt) do { const char* _b = (Ab) + (size_t)((kt) & ktm) * 128; PG_GLDS(_b + (o0), bufoff, 0); PG_GLDS(_b + (o1), bufoff, 1); } while (0)
#define PG_GLDSB(gp, bufoff, i) __builtin_amdgcn_global_load_lds((const unsigned*)(gp), (LAS unsigned*)(lds + (bufoff) + ldsw + (i) * 8192), 16, 0, BAUX)
#define PG_STAGE_B(bufoff, Bb, h, kt) do { const char* _b = (Bb) + (size_t)((kt) & ktm) * 128 + (h) * hB; PG_GLDSB(_b + voffB[0], bufoff, 0); PG_GLDSB(_b + voffB[1], bufoff, 1); } while (0)
#define PG_LDA(dst, b, h) do { _Pragma("unroll") for (int m = 0; m < 4; ++m) _Pragma("unroll") for (int k = 0; k < 2; ++k) dst[m][k] = *(const LAS bf16x8*)(lds + PG_SA(b, h) + aoffl + m * 2048 + k * 1024); } while (0)
#define PG_LDB(dst, b, h) do { _Pragma("unroll") for (int n = 0; n < 2; ++n) _Pragma("unroll") for (int k = 0; k < 2; ++k) dst[n][k] = *(const LAS bf16x8*)(lds + PG_SB(b, h) + boffl + n * 2048 + k * 1024); } while (0)
#define PG_CAT8(lo, hi) __builtin_shufflevector(__builtin_bit_cast(v4i_t, lo), __builtin_bit_cast(v4i_t, hi), 0, 1, 2, 3, 4, 5, 6, 7)
#define PG_MMA(ai, bj, At, Bt) do { __builtin_amdgcn_s_setprio(1); if constexpr (FP8) { _Pragma("unroll") for (int m = 0; m < 4; ++m) _Pragma("unroll") for (int n = 0; n < 2; ++n) \
            acc[ai][bj][m][n] = __builtin_amdgcn_mfma_scale_f32_16x16x128_f8f6f4(PG_CAT8(Bt[n][0], Bt[n][1]), PG_CAT8(At[m][0], At[m][1]), acc[ai][bj][m][n], 0, 0, 0, 0x79797979, 0, 0x7f7f7f7f); } \
        else { _Pragma("unroll") for (int m = 0; m < 4; ++m) _Pragma("unroll") for (int n = 0; n < 2; ++n) _Pragma("unroll") for (int k = 0; k < 2; ++k) \
        acc[ai][bj][m][n] = __builtin_amdgcn_mfma_f32_16x16x32_bf16(Bt[n][k], At[m][k], acc[ai][bj][m][n], 0, 0, 0); } __builtin_amdgcn_s_setprio(0); } while (0)
#define PG_WAIT_V(n) asm volatile("s_waitcnt vmcnt(" #n ")" ::: "memory")
#define PG_WAIT_L(n) asm volatile("s_waitcnt lgkmcnt(" #n ")" ::: "memory")
#define PG_BAR __builtin_amdgcn_s_barrier()
#define PG_SCHED __builtin_amdgcn_sched_barrier(0)
#define PG_KLOOP(T0, T1) _Pragma("clang loop unroll(disable)") for (int t = (T0); t < (T1); t += 2) { \
            const bool last = (t == nt - 2); \
            PG_LDB(B0, 0, 0); PG_LDB(B1, 0, 1); PG_SCHED; PG_LDA(At, 0, 0); PG_STAGE_A(PG_SA(1, 1), st.A, st.aoff[1][0], st.aoff[1][1], t + 1); \
            if (last) { Unit nu_; has_next = S.next(ui + 1, nu_); if (has_next) { st = nu_; } } \
            const int k2 = last ? 0 : t + 2, k3 = k2 + 1; \
            PG_WAIT_V(8); PG_WAIT_L(0); PG_BAR; PG_MMA(0, 0, At, B0); PG_MMA(0, 1, At, B1); PG_BAR; PG_SCHED; \
            PG_LDA(At, 0, 1); PG_STAGE_B(PG_SB(0, 0), st.B, 0, k2); PG_STAGE_B(PG_SB(0, 1), st.B, 1, k2); PG_STAGE_A(PG_SA(0, 0), st.A, st.aoff[0][0], st.aoff[0][1], k2); \
            PG_WAIT_V(8); PG_WAIT_L(0); PG_BAR; PG_MMA(1, 0, At, B0); PG_MMA(1, 1, At, B1); PG_BAR; PG_SCHED; \
            PG_LDB(B0, 1, 0); PG_LDB(B1, 1, 1); PG_SCHED; PG_LDA(At, 1, 0); PG_STAGE_A(PG_SA(0, 1), st.A, st.aoff[1][0], st.aoff[1][1], k2); \
            PG_WAIT_V(8); PG_WAIT_L(0); PG_BAR; PG_MMA(0, 0, At, B0); PG_MMA(0, 1, At, B1); PG_BAR; PG_SCHED; \
            PG_LDA(At, 1, 1); PG_STAGE_B(PG_SB(1, 0), st.B, 0, k3); PG_STAGE_B(PG_SB(1, 1), st.B, 1, k3); PG_STAGE_A(PG_SA(1, 0), st.A, st.aoff[0][0], st.aoff[0][1], k3); \
            PG_WAIT_V(8); PG_WAIT_L(0); PG_BAR; PG_MMA(1, 0, At, B0); PG_MMA(1, 1, At, B1); PG_BAR; PG_SCHED; \
        }
    Unit st; int ui = 0;
    if (!S.next(0, st)) return;
    EpiInfo cur; cur.pm = st.pm; cur.pn = st.pn; cur.aux = st.aux; cur.aux2 = st.aux2; cur.ord = st.ord;
    Acc acc;
#pragma unroll
    for (int a = 0; a < 2; ++a)
#pragma unroll
        for (int b = 0; b < 2; ++b)
#pragma unroll
            for (int m = 0; m < 4; ++m)
#pragma unroll
                for (int n = 0; n < 2; ++n) acc[a][b][m][n] = (f32x4){0.f, 0.f, 0.f, 0.f};
    bf16x8 At[4][2], B0[2][2], B1[2][2];
    PG_STAGE_B(PG_SB(0, 0), st.B, 0, 0); PG_STAGE_B(PG_SB(0, 1), st.B, 1, 0); PG_STAGE_A(PG_SA(0, 0), st.A, st.aoff[0][0], st.aoff[0][1], 0); PG_STAGE_A(PG_SA(0, 1), st.A, st.aoff[1][0], st.aoff[1][1], 0);
    if (wr == 1) PG_BAR;
    PG_WAIT_V(2); PG_BAR;
    PG_STAGE_B(PG_SB(1, 0), st.B, 0, 1); PG_STAGE_A(PG_SA(1, 0), st.A, st.aoff[0][0], st.aoff[0][1], 1); PG_STAGE_B(PG_SB(1, 1), st.B, 1, 1);
    PG_WAIT_V(6); PG_BAR;
    for (;;) {
        bool has_next = false;
        if constexpr (Epi::HAS_MID) { PG_KLOOP(0, Epi::MID_T) E.mid(acc, cur, wr, wc, fr, fq); PG_KLOOP(Epi::MID_T, nt) } else { PG_KLOOP(0, nt) }
        if (wr == 0) PG_BAR;
        E(acc, cur, wr, wc, fr, fq);
        if (!has_next) break;
#pragma unroll
        for (int a = 0; a < 2; ++a)
#pragma unroll
            for (int b = 0; b < 2; ++b)
#pragma unroll
                for (int m = 0; m < 4; ++m)
#pragma unroll
                    for (int n = 0; n < 2; ++n) acc[a][b][m][n] = (f32x4){0.f, 0.f, 0.f, 0.f};
        cur.pm = st.pm; cur.pn = st.pn; cur.aux = st.aux; cur.aux2 = st.aux2; cur.ord = st.ord; ++ui;
        if (wr == 1) PG_BAR;
    }
    PG_WAIT_V(0);
    PG_BAR;
#undef PG_SA
#undef PG_SB
#undef PG_GLDS
#undef PG_GLDSB
#undef PG_STAGE_A
#undef PG_STAGE_B
#undef PG_LDA
#undef PG_LDB
#undef PG_MMA
#undef PG_WAIT_V
#undef PG_WAIT_L
#undef PG_BAR
#undef PG_SCHED
#undef PG_KLOOP
}

struct LaneRC { int R[2], C[2]; __device__ __forceinline__ LaneRC() { const int t = opaque_tid(); stage_rc(t * 16, R[0], C[0]); stage_rc(t * 16 + 8192, R[1], C[1]); } };

struct DenseSched {
    const bf16_t* A; const bf16_t* Bt; int lda, ldb, nM, nN, nwg, G, c;
    __device__ __forceinline__ void init(const bf16_t* A_, int lda_, const bf16_t* Bt_, int ldb_, int M, int N, int G_, int c_) { A = A_; Bt = Bt_; lda = lda_; ldb = ldb_; nM = M / BM; nN = N / BM; nwg = nM * nN; G = G_; c = c_; }
    __device__ __forceinline__ bool next(int i, Unit& u) const {
        const long L = (long)i * G + c; if (L >= nwg) return false;
        int wgid = (int)L; { const int q = nwg / 8, r = nwg % 8, xcd = wgid % 8, off = wgid / 8; wgid = (xcd < r ? xcd * (q + 1) : r * (q + 1) + (xcd - r) * q) + off; }
        const int WGM = PG_WGM, nig = WGM * nN, gid = wgid / nig, fm = gid * WGM, gsz = (nM - fm) < WGM ? (nM - fm) : WGM;
        u.pm = fm + ((wgid % nig) % gsz); u.pn = (wgid % nig) / gsz; u.aux = 0; u.aux2 = 0; u.ord = i;
        u.A = (const char*)A; u.B = (const char*)(Bt + (size_t)u.pn * BM * ldb); const LaneRC rc;
#pragma unroll
        for (int h = 0; h < 2; ++h)
#pragma unroll
            for (int j = 0; j < 2; ++j) u.aoff[h][j] = (unsigned)(((u.pm * BM + 128 * h + rc.R[j]) * lda + rc.C[j]) * 2);
        return true;
    }
};
}
namespace pg {
constexpr int TAB_OFF = RING_BYTES + 1024;
__device__ __forceinline__ void moe_build_tab(LAS unsigned char* lds, const unsigned* cnt) {
    LAS int* tab = (LAS int*)(lds + TAB_OFF);
    if (threadIdx.x == 0) { int acc = 0; for (int e = 0; e < NE; ++e) { const int n = (int)__hip_atomic_load(cnt + e, __ATOMIC_RELAXED, __HIP_MEMORY_SCOPE_AGENT); tab[e] = acc; tab[40 + e] = n; acc += (n + 255) >> 8; } tab[NE] = acc; }
    __syncthreads();
}
#ifndef MOE_MAXU_OVERRIDE
#define MOE_MAXU_OVERRIDE 9
#endif
constexpr int MOE_MAXU = MOE_MAXU_OVERRIDE;
constexpr int UT_OFF = RING_BYTES + 1536;
constexpr int UB_OFF = UT_OFF + MOE_MAXU * 512;
static_assert(UB_OFF + MOE_MAXU * 1024 <= LDS_BYTES, "LDS map");
template <int KIND>
struct MoeSched {
    static constexpr int NPN = KIND == 1 ? 8 : 4;
    unsigned char* ws; const LAS int* tab; LAS unsigned char* lds; int G, c; bool freeze = false;
    __device__ __forceinline__ bool unit(int i, int& e, int& rb, int& pn) const {
        const int x = c & 7, j = c >> 3, NJ = G >> 3;
        int L = i * NJ + j; e = -1; rb = 0; pn = 0;
#pragma unroll
        for (int q = 0; q < NE / 8; ++q) { const int eq = x + 8 * q, uq = (tab[eq + 1] - tab[eq]) * NPN;
            if (e < 0) { if (L < uq) { e = eq; rb = L / NPN; pn = L % NPN; } else L -= uq; } }
        if (e < 0) return false;
        e = __builtin_amdgcn_readfirstlane(e); rb = __builtin_amdgcn_readfirstlane(rb); pn = __builtin_amdgcn_readfirstlane(pn);
        return true;
    }
    __device__ __forceinline__ void init(unsigned char* ws_, LAS unsigned char* lds_, int G_, int c_, const float* bias) {
        ws = ws_; lds = lds_; tab = (const LAS int*)(lds_ + TAB_OFF); G = G_; c = c_;
        const int tid = opaque_tid();
        for (int i = 0; i < MOE_MAXU; ++i) { int e, rb, pn; if (!unit(i, e, rb, pn)) break;
            if (tid < 256) { if (KIND == 1) { const int nvalid = min(256, tab[40 + e] - rb * 256); const int tok = tid < nvalid ? ((const int*)(ws + WS_SLOT_TOK))[(size_t)e * CAP + rb * 256 + tid] : T;
                    ((LAS unsigned short*)(lds + UT_OFF))[i * 256 + tid] = (unsigned short)tok; } }
            else ((LAS float*)(lds + UB_OFF))[i * 256 + tid - 256] = bias[(size_t)e * (NPN * 256) + pn * 256 + tid - 256]; }
        __syncthreads();
    }
    __device__ __forceinline__ bool next(int i, Unit& u) const {
        int e, rb, pn; if (!unit(i, e, rb, pn)) return false;
#if defined(PROBE_FREEZE)
        if (freeze) { int e0, r0, p0; unit(0, e0, r0, p0); e = e0; rb = r0; pn = p0; }
#endif
        const int blk = tab[e] + rb, nvalid = min(256, tab[40 + e] - rb * 256);
        u.pm = rb; u.pn = pn; u.aux = e; u.ord = i; const LaneRC rc;
        if (KIND == 1) {
            u.aux2 = blk; u.A = (const char*)(ws + WS_H2); u.B = (const char*)(ws + WS_W1_T + ((size_t)e * 2 * DFF + (size_t)pn * BM) * D);
#pragma unroll
            for (int h = 0; h < 2; ++h)
#pragma unroll
                for (int jj = 0; jj < 2; ++jj) { const int r = 128 * h + rc.R[jj]; int tok;
                    if (i < MOE_MAXU) tok = ((const LAS unsigned short*)(lds + UT_OFF))[i * 256 + r];
                    else { tok = r < nvalid ? ((const int*)(ws + WS_SLOT_TOK))[(size_t)e * CAP + rb * 256 + r] : T; __builtin_amdgcn_s_waitcnt(0x0F70); }
                    u.aoff[h][jj] = (unsigned)(tok * D + rc.C[jj] * 2); }
        } else {
            u.aux2 = blk | (nvalid << 16); u.A = (const char*)(ws + WS_ACT); u.B = (const char*)(ws + WS_W2_T + ((size_t)e * D + (size_t)pn * BM) * DFF);
#pragma unroll
            for (int h = 0; h < 2; ++h)
#pragma unroll
                for (int jj = 0; jj < 2; ++jj) u.aoff[h][jj] = (unsigned)((blk * 256 + 128 * h + rc.R[jj]) * DFF + rc.C[jj] * 2);
        }
        return true;
    }
};
}
namespace pg {
struct EpiBase { static constexpr bool HAS_MID = false; static constexpr int MID_T = -1; __device__ __forceinline__ void mid(Acc&, const EpiInfo&, int, int, int, int) const {} };
__device__ __forceinline__ u32x4 pack8(const f32x4 a, const f32x4 b) { u32x4 w; w.x = pk2(a[0], a[1]); w.y = pk2(a[2], a[3]); w.z = pk2(b[0], b[1]); w.w = pk2(b[2], b[3]); return w; }
__device__ __forceinline__ void unpack8(const u32x4 w, f32x4& a, f32x4& b) { a = (f32x4){bflo(w.x), bfhi(w.x), bflo(w.y), bfhi(w.y)}; b = (f32x4){bflo(w.z), bfhi(w.z), bflo(w.w), bfhi(w.w)}; }

struct EpiNull : EpiBase {
    __device__ __forceinline__ void operator()(Acc& acc, const EpiInfo&, int, int, int, int) const {
#pragma unroll
        for (int a = 0; a < 2; ++a)
#pragma unroll
            for (int b = 0; b < 2; ++b)
#pragma unroll
                for (int m = 0; m < 4; ++m)
#pragma unroll
                    for (int n = 0; n < 2; ++n) asm volatile("" :: "v"(acc[a][b][m][n]));
    }
};
struct EpiInProj : EpiBase {
    unsigned char* ws; const float* qg; const float* kg;
    __device__ __forceinline__ void operator()(Acc& acc, const EpiInfo& u, int wr, int wc, int fr, int fq) const {
        const int pn = u.pn, row0 = u.pm * BM + wr * 64 + fr, colw = 64 * wc + 8 * fq;
        if (pn < 2) {
            bf16_t* acat = (bf16_t*)(ws + WS_ACAT);
#pragma unroll
            for (int ai = 0; ai < 2; ++ai)
#pragma unroll
                for (int m = 0; m < 4; ++m) { const int tok = row0 + ai * 128 + m * 16;
#pragma unroll
                    for (int bj = 0; bj < 2; ++bj) { const int cu = pn * 256 + colw + 32 * bj, g = cu >> 4, h0 = cu & 15;
                        *(u32x4*)(acat + ((size_t)(g * ACAT_ROWS + (tok >> 5))) * ACAT_LD + (tok & 31) * 16 + h0) = pack8(acc[ai][bj][m][0], acc[ai][bj][m][1]); } }
        } else if (pn < 10) {
            const bool isq = pn < 6; const float* gain = isq ? qg : kg; const float sc = isq ? QC2 : 1.f;
            bf16_t* dst = (bf16_t*)(ws + (isq ? WS_Q : WS_K)) + (size_t)(pn - (isq ? 2 : 6)) * 256 + colw;
            f32x4 gv[2][2];
#pragma unroll
            for (int bj = 0; bj < 2; ++bj)
#pragma unroll
                for (int n = 0; n < 2; ++n) gv[bj][n] = *(const f32x4*)(gain + 32 * bj + 8 * fq + 4 * n);
#pragma unroll
            for (int ai = 0; ai < 2; ++ai)
#pragma unroll
                for (int m = 0; m < 4; ++m) { const int tok = row0 + ai * 128 + m * 16; float ss = 0.f;
#pragma unroll
                    for (int bj = 0; bj < 2; ++bj)
#pragma unroll
                        for (int n = 0; n < 2; ++n) { const f32x4 v = acc[ai][bj][m][n]; ss += (v[0] * v[0] + v[1] * v[1]) + (v[2] * v[2] + v[3] * v[3]); }
                    ss += __shfl_xor(ss, 16); ss += __shfl_xor(ss, 32);
                    const float r = rsqrtf(ss * (1.f / 64.f) + EPS) * sc;
#pragma unroll
                    for (int bj = 0; bj < 2; ++bj) store16(dst + (size_t)tok * D + 32 * bj, pack8(acc[ai][bj][m][0] * r * gv[bj][0], acc[ai][bj][m][1] * r * gv[bj][1])); }
        } else {
            const size_t base = pn < 14 ? WS_V : (pn < 18 ? WS_GS : WS_GA); const int t0 = pn < 14 ? 10 : (pn < 18 ? 14 : 18); const bool ntst = pn >= 14;
            bf16_t* dst = (bf16_t*)(ws + base) + (size_t)(pn - t0) * 256 + colw;
#pragma unroll
            for (int ai = 0; ai < 2; ++ai)
#pragma unroll
                for (int m = 0; m < 4; ++m) { const int tok = row0 + ai * 128 + m * 16;
#pragma unroll
                    for (int bj = 0; bj < 2; ++bj) { const u32x4 w = pack8(acc[ai][bj][m][0], acc[ai][bj][m][1]); if (ntst) NT_STORE(w, (u32x4*)(dst + (size_t)tok * D + 32 * bj)); else store16(dst + (size_t)tok * D + 32 * bj, w); } }
        }
    }
};
struct EpiSsm2 : EpiBase {
    unsigned char* ws;
    __device__ __forceinline__ void operator()(Acc& acc, const EpiInfo& u, int wr, int wc, int fr, int fq) const {
        bf16_t* Z = (bf16_t*)(ws + WS_Z); const int g = u.aux;
#pragma unroll
        for (int ai = 0; ai < 2; ++ai)
#pragma unroll
            for (int m = 0; m < 4; ++m) { const int r = u.pm * BM + ai * 128 + wr * 64 + m * 16 + fr, b = r >> 6, c = r & 63;
#pragma unroll
                for (int bj = 0; bj < 2; ++bj) { const int n_ = u.pn * 256 + 64 * wc + 32 * bj + 8 * fq, t = n_ >> 4, h0 = n_ & 15; const int tok = b * SEQ + c * CH_L + t;
                    f32x4 a = acc[ai][bj][m][0], bb = acc[ai][bj][m][1];
#pragma unroll
                    for (int q = 0; q < 4; ++q) { a[q] = gelu_tanh(a[q]); bb[q] = gelu_tanh(bb[q]); }
                    *(u32x4*)(Z + (size_t)tok * SSM_W + 16 * g + h0) = pack8(a, bb); } }
    }
};
struct EpiGlu : EpiBase {
    unsigned char* ws; const float* bglu;
    __device__ __forceinline__ void operator()(Acc& acc, const EpiInfo& u, int wr, int wc, int fr, int fq) const {
        asm volatile("" : "+v"(fr), "+v"(fq));
        const bf16_t* Z = (const bf16_t*)(ws + WS_Z); bf16_t* MA = (bf16_t*)(ws + WS_MA);
        const int col0 = u.pn * 256 + 64 * wc + 8 * fq;
        f32x4 cb[2][2];
#pragma unroll
        for (int bj = 0; bj < 2; ++bj) { cb[bj][0] = *(const f32x4*)(bglu + col0 + 32 * bj); cb[bj][1] = *(const f32x4*)(bglu + col0 + 32 * bj + 4); }
#pragma unroll
        for (int ai = 0; ai < 2; ++ai) { u32x4 zz[4][2];
#pragma unroll
            for (int m = 0; m < 4; ++m) { const int tok = u.pm * BM + ai * 128 + wr * 64 + m * 16 + fr;
#pragma unroll
                for (int bj = 0; bj < 2; ++bj) zz[m][bj] = *(const u32x4*)(Z + (size_t)tok * SSM_W + col0 + 32 * bj); }
            asm volatile("" ::: "memory");
#pragma unroll
            for (int m = 0; m < 4; ++m) { const int tok = u.pm * BM + ai * 128 + wr * 64 + m * 16 + fr;
#pragma unroll
                for (int bj = 0; bj < 2; ++bj) { f32x4 z0, z1; unpack8(zz[m][bj], z0, z1);
                    f32x4 a = acc[ai][bj][m][0] + cb[bj][0], bb = acc[ai][bj][m][1] + cb[bj][1];
#pragma unroll
                    for (int q = 0; q < 4; ++q) { a[q] = z0[q] * sigmoid_f(a[q]); bb[q] = z1[q] * sigmoid_f(bb[q]); }
                    *(u32x4*)(MA + (size_t)tok * MA_LD + 1024 + col0 + 32 * bj) = pack8(a, bb); } }
            asm volatile("" ::: "memory"); }
    }
};
struct EpiMerged : EpiBase {
    static constexpr bool HAS_MID = true; static constexpr int MID_T = 16;
    unsigned char* ws;
    __device__ __forceinline__ float ratio(float a, float s) const { a = fminf(fmaxf(a, -30.f), 30.f); s = fminf(fmaxf(s, -30.f), 30.f); return (1.f + __expf(-s)) * __builtin_amdgcn_rcpf(1.f + __expf(-a)); }
    __device__ __forceinline__ void mid(Acc& acc, const EpiInfo& u, int wr, int wc, int fr, int fq) const {
        asm volatile("" : "+v"(fr), "+v"(fq));
        const bf16_t* GS = (const bf16_t*)(ws + WS_GS); const bf16_t* GA = (const bf16_t*)(ws + WS_GA);
        const int col0 = u.pn * 256 + 64 * wc + 8 * fq;
#pragma unroll
        for (int ai = 0; ai < 2; ++ai)
#pragma unroll
            for (int mp = 0; mp < 2; ++mp) { u32x4 gs_[2][2], ga_[2][2];
#pragma unroll
                for (int mm = 0; mm < 2; ++mm) { const int tok = u.pm * BM + ai * 128 + wr * 64 + (2 * mp + mm) * 16 + fr;
#pragma unroll
                    for (int bj = 0; bj < 2; ++bj) { gs_[mm][bj] = *(const u32x4*)(GS + (size_t)tok * D + col0 + 32 * bj); ga_[mm][bj] = *(const u32x4*)(GA + (size_t)tok * D + col0 + 32 * bj); } }
#pragma unroll
                for (int mm = 0; mm < 2; ++mm)
#pragma unroll
                    for (int bj = 0; bj < 2; ++bj) { const int m = 2 * mp + mm; const u32x4 ws_ = gs_[mm][bj], wa_ = ga_[mm][bj];
                        acc[ai][bj][m][0][0] *= ratio(bflo(wa_.x), bflo(ws_.x)); acc[ai][bj][m][0][1] *= ratio(bfhi(wa_.x), bfhi(ws_.x));
                        acc[ai][bj][m][0][2] *= ratio(bflo(wa_.y), bflo(ws_.y)); acc[ai][bj][m][0][3] *= ratio(bfhi(wa_.y), bfhi(ws_.y));
                        acc[ai][bj][m][1][0] *= ratio(bflo(wa_.z), bflo(ws_.z)); acc[ai][bj][m][1][1] *= ratio(bfhi(wa_.z), bfhi(ws_.z));
                        acc[ai][bj][m][1][2] *= ratio(bflo(wa_.w), bflo(ws_.w)); acc[ai][bj][m][1][3] *= ratio(bfhi(wa_.w), bfhi(ws_.w)); }
                asm volatile("" ::: "memory"); }
    }
    __device__ __forceinline__ void operator()(Acc& acc, const EpiInfo& u, int wr, int wc, int fr, int fq) const {
        asm volatile("" : "+v"(fr), "+v"(fq));
        const bf16_t* GS = (const bf16_t*)(ws + WS_GS); bf16_t* O = (bf16_t*)(ws + WS_MERGED);
        const int col0 = u.pn * 256 + 64 * wc + 8 * fq;
#pragma unroll
        for (int ai = 0; ai < 2; ++ai) { u32x4 gs_[4][2];
#pragma unroll
            for (int m = 0; m < 4; ++m) { const int tok = u.pm * BM + ai * 128 + wr * 64 + m * 16 + fr;
#pragma unroll
                for (int bj = 0; bj < 2; ++bj) gs_[m][bj] = *(const u32x4*)(GS + (size_t)tok * D + col0 + 32 * bj); }
#pragma unroll
            for (int m = 0; m < 4; ++m) { const int tok = u.pm * BM + ai * 128 + wr * 64 + m * 16 + fr;
#pragma unroll
                for (int bj = 0; bj < 2; ++bj) { f32x4 s0, s1; unpack8(gs_[m][bj], s0, s1);
                    f32x4 a = acc[ai][bj][m][0], bb = acc[ai][bj][m][1];
#pragma unroll
                    for (int q = 0; q < 4; ++q) { a[q] *= sigmoid_c(s0[q]); bb[q] *= sigmoid_c(s1[q]); }
                    *(u32x4*)(O + (size_t)tok * D + col0 + 32 * bj) = pack8(a, bb); } }
            asm volatile("" ::: "memory"); }
    }
};
struct EpiWout : EpiBase {
    const float* x; bf16_t* out;
    __device__ __forceinline__ void operator()(Acc& acc, const EpiInfo& u, int wr, int wc, int fr, int fq) const {
        asm volatile("" : "+v"(fr), "+v"(fq));
        const int col0 = u.pn * 256 + 64 * wc + 8 * fq;
#pragma unroll
        for (int ai = 0; ai < 2; ++ai)
#pragma unroll
            for (int mp = 0; mp < 2; ++mp) { f32x4 xv[2][2][2];
#pragma unroll
                for (int mm = 0; mm < 2; ++mm) { const int tok = u.pm * BM + ai * 128 + wr * 64 + (2 * mp + mm) * 16 + fr;
#pragma unroll
                    for (int bj = 0; bj < 2; ++bj) { const size_t o = (size_t)tok * D + col0 + 32 * bj; xv[mm][bj][0] = NT_LOAD((const f32x4*)(x + o)); xv[mm][bj][1] = NT_LOAD((const f32x4*)(x + o + 4)); } }
                asm volatile("" ::: "memory");
#pragma unroll
                for (int mm = 0; mm < 2; ++mm) { const int m = 2 * mp + mm, tok = u.pm * BM + ai * 128 + wr * 64 + m * 16 + fr;
#pragma unroll
                    for (int bj = 0; bj < 2; ++bj) *(u32x4*)(out + (size_t)tok * D + col0 + 32 * bj) = pack8(xv[mm][bj][0] + acc[ai][bj][m][0], xv[mm][bj][1] + acc[ai][bj][m][1]); }
                asm volatile("" ::: "memory"); }
    }
};
struct EpiMoe1 : EpiBase {
    unsigned char* ws; const float* b1; LAS unsigned char* lds; bool nostore = false;
    __device__ __forceinline__ void operator()(Acc& acc, const EpiInfo& u, int wr, int wc, int fr, int fq) const {
        asm volatile("" : "+v"(fr), "+v"(fq));
        unsigned char* ACT = ws + WS_ACT; const int e = u.aux, blk = u.aux2;
        f32x4 cb[2][2];
#pragma unroll
        for (int bj = 0; bj < 2; ++bj) { const int cl = 64 * wc + 32 * bj + 8 * fq; f32x4 r0, r1;
            if (u.ord < MOE_MAXU) { const LAS float* bl = (const LAS float*)(lds + UB_OFF) + u.ord * 256 + cl; r0 = *(const LAS f32x4*)bl; r1 = *(const LAS f32x4*)(bl + 4); }
            else { const float* bg = b1 + (size_t)e * 2 * DFF + u.pn * 256 + cl; r0 = *(const f32x4*)bg; r1 = *(const f32x4*)(bg + 4); __builtin_amdgcn_s_waitcnt(0x0F70); }
            cb[bj][0] = __builtin_shufflevector(r0, r0, 0, 2, 1, 3); cb[bj][1] = __builtin_shufflevector(r1, r1, 0, 2, 1, 3); }
        const f32x2 c7 = {7.f, 7.f}, one = {1.f, 1.f}, cexp = {-1.702f * 1.4426950408889634f, -1.702f * 1.4426950408889634f};
#pragma unroll
        for (int ai = 0; ai < 2; ++ai)
#pragma unroll
            for (int m = 0; m < 4; ++m) { const int row = ai * 128 + wr * 64 + m * 16 + fr; unsigned w[2];
#pragma unroll
                for (int bj = 0; bj < 2; ++bj) { f32x2 r[2];
#pragma unroll
                    for (int n = 0; n < 2; ++n) { const f32x4 h = acc[ai][bj][m][n] + cb[bj][n];
                        f32x2 g = {fminf(h[0], 7.f), fminf(h[1], 7.f)}; const f32x2 up = {fminf(fmaxf(h[2], -7.f), 7.f), fminf(fmaxf(h[3], -7.f), 7.f)};
                        const f32x2 x = g * cexp; f32x2 ex = {__builtin_amdgcn_exp2f(x[0]), __builtin_amdgcn_exp2f(x[1])};
                        ex = ex + one; const f32x2 s = {__builtin_amdgcn_rcpf(ex[0]), __builtin_amdgcn_rcpf(ex[1])};
                        r[n] = (up * g + g) * s; }
                    w[bj] = pk4_fp8(r[0][0], r[0][1], r[1][0], r[1][1]); }
                unsigned char* rowp = ACT + ((size_t)blk * 256 + row) * DFF + ((u.pn * 256 + 64 * wc + 8 * fq) >> 1);
#if defined(PROBE_NOSTORE)
                if (nostore) { asm volatile("" :: "v"(w[0]), "v"(w[1])); } else
#endif
                { *(unsigned*)rowp = w[0]; *(unsigned*)(rowp + 16) = w[1]; } }
        (void)c7;
    }
};
struct EpiMoe2 : EpiBase {
    unsigned char* ws; const float* b2; LAS unsigned char* lds; bool nostore = false;
    __device__ __forceinline__ void operator()(Acc& acc, const EpiInfo& u, int wr, int wc, int fr, int fq) const {
        asm volatile("" : "+v"(fr), "+v"(fq));
        bf16_t* Y = (bf16_t*)(ws + WS_Y); const int e = u.aux, blk = u.aux2 & 0xffff;
        f32x4 cb[2][2];
#pragma unroll
        for (int bj = 0; bj < 2; ++bj) { const int cl = 64 * wc + 32 * bj + 8 * fq;
            if (u.ord < MOE_MAXU) { const LAS float* bl = (const LAS float*)(lds + UB_OFF) + u.ord * 256 + cl; cb[bj][0] = *(const LAS f32x4*)bl; cb[bj][1] = *(const LAS f32x4*)(bl + 4); }
            else { const float* bg = b2 + (size_t)e * D + u.pn * 256 + cl; cb[bj][0] = *(const f32x4*)bg; cb[bj][1] = *(const f32x4*)(bg + 4); __builtin_amdgcn_s_waitcnt(0x0F70); } }
#pragma unroll
        for (int ai = 0; ai < 2; ++ai)
#pragma unroll
            for (int m = 0; m < 4; ++m) { const int row = ai * 128 + wr * 64 + m * 16 + fr;
#pragma unroll
                for (int bj = 0; bj < 2; ++bj) { const int col = u.pn * 256 + 64 * wc + 32 * bj + 8 * fq;
                    const u32x4 w = pack8(acc[ai][bj][m][0] + cb[bj][0], acc[ai][bj][m][1] + cb[bj][1]);
#if defined(PROBE_NOSTORE)
                    if (nostore) { asm volatile("" :: "v"(w)); } else
#endif
                    store16(Y + ((size_t)blk * 256 + row) * D + col, w); } }
    }
};
}
namespace attn_body {
using bf16=__hip_bfloat16;
using bf16x8=__attribute__((ext_vector_type(8)))short;
using s16x4=__attribute__((ext_vector_type(4)))short;
using f32x16=__attribute__((ext_vector_type(16)))float;
using u32x4=__attribute__((ext_vector_type(4)))unsigned;
constexpr int SEQ=2048,D=64,DM=1024;
constexpr int NW=8,QBLK=32,QB=QBLK*NW,KVBLK=64,NQB=SEQ/QB;
constexpr int ATTN_PITCH=DM, ATTN_UNIT_ROWS=QB;
__device__ __forceinline__ int crow(int r,int hi){return (r&3)+8*(r>>2)+4*hi;}
#define SBAR() __builtin_amdgcn_sched_barrier(0)
__device__ __forceinline__ void cmask(f32x16&p0,f32x16&p1,int jb,int qrel,int hi){
  const float NEG=-INFINITY; int kb=64*jb+4*hi;
  #pragma unroll
  for(int r=0;r<16;++r){int kv=kb+(r&3)+8*(r>>2); if(kv>qrel)p0[r]=NEG; if(kv+32>qrel)p1[r]=NEG;}
}

constexpr int NSLOT=3, SLOTB=8192;
constexpr int LDS_K=0, LDS_V=NSLOT*SLOTB, LDS_WS=2*NSLOT*SLOTB, LDS_OST=LDS_WS+NW*64*4, ALDS_BYTES=LDS_OST+NW*4096;
constexpr float C2=0.125f*1.4426950408889634f;
__device__ __forceinline__ void glds16(const void*gsrc,unsigned lds_dst){unsigned keep;
  asm volatile("s_mov_b32 %0, m0\n\ts_mov_b32 m0, %2\n\ts_nop 0\n\tglobal_load_lds_dwordx4 %1, off\n\ts_mov_b32 m0, %0":"=&s"(keep):"v"(gsrc),"s"(lds_dst):"memory");}
__device__ __forceinline__ float max3f(float a,float b,float c){float r;asm("v_max3_f32 %0, %1, %2, %3":"=v"(r):"v"(a),"v"(b),"v"(c));return r;}
__device__ __forceinline__ float max2f(float a,float b){float r;asm("v_max_f32_e32 %0, %1, %2":"=v"(r):"v"(a),"v"(b));return r;}
__device__ __forceinline__ float fadd_s(float a,float b){float r;asm("v_add_f32_e32 %0, %1, %2":"=v"(r):"v"(a),"v"(b));return r;}
__device__ __forceinline__ float fsub_s(float a,float b){float r;asm("v_sub_f32_e32 %0, %1, %2":"=v"(r):"v"(a),"v"(b));return r;}
typedef float f32x2_t __attribute__((ext_vector_type(2))); typedef __bf16 bf16x2_t __attribute__((ext_vector_type(2)));
__device__ __forceinline__ unsigned cvtpk_s(float lo,float hi){f32x2_t v={lo,hi};bf16x2_t b=__builtin_convertvector(v,bf16x2_t);return __builtin_bit_cast(unsigned,b);}
#define WAIT_BAR(N) asm volatile("s_waitcnt vmcnt(" #N ") lgkmcnt(0)\n\ts_barrier":::"memory")

__device__ __forceinline__ void qkt(f32x16&p0,f32x16&p1,const char*Kslot,const bf16x8*qr,const f32x16&negm,int r32,int hi){
  const char*kb=Kslot+hi*1024+r32*16;
  #pragma unroll
  for(int d0=0;d0<4;++d0){
    const bf16x8 b0=*reinterpret_cast<const bf16x8*>(kb+d0*2048);
    const bf16x8 b1=*reinterpret_cast<const bf16x8*>(kb+d0*2048+512);
    if(d0==0){p0=__builtin_amdgcn_mfma_f32_32x32x16_bf16(b0,qr[0],negm,0,0,0);p1=__builtin_amdgcn_mfma_f32_32x32x16_bf16(b1,qr[0],negm,0,0,0);}
    else{p0=__builtin_amdgcn_mfma_f32_32x32x16_bf16(b0,qr[d0],p0,0,0,0);p1=__builtin_amdgcn_mfma_f32_32x32x16_bf16(b1,qr[d0],p1,0,0,0);}}
}
typedef __attribute__((address_space(3))) const char* lds_cptr;
typedef short v4i16_t __attribute__((ext_vector_type(4)));
__device__ __forceinline__ void kload8(bf16x8*kf,lds_cptr kp){
  kf[0]=*(const __attribute__((address_space(3))) bf16x8*)(kp);      kf[1]=*(const __attribute__((address_space(3))) bf16x8*)(kp+512);
  kf[2]=*(const __attribute__((address_space(3))) bf16x8*)(kp+2048); kf[3]=*(const __attribute__((address_space(3))) bf16x8*)(kp+2560);
  kf[4]=*(const __attribute__((address_space(3))) bf16x8*)(kp+4096); kf[5]=*(const __attribute__((address_space(3))) bf16x8*)(kp+4608);
  kf[6]=*(const __attribute__((address_space(3))) bf16x8*)(kp+6144); kf[7]=*(const __attribute__((address_space(3))) bf16x8*)(kp+6656);
}
__device__ __forceinline__ void kload2(bf16x8*kf,lds_cptr kp,int j){ kf[2*j]=*(const __attribute__((address_space(3))) bf16x8*)(kp+j*2048); kf[2*j+1]=*(const __attribute__((address_space(3))) bf16x8*)(kp+j*2048+512); }
__device__ __forceinline__ s16x4 vtr(lds_cptr p){ return __builtin_bit_cast(s16x4,__builtin_amdgcn_ds_read_tr16_b64_v4i16((__attribute__((address_space(3))) v4i16_t*)p)); }
__device__ __forceinline__ float rowmax(const f32x16&p0,const f32x16&p1){
  float a=max3f(p0[0],p0[1],p1[0]),b=max3f(p0[2],p0[3],p1[1]);a=max3f(a,p1[2],p1[3]);
  #pragma unroll
  for(int r=4;r<16;r+=4){a=max3f(a,p0[r],p0[r+1]);b=max3f(b,p0[r+2],p0[r+3]);a=max3f(a,p1[r],p1[r+1]);b=max3f(b,p1[r+2],p1[r+3]);}
  const float m=max2f(a,b);
  auto rr=__builtin_amdgcn_permlane32_swap(__float_as_uint(m),__float_as_uint(m),false,false);
  return max2f(__uint_as_float(rr[0]),__uint_as_float(rr[1]));
}
__device__ __forceinline__ void pv(f32x16*o,int vb,bf16x8 pa0,bf16x8 pa1,bf16x8 pa2,bf16x8 pa3){
  #pragma unroll
  for(int d0=0;d0<2;++d0){s16x4 lo[4],hi[4];
    #pragma unroll
    for(int ks=0;ks<4;++ks){
      asm volatile("ds_read_b64_tr_b16 %0,%1 offset:%c2":"=&v"(lo[ks]):"v"(vb),"i"(d0*4096+ks*1024):"memory");
      asm volatile("ds_read_b64_tr_b16 %0,%1 offset:%c2":"=&v"(hi[ks]):"v"(vb),"i"(d0*4096+ks*1024+512):"memory");}
    asm volatile("s_waitcnt lgkmcnt(0)":::"memory");SBAR();
    #define PK(k) (bf16x8){lo[k][0],lo[k][1],lo[k][2],lo[k][3],hi[k][0],hi[k][1],hi[k][2],hi[k][3]}
    o[d0]=__builtin_amdgcn_mfma_f32_32x32x16_bf16(pa0,PK(0),o[d0],0,0,0);
    o[d0]=__builtin_amdgcn_mfma_f32_32x32x16_bf16(pa1,PK(1),o[d0],0,0,0);
    o[d0]=__builtin_amdgcn_mfma_f32_32x32x16_bf16(pa2,PK(2),o[d0],0,0,0);
    o[d0]=__builtin_amdgcn_mfma_f32_32x32x16_bf16(pa3,PK(3),o[d0],0,0,0);
    #undef PK
  }
}

#ifndef ATTN_STORE16
#define ATTN_STORE16(p,v) (*(u32x4*)(p)=(v))
#endif
template<int THRL> __device__ __forceinline__ void attn_unit(int b,int qcol,int kcol,int vcol,int ocol,int qb,const bf16*Q,const bf16*__restrict__ K,const bf16*__restrict__ V,bf16*O,char*shm){
  int tid_=threadIdx.x; asm volatile("":"+v"(tid_));
  const int tid=tid_,lane=tid&63,r32=lane&31,hi=lane>>5; const int wid=__builtin_amdgcn_readfirstlane(tid>>6);
  const long rowbase=(long)b*SEQ; const int q0=qb*QB;
  const bf16*Qw=Q+(rowbase+q0+wid*QBLK)*DM+qcol;
  const bf16*Kh=K+rowbase*DM+kcol,*Vh=V+rowbase*DM+vcol;
  const unsigned lds0=(unsigned)(uintptr_t)shm;
  float*wsf=(float*)(shm+LDS_WS)+wid*64;
  const bf16*ksrc=Kh+(long)lane*DM+wid*8;
  const bf16*vsrc=Vh+(long)(16*(wid&3)+(lane>>2))*DM+(wid>>2)*32+(lane&3)*8;
  const unsigned kdst=lds0+LDS_K+wid*1024, vdst=lds0+LDS_V+wid*1024;
  #define DMA_K(t,slot) glds16(ksrc+(long)(t)*KVBLK*DM,(unsigned)__builtin_amdgcn_readfirstlane(kdst+(slot)))
  #define DMA_V(t,slot) glds16(vsrc+(long)(t)*KVBLK*DM,(unsigned)__builtin_amdgcn_readfirstlane(vdst+(slot)))
  const int vb0=(int)(lds0+LDS_V)+((lane>>4)&1)*32+(lane&3)*8+(4*hi+((lane&15)>>2))*64;
  const char*Kbase=shm+LDS_K; bf16x8 kf[8];
  const lds_cptr shm3=(lds_cptr)shm; const lds_cptr kp0=shm3+LDS_K+hi*1024+r32*16; const lds_cptr vp0=shm3+LDS_V+((lane>>4)&1)*32+(lane&3)*8+(4*hi+((lane&15)>>2))*64;
  const int NT=(q0+QB)/KVBLK;
  DMA_K(0,0);DMA_V(0,0);DMA_K(1,SLOTB);
  bf16x8 qr[4];
  #pragma unroll
  for(int d0=0;d0<4;++d0)qr[d0]=*reinterpret_cast<const bf16x8*>(&Qw[(long)r32*DM+d0*16+hi*8]);
  float l_reg=0.f;f32x16 o[2];o[0]=f32x16{};o[1]=f32x16{};const f32x16 negm=f32x16{};
  const int qrel=wid*QBLK+r32;
  #define CMASK(P0,P1,t) do{int jb_=(t)-(NT-4); if(jb_>=0)cmask(P0,P1,jb_,qrel,hi);}while(0)
  #define START(P0,P1) do{ _Pragma("unroll") for(int r=0;r<16;++r)P0[r]=__builtin_amdgcn_exp2f(P0[r]); }while(0)
  #define RESC() do{}while(0)
  f32x16 pA0,pA1,pB0,pB1;
  int sl_prev=0,sl_cur=0,sl_next=SLOTB;
  #define ROT() do{sl_prev=sl_cur;sl_cur=sl_next;sl_next=(sl_next==(NSLOT-1)*SLOTB)?0:sl_next+SLOTB;}while(0)
  DMA_K(2,2*SLOTB);
  WAIT_BAR(3);
  qkt(pA0,pA1,Kbase,qr,negm,r32,hi);asm volatile("s_nop 15\n\ts_nop 7":"+v"(pA0),"+v"(pA1));CMASK(pA0,pA1,0);
  START(pA0,pA1);
  _Pragma("unroll") for(int r=0;r<16;++r)pA1[r]=__builtin_amdgcn_exp2f(pA1[r]);
  WAIT_BAR(0);
  DMA_K(3,0);DMA_V(1,SLOTB);
  ROT();
  kload8(kf,kp0+sl_cur);
  WAIT_BAR(2);
  s16x4 vlo[8],vhi[8]; u32x4 pw0,pw1,pw2,pw3;
  #define PKW(P,B) cvtpk_s(P[B],P[B+1])
  #define PAF(k) __builtin_bit_cast(bf16x8,pw##k)
  #define VFR(i) (bf16x8){vlo[i][0],vlo[i][1],vlo[i][2],vlo[i][3],vhi[i][0],vhi[i][1],vhi[i][2],vhi[i][3]}
  #define PIN(x) asm volatile("":"+v"(x))
  #define MX3(a,b,c) __builtin_fmaxf(__builtin_fmaxf((a),(b)),(c))
  #define GAPA(MF,A0,A1,A2,A3,W0,W1,PW) do{ MF; sacc+=A0; sacc+=A1; sacc+=A2; sacc+=A3; PIN(sacc); W0; W1; PIN(PW); SBAR(); }while(0)
  #define EX(v) __builtin_amdgcn_exp2f(v)
  #define GAPB(MF,X,B) do{ MF; X[B]=EX(X[B]); X[B+1]=EX(X[B+1]); X[B+2]=EX(X[B+2]); X[B+3]=EX(X[B+3]); PIN(X); SBAR(); }while(0)
  #define VRD(i) do{ vlo[i]=vtr(vp_+(((i)>>2)*4096+((i)&3)*1024)); vhi[i]=vtr(vp_+(((i)>>2)*4096+((i)&3)*1024+512)); }while(0)
  #define KRD(G,j) do{ if(G){ kload2(kf,kp0+sl_next,j); SBAR(); } }while(0)
  #define STEP(C0,C1,P0,P1,t,GK,GV,GL) do{ SBAR(); \
    const lds_cptr vp_=vp0+sl_prev; \
    VRD(0); SBAR(); float sacc=(P0[0]+P0[1]); \
    GAPA(C0=__builtin_amdgcn_mfma_f32_32x32x16_bf16(kf[0],qr[0],negm,0,0,0), P0[2],P0[3],P0[4],P0[5],     pw0[0]=PKW(P0,0), pw0[1]=PKW(P0,2), pw0); \
    VRD(4); SBAR(); GAPA(C1=__builtin_amdgcn_mfma_f32_32x32x16_bf16(kf[1],qr[0],negm,0,0,0), P0[6],P0[7],P0[8],P0[9],     pw0[2]=PKW(P0,4), pw0[3]=PKW(P0,6), pw0); \
    VRD(1); SBAR(); GAPA(C0=__builtin_amdgcn_mfma_f32_32x32x16_bf16(kf[2],qr[1],C0,0,0,0),   P0[10],P0[11],P0[12],P0[13], pw1[0]=PKW(P0,8), pw1[1]=PKW(P0,10), pw1); \
    VRD(5); SBAR(); GAPA(C1=__builtin_amdgcn_mfma_f32_32x32x16_bf16(kf[3],qr[1],C1,0,0,0),   P0[14],P0[15],P1[0],P1[1],   pw1[2]=PKW(P0,12),pw1[3]=PKW(P0,14), pw1); \
    VRD(2); SBAR(); GAPA(C0=__builtin_amdgcn_mfma_f32_32x32x16_bf16(kf[4],qr[2],C0,0,0,0),   P1[2],P1[3],P1[4],P1[5],     pw2[0]=PKW(P1,0), pw2[1]=PKW(P1,2), pw2); \
    VRD(6); SBAR(); GAPA(C1=__builtin_amdgcn_mfma_f32_32x32x16_bf16(kf[5],qr[2],C1,0,0,0),   P1[6],P1[7],P1[8],P1[9],     pw2[2]=PKW(P1,4), pw2[3]=PKW(P1,6), pw2); \
    VRD(3); SBAR(); GAPA(C0=__builtin_amdgcn_mfma_f32_32x32x16_bf16(kf[6],qr[3],C0,0,0,0),   P1[10],P1[11],P1[12],P1[13], pw3[0]=PKW(P1,8), pw3[1]=PKW(P1,10), pw3); \
    VRD(7); SBAR(); GAPA(C1=__builtin_amdgcn_mfma_f32_32x32x16_bf16(kf[7],qr[3],C1,0,0,0),   P1[14],P1[15],0.f,0.f,       pw3[2]=PKW(P1,12),pw3[3]=PKW(P1,14), pw3); \
    l_reg+=sacc; \
    if(GK){DMA_K((t)+3,sl_cur);} if(GV){DMA_V((t)+1,sl_next);} \
    CMASK(C0,C1,t); \
    SBAR(); \
    GAPB(o[0]=__builtin_amdgcn_mfma_f32_32x32x16_bf16(PAF(0),VFR(0),o[0],0,0,0), C0,0); \
    GAPB(o[1]=__builtin_amdgcn_mfma_f32_32x32x16_bf16(PAF(0),VFR(4),o[1],0,0,0), C0,4); \
    KRD(GL,0); GAPB(o[0]=__builtin_amdgcn_mfma_f32_32x32x16_bf16(PAF(1),VFR(1),o[0],0,0,0), C0,8); \
    KRD(GL,1); GAPB(o[1]=__builtin_amdgcn_mfma_f32_32x32x16_bf16(PAF(1),VFR(5),o[1],0,0,0), C0,12); \
    KRD(GL,2); GAPB(o[0]=__builtin_amdgcn_mfma_f32_32x32x16_bf16(PAF(2),VFR(2),o[0],0,0,0), C1,0); \
    KRD(GL,3); GAPB(o[1]=__builtin_amdgcn_mfma_f32_32x32x16_bf16(PAF(2),VFR(6),o[1],0,0,0), C1,4); \
    GAPB(o[0]=__builtin_amdgcn_mfma_f32_32x32x16_bf16(PAF(3),VFR(3),o[0],0,0,0), C1,8); \
    GAPB(o[1]=__builtin_amdgcn_mfma_f32_32x32x16_bf16(PAF(3),VFR(7),o[1],0,0,0), C1,12); \
    }while(0)
  int t=1;
  #undef CMASK
  #define CMASK(P0,P1,t) do{}while(0)
  for(;t+5<NT;t+=2){
    STEP(pB0,pB1,pA0,pA1,t,true,true,true);     WAIT_BAR(2); RESC(); ROT();
    STEP(pA0,pA1,pB0,pB1,t+1,true,true,true);   WAIT_BAR(2); RESC(); ROT();
  }
  #undef CMASK
  #define CMASK(P0,P1,t) do{int jb_=(t)-(NT-4); if(jb_>=0)cmask(P0,P1,jb_,qrel,hi);}while(0)
  #define ENDW(tt) do{ if((tt)+3<NT){WAIT_BAR(2);} else if((tt)+2<NT){WAIT_BAR(1);} else {WAIT_BAR(0);} }while(0)
  for(;t+1<NT;t+=2){
    STEP(pB0,pB1,pA0,pA1,t,(t+3<NT),(t+1<NT),(t+1<NT));       ENDW(t);   RESC(); ROT();
    STEP(pA0,pA1,pB0,pB1,t+1,(t+4<NT),(t+2<NT),(t+2<NT));     ENDW(t+1); RESC(); ROT();
  }
  STEP(pB0,pB1,pA0,pA1,NT-1,false,false,false); RESC();
  { float sacc=pB0[0]+pB0[1]; _Pragma("unroll") for(int r=2;r<16;++r)sacc+=pB0[r]; _Pragma("unroll") for(int r=0;r<16;++r)sacc+=pB1[r]; l_reg+=sacc;
    pw0=(u32x4){PKW(pB0,0),PKW(pB0,2),PKW(pB0,4),PKW(pB0,6)};pw1=(u32x4){PKW(pB0,8),PKW(pB0,10),PKW(pB0,12),PKW(pB0,14)};pw2=(u32x4){PKW(pB1,0),PKW(pB1,2),PKW(pB1,4),PKW(pB1,6)};pw3=(u32x4){PKW(pB1,8),PKW(pB1,10),PKW(pB1,12),PKW(pB1,14)};
    SBAR(); pv(o,vb0+sl_cur,PAF(0),PAF(1),PAF(2),PAF(3)); }
  #undef PKW
  #undef PAF
  #undef VFR
  #undef PIN
  #undef MX3
  #undef GAPA
  #undef GAPB
  #undef EX
  #undef VRD
  #undef KRD
  #undef STEP
  #undef ENDW
  {auto rr=__builtin_amdgcn_permlane32_swap(__float_as_uint(l_reg),__float_as_uint(l_reg),false,false);l_reg=__uint_as_float(rr[0])+__uint_as_float(rr[1]);}
  if(hi==0)wsf[32+r32]=l_reg;asm volatile("s_waitcnt lgkmcnt(0)":::"memory");
  float rli[16];
  #pragma unroll
  for(int r=0;r<16;++r)rli[r]=__builtin_amdgcn_rcpf(wsf[32+crow(r,hi)]);
  bf16*Ow=O+(rowbase+q0+wid*QBLK)*DM+ocol;
  { bf16*stg=(bf16*)(shm+LDS_OST)+wid*2048;
    #pragma unroll
    for(int r=0;r<16;++r){const int orow=crow(r,hi);
      #pragma unroll
      for(int d0=0;d0<2;++d0)stg[orow*64+d0*32+r32]=__float2bfloat16(o[d0][r]*rli[r]);}
    asm volatile("s_waitcnt lgkmcnt(0)":::"memory");
    #pragma unroll
    for(int i=0;i<4;++i){const int row=i*8+(lane>>3),ch=lane&7; const u32x4 v=*(const u32x4*)(stg+row*64+ch*8); ATTN_STORE16(Ow+(long)row*DM+ch*8,v);} }
  asm volatile("s_waitcnt lgkmcnt(0)\n\ts_barrier":::"memory");
  #undef DMA_K
  #undef DMA_V
  #undef CMASK
  #undef START
  #undef RESC
  #undef ROT
}
constexpr int ATTN_LDS_BYTES=ALDS_BYTES;

#undef SBAR
#undef WAIT_BAR
#undef ATTN_STORE16
}
namespace attn128 {
using bf16=__hip_bfloat16;
using bf16x8=__attribute__((ext_vector_type(8)))short;
using s16x4=__attribute__((ext_vector_type(4)))short;
using f32x16=__attribute__((ext_vector_type(16)))float;
using u32x4=__attribute__((ext_vector_type(4)))unsigned;
constexpr int SEQ=2048,D=64,DM=1024;
constexpr int NW=8,QBLK=32,QB=QBLK*NW,KVBLK=64,NQB=SEQ/QB;
constexpr int ATTN_PITCH=DM, ATTN_UNIT_ROWS=QB;
__device__ __forceinline__ int crow(int r,int hi){return (r&3)+8*(r>>2)+4*hi;}
#define SBAR() __builtin_amdgcn_sched_barrier(0)
__device__ __forceinline__ void cmask(f32x16&p0,f32x16&p1,int jb,int qrel,int hi){
  const float NEG=-INFINITY; int kb=64*jb+4*hi;
  #pragma unroll
  for(int r=0;r<16;++r){int kv=kb+(r&3)+8*(r>>2); if(kv>qrel)p0[r]=NEG; if(kv+32>qrel)p1[r]=NEG;}
}

constexpr int NSLOT=3, SLOTB=8192;
constexpr int VSLOTB=2*SLOTB;
constexpr int LDS_K=0, LDS_V=NSLOT*SLOTB, LDS_WS=LDS_V+NSLOT*VSLOTB, LDS_OST=LDS_WS+NW*64*4, ALDS_BYTES=LDS_OST+NW*4096;
constexpr float C2=0.125f*1.4426950408889634f;
__device__ __forceinline__ void glds16(const void*gsrc,unsigned lds_dst){unsigned keep;
  asm volatile("s_mov_b32 %0, m0\n\ts_mov_b32 m0, %2\n\ts_nop 0\n\tglobal_load_lds_dwordx4 %1, off\n\ts_mov_b32 m0, %0":"=&s"(keep):"v"(gsrc),"s"(lds_dst):"memory");}
__device__ __forceinline__ float max3f(float a,float b,float c){float r;asm("v_max3_f32 %0, %1, %2, %3":"=v"(r):"v"(a),"v"(b),"v"(c));return r;}
__device__ __forceinline__ float max2f(float a,float b){float r;asm("v_max_f32_e32 %0, %1, %2":"=v"(r):"v"(a),"v"(b));return r;}
__device__ __forceinline__ float fadd_s(float a,float b){float r;asm("v_add_f32_e32 %0, %1, %2":"=v"(r):"v"(a),"v"(b));return r;}
__device__ __forceinline__ float fsub_s(float a,float b){float r;asm("v_sub_f32_e32 %0, %1, %2":"=v"(r):"v"(a),"v"(b));return r;}
typedef float f32x2_t __attribute__((ext_vector_type(2))); typedef __bf16 bf16x2_t __attribute__((ext_vector_type(2)));
__device__ __forceinline__ unsigned cvtpk_s(float lo,float hi){f32x2_t v={lo,hi};bf16x2_t b=__builtin_convertvector(v,bf16x2_t);return __builtin_bit_cast(unsigned,b);}
#define WAIT_BAR(N) asm volatile("s_waitcnt vmcnt(" #N ") lgkmcnt(0)\n\ts_barrier":::"memory")

__device__ __forceinline__ void qkt(f32x16&p0,f32x16&p1,const char*Kslot,const bf16x8*qr,const f32x16&negm,int r32,int hi){
  const char*kb=Kslot+hi*1024+r32*16;
  #pragma unroll
  for(int d0=0;d0<4;++d0){
    const bf16x8 b0=*reinterpret_cast<const bf16x8*>(kb+d0*2048);
    const bf16x8 b1=*reinterpret_cast<const bf16x8*>(kb+d0*2048+512);
    if(d0==0){p0=__builtin_amdgcn_mfma_f32_32x32x16_bf16(b0,qr[0],negm,0,0,0);p1=__builtin_amdgcn_mfma_f32_32x32x16_bf16(b1,qr[0],negm,0,0,0);}
    else{p0=__builtin_amdgcn_mfma_f32_32x32x16_bf16(b0,qr[d0],p0,0,0,0);p1=__builtin_amdgcn_mfma_f32_32x32x16_bf16(b1,qr[d0],p1,0,0,0);}}
}
typedef __attribute__((address_space(3))) const char* lds_cptr;
typedef short v4i16_t __attribute__((ext_vector_type(4)));
__device__ __forceinline__ void kload8(bf16x8*kf,lds_cptr kp){
  kf[0]=*(const __attribute__((address_space(3))) bf16x8*)(kp);      kf[1]=*(const __attribute__((address_space(3))) bf16x8*)(kp+512);
  kf[2]=*(const __attribute__((address_space(3))) bf16x8*)(kp+2048); kf[3]=*(const __attribute__((address_space(3))) bf16x8*)(kp+2560);
  kf[4]=*(const __attribute__((address_space(3))) bf16x8*)(kp+4096); kf[5]=*(const __attribute__((address_space(3))) bf16x8*)(kp+4608);
  kf[6]=*(const __attribute__((address_space(3))) bf16x8*)(kp+6144); kf[7]=*(const __attribute__((address_space(3))) bf16x8*)(kp+6656);
}
__device__ __forceinline__ void kload2(bf16x8*kf,lds_cptr kp,int j){ kf[2*j]=*(const __attribute__((address_space(3))) bf16x8*)(kp+j*2048); kf[2*j+1]=*(const __attribute__((address_space(3))) bf16x8*)(kp+j*2048+512); }
__device__ __forceinline__ s16x4 vtr(lds_cptr p){ return __builtin_bit_cast(s16x4,__builtin_amdgcn_ds_read_tr16_b64_v4i16((__attribute__((address_space(3))) v4i16_t*)p)); }
__device__ __forceinline__ float rowmax(const f32x16&p0,const f32x16&p1){
  float a=max3f(p0[0],p0[1],p1[0]),b=max3f(p0[2],p0[3],p1[1]);a=max3f(a,p1[2],p1[3]);
  #pragma unroll
  for(int r=4;r<16;r+=4){a=max3f(a,p0[r],p0[r+1]);b=max3f(b,p0[r+2],p0[r+3]);a=max3f(a,p1[r],p1[r+1]);b=max3f(b,p1[r+2],p1[r+3]);}
  const float m=max2f(a,b);
  auto rr=__builtin_amdgcn_permlane32_swap(__float_as_uint(m),__float_as_uint(m),false,false);
  return max2f(__uint_as_float(rr[0]),__uint_as_float(rr[1]));
}
__device__ __forceinline__ void pv(f32x16*o,int vb,bf16x8 pa0,bf16x8 pa1,bf16x8 pa2,bf16x8 pa3){
  #pragma unroll
  for(int d0=0;d0<4;++d0){s16x4 lo[4],hi[4];
    #pragma unroll
    for(int ks=0;ks<4;++ks){
      asm volatile("ds_read_b64_tr_b16 %0,%1 offset:%c2":"=&v"(lo[ks]):"v"(vb),"i"(d0*4096+ks*1024):"memory");
      asm volatile("ds_read_b64_tr_b16 %0,%1 offset:%c2":"=&v"(hi[ks]):"v"(vb),"i"(d0*4096+ks*1024+512):"memory");}
    asm volatile("s_waitcnt lgkmcnt(0)":::"memory");SBAR();
    #define PK(k) (bf16x8){lo[k][0],lo[k][1],lo[k][2],lo[k][3],hi[k][0],hi[k][1],hi[k][2],hi[k][3]}
    o[d0]=__builtin_amdgcn_mfma_f32_32x32x16_bf16(pa0,PK(0),o[d0],0,0,0);
    o[d0]=__builtin_amdgcn_mfma_f32_32x32x16_bf16(pa1,PK(1),o[d0],0,0,0);
    o[d0]=__builtin_amdgcn_mfma_f32_32x32x16_bf16(pa2,PK(2),o[d0],0,0,0);
    o[d0]=__builtin_amdgcn_mfma_f32_32x32x16_bf16(pa3,PK(3),o[d0],0,0,0);
    #undef PK
  }
}

#ifndef ATTN_STORE16
#define ATTN_STORE16(p,v) (*(u32x4*)(p)=(v))
#endif
template<int THRL> __device__ __forceinline__ void attn_unit(int b,int qcol,int kcol,int vcol,int ocol,int qb,const bf16*Q,const bf16*__restrict__ K,const bf16*__restrict__ V,bf16*O,char*shm){
  int tid_=threadIdx.x; asm volatile("":"+v"(tid_));
  const int tid=tid_,lane=tid&63,r32=lane&31,hi=lane>>5; const int wid=__builtin_amdgcn_readfirstlane(tid>>6);
  const long rowbase=(long)b*SEQ; const int q0=qb*QB;
  const bf16*Qw=Q+(rowbase+q0+wid*QBLK)*DM+qcol;
  const bf16*Kh=K+rowbase*DM+kcol,*Vh=V+rowbase*DM+vcol;
  const unsigned lds0=(unsigned)(uintptr_t)shm;
  float*wsf=(float*)(shm+LDS_WS)+wid*64;
  const bf16*ksrc=Kh+(long)lane*DM+wid*8;
  const bf16*vsrc=Vh+(long)(16*(wid&3)+(lane>>2))*DM+(wid>>2)*32+(lane&3)*8;
  const unsigned kdst=lds0+LDS_K+wid*1024, vdst=lds0+LDS_V+wid*1024;
  #define DMA_K(t,slot) glds16(ksrc+(long)(t)*KVBLK*DM,(unsigned)__builtin_amdgcn_readfirstlane(kdst+(slot)))
  #define DMA_V(t,slot) do{ glds16(vsrc+(long)(t)*KVBLK*DM,(unsigned)__builtin_amdgcn_readfirstlane(vdst+2*(slot))); glds16(vsrc+64+(long)(t)*KVBLK*DM,(unsigned)__builtin_amdgcn_readfirstlane(vdst+8192+2*(slot))); }while(0)
  const int vb0=(int)(lds0+LDS_V)+((lane>>4)&1)*32+(lane&3)*8+(4*hi+((lane&15)>>2))*64;
  const char*Kbase=shm+LDS_K; bf16x8 kf[8];
  const lds_cptr shm3=(lds_cptr)shm; const lds_cptr kp0=shm3+LDS_K+hi*1024+r32*16; const lds_cptr vp0=shm3+LDS_V+((lane>>4)&1)*32+(lane&3)*8+(4*hi+((lane&15)>>2))*64;
  const int NT=(q0+QB)/KVBLK;
  DMA_K(0,0);DMA_V(0,0);DMA_K(1,SLOTB);
  bf16x8 qr[4];
  #pragma unroll
  for(int d0=0;d0<4;++d0)qr[d0]=*reinterpret_cast<const bf16x8*>(&Qw[(long)r32*DM+d0*16+hi*8]);
  float l_reg=0.f;f32x16 o[4];o[0]=f32x16{};o[1]=f32x16{};o[2]=f32x16{};o[3]=f32x16{};const f32x16 negm=f32x16{};
  const int qrel=wid*QBLK+r32;
  #define CMASK(P0,P1,t) do{int jb_=(t)-(NT-4); if(jb_>=0)cmask(P0,P1,jb_,qrel,hi);}while(0)
  #define START(P0,P1) do{ _Pragma("unroll") for(int r=0;r<16;++r)P0[r]=__builtin_amdgcn_exp2f(P0[r]); }while(0)
  #define RESC() do{}while(0)
  f32x16 pA0,pA1,pB0,pB1;
  int sl_prev=0,sl_cur=0,sl_next=SLOTB;
  #define ROT() do{sl_prev=sl_cur;sl_cur=sl_next;sl_next=(sl_next==(NSLOT-1)*SLOTB)?0:sl_next+SLOTB;}while(0)
  DMA_K(2,2*SLOTB);
  WAIT_BAR(4);
  qkt(pA0,pA1,Kbase,qr,negm,r32,hi);asm volatile("s_nop 15\n\ts_nop 7":"+v"(pA0),"+v"(pA1));CMASK(pA0,pA1,0);
  START(pA0,pA1);
  _Pragma("unroll") for(int r=0;r<16;++r)pA1[r]=__builtin_amdgcn_exp2f(pA1[r]);
  WAIT_BAR(0);
  DMA_K(3,0);DMA_V(1,SLOTB);
  ROT();
  kload8(kf,kp0+sl_cur);
  WAIT_BAR(3);
  s16x4 vlo[8],vhi[8]; u32x4 pw0,pw1,pw2,pw3;
  #define PKW(P,B) cvtpk_s(P[B],P[B+1])
  #define PAF(k) __builtin_bit_cast(bf16x8,pw##k)
  #define VFR(i) (bf16x8){vlo[i][0],vlo[i][1],vlo[i][2],vlo[i][3],vhi[i][0],vhi[i][1],vhi[i][2],vhi[i][3]}
  #define PIN(x) asm volatile("":"+v"(x))
  #define MX3(a,b,c) __builtin_fmaxf(__builtin_fmaxf((a),(b)),(c))
  #define GAPA(MF,A0,A1,A2,A3,W0,W1,PW) do{ MF; sacc+=A0; sacc+=A1; sacc+=A2; sacc+=A3; PIN(sacc); W0; W1; PIN(PW); SBAR(); }while(0)
  #define EX(v) __builtin_amdgcn_exp2f(v)
  #define GAPB(MF,X,B) do{ MF; X[B]=EX(X[B]); X[B+1]=EX(X[B+1]); PIN(X); SBAR(); }while(0)
  #define VRD2(i) do{ vlo[i]=vtr(vp_+((((i)>>2)+2)*4096+((i)&3)*1024)); vhi[i]=vtr(vp_+((((i)>>2)+2)*4096+((i)&3)*1024+512)); }while(0)
  #define VRD(i) do{ vlo[i]=vtr(vp_+(((i)>>2)*4096+((i)&3)*1024)); vhi[i]=vtr(vp_+(((i)>>2)*4096+((i)&3)*1024+512)); }while(0)
  #define KRD(G,j) do{ if(G){ kload2(kf,kp0+sl_next,j); SBAR(); } }while(0)
  #define STEP(C0,C1,P0,P1,t,GK,GV,GL) do{ SBAR(); \
    const lds_cptr vp_=vp0+2*sl_prev; \
    VRD(0); SBAR(); float sacc=(P0[0]+P0[1]); \
    GAPA(C0=__builtin_amdgcn_mfma_f32_32x32x16_bf16(kf[0],qr[0],negm,0,0,0), P0[2],P0[3],P0[4],P0[5],     pw0[0]=PKW(P0,0), pw0[1]=PKW(P0,2), pw0); \
    VRD(4); SBAR(); GAPA(C1=__builtin_amdgcn_mfma_f32_32x32x16_bf16(kf[1],qr[0],negm,0,0,0), P0[6],P0[7],P0[8],P0[9],     pw0[2]=PKW(P0,4), pw0[3]=PKW(P0,6), pw0); \
    VRD(1); SBAR(); GAPA(C0=__builtin_amdgcn_mfma_f32_32x32x16_bf16(kf[2],qr[1],C0,0,0,0),   P0[10],P0[11],P0[12],P0[13], pw1[0]=PKW(P0,8), pw1[1]=PKW(P0,10), pw1); \
    VRD(5); SBAR(); GAPA(C1=__builtin_amdgcn_mfma_f32_32x32x16_bf16(kf[3],qr[1],C1,0,0,0),   P0[14],P0[15],P1[0],P1[1],   pw1[2]=PKW(P0,12),pw1[3]=PKW(P0,14), pw1); \
    VRD(2); SBAR(); GAPA(C0=__builtin_amdgcn_mfma_f32_32x32x16_bf16(kf[4],qr[2],C0,0,0,0),   P1[2],P1[3],P1[4],P1[5],     pw2[0]=PKW(P1,0), pw2[1]=PKW(P1,2), pw2); \
    VRD(6); SBAR(); GAPA(C1=__builtin_amdgcn_mfma_f32_32x32x16_bf16(kf[5],qr[2],C1,0,0,0),   P1[6],P1[7],P1[8],P1[9],     pw2[2]=PKW(P1,4), pw2[3]=PKW(P1,6), pw2); \
    VRD(3); SBAR(); GAPA(C0=__builtin_amdgcn_mfma_f32_32x32x16_bf16(kf[6],qr[3],C0,0,0,0),   P1[10],P1[11],P1[12],P1[13], pw3[0]=PKW(P1,8), pw3[1]=PKW(P1,10), pw3); \
    VRD(7); SBAR(); GAPA(C1=__builtin_amdgcn_mfma_f32_32x32x16_bf16(kf[7],qr[3],C1,0,0,0),   P1[14],P1[15],0.f,0.f,       pw3[2]=PKW(P1,12),pw3[3]=PKW(P1,14), pw3); \
    l_reg+=sacc; \
    if(GK){DMA_K((t)+3,sl_cur);} if(GV){DMA_V((t)+1,sl_next);} \
    CMASK(C0,C1,t); \
    SBAR(); \
    GAPB(o[0]=__builtin_amdgcn_mfma_f32_32x32x16_bf16(PAF(0),VFR(0),o[0],0,0,0), C0,0);  VRD2(0); SBAR(); \
    GAPB(o[1]=__builtin_amdgcn_mfma_f32_32x32x16_bf16(PAF(0),VFR(4),o[1],0,0,0), C0,2);  VRD2(4); SBAR(); \
    KRD(GL,0); GAPB(o[0]=__builtin_amdgcn_mfma_f32_32x32x16_bf16(PAF(1),VFR(1),o[0],0,0,0), C0,4);  VRD2(1); SBAR(); \
    KRD(GL,1); GAPB(o[1]=__builtin_amdgcn_mfma_f32_32x32x16_bf16(PAF(1),VFR(5),o[1],0,0,0), C0,6);  VRD2(5); SBAR(); \
    KRD(GL,2); GAPB(o[0]=__builtin_amdgcn_mfma_f32_32x32x16_bf16(PAF(2),VFR(2),o[0],0,0,0), C0,8);  VRD2(2); SBAR(); \
    KRD(GL,3); GAPB(o[1]=__builtin_amdgcn_mfma_f32_32x32x16_bf16(PAF(2),VFR(6),o[1],0,0,0), C0,10); VRD2(6); SBAR(); \
    GAPB(o[0]=__builtin_amdgcn_mfma_f32_32x32x16_bf16(PAF(3),VFR(3),o[0],0,0,0), C0,12); VRD2(3); SBAR(); \
    GAPB(o[1]=__builtin_amdgcn_mfma_f32_32x32x16_bf16(PAF(3),VFR(7),o[1],0,0,0), C0,14); VRD2(7); SBAR(); \
    GAPB(o[2]=__builtin_amdgcn_mfma_f32_32x32x16_bf16(PAF(0),VFR(0),o[2],0,0,0), C1,0); \
    GAPB(o[3]=__builtin_amdgcn_mfma_f32_32x32x16_bf16(PAF(0),VFR(4),o[3],0,0,0), C1,2); \
    GAPB(o[2]=__builtin_amdgcn_mfma_f32_32x32x16_bf16(PAF(1),VFR(1),o[2],0,0,0), C1,4); \
    GAPB(o[3]=__builtin_amdgcn_mfma_f32_32x32x16_bf16(PAF(1),VFR(5),o[3],0,0,0), C1,6); \
    GAPB(o[2]=__builtin_amdgcn_mfma_f32_32x32x16_bf16(PAF(2),VFR(2),o[2],0,0,0), C1,8); \
    GAPB(o[3]=__builtin_amdgcn_mfma_f32_32x32x16_bf16(PAF(2),VFR(6),o[3],0,0,0), C1,10); \
    GAPB(o[2]=__builtin_amdgcn_mfma_f32_32x32x16_bf16(PAF(3),VFR(3),o[2],0,0,0), C1,12); \
    GAPB(o[3]=__builtin_amdgcn_mfma_f32_32x32x16_bf16(PAF(3),VFR(7),o[3],0,0,0), C1,14); \
    }while(0)
  int t=1;
  #undef CMASK
  #define CMASK(P0,P1,t) do{}while(0)
  for(;t+5<NT;t+=2){
    STEP(pB0,pB1,pA0,pA1,t,true,true,true);     WAIT_BAR(3); RESC(); ROT();
    STEP(pA0,pA1,pB0,pB1,t+1,true,true,true);   WAIT_BAR(3); RESC(); ROT();
  }
  #undef CMASK
  #define CMASK(P0,P1,t) do{int jb_=(t)-(NT-4); if(jb_>=0)cmask(P0,P1,jb_,qrel,hi);}while(0)
  #define ENDW(tt) do{ if((tt)+3<NT){WAIT_BAR(3);} else if((tt)+2<NT){WAIT_BAR(2);} else {WAIT_BAR(0);} }while(0)
  for(;t+1<NT;t+=2){
    STEP(pB0,pB1,pA0,pA1,t,(t+3<NT),(t+1<NT),(t+1<NT));       ENDW(t);   RESC(); ROT();
    STEP(pA0,pA1,pB0,pB1,t+1,(t+4<NT),(t+2<NT),(t+2<NT));     ENDW(t+1); RESC(); ROT();
  }
  STEP(pB0,pB1,pA0,pA1,NT-1,false,false,false); RESC();
  { float sacc=pB0[0]+pB0[1]; _Pragma("unroll") for(int r=2;r<16;++r)sacc+=pB0[r]; _Pragma("unroll") for(int r=0;r<16;++r)sacc+=pB1[r]; l_reg+=sacc;
    pw0=(u32x4){PKW(pB0,0),PKW(pB0,2),PKW(pB0,4),PKW(pB0,6)};pw1=(u32x4){PKW(pB0,8),PKW(pB0,10),PKW(pB0,12),PKW(pB0,14)};pw2=(u32x4){PKW(pB1,0),PKW(pB1,2),PKW(pB1,4),PKW(pB1,6)};pw3=(u32x4){PKW(pB1,8),PKW(pB1,10),PKW(pB1,12),PKW(pB1,14)};
    SBAR(); pv(o,vb0+2*sl_cur,PAF(0),PAF(1),PAF(2),PAF(3)); }
  #undef PKW
  #undef PAF
  #undef VFR
  #undef PIN
  #undef MX3
  #undef GAPA
  #undef GAPB
  #undef EX
  #undef VRD
  #undef VRD2
  #undef KRD
  #undef STEP
  #undef ENDW
  {auto rr=__builtin_amdgcn_permlane32_swap(__float_as_uint(l_reg),__float_as_uint(l_reg),false,false);l_reg=__uint_as_float(rr[0])+__uint_as_float(rr[1]);}
  if(hi==0)wsf[32+r32]=l_reg;asm volatile("s_waitcnt lgkmcnt(0)":::"memory");
  float rli[16];
  #pragma unroll
  for(int r=0;r<16;++r)rli[r]=__builtin_amdgcn_rcpf(wsf[32+crow(r,hi)]);
  bf16*Ow=O+(rowbase+q0+wid*QBLK)*DM+ocol;
  { bf16*stg=(bf16*)(shm+LDS_OST)+wid*2048;
    #pragma unroll
    for(int hv=0;hv<2;++hv){
      #pragma unroll
      for(int r=0;r<16;++r){const int orow=crow(r,hi);
        #pragma unroll
        for(int d0=0;d0<2;++d0)stg[orow*64+d0*32+r32]=__float2bfloat16(o[2*hv+d0][r]*rli[r]);}
      asm volatile("s_waitcnt lgkmcnt(0)":::"memory");
      #pragma unroll
      for(int i=0;i<4;++i){const int row=i*8+(lane>>3),ch=lane&7; const u32x4 v=*(const u32x4*)(stg+row*64+ch*8); ATTN_STORE16(Ow+(long)row*DM+hv*64+ch*8,v);}
      asm volatile("s_waitcnt lgkmcnt(0)":::"memory"); } }
  asm volatile("s_waitcnt lgkmcnt(0)\n\ts_barrier":::"memory");
  #undef DMA_K
  #undef DMA_V
  #undef CMASK
  #undef START
  #undef RESC
  #undef ROT
}
constexpr int ATTN_LDS_BYTES=ALDS_BYTES;

#undef SBAR
#undef WAIT_BAR
#undef ATTN_STORE16
}
constexpr size_t WS_ATT0 = WS_ACT, WS_ATT1 = WS_ACT + 32 * MiB;

__device__ __forceinline__ void diff_combine(const Params& P, int b, int h, int qb) {
    int tid_ = threadIdx.x; asm volatile("" : "+v"(tid_));
    const int tid = tid_, lane = tid & 63, wid = tid >> 6;
    const float lam = __expf(wave_sum(P.in[I_LQ1][lane] * P.in[I_LK1][lane])) - __expf(wave_sum(P.in[I_LQ2][lane] * P.in[I_LK2][lane])) + 0.2f;
    const int ch = lane & 15;
    const f32x4 g0 = *(const f32x4*)(P.in[I_SG] + 8 * ch), g1 = *(const f32x4*)(P.in[I_SG] + 8 * ch + 4);
    const size_t row0 = (size_t)b * SEQ + qb * 256 + wid * 32 + (lane >> 4);
    const bf16_t* s0 = (const bf16_t*)(P.ws + WS_ATT0) + row0 * D + h * 128 + 8 * ch; const bf16_t* s1 = (const bf16_t*)(P.ws + WS_ATT1) + row0 * D + h * 128 + 8 * ch;
    bf16_t* dst = (bf16_t*)(P.ws + WS_MA) + row0 * MA_LD + h * 128 + 8 * ch;
#pragma unroll
    for (int hb = 0; hb < 2; ++hb) { u32x4 ra[4], rb[4];
#pragma unroll
        for (int q = 0; q < 4; ++q) { const int it = 4 * hb + q; ra[q] = *(const u32x4*)(s0 + (size_t)(4 * it) * D); rb[q] = *(const u32x4*)(s1 + (size_t)(4 * it) * D); }
        asm volatile("" ::: "memory");
#pragma unroll
        for (int q = 0; q < 4; ++q) { const int it = 4 * hb + q;
            f32x4 a0, a1, b0, b1; pg::unpack8(ra[q], a0, a1); pg::unpack8(rb[q], b0, b1);
            const f32x4 o0 = a0 - lam * b0, o1 = a1 - lam * b1;
            float ss = (o0[0] * o0[0] + o0[1] * o0[1]) + (o0[2] * o0[2] + o0[3] * o0[3]) + (o1[0] * o1[0] + o1[1] * o1[1]) + (o1[2] * o1[2] + o1[3] * o1[3]);
            ss += __shfl_xor(ss, 1); ss += __shfl_xor(ss, 2); ss += __shfl_xor(ss, 4); ss += __shfl_xor(ss, 8);
            const float r = rsqrtf(ss * (1.f / 128.f) + EPS) * 0.8f;
            *(u32x4*)(dst + (size_t)(4 * it) * MA_LD) = pg::pack8(o0 * r * g0, o1 * r * g1); }
        asm volatile("" ::: "memory"); }
}
__device__ __forceinline__ void attn_phase(const Params& P, char* lds, int vcu, int G) {
    using attn_body::bf16;
    const bf16* Q = (const bf16*)(P.ws + WS_Q); const bf16* K = (const bf16*)(P.ws + WS_K); const bf16* V = (const bf16*)(P.ws + WS_V);
    for (int v = vcu; v < 256; v += G) {
        const int bh = v >> 2, b = bh >> 3, h = bh & 7, s = v & 3;
        for (int i = 0; i < 2; ++i) { const int qb = i == 0 ? 7 - s : s;
#ifndef ATTN_V128
#define ATTN_V128 1
#endif
#if ATTN_V128
            for (int m = 0; m < 2; ++m) {
#if EXPERTS_IN_ATTN
#ifndef CONV_SLOTS
#define CONV_SLOTS 4
#endif
#ifndef CONV_SPLIT
#define CONV_SPLIT 1
#endif
                if (CONV_SLOTS == 2 ? (i == 0 && m == ((v >> 2) & 1)) : ((i * 2 + m - (((v >> 2) + v) & 3)) & (CONV_SPLIT == 2 ? 1 : 3)) == 0) {
                    constexpr int per = (EXP_M10 - EXP_ATT0) / 256; const int hsel = CONV_SPLIT == 2 ? (((i * 2 + m - (((v >> 2) + v) & 3)) >> 1) & 1) : 0;
                    expert_convert_slice(P, (LAS unsigned char*)lds, EXP_ATT0 + v * per + hsel * (per / 2), CONV_SPLIT == 2 ? EXP_ATT0 + v * per + (hsel + 1) * (per / 2) : EXP_ATT0 + (v + 1) * per);
#if defined(PROBE_CONV2)
                    asm volatile("s_waitcnt vmcnt(0) lgkmcnt(0)" ::: "memory"); __syncthreads(); expert_convert_slice(P, (LAS unsigned char*)lds, EXP_ATT0 + v * per, EXP_ATT0 + (v + 1) * per, true);
#endif
                    asm volatile("s_waitcnt vmcnt(0) lgkmcnt(0)" ::: "memory"); __syncthreads(); }
#endif
                attn128::attn_unit<8>(b, h * 128 + m * 64, h * 128 + m * 64, h * 128, h * 128, qb, (const attn128::bf16*)Q, (const attn128::bf16*)K, (const attn128::bf16*)V, (attn128::bf16*)(P.ws + (m == 0 ? WS_ATT0 : WS_ATT1)), lds); }
#else
            for (int pass = 0; pass < 4; ++pass) { const int m = pass >> 1, vh = pass & 1;
#if EXPERTS_IN_ATTN
                if (i * 4 + pass == (((v >> 2) + v) & 3)) {
                    constexpr int per = (EXP_M10 - EXP_ATT0) / 256; expert_convert_slice(P, (LAS unsigned char*)lds, EXP_ATT0 + v * per, EXP_ATT0 + (v + 1) * per);
                    asm volatile("s_waitcnt vmcnt(0) lgkmcnt(0)" ::: "memory"); __syncthreads(); }
#endif
                attn_body::attn_unit<8>(b, h * 128 + m * 64, h * 128 + m * 64, h * 128 + vh * 64, h * 128 + vh * 64, qb, Q, K, V, (bf16*)(P.ws + (m == 0 ? WS_ATT0 : WS_ATT1)), lds); }
#endif
            asm volatile("s_waitcnt vmcnt(0)" ::: "memory");
            diff_combine(P, b, h, qb);
        }
    }
}

__device__ __forceinline__ void ssm1_phase(const Params& P, LAS unsigned char* lds, int vcu, int G) {
    const int tid = opaque_tid(), lane = tid & 63, wid = __builtin_amdgcn_readfirstlane(tid >> 6), fr = lane & 15, fq = lane >> 4;
    LAS float* Sl = (LAS float*)lds;
    for (int u = vcu; u < SSM_G * BATCH; u += G) {
        const int g = u >> 3, b = u & 7;
        bf16_t* A = (bf16_t*)(P.ws + WS_ACAT) + (size_t)(g * ACAT_ROWS + b * NCH) * ACAT_LD;
        const bf16_t* Bw = (const bf16_t*)(P.ws + WS_WS_T) + (size_t)(g * 128 + 16 * wid + fr) * 512 + fq * 8;
        constexpr int SA_OFF = 40960, SA_RS = 1040;
#pragma unroll
        for (int i = 0; i < 8; ++i) { const int r = wid * 8 + i;
            __builtin_amdgcn_global_load_lds((const unsigned*)(A + (size_t)r * ACAT_LD + lane * 8), (LAS unsigned*)(lds + SA_OFF + r * SA_RS), 16, 0, 0); }
        bf16x8 bfr[16];
#pragma unroll
        for (int ks = 0; ks < 16; ++ks) bfr[ks] = *(const bf16x8*)(Bw + ks * 32);
        asm volatile("s_waitcnt vmcnt(0)" ::: "memory");
        __syncthreads();
        f32x4 acc[4];
#pragma unroll
        for (int m = 0; m < 4; ++m) acc[m] = (f32x4){0.f, 0.f, 0.f, 0.f};
#pragma unroll
        for (int ks = 0; ks < 16; ++ks) {
#pragma unroll
            for (int m = 0; m < 4; ++m) { const bf16x8 af = *(const LAS bf16x8*)(lds + SA_OFF + (16 * m + fr) * SA_RS + ks * 64 + fq * 16);
                acc[m] = __builtin_amdgcn_mfma_f32_16x16x32_bf16(af, bfr[ks], acc[m], 0, 0, 0); }
        }
#pragma unroll
        for (int m = 0; m < 4; ++m)
#pragma unroll
            for (int q = 0; q < 4; ++q) Sl[(16 * m + 4 * fq + q) * 129 + 16 * wid + fr] = acc[m][q];
        __syncthreads();
        if (tid < SSM_P) {
            const int p = tid; const SsmGP gp = ssm_gp(P, g, p); float aLr, aLi; ssm_pow(gp, CH_L, aLr, aLi);
            float xr = 0.f, xi = 0.f;
            bf16_t* xp = A + 512 + p;
            for (int c = 0; c < NCH; ++c) {
                xp[(size_t)c * ACAT_LD] = (bf16_t)f2bf(xr); xp[(size_t)c * ACAT_LD + 64] = (bf16_t)f2bf(xi);
                const float sr = Sl[c * 129 + p], si = Sl[c * 129 + 64 + p];
                const float nr = aLr * xr - aLi * xi + sr, ni = aLr * xi + aLi * xr + si; xr = nr; xi = ni;
            }
        }
        __syncthreads();
    }
}
namespace pg {
struct Ssm2Sched {
    unsigned char* ws; int G, c;
    __device__ __forceinline__ void init(unsigned char* ws_, int G_, int c_) { ws = ws_; G = G_; c = c_; }
    __device__ __forceinline__ bool next(int i, Unit& u) const {
        const int L = i * G + c; if (L >= SSM_G * 4) return false;
        const int g = L >> 2; u.pm = (L >> 1) & 1; u.pn = L & 1; u.aux = g; u.aux2 = 0; u.ord = i; const LaneRC rc;
        u.A = (const char*)((const bf16_t*)(ws + WS_ACAT) + (size_t)g * ACAT_ROWS * ACAT_LD); u.B = (const char*)((const bf16_t*)(ws + WS_BT_SSM) + ((size_t)g * 512 + u.pn * BM) * ACAT_LD);
#pragma unroll
        for (int h = 0; h < 2; ++h)
#pragma unroll
            for (int j = 0; j < 2; ++j) u.aoff[h][j] = (unsigned)(((u.pm * BM + 128 * h + rc.R[j]) * ACAT_LD + rc.C[j]) * 2);
        return true;
    }
};
}

constexpr int RT_LG_OFF = RING_BYTES + 2048;
constexpr int RT_HIST_OFF = RT_LG_OFF + 64 * 33 * 4;
__device__ __forceinline__ void router_phase(const Params& P, LAS unsigned char* lds, int vcu, int G) {
    const int tid = opaque_tid(), lane = tid & 63, wid = __builtin_amdgcn_readfirstlane(tid >> 6);
    const float* wrt = (const float*)(P.ws + WS_WR_T);
#pragma unroll
    for (int i = 0; i < 16; ++i) __builtin_amdgcn_global_load_lds((const unsigned*)(wrt + (size_t)(tid + NTHREADS * i) * 4), (LAS unsigned*)(lds + wid * 1024 + i * 8192), 16, 0, 0);
    LAS float* lg = (LAS float*)(lds + RT_LG_OFF); LAS int* hist = (LAS int*)(lds + RT_HIST_OFF);
    int* slot_tok = (int*)(P.ws + WS_SLOT_TOK); float* slot_gate = (float*)(P.ws + WS_SLOT_GATE); int* tok_ep = (int*)(P.ws + WS_TOK_EP);
    unsigned char* H2 = P.ws + WS_H2;
    for (int tb = vcu; tb < T / 64; tb += G) {
        if (tid < 64) hist[tid] = 0;
        _Pragma("clang loop unroll(disable)") for (int pass = 0; pass < 2; ++pass) {
            const int t0 = tb * 64 + wid * 8 + pass * 4;
            f32x4 h[4][4];
            { u32x2 hr[4][4];
#pragma unroll
              for (int t = 0; t < 4; ++t)
#pragma unroll
                  for (int j = 0; j < 4; ++j) hr[t][j] = NT_LOAD((const u32x2*)((const bf16_t*)(P.ws + WS_X1) + (size_t)(t0 + t) * D) + lane + 64 * j);
#pragma unroll
              for (int t = 0; t < 4; ++t)
#pragma unroll
                  for (int j = 0; j < 4; ++j) h[t][j] = (f32x4){bflo(hr[t][j].x), bfhi(hr[t][j].x), bflo(hr[t][j].y), bfhi(hr[t][j].y)}; }
            if (pass == 0) { asm volatile("s_waitcnt vmcnt(0)" ::: "memory"); __syncthreads(); }
            f32x2 ha[4][4], hb[4][4];
#pragma unroll
            for (int tp = 0; tp < 2; ++tp) {
                float s0 = 0.f, s1 = 0.f;
#pragma unroll
                for (int j = 0; j < 4; ++j) { const f32x4 a = h[2 * tp][j], b = h[2 * tp + 1][j]; s0 += (a.x * a.x + a.y * a.y) + (a.z * a.z + a.w * a.w); s1 += (b.x * b.x + b.y * b.y) + (b.z * b.z + b.w * b.w); }
                const float r0 = rsqrtf(wave_sum(s0) * (1.f / D) + EPS), r1 = rsqrtf(wave_sum(s1) * (1.f / D) + EPS);
#pragma unroll
                for (int j = 0; j < 4; ++j) { const f32x4 g2 = ((const f32x4*)P.in[I_G2])[lane + 64 * j]; const f32x4 a = h[2 * tp][j] * r0 * g2, b = h[2 * tp + 1][j] * r1 * g2;
                    ((unsigned*)(H2 + (size_t)(t0 + 2 * tp) * D))[lane + 64 * j] = pk4_fp8(a.x, a.y, a.z, a.w);
                    ((unsigned*)(H2 + (size_t)(t0 + 2 * tp + 1) * D))[lane + 64 * j] = pk4_fp8(b.x, b.y, b.z, b.w);
#pragma unroll
                    for (int c = 0; c < 4; ++c) { const f32x2 pr = {a[c], b[c]}; if (tp == 0) ha[j][c] = pr; else hb[j][c] = pr; } }
            }
            f32x2 v[64];
#pragma unroll
            for (int e = 0; e < NE; ++e) { f32x2 a0 = {0.f, 0.f}, a1 = {0.f, 0.f};
                f32x4 w[4];
#pragma unroll
                for (int j = 0; j < 4; ++j) w[j] = ((const LAS f32x4*)(lds + e * 4096))[lane + 64 * j];
#pragma unroll
                for (int j = 0; j < 4; ++j)
#pragma unroll
                    for (int c = 0; c < 4; ++c) { const f32x2 ww = {w[j][c], w[j][c]}; a0 += ha[j][c] * ww; a1 += hb[j][c] * ww; }
                v[e] = a0; v[32 + e] = a1; }
#pragma unroll
            for (int half = 32; half >= 1; half >>= 1) { const bool upper = (lane & half) != 0;
#pragma unroll
                for (int i = 0; i < half; ++i) { const f32x2 send = upper ? v[i] : v[i + half], keep = upper ? v[i + half] : v[i]; const f32x2 got = {__shfl_xor(send.x, half), __shfl_xor(send.y, half)}; v[i] = keep + got; } }
            const float br = P.in[I_BR][lane & 31]; const int tl = wid * 8 + pass * 4 + 2 * (lane >> 5);
            lg[tl * 33 + (lane & 31)] = v[0].x + br; lg[(tl + 1) * 33 + (lane & 31)] = v[0].y + br;
        }
        __syncthreads();
        if (wid == 0) {
            const int tok = tb * 64 + lane;
            float tv[4]; int ti[4];
#pragma unroll
            for (int k = 0; k < 4; ++k) { tv[k] = -INFINITY; ti[k] = 0; }
            for (int e = 0; e < NE; ++e) { const float x = lg[lane * 33 + e];
                if (x > tv[3]) { if (x > tv[2]) { tv[3] = tv[2]; ti[3] = ti[2]; if (x > tv[1]) { tv[2] = tv[1]; ti[2] = ti[1]; if (x > tv[0]) { tv[1] = tv[0]; ti[1] = ti[0]; tv[0] = x; ti[0] = e; } else { tv[1] = x; ti[1] = e; } } else { tv[2] = x; ti[2] = e; } } else { tv[3] = x; ti[3] = e; } } }
            const float e1 = __expf(tv[1] - tv[0]), e2 = __expf(tv[2] - tv[0]), e3 = __expf(tv[3] - tv[0]); const float inv = 1.f / (1.f + e1 + e2 + e3);
            const float gk[4] = {inv, e1 * inv, e2 * inv, e3 * inv};
            int lp[4];
#pragma unroll
            for (int k = 0; k < 4; ++k) lp[k] = atomicAdd((int*)&hist[ti[k]], 1);
            asm volatile("s_waitcnt lgkmcnt(0)" ::: "memory");
            { const int l2 = opaque_tid() & 63;
              if (l2 < NE) { const int n = hist[l2]; hist[32 + l2] = n ? (int)atomicAdd((unsigned*)(P.ws + WS_CTL) + CW_CNT + l2, (unsigned)n) : 0; } }
            asm volatile("s_waitcnt vmcnt(0) lgkmcnt(0)" ::: "memory");
#pragma unroll
            for (int k = 0; k < 4; ++k) { const int e = ti[k], pos = hist[32 + e] + lp[k];
                slot_tok[(size_t)e * CAP + pos] = tok; slot_gate[(size_t)e * CAP + pos] = gk[k]; tok_ep[tok * 4 + k] = (e << 16) | pos; }
        }
        __syncthreads();
    }
}

#ifndef COMB_Y_DEFAULT
#define COMB_Y_LOAD(p) NT_LOAD(p)
#else
#define COMB_Y_LOAD(p) (*(p))
#endif
__device__ __forceinline__ void combine_phase(const Params& P, LAS unsigned char* lds, int vcu, int G) {
    const int tid = opaque_tid(), lane = tid & 63, wid = __builtin_amdgcn_readfirstlane(tid >> 6);
    const LAS int* tab = (const LAS int*)(lds + pg::TAB_OFF);
    const int* tok_ep = (const int*)(P.ws + WS_TOK_EP); const bf16_t* Y = (const bf16_t*)(P.ws + WS_Y); const float* sgate = (const float*)(P.ws + WS_SLOT_GATE);
    for (int tok = (vcu * NWAVES + wid) * 2; tok < T; tok += G * NWAVES * 2) {
        f32x4 a[2][4]; u32x2 xr[2][4]; u32x2 yv[2][4][4]; float gk[2][4];
#pragma unroll
        for (int tt = 0; tt < 2; ++tt) {
#pragma unroll
            for (int j = 0; j < 4; ++j) xr[tt][j] = NT_LOAD((const u32x2*)((const bf16_t*)(P.ws + WS_X1) + (size_t)(tok + tt) * D) + lane + 64 * j);
#pragma unroll
            for (int k = 0; k < 4; ++k) { const int ep = tok_ep[(tok + tt) * 4 + k]; const int slot = tab[ep >> 16] * 256 + (ep & 0xffff); gk[tt][k] = sgate[(size_t)(ep >> 16) * CAP + (ep & 0xffff)];
#pragma unroll
                for (int j = 0; j < 4; ++j) yv[tt][k][j] = COMB_Y_LOAD((const u32x2*)(Y + (size_t)slot * D) + lane + 64 * j); } }
        asm volatile("" ::: "memory");
#pragma unroll
        for (int tt = 0; tt < 2; ++tt) {
#pragma unroll
            for (int j = 0; j < 4; ++j) a[tt][j] = (f32x4){bflo(xr[tt][j].x), bfhi(xr[tt][j].x), bflo(xr[tt][j].y), bfhi(xr[tt][j].y)};
#pragma unroll
            for (int k = 0; k < 4; ++k)
#pragma unroll
                for (int j = 0; j < 4; ++j) { const u32x2 w = yv[tt][k][j]; a[tt][j] += gk[tt][k] * (f32x4){bflo(w.x), bfhi(w.x), bflo(w.y), bfhi(w.y)}; }
#pragma unroll
            for (int j = 0; j < 4; ++j) NT_STORE(a[tt][j], (f32x4*)(P.out + (size_t)(tok + tt) * D) + lane + 64 * j); }
    }
}
#define XB_TMO      128
#define XB_XCNT(j)  (256  + 64 * (j))
#define XB_XSUB(j)  (1280 + 64 * (j))
#define XB_XGEN(j)  (2304 + 64 * (j))
#define XB_TOP      3328
#define XB_TOPGEN   3392
#define XCD_BAR_WORDS 3456
#define XB_SPIN_CAP (1u << 18)
__device__ __forceinline__ unsigned xb_ld(unsigned* p)              { return __hip_atomic_load(p, __ATOMIC_RELAXED, __HIP_MEMORY_SCOPE_AGENT); }
__device__ __forceinline__ unsigned xb_add(unsigned* p, unsigned v) { return __hip_atomic_fetch_add(p, v, __ATOMIC_RELAXED, __HIP_MEMORY_SCOPE_AGENT); }
__device__ __forceinline__ unsigned xb_xcc_id() { return (unsigned)__builtin_amdgcn_s_getreg((3 << 11) | 20) & 0xFu; }
#define XB_SPIN(cond, bar) do { unsigned _sp = 0; while (cond) { __builtin_amdgcn_s_sleep(1); \
    if ((++_sp & 255u) == 0u) { if (xb_ld(&(bar)[XB_TMO])) break; if (_sp > XB_SPIN_CAP) { atomicAdd(&(bar)[XB_TMO], 1u); break; } } } } while (0)
struct XcdBarrier { unsigned* bar; unsigned x; volatile LAS unsigned* st; };
__device__ __forceinline__ XcdBarrier xcd_barrier_post(unsigned* bar, volatile LAS unsigned* st) {
    XcdBarrier b; b.bar = bar; b.x = xb_xcc_id(); b.st = st;
    if (threadIdx.x == 0) (void)xb_add(&bar[XB_XCNT(b.x)], 1u);
    return b;
}
__device__ __forceinline__ void xcd_barrier_complete(unsigned* bar, unsigned x, unsigned& nloc, unsigned& nx) {
    const unsigned G = gridDim.x * gridDim.y * gridDim.z;
    unsigned sum, cnt, mine, sp = 0u;
    for (;;) {
        sum = 0u; cnt = 0u; mine = 0u;
#pragma unroll
        for (unsigned j = 0; j < 16; ++j) { const unsigned c = xb_ld(&bar[XB_XCNT(j)]); sum += c; cnt += (c > 0u) ? 1u : 0u; mine = (j == x) ? c : mine; }
        if (sum == G) break;
        __builtin_amdgcn_s_sleep(1);
        if ((++sp & 255u) == 0u) { if (xb_ld(&bar[XB_TMO])) break; if (sp > XB_SPIN_CAP) { atomicAdd(&bar[XB_TMO], 1u); break; } }
    }
    nloc = mine > 0u ? mine : 1u; nx = cnt > 0u ? cnt : 1u;
}
__device__ __forceinline__ void xcd_barrier(const XcdBarrier& b) {
    asm volatile("s_waitcnt vmcnt(0)" ::: "memory");
    __syncthreads();
    if (threadIdx.x == 0) {
        unsigned* bar = b.bar;
        __builtin_amdgcn_s_waitcnt(0);
        unsigned nloc = b.st[0], nx = b.st[1];
        if (nloc == 0u) { xcd_barrier_complete(bar, b.x, nloc, nx); b.st[0] = nloc; b.st[1] = nx; }
        const unsigned old = xb_add(&bar[XB_XSUB(b.x)], 1u);
        const unsigned gen = old / nloc;
        if (old + 1u == (gen + 1u) * nloc) {
            __builtin_amdgcn_fence(__ATOMIC_RELEASE, "agent");
            asm volatile("s_waitcnt vmcnt(0)" ::: "memory");
            const unsigned og = xb_add(&bar[XB_TOP], 1u);
            const unsigned tg = og / nx;
            if (og + 1u == (tg + 1u) * nx) xb_add(&bar[XB_TOPGEN], 1u);
            else XB_SPIN(xb_ld(&bar[XB_TOPGEN]) == tg, bar);
            __builtin_amdgcn_fence(__ATOMIC_ACQUIRE, "agent");
            xb_add(&bar[XB_XGEN(b.x)], 1u);
            asm volatile("s_waitcnt vmcnt(0)" ::: "memory");
        } else {
            XB_SPIN(xb_ld(&bar[XB_XGEN(b.x)]) == gen, bar);
            __builtin_amdgcn_fence(__ATOMIC_ACQUIRE, "agent");
            asm volatile("s_waitcnt vmcnt(0)" ::: "memory");
        }
    }
    __syncthreads();
}
#ifndef PH_MASK
#define PH_MASK 0xffffffffu
#endif
__global__ void __launch_bounds__(NTHREADS, 2) mega_fwd(Params P) {
    extern __shared__ __attribute__((aligned(16))) unsigned char lds_[];
    LAS unsigned char* lds = (LAS unsigned char*)lds_;
    const int tid = threadIdx.x;
    const int G = gridDim.x, bx = blockIdx.x, vcu = (G % 8 == 0) ? (bx % 8) * (G / 8) + bx / 8 : bx;
    for (int u = tid; u < (LDS_BYTES - RING_BYTES) / 4; u += NTHREADS) ((LAS unsigned*)(lds + RING_BYTES))[u] = 0u;
    __syncthreads();
    unsigned* ctl = (unsigned*)(P.ws + WS_CTL);
    const XcdBarrier bar = xcd_barrier_post(ctl + CW_BAR, (volatile LAS unsigned*)(lds + MISC_OFF) + 8);
#ifndef PH_REP
#define PH_REP 0u
#endif
#ifndef BAR_REP
#define BAR_REP 1
#endif
#define GRID_BAR() do { for (int b_ = 0; b_ < BAR_REP; ++b_) xcd_barrier(bar); } while (0)
#define ON(k) for (int r_ = 0; r_ < 1 + (int)((PH_REP >> (k)) & 1u); ++r_) if ((PH_MASK >> (k)) & 1u)
#ifndef FWD_REP
#define FWD_REP 1
#endif
    for (int fwd_ = 0; fwd_ < FWD_REP; ++fwd_) {
    if (fwd_ > 0) { GRID_BAR(); if (bx == 0 && tid < 64) ctl[CW_CNT + tid] = 0u; }
    ON(0) p0_prologue(P, lds, vcu, G);
    GRID_BAR();
    ON(1) { pg::DenseSched S; S.init((const bf16_t*)(P.ws + WS_XN), D, (const bf16_t*)(P.ws + WS_WIN_T), D, T, IN_W, G, bx);
        pg::EpiInProj E; E.ws = P.ws; E.qg = P.in[I_QG]; E.kg = P.in[I_KG];
#if defined(PROBE_NULL_EPI)
        if (r_ == 1) { pg::EpiNull EN; pg::gemm_phase(lds, S, EN, D / 64, D); } else
#endif
#ifndef INPROJ_BAUX
#define INPROJ_BAUX 0
#endif
        pg::gemm_phase<false, INPROJ_BAUX>(lds, S, E, D / 64, D);
#if EXPERTS_IN_ATTN
        if (r_ == 0 && G == 256 && bx >= 128) expert_convert_slice(P, lds, EXP_IN0 + (bx - 128) * EXP_N_IN, EXP_IN0 + (bx - 127) * EXP_N_IN);
        __syncthreads();
#endif
    }
    GRID_BAR();
    ON(2) { ssm_toeplitz_expand(P, vcu, G); ssm1_phase(P, lds, vcu, G); }
    ON(3) attn_phase(P, (char*)lds_, vcu, G);
    GRID_BAR();
    ON(4) { pg::Ssm2Sched S; S.init(P.ws, G, bx); pg::EpiSsm2 E; E.ws = P.ws; pg::gemm_phase(lds, S, E, ACAT_LD / 64, ACAT_LD);
#if EXPERTS_IN_ATTN
        if (r_ == 0 && G == 256 && bx >= 128) expert_convert_slice(P, lds, EXP_S20 + (bx - 128) * EXP_N_S2, EXP_S20 + (bx - 127) * EXP_N_S2);
        __syncthreads();
#endif
    }
    GRID_BAR();
    ON(5) { pg::DenseSched S; S.init((const bf16_t*)(P.ws + WS_Z), SSM_W, (const bf16_t*)(P.ws + WS_WGLU_T), SSM_W, T, SSM_W, G, bx);
        pg::EpiGlu E; E.ws = P.ws; E.bglu = P.in[I_BGLU]; pg::gemm_phase(lds, S, E, SSM_W / 64, SSM_W);
#if EXPERTS_IN_ATTN
        if (r_ == 0 && G == 256 && bx >= 128) expert_convert_slice(P, lds, EXP_GLU0 + (bx - 128) * EXP_N_GLU, EXP_GLU0 + (bx - 127) * EXP_N_GLU);
        __syncthreads();
#endif
    }
    GRID_BAR();
    ON(6) { pg::DenseSched S; S.init((const bf16_t*)(P.ws + WS_MA), MA_LD, (const bf16_t*)(P.ws + WS_WP_T), MA_LD, T, D, G, bx);
        pg::EpiMerged E; E.ws = P.ws; pg::gemm_phase(lds, S, E, MA_LD / 64, MA_LD); }
    GRID_BAR();
    ON(7) { pg::DenseSched S; S.init((const bf16_t*)(P.ws + WS_MERGED), D, (const bf16_t*)(P.ws + WS_WOUT_T), D, T, D, G, bx);
        pg::EpiWout E; E.x = P.in[I_X]; E.out = (bf16_t*)(P.ws + WS_X1); pg::gemm_phase(lds, S, E, D / 64, D); }
    GRID_BAR();
    ON(8) router_phase(P, lds, vcu, G);
    GRID_BAR();
    pg::moe_build_tab(lds, (const unsigned*)(P.ws + WS_CTL) + CW_CNT);
    ON(9) { pg::MoeSched<1> S; S.init(P.ws, lds, G, bx, P.in[I_B1]); pg::EpiMoe1 E; E.ws = P.ws; E.b1 = P.in[I_B1]; E.lds = lds; E.nostore = (r_ == 1);
#if defined(PROBE_MOE_NT)
        if (r_ == 1) { pg::EpiNull EN; pg::gemm_phase<true>(lds, S, EN, PROBE_MOE_NT, D / 2, 7); } else
#endif
        pg::gemm_phase<true>(lds, S, E, D / 128, D / 2);
#if EXPERTS_IN_ATTN
        if (r_ == 0 && G == 256 && (bx >> 3) >= 16) { const int k_ = (bx & 7) * 16 + (bx >> 3) - 16; expert_convert_slice(P, lds, EXP_M10 + k_ * EXP_N_M1, EXP_M10 + (k_ + 1) * EXP_N_M1); }
        __syncthreads();
#endif
    }
    GRID_BAR();
    ON(10) { pg::MoeSched<2> S; S.init(P.ws, lds, G, bx, P.in[I_B2]);
#if defined(PROBE_FREEZE)
        S.freeze = (r_ == 1);
#endif
 pg::EpiMoe2 E; E.ws = P.ws; E.b2 = P.in[I_B2]; E.lds = lds; E.nostore = (r_ == 1);
#if defined(PROBE_MOE_NT)
        if (r_ == 1) { pg::EpiNull EN; pg::gemm_phase<true>(lds, S, EN, PROBE_MOE_NT, DFF / 2, 7); } else
#endif
        pg::gemm_phase<true>(lds, S, E, DFF / 128, DFF / 2); }
    GRID_BAR();
    ON(11) combine_phase(P, lds, vcu, G);
    }
#undef ON
}

extern "C" void kernel_launch(void* const* d_in, const int* in_sizes, int n_in, void* d_out, int out_size, void* d_ws, size_t ws_size, hipStream_t stream) {
    static int grid = 0;
    if (grid == 0) {
        int dev = 0, cus = 0, per_cu = 0;
        if (hipGetDevice(&dev) != hipSuccess || hipDeviceGetAttribute(&cus, hipDeviceAttributeMultiprocessorCount, dev) != hipSuccess) { fprintf(stderr, "kernel_launch: device query failed\n"); grid = -1; return; }
        if (hipFuncSetAttribute((const void*)mega_fwd, hipFuncAttributeMaxDynamicSharedMemorySize, LDS_BYTES) != hipSuccess) { fprintf(stderr, "kernel_launch: hipFuncSetAttribute failed\n"); grid = -1; return; }
        if (hipOccupancyMaxActiveBlocksPerMultiprocessor(&per_cu, (const void*)mega_fwd, NTHREADS, LDS_BYTES) != hipSuccess || per_cu < 1) { fprintf(stderr, "kernel_launch: occupancy query reports %d workgroups per CU\n", per_cu); per_cu = 1; }
        (void)hipGetLastError();
        grid = cus;
        if (ws_size < WS_END) { fprintf(stderr, "kernel_launch: workspace too small\n"); grid = -1; return; }
    }
    if (grid < 0) return;
    hipMemsetAsync((char*)d_ws + WS_CTL, 0, CTL_ZERO_BYTES, stream);
    Params P{};
    for (int i = 0; i < 30; ++i) P.in[i] = (const float*)d_in[i];
    P.out = (float*)d_out; P.ws = (unsigned char*)d_ws;
    hipLaunchKernelGGL(mega_fwd, dim3(grid), dim3(NTHREADS), LDS_BYTES, stream, P);
#if defined(PROBE_TWO_LAUNCHES)
    hipMemsetAsync((char*)d_ws + WS_CTL, 0, CTL_ZERO_BYTES, stream);
    hipLaunchKernelGGL(mega_fwd, dim3(grid), dim3(NTHREADS), LDS_BYTES, stream, P);
#endif
}
```

```cpp
#include <hip/hip_runtime.h>
#include <hip/hip_bf16.h>
#include <stdint.h>
#include <math.h>
#include <cstdio>

constexpr int D = 1024, BATCH = 8, SEQ = 2048, T = BATCH * SEQ;
constexpr int SSM_W = 512, SSM_H = 16, SSM_G = 32, SSM_P = 64;
constexpr int CH_L = 32, NCH = SEQ / CH_L;
constexpr int ACAT_ROWS = BATCH * NCH;
constexpr int ACAT_LD = CH_L * SSM_H + 2 * SSM_P;
constexpr int AH = 8, AW = 1024;
constexpr int IN_W = 5632;
constexpr int NE = 32, DFF = 1024;
constexpr float EPS = 1e-5f;
constexpr int OFF_U = 0, OFF_Q = 512, OFF_K = 1536, OFF_V = 2560, OFF_GS = 3584, OFF_GA = 4608;
constexpr int CAP = T;
constexpr int MAXBLK = 288;
constexpr float QC2 = 0.125f * 1.4426950408889634f;
constexpr int MA_LD = 1536;

constexpr size_t MiB = 1u << 20;
constexpr size_t WS_CTL = 0, CTL_ZERO_BYTES = 64 * 1024;
constexpr size_t WS_WIN_T = 2 * MiB;
constexpr size_t WS_WGLU_T = 13 * MiB;
constexpr size_t WS_WP_T = 14 * MiB;
constexpr size_t WS_WOUT_T = 17 * MiB;
constexpr size_t WS_WR_T = 19 * MiB;
constexpr size_t WS_KJ = 21 * MiB;
constexpr size_t WS_WS_T = 22 * MiB;
constexpr size_t WS_BT_SSM = 26 * MiB;
constexpr size_t WS_W1_T = 48 * MiB;
constexpr size_t WS_W2_T = 176 * MiB;
constexpr size_t WS_XN = 240 * MiB;
constexpr size_t WS_ACAT = 272 * MiB;
constexpr size_t WS_Q = 292 * MiB, WS_K = 324 * MiB, WS_V = 356 * MiB;
constexpr size_t WS_GS = 388 * MiB, WS_GA = 420 * MiB;
constexpr size_t WS_X1 = 292 * MiB;
constexpr size_t WS_WIN8 = 404 * MiB;
constexpr size_t WS_XN8 = 436 * MiB;
constexpr size_t WS_Z = 452 * MiB;
constexpr size_t WS_MA = 468 * MiB;
constexpr size_t WS_MERGED = 516 * MiB;
constexpr size_t WS_H2 = 548 * MiB;
constexpr size_t WS_SLOT_TOK = 582 * MiB;
constexpr size_t WS_SLOT_GATE = 584 * MiB;
constexpr size_t WS_TOK_EP = 586 * MiB;
constexpr size_t WS_ACT = 588 * MiB;
constexpr size_t WS_Y = 732 * MiB;
constexpr size_t WS_END = 876 * MiB;
constexpr int CW_CNT = 64;
constexpr int CW_EARLY = 256;
constexpr int CW_SSM1 = 1536;
constexpr int CW_M1DONE = 2688;
constexpr int CW_P0 = 9344;
constexpr int CW_S2 = 10496, CW_PRE5 = 11648;
constexpr int CW_QKV = 8192;
constexpr int CW_BAR = 4096;

typedef unsigned short bf16_t;
typedef short bf16x8 __attribute__((ext_vector_type(8)));
typedef float f32x4 __attribute__((ext_vector_type(4)));
typedef float f32x2 __attribute__((ext_vector_type(2)));
typedef unsigned u32x4 __attribute__((ext_vector_type(4)));
typedef unsigned u32x2 __attribute__((ext_vector_type(2)));
#define LAS __attribute__((address_space(3)))
#define GAS __attribute__((address_space(1)))

__device__ __forceinline__ float wave_sum(float v) {
#pragma unroll
    for (int o = 1; o < 64; o <<= 1) v += __shfl_xor(v, o);
    return v;
}
typedef __bf16 bf16x2_hw __attribute__((ext_vector_type(2)));
__device__ __forceinline__ unsigned pk2(float lo, float hi) { const f32x2 v = {lo, hi}; return __builtin_bit_cast(unsigned, __builtin_convertvector(v, bf16x2_hw)); }
__device__ __forceinline__ unsigned f2bf(float f) { return pk2(f, 0.f) & 0xffffu; }
__device__ __forceinline__ float bf2f(unsigned short b) { return __builtin_bit_cast(float, (unsigned)b << 16); }
__device__ __forceinline__ float bflo(unsigned w) { return __builtin_bit_cast(float, w << 16); }
__device__ __forceinline__ float bfhi(unsigned w) { return __builtin_bit_cast(float, w & 0xffff0000u); }
__device__ __forceinline__ float sigmoid_f(float x) { return __builtin_amdgcn_rcpf(1.f + __expf(-x)); }
__device__ __forceinline__ float sigmoid_c(float x) { x = fminf(fmaxf(x, -30.f), 30.f); return __builtin_amdgcn_rcpf(1.f + __expf(-x)); }
__device__ __forceinline__ float gelu_tanh(float x) { const float u = 0.7978845608028654f * (x + 0.044715f * x * x * x); return x * sigmoid_f(2.f * u); }

__device__ __forceinline__ unsigned pk4_fp8(float a, float b, float cc, float d) { int w = 0; w = __builtin_amdgcn_cvt_pk_fp8_f32(a, b, w, false); w = __builtin_amdgcn_cvt_pk_fp8_f32(cc, d, w, true); return (unsigned)w; }
__device__ __forceinline__ void unpk4_fp8(unsigned w, float& a, float& b, float& cc, float& d) { const f32x2 lo = __builtin_amdgcn_cvt_pk_f32_fp8((int)w, false), hi = __builtin_amdgcn_cvt_pk_f32_fp8((int)w, true); a = lo.x; b = lo.y; cc = hi.x; d = hi.y; }
constexpr float W8_SCALE = 64.f;
#ifndef WT_STORES
#define WT_STORES 0
#endif
__device__ __forceinline__ void store16(void* p, const u32x4 v) {
#if WT_STORES
    asm volatile("global_store_dwordx4 %0, %1, off sc1\n\ts_nop 1" :: "v"(p), "v"(v) : "memory");
#else
    *(u32x4*)p = v;
#endif
}
#ifndef NT_STREAMS
#define NT_STREAMS 1
#endif
#if NT_STREAMS
#define NT_LOAD(p) __builtin_nontemporal_load(p)
#define NT_STORE(v, p) __builtin_nontemporal_store((v), (p))
#else
#define NT_LOAD(p) (*(p))
#define NT_STORE(v, p) (*(p) = (v))
#endif
__device__ __forceinline__ int opaque_tid() { int t = threadIdx.x; asm volatile("" : "+v"(t)); return t; }

struct Params {
    const float* in[30];
    float* out;
    unsigned char* ws;
};
enum { I_X = 0, I_G1, I_WIN, I_LRE, I_LIM, I_LOGDT, I_BRE, I_BIM, I_CRE, I_CIM, I_DSK, I_WGLU, I_BGLU, I_QG, I_KG, I_LQ1, I_LK1, I_LQ2, I_LK2, I_SG, I_WPS, I_WPA, I_WOUT, I_G2, I_WR, I_BR, I_W1, I_B1, I_W2, I_B2 };

constexpr int NWAVES = 8, NTHREADS = 512;
constexpr int LDS_BYTES = 147456;
constexpr int RING_BYTES = 131072;
constexpr int MISC_OFF = RING_BYTES + 320;
__device__ __forceinline__ void p0_transpose_item(const float* __restrict__ W, int N, bf16_t* __restrict__ WT, int ldo, int k_off, LAS float* scr, int kb, int nb, int lane, bool perm64 = false  ) {
    const int k0 = 64 * kb, n0 = 32 * nb;
    { f32x4 v[8];
#pragma unroll
        for (int i = 0; i < 8; ++i) v[i] = NT_LOAD((const f32x4*)(W + (size_t)(k0 + 8 * i + (lane >> 3)) * N + n0 + (lane & 7) * 4));
#pragma unroll
        for (int i = 0; i < 8; ++i) { LAS float* d = scr + (8 * i + (lane >> 3)) * 33 + (lane & 7) * 4; d[0] = v[i].x; d[1] = v[i].y; d[2] = v[i].z; d[3] = v[i].w; } }
    asm volatile("s_waitcnt lgkmcnt(0)" ::: "memory");
    const int c = lane & 7;
#pragma unroll
    for (int j = 0; j < 4; ++j) { const int n = (lane >> 3) + 8 * j; const LAS float* s = scr + (8 * c) * 33 + n;
        u32x4 o; o.x = pk2(s[0 * 33], s[1 * 33]); o.y = pk2(s[2 * 33], s[3 * 33]); o.z = pk2(s[4 * 33], s[5 * 33]); o.w = pk2(s[6 * 33], s[7 * 33]);
        int rw = n0 + n; if (perm64) { const int pq = rw & 63; rw = (rw & ~63) + 32 * ((pq >> 3) & 1) + 8 * (pq >> 4) + (pq & 7); }
        *(u32x4*)(WT + (size_t)rw * ldo + k_off + k0 + 8 * c) = o; }
    asm volatile("s_waitcnt lgkmcnt(0)" ::: "memory");
}
__device__ __forceinline__ void p0_transpose_item_fp8(const float* __restrict__ W, int N, unsigned char* __restrict__ WT, int ldo, LAS float* scr, int kb, int nb, int lane, bool perm64 = false  ) {
    const int k0 = 64 * kb, n0 = 32 * nb;
    { f32x4 v[8];
#pragma unroll
        for (int i = 0; i < 8; ++i) v[i] = NT_LOAD((const f32x4*)(W + (size_t)(k0 + 8 * i + (lane >> 3)) * N + n0 + (lane & 7) * 4));
#pragma unroll
        for (int i = 0; i < 8; ++i) { LAS float* d = scr + (8 * i + (lane >> 3)) * 33 + (lane & 7) * 4; d[0] = v[i].x; d[1] = v[i].y; d[2] = v[i].z; d[3] = v[i].w; } }
    asm volatile("s_waitcnt lgkmcnt(0)" ::: "memory");
    const int n = lane >> 1, half = lane & 1; const LAS float* s = scr + (32 * half) * 33 + n;
    unsigned o[8];
#pragma unroll
    for (int q = 0; q < 8; ++q) o[q] = pk4_fp8(s[(4 * q) * 33] * W8_SCALE, s[(4 * q + 1) * 33] * W8_SCALE, s[(4 * q + 2) * 33] * W8_SCALE, s[(4 * q + 3) * 33] * W8_SCALE);
    int rw = n0 + n; if (perm64) { const int pq = rw & 63; rw = (rw & ~63) + 32 * ((pq >> 3) & 1) + 8 * (pq >> 4) + (pq & 7); }
    u32x4* dst = (u32x4*)(WT + (size_t)rw * ldo + k0 + 32 * half);
    dst[0] = (u32x4){o[0], o[1], o[2], o[3]}; dst[1] = (u32x4){o[4], o[5], o[6], o[7]};
    asm volatile("s_waitcnt lgkmcnt(0)" ::: "memory");
}
__device__ __forceinline__ void p0_transpose_f32_item(const float* __restrict__ W, float* __restrict__ WT, int K, LAS float* scr, int kb, int lane) {
    const int k0 = 64 * kb;
#pragma unroll 8
    for (int i = 0; i < 32; ++i) { const int kk = 2 * i + (lane >> 5); scr[kk * 33 + (lane & 31)] = W[(size_t)(k0 + kk) * 32 + (lane & 31)]; }
    asm volatile("s_waitcnt lgkmcnt(0)" ::: "memory");
#pragma unroll 8
    for (int n = 0; n < 32; ++n) WT[(size_t)n * K + k0 + lane] = scr[lane * 33 + n];
    asm volatile("s_waitcnt lgkmcnt(0)" ::: "memory");
}
__device__ __forceinline__ void rms_row_to_bf16(const float* __restrict__ xrow, const float* __restrict__ g, bf16_t* __restrict__ orow, unsigned char* __restrict__ orow8, int lane) {
    const f32x4* xr = (const f32x4*)xrow + lane; const f32x4* gr = (const f32x4*)g + lane;
    f32x4 v[4]; float s = 0.f;
#pragma unroll
    for (int j = 0; j < 4; ++j) { v[j] = NT_LOAD(xr + 64 * j); s += (v[j].x * v[j].x + v[j].y * v[j].y) + (v[j].z * v[j].z + v[j].w * v[j].w); }
    const float r = rsqrtf(wave_sum(s) * (1.f / D) + EPS);
    u32x2* o8 = (u32x2*)orow + lane; unsigned* o4 = (unsigned*)orow8 + lane;
#pragma unroll
    for (int j = 0; j < 4; ++j) { const f32x4 gg = gr[64 * j]; const f32x4 y = {v[j].x * r * gg.x, v[j].y * r * gg.y, v[j].z * r * gg.z, v[j].w * r * gg.w};
        u32x2 w; w.x = pk2(y.x, y.y); w.y = pk2(y.z, y.w); o8[64 * j] = w; o4[64 * j] = pk4_fp8(y.x, y.y, y.z, y.w); }
}
struct SsmGP { float lrdt, lidt, cr, ci; };
__device__ __forceinline__ SsmGP ssm_gp(const Params& P, int g, int p) {
    const float dt = expf(P.in[I_LOGDT][g]);
    const float lr = fminf(P.in[I_LRE][g * SSM_P + p], -1e-4f), li = P.in[I_LIM][g * SSM_P + p];
    const float mag = expf(lr * dt);
    float sn, cs; sincosf(li * dt, &sn, &cs);
    const float ar = mag * cs, ai = mag * sn;
    const float den = lr * lr + li * li, nr = ar - 1.f;
    SsmGP r; r.lrdt = lr * dt; r.lidt = li * dt; r.cr = (nr * lr + ai * li) / den; r.ci = (ai * lr - nr * li) / den;
    return r;
}
__device__ __forceinline__ void ssm_pow(const SsmGP& q, int j, float& pr, float& pi) {
    const float m = expf((float)j * q.lrdt); float sn, cs; sincosf((float)j * q.lidt, &sn, &cs); pr = m * cs; pi = m * sn;
}

#ifndef EXP_DMA_AUX
#define EXP_DMA_AUX 2
#endif
struct ExpItem { const float* W; unsigned char* WT; int N, ldo, kb, nb, sw; };
__device__ __forceinline__ ExpItem exp_item(const Params& P, int it) {
    constexpr int I_E1 = (1024 / 128) * (2048 / 32), I_E2 = (1024 / 128) * (1024 / 32);
    ExpItem x;
    if (it < NE * I_E1) { const int e = it / I_E1, q = it % I_E1; x.W = P.in[I_W1] + (size_t)e * D * 2 * DFF; x.WT = P.ws + WS_W1_T + (size_t)e * 2 * DFF * D; x.N = 2 * DFF; x.ldo = D; x.kb = q / 64; x.nb = q % 64; x.sw = 3; }
    else { const int r = it - NE * I_E1, e = r / I_E2, q = r % I_E2; x.W = P.in[I_W2] + (size_t)e * DFF * D; x.WT = P.ws + WS_W2_T + (size_t)e * D * DFF; x.N = D; x.ldo = DFF; x.kb = q / 32; x.nb = q % 32; x.sw = 0; }
    return x;
}
__device__ __forceinline__ void exp_dma(const ExpItem& x, int lane, LAS unsigned char* buf) {
    const float* src = x.W + (size_t)(128 * x.kb + (lane >> 3)) * x.N + 32 * x.nb;
#pragma unroll
    for (int i = 0; i < 16; ++i) __builtin_amdgcn_global_load_lds((const unsigned*)(src + (size_t)(8 * i) * x.N + ((((lane & 7) ^ (lane >> 3) ^ (i >> 1)) & 7) << 2)), (LAS unsigned*)(buf + i * 1024), 16, 0, EXP_DMA_AUX);
}
#if defined(PROBE_CONV_NOSTORE)
#define g_conv_nostore nostore_
__device__ __forceinline__ void exp_finish_lds(const ExpItem& x, int lane, const LAS unsigned char* buf, bool nostore_ = false) {
#else
__device__ __forceinline__ void exp_finish_lds(const ExpItem& x, int lane, const LAS unsigned char* buf) {
#endif
    const int c = lane & 7;
#pragma unroll
    for (int pass = 0; pass < 4; ++pass) {
        const int n = 8 * pass + (lane >> 3), q0 = (n >> 2) ^ c;
        int no = n ^ ((((n >> 1) ^ n) & 1) ? x.sw : 0);
        if (x.sw != 0) { const int pq = (32 * x.nb + no) & 63, qa = pq >> 2, qt = 8 * ((qa >> 1) & 1) + 2 * (qa >> 2) + (qa & 1);
            no = 4 * qt + (pq & 3) - 32 * (x.nb & 1); }
        if (x.sw == 0) { const int pq = (32 * x.nb + n) & 63; no = 32 * ((pq >> 3) & 1) + 8 * (pq >> 4) + (pq & 7) - 32 * (x.nb & 1); }
        const LAS unsigned char* rb = buf + c * 2048 + ((n & 3) << 2);
        float f[16];
#pragma unroll
        for (int j = 0; j < 16; ++j) f[j] = *(const LAS float*)(rb + j * 128 + (((q0 ^ j) & 7) << 4)) * W8_SCALE;
        const u32x4 o = (u32x4){pk4_fp8(f[0], f[1], f[2], f[3]), pk4_fp8(f[4], f[5], f[6], f[7]), pk4_fp8(f[8], f[9], f[10], f[11]), pk4_fp8(f[12], f[13], f[14], f[15])};
#if defined(PROBE_CONV_NOSTORE)
        if (g_conv_nostore) { asm volatile("" :: "v"(o)); } else
#endif
#if NT_STREAMS && !defined(CONV_ST_DEFAULT)
        __builtin_nontemporal_store(o, (u32x4*)(x.WT + (size_t)(32 * x.nb + no) * x.ldo + 128 * x.kb + 16 * c));
#else
        *(u32x4*)(x.WT + (size_t)(32 * x.nb + no) * x.ldo + 128 * x.kb + 16 * c) = o;
#endif
    }
    asm volatile("s_waitcnt lgkmcnt(0)" ::: "memory");
}
constexpr int EXP_ITEMS = NE * ((1024 / 128) * (2048 / 32) + (1024 / 128) * (1024 / 32));
constexpr int EXP_N_IN = 32, EXP_N_S2 = 0, EXP_N_GLU = 0, EXP_N_M1 = 0;
constexpr int EXP_IN0 = 0, EXP_S20 = 128 * EXP_N_IN, EXP_GLU0 = EXP_S20 + 128 * EXP_N_S2, EXP_ATT0 = EXP_GLU0 + 128 * EXP_N_GLU, EXP_M10 = EXP_ITEMS - 128 * EXP_N_M1;
static_assert((EXP_M10 - EXP_ATT0) % 256 == 0 && EXP_M10 >= NE * (1024 / 128) * (2048 / 32), "item split (the expert-GEMM-1 tail share must be W2 items only)");
__device__ __forceinline__ void expert_convert_slice(const Params& P, LAS unsigned char* lds, int i0, int i1, bool probe_nostore = false) {
    const int tid = opaque_tid(), lane = tid & 63, wave = __builtin_amdgcn_readfirstlane(tid >> 6);
    LAS unsigned char* b0 = lds + wave * 16384;
    for (int it = i0 + wave; it < i1; it += NWAVES) {
        const ExpItem c0 = exp_item(P, it);
        exp_dma(c0, lane, b0);
        asm volatile("s_waitcnt vmcnt(0)" ::: "memory");
#if defined(PROBE_CONV_NOSTORE)
        exp_finish_lds(c0, lane, b0, probe_nostore);
#else
        exp_finish_lds(c0, lane, b0);
#endif
    }
}
#ifndef INPROJ_FP8_MASK
#define INPROJ_FP8_MASK 0x3FFC00u
#endif
constexpr bool pg_inproj_fp8_tile(int pn) { return (INPROJ_FP8_MASK >> pn) & 1u; }
__device__ __forceinline__ void p0_prologue(const Params& P, LAS unsigned char* lds, int vcu, int G, int part) {
    const int tid = opaque_tid(), lane = tid & 63, wave = __builtin_amdgcn_readfirstlane(tid >> 6);
    LAS float* scr = (LAS float*)(lds + wave * 16384);
    unsigned char* ws = P.ws;
    const int gw = vcu * NWAVES + wave, NGW = G * NWAVES;
    constexpr int I_IN = (D / 64) * (IN_W / 32);
    constexpr int I_GLU = (512 / 64) * (512 / 32);
    constexpr int I_PS = (512 / 64) * (1024 / 32);
    constexpr int I_PA = (1024 / 64) * (1024 / 32);
    constexpr int I_OUT = I_PA;
    constexpr int I_R = 1024 / 64;
    constexpr int I_E1 = (1024 / 64) * (2048 / 32);
    constexpr int I_E2 = (1024 / 64) * (1024 / 32);
#ifndef EXPERTS_IN_ATTN
#define EXPERTS_IN_ATTN 1
#endif
    constexpr int NITEMS = I_IN + I_GLU + I_PS + I_PA + I_OUT + I_R + (EXPERTS_IN_ATTN ? 0 : NE * I_E1 + NE * I_E2);
    for (int it = (part == 0 ? gw : I_IN + gw); it < (part == 0 ? I_IN : NITEMS); it += NGW) {
        int r = it;
        if (r < I_IN) { const int nblk = IN_W / 32, nb = r % nblk, pnr = nb >> 3;
            if (!pg_inproj_fp8_tile(pnr)) p0_transpose_item(P.in[I_WIN], IN_W, (bf16_t*)(ws + WS_WIN_T), D, 0, scr, r / nblk, nb, lane);
            else p0_transpose_item_fp8(P.in[I_WIN], IN_W, ws + WS_WIN8, D, scr, r / nblk, nb, lane, pnr >= 14);
            continue; } r -= I_IN;
        if (r < I_GLU) { const int nblk = 512 / 32; p0_transpose_item(P.in[I_WGLU], 512, (bf16_t*)(ws + WS_WGLU_T), 512, 0, scr, r / nblk, r % nblk, lane); continue; } r -= I_GLU;
        if (r < I_PS) { const int nblk = 1024 / 32; p0_transpose_item(P.in[I_WPS], 1024, (bf16_t*)(ws + WS_WP_T), MA_LD, 1024, scr, r / nblk, r % nblk, lane, true); continue; } r -= I_PS;
        if (r < I_PA) { const int nblk = 1024 / 32; p0_transpose_item(P.in[I_WPA], 1024, (bf16_t*)(ws + WS_WP_T), MA_LD, 0, scr, r / nblk, r % nblk, lane, true); continue; } r -= I_PA;
        if (r < I_OUT) { const int nblk = 1024 / 32; p0_transpose_item(P.in[I_WOUT], 1024, (bf16_t*)(ws + WS_WOUT_T), D, 0, scr, r / nblk, r % nblk, lane); continue; } r -= I_OUT;
        if (r < I_R) { p0_transpose_f32_item(P.in[I_WR], (float*)(ws + WS_WR_T), D, scr, r, lane); continue; } r -= I_R;
        if (EXPERTS_IN_ATTN) continue;
        if (r < NE * I_E1) { const int e = r / I_E1, q = r % I_E1, nblk = 2048 / 32;
            p0_transpose_item_fp8(P.in[I_W1] + (size_t)e * D * 2 * DFF, 2 * DFF, ws + WS_W1_T + (size_t)e * 2 * DFF * D, D, scr, q / nblk, q % nblk, lane); continue; } r -= NE * I_E1;
        { const int e = r / I_E2, q = r % I_E2, nblk = 1024 / 32;
            p0_transpose_item_fp8(P.in[I_W2] + (size_t)e * DFF * D, D, ws + WS_W2_T + (size_t)e * D * DFF, DFF, scr, q / nblk, q % nblk, lane); }
    }
#if EXPERTS_IN_ATTN
    if (G != 256 && part == 1) { __syncthreads(); for (int c0 = vcu * 64; c0 < EXP_ATT0; c0 += G * 64) expert_convert_slice(P, lds, c0, min(EXP_ATT0, c0 + 64));
        for (int c0 = EXP_M10 + vcu * 64; c0 < EXP_ITEMS; c0 += G * 64) expert_convert_slice(P, lds, c0, min(EXP_ITEMS, c0 + 64)); __syncthreads(); }
#endif
    if (part == 0) for (int m = gw; m < T; m += NGW) rms_row_to_bf16(P.in[I_X] + (size_t)m * D, P.in[I_G1], (bf16_t*)(ws + WS_XN) + (size_t)m * D, ws + WS_XN8 + (size_t)m * D, lane);
    if (part == 0) return;
    if (gw == 0) { u32x4* z = (u32x4*)(ws + WS_H2 + (size_t)T * D); z[lane] = (u32x4){0u, 0u, 0u, 0u}; }
    const int gt = vcu * NTHREADS + tid, NGT = G * NTHREADS;
#ifndef TABLES_REP
#define TABLES_REP 1
#endif
    _Pragma("clang loop unroll(disable)") for (int trep = 0; trep < TABLES_REP; ++trep) {
#ifndef REP_II
#define REP_II 1
#define REP_III 1
#define REP_IV 1
#endif
    _Pragma("clang loop unroll(disable)") for (int r2 = 0; r2 < REP_II; ++r2)
    for (int it = vcu + G * wave; it < SSM_G * CH_L; it += NGW) {
        const int g = it / CH_L, j = it % CH_L, i16 = lane & 15, q = lane >> 4;
        { const SsmGP gp = ssm_gp(P, g, lane); float pr, pi; ssm_pow(gp, j, pr, pi); scr[2 * lane] = pr * gp.cr - pi * gp.ci; scr[2 * lane + 1] = pr * gp.ci + pi * gp.cr; }
        float cre[16], cim[16], brv[16], biv[16];
#pragma unroll
        for (int s4 = 0; s4 < 4; ++s4) { const f32x4 vr = *(const f32x4*)(P.in[I_CRE] + (g * SSM_H + i16) * SSM_P + 16 * s4 + 4 * q), vi = *(const f32x4*)(P.in[I_CIM] + (g * SSM_H + i16) * SSM_P + 16 * s4 + 4 * q);
#pragma unroll
            for (int c = 0; c < 4; ++c) { const int pp = 16 * s4 + 4 * q + c; cre[4 * s4 + c] = vr[c]; cim[4 * s4 + c] = vi[c];
                brv[4 * s4 + c] = P.in[I_BRE][(g * SSM_P + pp) * SSM_H + i16]; biv[4 * s4 + c] = P.in[I_BIM][(g * SSM_P + pp) * SSM_H + i16]; } }
        asm volatile("s_waitcnt lgkmcnt(0)" ::: "memory");
        f32x4 kacc = {0.f, 0.f, 0.f, 0.f};
#pragma unroll
        for (int s = 0; s < 16; ++s) { const int pp = 16 * (s >> 2) + 4 * q + (s & 3); const float wr = scr[2 * pp], wi = scr[2 * pp + 1];
            const float mr = cre[s] * wr - cim[s] * wi, mi = cre[s] * wi + cim[s] * wr;
            kacc = __builtin_amdgcn_mfma_f32_16x16x4f32(mr, brv[s], kacc, 0, 0, 0);
            kacc = __builtin_amdgcn_mfma_f32_16x16x4f32(-mi, biv[s], kacc, 0, 0, 0); }
#pragma unroll
        for (int r = 0; r < 4; ++r) { const int h = 4 * q + r; float v = kacc[r];
            if (j == 0 && h == i16) v += P.in[I_DSK][g * SSM_H + h];
            ((float*)(ws + WS_KJ))[((size_t)(g * CH_L + j) * SSM_H + h) * SSM_H + i16] = v; }
        asm volatile("s_waitcnt lgkmcnt(0)" ::: "memory");
    }
    _Pragma("clang loop unroll(disable)") for (int r3 = 0; r3 < REP_III; ++r3)
    for (int it = gt; it < SSM_G * 128 * CH_L; it += NGT) {
        const int s = it % CH_L, n = (it / CH_L) % 128, g = it / (CH_L * 128), p = n & 63, part = n >> 6;
        const SsmGP q = ssm_gp(P, g, p); float pr, pi; ssm_pow(q, CH_L - 1 - s, pr, pi);
        const float wr = pr * q.cr - pi * q.ci, wi = pr * q.ci + pi * q.cr;
        float br[16], bi[16];
#pragma unroll
        for (int q4 = 0; q4 < 4; ++q4) { const f32x4 vb = *(const f32x4*)(P.in[I_BRE] + (g * SSM_P + p) * SSM_H + 4 * q4), vi = *(const f32x4*)(P.in[I_BIM] + (g * SSM_P + p) * SSM_H + 4 * q4);
#pragma unroll
            for (int c = 0; c < 4; ++c) { br[4 * q4 + c] = vb[c]; bi[4 * q4 + c] = vi[c]; } }
        unsigned o[8];
#pragma unroll
        for (int h2 = 0; h2 < 8; ++h2) {
            float v0, v1;
            if (part == 0) { v0 = wr * br[2 * h2] - wi * bi[2 * h2]; v1 = wr * br[2 * h2 + 1] - wi * bi[2 * h2 + 1]; }
            else { v0 = wr * bi[2 * h2] + wi * br[2 * h2]; v1 = wr * bi[2 * h2 + 1] + wi * br[2 * h2 + 1]; }
            o[h2] = pk2(v0, v1);
        }
        u32x4* dst = (u32x4*)((bf16_t*)(ws + WS_WS_T) + ((size_t)(g * 128 + n) * 512 + s * 16));
        dst[0] = (u32x4){o[0], o[1], o[2], o[3]}; dst[1] = (u32x4){o[4], o[5], o[6], o[7]};
    }
    _Pragma("clang loop unroll(disable)") for (int r4 = 0; r4 < REP_IV; ++r4)
    for (int it = gt; it < SSM_G * CH_L * SSM_P; it += NGT) {
        const int p = it % SSM_P, t = (it / SSM_P) % CH_L, g = it / (SSM_P * CH_L);
        const SsmGP q = ssm_gp(P, g, p); float pr, pi; ssm_pow(q, t + 1, pr, pi);
        bf16_t* base = (bf16_t*)(ws + WS_BT_SSM) + ((size_t)(g * 512 + t * 16)) * ACAT_LD + 512 + p;
#pragma unroll
        for (int h = 0; h < SSM_H; ++h) {
            const float cre = P.in[I_CRE][(g * SSM_H + h) * SSM_P + p], cim = P.in[I_CIM][(g * SSM_H + h) * SSM_P + p];
            base[(size_t)h * ACAT_LD] = (bf16_t)f2bf(cre * pr - cim * pi);
            base[(size_t)h * ACAT_LD + 64] = (bf16_t)f2bf(-(cre * pi + cim * pr));
        }
    }
    }
}
__device__ __forceinline__ void ssm_toeplitz_expand(const Params& P, int vcu, int G) {
    const int gt = vcu * NTHREADS + opaque_tid(), NGT = G * NTHREADS;
    unsigned char* ws = P.ws;
    for (int it = gt; it < SSM_G * 512 * 64; it += NGT) {
        const int kc = it & 63, n = (it >> 6) & 511, g = it >> 15;
        const int s = kc >> 1, hq = (kc & 1) * 8, t = n >> 4, h = n & 15;
        u32x4 o = (u32x4){0u, 0u, 0u, 0u};
        if (s <= t) { const float* kj = (const float*)(ws + WS_KJ) + ((size_t)(g * CH_L + (t - s)) * SSM_H + h) * SSM_H + hq;
            const f32x4 a = *(const f32x4*)kj, b = *(const f32x4*)(kj + 4);
            o.x = pk2(a.x, a.y); o.y = pk2(a.z, a.w); o.z = pk2(b.x, b.y); o.w = pk2(b.z, b.w); }
        *(u32x4*)((bf16_t*)(ws + WS_BT_SSM) + ((size_t)(g * 512 + n)) * ACAT_LD + kc * 8) = o;
    }
}
#ifndef PG_WGM
#define PG_WGM 8
#endif
namespace pg {
constexpr int BM = 256, BK = 64, HALF = 128, HTB = HALF * BK * 2, STAGE_BYTES = 8 * HTB;
__host__ __device__ __forceinline__ int lds_byte(int r, int c) { const int st = (r >> 4) * 2 + (c >> 5), rr = r & 15, cc = c & 31, ob = rr * 64 + cc * 2; return st * 1024 + (ob ^ (((ob >> 9) & 1) << 5)); }
__host__ __device__ __forceinline__ void stage_rc(int b, int& R, int& C) { const int st = b / 1024, sb = b % 1024, swz = sb ^ (((sb >> 9) & 1) << 5); R = (st >> 1) * 16 + swz / 64; C = (st & 1) * 32 + (swz % 64) / 2; }
__host__ __device__ __forceinline__ int perm32(int rho) { const int n = rho >> 4, i = rho & 15; return 8 * (i >> 2) + 4 * n + (i & 3); }

struct Unit {
    const char* A;
    const char* B;
    unsigned aoff[2][2];
    int pm, pn, aux, aux2;
    int ord;
};
struct EpiInfo { int pm, pn, aux, aux2, ord; };
typedef f32x4 Acc[2][2][4][2];

typedef int v8i_t __attribute__((ext_vector_type(8)));
typedef int v4i_t __attribute__((ext_vector_type(4)));
template <bool FP8 = false, int BAUX = 0  , class Sched, class Epi>
__device__ __forceinline__ void gemm_phase(LAS unsigned char* lds, const Sched& S, const Epi& E, const int nt, const int ldb, const int ktm = -1  , const Acc* pre = nullptr  ) {
    const int tid = opaque_tid(), wid = __builtin_amdgcn_readfirstlane(tid >> 6), lane = tid & 63, wr = wid >> 2, wc = wid & 3, fr = lane & 15, fq = lane >> 4;
    unsigned voffB[2];
#pragma unroll
    for (int i = 0; i < 2; ++i) { int R, C; stage_rc(tid * 16 + i * 8192, R, C); voffB[i] = (unsigned)((64 * (R >> 5) + perm32(R & 31)) * ldb + C) * 2u; }
    const unsigned hB = (unsigned)(32 * ldb * 2);
    const unsigned ldsw = (unsigned)wid * 1024u;
    const int aoffl = lds_byte(wr * 64 + fr, fq * 8), boffl = lds_byte(wc * 32 + fr, fq * 8);
#define PG_SA(b, h) (((b) * 2 + (h)) * pg::HTB)
#define PG_SB(b, h) ((4 + (b) * 2 + (h)) * pg::HTB)
#define PG_GLDS(gp, bufoff, i) __builtin_amdgcn_global_load_lds((const unsigned*)(gp), (LAS unsigned*)(lds + (bufoff) + ldsw + (i) * 8192), 16, 0, 0)
#define PG_STAGE_A(bufoff, Ab, o0, o1, kt) do { const char* _b = (Ab) + (size_t)((kt) & ktm) * 128; PG_GLDS(_b + (o0), bufoff, 0); PG_GLDS(_b + (o1), bufoff, 1); } while (0)
#define PG_GLDSB(gp, bufoff, i) __builtin_amdgcn_global_load_lds((const unsigned*)(gp), (LAS unsigned*)(lds + (bufoff) + ldsw + (i) * 8192), 16, 0, BAUX)
#define PG_STAGE_B(bufoff, Bb, h, kt) do { const char* _b = (Bb) + (size_t)((kt) & ktm) * 128 + (h) * hB; PG_GLDSB(_b + voffB[0], bufoff, 0); PG_GLDSB(_b + voffB[1], bufoff, 1); } while (0)
#define PG_LDA(dst, b, h) do { _Pragma("unroll") for (int m = 0; m < 4; ++m) _Pragma("unroll") for (int k = 0; k < 2; ++k) dst[m][k] = *(const LAS bf16x8*)(lds + PG_SA(b, h) + aoffl + m * 2048 + k * 1024); } while (0)
#define PG_LDB(dst, b, h) do { _Pragma("unroll") for (int n = 0; n < 2; ++n) _Pragma("unroll") for (int k = 0; k < 2; ++k) dst[n][k] = *(const LAS bf16x8*)(lds + PG_SB(b, h) + boffl + n * 2048 + k * 1024); } while (0)
#define PG_CAT8(lo, hi) __builtin_shufflevector(__builtin_bit_cast(v4i_t, lo), __builtin_bit_cast(v4i_t, hi), 0, 1, 2, 3, 4, 5, 6, 7)
#define PG_MMA(ai, bj, At, Bt) do { __builtin_amdgcn_s_setprio(1); if constexpr (FP8) { _Pragma("unroll") for (int m = 0; m < 4; ++m) _Pragma("unroll") for (int n = 0; n < 2; ++n) \
            acc[ai][bj][m][n] = __builtin_amdgcn_mfma_scale_f32_16x16x128_f8f6f4(PG_CAT8(Bt[n][0], Bt[n][1]), PG_CAT8(At[m][0], At[m][1]), acc[ai][bj][m][n], 0, 0, 0, 0x79797979, 0, 0x7f7f7f7f); } \
        else { _Pragma("unroll") for (int m = 0; m < 4; ++m) _Pragma("unroll") for (int n = 0; n < 2; ++n) _Pragma("unroll") for (int k = 0; k < 2; ++k) \
        acc[ai][bj][m][n] = __builtin_amdgcn_mfma_f32_16x16x32_bf16(Bt[n][k], At[m][k], acc[ai][bj][m][n], 0, 0, 0); } __builtin_amdgcn_s_setprio(0); } while (0)
#define PG_WAIT_V(n) asm volatile("s_waitcnt vmcnt(" #n ")" ::: "memory")
#define PG_WAIT_L(n) asm volatile("s_waitcnt lgkmcnt(" #n ")" ::: "memory")
#define PG_BAR __builtin_amdgcn_s_barrier()
#define PG_SCHED __builtin_amdgcn_sched_barrier(0)
#define PG_KLOOP(T0, T1) _Pragma("clang loop unroll(disable)") for (int t = (T0); t < (T1); t += 2) { \
            const bool last = (t == nt - 2); \
            PG_LDB(B0, 0, 0); PG_LDB(B1, 0, 1); PG_SCHED; PG_LDA(At, 0, 0); PG_STAGE_A(PG_SA(1, 1), st.A, st.aoff[1][0], st.aoff[1][1], t + 1); \
            if (last) { Unit nu_; has_next = S.next(ui + 1, nu_); if (has_next) { st = nu_; } } \
            const int k2 = last ? 0 : t + 2, k3 = k2 + 1; \
            PG_WAIT_V(8); PG_WAIT_L(0); PG_BAR; PG_MMA(0, 0, At, B0); PG_MMA(0, 1, At, B1); PG_BAR; PG_SCHED; \
            PG_LDA(At, 0, 1); PG_STAGE_B(PG_SB(0, 0), st.B, 0, k2); PG_STAGE_B(PG_SB(0, 1), st.B, 1, k2); PG_STAGE_A(PG_SA(0, 0), st.A, st.aoff[0][0], st.aoff[0][1], k2); \
            PG_WAIT_V(8); PG_WAIT_L(0); PG_BAR; PG_MMA(1, 0, At, B0); PG_MMA(1, 1, At, B1); PG_BAR; PG_SCHED; \
            PG_LDB(B0, 1, 0); PG_LDB(B1, 1, 1); PG_SCHED; PG_LDA(At, 1, 0); PG_STAGE_A(PG_SA(0, 1), st.A, st.aoff[1][0], st.aoff[1][1], k2); \
            PG_WAIT_V(8); PG_WAIT_L(0); PG_BAR; PG_MMA(0, 0, At, B0); PG_MMA(0, 1, At, B1); PG_BAR; PG_SCHED; \
            PG_LDA(At, 1, 1); PG_STAGE_B(PG_SB(1, 0), st.B, 0, k3); PG_STAGE_B(PG_SB(1, 1), st.B, 1, k3); PG_STAGE_A(PG_SA(1, 0), st.A, st.aoff[0][0], st.aoff[0][1], k3); \
            PG_WAIT_V(8); PG_WAIT_L(0); PG_BAR; PG_MMA(1, 0, At, B0); PG_MMA(1, 1, At, B1); PG_BAR; PG_SCHED; \
        }
    Unit st; int ui = 0;
    if (!S.next(0, st)) return;
    EpiInfo cur; cur.pm = st.pm; cur.pn = st.pn; cur.aux = st.aux; cur.aux2 = st.aux2; cur.ord = st.ord;
    Acc acc;
#pragma unroll
    for (int a = 0; a < 2; ++a)
#pragma unroll
        for (int b = 0; b < 2; ++b)
#pragma unroll
            for (int m = 0; m < 4; ++m)
#pragma unroll
                for (int n = 0; n < 2; ++n) acc[a][b][m][n] = pre ? (*pre)[a][b][m][n] : (f32x4){0.f, 0.f, 0.f, 0.f};
    bf16x8 At[4][2], B0[2][2], B1[2][2];
    PG_STAGE_B(PG_SB(0, 0), st.B, 0, 0); PG_STAGE_B(PG_SB(0, 1), st.B, 1, 0); PG_STAGE_A(PG_SA(0, 0), st.A, st.aoff[0][0], st.aoff[0][1], 0); PG_STAGE_A(PG_SA(0, 1), st.A, st.aoff[1][0], st.aoff[1][1], 0);
    if (wr == 1) PG_BAR;
    PG_WAIT_V(2); PG_BAR;
    PG_STAGE_B(PG_SB(1, 0), st.B, 0, 1); PG_STAGE_A(PG_SA(1, 0), st.A, st.aoff[0][0], st.aoff[0][1], 1); PG_STAGE_B(PG_SB(1, 1), st.B, 1, 1);
    PG_WAIT_V(6); PG_BAR;
    for (;;) {
        bool has_next = false;
        if constexpr (Epi::HAS_MID) { PG_KLOOP(0, Epi::MID_T) E.mid(acc, cur, wr, wc, fr, fq); PG_KLOOP(Epi::MID_T, nt) } else { PG_KLOOP(0, nt) }
        if (wr == 0) PG_BAR;
        E(acc, cur, wr, wc, fr, fq);
        if (!has_next) break;
#pragma unroll
        for (int a = 0; a < 2; ++a)
#pragma unroll
            for (int b = 0; b < 2; ++b)
#pragma unroll
                for (int m = 0; m < 4; ++m)
#pragma unroll
                    for (int n = 0; n < 2; ++n) acc[a][b][m][n] = (f32x4){0.f, 0.f, 0.f, 0.f};
        cur.pm = st.pm; cur.pn = st.pn; cur.aux = st.aux; cur.aux2 = st.aux2; cur.ord = st.ord; ++ui;
        if (wr == 1) PG_BAR;
    }
    PG_WAIT_V(0);
    PG_BAR;
#undef PG_SA
#undef PG_SB
#undef PG_GLDS
#undef PG_GLDSB
#undef PG_STAGE_A
#undef PG_STAGE_B
#undef PG_LDA
#undef PG_LDB
#undef PG_MMA
#undef PG_WAIT_V
#undef PG_WAIT_L
#undef PG_BAR
#undef PG_SCHED
#undef PG_KLOOP
}

struct LaneRC { int R[2], C[2]; __device__ __forceinline__ LaneRC() { const int t = opaque_tid(); stage_rc(t * 16, R[0], C[0]); stage_rc(t * 16 + 8192, R[1], C[1]); } };

struct DenseSched {
    const bf16_t* A; const bf16_t* Bt; int lda, ldb, nM, nN, nwg, G, c;
    __device__ __forceinline__ void init(const bf16_t* A_, int lda_, const bf16_t* Bt_, int ldb_, int M, int N, int G_, int c_) { A = A_; Bt = Bt_; lda = lda_; ldb = ldb_; nM = M / BM; nN = N / BM; nwg = nM * nN; G = G_; c = c_; }
    __device__ __forceinline__ bool next(int i, Unit& u) const {
        const long L = (long)i * G + c; if (L >= nwg) return false;
        int wgid = (int)L; { const int q = nwg / 8, r = nwg % 8, xcd = wgid % 8, off = wgid / 8; wgid = (xcd < r ? xcd * (q + 1) : r * (q + 1) + (xcd - r) * q) + off; }
        const int WGM = PG_WGM, nig = WGM * nN, gid = wgid / nig, fm = gid * WGM, gsz = (nM - fm) < WGM ? (nM - fm) : WGM;
        u.pm = fm + ((wgid % nig) % gsz); u.pn = (wgid % nig) / gsz; u.aux = 0; u.aux2 = 0; u.ord = i;
        u.A = (const char*)A; u.B = (const char*)(Bt + (size_t)u.pn * BM * ldb); const LaneRC rc;
#pragma unroll
        for (int h = 0; h < 2; ++h)
#pragma unroll
            for (int j = 0; j < 2; ++j) u.aoff[h][j] = (unsigned)(((u.pm * BM + 128 * h + rc.R[j]) * lda + rc.C[j]) * 2);
        return true;
    }
};
#ifndef INPROJ_FP8_MASK
#define INPROJ_FP8_MASK 0x3FFC00u
#endif
constexpr bool inproj_fp8_tile(int pn) { return (INPROJ_FP8_MASK >> pn) & 1u; }
constexpr int inproj_ntiles(int kind) { int n = 0; for (int t = 0; t < IN_W / BM; ++t) n += (inproj_fp8_tile(t) ? 1 : 0) == kind; return n; }
template <int KIND>
struct InProjSched {
    const char* A; const char* Bt; int G, c;
    static constexpr int nM = T / BM, nN = inproj_ntiles(KIND), nwg = nM * nN, ES = KIND == 0 ? 2 : 1;
    __device__ __forceinline__ void init(const void* A_, const void* Bt_, int G_, int c_) { A = (const char*)A_; Bt = (const char*)Bt_; G = G_; c = c_; }
    __device__ __forceinline__ bool next(int i, Unit& u) const {
        const long L = (long)i * G + c; if (L >= nwg) return false;
        int wgid = (int)L; { const int q = nwg / 8, r = nwg % 8, xcd = wgid % 8, off = wgid / 8; wgid = (xcd < r ? xcd * (q + 1) : r * (q + 1) + (xcd - r) * q) + off; }
        const int WGM = PG_WGM, nig = WGM * nN, gid = wgid / nig, fm = gid * WGM, gsz = (nM - fm) < WGM ? (nM - fm) : WGM;
        const int pnl = (wgid % nig) / gsz;
        int pn = 0, seen = 0;
#pragma unroll
        for (int t = 0; t < IN_W / BM; ++t) { const bool mine = (inproj_fp8_tile(t) ? 1 : 0) == KIND; if (mine && seen == pnl) pn = t; seen += mine ? 1 : 0; }
        u.pm = fm + ((wgid % nig) % gsz); u.pn = pn; u.aux = 0; u.aux2 = 0; u.ord = i;
        u.A = A; u.B = Bt + (size_t)u.pn * BM * D * ES; const LaneRC rc;
#pragma unroll
        for (int h = 0; h < 2; ++h)
#pragma unroll
            for (int j = 0; j < 2; ++j) u.aoff[h][j] = (unsigned)((u.pm * BM + 128 * h + rc.R[j]) * D * ES + rc.C[j] * 2);
        return true;
    }
};
}
namespace pg {
constexpr int TAB_OFF = RING_BYTES + 1024;
__device__ __forceinline__ void moe_build_tab(LAS unsigned char* lds, const unsigned* cnt, int G, int c) {
    LAS int* tab = (LAS int*)(lds + TAB_OFF);
    if (threadIdx.x == 0) { int acc = 0; for (int e = 0; e < NE; ++e) { const int n = (int)__hip_atomic_load(cnt + e, __ATOMIC_RELAXED, __HIP_MEMORY_SCOPE_AGENT); tab[e] = acc; tab[40 + e] = n; acc += (n + 255) >> 8; } tab[NE] = acc;
        const int NJ = G >> 3; int B[8], bmax = 0, bmin = 1 << 30;
        for (int x = 0; x < 8; ++x) { int b = 0; for (int q = 0; q < NE / 8; ++q) b += tab[x + 8 * q + 1] - tab[x + 8 * q]; B[x] = b; bmax = b > bmax ? b : bmax; bmin = b < bmin ? b : bmin; }
#ifndef MOE_EARLY
#define MOE_EARLY 1
#endif
        const int r1max = (8 * bmax + NJ - 1) / NJ, minu = (8 * bmin) / NJ, r2t = (4 * bmax) / NJ, sig = minu - 2;
        const bool on = MOE_EARLY && G == 256 && ((4 * bmax) % NJ) != 0 && sig >= 2 && r2t >= 1;
        int E[8], idle[8], tot_idle = 0;
        for (int x = 0; x < 8; ++x) { int e_ = on ? 4 * B[x] - NJ * r2t : 0; e_ = e_ < 0 ? 0 : (e_ > NJ ? NJ : e_); E[x] = e_;
            int i_ = on ? NJ * r1max - 8 * B[x] : 0; i_ = i_ < 0 ? 0 : (i_ > NJ ? NJ : i_); idle[x] = i_; tot_idle += i_; }
        int cum = 0; for (int x = 0; x < 8; ++x) { int d = tot_idle - cum; d = d < 0 ? 0 : (d > E[x] ? E[x] : d); tab[80 + x] = d; cum += E[x]; }
        tab[88] = on ? sig : -1;
        tab[91] = on ? (4 * sig - 8) / 8 : 2;
        const int x0 = c & 7, j0 = c >> 3; int r = -1, ex = -1, ek = 0;
        if (j0 >= NJ - idle[x0]) { r = j0 - (NJ - idle[x0]); for (int x = 0; x < x0; ++x) r += idle[x]; }
        if (r >= 0) { for (int x = 0; x < 8; ++x) { if (ex < 0) { if (r < E[x]) { ex = x; ek = r; } else r -= E[x]; } } }
        tab[89] = ex; tab[90] = ek; }
    __syncthreads();
}
#ifndef MOE_MAXU_OVERRIDE
#define MOE_MAXU_OVERRIDE 9
#endif
constexpr int MOE_MAXU = MOE_MAXU_OVERRIDE;
constexpr int UT_OFF = RING_BYTES + 1536;
constexpr int UB_OFF = UT_OFF + MOE_MAXU * 512;
static_assert(UB_OFF + MOE_MAXU * 1024 <= LDS_BYTES, "LDS map");
template <int KIND>
struct MoeSched {
    static constexpr int NPN = KIND == 1 ? 8 : 4;
    unsigned char* ws; const LAS int* tab; LAS unsigned char* lds; int G, c; bool freeze = false;
    int ibase = 0, off = 0, maxi = 1 << 30, ord0 = 0;
    __device__ __forceinline__ bool unit(int i, int& e, int& rb, int& pn) const {
        const int x = c & 7, j = c >> 3, NJ = G >> 3;
        int L = (i + ibase) * NJ + j + off; e = -1; rb = 0; pn = 0; if (i >= maxi) return false;
#pragma unroll
        for (int q = 0; q < NE / 8; ++q) { const int eq = x + 8 * q, uq = (tab[eq + 1] - tab[eq]) * NPN;
            if (e < 0) { if (L < uq) { e = eq; rb = L / NPN; pn = L % NPN; } else L -= uq; } }
        if (e < 0) return false;
        e = __builtin_amdgcn_readfirstlane(e); rb = __builtin_amdgcn_readfirstlane(rb); pn = __builtin_amdgcn_readfirstlane(pn);
        return true;
    }
    __device__ __forceinline__ void init(unsigned char* ws_, LAS unsigned char* lds_, int G_, int c_, const float* bias) {
        ws = ws_; lds = lds_; tab = (const LAS int*)(lds_ + TAB_OFF); G = G_; c = c_; off = KIND == 2 ? __builtin_amdgcn_readfirstlane(tab[80 + (c_ & 7)]) : 0; ibase = 0; maxi = 1 << 30; ord0 = 0;
        const int tid = opaque_tid();
        int tokv[MOE_MAXU]; float bv[MOE_MAXU]; bool ok[MOE_MAXU];
#pragma unroll
        for (int i = 0; i < MOE_MAXU; ++i) { int e, rb, pn; ok[i] = unit(i, e, rb, pn); tokv[i] = T; bv[i] = 0.f;
            if (ok[i]) { if (tid < 256) { if (KIND == 1) { const int nvalid = min(256, tab[40 + e] - rb * 256); if (tid < nvalid) tokv[i] = ((const int*)(ws + WS_SLOT_TOK))[((size_t)e * CAP + rb * 256 + tid) * 2]; } }
                else { const int cq = tid - 256, ca = KIND == 2 ? (cq & ~63) + 16 * ((cq >> 3) & 3) + 8 * ((cq >> 5) & 1) + (cq & 7) : (cq & ~63) + 16 * ((cq >> 3) & 3) + 8 * ((cq >> 5) & 1) + (cq & 7);
                    bv[i] = bias[(size_t)e * (NPN * 256) + pn * 256 + ca]; } } }
#pragma unroll
        for (int i = 0; i < MOE_MAXU; ++i) if (ok[i]) { if (tid < 256) { if (KIND == 1) ((LAS unsigned short*)(lds + UT_OFF))[i * 256 + tid] = (unsigned short)tokv[i]; }
            else ((LAS float*)(lds + UB_OFF))[i * 256 + tid - 256] = bv[i]; }
        __syncthreads();
    }
    __device__ __forceinline__ void init_part(unsigned char* ws_, LAS unsigned char* lds_, int G_, int c_, int ibase_) { ws = ws_; lds = lds_; tab = (const LAS int*)(lds_ + TAB_OFF); G = G_; c = c_; off = KIND == 2 ? __builtin_amdgcn_readfirstlane(tab[80 + (c_ & 7)]) : 0; ibase = ibase_; maxi = 1 << 30; ord0 = 0; }
    __device__ __forceinline__ void init_early(unsigned char* ws_, LAS unsigned char* lds_, int G_, int x, int k) { ws = ws_; lds = lds_; tab = (const LAS int*)(lds_ + TAB_OFF); G = G_; c = x + 8 * k; ibase = 0; off = 0; maxi = 1; ord0 = MOE_MAXU; }
    __device__ __forceinline__ bool next(int i, Unit& u) const {
        int e, rb, pn; if (!unit(i, e, rb, pn)) return false;
#if defined(PROBE_FREEZE)
        if (freeze) { int e0, r0, p0; unit(0, e0, r0, p0); e = e0; rb = r0; pn = p0; }
#endif
        const int blk = tab[e] + rb, nvalid = min(256, tab[40 + e] - rb * 256);
        u.pm = rb; u.pn = pn; u.aux = e; u.ord = i + ibase + ord0; const LaneRC rc;
        if (KIND == 1) {
            u.aux2 = blk; u.A = (const char*)(ws + WS_H2); u.B = (const char*)(ws + WS_W1_T + ((size_t)e * 2 * DFF + (size_t)pn * BM) * D);
#pragma unroll
            for (int h = 0; h < 2; ++h)
#pragma unroll
                for (int jj = 0; jj < 2; ++jj) { const int r = 128 * h + rc.R[jj]; int tok;
                    if (i < MOE_MAXU) tok = ((const LAS unsigned short*)(lds + UT_OFF))[i * 256 + r];
                    else { tok = r < nvalid ? ((const int*)(ws + WS_SLOT_TOK))[((size_t)e * CAP + rb * 256 + r) * 2] : T; __builtin_amdgcn_s_waitcnt(0x0F70); }
                    u.aoff[h][jj] = (unsigned)(tok * D + rc.C[jj] * 2); }
        } else {
            u.aux2 = blk | (nvalid << 16); u.A = (const char*)(ws + WS_ACT); u.B = (const char*)(ws + WS_W2_T + ((size_t)e * D + (size_t)pn * BM) * DFF);
#pragma unroll
            for (int h = 0; h < 2; ++h)
#pragma unroll
                for (int jj = 0; jj < 2; ++jj) u.aoff[h][jj] = (unsigned)((blk * 256 + 128 * h + rc.R[jj]) * DFF + rc.C[jj] * 2);
        }
        return true;
    }
};
}
namespace pg {
struct EpiBase { static constexpr bool HAS_MID = false; static constexpr int MID_T = -1; __device__ __forceinline__ void mid(Acc&, const EpiInfo&, int, int, int, int) const {} };
__device__ __forceinline__ u32x4 pack8(const f32x4 a, const f32x4 b) { u32x4 w; w.x = pk2(a[0], a[1]); w.y = pk2(a[2], a[3]); w.z = pk2(b[0], b[1]); w.w = pk2(b[2], b[3]); return w; }
__device__ __forceinline__ void unpack8(const u32x4 w, f32x4& a, f32x4& b) { a = (f32x4){bflo(w.x), bfhi(w.x), bflo(w.y), bfhi(w.y)}; b = (f32x4){bflo(w.z), bfhi(w.z), bflo(w.w), bfhi(w.w)}; }

struct EpiNull : EpiBase {
    __device__ __forceinline__ void operator()(Acc& acc, const EpiInfo&, int, int, int, int) const {
#pragma unroll
        for (int a = 0; a < 2; ++a)
#pragma unroll
            for (int b = 0; b < 2; ++b)
#pragma unroll
                for (int m = 0; m < 4; ++m)
#pragma unroll
                    for (int n = 0; n < 2; ++n) asm volatile("" :: "v"(acc[a][b][m][n]));
    }
};
struct EpiInProj : EpiBase {
    unsigned char* ws; const float* qg; const float* kg;
    __device__ __forceinline__ void operator()(Acc& acc, const EpiInfo& u, int wr, int wc, int fr, int fq) const {
        const int pn = u.pn, row0 = u.pm * BM + wr * 64 + fr, colw = 64 * wc + 8 * fq;
        if (pn < 2) {
            bf16_t* acat = (bf16_t*)(ws + WS_ACAT);
#pragma unroll
            for (int ai = 0; ai < 2; ++ai)
#pragma unroll
                for (int m = 0; m < 4; ++m) { const int tok = row0 + ai * 128 + m * 16;
#pragma unroll
                    for (int bj = 0; bj < 2; ++bj) { const int cu = pn * 256 + colw + 32 * bj, g = cu >> 4, h0 = cu & 15;
                        *(u32x4*)(acat + ((size_t)(g * ACAT_ROWS + (tok >> 5))) * ACAT_LD + (tok & 31) * 16 + h0) = pack8(acc[ai][bj][m][0], acc[ai][bj][m][1]); } }
        } else if (pn < 10) {
            const bool isq = pn < 6; const float* gain = isq ? qg : kg; const float sc = isq ? QC2 : 1.f;
            bf16_t* dst = (bf16_t*)(ws + (isq ? WS_Q : WS_K)) + (size_t)(pn - (isq ? 2 : 6)) * 256 + colw;
            f32x4 gv[2][2];
#pragma unroll
            for (int bj = 0; bj < 2; ++bj)
#pragma unroll
                for (int n = 0; n < 2; ++n) gv[bj][n] = *(const f32x4*)(gain + 32 * bj + 8 * fq + 4 * n);
#pragma unroll
            for (int ai = 0; ai < 2; ++ai)
#pragma unroll
                for (int m = 0; m < 4; ++m) { const int tok = row0 + ai * 128 + m * 16; float ss = 0.f;
#pragma unroll
                    for (int bj = 0; bj < 2; ++bj)
#pragma unroll
                        for (int n = 0; n < 2; ++n) { const f32x4 v = acc[ai][bj][m][n]; ss += (v[0] * v[0] + v[1] * v[1]) + (v[2] * v[2] + v[3] * v[3]); }
                    ss += __shfl_xor(ss, 16); ss += __shfl_xor(ss, 32);
                    const float r = rsqrtf(ss * (1.f / 64.f) + EPS) * sc;
#pragma unroll
                    for (int bj = 0; bj < 2; ++bj) store16(dst + (size_t)tok * D + 32 * bj, pack8(acc[ai][bj][m][0] * r * gv[bj][0], acc[ai][bj][m][1] * r * gv[bj][1])); }
        } else if (pn < 14) {
            bf16_t* dst = (bf16_t*)(ws + WS_V) + (size_t)(pn - 10) * 256 + colw;
#pragma unroll
            for (int ai = 0; ai < 2; ++ai)
#pragma unroll
                for (int m = 0; m < 4; ++m) { const int tok = row0 + ai * 128 + m * 16;
#pragma unroll
                    for (int bj = 0; bj < 2; ++bj) store16(dst + (size_t)tok * D + 32 * bj, pack8(acc[ai][bj][m][0], acc[ai][bj][m][1])); }
        } else {
            const bool isS = pn < 18; unsigned char* dst = ws + (isS ? WS_GS : WS_GA) + (size_t)(pn - (isS ? 14 : 18)) * 256 + 64 * wc + 16 * fq; const float lo = isS ? 1.f : 0.f;
            const f32x2 cexp = {-1.4426950408889634f, -1.4426950408889634f}, one = {1.f, 1.f};
#pragma unroll
            for (int ai = 0; ai < 2; ++ai)
#pragma unroll
                for (int m = 0; m < 4; ++m) { const int tok = row0 + ai * 128 + m * 16; u32x4 w4;
#pragma unroll
                    for (int bj = 0; bj < 2; ++bj) { u32x2 w = {0u, 0u};
#pragma unroll
                        for (int n = 0; n < 2; ++n) { const f32x4 v = acc[ai][bj][m][n]; unsigned pk = 0u;
#pragma unroll
                            for (int hp = 0; hp < 2; ++hp) { const f32x2 x = (f32x2){v[2 * hp], v[2 * hp + 1]} * cexp; f32x2 ex = {__builtin_amdgcn_exp2f(x[0]), __builtin_amdgcn_exp2f(x[1])}; ex = ex + one;
                                const float s0 = fmaxf(__builtin_rintf(255.f * __builtin_amdgcn_rcpf(ex[0])), lo), s1 = fmaxf(__builtin_rintf(255.f * __builtin_amdgcn_rcpf(ex[1])), lo);
                                pk = __builtin_amdgcn_cvt_pk_u8_f32(s0, 2 * hp, pk); pk = __builtin_amdgcn_cvt_pk_u8_f32(s1, 2 * hp + 1, pk); }
                            if (n == 0) w.x = pk; else w.y = pk; }
                        if (bj == 0) { w4.x = w.x; w4.y = w.y; } else { w4.z = w.x; w4.w = w.y; } }
                    NT_STORE(w4, (u32x4*)(dst + (size_t)tok * D)); }
        }
    }
};
struct EpiSsm2 : EpiBase {
    unsigned char* ws;
    __device__ __forceinline__ void operator()(Acc& acc, const EpiInfo& u, int wr, int wc, int fr, int fq) const {
        bf16_t* Z = (bf16_t*)(ws + WS_Z); const int g = u.aux;
#pragma unroll
        for (int ai = 0; ai < 2; ++ai)
#pragma unroll
            for (int m = 0; m < 4; ++m) { const int r = u.pm * BM + ai * 128 + wr * 64 + m * 16 + fr, b = r >> 6, c = r & 63;
#pragma unroll
                for (int bj = 0; bj < 2; ++bj) { const int n_ = u.pn * 256 + 64 * wc + 32 * bj + 8 * fq, t = n_ >> 4, h0 = n_ & 15; const int tok = b * SEQ + c * CH_L + t;
                    f32x4 a = acc[ai][bj][m][0], bb = acc[ai][bj][m][1];
#pragma unroll
                    for (int q = 0; q < 4; ++q) { a[q] = gelu_tanh(a[q]); bb[q] = gelu_tanh(bb[q]); }
                    *(u32x4*)(Z + (size_t)tok * SSM_W + 16 * g + h0) = pack8(a, bb); } }
    }
};
struct EpiGlu : EpiBase {
    unsigned char* ws; const float* bglu;
    __device__ __forceinline__ void operator()(Acc& acc, const EpiInfo& u, int wr, int wc, int fr, int fq) const {
        asm volatile("" : "+v"(fr), "+v"(fq));
        const bf16_t* Z = (const bf16_t*)(ws + WS_Z); bf16_t* MA = (bf16_t*)(ws + WS_MA);
        const int col0 = u.pn * 256 + 64 * wc + 8 * fq;
        f32x4 cb[2][2];
#pragma unroll
        for (int bj = 0; bj < 2; ++bj) { cb[bj][0] = *(const f32x4*)(bglu + col0 + 32 * bj); cb[bj][1] = *(const f32x4*)(bglu + col0 + 32 * bj + 4); }
#pragma unroll
        for (int ai = 0; ai < 2; ++ai) { u32x4 zz[4][2];
#pragma unroll
            for (int m = 0; m < 4; ++m) { const int tok = u.pm * BM + ai * 128 + wr * 64 + m * 16 + fr;
#pragma unroll
                for (int bj = 0; bj < 2; ++bj) zz[m][bj] = *(const u32x4*)(Z + (size_t)tok * SSM_W + col0 + 32 * bj); }
            asm volatile("" ::: "memory");
#pragma unroll
            for (int m = 0; m < 4; ++m) { const int tok = u.pm * BM + ai * 128 + wr * 64 + m * 16 + fr;
#pragma unroll
                for (int bj = 0; bj < 2; ++bj) { f32x4 z0, z1; unpack8(zz[m][bj], z0, z1);
                    f32x4 a = acc[ai][bj][m][0] + cb[bj][0], bb = acc[ai][bj][m][1] + cb[bj][1];
#pragma unroll
                    for (int q = 0; q < 4; ++q) { a[q] = z0[q] * sigmoid_f(a[q]); bb[q] = z1[q] * sigmoid_f(bb[q]); }
                    *(u32x4*)(MA + (size_t)tok * MA_LD + 1024 + col0 + 32 * bj) = pack8(a, bb); } }
            asm volatile("" ::: "memory"); }
    }
};
struct EpiMerged : EpiBase {
    static constexpr bool HAS_MID = true; static constexpr int MID_T = 16;
    unsigned char* ws;
    __device__ __forceinline__ void mid(Acc& acc, const EpiInfo& u, int wr, int wc, int fr, int fq) const {
        asm volatile("" : "+v"(fr), "+v"(fq));
        const unsigned char* GS = ws + WS_GS; const unsigned char* GA = ws + WS_GA;
        const int col0 = u.pn * 256 + 64 * wc + 16 * fq;
#pragma unroll
        for (int ai = 0; ai < 2; ++ai)
#pragma unroll
            for (int mp = 0; mp < 2; ++mp) { u32x2 gs_[2][2], ga_[2][2];
#pragma unroll
                for (int mm = 0; mm < 2; ++mm) { const int tok = u.pm * BM + ai * 128 + wr * 64 + (2 * mp + mm) * 16 + fr;
                    const u32x4 s4 = *(const u32x4*)(GS + (size_t)tok * D + col0), a4 = *(const u32x4*)(GA + (size_t)tok * D + col0);
                    gs_[mm][0] = (u32x2){s4.x, s4.y}; gs_[mm][1] = (u32x2){s4.z, s4.w}; ga_[mm][0] = (u32x2){a4.x, a4.y}; ga_[mm][1] = (u32x2){a4.z, a4.w}; }
#pragma unroll
                for (int mm = 0; mm < 2; ++mm)
#pragma unroll
                    for (int bj = 0; bj < 2; ++bj) { const int m = 2 * mp + mm;
#pragma unroll
                        for (int n = 0; n < 2; ++n) { const unsigned ws_ = n ? gs_[mm][bj].y : gs_[mm][bj].x, wa_ = n ? ga_[mm][bj].y : ga_[mm][bj].x;
#pragma unroll
                            for (int q = 0; q < 4; ++q) acc[ai][bj][m][n][q] *= (float)((wa_ >> (8 * q)) & 0xffu) * __builtin_amdgcn_rcpf((float)((ws_ >> (8 * q)) & 0xffu)); } }
                asm volatile("" ::: "memory"); }
    }
    __device__ __forceinline__ void operator()(Acc& acc, const EpiInfo& u, int wr, int wc, int fr, int fq) const {
        asm volatile("" : "+v"(fr), "+v"(fq));
        const unsigned char* GS = ws + WS_GS; bf16_t* O = (bf16_t*)(ws + WS_MERGED);
        const int col0 = u.pn * 256 + 64 * wc + 16 * fq;
#pragma unroll
        for (int ai = 0; ai < 2; ++ai) { u32x2 gs_[4][2];
#pragma unroll
            for (int m = 0; m < 4; ++m) { const int tok = u.pm * BM + ai * 128 + wr * 64 + m * 16 + fr;
                const u32x4 s4 = *(const u32x4*)(GS + (size_t)tok * D + col0); gs_[m][0] = (u32x2){s4.x, s4.y}; gs_[m][1] = (u32x2){s4.z, s4.w}; }
#pragma unroll
            for (int m = 0; m < 4; ++m) { const int tok = u.pm * BM + ai * 128 + wr * 64 + m * 16 + fr;
#pragma unroll
                for (int bj = 0; bj < 2; ++bj) { f32x4 a = acc[ai][bj][m][0], bb = acc[ai][bj][m][1]; const unsigned w0 = gs_[m][bj].x, w1 = gs_[m][bj].y;
#pragma unroll
                    for (int q = 0; q < 4; ++q) { a[q] *= (float)((w0 >> (8 * q)) & 0xffu) * (1.f / 255.f); bb[q] *= (float)((w1 >> (8 * q)) & 0xffu) * (1.f / 255.f); }
                    *(u32x4*)(O + (size_t)tok * D + col0 + 8 * bj) = pack8(a, bb); } }
            asm volatile("" ::: "memory"); }
    }
};
struct EpiWout : EpiBase {
    const float* x; bf16_t* out; bool pre = false;
    __device__ __forceinline__ void operator()(Acc& acc, const EpiInfo& u, int wr, int wc, int fr, int fq) const {
        asm volatile("" : "+v"(fr), "+v"(fq));
        const int col0 = u.pn * 256 + 64 * wc + 8 * fq;
        if (pre && u.ord == 0) {
#pragma unroll
            for (int ai = 0; ai < 2; ++ai)
#pragma unroll
                for (int m = 0; m < 4; ++m) { const int tok = u.pm * BM + ai * 128 + wr * 64 + m * 16 + fr;
#pragma unroll
                    for (int bj = 0; bj < 2; ++bj) *(u32x4*)(out + (size_t)tok * D + col0 + 32 * bj) = pack8(acc[ai][bj][m][0], acc[ai][bj][m][1]); }
            return; }
#pragma unroll
        for (int ai = 0; ai < 2; ++ai)
#pragma unroll
            for (int mp = 0; mp < 2; ++mp) { f32x4 xv[2][2][2];
#pragma unroll
                for (int mm = 0; mm < 2; ++mm) { const int tok = u.pm * BM + ai * 128 + wr * 64 + (2 * mp + mm) * 16 + fr;
#pragma unroll
                    for (int bj = 0; bj < 2; ++bj) { const size_t o = (size_t)tok * D + col0 + 32 * bj; xv[mm][bj][0] = NT_LOAD((const f32x4*)(x + o)); xv[mm][bj][1] = NT_LOAD((const f32x4*)(x + o + 4)); } }
                asm volatile("" ::: "memory");
#pragma unroll
                for (int mm = 0; mm < 2; ++mm) { const int m = 2 * mp + mm, tok = u.pm * BM + ai * 128 + wr * 64 + m * 16 + fr;
#pragma unroll
                    for (int bj = 0; bj < 2; ++bj) *(u32x4*)(out + (size_t)tok * D + col0 + 32 * bj) = pack8(xv[mm][bj][0] + acc[ai][bj][m][0], xv[mm][bj][1] + acc[ai][bj][m][1]); }
                asm volatile("" ::: "memory"); }
    }
};
struct EpiMoe1 : EpiBase {
    unsigned char* ws; const float* b1; LAS unsigned char* lds; bool nostore = false; unsigned* sig = nullptr; int sig_ord = -1; unsigned xcc = 0, nloc = 1;
    __device__ __forceinline__ void operator()(Acc& acc, const EpiInfo& u, int wr, int wc, int fr, int fq) const {
        asm volatile("" : "+v"(fr), "+v"(fq));
        if (u.ord == sig_ord) {
            asm volatile("s_waitcnt vmcnt(0)" ::: "memory"); __builtin_amdgcn_s_barrier();
            if (opaque_tid() == 0) { const unsigned old = __hip_atomic_fetch_add(sig + 64 * (1 + xcc), 1u, __ATOMIC_RELAXED, __HIP_MEMORY_SCOPE_AGENT);
                if (old + 1u == nloc) { __builtin_amdgcn_fence(__ATOMIC_RELEASE, "agent"); asm volatile("s_waitcnt vmcnt(0)" ::: "memory"); (void)__hip_atomic_fetch_add(sig, nloc, __ATOMIC_RELAXED, __HIP_MEMORY_SCOPE_AGENT); } } }
        unsigned char* ACT = ws + WS_ACT; const int e = u.aux, blk = u.aux2;
        f32x4 cb[2][2];
#pragma unroll
        for (int bj = 0; bj < 2; ++bj) { const int cl = 64 * wc + 32 * bj + 8 * fq; f32x4 r0, r1;
            if (u.ord < MOE_MAXU) { const LAS float* bl = (const LAS float*)(lds + UB_OFF) + u.ord * 256 + cl; r0 = *(const LAS f32x4*)bl; r1 = *(const LAS f32x4*)(bl + 4); }
            else { const float* bg = b1 + (size_t)e * 2 * DFF + u.pn * 256 + 64 * wc + 16 * fq + 8 * bj; r0 = *(const f32x4*)bg; r1 = *(const f32x4*)(bg + 4); __builtin_amdgcn_s_waitcnt(0x0F70); }
            cb[bj][0] = __builtin_shufflevector(r0, r0, 0, 2, 1, 3); cb[bj][1] = __builtin_shufflevector(r1, r1, 0, 2, 1, 3); }
        const f32x2 c7 = {7.f, 7.f}, one = {1.f, 1.f}, cexp = {-1.702f * 1.4426950408889634f, -1.702f * 1.4426950408889634f};
#pragma unroll
        for (int ai = 0; ai < 2; ++ai) { unsigned wq[4][2];
#pragma unroll
            for (int m = 0; m < 4; ++m) { unsigned w[2];
#pragma unroll
                for (int bj = 0; bj < 2; ++bj) { f32x2 r[2];
#pragma unroll
                    for (int n = 0; n < 2; ++n) { const f32x4 h = acc[ai][bj][m][n] + cb[bj][n];
                        f32x2 g = {fminf(h[0], 7.f), fminf(h[1], 7.f)}; const f32x2 up = {fminf(fmaxf(h[2], -7.f), 7.f), fminf(fmaxf(h[3], -7.f), 7.f)};
                        const f32x2 x = g * cexp; f32x2 ex = {__builtin_amdgcn_exp2f(x[0]), __builtin_amdgcn_exp2f(x[1])};
                        ex = ex + one; const f32x2 s = {__builtin_amdgcn_rcpf(ex[0]), __builtin_amdgcn_rcpf(ex[1])};
                        r[n] = (up * g + g) * s; }
                    w[bj] = pk4_fp8(r[0][0], r[0][1], r[1][0], r[1][1]); }
                wq[m][0] = w[0]; wq[m][1] = w[1]; }
#pragma unroll
            for (int mp = 0; mp < 2; ++mp) {
                const auto s0 = __builtin_amdgcn_permlane16_swap(wq[2 * mp][0], wq[2 * mp + 1][0], false, false), s1 = __builtin_amdgcn_permlane16_swap(wq[2 * mp][1], wq[2 * mp + 1][1], false, false);
                const int row = ai * 128 + wr * 64 + (2 * mp + (fq & 1)) * 16 + fr;
                *(u32x4*)(ACT + ((size_t)blk * 256 + row) * DFF + ((u.pn * 256 + 64 * wc) >> 1) + 8 * (fq & ~1)) = (u32x4){s0[0], s1[0], s0[1], s1[1]}; } }
        (void)c7;
    }
};
struct EpiMoe2 : EpiBase {
    unsigned char* ws; const float* b2; LAS unsigned char* lds; bool nostore = false;
    __device__ __forceinline__ void operator()(Acc& acc, const EpiInfo& u, int wr, int wc, int fr, int fq) const {
        asm volatile("" : "+v"(fr), "+v"(fq));
        unsigned char* Y = ws + WS_Y; const int e = u.aux, blk = u.aux2 & 0xffff;
        f32x4 cb[2][2];
#pragma unroll
        for (int bj = 0; bj < 2; ++bj) { const int cl = 64 * wc + 32 * bj + 8 * fq;
            if (u.ord < MOE_MAXU) { const LAS float* bl = (const LAS float*)(lds + UB_OFF) + u.ord * 256 + cl; cb[bj][0] = *(const LAS f32x4*)bl; cb[bj][1] = *(const LAS f32x4*)(bl + 4); }
            else { const float* bg = b2 + (size_t)e * D + u.pn * 256 + 64 * wc + 16 * fq + 8 * bj; cb[bj][0] = *(const f32x4*)bg; cb[bj][1] = *(const f32x4*)(bg + 4); __builtin_amdgcn_s_waitcnt(0x0F70); } }
#pragma unroll
        for (int ai = 0; ai < 2; ++ai)
#pragma unroll
            for (int m = 0; m < 4; ++m) { const int row = ai * 128 + wr * 64 + m * 16 + fr; u32x4 w;
#pragma unroll
                for (int bj = 0; bj < 2; ++bj) { const f32x4 y0 = (acc[ai][bj][m][0] + cb[bj][0]) * 16.f, y1 = (acc[ai][bj][m][1] + cb[bj][1]) * 16.f;
                    const unsigned lo = pk4_fp8(y0[0], y0[1], y0[2], y0[3]), hi = pk4_fp8(y1[0], y1[1], y1[2], y1[3]); if (bj == 0) { w.x = lo; w.y = hi; } else { w.z = lo; w.w = hi; } }
                *(u32x4*)(Y + ((size_t)blk * 256 + row) * D + u.pn * 256 + 64 * wc + 16 * fq) = w; }
    }
};
}
namespace attn_body {
using bf16=__hip_bfloat16;
using bf16x8=__attribute__((ext_vector_type(8)))short;
using s16x4=__attribute__((ext_vector_type(4)))short;
using f32x16=__attribute__((ext_vector_type(16)))float;
using u32x4=__attribute__((ext_vector_type(4)))unsigned;
constexpr int SEQ=2048,D=64,DM=1024;
constexpr int NW=8,QBLK=32,QB=QBLK*NW,KVBLK=64,NQB=SEQ/QB;
constexpr int ATTN_PITCH=DM, ATTN_UNIT_ROWS=QB;
__device__ __forceinline__ int crow(int r,int hi){return (r&3)+8*(r>>2)+4*hi;}
#define SBAR() __builtin_amdgcn_sched_barrier(0)
__device__ __forceinline__ void cmask(f32x16&p0,f32x16&p1,int jb,int qrel,int hi){
  const float NEG=-INFINITY; int kb=64*jb+4*hi;
  #pragma unroll
  for(int r=0;r<16;++r){int kv=kb+(r&3)+8*(r>>2); if(kv>qrel)p0[r]=NEG; if(kv+32>qrel)p1[r]=NEG;}
}

constexpr int NSLOT=3, SLOTB=8192;
constexpr int LDS_K=0, LDS_V=NSLOT*SLOTB, LDS_WS=2*NSLOT*SLOTB, LDS_OST=LDS_WS+NW*64*4, ALDS_BYTES=LDS_OST+NW*4096;
constexpr float C2=0.125f*1.4426950408889634f;
__device__ __forceinline__ void glds16(const void*gsrc,unsigned lds_dst){unsigned keep;
  asm volatile("s_mov_b32 %0, m0\n\ts_mov_b32 m0, %2\n\ts_nop 0\n\tglobal_load_lds_dwordx4 %1, off\n\ts_mov_b32 m0, %0":"=&s"(keep):"v"(gsrc),"s"(lds_dst):"memory");}
__device__ __forceinline__ float max3f(float a,float b,float c){float r;asm("v_max3_f32 %0, %1, %2, %3":"=v"(r):"v"(a),"v"(b),"v"(c));return r;}
__device__ __forceinline__ float max2f(float a,float b){float r;asm("v_max_f32_e32 %0, %1, %2":"=v"(r):"v"(a),"v"(b));return r;}
__device__ __forceinline__ float fadd_s(float a,float b){float r;asm("v_add_f32_e32 %0, %1, %2":"=v"(r):"v"(a),"v"(b));return r;}
__device__ __forceinline__ float fsub_s(float a,float b){float r;asm("v_sub_f32_e32 %0, %1, %2":"=v"(r):"v"(a),"v"(b));return r;}
typedef float f32x2_t __attribute__((ext_vector_type(2))); typedef __bf16 bf16x2_t __attribute__((ext_vector_type(2)));
__device__ __forceinline__ unsigned cvtpk_s(float lo,float hi){f32x2_t v={lo,hi};bf16x2_t b=__builtin_convertvector(v,bf16x2_t);return __builtin_bit_cast(unsigned,b);}
#define WAIT_BAR(N) asm volatile("s_waitcnt vmcnt(" #N ") lgkmcnt(0)\n\ts_barrier":::"memory")

__device__ __forceinline__ void qkt(f32x16&p0,f32x16&p1,const char*Kslot,const bf16x8*qr,const f32x16&negm,int r32,int hi){
  const char*kb=Kslot+hi*1024+r32*16;
  #pragma unroll
  for(int d0=0;d0<4;++d0){
    const bf16x8 b0=*reinterpret_cast<const bf16x8*>(kb+d0*2048);
    const bf16x8 b1=*reinterpret_cast<const bf16x8*>(kb+d0*2048+512);
    if(d0==0){p0=__builtin_amdgcn_mfma_f32_32x32x16_bf16(b0,qr[0],negm,0,0,0);p1=__builtin_amdgcn_mfma_f32_32x32x16_bf16(b1,qr[0],negm,0,0,0);}
    else{p0=__builtin_amdgcn_mfma_f32_32x32x16_bf16(b0,qr[d0],p0,0,0,0);p1=__builtin_amdgcn_mfma_f32_32x32x16_bf16(b1,qr[d0],p1,0,0,0);}}
}
typedef __attribute__((address_space(3))) const char* lds_cptr;
typedef short v4i16_t __attribute__((ext_vector_type(4)));
__device__ __forceinline__ void kload8(bf16x8*kf,lds_cptr kp){
  kf[0]=*(const __attribute__((address_space(3))) bf16x8*)(kp);      kf[1]=*(const __attribute__((address_space(3))) bf16x8*)(kp+512);
  kf[2]=*(const __attribute__((address_space(3))) bf16x8*)(kp+2048); kf[3]=*(const __attribute__((address_space(3))) bf16x8*)(kp+2560);
  kf[4]=*(const __attribute__((address_space(3))) bf16x8*)(kp+4096); kf[5]=*(const __attribute__((address_space(3))) bf16x8*)(kp+4608);
  kf[6]=*(const __attribute__((address_space(3))) bf16x8*)(kp+6144); kf[7]=*(const __attribute__((address_space(3))) bf16x8*)(kp+6656);
}
__device__ __forceinline__ void kload2(bf16x8*kf,lds_cptr kp,int j){ kf[2*j]=*(const __attribute__((address_space(3))) bf16x8*)(kp+j*2048); kf[2*j+1]=*(const __attribute__((address_space(3))) bf16x8*)(kp+j*2048+512); }
__device__ __forceinline__ s16x4 vtr(lds_cptr p){ return __builtin_bit_cast(s16x4,__builtin_amdgcn_ds_read_tr16_b64_v4i16((__attribute__((address_space(3))) v4i16_t*)p)); }
__device__ __forceinline__ float rowmax(const f32x16&p0,const f32x16&p1){
  float a=max3f(p0[0],p0[1],p1[0]),b=max3f(p0[2],p0[3],p1[1]);a=max3f(a,p1[2],p1[3]);
  #pragma unroll
  for(int r=4;r<16;r+=4){a=max3f(a,p0[r],p0[r+1]);b=max3f(b,p0[r+2],p0[r+3]);a=max3f(a,p1[r],p1[r+1]);b=max3f(b,p1[r+2],p1[r+3]);}
  const float m=max2f(a,b);
  auto rr=__builtin_amdgcn_permlane32_swap(__float_as_uint(m),__float_as_uint(m),false,false);
  return max2f(__uint_as_float(rr[0]),__uint_as_float(rr[1]));
}
__device__ __forceinline__ void pv(f32x16*o,int vb,bf16x8 pa0,bf16x8 pa1,bf16x8 pa2,bf16x8 pa3){
  #pragma unroll
  for(int d0=0;d0<2;++d0){s16x4 lo[4],hi[4];
    #pragma unroll
    for(int ks=0;ks<4;++ks){
      asm volatile("ds_read_b64_tr_b16 %0,%1 offset:%c2":"=&v"(lo[ks]):"v"(vb),"i"(d0*4096+ks*1024):"memory");
      asm volatile("ds_read_b64_tr_b16 %0,%1 offset:%c2":"=&v"(hi[ks]):"v"(vb),"i"(d0*4096+ks*1024+512):"memory");}
    asm volatile("s_waitcnt lgkmcnt(0)":::"memory");SBAR();
    #define PK(k) (bf16x8){lo[k][0],lo[k][1],lo[k][2],lo[k][3],hi[k][0],hi[k][1],hi[k][2],hi[k][3]}
    o[d0]=__builtin_amdgcn_mfma_f32_32x32x16_bf16(pa0,PK(0),o[d0],0,0,0);
    o[d0]=__builtin_amdgcn_mfma_f32_32x32x16_bf16(pa1,PK(1),o[d0],0,0,0);
    o[d0]=__builtin_amdgcn_mfma_f32_32x32x16_bf16(pa2,PK(2),o[d0],0,0,0);
    o[d0]=__builtin_amdgcn_mfma_f32_32x32x16_bf16(pa3,PK(3),o[d0],0,0,0);
    #undef PK
  }
}

#ifndef ATTN_STORE16
#define ATTN_STORE16(p,v) (*(u32x4*)(p)=(v))
#endif
template<int THRL> __device__ __forceinline__ void attn_unit(int b,int qcol,int kcol,int vcol,int ocol,int qb,const bf16*Q,const bf16*__restrict__ K,const bf16*__restrict__ V,bf16*O,char*shm){
  int tid_=threadIdx.x; asm volatile("":"+v"(tid_));
  const int tid=tid_,lane=tid&63,r32=lane&31,hi=lane>>5; const int wid=__builtin_amdgcn_readfirstlane(tid>>6);
  const long rowbase=(long)b*SEQ; const int q0=qb*QB;
  const bf16*Qw=Q+(rowbase+q0+wid*QBLK)*DM+qcol;
  const bf16*Kh=K+rowbase*DM+kcol,*Vh=V+rowbase*DM+vcol;
  const unsigned lds0=(unsigned)(uintptr_t)shm;
  float*wsf=(float*)(shm+LDS_WS)+wid*64;
  const bf16*ksrc=Kh+(long)lane*DM+wid*8;
  const bf16*vsrc=Vh+(long)(16*(wid&3)+(lane>>2))*DM+(wid>>2)*32+(lane&3)*8;
  const unsigned kdst=lds0+LDS_K+wid*1024, vdst=lds0+LDS_V+wid*1024;
  #define DMA_K(t,slot) glds16(ksrc+(long)(t)*KVBLK*DM,(unsigned)__builtin_amdgcn_readfirstlane(kdst+(slot)))
  #define DMA_V(t,slot) glds16(vsrc+(long)(t)*KVBLK*DM,(unsigned)__builtin_amdgcn_readfirstlane(vdst+(slot)))
  const int vb0=(int)(lds0+LDS_V)+((lane>>4)&1)*32+(lane&3)*8+(4*hi+((lane&15)>>2))*64;
  const char*Kbase=shm+LDS_K; bf16x8 kf[8];
  const lds_cptr shm3=(lds_cptr)shm; const lds_cptr kp0=shm3+LDS_K+hi*1024+r32*16; const lds_cptr vp0=shm3+LDS_V+((lane>>4)&1)*32+(lane&3)*8+(4*hi+((lane&15)>>2))*64;
  const int NT=(q0+QB)/KVBLK;
  DMA_K(0,0);DMA_V(0,0);DMA_K(1,SLOTB);
  bf16x8 qr[4];
  #pragma unroll
  for(int d0=0;d0<4;++d0)qr[d0]=*reinterpret_cast<const bf16x8*>(&Qw[(long)r32*DM+d0*16+hi*8]);
  float l_reg=0.f;f32x16 o[2];o[0]=f32x16{};o[1]=f32x16{};const f32x16 negm=f32x16{};
  const int qrel=wid*QBLK+r32;
  #define CMASK(P0,P1,t) do{int jb_=(t)-(NT-4); if(jb_>=0)cmask(P0,P1,jb_,qrel,hi);}while(0)
  #define START(P0,P1) do{ _Pragma("unroll") for(int r=0;r<16;++r)P0[r]=__builtin_amdgcn_exp2f(P0[r]); }while(0)
  #define RESC() do{}while(0)
  f32x16 pA0,pA1,pB0,pB1;
  int sl_prev=0,sl_cur=0,sl_next=SLOTB;
  #define ROT() do{sl_prev=sl_cur;sl_cur=sl_next;sl_next=(sl_next==(NSLOT-1)*SLOTB)?0:sl_next+SLOTB;}while(0)
  DMA_K(2,2*SLOTB);
  WAIT_BAR(3);
  qkt(pA0,pA1,Kbase,qr,negm,r32,hi);asm volatile("s_nop 15\n\ts_nop 7":"+v"(pA0),"+v"(pA1));CMASK(pA0,pA1,0);
  START(pA0,pA1);
  _Pragma("unroll") for(int r=0;r<16;++r)pA1[r]=__builtin_amdgcn_exp2f(pA1[r]);
  WAIT_BAR(0);
  DMA_K(3,0);DMA_V(1,SLOTB);
  ROT();
  kload8(kf,kp0+sl_cur);
  WAIT_BAR(2);
  s16x4 vlo[8],vhi[8]; u32x4 pw0,pw1,pw2,pw3;
  #define PKW(P,B) cvtpk_s(P[B],P[B+1])
  #define PAF(k) __builtin_bit_cast(bf16x8,pw##k)
  #define VFR(i) (bf16x8){vlo[i][0],vlo[i][1],vlo[i][2],vlo[i][3],vhi[i][0],vhi[i][1],vhi[i][2],vhi[i][3]}
  #define PIN(x) asm volatile("":"+v"(x))
  #define MX3(a,b,c) __builtin_fmaxf(__builtin_fmaxf((a),(b)),(c))
  #define GAPA(MF,A0,A1,A2,A3,W0,W1,PW) do{ MF; sacc+=A0; sacc+=A1; sacc+=A2; sacc+=A3; PIN(sacc); W0; W1; PIN(PW); SBAR(); }while(0)
  #define EX(v) __builtin_amdgcn_exp2f(v)
  #define GAPB(MF,X,B) do{ MF; X[B]=EX(X[B]); X[B+1]=EX(X[B+1]); X[B+2]=EX(X[B+2]); X[B+3]=EX(X[B+3]); PIN(X); SBAR(); }while(0)
  #define VRD(i) do{ vlo[i]=vtr(vp_+(((i)>>2)*4096+((i)&3)*1024)); vhi[i]=vtr(vp_+(((i)>>2)*4096+((i)&3)*1024+512)); }while(0)
  #define KRD(G,j) do{ if(G){ kload2(kf,kp0+sl_next,j); SBAR(); } }while(0)
  #define STEP(C0,C1,P0,P1,t,GK,GV,GL) do{ SBAR(); \
    const lds_cptr vp_=vp0+sl_prev; \
    VRD(0); SBAR(); float sacc=(P0[0]+P0[1]); \
    GAPA(C0=__builtin_amdgcn_mfma_f32_32x32x16_bf16(kf[0],qr[0],negm,0,0,0), P0[2],P0[3],P0[4],P0[5],     pw0[0]=PKW(P0,0), pw0[1]=PKW(P0,2), pw0); \
    VRD(4); SBAR(); GAPA(C1=__builtin_amdgcn_mfma_f32_32x32x16_bf16(kf[1],qr[0],negm,0,0,0), P0[6],P0[7],P0[8],P0[9],     pw0[2]=PKW(P0,4), pw0[3]=PKW(P0,6), pw0); \
    VRD(1); SBAR(); GAPA(C0=__builtin_amdgcn_mfma_f32_32x32x16_bf16(kf[2],qr[1],C0,0,0,0),   P0[10],P0[11],P0[12],P0[13], pw1[0]=PKW(P0,8), pw1[1]=PKW(P0,10), pw1); \
    VRD(5); SBAR(); GAPA(C1=__builtin_amdgcn_mfma_f32_32x32x16_bf16(kf[3],qr[1],C1,0,0,0),   P0[14],P0[15],P1[0],P1[1],   pw1[2]=PKW(P0,12),pw1[3]=PKW(P0,14), pw1); \
    VRD(2); SBAR(); GAPA(C0=__builtin_amdgcn_mfma_f32_32x32x16_bf16(kf[4],qr[2],C0,0,0,0),   P1[2],P1[3],P1[4],P1[5],     pw2[0]=PKW(P1,0), pw2[1]=PKW(P1,2), pw2); \
    VRD(6); SBAR(); GAPA(C1=__builtin_amdgcn_mfma_f32_32x32x16_bf16(kf[5],qr[2],C1,0,0,0),   P1[6],P1[7],P1[8],P1[9],     pw2[2]=PKW(P1,4), pw2[3]=PKW(P1,6), pw2); \
    VRD(3); SBAR(); GAPA(C0=__builtin_amdgcn_mfma_f32_32x32x16_bf16(kf[6],qr[3],C0,0,0,0),   P1[10],P1[11],P1[12],P1[13], pw3[0]=PKW(P1,8), pw3[1]=PKW(P1,10), pw3); \
    VRD(7); SBAR(); GAPA(C1=__builtin_amdgcn_mfma_f32_32x32x16_bf16(kf[7],qr[3],C1,0,0,0),   P1[14],P1[15],0.f,0.f,       pw3[2]=PKW(P1,12),pw3[3]=PKW(P1,14), pw3); \
    l_reg+=sacc; \
    if(GK){DMA_K((t)+3,sl_cur);} if(GV){DMA_V((t)+1,sl_next);} \
    CMASK(C0,C1,t); \
    SBAR(); \
    GAPB(o[0]=__builtin_amdgcn_mfma_f32_32x32x16_bf16(PAF(0),VFR(0),o[0],0,0,0), C0,0); \
    GAPB(o[1]=__builtin_amdgcn_mfma_f32_32x32x16_bf16(PAF(0),VFR(4),o[1],0,0,0), C0,4); \
    KRD(GL,0); GAPB(o[0]=__builtin_amdgcn_mfma_f32_32x32x16_bf16(PAF(1),VFR(1),o[0],0,0,0), C0,8); \
    KRD(GL,1); GAPB(o[1]=__builtin_amdgcn_mfma_f32_32x32x16_bf16(PAF(1),VFR(5),o[1],0,0,0), C0,12); \
    KRD(GL,2); GAPB(o[0]=__builtin_amdgcn_mfma_f32_32x32x16_bf16(PAF(2),VFR(2),o[0],0,0,0), C1,0); \
    KRD(GL,3); GAPB(o[1]=__builtin_amdgcn_mfma_f32_32x32x16_bf16(PAF(2),VFR(6),o[1],0,0,0), C1,4); \
    GAPB(o[0]=__builtin_amdgcn_mfma_f32_32x32x16_bf16(PAF(3),VFR(3),o[0],0,0,0), C1,8); \
    GAPB(o[1]=__builtin_amdgcn_mfma_f32_32x32x16_bf16(PAF(3),VFR(7),o[1],0,0,0), C1,12); \
    }while(0)
  int t=1;
  #undef CMASK
  #define CMASK(P0,P1,t) do{}while(0)
  for(;t+5<NT;t+=2){
    STEP(pB0,pB1,pA0,pA1,t,true,true,true);     WAIT_BAR(2); RESC(); ROT();
    STEP(pA0,pA1,pB0,pB1,t+1,true,true,true);   WAIT_BAR(2); RESC(); ROT();
  }
  #undef CMASK
  #define CMASK(P0,P1,t) do{int jb_=(t)-(NT-4); if(jb_>=0)cmask(P0,P1,jb_,qrel,hi);}while(0)
  #define ENDW(tt) do{ if((tt)+3<NT){WAIT_BAR(2);} else if((tt)+2<NT){WAIT_BAR(1);} else {WAIT_BAR(0);} }while(0)
  for(;t+1<NT;t+=2){
    STEP(pB0,pB1,pA0,pA1,t,(t+3<NT),(t+1<NT),(t+1<NT));       ENDW(t);   RESC(); ROT();
    STEP(pA0,pA1,pB0,pB1,t+1,(t+4<NT),(t+2<NT),(t+2<NT));     ENDW(t+1); RESC(); ROT();
  }
  STEP(pB0,pB1,pA0,pA1,NT-1,false,false,false); RESC();
  { float sacc=pB0[0]+pB0[1]; _Pragma("unroll") for(int r=2;r<16;++r)sacc+=pB0[r]; _Pragma("unroll") for(int r=0;r<16;++r)sacc+=pB1[r]; l_reg+=sacc;
    pw0=(u32x4){PKW(pB0,0),PKW(pB0,2),PKW(pB0,4),PKW(pB0,6)};pw1=(u32x4){PKW(pB0,8),PKW(pB0,10),PKW(pB0,12),PKW(pB0,14)};pw2=(u32x4){PKW(pB1,0),PKW(pB1,2),PKW(pB1,4),PKW(pB1,6)};pw3=(u32x4){PKW(pB1,8),PKW(pB1,10),PKW(pB1,12),PKW(pB1,14)};
    SBAR(); pv(o,vb0+sl_cur,PAF(0),PAF(1),PAF(2),PAF(3)); }
  #undef PKW
  #undef PAF
  #undef VFR
  #undef PIN
  #undef MX3
  #undef GAPA
  #undef GAPB
  #undef EX
  #undef VRD
  #undef KRD
  #undef STEP
  #undef ENDW
  {auto rr=__builtin_amdgcn_permlane32_swap(__float_as_uint(l_reg),__float_as_uint(l_reg),false,false);l_reg=__uint_as_float(rr[0])+__uint_as_float(rr[1]);}
  if(hi==0)wsf[32+r32]=l_reg;asm volatile("s_waitcnt lgkmcnt(0)":::"memory");
  float rli[16];
  #pragma unroll
  for(int r=0;r<16;++r)rli[r]=__builtin_amdgcn_rcpf(wsf[32+crow(r,hi)]);
  bf16*Ow=O+(rowbase+q0+wid*QBLK)*DM+ocol;
  { bf16*stg=(bf16*)(shm+LDS_OST)+wid*2048;
    #pragma unroll
    for(int r=0;r<16;++r){const int orow=crow(r,hi);
      #pragma unroll
      for(int d0=0;d0<2;++d0)stg[orow*64+d0*32+r32]=__float2bfloat16(o[d0][r]*rli[r]);}
    asm volatile("s_waitcnt lgkmcnt(0)":::"memory");
    #pragma unroll
    for(int i=0;i<4;++i){const int row=i*8+(lane>>3),ch=lane&7; const u32x4 v=*(const u32x4*)(stg+row*64+ch*8); ATTN_STORE16(Ow+(long)row*DM+ch*8,v);} }
  asm volatile("s_waitcnt lgkmcnt(0)\n\ts_barrier":::"memory");
  #undef DMA_K
  #undef DMA_V
  #undef CMASK
  #undef START
  #undef RESC
  #undef ROT
}
constexpr int ATTN_LDS_BYTES=ALDS_BYTES;

#undef SBAR
#undef WAIT_BAR
#undef ATTN_STORE16
}
namespace attn128 {
using bf16=__hip_bfloat16;
using bf16x8=__attribute__((ext_vector_type(8)))short;
using s16x4=__attribute__((ext_vector_type(4)))short;
using f32x16=__attribute__((ext_vector_type(16)))float;
using u32x4=__attribute__((ext_vector_type(4)))unsigned;
constexpr int SEQ=2048,D=64,DM=1024;
constexpr int NW=8,QBLK=32,QB=QBLK*NW,KVBLK=64,NQB=SEQ/QB;
constexpr int ATTN_PITCH=DM, ATTN_UNIT_ROWS=QB;
__device__ __forceinline__ int crow(int r,int hi){return (r&3)+8*(r>>2)+4*hi;}
#define SBAR() __builtin_amdgcn_sched_barrier(0)
__device__ __forceinline__ void cmask(f32x16&p0,f32x16&p1,int jb,int qrel,int hi){
  const float NEG=-INFINITY; int kb=64*jb+4*hi;
  #pragma unroll
  for(int r=0;r<16;++r){int kv=kb+(r&3)+8*(r>>2); if(kv>qrel)p0[r]=NEG; if(kv+32>qrel)p1[r]=NEG;}
}

constexpr int NSLOT=3, SLOTB=8192;
constexpr int VSLOTB=2*SLOTB;
constexpr int LDS_K=0, LDS_V=NSLOT*SLOTB, LDS_WS=LDS_V+NSLOT*VSLOTB, LDS_OST=LDS_WS+NW*64*4, ALDS_BYTES=LDS_OST+NW*4096;
constexpr float C2=0.125f*1.4426950408889634f;
__device__ __forceinline__ void glds16(const void*gsrc,unsigned lds_dst){unsigned keep;
  asm volatile("s_mov_b32 %0, m0\n\ts_mov_b32 m0, %2\n\ts_nop 0\n\tglobal_load_lds_dwordx4 %1, off\n\ts_mov_b32 m0, %0":"=&s"(keep):"v"(gsrc),"s"(lds_dst):"memory");}
__device__ __forceinline__ float max3f(float a,float b,float c){float r;asm("v_max3_f32 %0, %1, %2, %3":"=v"(r):"v"(a),"v"(b),"v"(c));return r;}
__device__ __forceinline__ float max2f(float a,float b){float r;asm("v_max_f32_e32 %0, %1, %2":"=v"(r):"v"(a),"v"(b));return r;}
__device__ __forceinline__ float fadd_s(float a,float b){float r;asm("v_add_f32_e32 %0, %1, %2":"=v"(r):"v"(a),"v"(b));return r;}
__device__ __forceinline__ float fsub_s(float a,float b){float r;asm("v_sub_f32_e32 %0, %1, %2":"=v"(r):"v"(a),"v"(b));return r;}
typedef float f32x2_t __attribute__((ext_vector_type(2))); typedef __bf16 bf16x2_t __attribute__((ext_vector_type(2)));
__device__ __forceinline__ unsigned cvtpk_s(float lo,float hi){f32x2_t v={lo,hi};bf16x2_t b=__builtin_convertvector(v,bf16x2_t);return __builtin_bit_cast(unsigned,b);}
#define WAIT_BAR(N) asm volatile("s_waitcnt vmcnt(" #N ") lgkmcnt(0)\n\ts_barrier":::"memory")

__device__ __forceinline__ void qkt(f32x16&p0,f32x16&p1,const char*Kslot,const bf16x8*qr,const f32x16&negm,int r32,int hi){
  const char*kb=Kslot+hi*1024+r32*16;
  #pragma unroll
  for(int d0=0;d0<4;++d0){
    const bf16x8 b0=*reinterpret_cast<const bf16x8*>(kb+d0*2048);
    const bf16x8 b1=*reinterpret_cast<const bf16x8*>(kb+d0*2048+512);
    if(d0==0){p0=__builtin_amdgcn_mfma_f32_32x32x16_bf16(b0,qr[0],negm,0,0,0);p1=__builtin_amdgcn_mfma_f32_32x32x16_bf16(b1,qr[0],negm,0,0,0);}
    else{p0=__builtin_amdgcn_mfma_f32_32x32x16_bf16(b0,qr[d0],p0,0,0,0);p1=__builtin_amdgcn_mfma_f32_32x32x16_bf16(b1,qr[d0],p1,0,0,0);}}
}
typedef __attribute__((address_space(3))) const char* lds_cptr;
typedef short v4i16_t __attribute__((ext_vector_type(4)));
__device__ __forceinline__ void kload8(bf16x8*kf,lds_cptr kp){
  kf[0]=*(const __attribute__((address_space(3))) bf16x8*)(kp);      kf[1]=*(const __attribute__((address_space(3))) bf16x8*)(kp+512);
  kf[2]=*(const __attribute__((address_space(3))) bf16x8*)(kp+2048); kf[3]=*(const __attribute__((address_space(3))) bf16x8*)(kp+2560);
  kf[4]=*(const __attribute__((address_space(3))) bf16x8*)(kp+4096); kf[5]=*(const __attribute__((address_space(3))) bf16x8*)(kp+4608);
  kf[6]=*(const __attribute__((address_space(3))) bf16x8*)(kp+6144); kf[7]=*(const __attribute__((address_space(3))) bf16x8*)(kp+6656);
}
__device__ __forceinline__ void kload2(bf16x8*kf,lds_cptr kp,int j){ kf[2*j]=*(const __attribute__((address_space(3))) bf16x8*)(kp+j*2048); kf[2*j+1]=*(const __attribute__((address_space(3))) bf16x8*)(kp+j*2048+512); }
__device__ __forceinline__ s16x4 vtr(lds_cptr p){ return __builtin_bit_cast(s16x4,__builtin_amdgcn_ds_read_tr16_b64_v4i16((__attribute__((address_space(3))) v4i16_t*)p)); }
__device__ __forceinline__ float rowmax(const f32x16&p0,const f32x16&p1){
  float a=max3f(p0[0],p0[1],p1[0]),b=max3f(p0[2],p0[3],p1[1]);a=max3f(a,p1[2],p1[3]);
  #pragma unroll
  for(int r=4;r<16;r+=4){a=max3f(a,p0[r],p0[r+1]);b=max3f(b,p0[r+2],p0[r+3]);a=max3f(a,p1[r],p1[r+1]);b=max3f(b,p1[r+2],p1[r+3]);}
  const float m=max2f(a,b);
  auto rr=__builtin_amdgcn_permlane32_swap(__float_as_uint(m),__float_as_uint(m),false,false);
  return max2f(__uint_as_float(rr[0]),__uint_as_float(rr[1]));
}
__device__ __forceinline__ void pv(f32x16*o,int vb,bf16x8 pa0,bf16x8 pa1,bf16x8 pa2,bf16x8 pa3){
  #pragma unroll
  for(int d0=0;d0<4;++d0){s16x4 lo[4],hi[4];
    #pragma unroll
    for(int ks=0;ks<4;++ks){
      asm volatile("ds_read_b64_tr_b16 %0,%1 offset:%c2":"=&v"(lo[ks]):"v"(vb),"i"(d0*4096+ks*1024):"memory");
      asm volatile("ds_read_b64_tr_b16 %0,%1 offset:%c2":"=&v"(hi[ks]):"v"(vb),"i"(d0*4096+ks*1024+512):"memory");}
    asm volatile("s_waitcnt lgkmcnt(0)":::"memory");SBAR();
    #define PK(k) (bf16x8){lo[k][0],lo[k][1],lo[k][2],lo[k][3],hi[k][0],hi[k][1],hi[k][2],hi[k][3]}
    o[d0]=__builtin_amdgcn_mfma_f32_32x32x16_bf16(pa0,PK(0),o[d0],0,0,0);
    o[d0]=__builtin_amdgcn_mfma_f32_32x32x16_bf16(pa1,PK(1),o[d0],0,0,0);
    o[d0]=__builtin_amdgcn_mfma_f32_32x32x16_bf16(pa2,PK(2),o[d0],0,0,0);
    o[d0]=__builtin_amdgcn_mfma_f32_32x32x16_bf16(pa3,PK(3),o[d0],0,0,0);
    #undef PK
  }
}

#ifndef ATTN_STORE16
#define ATTN_STORE16(p,v) (*(u32x4*)(p)=(v))
#endif
template<int THRL> __device__ __forceinline__ void attn_unit(int b,int qcol,int kcol,int vcol,int ocol,int qb,const bf16*Q,const bf16*__restrict__ K,const bf16*__restrict__ V,bf16*O,char*shm){
  int tid_=threadIdx.x; asm volatile("":"+v"(tid_));
  const int tid=tid_,lane=tid&63,r32=lane&31,hi=lane>>5; const int wid=__builtin_amdgcn_readfirstlane(tid>>6);
  const long rowbase=(long)b*SEQ; const int q0=qb*QB;
  const bf16*Qw=Q+(rowbase+q0+wid*QBLK)*DM+qcol;
  const bf16*Kh=K+rowbase*DM+kcol,*Vh=V+rowbase*DM+vcol;
  const unsigned lds0=(unsigned)(uintptr_t)shm;
  float*wsf=(float*)(shm+LDS_WS)+wid*64;
  const bf16*ksrc=Kh+(long)lane*DM+wid*8;
  const bf16*vsrc=Vh+(long)(16*(wid&3)+(lane>>2))*DM+(wid>>2)*32+(lane&3)*8;
  const unsigned kdst=lds0+LDS_K+wid*1024, vdst=lds0+LDS_V+wid*1024;
  #define DMA_K(t,slot) glds16(ksrc+(long)(t)*KVBLK*DM,(unsigned)__builtin_amdgcn_readfirstlane(kdst+(slot)))
  #define DMA_V(t,slot) do{ glds16(vsrc+(long)(t)*KVBLK*DM,(unsigned)__builtin_amdgcn_readfirstlane(vdst+2*(slot))); glds16(vsrc+64+(long)(t)*KVBLK*DM,(unsigned)__builtin_amdgcn_readfirstlane(vdst+8192+2*(slot))); }while(0)
  const int vb0=(int)(lds0+LDS_V)+((lane>>4)&1)*32+(lane&3)*8+(4*hi+((lane&15)>>2))*64;
  const char*Kbase=shm+LDS_K; bf16x8 kf[8];
  const lds_cptr shm3=(lds_cptr)shm; const lds_cptr kp0=shm3+LDS_K+hi*1024+r32*16; const lds_cptr vp0=shm3+LDS_V+((lane>>4)&1)*32+(lane&3)*8+(4*hi+((lane&15)>>2))*64;
  const int NT=(q0+QB)/KVBLK;
  DMA_K(0,0);DMA_V(0,0);DMA_K(1,SLOTB);
  bf16x8 qr[4];
  #pragma unroll
  for(int d0=0;d0<4;++d0)qr[d0]=*reinterpret_cast<const bf16x8*>(&Qw[(long)r32*DM+d0*16+hi*8]);
  float l_reg=0.f;f32x16 o[4];o[0]=f32x16{};o[1]=f32x16{};o[2]=f32x16{};o[3]=f32x16{};const f32x16 negm=f32x16{};
  const int qrel=wid*QBLK+r32;
  #define CMASK(P0,P1,t) do{int jb_=(t)-(NT-4); if(jb_>=0)cmask(P0,P1,jb_,qrel,hi);}while(0)
  #define START(P0,P1) do{ _Pragma("unroll") for(int r=0;r<16;++r)P0[r]=__builtin_amdgcn_exp2f(P0[r]); }while(0)
  #define RESC() do{}while(0)
  f32x16 pA0,pA1,pB0,pB1;
  int sl_prev=0,sl_cur=0,sl_next=SLOTB;
  #define ROT() do{sl_prev=sl_cur;sl_cur=sl_next;sl_next=(sl_next==(NSLOT-1)*SLOTB)?0:sl_next+SLOTB;}while(0)
  DMA_K(2,2*SLOTB);
  WAIT_BAR(4);
  qkt(pA0,pA1,Kbase,qr,negm,r32,hi);asm volatile("s_nop 15\n\ts_nop 7":"+v"(pA0),"+v"(pA1));CMASK(pA0,pA1,0);
  START(pA0,pA1);
  _Pragma("unroll") for(int r=0;r<16;++r)pA1[r]=__builtin_amdgcn_exp2f(pA1[r]);
  WAIT_BAR(0);
  DMA_K(3,0);DMA_V(1,SLOTB);
  ROT();
  kload8(kf,kp0+sl_cur);
  WAIT_BAR(3);
  s16x4 vlo[8],vhi[8]; u32x4 pw0,pw1,pw2,pw3;
  #define PKW(P,B) cvtpk_s(P[B],P[B+1])
  #define PAF(k) __builtin_bit_cast(bf16x8,pw##k)
  #define VFR(i) (bf16x8){vlo[i][0],vlo[i][1],vlo[i][2],vlo[i][3],vhi[i][0],vhi[i][1],vhi[i][2],vhi[i][3]}
  #define PIN(x) asm volatile("":"+v"(x))
  #define MX3(a,b,c) __builtin_fmaxf(__builtin_fmaxf((a),(b)),(c))
  #define GAPA(MF,A0,A1,A2,A3,W0,W1,PW) do{ MF; sacc+=A0; sacc+=A1; sacc+=A2; sacc+=A3; PIN(sacc); W0; W1; PIN(PW); SBAR(); }while(0)
  #define EX(v) __builtin_amdgcn_exp2f(v)
  #define GAPB(MF,X,B) do{ MF; X[B]=EX(X[B]); X[B+1]=EX(X[B+1]); PIN(X); SBAR(); }while(0)
  #define VRD2(i) do{ vlo[i]=vtr(vp_+((((i)>>2)+2)*4096+((i)&3)*1024)); vhi[i]=vtr(vp_+((((i)>>2)+2)*4096+((i)&3)*1024+512)); }while(0)
  #define VRD(i) do{ vlo[i]=vtr(vp_+(((i)>>2)*4096+((i)&3)*1024)); vhi[i]=vtr(vp_+(((i)>>2)*4096+((i)&3)*1024+512)); }while(0)
  #define KRD(G,j) do{ if(G){ kload2(kf,kp0+sl_next,j); SBAR(); } }while(0)
  #define STEP(C0,C1,P0,P1,t,GK,GV,GL) do{ SBAR(); \
    const lds_cptr vp_=vp0+2*sl_prev; \
    VRD(0); SBAR(); float sacc=(P0[0]+P0[1]); \
    GAPA(C0=__builtin_amdgcn_mfma_f32_32x32x16_bf16(kf[0],qr[0],negm,0,0,0), P0[2],P0[3],P0[4],P0[5],     pw0[0]=PKW(P0,0), pw0[1]=PKW(P0,2), pw0); \
    VRD(4); SBAR(); GAPA(C1=__builtin_amdgcn_mfma_f32_32x32x16_bf16(kf[1],qr[0],negm,0,0,0), P0[6],P0[7],P0[8],P0[9],     pw0[2]=PKW(P0,4), pw0[3]=PKW(P0,6), pw0); \
    VRD(1); SBAR(); GAPA(C0=__builtin_amdgcn_mfma_f32_32x32x16_bf16(kf[2],qr[1],C0,0,0,0),   P0[10],P0[11],P0[12],P0[13], pw1[0]=PKW(P0,8), pw1[1]=PKW(P0,10), pw1); \
    VRD(5); SBAR(); GAPA(C1=__builtin_amdgcn_mfma_f32_32x32x16_bf16(kf[3],qr[1],C1,0,0,0),   P0[14],P0[15],P1[0],P1[1],   pw1[2]=PKW(P0,12),pw1[3]=PKW(P0,14), pw1); \
    VRD(2); SBAR(); GAPA(C0=__builtin_amdgcn_mfma_f32_32x32x16_bf16(kf[4],qr[2],C0,0,0,0),   P1[2],P1[3],P1[4],P1[5],     pw2[0]=PKW(P1,0), pw2[1]=PKW(P1,2), pw2); \
    VRD(6); SBAR(); GAPA(C1=__builtin_amdgcn_mfma_f32_32x32x16_bf16(kf[5],qr[2],C1,0,0,0),   P1[6],P1[7],P1[8],P1[9],     pw2[2]=PKW(P1,4), pw2[3]=PKW(P1,6), pw2); \
    VRD(3); SBAR(); GAPA(C0=__builtin_amdgcn_mfma_f32_32x32x16_bf16(kf[6],qr[3],C0,0,0,0),   P1[10],P1[11],P1[12],P1[13], pw3[0]=PKW(P1,8), pw3[1]=PKW(P1,10), pw3); \
    VRD(7); SBAR(); GAPA(C1=__builtin_amdgcn_mfma_f32_32x32x16_bf16(kf[7],qr[3],C1,0,0,0),   P1[14],P1[15],0.f,0.f,       pw3[2]=PKW(P1,12),pw3[3]=PKW(P1,14), pw3); \
    l_reg+=sacc; \
    if(GK){DMA_K((t)+3,sl_cur);} if(GV){DMA_V((t)+1,sl_next);} \
    CMASK(C0,C1,t); \
    SBAR(); \
    GAPB(o[0]=__builtin_amdgcn_mfma_f32_32x32x16_bf16(PAF(0),VFR(0),o[0],0,0,0), C0,0);  VRD2(0); SBAR(); \
    GAPB(o[1]=__builtin_amdgcn_mfma_f32_32x32x16_bf16(PAF(0),VFR(4),o[1],0,0,0), C0,2);  VRD2(4); SBAR(); \
    KRD(GL,0); GAPB(o[0]=__builtin_amdgcn_mfma_f32_32x32x16_bf16(PAF(1),VFR(1),o[0],0,0,0), C0,4);  VRD2(1); SBAR(); \
    KRD(GL,1); GAPB(o[1]=__builtin_amdgcn_mfma_f32_32x32x16_bf16(PAF(1),VFR(5),o[1],0,0,0), C0,6);  VRD2(5); SBAR(); \
    KRD(GL,2); GAPB(o[0]=__builtin_amdgcn_mfma_f32_32x32x16_bf16(PAF(2),VFR(2),o[0],0,0,0), C0,8);  VRD2(2); SBAR(); \
    KRD(GL,3); GAPB(o[1]=__builtin_amdgcn_mfma_f32_32x32x16_bf16(PAF(2),VFR(6),o[1],0,0,0), C0,10); VRD2(6); SBAR(); \
    GAPB(o[0]=__builtin_amdgcn_mfma_f32_32x32x16_bf16(PAF(3),VFR(3),o[0],0,0,0), C0,12); VRD2(3); SBAR(); \
    GAPB(o[1]=__builtin_amdgcn_mfma_f32_32x32x16_bf16(PAF(3),VFR(7),o[1],0,0,0), C0,14); VRD2(7); SBAR(); \
    GAPB(o[2]=__builtin_amdgcn_mfma_f32_32x32x16_bf16(PAF(0),VFR(0),o[2],0,0,0), C1,0); \
    GAPB(o[3]=__builtin_amdgcn_mfma_f32_32x32x16_bf16(PAF(0),VFR(4),o[3],0,0,0), C1,2); \
    GAPB(o[2]=__builtin_amdgcn_mfma_f32_32x32x16_bf16(PAF(1),VFR(1),o[2],0,0,0), C1,4); \
    GAPB(o[3]=__builtin_amdgcn_mfma_f32_32x32x16_bf16(PAF(1),VFR(5),o[3],0,0,0), C1,6); \
    GAPB(o[2]=__builtin_amdgcn_mfma_f32_32x32x16_bf16(PAF(2),VFR(2),o[2],0,0,0), C1,8); \
    GAPB(o[3]=__builtin_amdgcn_mfma_f32_32x32x16_bf16(PAF(2),VFR(6),o[3],0,0,0), C1,10); \
    GAPB(o[2]=__builtin_amdgcn_mfma_f32_32x32x16_bf16(PAF(3),VFR(3),o[2],0,0,0), C1,12); \
    GAPB(o[3]=__builtin_amdgcn_mfma_f32_32x32x16_bf16(PAF(3),VFR(7),o[3],0,0,0), C1,14); \
    }while(0)
  int t=1;
  #undef CMASK
  #define CMASK(P0,P1,t) do{}while(0)
  for(;t+5<NT;t+=2){
    STEP(pB0,pB1,pA0,pA1,t,true,true,true);     WAIT_BAR(3); RESC(); ROT();
    STEP(pA0,pA1,pB0,pB1,t+1,true,true,true);   WAIT_BAR(3); RESC(); ROT();
  }
  #undef CMASK
  #define CMASK(P0,P1,t) do{int jb_=(t)-(NT-4); if(jb_>=0)cmask(P0,P1,jb_,qrel,hi);}while(0)
  #define ENDW(tt) do{ if((tt)+3<NT){WAIT_BAR(3);} else if((tt)+2<NT){WAIT_BAR(2);} else {WAIT_BAR(0);} }while(0)
  for(;t+1<NT;t+=2){
    STEP(pB0,pB1,pA0,pA1,t,(t+3<NT),(t+1<NT),(t+1<NT));       ENDW(t);   RESC(); ROT();
    STEP(pA0,pA1,pB0,pB1,t+1,(t+4<NT),(t+2<NT),(t+2<NT));     ENDW(t+1); RESC(); ROT();
  }
  STEP(pB0,pB1,pA0,pA1,NT-1,false,false,false); RESC();
  { float sacc=pB0[0]+pB0[1]; _Pragma("unroll") for(int r=2;r<16;++r)sacc+=pB0[r]; _Pragma("unroll") for(int r=0;r<16;++r)sacc+=pB1[r]; l_reg+=sacc;
    pw0=(u32x4){PKW(pB0,0),PKW(pB0,2),PKW(pB0,4),PKW(pB0,6)};pw1=(u32x4){PKW(pB0,8),PKW(pB0,10),PKW(pB0,12),PKW(pB0,14)};pw2=(u32x4){PKW(pB1,0),PKW(pB1,2),PKW(pB1,4),PKW(pB1,6)};pw3=(u32x4){PKW(pB1,8),PKW(pB1,10),PKW(pB1,12),PKW(pB1,14)};
    SBAR(); pv(o,vb0+2*sl_cur,PAF(0),PAF(1),PAF(2),PAF(3)); }
  #undef PKW
  #undef PAF
  #undef VFR
  #undef PIN
  #undef MX3
  #undef GAPA
  #undef GAPB
  #undef EX
  #undef VRD
  #undef VRD2
  #undef KRD
  #undef STEP
  #undef ENDW
  {auto rr=__builtin_amdgcn_permlane32_swap(__float_as_uint(l_reg),__float_as_uint(l_reg),false,false);l_reg=__uint_as_float(rr[0])+__uint_as_float(rr[1]);}
  if(hi==0)wsf[32+r32]=l_reg;asm volatile("s_waitcnt lgkmcnt(0)":::"memory");
  float rli[16];
  #pragma unroll
  for(int r=0;r<16;++r)rli[r]=__builtin_amdgcn_rcpf(wsf[32+crow(r,hi)]);
  bf16*Ow=O+(rowbase+q0+wid*QBLK)*DM+ocol;
  { bf16*stg=(bf16*)(shm+LDS_OST)+wid*2048;
    #pragma unroll
    for(int hv=0;hv<2;++hv){
      #pragma unroll
      for(int r=0;r<16;++r){const int orow=crow(r,hi);
        #pragma unroll
        for(int d0=0;d0<2;++d0)stg[orow*64+d0*32+r32]=__float2bfloat16(o[2*hv+d0][r]*rli[r]);}
      asm volatile("s_waitcnt lgkmcnt(0)":::"memory");
      #pragma unroll
      for(int i=0;i<4;++i){const int row=i*8+(lane>>3),ch=lane&7; const u32x4 v=*(const u32x4*)(stg+row*64+ch*8); ATTN_STORE16(Ow+(long)row*DM+hv*64+ch*8,v);}
      asm volatile("s_waitcnt lgkmcnt(0)":::"memory"); } }
  asm volatile("s_waitcnt lgkmcnt(0)\n\ts_barrier":::"memory");
  #undef DMA_K
  #undef DMA_V
  #undef CMASK
  #undef START
  #undef RESC
  #undef ROT
}
constexpr int ATTN_LDS_BYTES=ALDS_BYTES;

#undef SBAR
#undef WAIT_BAR
#undef ATTN_STORE16
}
constexpr size_t WS_ATT0 = WS_ACT, WS_ATT1 = WS_ACT + 32 * MiB;

__device__ __forceinline__ void diff_combine(const Params& P, int b, int h, int qb) {
    int tid_ = threadIdx.x; asm volatile("" : "+v"(tid_));
    const int tid = tid_, lane = tid & 63, wid = tid >> 6;
    const float lam = __expf(wave_sum(P.in[I_LQ1][lane] * P.in[I_LK1][lane])) - __expf(wave_sum(P.in[I_LQ2][lane] * P.in[I_LK2][lane])) + 0.2f;
    const int ch = lane & 15;
    const f32x4 g0 = *(const f32x4*)(P.in[I_SG] + 8 * ch), g1 = *(const f32x4*)(P.in[I_SG] + 8 * ch + 4);
    const size_t row0 = (size_t)b * SEQ + qb * 256 + wid * 32 + (lane >> 4);
    const bf16_t* s0 = (const bf16_t*)(P.ws + WS_ATT0) + row0 * D + h * 128 + 8 * ch; const bf16_t* s1 = (const bf16_t*)(P.ws + WS_ATT1) + row0 * D + h * 128 + 8 * ch;
    bf16_t* dst = (bf16_t*)(P.ws + WS_MA) + row0 * MA_LD + h * 128 + 8 * ch;
#pragma unroll
    for (int hb = 0; hb < 2; ++hb) { u32x4 ra[4], rb[4];
#pragma unroll
        for (int q = 0; q < 4; ++q) { const int it = 4 * hb + q; ra[q] = *(const u32x4*)(s0 + (size_t)(4 * it) * D); rb[q] = *(const u32x4*)(s1 + (size_t)(4 * it) * D); }
        asm volatile("" ::: "memory");
#pragma unroll
        for (int q = 0; q < 4; ++q) { const int it = 4 * hb + q;
            f32x4 a0, a1, b0, b1; pg::unpack8(ra[q], a0, a1); pg::unpack8(rb[q], b0, b1);
            const f32x4 o0 = a0 - lam * b0, o1 = a1 - lam * b1;
            float ss = (o0[0] * o0[0] + o0[1] * o0[1]) + (o0[2] * o0[2] + o0[3] * o0[3]) + (o1[0] * o1[0] + o1[1] * o1[1]) + (o1[2] * o1[2] + o1[3] * o1[3]);
            ss += __shfl_xor(ss, 1); ss += __shfl_xor(ss, 2); ss += __shfl_xor(ss, 4); ss += __shfl_xor(ss, 8);
            const float r = rsqrtf(ss * (1.f / 128.f) + EPS) * 0.8f;
            *(u32x4*)(dst + (size_t)(4 * it) * MA_LD) = pg::pack8(o0 * r * g0, o1 * r * g1); }
        asm volatile("" ::: "memory"); }
}
__device__ __forceinline__ void attn_phase(const Params& P, char* lds, int vcu, int G) {
    using attn_body::bf16;
    const bf16* Q = (const bf16*)(P.ws + WS_Q); const bf16* K = (const bf16*)(P.ws + WS_K); const bf16* V = (const bf16*)(P.ws + WS_V);
    for (int v = vcu; v < 256; v += G) {
        const int bh = v >> 2, b = bh >> 3, h = bh & 7, s = v & 3;
        for (int i = 0; i < 2; ++i) { const int qb = i == 0 ? 7 - s : s;
#ifndef ATTN_V128
#define ATTN_V128 1
#endif
#if ATTN_V128
            for (int m = 0; m < 2; ++m) {
#if EXPERTS_IN_ATTN
#ifndef CONV_SLOTS
#define CONV_SLOTS 4
#endif
#ifndef CONV_SPLIT
#define CONV_SPLIT 1
#endif
                if (CONV_SLOTS == 2 ? (i == 0 && m == ((v >> 2) & 1)) : ((i * 2 + m - (((v >> 2) + v) & 3)) & (CONV_SPLIT == 2 ? 1 : 3)) == 0) {
#ifndef ATT_PER_A
#define ATT_PER_A 40
#endif
                    constexpr int per = (EXP_M10 - EXP_ATT0) / 256, perA = ATT_PER_A, perB = 2 * per - ATT_PER_A;
                    const int bx_ = (v & 31) * 8 + (v >> 5); const bool grpA = bx_ < 128;
                    const int s0_ = (G != 256) ? EXP_ATT0 + v * per : (grpA ? EXP_ATT0 + bx_ * perA : EXP_ATT0 + 128 * perA + (bx_ - 128) * perB), s1_ = s0_ + ((G != 256) ? per : (grpA ? perA : perB));
                    expert_convert_slice(P, (LAS unsigned char*)lds, s0_, s1_);
#if defined(PROBE_CONV2)
                    asm volatile("s_waitcnt vmcnt(0) lgkmcnt(0)" ::: "memory"); __syncthreads(); expert_convert_slice(P, (LAS unsigned char*)lds, EXP_ATT0 + v * per, EXP_ATT0 + (v + 1) * per, true);
#endif
                    asm volatile("s_waitcnt vmcnt(0) lgkmcnt(0)" ::: "memory"); __syncthreads(); }
#endif
                attn128::attn_unit<8>(b, h * 128 + m * 64, h * 128 + m * 64, h * 128, h * 128, qb, (const attn128::bf16*)Q, (const attn128::bf16*)K, (const attn128::bf16*)V, (attn128::bf16*)(P.ws + (m == 0 ? WS_ATT0 : WS_ATT1)), lds); }
#else
            for (int pass = 0; pass < 4; ++pass) { const int m = pass >> 1, vh = pass & 1;
#if EXPERTS_IN_ATTN
                if (i * 4 + pass == (((v >> 2) + v) & 3)) {
                    constexpr int per = (EXP_M10 - EXP_ATT0) / 256; expert_convert_slice(P, (LAS unsigned char*)lds, EXP_ATT0 + v * per, EXP_ATT0 + (v + 1) * per);
                    asm volatile("s_waitcnt vmcnt(0) lgkmcnt(0)" ::: "memory"); __syncthreads(); }
#endif
                attn_body::attn_unit<8>(b, h * 128 + m * 64, h * 128 + m * 64, h * 128 + vh * 64, h * 128 + vh * 64, qb, Q, K, V, (bf16*)(P.ws + (m == 0 ? WS_ATT0 : WS_ATT1)), lds); }
#endif
            asm volatile("s_waitcnt vmcnt(0)" ::: "memory");
            diff_combine(P, b, h, qb);
        }
    }
}

__device__ __forceinline__ void ssm1_phase(const Params& P, LAS unsigned char* lds, int vcu, int G) {
    const int tid = opaque_tid(), lane = tid & 63, wid = __builtin_amdgcn_readfirstlane(tid >> 6), fr = lane & 15, fq = lane >> 4;
    LAS float* Sl = (LAS float*)lds;
    for (int u = vcu; u < SSM_G * BATCH; u += G) {
        const int g = u >> 3, b = u & 7;
        bf16_t* A = (bf16_t*)(P.ws + WS_ACAT) + (size_t)(g * ACAT_ROWS + b * NCH) * ACAT_LD;
        const bf16_t* Bw = (const bf16_t*)(P.ws + WS_WS_T) + (size_t)(g * 128 + 16 * wid + fr) * 512 + fq * 8;
        constexpr int SA_OFF = 40960, SA_RS = 1040;
#pragma unroll
        for (int i = 0; i < 8; ++i) { const int r = wid * 8 + i;
            __builtin_amdgcn_global_load_lds((const unsigned*)(A + (size_t)r * ACAT_LD + lane * 8), (LAS unsigned*)(lds + SA_OFF + r * SA_RS), 16, 0, 0); }
        bf16x8 bfr[16];
#pragma unroll
        for (int ks = 0; ks < 16; ++ks) bfr[ks] = *(const bf16x8*)(Bw + ks * 32);
        asm volatile("s_waitcnt vmcnt(0)" ::: "memory");
        __syncthreads();
        f32x4 acc[4];
#pragma unroll
        for (int m = 0; m < 4; ++m) acc[m] = (f32x4){0.f, 0.f, 0.f, 0.f};
#pragma unroll
        for (int ks = 0; ks < 16; ++ks) {
#pragma unroll
            for (int m = 0; m < 4; ++m) { const bf16x8 af = *(const LAS bf16x8*)(lds + SA_OFF + (16 * m + fr) * SA_RS + ks * 64 + fq * 16);
                acc[m] = __builtin_amdgcn_mfma_f32_16x16x32_bf16(af, bfr[ks], acc[m], 0, 0, 0); }
        }
#pragma unroll
        for (int m = 0; m < 4; ++m)
#pragma unroll
            for (int q = 0; q < 4; ++q) Sl[(16 * m + 4 * fq + q) * 129 + 16 * wid + fr] = acc[m][q];
        __syncthreads();
        if (tid < SSM_P) {
            const int p = tid; const SsmGP gp = ssm_gp(P, g, p); float aLr, aLi; ssm_pow(gp, CH_L, aLr, aLi);
            float xr = 0.f, xi = 0.f;
            bf16_t* xp = A + 512 + p;
            for (int c = 0; c < NCH; ++c) {
                xp[(size_t)c * ACAT_LD] = (bf16_t)f2bf(xr); xp[(size_t)c * ACAT_LD + 64] = (bf16_t)f2bf(xi);
                const float sr = Sl[c * 129 + p], si = Sl[c * 129 + 64 + p];
                const float nr = aLr * xr - aLi * xi + sr, ni = aLr * xi + aLi * xr + si; xr = nr; xi = ni;
            }
        }
        __syncthreads();
    }
}
namespace pg {
struct Ssm2Sched {
    unsigned char* ws; int G, c;
    __device__ __forceinline__ void init(unsigned char* ws_, int G_, int c_) { ws = ws_; G = G_; c = c_; }
    __device__ __forceinline__ bool next(int i, Unit& u) const {
        const int L = i * G + c; if (L >= SSM_G * 4) return false;
        const int g = L >> 2; u.pm = (L >> 1) & 1; u.pn = L & 1; u.aux = g; u.aux2 = 0; u.ord = i; const LaneRC rc;
        u.A = (const char*)((const bf16_t*)(ws + WS_ACAT) + (size_t)g * ACAT_ROWS * ACAT_LD); u.B = (const char*)((const bf16_t*)(ws + WS_BT_SSM) + ((size_t)g * 512 + u.pn * BM) * ACAT_LD);
#pragma unroll
        for (int h = 0; h < 2; ++h)
#pragma unroll
            for (int j = 0; j < 2; ++j) u.aoff[h][j] = (unsigned)(((u.pm * BM + 128 * h + rc.R[j]) * ACAT_LD + rc.C[j]) * 2);
        return true;
    }
};
}

constexpr int RT_LG_OFF = RING_BYTES + 2048;
constexpr int RT_HIST_OFF = RT_LG_OFF + 64 * 33 * 4;
__device__ __forceinline__ void router_phase(const Params& P, LAS unsigned char* lds, int vcu, int G) {
    const int tid = opaque_tid(), lane = tid & 63, wid = __builtin_amdgcn_readfirstlane(tid >> 6);
    const float* wrt = (const float*)(P.ws + WS_WR_T);
#pragma unroll
    for (int i = 0; i < 16; ++i) __builtin_amdgcn_global_load_lds((const unsigned*)(wrt + (size_t)(tid + NTHREADS * i) * 4), (LAS unsigned*)(lds + wid * 1024 + i * 8192), 16, 0, 0);
    LAS float* lg = (LAS float*)(lds + RT_LG_OFF); LAS int* hist = (LAS int*)(lds + RT_HIST_OFF);
    int* slot_tok = (int*)(P.ws + WS_SLOT_TOK); float* slot_gate = (float*)(P.ws + WS_SLOT_GATE); int* tok_ep = (int*)(P.ws + WS_TOK_EP);
    unsigned char* H2 = P.ws + WS_H2;
    for (int tb = vcu; tb < T / 64; tb += G) {
        if (tid < 64) hist[tid] = 0;
        _Pragma("clang loop unroll(disable)") for (int pass = 0; pass < 2; ++pass) {
            const int t0 = tb * 64 + wid * 8 + pass * 4;
            f32x4 h[4][4];
            { u32x2 hr[4][4];
#pragma unroll
              for (int t = 0; t < 4; ++t)
#pragma unroll
                  for (int j = 0; j < 4; ++j) hr[t][j] = NT_LOAD((const u32x2*)((const bf16_t*)(P.ws + WS_X1) + (size_t)(t0 + t) * D) + lane + 64 * j);
#pragma unroll
              for (int t = 0; t < 4; ++t)
#pragma unroll
                  for (int j = 0; j < 4; ++j) h[t][j] = (f32x4){bflo(hr[t][j].x), bfhi(hr[t][j].x), bflo(hr[t][j].y), bfhi(hr[t][j].y)}; }
            if (pass == 0) { asm volatile("s_waitcnt vmcnt(0)" ::: "memory"); __syncthreads(); }
            f32x2 ha[4][4], hb[4][4];
#pragma unroll
            for (int tp = 0; tp < 2; ++tp) {
                float s0 = 0.f, s1 = 0.f;
#pragma unroll
                for (int j = 0; j < 4; ++j) { const f32x4 a = h[2 * tp][j], b = h[2 * tp + 1][j]; s0 += (a.x * a.x + a.y * a.y) + (a.z * a.z + a.w * a.w); s1 += (b.x * b.x + b.y * b.y) + (b.z * b.z + b.w * b.w); }
                const float r0 = rsqrtf(wave_sum(s0) * (1.f / D) + EPS), r1 = rsqrtf(wave_sum(s1) * (1.f / D) + EPS);
#pragma unroll
                for (int j = 0; j < 4; ++j) { const f32x4 g2 = ((const f32x4*)P.in[I_G2])[lane + 64 * j]; const f32x4 a = h[2 * tp][j] * r0 * g2, b = h[2 * tp + 1][j] * r1 * g2;
                    ((unsigned*)(H2 + (size_t)(t0 + 2 * tp) * D))[lane + 64 * j] = pk4_fp8(a.x, a.y, a.z, a.w);
                    ((unsigned*)(H2 + (size_t)(t0 + 2 * tp + 1) * D))[lane + 64 * j] = pk4_fp8(b.x, b.y, b.z, b.w);
#pragma unroll
                    for (int c = 0; c < 4; ++c) { const f32x2 pr = {a[c], b[c]}; if (tp == 0) ha[j][c] = pr; else hb[j][c] = pr; } }
            }
            f32x2 v[64];
#pragma unroll
            for (int e = 0; e < NE; ++e) { f32x2 a0 = {0.f, 0.f}, a1 = {0.f, 0.f};
                f32x4 w[4];
#pragma unroll
                for (int j = 0; j < 4; ++j) w[j] = ((const LAS f32x4*)(lds + e * 4096))[lane + 64 * j];
#pragma unroll
                for (int j = 0; j < 4; ++j)
#pragma unroll
                    for (int c = 0; c < 4; ++c) { const f32x2 ww = {w[j][c], w[j][c]}; a0 += ha[j][c] * ww; a1 += hb[j][c] * ww; }
                v[e] = a0; v[32 + e] = a1; }
#pragma unroll
            for (int half = 32; half >= 1; half >>= 1) { const bool upper = (lane & half) != 0;
#pragma unroll
                for (int i = 0; i < half; ++i) { const f32x2 send = upper ? v[i] : v[i + half], keep = upper ? v[i + half] : v[i]; const f32x2 got = {__shfl_xor(send.x, half), __shfl_xor(send.y, half)}; v[i] = keep + got; } }
            const float br = P.in[I_BR][lane & 31]; const int tl = wid * 8 + pass * 4 + 2 * (lane >> 5);
            lg[tl * 33 + (lane & 31)] = v[0].x + br; lg[(tl + 1) * 33 + (lane & 31)] = v[0].y + br;
        }
        __syncthreads();
        if (wid == 0) {
            const int tok = tb * 64 + lane;
            float tv[4]; int ti[4];
#pragma unroll
            for (int k = 0; k < 4; ++k) { tv[k] = -INFINITY; ti[k] = 0; }
            for (int e = 0; e < NE; ++e) { const float x = lg[lane * 33 + e];
                if (x > tv[3]) { if (x > tv[2]) { tv[3] = tv[2]; ti[3] = ti[2]; if (x > tv[1]) { tv[2] = tv[1]; ti[2] = ti[1]; if (x > tv[0]) { tv[1] = tv[0]; ti[1] = ti[0]; tv[0] = x; ti[0] = e; } else { tv[1] = x; ti[1] = e; } } else { tv[2] = x; ti[2] = e; } } else { tv[3] = x; ti[3] = e; } } }
            const float e1 = __expf(tv[1] - tv[0]), e2 = __expf(tv[2] - tv[0]), e3 = __expf(tv[3] - tv[0]); const float inv = 1.f / (1.f + e1 + e2 + e3);
            const float gk[4] = {inv, e1 * inv, e2 * inv, e3 * inv};
            int lp[4];
#pragma unroll
            for (int k = 0; k < 4; ++k) lp[k] = atomicAdd((int*)&hist[ti[k]], 1);
            asm volatile("s_waitcnt lgkmcnt(0)" ::: "memory");
            { const int l2 = opaque_tid() & 63;
              if (l2 < NE) { const int n = hist[l2]; hist[32 + l2] = n ? (int)atomicAdd((unsigned*)(P.ws + WS_CTL) + CW_CNT + l2, (unsigned)n) : 0; } }
            asm volatile("s_waitcnt vmcnt(0) lgkmcnt(0)" ::: "memory");
            u32x4 epw;
#pragma unroll
            for (int k = 0; k < 4; ++k) { const int e = ti[k], pos = hist[32 + e] + lp[k];
                *(u32x2*)(slot_tok + ((size_t)e * CAP + pos) * 2) = (u32x2){(unsigned)tok, __builtin_bit_cast(unsigned, gk[k])}; epw[k] = (unsigned)((e << 16) | pos); }
            *(u32x4*)(tok_ep + tok * 4) = epw;
        }
        __syncthreads();
    }
}

#ifdef COMB_Y_NT
#define COMB_Y_LOAD(p) NT_LOAD(p)
#else
#define COMB_Y_LOAD(p) (*(p))
#endif
__device__ __forceinline__ void combine_phase(const Params& P, LAS unsigned char* lds, int vcu, int G) {
    const int tid = opaque_tid(), lane = tid & 63, wid = __builtin_amdgcn_readfirstlane(tid >> 6);
    const LAS int* tab = (const LAS int*)(lds + pg::TAB_OFF);
    const int* tok_ep = (const int*)(P.ws + WS_TOK_EP); const unsigned char* Y = P.ws + WS_Y; const float* sgate = (const float*)(P.ws + WS_SLOT_TOK);
    for (int tok = (vcu * NWAVES + wid) * 2; tok < T; tok += G * NWAVES * 2) {
        f32x4 a[2][4]; u32x2 xr[2][4]; unsigned yv[2][4][4]; float gk[2][4];
#pragma unroll
        for (int tt = 0; tt < 2; ++tt) {
#pragma unroll
            for (int j = 0; j < 4; ++j) xr[tt][j] = NT_LOAD((const u32x2*)((const bf16_t*)(P.ws + WS_X1) + (size_t)(tok + tt) * D) + lane + 64 * j);
#pragma unroll
            for (int k = 0; k < 4; ++k) { const int ep = tok_ep[(tok + tt) * 4 + k]; const int slot = tab[ep >> 16] * 256 + (ep & 0xffff); gk[tt][k] = sgate[((size_t)(ep >> 16) * CAP + (ep & 0xffff)) * 2 + 1] * (1.f / 16.f);
#pragma unroll
                for (int j = 0; j < 4; ++j) yv[tt][k][j] = COMB_Y_LOAD((const unsigned*)(Y + (size_t)slot * D) + lane + 64 * j); } }
        asm volatile("" ::: "memory");
#pragma unroll
        for (int tt = 0; tt < 2; ++tt) {
#pragma unroll
            for (int j = 0; j < 4; ++j) a[tt][j] = (f32x4){bflo(xr[tt][j].x), bfhi(xr[tt][j].x), bflo(xr[tt][j].y), bfhi(xr[tt][j].y)};
#pragma unroll
            for (int k = 0; k < 4; ++k)
#pragma unroll
                for (int j = 0; j < 4; ++j) { float y0, y1, y2, y3; unpk4_fp8(yv[tt][k][j], y0, y1, y2, y3); a[tt][j] += gk[tt][k] * (f32x4){y0, y1, y2, y3}; }
#pragma unroll
            for (int j = 0; j < 4; ++j) NT_STORE(a[tt][j], (f32x4*)(P.out + (size_t)(tok + tt) * D) + lane + 64 * j); }
    }
}
#define XB_TMO      128
#define XB_XCNT(j)  (256  + 64 * (j))
#define XB_XSUB(j)  (1280 + 64 * (j))
#define XB_XGEN(j)  (2304 + 64 * (j))
#define XB_TOP      3328
#define XB_TOPGEN   3392
#define XCD_BAR_WORDS 3456
#define XB_SPIN_CAP (1u << 18)
__device__ __forceinline__ unsigned xb_ld(unsigned* p)              { return __hip_atomic_load(p, __ATOMIC_RELAXED, __HIP_MEMORY_SCOPE_AGENT); }
__device__ __forceinline__ unsigned xb_add(unsigned* p, unsigned v) { return __hip_atomic_fetch_add(p, v, __ATOMIC_RELAXED, __HIP_MEMORY_SCOPE_AGENT); }
__device__ __forceinline__ unsigned xb_xcc_id() { return (unsigned)__builtin_amdgcn_s_getreg((3 << 11) | 20) & 0xFu; }
#define XB_SPIN(cond, bar) do { unsigned _sp = 0; while (cond) { __builtin_amdgcn_s_sleep(1); \
    if ((++_sp & 255u) == 0u) { if (xb_ld(&(bar)[XB_TMO])) break; if (_sp > XB_SPIN_CAP) { atomicAdd(&(bar)[XB_TMO], 1u); break; } } } } while (0)
struct XcdBarrier { unsigned* bar; unsigned x; volatile LAS unsigned* st; };
__device__ __forceinline__ XcdBarrier xcd_barrier_post(unsigned* bar, volatile LAS unsigned* st) {
    XcdBarrier b; b.bar = bar; b.x = xb_xcc_id(); b.st = st;
    if (threadIdx.x == 0) (void)xb_add(&bar[XB_XCNT(b.x)], 1u);
    return b;
}
__device__ __forceinline__ void xcd_barrier_complete(unsigned* bar, unsigned x, unsigned& nloc, unsigned& nx) {
    const unsigned G = gridDim.x * gridDim.y * gridDim.z;
    unsigned sum, cnt, mine, sp = 0u;
    for (;;) {
        sum = 0u; cnt = 0u; mine = 0u;
#pragma unroll
        for (unsigned j = 0; j < 16; ++j) { const unsigned c = xb_ld(&bar[XB_XCNT(j)]); sum += c; cnt += (c > 0u) ? 1u : 0u; mine = (j == x) ? c : mine; }
        if (sum == G) break;
        __builtin_amdgcn_s_sleep(1);
        if ((++sp & 255u) == 0u) { if (xb_ld(&bar[XB_TMO])) break; if (sp > XB_SPIN_CAP) { atomicAdd(&bar[XB_TMO], 1u); break; } }
    }
    nloc = mine > 0u ? mine : 1u; nx = cnt > 0u ? cnt : 1u;
}
__device__ __forceinline__ void xcd_barrier_enter(const XcdBarrier& b) {
    asm volatile("s_waitcnt vmcnt(0)" ::: "memory");
    __syncthreads();
}
__device__ __forceinline__ void xcd_barrier_finish(const XcdBarrier& b);
__device__ __forceinline__ void xcd_barrier(const XcdBarrier& b) { xcd_barrier_enter(b); xcd_barrier_finish(b); }
__device__ __forceinline__ void xcd_barrier_finish(const XcdBarrier& b) {
    if (threadIdx.x == 0) {
        unsigned* bar = b.bar;
        __builtin_amdgcn_s_waitcnt(0);
        unsigned nloc = b.st[0], nx = b.st[1];
        if (nloc == 0u) { xcd_barrier_complete(bar, b.x, nloc, nx); b.st[0] = nloc; b.st[1] = nx; }
        const unsigned old = xb_add(&bar[XB_XSUB(b.x)], 1u);
        const unsigned gen = old / nloc;
        if (old + 1u == (gen + 1u) * nloc) {
            __builtin_amdgcn_fence(__ATOMIC_RELEASE, "agent");
            asm volatile("s_waitcnt vmcnt(0)" ::: "memory");
            const unsigned og = xb_add(&bar[XB_TOP], 1u);
            const unsigned tg = og / nx;
            if (og + 1u == (tg + 1u) * nx) xb_add(&bar[XB_TOPGEN], 1u);
            else XB_SPIN(xb_ld(&bar[XB_TOPGEN]) == tg, bar);
            __builtin_amdgcn_fence(__ATOMIC_ACQUIRE, "agent");
            xb_add(&bar[XB_XGEN(b.x)], 1u);
            asm volatile("s_waitcnt vmcnt(0)" ::: "memory");
        } else {
            XB_SPIN(xb_ld(&bar[XB_XGEN(b.x)]) == gen, bar);
            __builtin_amdgcn_fence(__ATOMIC_ACQUIRE, "agent");
            asm volatile("s_waitcnt vmcnt(0)" ::: "memory");
        }
    }
    __syncthreads();
}

__device__ __forceinline__ void xcd_announce(const XcdBarrier& b, unsigned* w) {
    asm volatile("s_waitcnt vmcnt(0)" ::: "memory");
    __syncthreads();
    if (threadIdx.x == 0) { unsigned nloc = b.st[0]; if (nloc == 0u) { unsigned nx; xcd_barrier_complete(b.bar, b.x, nloc, nx); b.st[0] = nloc; b.st[1] = nx; }
        const unsigned old = xb_add(&w[64 * (1 + b.x)], 1u);
        if (old + 1u == nloc) { __builtin_amdgcn_fence(__ATOMIC_RELEASE, "agent"); asm volatile("s_waitcnt vmcnt(0)" ::: "memory"); xb_add(&w[0], nloc); } }
}
__device__ __forceinline__ void xcd_await(const XcdBarrier& b, unsigned* w) {
    if (threadIdx.x == 0) { const unsigned G = gridDim.x * gridDim.y * gridDim.z; XB_SPIN(xb_ld(&w[0]) < G, b.bar); __builtin_amdgcn_fence(__ATOMIC_ACQUIRE, "agent"); asm volatile("s_waitcnt vmcnt(0)" ::: "memory"); }
    __syncthreads();
}
#ifndef PH_MASK
#define PH_MASK 0xffffffffu
#endif
__global__ void __launch_bounds__(NTHREADS, 2) mega_fwd(Params P) {
    extern __shared__ __attribute__((aligned(16))) unsigned char lds_[];
    LAS unsigned char* lds = (LAS unsigned char*)lds_;
    const int tid = threadIdx.x;
    const int G = gridDim.x, bx = blockIdx.x, vcu = (G % 8 == 0) ? (bx % 8) * (G / 8) + bx / 8 : bx;
    for (int u = tid; u < (LDS_BYTES - RING_BYTES) / 4; u += NTHREADS) ((LAS unsigned*)(lds + RING_BYTES))[u] = 0u;
    __syncthreads();
    unsigned* ctl = (unsigned*)(P.ws + WS_CTL);
    const XcdBarrier bar = xcd_barrier_post(ctl + CW_BAR, (volatile LAS unsigned*)(lds + MISC_OFF) + 8);
#ifndef PH_REP
#define PH_REP 0u
#endif
#ifndef BAR_REP
#define BAR_REP 1
#endif
#define GRID_BAR() do { for (int b_ = 0; b_ < BAR_REP; ++b_) xcd_barrier(bar); } while (0)
#define ON(k) for (int r_ = 0; r_ < 1 + (int)((PH_REP >> (k)) & 1u); ++r_) if ((PH_MASK >> (k)) & 1u)
#ifndef FWD_REP
#define FWD_REP 1
#endif
    for (int fwd_ = 0; fwd_ < FWD_REP; ++fwd_) {
    if (fwd_ > 0) { GRID_BAR(); if (bx == 0 && tid < 64) ctl[CW_CNT + tid] = 0u; }
    _Pragma("clang loop unroll(disable)") for (int part = 0; part < 2; ++part) { p0_prologue(P, lds, vcu, G, part); if (part == 0) xcd_announce(bar, ctl + CW_P0); }
    xcd_await(bar, ctl + CW_P0);
    ON(1) { pg::EpiInProj E; E.ws = P.ws; E.qg = P.in[I_QG]; E.kg = P.in[I_KG];
        { pg::InProjSched<0> S; S.init(P.ws + WS_XN, P.ws + WS_WIN_T, G, bx); pg::gemm_phase<false>(lds, S, E, D / 64, D); }
        { pg::InProjSched<1> S; S.init(P.ws + WS_XN8, P.ws + WS_WIN8, G, bx); pg::gemm_phase<true>(lds, S, E, D / 128, D / 2); }
        if (r_ == 0) xcd_announce(bar, ctl + CW_QKV);
#if EXPERTS_IN_ATTN
        if (r_ == 0 && G == 256 && bx >= 128) expert_convert_slice(P, lds, EXP_IN0 + (bx - 128) * EXP_N_IN, EXP_IN0 + (bx - 127) * EXP_N_IN);
        __syncthreads();
#endif
    }
    xcd_await(bar, ctl + CW_QKV);
    ON(2) { ssm_toeplitz_expand(P, vcu, G); ssm1_phase(P, lds, vcu, G); }
    xcd_announce(bar, ctl + CW_SSM1);
    const bool grpA = (G != 256) || bx < 128;
    if (grpA) {
        xcd_await(bar, ctl + CW_SSM1);
        ON(4) { pg::Ssm2Sched S; S.init(P.ws, G, bx); pg::EpiSsm2 E; E.ws = P.ws; pg::gemm_phase(lds, S, E, ACAT_LD / 64, ACAT_LD); }
        xcd_announce(bar, ctl + CW_S2); xcd_await(bar, ctl + CW_S2);
        ON(5) { pg::DenseSched S; S.init((const bf16_t*)(P.ws + WS_Z), SSM_W, (const bf16_t*)(P.ws + WS_WGLU_T), SSM_W, T, SSM_W, G, bx);
            pg::EpiGlu E; E.ws = P.ws; E.bglu = P.in[I_BGLU]; pg::gemm_phase(lds, S, E, SSM_W / 64, SSM_W); }
    } else xcd_announce(bar, ctl + CW_S2);
    ON(3) attn_phase(P, (char*)lds_, vcu, G);
    xcd_announce(bar, ctl + CW_PRE5);
    unsigned wg0_ = 0u, wg1_ = 0u;
    { pg::DenseSched S0; S0.init((const bf16_t*)(P.ws + WS_MA), MA_LD, (const bf16_t*)(P.ws + WS_WP_T), MA_LD, T, D, G, bx); pg::Unit u0;
      if (S0.next(0, u0)) { const int t_ = opaque_tid(); const size_t o_ = (size_t)(u0.pm * 256 + (t_ >> 1)) * D + u0.pn * 256 + (t_ & 1) * 128;
          wg0_ = *(const unsigned*)(P.ws + WS_GS + o_); wg1_ = *(const unsigned*)(P.ws + WS_GA + o_); } }
    xcd_await(bar, ctl + CW_PRE5);
    asm volatile("" :: "v"(wg0_), "v"(wg1_));
    ON(6) { pg::DenseSched S; S.init((const bf16_t*)(P.ws + WS_MA), MA_LD, (const bf16_t*)(P.ws + WS_WP_T), MA_LD, T, D, G, bx);
        pg::EpiMerged E; E.ws = P.ws; pg::gemm_phase(lds, S, E, MA_LD / 64, MA_LD); }
    pg::Acc accx;
    { xcd_barrier_enter(bar);
      pg::DenseSched S0; S0.init((const bf16_t*)(P.ws + WS_MERGED), D, (const bf16_t*)(P.ws + WS_WOUT_T), D, T, D, G, bx); pg::Unit u0; const bool has0 = S0.next(0, u0);
      const int t_ = opaque_tid(), w_ = __builtin_amdgcn_readfirstlane(t_ >> 6), l_ = t_ & 63, wr_ = w_ >> 2, wc_ = w_ & 3, fr_ = l_ & 15, fq_ = l_ >> 4;
      _Pragma("clang loop unroll(disable)") for (int ps_ = 0; ps_ < 2; ++ps_) {
          if ((w_ != 0) == (ps_ == 0)) {
#pragma unroll
              for (int ai = 0; ai < 2; ++ai)
#pragma unroll
                  for (int m = 0; m < 4; ++m)
#pragma unroll
                      for (int bj = 0; bj < 2; ++bj)
#pragma unroll
                          for (int n = 0; n < 2; ++n) { const float* xp = P.in[I_X] + (size_t)(u0.pm * 256 + ai * 128 + wr_ * 64 + m * 16 + fr_) * D + u0.pn * 256 + 64 * wc_ + 32 * bj + 8 * fq_ + 4 * n;
                              accx[ai][bj][m][n] = has0 ? NT_LOAD((const f32x4*)xp) : (f32x4){0.f, 0.f, 0.f, 0.f}; } }
          if (ps_ == 0) { for (int b_ = 0; b_ < BAR_REP; ++b_) xcd_barrier_finish(bar); } } }
    ON(7) { pg::DenseSched S; S.init((const bf16_t*)(P.ws + WS_MERGED), D, (const bf16_t*)(P.ws + WS_WOUT_T), D, T, D, G, bx);
        pg::EpiWout E; E.x = P.in[I_X]; E.out = (bf16_t*)(P.ws + WS_X1); E.pre = (r_ == 0); pg::gemm_phase(lds, S, E, D / 64, D, -1, r_ == 0 ? &accx : nullptr); }
    GRID_BAR();
    ON(8) router_phase(P, lds, vcu, G);
    GRID_BAR();
    pg::moe_build_tab(lds, (const unsigned*)(P.ws + WS_CTL) + CW_CNT, G, bx);
    ON(9) { pg::MoeSched<1> S; S.init(P.ws, lds, G, bx, P.in[I_B1]); pg::EpiMoe1 E; E.ws = P.ws; E.b1 = P.in[I_B1]; E.lds = lds; E.nostore = (r_ == 1); E.sig = ctl + CW_EARLY; E.xcc = bar.x; E.nloc = bar.st[0]; E.sig_ord = r_ == 0 ? __builtin_amdgcn_readfirstlane(((const LAS int*)(lds + pg::TAB_OFF))[88]) : -1;
#if defined(PROBE_MOE_NT)
        if (r_ == 1) { pg::EpiNull EN; pg::gemm_phase<true>(lds, S, EN, PROBE_MOE_NT, D / 2, 7); } else
#endif
        pg::gemm_phase<true>(lds, S, E, D / 128, D / 2);
#if EXPERTS_IN_ATTN
        if (r_ == 0 && G == 256 && (bx >> 3) >= 16) { const int k_ = (bx & 7) * 16 + (bx >> 3) - 16; expert_convert_slice(P, lds, EXP_M10 + k_ * EXP_N_M1, EXP_M10 + (k_ + 1) * EXP_N_M1); }
        __syncthreads();
#endif
    }
    xcd_announce(bar, ctl + CW_M1DONE);
    _Pragma("clang loop unroll(disable)") for (int pass = 0; pass < 3; ++pass) {
        pg::MoeSched<2> S; pg::EpiMoe2 E; E.ws = P.ws; E.b2 = P.in[I_B2]; E.lds = lds;
        const int sg_ = __builtin_amdgcn_readfirstlane(((const LAS int*)(lds + pg::TAB_OFF))[88]), n1_ = __builtin_amdgcn_readfirstlane(((const LAS int*)(lds + pg::TAB_OFF))[91]);
        if (pass == 0) {
            const int ex = __builtin_amdgcn_readfirstlane(((const LAS int*)(lds + pg::TAB_OFF))[89]), ek = __builtin_amdgcn_readfirstlane(((const LAS int*)(lds + pg::TAB_OFF))[90]);
            if (ex < 0) continue;
            xcd_await(bar, ctl + CW_EARLY);
            S.init_early(P.ws, lds, G, ex, ek);
        } else if (pass == 1) {
            if (sg_ >= 0) xcd_await(bar, ctl + CW_EARLY); else xcd_await(bar, ctl + CW_M1DONE);
            S.init(P.ws, lds, G, bx, P.in[I_B2]); S.maxi = n1_;
        } else { xcd_await(bar, ctl + CW_M1DONE); S.init_part(P.ws, lds, G, bx, n1_); }
        pg::gemm_phase<true>(lds, S, E, DFF / 128, DFF / 2);
    }
    GRID_BAR();
    ON(11) combine_phase(P, lds, vcu, G);
    }
#undef ON
}

extern "C" void kernel_launch(void* const* d_in, const int* in_sizes, int n_in, void* d_out, int out_size, void* d_ws, size_t ws_size, hipStream_t stream) {
    static int grid = 0;
    if (grid == 0) {
        int dev = 0, cus = 0, per_cu = 0;
        if (hipGetDevice(&dev) != hipSuccess || hipDeviceGetAttribute(&cus, hipDeviceAttributeMultiprocessorCount, dev) != hipSuccess) { fprintf(stderr, "kernel_launch: device query failed\n"); grid = -1; return; }
        if (hipFuncSetAttribute((const void*)mega_fwd, hipFuncAttributeMaxDynamicSharedMemorySize, LDS_BYTES) != hipSuccess) { fprintf(stderr, "kernel_launch: hipFuncSetAttribute failed\n"); grid = -1; return; }
        if (hipOccupancyMaxActiveBlocksPerMultiprocessor(&per_cu, (const void*)mega_fwd, NTHREADS, LDS_BYTES) != hipSuccess || per_cu < 1) { fprintf(stderr, "kernel_launch: occupancy query reports %d workgroups per CU\n", per_cu); per_cu = 1; }
        (void)hipGetLastError();
        grid = cus;
        if (ws_size < WS_END) { fprintf(stderr, "kernel_launch: workspace too small\n"); grid = -1; return; }
    }
    if (grid < 0) return;
    hipMemsetAsync((char*)d_ws + WS_CTL, 0, CTL_ZERO_BYTES, stream);
    Params P{};
    for (int i = 0; i < 30; ++i) P.in[i] = (const float*)d_in[i];
    P.out = (float*)d_out; P.ws = (unsigned char*)d_ws;
    hipLaunchKernelGGL(mega_fwd, dim3(grid), dim3(NTHREADS), LDS_BYTES, stream, P);
#if defined(PROBE_TWO_LAUNCHES)
    hipMemsetAsync((char*)d_ws + WS_CTL, 0, CTL_ZERO_BYTES, stream);
    hipLaunchKernelGGL(mega_fwd, dim3(grid), dim3(NTHREADS), LDS_BYTES, stream, P);
#endif
}
```
